# Optimizing an MI355X kernel written in HIP

```python
import math
import jax
import jax.numpy as jnp
from jax import lax
import numpy as np

D_MODEL = 1024
BATCH = 4
SEQ = 8192
DEPTH = 2

MIX_WIDTH = D_MODEL // 2
DN_HEADS = 4
DN_DIM = MIX_WIDTH // DN_HEADS
DN_CONV = 5
CHUNK = 64
POOL_WINDOWS = (2, 4, 8, 16)
POOL_GROUPS = 4
POOL_DIM = MIX_WIDTH // POOL_GROUPS
ML_HEADS = 4
ML_V_DIM = MIX_WIDTH // ML_HEADS
ML_QK_DIM = ML_V_DIM // 2
N_BRANCH = 3
N_EXPERTS = 32
N_GROUPS = 8
EXPERTS_PER_GROUP = N_EXPERTS // N_GROUPS
TOP_K = 2
D_EXPERT = D_MODEL // 2
MOE_BLOCK = 128
LN_EPS = 1e-5
NORM_EPS = 1e-6

SPLITS = (3 * MIX_WIDTH,
          MIX_WIDTH,
          2 * DN_HEADS,
          2 * DN_HEADS,
          MIX_WIDTH,
          ML_HEADS * ML_QK_DIM,
          ML_HEADS * ML_QK_DIM,
          MIX_WIDTH,
          MIX_WIDTH,
          2 * ML_HEADS,
          2 * ML_HEADS,
          N_BRANCH * D_MODEL)
D_IN_PROJ = sum(SPLITS)

kernel_name = 'hybrid_gdn_pool_mlstm_grouped_moe_encoder'


def layer_norm(x, g, b):
    xf = x.astype(jnp.float32)
    mu = jnp.mean(xf, -1, keepdims=True)
    var = jnp.mean(jnp.square(xf - mu), -1, keepdims=True)
    return ((xf - mu) * lax.rsqrt(var + LN_EPS) * g.astype(jnp.float32) + b.astype(jnp.float32)).astype(x.dtype)


def head_rms_norm(h, w):
    h = h * lax.rsqrt(jnp.mean(h * h, -1, keepdims=True) + NORM_EPS)
    return h.reshape(h.shape[0], h.shape[1], -1) * w


def head_layer_norm(h, w):
    h = h - jnp.mean(h, -1, keepdims=True)
    h = h * lax.rsqrt(jnp.mean(h * h, -1, keepdims=True) + NORM_EPS)
    return h.reshape(h.shape[0], h.shape[1], -1) * w


def l2norm(x):
    return x * lax.rsqrt(jnp.sum(x * x, -1, keepdims=True) + NORM_EPS)


def centred_depthwise_conv(x, w):
    width, ch = w.shape
    pad = width // 2
    return lax.conv_general_dilated(x, w[:, None, :], window_strides=(1,), padding=[(pad, pad)],
                                    dimension_numbers=('NWC', 'WIO', 'NWC'), feature_group_count=ch)


def tri_masks(n):
    ones = jnp.ones((n, n), dtype=bool)
    return jnp.tril(ones), jnp.tril(ones, -1)


def gated_delta_rule(q, k, v, beta, g):
    nb, nh, ns, dk = q.shape
    dv = v.shape[-1]
    nc = ns // CHUNK
    q, k, v = (t.reshape(nb, nh, nc, CHUNK, -1) for t in (q, k, v))
    beta, g = (t.reshape(nb, nh, nc, CHUNK) for t in (beta, g))
    incl, strict = tri_masks(CHUNK)
    gc = jnp.cumsum(g, axis=-1)
    decay = jnp.exp(jnp.where(incl, gc[..., :, None] - gc[..., None, :], -jnp.inf))
    kb = k * beta[..., None]
    m = jnp.where(strict, jnp.einsum('bhnid,bhnjd->bhnij', kb, k) * decay, 0.0)
    a_mat = m + jnp.eye(CHUNK, dtype=m.dtype)
    rhs = jnp.concatenate([v * beta[..., None], kb * jnp.exp(gc)[..., None]], axis=-1)
    sol = lax.linalg.triangular_solve(a_mat, rhs, left_side=True, lower=True, unit_diagonal=True)
    u, w = sol[..., :dv], sol[..., dv:]
    g_last = gc[..., -1]
    k_dec = k * jnp.exp(g_last[..., None] - gc)[..., None]

    def step(state, inp):
        w_n, u_n, kd_n, gl_n = inp
        v_new = u_n - jnp.einsum('bhlk,bhkv->bhlv', w_n, state)
        state_next = state * jnp.exp(gl_n)[..., None, None] + jnp.einsum('bhlk,bhlv->bhkv', kd_n, v_new)
        return state_next, (state, v_new)

    xs = tuple(jnp.moveaxis(t, 2, 0) for t in (w, u, k_dec, g_last))
    s0 = jnp.zeros((nb, nh, dk, dv), jnp.float32)
    _, (states, v_new) = lax.scan(step, s0, xs)
    states = jnp.moveaxis(states, 0, 2)
    v_new = jnp.moveaxis(v_new, 0, 2)
    attn = jnp.einsum('bhnid,bhnjd->bhnij', q, k) * decay
    o = (jnp.einsum('bhnld,bhndv->bhnlv', q * jnp.exp(gc)[..., None], states)
         + jnp.einsum('bhnij,bhnjv->bhniv', attn, v_new))
    return o.reshape(nb, nh, ns, dv)


def mlstm_chunkwise(q, k, v, i_pre, f_pre):
    nb, nh, ns, dqk = q.shape
    dv = v.shape[-1]
    nc = ns // CHUNK
    q, k, v = (t.reshape(nb, nh, nc, CHUNK, -1) for t in (q, k, v))
    i_pre, f_pre = (t.reshape(nb, nh, nc, CHUNK) for t in (i_pre, f_pre))
    incl, _ = tri_masks(CHUNK)
    bc = jnp.cumsum(jax.nn.log_sigmoid(f_pre), axis=-1)
    b_last = bc[..., -1]
    d_log = jnp.where(incl, bc[..., :, None] - bc[..., None, :] + i_pre[..., None, :], -jnp.inf)
    lw = b_last[..., None] - bc + i_pre
    a_max = jnp.max(lw, -1)
    wgt = jnp.exp(lw - a_max[..., None])
    c_chunk = jnp.einsum('bhnl,bhnld,bhnle->bhnde', wgt, k, v)
    n_chunk = jnp.einsum('bhnl,bhnld->bhnd', wgt, k)

    def step(carry, inp):
        c, nv, m = carry
        cc, ncv, am, bl = inp
        m_new = jnp.maximum(bl + m, am)
        sp = jnp.exp(bl + m - m_new)
        sc = jnp.exp(am - m_new)
        c_new = c * sp[..., None, None] + cc * sc[..., None, None]
        n_new = nv * sp[..., None] + ncv * sc[..., None]
        return (c_new, n_new, m_new), (c, nv, m)

    init = (jnp.zeros((nb, nh, dqk, dv), jnp.float32), jnp.zeros((nb, nh, dqk), jnp.float32),
            jnp.zeros((nb, nh), jnp.float32))
    xs = tuple(jnp.moveaxis(t, 2, 0) for t in (c_chunk, n_chunk, a_max, b_last))
    _, (c_prev, n_prev, m_prev) = lax.scan(step, init, xs)
    c_prev, n_prev, m_prev = (jnp.moveaxis(t, 0, 2) for t in (c_prev, n_prev, m_prev))
    inter_log = bc + m_prev[..., None]
    m_out = jnp.maximum(inter_log, jnp.max(d_log, -1))
    s = jnp.einsum('bhnid,bhnjd->bhnij', q, k) * jnp.exp(d_log - m_out[..., None])
    inter = jnp.exp(inter_log - m_out)
    num = (inter[..., None] * jnp.einsum('bhnld,bhnde->bhnle', q, c_prev)
           + jnp.einsum('bhnij,bhnje->bhnie', s, v))
    den = inter * jnp.einsum('bhnld,bhnd->bhnl', q, n_prev) + jnp.sum(s, -1)
    h = num / jnp.maximum(jnp.abs(den), jnp.exp(-m_out))[..., None]
    return h.reshape(nb, nh, ns, dv)


def bidirectional(fn, shared, fwd_gates, bwd_gates):
    flip = lambda t: jnp.flip(t, axis=2)
    y_f = fn(*shared, *fwd_gates)
    y_b = fn(*[flip(t) for t in shared], *[flip(t) for t in bwd_gates])
    return y_f + flip(y_b)


def multiscale_pool(u, w_group, scale):
    nb, ns, _ = u.shape
    cs = jnp.concatenate([jnp.zeros((nb, 1, MIX_WIDTH), u.dtype), jnp.cumsum(u, axis=1)], axis=1)
    pos = jnp.arange(ns)
    outs = []
    for gi, win in enumerate(POOL_WINDOWS):
        lo = jnp.clip(pos - win // 2, 0, ns)
        hi = jnp.clip(pos + win // 2, 0, ns)
        cg = cs[:, :, gi * POOL_DIM:(gi + 1) * POOL_DIM]
        mean = (cg[:, hi] - cg[:, lo]) / (hi - lo).astype(u.dtype)[None, :, None]
        outs.append(mean - u[:, :, gi * POOL_DIM:(gi + 1) * POOL_DIM])
    p = jnp.stack(outs, axis=2)
    y = jnp.einsum('bsgc,gcd->bsgd', p, w_group).reshape(nb, ns, MIX_WIDTH)
    return y * scale


def hybrid_mixer(h, w_in, dn_conv_w, dn_a_log, dn_dt_bias, dn_norm_w, pool_w, pool_scale,
                 ml_gate_b, ml_norm_w, w_branch, w_out):
    nb, ns, _ = h.shape
    f32 = jnp.float32
    idx = [int(c) for c in np.cumsum(SPLITS)[:-1]]
    proj = h @ w_in
    (dn_qkv, dn_z, dn_a, dn_b, pool_u, ml_q, ml_k, ml_v, ml_o, ml_i, ml_f,
     gate_pre) = jnp.split(proj, idx, axis=-1)
    heads = lambda t, nh: t.astype(f32).reshape(nb, ns, nh, -1).transpose(0, 2, 1, 3)
    dir_gates = lambda t: t.astype(f32).reshape(nb, ns, 2, -1).transpose(2, 0, 3, 1)

    qkv = jax.nn.silu(centred_depthwise_conv(dn_qkv.astype(f32), dn_conv_w.astype(f32)))
    dq, dk, dv = jnp.split(qkv, 3, axis=-1)
    dq = l2norm(heads(dq, DN_HEADS)) * DN_DIM ** -0.5
    dk = l2norm(heads(dk, DN_HEADS))
    dv = heads(dv, DN_HEADS)
    beta = jax.nn.sigmoid(dir_gates(dn_b))
    a_log = dn_a_log.astype(f32).reshape(2, 1, DN_HEADS, 1)
    dt_bias = dn_dt_bias.astype(f32).reshape(2, 1, DN_HEADS, 1)
    g = -jnp.exp(a_log) * jax.nn.softplus(dir_gates(dn_a) + dt_bias)
    o_dn = bidirectional(gated_delta_rule, (dq, dk, dv), (beta[0], g[0]), (beta[1], g[1]))
    y_dn = head_rms_norm(o_dn.transpose(0, 2, 1, 3), dn_norm_w.astype(f32)) * jax.nn.silu(dn_z.astype(f32))

    y_pool = multiscale_pool(pool_u.astype(f32), pool_w.astype(f32), pool_scale.astype(f32))

    mq = heads(ml_q, ML_HEADS)
    mk = heads(ml_k, ML_HEADS) * ML_QK_DIM ** -0.5
    mv = heads(ml_v, ML_HEADS)
    gb = ml_gate_b.astype(f32).reshape(2, 2, 1, ML_HEADS, 1)
    ig = dir_gates(ml_i) + gb[0]
    fg = dir_gates(ml_f) + gb[1]
    h_ml = bidirectional(mlstm_chunkwise, (mq, mk, mv), (ig[0], fg[0]), (ig[1], fg[1]))
    y_ml = head_layer_norm(h_ml.transpose(0, 2, 1, 3), ml_norm_w.astype(f32)) * jax.nn.sigmoid(ml_o.astype(f32))

    branches = jnp.stack([y_dn, y_pool, y_ml], axis=2).astype(h.dtype)
    y = jnp.einsum('bsrm,rmd->bsrd', branches, w_branch)
    gate = jax.nn.sigmoid(gate_pre.reshape(nb, ns, N_BRANCH, D_MODEL))
    merged = jnp.sum(gate * y, axis=2)
    return merged @ w_out


def route(h2, router_w, router_b):
    t = h2.shape[0]
    scores = jax.nn.sigmoid(h2.astype(jnp.float32) @ router_w.astype(jnp.float32))
    sel = (scores + router_b.astype(jnp.float32)).reshape(t, N_GROUPS, EXPERTS_PER_GROUP)
    group_score = jnp.sum(lax.top_k(sel, TOP_K)[0], axis=-1)
    grp = jnp.argmax(group_score, axis=-1)
    sel_in = sel[jnp.arange(t), grp]
    _, local = lax.top_k(sel_in, TOP_K)
    expert = grp[:, None] * EXPERTS_PER_GROUP + local
    w = jnp.take_along_axis(scores, expert, axis=1)
    return expert, w / jnp.sum(w, axis=-1, keepdims=True)


def moe_ffn(h, router_w, router_b, w1, w3, w2):
    nb, ns, d = h.shape
    t = nb * ns
    h2 = h.reshape(t, d)
    expert, gate = route(h2, router_w, router_b)
    a = t * TOP_K
    flat_e = expert.reshape(a)
    flat_tok = jnp.repeat(jnp.arange(t, dtype=jnp.int32), TOP_K)
    flat_w = gate.reshape(a)
    order = jnp.argsort(flat_e)
    e_sorted = flat_e[order]
    counts = jnp.bincount(flat_e, length=N_EXPERTS)
    padded = ((counts + MOE_BLOCK - 1) // MOE_BLOCK) * MOE_BLOCK
    start = jnp.cumsum(counts) - counts
    pend = jnp.cumsum(padded)
    pstart = pend - padded
    dest = pstart[e_sorted] + jnp.arange(a) - start[e_sorted]
    n_rows = a + N_EXPERTS * MOE_BLOCK
    n_blocks = n_rows // MOE_BLOCK
    row_tok = jnp.full((n_rows,), t, dtype=jnp.int32).at[dest].set(flat_tok[order])
    row_w = jnp.zeros((n_rows,), jnp.float32).at[dest].set(flat_w[order])
    block_expert = jnp.clip(jnp.searchsorted(pend, jnp.arange(n_blocks) * MOE_BLOCK, side='right'),
                            0, N_EXPERTS - 1)
    hp = jnp.concatenate([h2, jnp.zeros((1, d), h2.dtype)], axis=0)
    xb = hp[row_tok].reshape(n_blocks, MOE_BLOCK, d)

    def expert_block(args):
        xblk, e = args
        act = jax.nn.silu(xblk @ w1[e]) * (xblk @ w3[e])
        return act @ w2[e]

    yb = lax.map(expert_block, (xb, block_expert))
    y = yb.reshape(n_rows, d).astype(jnp.float32) * row_w[:, None]
    out = jnp.zeros((t + 1, d), jnp.float32).at[row_tok].add(y)[:t]
    return out.reshape(nb, ns, d).astype(h.dtype)


def setup_inputs(seed: int = 0) -> dict:
    key = jax.random.key(seed)
    ks = jax.random.split(key, 24)
    f32 = jnp.float32
    nrm = lambda i, shape, scale: jax.random.normal(ks[i], shape, f32) * scale
    out_scale = (8.0 * DEPTH) ** -0.25
    dt = jnp.exp(jax.random.uniform(ks[4], (DEPTH, 2 * DN_HEADS), f32, math.log(1e-3), math.log(1e-1)))
    dn_dt_bias = dt + jnp.log(-jnp.expm1(-dt))
    dn_a_log = jnp.log(jax.random.uniform(ks[5], (DEPTH, 2 * DN_HEADS), f32, 1.0, 16.0))
    f_bias = jnp.tile(jnp.linspace(3.0, 6.0, ML_HEADS, dtype=f32), (DEPTH, 2)) + nrm(6, (DEPTH, 2 * ML_HEADS), 0.1)
    i_bias = nrm(7, (DEPTH, 2 * ML_HEADS), 0.1)
    return {
        'x': nrm(0, (BATCH, SEQ, D_MODEL), 1.0),
        'ln_in_g': 1.0 + nrm(1, (D_MODEL,), 0.02),
        'ln_in_b': nrm(2, (D_MODEL,), 0.02),
        'w_in': nrm(3, (DEPTH, D_MODEL, D_IN_PROJ), D_MODEL ** -0.5),
        'dn_conv_w': nrm(8, (DEPTH, DN_CONV, 3 * MIX_WIDTH), DN_CONV ** -0.5),
        'dn_a_log': dn_a_log,
        'dn_dt_bias': dn_dt_bias,
        'dn_norm_w': 1.0 + nrm(9, (DEPTH, MIX_WIDTH), 0.02),
        'pool_w': nrm(10, (DEPTH, POOL_GROUPS, POOL_DIM, POOL_DIM), POOL_DIM ** -0.5),
        'pool_scale': 1.0 + nrm(11, (DEPTH, MIX_WIDTH), 0.02),
        'ml_gate_b': jnp.concatenate([i_bias, f_bias], axis=-1),
        'ml_norm_w': 1.0 + nrm(12, (DEPTH, MIX_WIDTH), 0.02),
        'w_branch': nrm(13, (DEPTH, N_BRANCH, MIX_WIDTH, D_MODEL), MIX_WIDTH ** -0.5),
        'w_out': nrm(14, (DEPTH, D_MODEL, D_MODEL), out_scale * D_MODEL ** -0.5),
        'ln_mix_g': 1.0 + nrm(15, (DEPTH, D_MODEL), 0.02),
        'ln_mix_b': nrm(16, (DEPTH, D_MODEL), 0.02),
        'router_w': nrm(17, (D_MODEL, N_EXPERTS), D_MODEL ** -0.5),
        'router_b': nrm(18, (N_EXPERTS,), 0.01),
        'moe_w1': nrm(19, (DEPTH, N_EXPERTS, D_MODEL, D_EXPERT), D_MODEL ** -0.5),
        'moe_w3': nrm(20, (DEPTH, N_EXPERTS, D_MODEL, D_EXPERT), D_MODEL ** -0.5),
        'moe_w2': nrm(21, (DEPTH, N_EXPERTS, D_EXPERT, D_MODEL), out_scale * D_EXPERT ** -0.5),
        'ln_ffn_g': 1.0 + nrm(22, (DEPTH, D_MODEL), 0.02),
        'ln_ffn_b': nrm(23, (DEPTH, D_MODEL), 0.02),
    }


def reference(x, ln_in_g, ln_in_b, w_in, dn_conv_w, dn_a_log, dn_dt_bias, dn_norm_w, pool_w, pool_scale,
              ml_gate_b, ml_norm_w, w_branch, w_out, ln_mix_g, ln_mix_b, router_w, router_b,
              moe_w1, moe_w3, moe_w2, ln_ffn_g, ln_ffn_b):
    alpha = (2.0 * DEPTH) ** 0.25
    h = layer_norm(x, ln_in_g, ln_in_b)
    for l in range(DEPTH):
        mix = hybrid_mixer(h, w_in[l], dn_conv_w[l], dn_a_log[l], dn_dt_bias[l], dn_norm_w[l],
                           pool_w[l], pool_scale[l], ml_gate_b[l], ml_norm_w[l], w_branch[l], w_out[l])
        h = layer_norm(alpha * h + mix, ln_mix_g[l], ln_mix_b[l])
        ffn = moe_ffn(h, router_w, router_b, moe_w1[l], moe_w3[l], moe_w2[l])
        h = layer_norm(alpha * h + ffn, ln_ffn_g[l], ln_ffn_b[l])
    return h
```

```cpp
#include <hip/hip_runtime.h>
#include <cstdio>
#include <cstdint>

#define LAS __attribute__((address_space(3)))
#define GAS __attribute__((address_space(1)))
typedef unsigned short bf16;
typedef short bf16x8 __attribute__((ext_vector_type(8)));
typedef float f32x4 __attribute__((ext_vector_type(4)));
typedef float f32x2 __attribute__((ext_vector_type(2)));
typedef unsigned u32x4 __attribute__((ext_vector_type(4)));
typedef unsigned u32x2 __attribute__((ext_vector_type(2)));
#define RLX_AGENT __ATOMIC_RELAXED, __HIP_MEMORY_SCOPE_AGENT
#define LDS_WAIT() asm volatile("s_waitcnt lgkmcnt(0)" ::: "memory")
#define VM_WAIT() asm volatile("s_waitcnt vmcnt(0)" ::: "memory")

constexpr int NB = 4, SEQ = 8192, T = NB * SEQ, D = 1024, DEPTH = 2;
constexpr int DIN = 7200;
constexpr int MIXW = 512, NHEAD = 4, HD = 128, CH = 64, NCH = SEQ / CH;
constexpr int MLQK = 64;
constexpr int NEXP = 32, DEXP = 512;
constexpr float LN_EPS = 1e-5f, NORM_EPS = 1e-6f;
constexpr float ALPHA = 1.41421356237309515f;
constexpr int NWAVES = 8;
constexpr int NREC = NB * NHEAD * NCH * 2;

constexpr int C_QKV = 0, C_Z = 1536, C_A = 2048, C_B = 2056, C_POOL = 2064, C_MQ = 2576, C_MK = 2832, C_MV = 3088, C_MO = 3600, C_I = 4112, C_F = 4120, C_GATE = 4128;

constexpr size_t MiB = 1u << 20;
constexpr size_t WS_CTL = 0, CTL_ZERO_BYTES = 64 * 1024;
constexpr int CW_BAR = 4096;
constexpr size_t WS_HIST = 1 * MiB;
constexpr size_t WS_EID = WS_HIST + 64 * 1024;
constexpr size_t WS_EW = WS_EID + 256 * 1024;
constexpr size_t WS_POS = WS_EW + 256 * 1024;
constexpr size_t WS_ROWW = WS_POS + 256 * 1024;
constexpr size_t WS_GL = WS_ROWW + 512 * 1024;
constexpr size_t WS_WIN = 4 * MiB;
constexpr size_t WS_WGATE = 12 * MiB;
constexpr size_t WS_WBR = 18 * MiB;
constexpr size_t WS_WOUT = 21 * MiB;
constexpr size_t WS_HB = 24 * MiB;
constexpr size_t WS_SG = 88 * MiB;
constexpr size_t WS_DEN = 92 * MiB;
constexpr size_t WS_R1 = 93 * MiB;
constexpr size_t WS_PQKV = WS_R1;
constexpr size_t WS_OF = WS_R1, WS_OB = WS_R1 + 32 * MiB;
constexpr size_t WS_MRGP = WS_R1;
constexpr size_t WS_W13 = WS_R1, WS_W2 = WS_R1 + 64 * MiB;
constexpr size_t WS_R2 = 189 * MiB;
constexpr size_t DNREC = 73728;
constexpr size_t DN_W = 0, DN_QG = 16384, DN_KDT = 32768, DN_ATT = 49152, DN_UF = 57344;
constexpr size_t WS_PZ = 189 * MiB, WS_PPOOL = 221 * MiB, WS_PMQ = 253 * MiB, WS_PMK = 269 * MiB, WS_PMV = 285 * MiB, WS_PMO = 317 * MiB;
constexpr size_t WS_YP = 349 * MiB;
constexpr size_t WS_NUMF = 253 * MiB, WS_NUMB = 285 * MiB;
constexpr size_t WS_ML = 381 * MiB;
constexpr size_t MLREC = 44032;
constexpr size_t ML_Q = 0, ML_ST = 8192, ML_KWT = 16384, ML_VF = 24576, ML_ROW = 43008;
constexpr size_t WS_GATE = 381 * MiB;
constexpr size_t WS_XS = 189 * MiB, WS_ACT = 333 * MiB, WS_YROWS = 405 * MiB;
constexpr size_t WS_END = 573 * MiB;
constexpr int MOE_ROWS = 73728;
static_assert(WS_ML + (size_t)NREC * MLREC <= WS_END + 15 * MiB, "ml records");
static_assert(WS_YROWS + (size_t)MOE_ROWS * 1024 * 2 <= WS_END, "moe rows");

constexpr int RING_BYTES = 131072;
constexpr int MISC_OFF = RING_BYTES + 320;
constexpr int LHIST_OFF = RING_BYTES + 1024;
constexpr int LPE_OFF = RING_BYTES + 2048;
constexpr int LARG_OFF = RING_BYTES + 4096;
constexpr int LDS_BYTES = 147456;

__device__ __forceinline__ float bf2f(unsigned b) { return __uint_as_float(b << 16); }
__device__ __forceinline__ unsigned f2bf(float f) { unsigned u = __float_as_uint(f); return (u + 0x7fffu + ((u >> 16) & 1u)) >> 16; }
__device__ __forceinline__ unsigned pk2(float lo, float hi) { return f2bf(lo) | (f2bf(hi) << 16); }
__device__ __forceinline__ float wave_sum(float v) {
#pragma unroll
    for (int o = 1; o < 64; o <<= 1) v += __shfl_xor(v, o);
    return v;
}
__device__ __forceinline__ float wave_max(float v) {
#pragma unroll
    for (int o = 1; o < 64; o <<= 1) v = fmaxf(v, __shfl_xor(v, o));
    return v;
}
__device__ __forceinline__ float fexp(float x) { return __builtin_amdgcn_exp2f(x * 1.44269504089f); }
__device__ __forceinline__ float sigmoidf_(float x) { return 1.0f / (1.0f + expf(-x)); }
__device__ __forceinline__ float siluf_(float x) { return x / (1.0f + expf(-x)); }
__device__ __forceinline__ float softplusf_(float x) { return fmaxf(x, 0.f) + log1pf(expf(-fabsf(x))); }
__device__ __forceinline__ float logsigmoidf_(float x) { return fminf(x, 0.f) - log1pf(expf(-fabsf(x))); }
__host__ __device__ __forceinline__ int sigma32(int p) { const int fq = p >> 3, j = p & 7; return 16 * (j >> 2) + 4 * fq + (j & 3); }

#define XB_TMO      128
#define XB_XCNT(j)  (256  + 64 * (j))
#define XB_XSUB(j)  (1280 + 64 * (j))
#define XB_XGEN(j)  (2304 + 64 * (j))
#define XB_TOP      3328
#define XB_TOPGEN   3392
#define XCD_BAR_WORDS 3456
#define XB_SPIN_CAP (1u << 20)
__device__ __forceinline__ unsigned xb_ld(unsigned* p)              { return __hip_atomic_load(p, __ATOMIC_RELAXED, __HIP_MEMORY_SCOPE_AGENT); }
__device__ __forceinline__ unsigned xb_add(unsigned* p, unsigned v) { return __hip_atomic_fetch_add(p, v, __ATOMIC_RELAXED, __HIP_MEMORY_SCOPE_AGENT); }
__device__ __forceinline__ unsigned xb_xcc_id() { return (unsigned)__builtin_amdgcn_s_getreg((3 << 11) | 20) & 0xFu; }
#define XB_SPIN(cond, bar) do { unsigned _sp = 0; while (cond) { __builtin_amdgcn_s_sleep(1); \
    if ((++_sp & 255u) == 0u) { if (xb_ld(&(bar)[XB_TMO])) break; if (_sp > XB_SPIN_CAP) { atomicAdd(&(bar)[XB_TMO], 1u); break; } } } } while (0)
struct XcdBarrier { unsigned* bar; unsigned x; volatile LAS unsigned* st; };
__device__ __forceinline__ XcdBarrier xcd_barrier_post(unsigned* bar, volatile LAS unsigned* st) {
    XcdBarrier b; b.bar = bar; b.x = xb_xcc_id(); b.st = st;
    if (threadIdx.x == 0) (void)xb_add(&bar[XB_XCNT(b.x)], 1u);
    return b;
}
__device__ __forceinline__ void xcd_barrier_complete(unsigned* bar, unsigned x, unsigned& nloc, unsigned& nx) {
    const unsigned G = gridDim.x * gridDim.y * gridDim.z;
    unsigned sum, cnt, mine, sp = 0u;
    for (;;) {
        sum = 0u; cnt = 0u; mine = 0u;
#pragma unroll
        for (unsigned j = 0; j < 16; ++j) { const unsigned c = xb_ld(&bar[XB_XCNT(j)]); sum += c; cnt += (c > 0u) ? 1u : 0u; mine = (j == x) ? c : mine; }
        if (sum == G) break;
        __builtin_amdgcn_s_sleep(1);
        if ((++sp & 255u) == 0u) { if (xb_ld(&bar[XB_TMO])) break; if (sp > XB_SPIN_CAP) { atomicAdd(&bar[XB_TMO], 1u); break; } }
    }
    nloc = mine > 0u ? mine : 1u; nx = cnt > 0u ? cnt : 1u;
}
__device__ __forceinline__ void xcd_barrier(const XcdBarrier& b, const int tid) {
    asm volatile("s_waitcnt vmcnt(0)" ::: "memory");
    __syncthreads();
    if (tid == 0) {
        unsigned* bar = b.bar;
        __builtin_amdgcn_s_waitcnt(0);
        unsigned nloc = b.st[0], nx = b.st[1];
        if (nloc == 0u) { xcd_barrier_complete(bar, b.x, nloc, nx); b.st[0] = nloc; b.st[1] = nx; }
        const unsigned old = xb_add(&bar[XB_XSUB(b.x)], 1u);
        const unsigned gen = old / nloc;
        if (old + 1u == (gen + 1u) * nloc) {
            __builtin_amdgcn_fence(__ATOMIC_RELEASE, "agent");
            asm volatile("s_waitcnt vmcnt(0)" ::: "memory");
            const unsigned og = xb_add(&bar[XB_TOP], 1u);
            const unsigned tg = og / nx;
            if (og + 1u == (tg + 1u) * nx) xb_add(&bar[XB_TOPGEN], 1u);
            else XB_SPIN(xb_ld(&bar[XB_TOPGEN]) == tg, bar);
            __builtin_amdgcn_fence(__ATOMIC_ACQUIRE, "agent");
            xb_add(&bar[XB_XGEN(b.x)], 1u);
            asm volatile("s_waitcnt vmcnt(0)" ::: "memory");
        } else {
            XB_SPIN(xb_ld(&bar[XB_XGEN(b.x)]) == gen, bar);
            __builtin_amdgcn_fence(__ATOMIC_ACQUIRE, "agent");
            asm volatile("s_waitcnt vmcnt(0)" ::: "memory");
        }
    }
    __syncthreads();
}

namespace pg8 {
constexpr int BM = 256, BK = 64, HALF = 128, HTB = HALF * BK * 2, STAGE_BYTES = 8 * HTB, NXCD = 8, WGM = 8;
__host__ __device__ __forceinline__ int lds_byte(int r, int c) { const int st = (r >> 4) * 2 + (c >> 5), rr = r & 15, cc = c & 31, ob = rr * 64 + cc * 2; return st * 1024 + (ob ^ (((ob >> 9) & 1) << 5)); }
__host__ __device__ __forceinline__ void stage_rc(int b, int& R, int& C) { const int st = b / 1024, sb = b % 1024, swz = sb ^ (((sb >> 9) & 1) << 5); R = (st >> 1) * 16 + swz / 64; C = (st & 1) * 32 + (swz % 64) / 2; }
__host__ __device__ __forceinline__ int perm32(int rho) { const int n = rho >> 4, i = rho & 15; return 8 * (i >> 2) + 4 * n + (i & 3); }

struct Unit { int pm, pn, aux; const char* A; const char* B; };

__device__ __forceinline__ void tile_of(int L, int nM, int nN, int& pm, int& pn) {
    const int nwg = nM * nN; int wgid = L;
    { const int q = nwg / NXCD, r = nwg % NXCD, xcd = wgid % NXCD, off = wgid / NXCD; wgid = (xcd < r ? xcd * (q + 1) : r * (q + 1) + (xcd - r) * q) + off; }
    const int nig = WGM * nN, gid = wgid / nig, fm = gid * WGM, gsz = (nM - fm) < WGM ? (nM - fm) : WGM;
    pm = fm + ((wgid % nig) % gsz); pn = (wgid % nig) / gsz;
}
struct StaticOrder {
    const char* A; const char* Bt; int nM, nN, nwg, G, c; size_t tstep;
    __device__ __forceinline__ void init(const void* A_, const void* Bt_, int M, int N, int K, int G_, int c_) { A = (const char*)A_; Bt = (const char*)Bt_; nM = M / BM; nN = N / BM; nwg = nM * nN; G = G_; c = c_; tstep = (size_t)BM * K * 2; }
    __device__ __forceinline__ bool next(int i, Unit& u) const {
        const long L = (long)i * G + c; if (L >= nwg) return false;
        tile_of((int)L, nM, nN, u.pm, u.pn); u.aux = 0; u.A = A + (size_t)u.pm * tstep; u.B = Bt + (size_t)u.pn * tstep; return true;
    }
};

typedef float f32x2_t __attribute__((ext_vector_type(2))); typedef __bf16 bf16x2_t __attribute__((ext_vector_type(2)));
__device__ __forceinline__ unsigned cvt_pk_bf16(float lo, float hi) { f32x2_t v = {lo, hi}; bf16x2_t b = __builtin_convertvector(v, bf16x2_t); return __builtin_bit_cast(unsigned, b); }

template <class Epi, class Sched, bool ALIGN_EPI = true, bool SP2 = true>
__device__ __forceinline__ void gemm_phase(LAS unsigned char* lds, const int tid, const int K, const Sched& S, const Epi& E) {
    const int wid = __builtin_amdgcn_readfirstlane(tid >> 6), lane = tid & 63, wr = wid >> 2, wc = wid & 3, fr = lane & 15, fq = lane >> 4;
    const int nt = K / BK;
    unsigned voffA, voffB;
    { int R, C; stage_rc(tid * 16, R, C); const int Rb = Epi::PERM ? ((R & ~31) + perm32(R & 31)) : R;
        voffA = (unsigned)(R * K + C) * 2u; voffB = (unsigned)(Rb * K + C) * 2u; }
    const size_t pstep = (size_t)64 * K * 2;
    const size_t kstep = (size_t)(BK * 2);
    const size_t hstep = (size_t)HALF * K * 2;
    const unsigned ldsw = (unsigned)wid * 1024u;
    const int aoff = lds_byte(wr * 64 + fr, fq * 8), boff = lds_byte(wc * 32 + fr, fq * 8);
#define PG8_SA(b, h) (((b) * 2 + (h)) * HTB)
#define PG8_SB(b, h) ((4 + (b) * 2 + (h)) * HTB)
#define PG8_STAGE(bufoff, gbase, voff) do { _Pragma("unroll") for (int _i = 0; _i < 2; ++_i) \
        __builtin_amdgcn_global_load_lds((const unsigned*)((const char*)(gbase) + _i * pstep + (voff)), (LAS unsigned*)(lds + (bufoff) + ldsw + _i * 8192), 16, 0, 0); } while (0)
#define PG8_LDA(dst, b, h) do { _Pragma("unroll") for (int m = 0; m < 4; ++m) _Pragma("unroll") for (int k = 0; k < 2; ++k) dst[m][k] = *(const LAS bf16x8*)(lds + PG8_SA(b, h) + aoff + m * 2048 + k * 1024); } while (0)
#define PG8_LDB(dst, b, h) do { _Pragma("unroll") for (int n = 0; n < 2; ++n) _Pragma("unroll") for (int k = 0; k < 2; ++k) dst[n][k] = *(const LAS bf16x8*)(lds + PG8_SB(b, h) + boff + n * 2048 + k * 1024); } while (0)
#define PG8_MMA(ai, bj, At, Bt) do { __builtin_amdgcn_s_setprio(1); _Pragma("unroll") for (int m = 0; m < 4; ++m) _Pragma("unroll") for (int n = 0; n < 2; ++n) _Pragma("unroll") for (int k = 0; k < 2; ++k) \
        acc[ai][bj][m][n] = __builtin_amdgcn_mfma_f32_16x16x32_bf16(Bt[n][k], At[m][k], acc[ai][bj][m][n], 0, 0, 0); __builtin_amdgcn_s_setprio(0); } while (0)
#define PG8_WAIT_V(n) asm volatile("s_waitcnt vmcnt(" #n ")" ::: "memory")
#define PG8_WAIT_L(n) asm volatile("s_waitcnt lgkmcnt(" #n ")" ::: "memory")
#define PG8_BAR __builtin_amdgcn_s_barrier()
#define PG8_SCHED __builtin_amdgcn_sched_barrier(0)
    Unit cur, nxt; int ui = 0;
    if (!S.next(0, cur)) return;
    f32x4 acc[2][2][4][2];
#pragma unroll
    for (int a = 0; a < 2; ++a)
#pragma unroll
        for (int b = 0; b < 2; ++b)
#pragma unroll
            for (int m = 0; m < 4; ++m)
#pragma unroll
                for (int n = 0; n < 2; ++n) acc[a][b][m][n] = (f32x4){0.f, 0.f, 0.f, 0.f};
    bf16x8 At[4][2], B0[2][2], B1[2][2];
    const char* cA = cur.A; const char* cB = cur.B;
    if constexpr (SP2) {
        PG8_STAGE(PG8_SB(0, 0), cB, voffB); PG8_STAGE(PG8_SB(0, 1), cB + hstep, voffB); PG8_STAGE(PG8_SA(0, 0), cA, voffA); PG8_STAGE(PG8_SA(0, 1), cA + hstep, voffA);
        if (wr == 1) PG8_BAR;
        PG8_WAIT_V(2); PG8_BAR;
        PG8_STAGE(PG8_SB(1, 0), cB + kstep, voffB); PG8_STAGE(PG8_SA(1, 0), cA + kstep, voffA); PG8_STAGE(PG8_SB(1, 1), cB + hstep + kstep, voffB);
        PG8_WAIT_V(6); PG8_BAR;
    } else {
        PG8_STAGE(PG8_SB(0, 0), cB, voffB); PG8_STAGE(PG8_SA(0, 0), cA, voffA); PG8_STAGE(PG8_SB(0, 1), cB + hstep, voffB); PG8_STAGE(PG8_SA(0, 1), cA + hstep, voffA);
        if (wr == 1) PG8_BAR;
        PG8_WAIT_V(4); PG8_BAR;
        PG8_STAGE(PG8_SB(1, 0), cB + kstep, voffB); PG8_STAGE(PG8_SA(1, 0), cA + kstep, voffA); PG8_STAGE(PG8_SB(1, 1), cB + hstep + kstep, voffB);
        PG8_WAIT_V(6); PG8_BAR;
    }
    for (;;) {
        const bool has_next = S.next(ui + 1, nxt);
        const char* nA = has_next ? nxt.A : cA; const char* nB = has_next ? nxt.B : cB;
        for (int t = 0; t < nt; t += 2) {
            const bool last = (t == nt - 2);
            const char* a1 = cA + (size_t)(t + 1) * kstep;
            const char* a2 = last ? nA : cA + (size_t)(t + 2) * kstep; const char* b2 = last ? nB : cB + (size_t)(t + 2) * kstep;
            const char* a3 = a2 + kstep; const char* b3 = b2 + kstep;
            if constexpr (SP2) {
            PG8_LDB(B0, 0, 0); PG8_LDB(B1, 0, 1); PG8_SCHED; PG8_LDA(At, 0, 0); PG8_STAGE(PG8_SA(1, 1), a1 + hstep, voffA);
            PG8_WAIT_V(8); PG8_WAIT_L(0); PG8_BAR; PG8_MMA(0, 0, At, B0); PG8_MMA(0, 1, At, B1); PG8_BAR; PG8_SCHED;
            PG8_LDA(At, 0, 1); PG8_STAGE(PG8_SB(0, 0), b2, voffB); PG8_STAGE(PG8_SB(0, 1), b2 + hstep, voffB); PG8_STAGE(PG8_SA(0, 0), a2, voffA);
            PG8_WAIT_V(8); PG8_WAIT_L(0); PG8_BAR; PG8_MMA(1, 0, At, B0); PG8_MMA(1, 1, At, B1); PG8_BAR; PG8_SCHED;
            PG8_LDB(B0, 1, 0); PG8_LDB(B1, 1, 1); PG8_SCHED; PG8_LDA(At, 1, 0); PG8_STAGE(PG8_SA(0, 1), a2 + hstep, voffA);
            PG8_WAIT_V(8); PG8_WAIT_L(0); PG8_BAR; PG8_MMA(0, 0, At, B0); PG8_MMA(0, 1, At, B1); PG8_BAR; PG8_SCHED;
            PG8_LDA(At, 1, 1); PG8_STAGE(PG8_SB(1, 0), b3, voffB); PG8_STAGE(PG8_SB(1, 1), b3 + hstep, voffB); PG8_STAGE(PG8_SA(1, 0), a3, voffA);
            PG8_WAIT_V(8); PG8_WAIT_L(0); PG8_BAR; PG8_MMA(1, 0, At, B0); PG8_MMA(1, 1, At, B1); PG8_BAR; PG8_SCHED;
            } else {
            PG8_LDB(B0, 0, 0); PG8_SCHED; PG8_LDA(At, 0, 0); PG8_STAGE(PG8_SA(1, 1), a1 + hstep, voffA);
            PG8_WAIT_L(8); PG8_BAR; PG8_WAIT_L(0); PG8_MMA(0, 0, At, B0); PG8_BAR; PG8_SCHED;
            PG8_LDB(B1, 0, 1); PG8_STAGE(PG8_SB(0, 0), b2, voffB);
            PG8_BAR; PG8_WAIT_L(0); PG8_MMA(0, 1, At, B1); PG8_BAR;
            PG8_LDA(At, 0, 1); PG8_STAGE(PG8_SA(0, 0), a2, voffA);
            PG8_BAR; PG8_WAIT_L(0); PG8_MMA(1, 0, At, B0); PG8_BAR; PG8_SCHED;
            PG8_STAGE(PG8_SB(0, 1), b2 + hstep, voffB);
            PG8_WAIT_V(6); PG8_BAR; PG8_MMA(1, 1, At, B1); PG8_BAR;
            PG8_LDB(B0, 1, 0); PG8_SCHED; PG8_LDA(At, 1, 0); PG8_STAGE(PG8_SA(0, 1), a2 + hstep, voffA);
            PG8_WAIT_L(8); PG8_BAR; PG8_WAIT_L(0); PG8_MMA(0, 0, At, B0); PG8_BAR; PG8_SCHED;
            PG8_LDB(B1, 1, 1); PG8_STAGE(PG8_SB(1, 0), b3, voffB);
            PG8_BAR; PG8_WAIT_L(0); PG8_MMA(0, 1, At, B1); PG8_BAR;
            PG8_LDA(At, 1, 1); PG8_STAGE(PG8_SA(1, 0), a3, voffA);
            PG8_BAR; PG8_WAIT_L(0); PG8_MMA(1, 0, At, B0); PG8_BAR; PG8_SCHED;
            PG8_STAGE(PG8_SB(1, 1), b3 + hstep, voffB);
            PG8_WAIT_V(6); PG8_BAR; PG8_MMA(1, 1, At, B1); PG8_BAR;
            }
        }
        if constexpr (ALIGN_EPI) { if (wr == 0) PG8_BAR; }
        E(acc, cur, wr, wc, fr, fq);
        if (!has_next) break;
#pragma unroll
        for (int a = 0; a < 2; ++a)
#pragma unroll
            for (int b = 0; b < 2; ++b)
#pragma unroll
                for (int m = 0; m < 4; ++m)
#pragma unroll
                    for (int n = 0; n < 2; ++n) acc[a][b][m][n] = (f32x4){0.f, 0.f, 0.f, 0.f};
        cur = nxt; cA = nA; cB = nB; ++ui;
        if constexpr (ALIGN_EPI) { if (wr == 1) PG8_BAR; }
    }
    PG8_WAIT_V(0);
    if constexpr (!ALIGN_EPI) { if (wr == 0) PG8_BAR; }
    PG8_BAR;
#undef PG8_SA
#undef PG8_SB
#undef PG8_STAGE
#undef PG8_LDA
#undef PG8_LDB
#undef PG8_MMA
#undef PG8_WAIT_V
#undef PG8_WAIT_L
#undef PG8_BAR
#undef PG8_SCHED
}
}

using pg8::Unit; using pg8::cvt_pk_bf16; using pg8::HALF; using pg8::BM;

struct EpiG1a {
    static constexpr bool PERM = true;
    bf16* O;
    __device__ __forceinline__ void operator()(const f32x4 (&acc)[2][2][4][2], const Unit& u, int wr, int wc, int fr, int fq) const {
        const int row0 = u.pm * BM + wr * 64 + fr, col0 = u.pn * BM + wc * 32 + 8 * fq;
#pragma unroll
        for (int ai = 0; ai < 2; ++ai)
#pragma unroll
            for (int m = 0; m < 4; ++m) { bf16* rowp = O + (size_t)(row0 + ai * HALF + m * 16) * 1536 + col0;
#pragma unroll
                for (int bj = 0; bj < 2; ++bj) { const f32x4 v0 = acc[ai][bj][m][0], v1 = acc[ai][bj][m][1];
                    u32x4 w; w.x = cvt_pk_bf16(v0[0], v0[1]); w.y = cvt_pk_bf16(v0[2], v0[3]); w.z = cvt_pk_bf16(v1[0], v1[1]); w.w = cvt_pk_bf16(v1[2], v1[3]);
                    *(u32x4*)(rowp + bj * HALF) = w; } }
    }
};
struct EpiG1b {
    static constexpr bool PERM = true;
    unsigned char* ws;
    __device__ __forceinline__ void operator()(const f32x4 (&acc)[2][2][4][2], const Unit& u, int wr, int wc, int fr, int fq) const {
        const int pn = u.pn; size_t off; int ld, ct;
        if (pn < 2) { off = WS_PZ; ld = 512; ct = pn; } else if (pn < 4) { off = WS_PPOOL; ld = 512; ct = pn - 2; } else if (pn == 4) { off = WS_PMQ; ld = 256; ct = 0; }
        else if (pn == 5) { off = WS_PMK; ld = 256; ct = 0; } else if (pn < 8) { off = WS_PMV; ld = 512; ct = pn - 6; } else { off = WS_PMO; ld = 512; ct = pn - 8; }
        bf16* O = (bf16*)(ws + off);
        const int row0 = u.pm * BM + wr * 64 + fr, col0 = ct * BM + wc * 32 + 8 * fq;
#pragma unroll
        for (int ai = 0; ai < 2; ++ai)
#pragma unroll
            for (int m = 0; m < 4; ++m) { bf16* rowp = O + (size_t)(row0 + ai * HALF + m * 16) * ld + col0;
#pragma unroll
                for (int bj = 0; bj < 2; ++bj) { const f32x4 v0 = acc[ai][bj][m][0], v1 = acc[ai][bj][m][1];
                    u32x4 w; w.x = cvt_pk_bf16(v0[0], v0[1]); w.y = cvt_pk_bf16(v0[2], v0[3]); w.z = cvt_pk_bf16(v1[0], v1[1]); w.w = cvt_pk_bf16(v1[2], v1[3]);
                    *(u32x4*)(rowp + bj * HALF) = w; } }
    }
};
__device__ __forceinline__ float fast_sigmoid(float x) { return __builtin_amdgcn_rcpf(1.0f + __builtin_amdgcn_exp2f(-1.44269504089f * x)); }
struct EpiGate {
    static constexpr bool PERM = true;
    bf16* O;
    __device__ __forceinline__ void operator()(const f32x4 (&acc)[2][2][4][2], const Unit& u, int wr, int wc, int fr, int fq) const {
        const int row0 = u.pm * BM + wr * 64 + fr, col0 = u.pn * BM + wc * 32 + 8 * fq;
#pragma unroll
        for (int ai = 0; ai < 2; ++ai)
#pragma unroll
            for (int m = 0; m < 4; ++m) { bf16* rowp = O + (size_t)(row0 + ai * HALF + m * 16) * 3072 + col0;
#pragma unroll
                for (int bj = 0; bj < 2; ++bj) { f32x4 v0 = acc[ai][bj][m][0], v1 = acc[ai][bj][m][1];
#pragma unroll
                    for (int j = 0; j < 4; ++j) { v0[j] = fast_sigmoid(v0[j]); v1[j] = fast_sigmoid(v1[j]); }
                    u32x4 w; w.x = cvt_pk_bf16(v0[0], v0[1]); w.y = cvt_pk_bf16(v0[2], v0[3]); w.z = cvt_pk_bf16(v1[0], v1[1]); w.w = cvt_pk_bf16(v1[2], v1[3]);
                    *(u32x4*)(rowp + bj * HALF) = w; } }
    }
};
__device__ __forceinline__ void unpack8(const u32x4 w, float (&f)[8]) {
    f[0] = __uint_as_float(w.x << 16); f[1] = __uint_as_float(w.x & 0xffff0000u); f[2] = __uint_as_float(w.y << 16); f[3] = __uint_as_float(w.y & 0xffff0000u);
    f[4] = __uint_as_float(w.z << 16); f[5] = __uint_as_float(w.z & 0xffff0000u); f[6] = __uint_as_float(w.w << 16); f[7] = __uint_as_float(w.w & 0xffff0000u);
}
struct EpiMerge {
    static constexpr bool PERM = true;
    const bf16* GATE; bf16* PART; bf16* FIN;
    __device__ __forceinline__ void operator()(const f32x4 (&acc)[2][2][4][2], const Unit& u, int wr, int wc, int fr, int fq) const {
        const int r = u.aux;
        const int row0 = u.pm * BM + wr * 64 + fr, col0 = u.pn * BM + wc * 32 + 8 * fq;
#pragma unroll
        for (int ai = 0; ai < 2; ++ai)
#pragma unroll
            for (int m = 0; m < 4; ++m) { const size_t row = (size_t)(row0 + ai * HALF + m * 16);
#pragma unroll
                for (int bj = 0; bj < 2; ++bj) { const f32x4 v0 = acc[ai][bj][m][0], v1 = acc[ai][bj][m][1];
                    const int c = col0 + bj * HALF;
                    const u32x4 gw = *(const u32x4*)(GATE + row * 3072 + r * 1024 + c);
                    float g[8]; unpack8(gw, g);
                    float o[8];
                    o[0] = v0[0] * g[0]; o[1] = v0[1] * g[1]; o[2] = v0[2] * g[2]; o[3] = v0[3] * g[3];
                    o[4] = v1[0] * g[4]; o[5] = v1[1] * g[5]; o[6] = v1[2] * g[6]; o[7] = v1[3] * g[7];
                    if (r > 0) { const u32x4 pw = *(const u32x4*)(PART + row * 1024 + c); float p[8]; unpack8(pw, p);
#pragma unroll
                        for (int j = 0; j < 8; ++j) o[j] += p[j]; }
                    u32x4 w; w.x = cvt_pk_bf16(o[0], o[1]); w.y = cvt_pk_bf16(o[2], o[3]); w.z = cvt_pk_bf16(o[4], o[5]); w.w = cvt_pk_bf16(o[6], o[7]);
                    bf16* dst = (r == 2) ? FIN : PART;
                    *(u32x4*)(dst + row * 1024 + c) = w; } }
    }
};
struct EpiOut {
    static constexpr bool PERM = false;
    float* C;
    __device__ __forceinline__ void operator()(const f32x4 (&acc)[2][2][4][2], const Unit& u, int wr, int wc, int fr, int fq) const {
        const int row0 = u.pm * BM + wr * 64 + fr, col0 = u.pn * BM + wc * 32 + 4 * fq;
#pragma unroll
        for (int ai = 0; ai < 2; ++ai)
#pragma unroll
            for (int m = 0; m < 4; ++m) { float* rowp = C + (size_t)(row0 + ai * HALF + m * 16) * D + col0;
#pragma unroll
                for (int bj = 0; bj < 2; ++bj)
#pragma unroll
                    for (int n = 0; n < 2; ++n) { f32x4* p = (f32x4*)(rowp + bj * HALF + n * 16); const f32x4 old = *p; *p = old * ALPHA + acc[ai][bj][m][n]; } }
    }
};
struct EpiMoe1 {
    static constexpr bool PERM = true;
    bf16* ACT;
    __device__ __forceinline__ void operator()(const f32x4 (&acc)[2][2][4][2], const Unit& u, int wr, int wc, int fr, int fq) const {
        const int row0 = u.pm * BM + wr * 64 + fr, col0 = u.pn * 128 + wc * 32 + 8 * fq;
#pragma unroll
        for (int ai = 0; ai < 2; ++ai)
#pragma unroll
            for (int m = 0; m < 4; ++m) { bf16* rowp = ACT + (size_t)(row0 + ai * HALF + m * 16) * DEXP + col0;
                float o[8];
#pragma unroll
                for (int n = 0; n < 2; ++n)
#pragma unroll
                    for (int j = 0; j < 4; ++j) { const float a = acc[ai][0][m][n][j], b = acc[ai][1][m][n][j]; o[n * 4 + j] = a * fast_sigmoid(a) * b; }
                u32x4 w; w.x = cvt_pk_bf16(o[0], o[1]); w.y = cvt_pk_bf16(o[2], o[3]); w.z = cvt_pk_bf16(o[4], o[5]); w.w = cvt_pk_bf16(o[6], o[7]);
                *(u32x4*)rowp = w; }
    }
};
struct EpiMoe2 {
    static constexpr bool PERM = true;
    bf16* Y; const float* roww;
    __device__ __forceinline__ void operator()(const f32x4 (&acc)[2][2][4][2], const Unit& u, int wr, int wc, int fr, int fq) const {
        const int row0 = u.pm * BM + wr * 64 + fr, col0 = u.pn * BM + wc * 32 + 8 * fq;
#pragma unroll
        for (int ai = 0; ai < 2; ++ai)
#pragma unroll
            for (int m = 0; m < 4; ++m) { const int row = row0 + ai * HALF + m * 16; const float rw = roww[row]; bf16* rowp = Y + (size_t)row * D + col0;
#pragma unroll
                for (int bj = 0; bj < 2; ++bj) { const f32x4 v0 = acc[ai][bj][m][0] * rw, v1 = acc[ai][bj][m][1] * rw;
                    u32x4 w; w.x = cvt_pk_bf16(v0[0], v0[1]); w.y = cvt_pk_bf16(v0[2], v0[3]); w.z = cvt_pk_bf16(v1[0], v1[1]); w.w = cvt_pk_bf16(v1[2], v1[3]);
                    *(u32x4*)(rowp + bj * HALF) = w; } }
    }
};

struct MergeOrder {
    const char* Y[3]; const char* W; int G, c;
    __device__ __forceinline__ bool next(int i, Unit& u) const {
        const int j = i / 3, r = i - 3 * j; const int L = j * G + c; if (L >= 128 * 4) return false;
        pg8::tile_of(L, 128, 4, u.pm, u.pn); u.aux = r;
        const char* y = (r == 0) ? Y[0] : ((r == 1) ? Y[1] : Y[2]);
        u.A = y + (size_t)u.pm * (256 * 512 * 2); u.B = W + (size_t)r * (1024 * 512 * 2) + (size_t)u.pn * (256 * 512 * 2); return true;
    }
};
template <int KDIM> struct MoeOrder {
    const char* A; const char* W; const LAS int* pe; int c, NP;
    __device__ __forceinline__ bool next(int i, Unit& u) const {
        const int L = i * 256 + c; if (L >= NP * 4) return false;
        const int p = L >> 2, pn = L & 3; const int e = __builtin_amdgcn_readfirstlane(pe[p]);
        u.pm = p; u.pn = pn; u.aux = e; u.A = A + (size_t)p * (256 * KDIM * 2); u.B = W + (size_t)e * (1024 * KDIM * 2) + (size_t)pn * (256 * KDIM * 2); return true;
    }
};

struct Args {
    const float* in[23]; float* out; unsigned char* ws; int ph_lo, ph_hi;
};
struct Frame {
    LAS unsigned char* lds; int tid, lane, wave, G, wg;
    float* out; unsigned char* ws;
};
__device__ __forceinline__ const float* inp_lds(LAS unsigned char* lds, int i) {
    const unsigned long long v = ((const LAS unsigned long long*)(lds + LARG_OFF))[i];
    const unsigned lo = __builtin_amdgcn_readfirstlane((unsigned)v), hi = __builtin_amdgcn_readfirstlane((unsigned)(v >> 32));
    return (const float*)(((unsigned long long)hi << 32) | lo);
}
__device__ __forceinline__ const float* inp(const Frame& F, int i) { return inp_lds(F.lds, i); }
__device__ __forceinline__ Frame fresh(LAS unsigned char* lds, int wave) {
    Frame F; int wgx = blockIdx.x; unsigned lb = (unsigned)(unsigned long long)lds;
    asm volatile("" : "+s"(wave), "+s"(wgx), "+s"(lb));
    F.lds = (LAS unsigned char*)(unsigned long long)lb;
    F.wave = wave; F.lane = (int)__builtin_amdgcn_mbcnt_hi(~0u, __builtin_amdgcn_mbcnt_lo(~0u, 0u)); F.tid = wave * 64 + F.lane;
    F.G = 256; F.wg = wgx;
    F.out = (float*)inp_lds(F.lds, 23); F.ws = (unsigned char*)inp_lds(F.lds, 24);
    return F;
}
enum { I_X = 0, I_LN_IN_G, I_LN_IN_B, I_W_IN, I_CONV, I_A_LOG, I_DT_BIAS, I_DN_NORM, I_POOL_W, I_POOL_SCALE, I_ML_GATE_B, I_ML_NORM, I_W_BRANCH, I_W_OUT, I_LN_MIX_G, I_LN_MIX_B,
       I_ROUTER_W, I_ROUTER_B, I_MOE_W1, I_MOE_W3, I_MOE_W2, I_LN_FFN_G, I_LN_FFN_B };

__device__ __forceinline__ void tr_item(const float* W, int ldw, int k0, int n0src, bf16* WT, int dpitch, int drow0, LAS float* scr, int lane) {
#pragma unroll 8
    for (int i = 0; i < 32; ++i) { const int kk = 2 * i + (lane >> 5); scr[kk * 33 + (lane & 31)] = W[(size_t)(k0 + kk) * ldw + n0src + (lane & 31)]; }
    LDS_WAIT(); asm volatile("" ::: "memory");
    const int c = lane & 7;
#pragma unroll
    for (int j = 0; j < 4; ++j) { const int n = (lane >> 3) + 8 * j; const LAS float* s = scr + (8 * c) * 33 + n;
        u32x4 o; o.x = pk2(s[0 * 33], s[1 * 33]); o.y = pk2(s[2 * 33], s[3 * 33]); o.z = pk2(s[4 * 33], s[5 * 33]); o.w = pk2(s[6 * 33], s[7 * 33]);
        *(u32x4*)(WT + (size_t)(drow0 + n) * dpitch + k0 + 8 * c) = o; }
    LDS_WAIT(); asm volatile("" ::: "memory");
}
__device__ __forceinline__ void tr_segment(const Frame& F, const float* W, int ldw, int K, int n0src, int ncols, bf16* WT, int drow0, int& it) {
    LAS float* scr = (LAS float*)(F.lds + F.wave * 16384);
    const int gw = F.wg * NWAVES + F.wave, NGW = F.G * NWAVES;
    const int nblk = ncols / 32, nitems = (K / 64) * nblk;
    int first = (gw - (it % NGW) + NGW) % NGW;
    for (int r = first; r < nitems; r += NGW) { const int kb = r / nblk, nb = r % nblk; tr_item(W, ldw, 64 * kb, n0src + 32 * nb, WT, K, drow0 + 32 * nb, scr, F.lane); }
    it += nitems;
}
__device__ __forceinline__ void wprep_mixer(const Frame& F, int l) {
    const float* win = inp(F, I_W_IN) + (size_t)l * D * DIN; int it = 0;
    bf16* Wi = (bf16*)(F.ws + WS_WIN); bf16* Wg = (bf16*)(F.ws + WS_WGATE); bf16* Wb = (bf16*)(F.ws + WS_WBR); bf16* Wo = (bf16*)(F.ws + WS_WOUT);
    tr_segment(F, win, DIN, D, C_QKV, 1536, Wi, 0, it);
    tr_segment(F, win, DIN, D, C_Z, 512, Wi, 1536, it);
    tr_segment(F, win, DIN, D, C_POOL, 512, Wi, 2048, it);
    tr_segment(F, win, DIN, D, C_MQ, 256, Wi, 2560, it);
    tr_segment(F, win, DIN, D, C_MK, 256, Wi, 2816, it);
    tr_segment(F, win, DIN, D, C_MV, 512, Wi, 3072, it);
    tr_segment(F, win, DIN, D, C_MO, 512, Wi, 3584, it);
    tr_segment(F, win, DIN, D, C_GATE, 3072, Wg, 0, it);
    const float* wbr = inp(F, I_W_BRANCH) + (size_t)l * 3 * MIXW * D;
    tr_segment(F, wbr, D, MIXW, 0, D, Wb, 0, it);
    tr_segment(F, wbr + (size_t)2 * MIXW * D, D, MIXW, 0, D, Wb + (size_t)2 * D * MIXW, 0, it);
    tr_segment(F, inp(F, I_W_OUT) + (size_t)l * D * D, D, D, 0, D, Wo, 0, it);
    const float* pw = inp(F, I_POOL_W) + (size_t)l * 4 * 128 * 128; const float* ps = inp(F, I_POOL_SCALE) + (size_t)l * MIXW; const float* wb1 = wbr + (size_t)MIXW * D;
    bf16* W1 = Wb + (size_t)D * MIXW;
    for (int idx = F.wg * 512 + F.tid; idx < D * MIXW; idx += F.G * 512) {
        const int m = idx >> 10, d = idx & 1023, g = m >> 7, c = m & 127;
        float s = 0.f;
        for (int dd = 0; dd < 128; ++dd) s += pw[(g * 128 + c) * 128 + dd] * ps[g * 128 + dd] * wb1[(size_t)(g * 128 + dd) * D + d];
        W1[(size_t)d * MIXW + m] = (bf16)f2bf(s);
    }
}
__device__ __forceinline__ void wprep_moe(const Frame& F, int l) {
    bf16* W13 = (bf16*)(F.ws + WS_W13); bf16* W2 = (bf16*)(F.ws + WS_W2);
    LAS float* scr = (LAS float*)(F.lds + F.wave * 16384);
    const int gw = F.wg * NWAVES + F.wave, NGW = F.G * NWAVES;
    for (int r = gw; r < NEXP * 2 * 256; r += NGW) {
        const int e = r >> 9, which = (r >> 8) & 1, kb = (r >> 4) & 15, nb = r & 15, n0 = nb * 32;
        const float* W = inp(F, which ? I_MOE_W3 : I_MOE_W1) + ((size_t)l * NEXP + e) * D * DEXP;
        tr_item(W, DEXP, 64 * kb, n0, W13 + (size_t)e * D * D, D, (n0 >> 7) * 256 + which * 128 + (n0 & 127), scr, F.lane);
    }
    for (int r = gw; r < NEXP * 256; r += NGW) {
        const int e = r >> 8, kb = (r >> 5) & 7, nb = r & 31;
        const float* W = inp(F, I_MOE_W2) + ((size_t)l * NEXP + e) * DEXP * D;
        tr_item(W, D, 64 * kb, 32 * nb, W2 + (size_t)e * D * DEXP, DEXP, 32 * nb, scr, F.lane);
    }
}

__device__ __forceinline__ int w32_addr(int k, int c4) { return (k >> 1) * 256 + (((((k & 1) << 3) | c4) ^ ((k >> 1) & 15)) << 4); }
__device__ __forceinline__ void stage_w32(const Frame& F, const float* src, int ldw, bool gates) {
    for (int idx = F.tid; idx < D * 8; idx += 512) {
        const int k = idx >> 3, c4 = idx & 7;
        int col = 4 * c4;
        if (gates) col = (c4 < 2) ? (C_A + 4 * c4) : (c4 < 4) ? (C_B + 4 * (c4 - 2)) : (c4 < 6) ? (C_I + 4 * (c4 - 4)) : (C_F + 4 * (c4 - 6));
        const f32x4 v = *(const f32x4*)(src + (size_t)k * ldw + col);
        *(LAS f32x4*)(F.lds + w32_addr(k, c4)) = v;
    }
}
template <int MODE>
__device__ __forceinline__ void ln_phase(const Frame& F, const float* gam, const float* bet, const float* w32src, int w32ld, bool do_proj, bool write_hb) {
    LAS int* lhist = (LAS int*)(F.lds + LHIST_OFF);
    if (do_proj) stage_w32(F, w32src, w32ld, MODE != 1);
    if (MODE == 1 && F.tid < 32) lhist[F.tid] = 0;
    __syncthreads();
    const int lane = F.lane;
    f32x2 gv[8], bv[8];
#pragma unroll
    for (int m = 0; m < 8; ++m) { gv[m] = *(const f32x2*)(gam + 2 * lane + 128 * m); bv[m] = *(const f32x2*)(bet + 2 * lane + 128 * m); }
    bf16* hb = (bf16*)(F.ws + WS_HB);
    const int rows_per_wg = T / F.G;
    for (int i = 0; i < rows_per_wg / NWAVES; ++i) {
        const int row = F.wg * rows_per_wg + F.wave * (rows_per_wg / NWAVES) + i;
        f32x2 v[8];
        if (MODE == 0) {
#pragma unroll
            for (int m = 0; m < 8; ++m) v[m] = *(const f32x2*)(inp(F, I_X) + (size_t)row * D + 2 * lane + 128 * m);
        } else if (MODE == 1) {
#pragma unroll
            for (int m = 0; m < 8; ++m) v[m] = *(const f32x2*)(F.out + (size_t)row * D + 2 * lane + 128 * m);
        } else {
            const int* pos = (const int*)(F.ws + WS_POS); const int p0 = pos[2 * row], p1 = pos[2 * row + 1];
            const bf16* Y = (const bf16*)(F.ws + WS_YROWS);
#pragma unroll
            for (int m = 0; m < 8; ++m) {
                const f32x2 o = *(const f32x2*)(F.out + (size_t)row * D + 2 * lane + 128 * m);
                const unsigned a = *(const unsigned*)(Y + (size_t)p0 * D + 2 * lane + 128 * m), b = *(const unsigned*)(Y + (size_t)p1 * D + 2 * lane + 128 * m);
                v[m].x = ALPHA * o.x + bf2f(a & 0xffffu) + bf2f(b & 0xffffu); v[m].y = ALPHA * o.y + bf2f(a >> 16) + bf2f(b >> 16);
            }
        }
        float s = 0.f;
#pragma unroll
        for (int m = 0; m < 8; ++m) s += v[m].x + v[m].y;
        const float mean = wave_sum(s) * (1.f / D);
        float s2 = 0.f;
#pragma unroll
        for (int m = 0; m < 8; ++m) { v[m].x -= mean; v[m].y -= mean; s2 += v[m].x * v[m].x + v[m].y * v[m].y; }
        const float rstd = 1.0f / sqrtf(wave_sum(s2) * (1.f / D) + LN_EPS);
#pragma unroll
        for (int m = 0; m < 8; ++m) { v[m].x = v[m].x * rstd * gv[m].x + bv[m].x; v[m].y = v[m].y * rstd * gv[m].y + bv[m].y; }
#pragma unroll
        for (int m = 0; m < 8; ++m) *(f32x2*)(F.out + (size_t)row * D + 2 * lane + 128 * m) = v[m];
        if (write_hb) {
#pragma unroll
            for (int m = 0; m < 8; ++m) *(unsigned*)(hb + (size_t)row * D + 2 * lane + 128 * m) = pk2(v[m].x, v[m].y);
        }
        if (!do_proj) continue;
        float acc[32];
#pragma unroll
        for (int c = 0; c < 32; ++c) acc[c] = 0.f;
#pragma unroll
        for (int m = 0; m < 8; ++m) {
#pragma unroll
            for (int e = 0; e < 2; ++e) {
                asm volatile("" ::: "memory");
                const int k = 2 * lane + 128 * m + e; const float xv = e ? v[m].y : v[m].x;
#pragma unroll
                for (int c4 = 0; c4 < 8; ++c4) { const f32x4 w = *(const LAS f32x4*)(F.lds + w32_addr(k, c4));
                    acc[4 * c4 + 0] += xv * w[0]; acc[4 * c4 + 1] += xv * w[1]; acc[4 * c4 + 2] += xv * w[2]; acc[4 * c4 + 3] += xv * w[3]; }
            }
        }
        float r16[16], r8[8], r4[4], r2[2], r1;
        { const bool hi = (lane & 32) != 0;
#pragma unroll
          for (int j = 0; j < 16; ++j) { const float a = acc[j], b = acc[j + 16]; const float send = hi ? a : b, keep = hi ? b : a; r16[j] = keep + __shfl_xor(send, 32); } }
        { const bool hi = (lane & 16) != 0;
#pragma unroll
          for (int j = 0; j < 8; ++j) { const float a = r16[j], b = r16[j + 8]; const float send = hi ? a : b, keep = hi ? b : a; r8[j] = keep + __shfl_xor(send, 16); } }
        { const bool hi = (lane & 8) != 0;
#pragma unroll
          for (int j = 0; j < 4; ++j) { const float a = r8[j], b = r8[j + 4]; const float send = hi ? a : b, keep = hi ? b : a; r4[j] = keep + __shfl_xor(send, 8); } }
        { const bool hi = (lane & 4) != 0;
#pragma unroll
          for (int j = 0; j < 2; ++j) { const float a = r4[j], b = r4[j + 2]; const float send = hi ? a : b, keep = hi ? b : a; r2[j] = keep + __shfl_xor(send, 4); } }
        { const bool hi = (lane & 2) != 0; const float a = r2[0], b = r2[1]; const float send = hi ? a : b, keep = hi ? b : a; r1 = keep + __shfl_xor(send, 2); }
        r1 += __shfl_xor(r1, 1);
        if (MODE != 1) {
            if ((lane & 1) == 0) ((float*)(F.ws + WS_SG))[(size_t)row * 32 + (lane >> 1)] = r1;
        } else {
            const float score = sigmoidf_(r1);
            const float sel = score + inp(F, I_ROUTER_B)[lane >> 1];
            const int gb = lane & ~7;
            const float v0 = __shfl(sel, gb + 0), v1 = __shfl(sel, gb + 2), v2 = __shfl(sel, gb + 4), v3 = __shfl(sel, gb + 6);
            int i1 = 0; float m1 = v0;
            if (v1 > m1) { m1 = v1; i1 = 1; } if (v2 > m1) { m1 = v2; i1 = 2; } if (v3 > m1) { m1 = v3; i1 = 3; }
            int i2 = -1; float m2 = -3.0e38f;
            if (i1 != 0 && v0 > m2) { m2 = v0; i2 = 0; } if (i1 != 1 && v1 > m2) { m2 = v1; i2 = 1; } if (i1 != 2 && v2 > m2) { m2 = v2; i2 = 2; } if (i1 != 3 && v3 > m2) { m2 = v3; i2 = 3; }
            float gs = m1 + m2; int gi = lane >> 3;
#pragma unroll
            for (int o = 8; o < 64; o <<= 1) { const float og = __shfl_xor(gs, o); const int oi = __shfl_xor(gi, o); if (og > gs || (og == gs && oi < gi)) { gs = og; gi = oi; } }
            const int src = gi * 8;
            const int e1 = gi * 4 + __shfl(i1, src), e2 = gi * 4 + __shfl(i2, src);
            const float s1 = __shfl(score, 2 * e1), s2 = __shfl(score, 2 * e2);
            if (lane == 0) {
                int* eid = (int*)(F.ws + WS_EID); float* ew = (float*)(F.ws + WS_EW);
                const float inv = 1.0f / (s1 + s2);
                eid[2 * row] = e1; eid[2 * row + 1] = e2; ew[2 * row] = s1 * inv; ew[2 * row + 1] = s2 * inv;
                __hip_atomic_fetch_add(lhist + e1, 1, __ATOMIC_RELAXED, __HIP_MEMORY_SCOPE_WORKGROUP); __hip_atomic_fetch_add(lhist + e2, 1, __ATOMIC_RELAXED, __HIP_MEMORY_SCOPE_WORKGROUP);
            }
        }
    }
    if (MODE == 1) {
        __syncthreads();
        if (F.tid < 32) ((int*)(F.ws + WS_HIST))[F.wg * 32 + F.tid] = lhist[F.tid];
    }
    __syncthreads();
}

__device__ __forceinline__ int invsigma32(int w) { return 8 * ((w >> 2) & 3) + 4 * (w >> 4) + (w & 3); }
__device__ __forceinline__ float wave_incl_scan(float v, int lane) {
#pragma unroll
    for (int o = 1; o < 64; o <<= 1) { const float t = __shfl_up(v, o); if (lane >= o) v += t; }
    return v;
}
__device__ __forceinline__ float wave_incl_maxscan(float v, int lane) {
#pragma unroll
    for (int o = 1; o < 64; o <<= 1) { const float t = __shfl_up(v, o); if (lane >= o) v = fmaxf(v, t); }
    return v;
}
constexpr int DQ_OFF = 0, DK_OFF = 17408, DV_OFF = 34816, DGM_OFF = 52224, DQK_OFF = 68864, DTM_OFF = 85504, DVEC_OFF = 120320;
constexpr int QROW = 272;
__device__ __forceinline__ void dn_prep(const Frame& F, int l) {
    LAS unsigned char* L = F.lds;
    const int lane = F.lane, wave = F.wave, tid = F.tid;
    const bf16* P = (const bf16*)(F.ws + WS_PQKV);
    const float* SG = (const float*)(F.ws + WS_SG);
    const float* cw = inp(F, I_CONV) + (size_t)l * 5 * 1536;
    for (int item = F.wg; item < NB * NHEAD * NCH; item += F.G) {
        const int b = item >> 9, h = (item >> 7) & 3, n = item & 127;
        const int t0 = b * SEQ + n * CH;
        {
            float w[3][5][2];
#pragma unroll
            for (int p = 0; p < 3; ++p)
#pragma unroll
                for (int j = 0; j < 5; ++j) { const f32x2 t = *(const f32x2*)(cw + j * 1536 + p * 512 + h * 128 + 2 * lane); w[p][j][0] = t.x; w[p][j][1] = t.y; }
            for (int ii = 0; ii < 8; ++ii) {
                const int i = wave + 8 * ii;
                float y[3][2];
#pragma unroll
                for (int p = 0; p < 3; ++p) { y[p][0] = 0.f; y[p][1] = 0.f; }
#pragma unroll
                for (int j = 0; j < 5; ++j) {
                    const int sp = n * CH + i + j - 2;
                    if (sp >= 0 && sp < SEQ) {
                        const bf16* src = P + (size_t)(b * SEQ + sp) * 1536 + h * 128 + 2 * lane;
#pragma unroll
                        for (int p = 0; p < 3; ++p) { const unsigned u = *(const unsigned*)(src + p * 512); y[p][0] += bf2f(u & 0xffffu) * w[p][j][0]; y[p][1] += bf2f(u >> 16) * w[p][j][1]; }
                    }
                }
#pragma unroll
                for (int p = 0; p < 3; ++p) { y[p][0] = siluf_(y[p][0]); y[p][1] = siluf_(y[p][1]); }
                const float sq = wave_sum(y[0][0] * y[0][0] + y[0][1] * y[0][1]), sk = wave_sum(y[1][0] * y[1][0] + y[1][1] * y[1][1]);
                const float rq = (1.0f / sqrtf(sq + NORM_EPS)) * 0.08838834764831845f, rk = 1.0f / sqrtf(sk + NORM_EPS);
                *(LAS unsigned*)(L + DQ_OFF + i * QROW + 4 * lane) = pk2(y[0][0] * rq, y[0][1] * rq);
                *(LAS unsigned*)(L + DK_OFF + i * QROW + 4 * lane) = pk2(y[1][0] * rk, y[1][1] * rk);
                *(LAS unsigned*)(L + DV_OFF + i * QROW + 4 * lane) = pk2(y[2][0], y[2][1]);
            }
        }
        __syncthreads();
        {
            const int j = lane, i0 = wave * 8;
            float g[8], qk[8];
#pragma unroll
            for (int ii = 0; ii < 8; ++ii) { g[ii] = 0.f; qk[ii] = 0.f; }
            for (int c8 = 0; c8 < 16; ++c8) {
                float kj[8]; unpack8(*(const LAS u32x4*)(L + DK_OFF + j * QROW + 16 * c8), kj);
#pragma unroll
                for (int ii = 0; ii < 8; ++ii) {
                    float ki[8], qi[8]; unpack8(*(const LAS u32x4*)(L + DK_OFF + (i0 + ii) * QROW + 16 * c8), ki); unpack8(*(const LAS u32x4*)(L + DQ_OFF + (i0 + ii) * QROW + 16 * c8), qi);
#pragma unroll
                    for (int e = 0; e < 8; ++e) { g[ii] += ki[e] * kj[e]; qk[ii] += qi[e] * kj[e]; }
                }
            }
#pragma unroll
            for (int ii = 0; ii < 8; ++ii) { *(LAS float*)(L + DGM_OFF + ((i0 + ii) * 65 + j) * 4) = g[ii]; *(LAS float*)(L + DQK_OFF + ((i0 + ii) * 65 + j) * 4) = qk[ii]; }
        }
        __syncthreads();
        if (wave < 2) {
            const int d = wave;
            const int ti = d ? 63 - lane : lane;
            const float a = SG[(size_t)(t0 + ti) * 32 + d * 4 + h], bb = SG[(size_t)(t0 + ti) * 32 + 8 + d * 4 + h];
            const float beta = sigmoidf_(bb);
            const float g = -expf(inp(F, I_A_LOG)[l * 8 + d * 4 + h]) * softplusf_(a + inp(F, I_DT_BIAS)[l * 8 + d * 4 + h]);
            const float gc = wave_incl_scan(g, lane);
            LAS float* vec = (LAS float*)(L + DVEC_OFF + d * 2048);
            vec[lane] = beta; vec[64 + lane] = gc;
            LAS float* TM = (LAS float*)(L + DTM_OFF + d * 17408);
            const LAS float* GM = (const LAS float*)(L + DGM_OFF);
            for (int i = 0; i < 64; ++i) {
                const float beta_i = __shfl(beta, i), gc_i = __shfl(gc, i);
                const int tii = d ? 63 - i : i;
                const float mrow = beta_i * GM[tii * 65 + ti] * fexp(fminf(gc_i - gc, 0.f));
                float t0a = (lane == i) ? 1.f : 0.f, t1a = 0.f, t2a = 0.f, t3a = 0.f;
                int jj = 0;
                for (; jj + 4 <= i; jj += 4) {
                    t0a -= __shfl(mrow, jj) * TM[jj * 68 + lane];
                    t1a -= __shfl(mrow, jj + 1) * TM[(jj + 1) * 68 + lane];
                    t2a -= __shfl(mrow, jj + 2) * TM[(jj + 2) * 68 + lane];
                    t3a -= __shfl(mrow, jj + 3) * TM[(jj + 3) * 68 + lane];
                }
                for (; jj < i; ++jj) t0a -= __shfl(mrow, jj) * TM[jj * 68 + lane];
                TM[i * 68 + lane] = (t0a + t1a) + (t2a + t3a);
            }
            if (lane == 63) ((float*)(F.ws + WS_GL))[(size_t)item * 2 + d] = expf(gc);
        }
        __syncthreads();
        {
            const int d = tid >> 8, tt = tid & 255;
            const LAS float* vec = (const LAS float*)(L + DVEC_OFF + d * 2048);
            const LAS float* TM = (const LAS float*)(L + DTM_OFF + d * 17408);
            unsigned char* rec = F.ws + WS_R2 + ((size_t)item * 2 + d) * DNREC;
            const float gl = vec[64 + 63];
            {
                float X[64];
                const bool isv = tt < 128; const int col = isv ? tt : tt - 128;
                const int imgoff = isv ? DV_OFF : DK_OFF;
#pragma unroll
                for (int j = 0; j < 64; ++j) {
                    const int tj = d ? 63 - j : j;
                    const float x = bf2f(*(const LAS unsigned short*)(L + imgoff + tj * QROW + 2 * col));
                    const float be = vec[j], gcj = vec[64 + j];
                    X[j] = isv ? x * be : x * be * fexp(gcj);
                }
                bf16* Uf = (bf16*)(rec + DN_UF); bf16* Wp = (bf16*)(rec + DN_W);
                const int wpos = (col & ~31) + invsigma32(col & 31);
                for (int i = 0; i < 64; ++i) {
                    float s0 = 0.f, s1 = 0.f, s2 = 0.f, s3 = 0.f;
#pragma unroll
                    for (int j4 = 0; j4 < 16; ++j4) { const f32x4 t = *(const LAS f32x4*)(TM + i * 68 + 4 * j4);
                        s0 += t[0] * X[4 * j4]; s1 += t[1] * X[4 * j4 + 1]; s2 += t[2] * X[4 * j4 + 2]; s3 += t[3] * X[4 * j4 + 3]; }
                    const float o = (s0 + s1) + (s2 + s3);
                    if (isv) { const int mt = i >> 4, fq = (i >> 2) & 3, r = i & 3; Uf[(((col >> 4) * 64 + fq * 16 + (col & 15)) * 16) + mt * 4 + r] = (bf16)f2bf(o); }
                    else Wp[i * 128 + wpos] = (bf16)f2bf(o);
                }
            }
            {
                bf16* Qg = (bf16*)(rec + DN_QG); bf16* Kd = (bf16*)(rec + DN_KDT);
#pragma unroll 2
                for (int e = 0; e < 32; ++e) {
                    const int idx = tt + 256 * e, i = idx >> 7, kk = idx & 127;
                    const int ti = d ? 63 - i : i;
                    const float gci = vec[64 + i];
                    const float qv = bf2f(*(const LAS unsigned short*)(L + DQ_OFF + ti * QROW + 2 * kk));
                    const float kv = bf2f(*(const LAS unsigned short*)(L + DK_OFF + ti * QROW + 2 * kk));
                    Qg[i * 128 + (kk & ~31) + invsigma32(kk & 31)] = (bf16)f2bf(qv * fexp(gci));
                    Kd[kk * 64 + (i & ~31) + invsigma32(i & 31)] = (bf16)f2bf(kv * fexp(gl - gci));
                }
            }
            {
                bf16* At = (bf16*)(rec + DN_ATT);
                const LAS float* QKM = (const LAS float*)(L + DQK_OFF);
#pragma unroll 2
                for (int e = 0; e < 16; ++e) {
                    const int idx = tt + 256 * e, i = idx >> 6, j = idx & 63;
                    const int ti = d ? 63 - i : i, tj = d ? 63 - j : j;
                    const float v = (j <= i) ? QKM[ti * 65 + tj] * fexp(fminf(vec[64 + i] - vec[64 + j], 0.f)) : 0.f;
                    At[i * 64 + (j & ~31) + invsigma32(j & 31)] = (bf16)f2bf(v);
                }
            }
        }
        __syncthreads();
    }
}

__device__ __forceinline__ bf16x8 pack_b(const f32x4 lo, const f32x4 hi) {
    u32x4 w; w.x = cvt_pk_bf16(lo[0], lo[1]); w.y = cvt_pk_bf16(lo[2], lo[3]); w.z = cvt_pk_bf16(hi[0], hi[1]); w.w = cvt_pk_bf16(hi[2], hi[3]);
    return __builtin_bit_cast(bf16x8, w);
}
__device__ __forceinline__ void dn_scan(const Frame& F) {
    if (F.wave != 0) return;
    const int wgid = F.wg; if (wgid >= 256) return;
    const int xcd = wgid & 7, within = wgid >> 3;
    const int chain = xcd + 8 * (within >> 3), slice = within & 7;
    const int b = chain >> 3, h = (chain >> 1) & 3, d = chain & 1;
    const int lane = F.lane, fr = lane & 15, fq = lane >> 4;
    const float* GL = (const float*)(F.ws + WS_GL);
    bf16* O = (bf16*)(F.ws + (d ? WS_OB : WS_OF));
    f32x4 S[8];
#pragma unroll
    for (int k = 0; k < 8; ++k) S[k] = (f32x4){0.f, 0.f, 0.f, 0.f};
    for (int step = 0; step < NCH; ++step) {
        const int n = d ? (NCH - 1 - step) : step;
        const int item = (b * NHEAD + h) * NCH + n;
        const unsigned char* rec = F.ws + WS_R2 + ((size_t)item * 2 + d) * DNREC;
        const bf16* Wp = (const bf16*)(rec + DN_W); const bf16* Qg = (const bf16*)(rec + DN_QG); const bf16* Kd = (const bf16*)(rec + DN_KDT);
        const bf16* At = (const bf16*)(rec + DN_ATT); const bf16* Uf = (const bf16*)(rec + DN_UF);
        const float egl = GL[(size_t)item * 2 + d];
        bf16x8 SB[4];
#pragma unroll
        for (int s = 0; s < 4; ++s) SB[s] = pack_b(S[2 * s], S[2 * s + 1]);
        f32x4 V[4], Q[4];
#pragma unroll
        for (int mt = 0; mt < 4; ++mt) { V[mt] = (f32x4){0.f, 0.f, 0.f, 0.f}; Q[mt] = (f32x4){0.f, 0.f, 0.f, 0.f}; }
#pragma unroll
        for (int s = 0; s < 4; ++s)
#pragma unroll
            for (int mt = 0; mt < 4; ++mt) {
                const bf16x8 a = *(const bf16x8*)(Wp + (16 * mt + fr) * 128 + 32 * s + 8 * fq);
                V[mt] = __builtin_amdgcn_mfma_f32_16x16x32_bf16(a, SB[s], V[mt], 0, 0, 0);
                const bf16x8 aq = *(const bf16x8*)(Qg + (16 * mt + fr) * 128 + 32 * s + 8 * fq);
                Q[mt] = __builtin_amdgcn_mfma_f32_16x16x32_bf16(aq, SB[s], Q[mt], 0, 0, 0);
            }
        {
            const u32x4 u0 = *(const u32x4*)(Uf + ((slice * 64 + lane) * 16)), u1 = *(const u32x4*)(Uf + ((slice * 64 + lane) * 16) + 8);
            float uu[16]; { float t[8]; unpack8(u0, t);
#pragma unroll
                for (int e = 0; e < 8; ++e) uu[e] = t[e]; unpack8(u1, t);
#pragma unroll
                for (int e = 0; e < 8; ++e) uu[8 + e] = t[e]; }
#pragma unroll
            for (int mt = 0; mt < 4; ++mt)
#pragma unroll
                for (int r = 0; r < 4; ++r) V[mt][r] = uu[mt * 4 + r] - V[mt][r];
        }
        bf16x8 VB[2];
#pragma unroll
        for (int s2 = 0; s2 < 2; ++s2) VB[s2] = pack_b(V[2 * s2], V[2 * s2 + 1]);
#pragma unroll
        for (int s2 = 0; s2 < 2; ++s2)
#pragma unroll
            for (int mt = 0; mt < 4; ++mt) {
                const bf16x8 a = *(const bf16x8*)(At + (16 * mt + fr) * 64 + 32 * s2 + 8 * fq);
                Q[mt] = __builtin_amdgcn_mfma_f32_16x16x32_bf16(a, VB[s2], Q[mt], 0, 0, 0);
            }
#pragma unroll
        for (int mt = 0; mt < 4; ++mt)
#pragma unroll
            for (int r = 0; r < 4; ++r) {
                const int i = 16 * mt + 4 * fq + r; const int tok = b * SEQ + n * CH + (d ? 63 - i : i);
                O[(size_t)tok * MIXW + h * HD + slice * 16 + fr] = (bf16)f2bf(Q[mt][r]);
            }
#pragma unroll
        for (int kt = 0; kt < 8; ++kt) {
            S[kt] = S[kt] * egl;
#pragma unroll
            for (int s2 = 0; s2 < 2; ++s2) {
                const bf16x8 a = *(const bf16x8*)(Kd + (16 * kt + fr) * 64 + 32 * s2 + 8 * fq);
                S[kt] = __builtin_amdgcn_mfma_f32_16x16x32_bf16(a, VB[s2], S[kt], 0, 0, 0);
            }
        }
    }
}

constexpr int MQ_OFF = 0, MK_OFF = 9216, MV_OFF = 18432, MQK_OFF = 35840, MVEC_OFF = 52480;
constexpr int MQROW = 144;
__device__ __forceinline__ void ml_prep(const Frame& F, int l) {
    LAS unsigned char* L = F.lds;
    const int lane = F.lane, wave = F.wave, tid = F.tid;
    const bf16* PQ = (const bf16*)(F.ws + WS_PMQ); const bf16* PK = (const bf16*)(F.ws + WS_PMK); const bf16* PV = (const bf16*)(F.ws + WS_PMV);
    const float* SG = (const float*)(F.ws + WS_SG);
    const float* gbias = inp(F, I_ML_GATE_B) + l * 16;
    for (int item = F.wg; item < NB * NHEAD * NCH; item += F.G) {
        const int b = item >> 9, h = (item >> 7) & 3, n = item & 127;
        const int t0 = b * SEQ + n * CH;
        {
            const int row = tid >> 3, c8 = tid & 7;
            const u32x4 q = *(const u32x4*)(PQ + (size_t)(t0 + row) * 256 + h * 64 + 8 * c8);
            u32x4 k = *(const u32x4*)(PK + (size_t)(t0 + row) * 256 + h * 64 + 8 * c8);
            { float f[8]; unpack8(k, f); k.x = pk2(f[0] * 0.125f, f[1] * 0.125f); k.y = pk2(f[2] * 0.125f, f[3] * 0.125f); k.z = pk2(f[4] * 0.125f, f[5] * 0.125f); k.w = pk2(f[6] * 0.125f, f[7] * 0.125f); }
            *(LAS u32x4*)(L + MQ_OFF + row * MQROW + 16 * c8) = q;
            *(LAS u32x4*)(L + MK_OFF + row * MQROW + 16 * c8) = k;
#pragma unroll
            for (int e = 0; e < 2; ++e) { const int idx = tid + 512 * e, r = idx >> 4, c = idx & 15;
                *(LAS u32x4*)(L + MV_OFF + r * QROW + 16 * c) = *(const u32x4*)(PV + (size_t)(t0 + r) * 512 + h * 128 + 8 * c); }
        }
        __syncthreads();
        {
            const int j = lane, i0 = wave * 8;
            float qk[8];
#pragma unroll
            for (int ii = 0; ii < 8; ++ii) qk[ii] = 0.f;
            for (int c8 = 0; c8 < 8; ++c8) {
                float kj[8]; unpack8(*(const LAS u32x4*)(L + MK_OFF + j * MQROW + 16 * c8), kj);
#pragma unroll
                for (int ii = 0; ii < 8; ++ii) { float qi[8]; unpack8(*(const LAS u32x4*)(L + MQ_OFF + (i0 + ii) * MQROW + 16 * c8), qi);
#pragma unroll
                    for (int e = 0; e < 8; ++e) qk[ii] += qi[e] * kj[e]; }
            }
#pragma unroll
            for (int ii = 0; ii < 8; ++ii) *(LAS float*)(L + MQK_OFF + ((i0 + ii) * 65 + j) * 4) = qk[ii];
        }
        if (wave < 2) {
            const int d = wave; const int ti = d ? 63 - lane : lane;
            const float ip = SG[(size_t)(t0 + ti) * 32 + 16 + d * 4 + h] + gbias[d * 4 + h];
            const float fp = SG[(size_t)(t0 + ti) * 32 + 24 + d * 4 + h] + gbias[8 + d * 4 + h];
            const float bc = wave_incl_scan(logsigmoidf_(fp), lane);
            const float bl = __shfl(bc, 63);
            const float lw = bl - bc + ip;
            const float am = wave_max(lw);
            const float wgt = expf(lw - am);
            const float ipb = ip - bc;
            const float dmax = bc + wave_incl_maxscan(ipb, lane);
            LAS float* vec = (LAS float*)(L + MVEC_OFF + d * 1024);
            vec[lane] = bc; vec[64 + lane] = dmax; vec[128 + lane] = wgt; vec[192 + lane] = ipb;
            float* row = (float*)(F.ws + WS_ML + ((size_t)item * 2 + d) * MLREC + ML_ROW);
            row[lane] = bc; row[64 + lane] = dmax; if (lane == 0) { row[128] = am; row[129] = bl; }
        }
        __syncthreads();
        {
            const int d = tid >> 8, tt = tid & 255;
            const LAS float* vec = (const LAS float*)(L + MVEC_OFF + d * 1024);
            const LAS float* QKM = (const LAS float*)(L + MQK_OFF);
            unsigned char* rec = F.ws + WS_ML + ((size_t)item * 2 + d) * MLREC;
            bf16* Qp = (bf16*)(rec + ML_Q); bf16* St = (bf16*)(rec + ML_ST); bf16* Kw = (bf16*)(rec + ML_KWT); bf16* Vf = (bf16*)(rec + ML_VF);
#pragma unroll 2
            for (int e = 0; e < 16; ++e) {
                const int idx = tt + 256 * e, i = idx >> 6, j = idx & 63;
                const int ti = d ? 63 - i : i, tj = d ? 63 - j : j;
                const float sv = (j <= i) ? QKM[ti * 65 + tj] * fexp(fminf(vec[i] + vec[192 + j] - vec[64 + i], 0.f)) : 0.f;
                St[i * 64 + j] = (bf16)f2bf(sv);
                Qp[i * 64 + (j & ~31) + invsigma32(j & 31)] = *(const LAS unsigned short*)(L + MQ_OFF + ti * MQROW + 2 * j);
                const float kv = bf2f(*(const LAS unsigned short*)(L + MK_OFF + tj * MQROW + 2 * i));
                Kw[i * 64 + j] = (bf16)f2bf(kv * vec[128 + j]);
            }
#pragma unroll 4
            for (int e = 0; e < 36; ++e) {
                const int idx = tt + 256 * e;
                const int el = idx & 7, lp = (idx >> 3) & 63, s = (idx >> 9) & 1, slice = idx >> 10;
                const int fr = lp & 15, fq = lp >> 4; const int j = 32 * s + 8 * fq + el; const int tj = d ? 63 - j : j;
                const unsigned short v = (slice < 8) ? *(const LAS unsigned short*)(L + MV_OFF + tj * QROW + 2 * (16 * slice + fr)) : (unsigned short)0x3F80;
                Vf[idx] = v;
            }
        }
        __syncthreads();
    }
}

__device__ __forceinline__ void ml_scan(const Frame& F) {
    if (F.wave > 1) return;
    const int task = F.wg + 256 * F.wave; if (task >= 288 || F.wg >= 256) return;
    const int chain = task & 31, slice = task >> 5;
    const int b = chain >> 3, h = (chain >> 1) & 3, d = chain & 1;
    const int lane = F.lane, fr = lane & 15, fq = lane >> 4;
    bf16* NUM = (bf16*)(F.ws + (d ? WS_NUMB : WS_NUMF)); float* DEN = (float*)(F.ws + WS_DEN);
    f32x4 C[4];
#pragma unroll
    for (int k = 0; k < 4; ++k) C[k] = (f32x4){0.f, 0.f, 0.f, 0.f};
    float m = 0.f;
    for (int step = 0; step < NCH; ++step) {
        const int n = d ? (NCH - 1 - step) : step;
        const int item = (b * NHEAD + h) * NCH + n;
        const unsigned char* rec = F.ws + WS_ML + ((size_t)item * 2 + d) * MLREC;
        const bf16* Qp = (const bf16*)(rec + ML_Q); const bf16* St = (const bf16*)(rec + ML_ST); const bf16* Kw = (const bf16*)(rec + ML_KWT); const bf16* Vf = (const bf16*)(rec + ML_VF);
        const float* row = (const float*)(rec + ML_ROW);
        const float am = row[128], bl = row[129];
        bf16x8 CB[2], VF[2];
#pragma unroll
        for (int s = 0; s < 2; ++s) { CB[s] = pack_b(C[2 * s], C[2 * s + 1]); VF[s] = *(const bf16x8*)(Vf + ((slice * 2 + s) * 64 + lane) * 8); }
        f32x4 QC[4], SV[4], KV[4];
#pragma unroll
        for (int mt = 0; mt < 4; ++mt) { QC[mt] = (f32x4){0.f, 0.f, 0.f, 0.f}; SV[mt] = (f32x4){0.f, 0.f, 0.f, 0.f}; KV[mt] = (f32x4){0.f, 0.f, 0.f, 0.f}; }
#pragma unroll
        for (int s = 0; s < 2; ++s)
#pragma unroll
            for (int mt = 0; mt < 4; ++mt) {
                const int off = (16 * mt + fr) * 64 + 32 * s + 8 * fq;
                QC[mt] = __builtin_amdgcn_mfma_f32_16x16x32_bf16(*(const bf16x8*)(Qp + off), CB[s], QC[mt], 0, 0, 0);
                SV[mt] = __builtin_amdgcn_mfma_f32_16x16x32_bf16(*(const bf16x8*)(St + off), VF[s], SV[mt], 0, 0, 0);
                KV[mt] = __builtin_amdgcn_mfma_f32_16x16x32_bf16(*(const bf16x8*)(Kw + off), VF[s], KV[mt], 0, 0, 0);
            }
#pragma unroll
        for (int mt = 0; mt < 4; ++mt) {
            const f32x4 bc4 = *(const f32x4*)(row + 16 * mt + 4 * fq), dm4 = *(const f32x4*)(row + 64 + 16 * mt + 4 * fq);
#pragma unroll
            for (int r = 0; r < 4; ++r) {
                const float il = bc4[r] + m, mo = fmaxf(il, dm4[r]);
                const float inter = expf(il - mo), e2 = expf(dm4[r] - mo);
                const float res = inter * QC[mt][r] + e2 * SV[mt][r];
                const int i = 16 * mt + 4 * fq + r; const int tok = b * SEQ + n * CH + (d ? 63 - i : i);
                if (slice < 8) NUM[(size_t)tok * MIXW + h * HD + slice * 16 + fr] = (bf16)f2bf(res);
                else if (fr == 0) DEN[(size_t)tok * 8 + h * 2 + d] = fmaxf(fabsf(res), expf(-mo));
            }
        }
        const float mn = fmaxf(bl + m, am), sp = expf(bl + m - mn), sc = expf(am - mn);
#pragma unroll
        for (int kt = 0; kt < 4; ++kt) C[kt] = C[kt] * sp + KV[kt] * sc;
        m = mn;
    }
}

__device__ __forceinline__ void pool_phase(const Frame& F) {
    const bf16* U = (const bf16*)(F.ws + WS_PPOOL); bf16* Y = (bf16*)(F.ws + WS_YP);
    const int gw = F.wg * NWAVES + F.wave, NGW = F.G * NWAVES, lane = F.lane;
    const int half = 1 << (lane >> 4);
    for (int t = gw; t < T; t += NGW) {
        const int sp = t & (SEQ - 1);
        const int lo = max(sp - half, 0), hi = min(sp + half, SEQ);
        float s[8];
#pragma unroll
        for (int e = 0; e < 8; ++e) s[e] = 0.f;
        for (int o = -8; o < 8; ++o) {
            const int q = sp + o;
            if (q >= lo && q < hi) { float f[8]; unpack8(*(const u32x4*)(U + (size_t)(t + o) * MIXW + 8 * lane), f);
#pragma unroll
                for (int e = 0; e < 8; ++e) s[e] += f[e]; }
        }
        float c[8]; unpack8(*(const u32x4*)(U + (size_t)t * MIXW + 8 * lane), c);
        const float inv = 1.0f / (float)(hi - lo);
        u32x4 w; w.x = pk2(s[0] * inv - c[0], s[1] * inv - c[1]); w.y = pk2(s[2] * inv - c[2], s[3] * inv - c[3]); w.z = pk2(s[4] * inv - c[4], s[5] * inv - c[5]); w.w = pk2(s[6] * inv - c[6], s[7] * inv - c[7]);
        *(u32x4*)(Y + (size_t)t * MIXW + 8 * lane) = w;
    }
}

__device__ __forceinline__ void norm_phase(const Frame& F, int l) {
    const bf16* OF = (const bf16*)(F.ws + WS_OF); const bf16* OB = (const bf16*)(F.ws + WS_OB);
    const bf16* NF = (const bf16*)(F.ws + WS_NUMF); const bf16* NBk = (const bf16*)(F.ws + WS_NUMB); const float* DEN = (const float*)(F.ws + WS_DEN);
    bf16* Z = (bf16*)(F.ws + WS_PZ); bf16* MO = (bf16*)(F.ws + WS_PMO);
    const int gw = F.wg * NWAVES + F.wave, NGW = F.G * NWAVES, lane = F.lane, h = lane >> 4;
    float nw[8], mw[8];
#pragma unroll
    for (int e = 0; e < 8; ++e) { nw[e] = inp(F, I_DN_NORM)[l * MIXW + 8 * lane + e]; mw[e] = inp(F, I_ML_NORM)[l * MIXW + 8 * lane + e]; }
    for (int t = gw; t < T; t += NGW) {
        const size_t off = (size_t)t * MIXW + 8 * lane;
        {
            float a[8], bq[8], z[8]; unpack8(*(const u32x4*)(OF + off), a); unpack8(*(const u32x4*)(OB + off), bq); unpack8(*(const u32x4*)(Z + off), z);
            float ss = 0.f;
#pragma unroll
            for (int e = 0; e < 8; ++e) { a[e] += bq[e]; ss += a[e] * a[e]; }
            ss += __shfl_xor(ss, 1); ss += __shfl_xor(ss, 2); ss += __shfl_xor(ss, 4); ss += __shfl_xor(ss, 8);
            const float r = 1.0f / sqrtf(ss * (1.f / HD) + NORM_EPS);
            float o[8];
#pragma unroll
            for (int e = 0; e < 8; ++e) o[e] = a[e] * r * nw[e] * siluf_(z[e]);
            u32x4 w; w.x = pk2(o[0], o[1]); w.y = pk2(o[2], o[3]); w.z = pk2(o[4], o[5]); w.w = pk2(o[6], o[7]);
            *(u32x4*)(Z + off) = w;
        }
        {
            float a[8], bq[8], g[8]; unpack8(*(const u32x4*)(NF + off), a); unpack8(*(const u32x4*)(NBk + off), bq); unpack8(*(const u32x4*)(MO + off), g);
            const float df = 1.0f / DEN[(size_t)t * 8 + h * 2], db = 1.0f / DEN[(size_t)t * 8 + h * 2 + 1];
            float s = 0.f;
#pragma unroll
            for (int e = 0; e < 8; ++e) { a[e] = a[e] * df + bq[e] * db; s += a[e]; }
            s += __shfl_xor(s, 1); s += __shfl_xor(s, 2); s += __shfl_xor(s, 4); s += __shfl_xor(s, 8);
            const float mean = s * (1.f / HD); float ss = 0.f;
#pragma unroll
            for (int e = 0; e < 8; ++e) { a[e] -= mean; ss += a[e] * a[e]; }
            ss += __shfl_xor(ss, 1); ss += __shfl_xor(ss, 2); ss += __shfl_xor(ss, 4); ss += __shfl_xor(ss, 8);
            const float r = 1.0f / sqrtf(ss * (1.f / HD) + NORM_EPS);
            float o[8];
#pragma unroll
            for (int e = 0; e < 8; ++e) o[e] = a[e] * r * mw[e] * sigmoidf_(g[e]);
            u32x4 w; w.x = pk2(o[0], o[1]); w.y = pk2(o[2], o[3]); w.z = pk2(o[4], o[5]); w.w = pk2(o[6], o[7]);
            *(u32x4*)(MO + off) = w;
        }
    }
}

__device__ __forceinline__ void moe_tables(const Frame& F) {
    LAS int* cnt = (LAS int*)(F.lds + LHIST_OFF + 128); LAS int* pstart = (LAS int*)(F.lds + LHIST_OFF + 256); LAS int* mybase = (LAS int*)(F.lds + LHIST_OFF + 384);
    LAS int* pe = (LAS int*)(F.lds + LPE_OFF);
    const int* hist = (const int*)(F.ws + WS_HIST);
    if (F.tid < 32) { cnt[F.tid] = 0; mybase[F.tid] = 0; }
    __syncthreads();
    { const int e = F.tid & 31, part = F.tid >> 5; int tot = 0, base = 0;
      for (int q = 0; q < 16; ++q) { const int w = part * 16 + q; const int v = hist[w * 32 + e]; tot += v; base += v * min(max(F.wg - w, 0), 1); }
      __hip_atomic_fetch_add(cnt + e, tot, __ATOMIC_RELAXED, __HIP_MEMORY_SCOPE_WORKGROUP); __hip_atomic_fetch_add(mybase + e, base, __ATOMIC_RELAXED, __HIP_MEMORY_SCOPE_WORKGROUP); }
    __syncthreads();
    if (F.tid == 0) { int acc = 0, p = 0; for (int e = 0; e < NEXP; ++e) { pstart[e] = acc; const int np = (cnt[e] + 255) >> 8; for (int q = 0; q < np; ++q) pe[p++] = e; acc += np * 256; } pe[319] = p; }
    __syncthreads();
}
__device__ __forceinline__ void moe_dispatch(const Frame& F) {
    moe_tables(F);
    LAS int* pstart = (LAS int*)(F.lds + LHIST_OFF + 256); LAS int* mybase = (LAS int*)(F.lds + LHIST_OFF + 384);
    LAS int* lpos = (LAS int*)(F.lds);
    LAS int* le = (LAS int*)(F.lds + 1024);
    const int* eid = (const int*)(F.ws + WS_EID); const float* ew = (const float*)(F.ws + WS_EW);
    int* pos = (int*)(F.ws + WS_POS); float* roww = (float*)(F.ws + WS_ROWW);
    const int rows_per_wg = T / F.G, row0 = F.wg * rows_per_wg;
    int my_e = 0; float my_w = 0.f;
    if (F.tid < 256) { my_e = eid[2 * row0 + F.tid]; my_w = ew[2 * row0 + F.tid]; le[F.tid] = my_e; }
    __syncthreads();
    if (F.tid < 256) {
        int rank = 0;
        for (int a = 0; a < F.tid; ++a) rank += (le[a] == my_e) ? 1 : 0;
        const int p = pstart[my_e] + mybase[my_e] + rank;
        lpos[F.tid] = p; pos[2 * row0 + F.tid] = p; roww[p] = my_w;
    }
    __syncthreads();
    const bf16* hb = (const bf16*)(F.ws + WS_HB); bf16* Xs = (bf16*)(F.ws + WS_XS);
    for (int a = F.wave; a < 2 * rows_per_wg; a += NWAVES) {
        const int t = row0 + (a >> 1), p = lpos[a];
        const u32x4* src = (const u32x4*)(hb + (size_t)t * D); u32x4* dst = (u32x4*)(Xs + (size_t)p * D);
        dst[F.lane] = src[F.lane]; dst[64 + F.lane] = src[64 + F.lane];
    }
    __syncthreads();
}

constexpr int NPHASE = 1 + 15 * DEPTH;
#ifndef PHM
#define PHM 0xFFFF
#endif
#define PHON(b) ((PHM >> (b)) & 1)
__global__ void __launch_bounds__(NWAVES * 64, 2) mega_fwd(Args args) {
    extern __shared__ __attribute__((aligned(16))) unsigned char lds_raw[];
    LAS unsigned char* lds = (LAS unsigned char*)lds_raw;
    const int wave = __builtin_amdgcn_readfirstlane((int)threadIdx.x >> 6);
    for (int u = threadIdx.x; u < (LDS_BYTES - RING_BYTES) / 4; u += NWAVES * 64) ((LAS unsigned*)(lds + RING_BYTES))[u] = 0u;
    __syncthreads();
    if (threadIdx.x == 0) { LAS unsigned long long* ap = (LAS unsigned long long*)(lds + LARG_OFF);
#pragma unroll
        for (int i = 0; i < 23; ++i) ap[i] = (unsigned long long)args.in[i];
        ap[23] = (unsigned long long)args.out; ap[24] = (unsigned long long)args.ws; }
    __syncthreads();
    const int lo = args.ph_lo, hi = args.ph_hi;
    if (hi - lo > 1) { const XcdBarrier b0 = xcd_barrier_post((unsigned*)(args.ws + WS_CTL) + CW_BAR, (volatile LAS unsigned*)(lds + MISC_OFF) + 8);
        if (threadIdx.x == 0) ((volatile LAS unsigned*)(lds + MISC_OFF))[10] = b0.x; }
    __syncthreads();
#define IN(k) (lo <= (k) && (k) < hi)
#define SEAM(k) do { if (IN((k) + 1)) { XcdBarrier bar; bar.bar = (unsigned*)(F.ws + WS_CTL) + CW_BAR; bar.st = (volatile LAS unsigned*)(F.lds + MISC_OFF) + 8; bar.x = __builtin_amdgcn_readfirstlane(bar.st[2]); xcd_barrier(bar, F.tid); } } while (0)

    if (PHON(15) && IN(0)) { const Frame F = fresh(lds, wave);
        wprep_mixer(F, 0);
        __syncthreads();
        ln_phase<0>(F, inp(F, I_LN_IN_G), inp(F, I_LN_IN_B), inp(F, I_W_IN), DIN, true, true);
        SEAM(0);
    }
#pragma unroll 1
    for (int l = 0; l < DEPTH; ++l) {
        const int pb = 1 + 15 * l;
        if (PHON(0) && IN(pb + 0)) { const Frame F = fresh(lds, wave);
            pg8::StaticOrder S; S.init(F.ws + WS_HB, F.ws + WS_WIN, T, 1536, D, F.G, F.wg);
            EpiG1a E{(bf16*)(F.ws + WS_PQKV)};
            pg8::gemm_phase<EpiG1a, pg8::StaticOrder>(F.lds, F.tid, D, S, E);
            SEAM(pb + 0);
        }
        if (PHON(1) && IN(pb + 1)) { const Frame F = fresh(lds, wave); dn_prep(F, l); SEAM(pb + 1); }
        if (PHON(2) && IN(pb + 2)) { const Frame F = fresh(lds, wave); dn_scan(F); SEAM(pb + 2); }
        if (PHON(3) && IN(pb + 3)) { const Frame F = fresh(lds, wave);
            pg8::StaticOrder S; S.init(F.ws + WS_HB, F.ws + WS_WIN + (size_t)1536 * D * 2, T, 2560, D, F.G, F.wg);
            EpiG1b E{F.ws};
            pg8::gemm_phase<EpiG1b, pg8::StaticOrder>(F.lds, F.tid, D, S, E);
            SEAM(pb + 3);
        }
        if (PHON(4) && IN(pb + 4)) { const Frame F = fresh(lds, wave); pool_phase(F); ml_prep(F, l); SEAM(pb + 4); }
        if (PHON(5) && IN(pb + 5)) { const Frame F = fresh(lds, wave); ml_scan(F); SEAM(pb + 5); }
        if (PHON(6) && IN(pb + 6)) { const Frame F = fresh(lds, wave); norm_phase(F, l); SEAM(pb + 6); }
        if (PHON(7) && IN(pb + 7)) { const Frame F = fresh(lds, wave);
            pg8::StaticOrder S; S.init(F.ws + WS_HB, F.ws + WS_WGATE, T, 3072, D, F.G, F.wg);
            EpiGate E{(bf16*)(F.ws + WS_GATE)};
            pg8::gemm_phase<EpiGate, pg8::StaticOrder>(F.lds, F.tid, D, S, E);
            SEAM(pb + 7);
        }
        if (PHON(8) && IN(pb + 8)) { const Frame F = fresh(lds, wave);
            MergeOrder S; S.Y[0] = (const char*)(F.ws + WS_PZ); S.Y[1] = (const char*)(F.ws + WS_YP); S.Y[2] = (const char*)(F.ws + WS_PMO); S.W = (const char*)(F.ws + WS_WBR); S.G = F.G; S.c = F.wg;
            EpiMerge E{(const bf16*)(F.ws + WS_GATE), (bf16*)(F.ws + WS_MRGP), (bf16*)(F.ws + WS_HB)};
            pg8::gemm_phase<EpiMerge, MergeOrder>(F.lds, F.tid, MIXW, S, E);
            SEAM(pb + 8);
        }
        if (PHON(9) && IN(pb + 9)) { const Frame F = fresh(lds, wave);
            pg8::StaticOrder S; S.init(F.ws + WS_HB, F.ws + WS_WOUT, T, D, D, F.G, F.wg);
            EpiOut E{F.out};
            pg8::gemm_phase<EpiOut, pg8::StaticOrder>(F.lds, F.tid, D, S, E);
            SEAM(pb + 9);
        }
        if (PHON(10) && IN(pb + 10)) { const Frame F = fresh(lds, wave);
            wprep_moe(F, l);
            __syncthreads();
            ln_phase<1>(F, inp(F, I_LN_MIX_G) + l * D, inp(F, I_LN_MIX_B) + l * D, inp(F, I_ROUTER_W), 32, true, true);
            SEAM(pb + 10);
        }
        if (PHON(11) && IN(pb + 11)) { const Frame F = fresh(lds, wave); moe_dispatch(F); SEAM(pb + 11); }
        if (PHON(12) && IN(pb + 12)) { const Frame F = fresh(lds, wave);
            moe_tables(F);
            MoeOrder<D> S; S.A = (const char*)(F.ws + WS_XS); S.W = (const char*)(F.ws + WS_W13); S.pe = (const LAS int*)(F.lds + LPE_OFF); S.c = F.wg; S.NP = __builtin_amdgcn_readfirstlane(S.pe[319]);
            EpiMoe1 E{(bf16*)(F.ws + WS_ACT)};
            pg8::gemm_phase<EpiMoe1, MoeOrder<D>>(F.lds, F.tid, D, S, E);
            SEAM(pb + 12);
        }
        if (PHON(13) && IN(pb + 13)) { const Frame F = fresh(lds, wave);
            moe_tables(F);
            MoeOrder<DEXP> S; S.A = (const char*)(F.ws + WS_ACT); S.W = (const char*)(F.ws + WS_W2); S.pe = (const LAS int*)(F.lds + LPE_OFF); S.c = F.wg; S.NP = __builtin_amdgcn_readfirstlane(S.pe[319]);
            EpiMoe2 E{(bf16*)(F.ws + WS_YROWS), (const float*)(F.ws + WS_ROWW)};
            pg8::gemm_phase<EpiMoe2, MoeOrder<DEXP>>(F.lds, F.tid, DEXP, S, E);
            SEAM(pb + 13);
        }
        if (PHON(14) && IN(pb + 14)) { const Frame F = fresh(lds, wave);
            const bool last = (l == DEPTH - 1);
            if (!last) { wprep_mixer(F, l + 1); __syncthreads(); }
            ln_phase<2>(F, inp(F, I_LN_FFN_G) + l * D, inp(F, I_LN_FFN_B) + l * D, inp(F, I_W_IN) + (size_t)(last ? l : l + 1) * D * DIN, DIN, !last, !last);
            SEAM(pb + 14);
        }
    }
#undef IN
#undef SEAM
}

#ifndef N_LAUNCH_MODE
#define N_LAUNCH_MODE 1
#endif
extern "C" void kernel_launch(void* const* d_in, const int* in_sizes, int n_in, void* d_out, int out_size, void* d_ws, size_t ws_size, hipStream_t stream) {
    static int grid = 0;
    if (grid == 0) {
        if (n_in != 23 || out_size != T * D || ws_size < WS_END) { fprintf(stderr, "kernel_launch: unexpected shapes (n_in %d out %d ws %zu)\n", n_in, out_size, ws_size); grid = -1; return; }
        int dev = 0, cus = 0, per_cu = 0;
        if (hipGetDevice(&dev) != hipSuccess || hipDeviceGetAttribute(&cus, hipDeviceAttributeMultiprocessorCount, dev) != hipSuccess) { grid = -1; return; }
        if (hipFuncSetAttribute((const void*)mega_fwd, hipFuncAttributeMaxDynamicSharedMemorySize, LDS_BYTES) != hipSuccess) { fprintf(stderr, "kernel_launch: hipFuncSetAttribute failed\n"); grid = -1; return; }
        (void)hipOccupancyMaxActiveBlocksPerMultiprocessor(&per_cu, (const void*)mega_fwd, NWAVES * 64, LDS_BYTES);
        (void)hipGetLastError();
        grid = cus;
        if (grid != 256) { fprintf(stderr, "kernel_launch: built for 256 CUs, got %d\n", cus); grid = -1; return; }
    }
    if (grid < 0) return;
    (void)hipMemsetAsync((char*)d_ws + WS_CTL, 0, CTL_ZERO_BYTES, stream);
    Args a{};
    for (int i = 0; i < 23; ++i) a.in[i] = (const float*)d_in[i];
    a.out = (float*)d_out; a.ws = (unsigned char*)d_ws;
#ifdef DIAG
    {
        const int his[12] = {0, 2, 3, 6, 15, 10, 6, 9, 2, 2, 5, 9};
        const int grids[12] = {0, 64, 2, 2, 16, 64, 64, 64, 64, 64, 64, 64}, blocks[12] = {0, 256, 128, 128, 256, 256, 256, 256, 256, 256, 256, 256};
        a.ph_lo = 0; a.ph_hi = his[DIAG];
        hipLaunchKernelGGL(mega_fwd, dim3(grid), dim3(NWAVES * 64), LDS_BYTES, stream, a);
        static int once = 0; if (!once) { once = 1; (void)hipFuncSetAttribute((const void*)diag_kernel, hipFuncAttributeMaxDynamicSharedMemorySize, 81920); }
        DArgs da{}; for (int i = 0; i < 23; ++i) da.in[i] = (const float*)d_in[i]; da.out = (float*)d_out; da.ws = (unsigned char*)d_ws; da.mode = DIAG; da.pad = 0;
        hipLaunchKernelGGL(diag_kernel, dim3(grids[DIAG]), dim3(blocks[DIAG]), 81920, stream, da);
        if (DIAG == 2 || DIAG == 3) {
            a.ph_lo = his[DIAG]; a.ph_hi = his[DIAG] + 1;
            hipLaunchKernelGGL(mega_fwd, dim3(grid), dim3(NWAVES * 64), LDS_BYTES, stream, a);
            da.mode = DIAG + 10;
            hipLaunchKernelGGL(diag_kernel, dim3(2), dim3(128), 81920, stream, da);
        }
        hipLaunchKernelGGL(diag_fill, dim3(1024), dim3(256), 0, stream, (float*)d_out, (unsigned char*)d_ws, out_size);
    }
#elif N_LAUNCH_MODE == 1
    a.ph_lo = 0; a.ph_hi = NPHASE;
    hipLaunchKernelGGL(mega_fwd, dim3(grid), dim3(NWAVES * 64), LDS_BYTES, stream, a);
#else
    for (int p = 0; p < NPHASE; ++p) { a.ph_lo = p; a.ph_hi = p + 1; hipLaunchKernelGGL(mega_fwd, dim3(grid), dim3(NWAVES * 64), LDS_BYTES, stream, a); }
#endif
}
```

```cpp
#include <hip/hip_runtime.h>
#include <cstdio>
#include <cstdint>

#define LAS __attribute__((address_space(3)))
#define GAS __attribute__((address_space(1)))
typedef unsigned short bf16;
typedef short bf16x8 __attribute__((ext_vector_type(8)));
typedef float f32x4 __attribute__((ext_vector_type(4)));
typedef float f32x2 __attribute__((ext_vector_type(2)));
typedef unsigned u32x4 __attribute__((ext_vector_type(4)));
typedef unsigned u32x2 __attribute__((ext_vector_type(2)));
#define RLX_AGENT __ATOMIC_RELAXED, __HIP_MEMORY_SCOPE_AGENT
#define LDS_WAIT() asm volatile("s_waitcnt lgkmcnt(0)" ::: "memory")
#define VM_WAIT() asm volatile("s_waitcnt vmcnt(0)" ::: "memory")

constexpr int NB = 4, SEQ = 8192, T = NB * SEQ, D = 1024, DEPTH = 2;
constexpr int DIN = 7200;
constexpr int MIXW = 512, NHEAD = 4, HD = 128, CH = 64, NCH = SEQ / CH;
constexpr int MLQK = 64;
constexpr int NEXP = 32, DEXP = 512;
constexpr float LN_EPS = 1e-5f, NORM_EPS = 1e-6f;
constexpr float ALPHA = 1.41421356237309515f;
constexpr int NWAVES = 8;
constexpr int NREC = NB * NHEAD * NCH * 2;

constexpr int C_QKV = 0, C_Z = 1536, C_A = 2048, C_B = 2056, C_POOL = 2064, C_MQ = 2576, C_MK = 2832, C_MV = 3088, C_MO = 3600, C_I = 4112, C_F = 4120, C_GATE = 4128;

constexpr size_t MiB = 1u << 20;
constexpr size_t WS_CTL = 0, CTL_ZERO_BYTES = 64 * 1024;
constexpr int CW_BAR = 4096;
constexpr size_t WS_HIST = 1 * MiB;
constexpr size_t WS_EID = WS_HIST + 64 * 1024;
constexpr size_t WS_EW = WS_EID + 256 * 1024;
constexpr size_t WS_POS = WS_EW + 256 * 1024;
constexpr size_t WS_ROWW = WS_POS + 256 * 1024;
constexpr size_t WS_GL = WS_ROWW + 512 * 1024;
constexpr size_t WS_WIN = 4 * MiB;
constexpr size_t WS_WGATE = 12 * MiB;
constexpr size_t WS_WBR = 18 * MiB;
constexpr size_t WS_WOUT = 21 * MiB;
constexpr size_t WS_HB = 24 * MiB;
constexpr size_t WS_SG = 88 * MiB;
constexpr size_t WS_DEN = 92 * MiB;
constexpr size_t WS_R1 = 93 * MiB;
constexpr size_t WS_PQKV = WS_R1;
constexpr size_t WS_OF = WS_R1, WS_OB = WS_R1 + 32 * MiB;
constexpr size_t WS_MRGP = WS_R1;
constexpr size_t WS_W13 = WS_R1, WS_W2 = WS_R1 + 64 * MiB;
constexpr size_t WS_R2 = 189 * MiB;
constexpr size_t DNREC = 73728;
constexpr size_t DN_W = 0, DN_QG = 16384, DN_KDT = 32768, DN_ATT = 49152, DN_UF = 57344;
constexpr size_t WS_PZ = 189 * MiB, WS_PPOOL = 221 * MiB, WS_PMQ = 253 * MiB, WS_PMK = 269 * MiB, WS_PMV = 285 * MiB, WS_PMO = 317 * MiB;
constexpr size_t WS_YP = 349 * MiB;
constexpr size_t WS_NUMF = 253 * MiB, WS_NUMB = 285 * MiB;
constexpr size_t WS_ML = 381 * MiB;
constexpr size_t MLREC = 44032;
constexpr size_t ML_Q = 0, ML_ST = 8192, ML_KWT = 16384, ML_VF = 24576, ML_ROW = 43008;
constexpr size_t WS_GATE = 381 * MiB;
constexpr size_t WS_XS = 189 * MiB, WS_ACT = 333 * MiB, WS_YROWS = 405 * MiB;
constexpr size_t WS_END = 573 * MiB;
constexpr int MOE_ROWS = 73728;
static_assert(WS_ML + (size_t)NREC * MLREC <= WS_END + 15 * MiB, "ml records");
static_assert(WS_YROWS + (size_t)MOE_ROWS * 1024 * 2 <= WS_END, "moe rows");

constexpr int RING_BYTES = 131072;
constexpr int MISC_OFF = RING_BYTES + 320;
constexpr int LHIST_OFF = RING_BYTES + 1024;
constexpr int LPE_OFF = RING_BYTES + 2048;
constexpr int LARG_OFF = RING_BYTES + 4096;
constexpr int LDS_BYTES = 147456;

__device__ __forceinline__ float bf2f(unsigned b) { return __uint_as_float(b << 16); }
__device__ __forceinline__ unsigned f2bf(float f) { unsigned u = __float_as_uint(f); return (u + 0x7fffu + ((u >> 16) & 1u)) >> 16; }
__device__ __forceinline__ unsigned pk2(float lo, float hi) { return f2bf(lo) | (f2bf(hi) << 16); }
__device__ __forceinline__ float wave_sum(float v) {
#pragma unroll
    for (int o = 1; o < 64; o <<= 1) v += __shfl_xor(v, o);
    return v;
}
__device__ __forceinline__ float wave_max(float v) {
#pragma unroll
    for (int o = 1; o < 64; o <<= 1) v = fmaxf(v, __shfl_xor(v, o));
    return v;
}
__device__ __forceinline__ float fexp(float x) { return __builtin_amdgcn_exp2f(x * 1.44269504089f); }
__device__ __forceinline__ float sigmoidf_(float x) { return 1.0f / (1.0f + expf(-x)); }
__device__ __forceinline__ float siluf_(float x) { return x / (1.0f + expf(-x)); }
__device__ __forceinline__ float softplusf_(float x) { return fmaxf(x, 0.f) + log1pf(expf(-fabsf(x))); }
__device__ __forceinline__ float logsigmoidf_(float x) { return fminf(x, 0.f) - log1pf(expf(-fabsf(x))); }
__host__ __device__ __forceinline__ int sigma32(int p) { const int fq = p >> 3, j = p & 7; return 16 * (j >> 2) + 4 * fq + (j & 3); }

#define XB_TMO      128
#define XB_XCNT(j)  (256  + 64 * (j))
#define XB_XSUB(j)  (1280 + 64 * (j))
#define XB_XGEN(j)  (2304 + 64 * (j))
#define XB_TOP      3328
#define XB_TOPGEN   3392
#define XCD_BAR_WORDS 3456
#define XB_SPIN_CAP (1u << 20)
__device__ __forceinline__ unsigned xb_ld(unsigned* p)              { return __hip_atomic_load(p, __ATOMIC_RELAXED, __HIP_MEMORY_SCOPE_AGENT); }
__device__ __forceinline__ unsigned xb_add(unsigned* p, unsigned v) { return __hip_atomic_fetch_add(p, v, __ATOMIC_RELAXED, __HIP_MEMORY_SCOPE_AGENT); }
__device__ __forceinline__ unsigned xb_xcc_id() { return (unsigned)__builtin_amdgcn_s_getreg((3 << 11) | 20) & 0xFu; }
#define XB_SPIN(cond, bar) do { unsigned _sp = 0; while (cond) { __builtin_amdgcn_s_sleep(1); \
    if ((++_sp & 255u) == 0u) { if (xb_ld(&(bar)[XB_TMO])) break; if (_sp > XB_SPIN_CAP) { atomicAdd(&(bar)[XB_TMO], 1u); break; } } } } while (0)
struct XcdBarrier { unsigned* bar; unsigned x; volatile LAS unsigned* st; };
__device__ __forceinline__ XcdBarrier xcd_barrier_post(unsigned* bar, volatile LAS unsigned* st) {
    XcdBarrier b; b.bar = bar; b.x = xb_xcc_id(); b.st = st;
    if (threadIdx.x == 0) (void)xb_add(&bar[XB_XCNT(b.x)], 1u);
    return b;
}
__device__ __forceinline__ void xcd_barrier_complete(unsigned* bar, unsigned x, unsigned& nloc, unsigned& nx) {
    const unsigned G = gridDim.x * gridDim.y * gridDim.z;
    unsigned sum, cnt, mine, sp = 0u;
    for (;;) {
        sum = 0u; cnt = 0u; mine = 0u;
#pragma unroll
        for (unsigned j = 0; j < 16; ++j) { const unsigned c = xb_ld(&bar[XB_XCNT(j)]); sum += c; cnt += (c > 0u) ? 1u : 0u; mine = (j == x) ? c : mine; }
        if (sum == G) break;
        __builtin_amdgcn_s_sleep(1);
        if ((++sp & 255u) == 0u) { if (xb_ld(&bar[XB_TMO])) break; if (sp > XB_SPIN_CAP) { atomicAdd(&bar[XB_TMO], 1u); break; } }
    }
    nloc = mine > 0u ? mine : 1u; nx = cnt > 0u ? cnt : 1u;
}
__device__ __forceinline__ void xcd_barrier(const XcdBarrier& b, const int tid) {
    asm volatile("s_waitcnt vmcnt(0)" ::: "memory");
    __syncthreads();
    if (tid == 0) {
        unsigned* bar = b.bar;
        __builtin_amdgcn_s_waitcnt(0);
        unsigned nloc = b.st[0], nx = b.st[1];
        if (nloc == 0u) { xcd_barrier_complete(bar, b.x, nloc, nx); b.st[0] = nloc; b.st[1] = nx; }
        const unsigned old = xb_add(&bar[XB_XSUB(b.x)], 1u);
        const unsigned gen = old / nloc;
        if (old + 1u == (gen + 1u) * nloc) {
            __builtin_amdgcn_fence(__ATOMIC_RELEASE, "agent");
            asm volatile("s_waitcnt vmcnt(0)" ::: "memory");
            const unsigned og = xb_add(&bar[XB_TOP], 1u);
            const unsigned tg = og / nx;
            if (og + 1u == (tg + 1u) * nx) xb_add(&bar[XB_TOPGEN], 1u);
            else XB_SPIN(xb_ld(&bar[XB_TOPGEN]) == tg, bar);
            __builtin_amdgcn_fence(__ATOMIC_ACQUIRE, "agent");
            xb_add(&bar[XB_XGEN(b.x)], 1u);
            asm volatile("s_waitcnt vmcnt(0)" ::: "memory");
        } else {
            XB_SPIN(xb_ld(&bar[XB_XGEN(b.x)]) == gen, bar);
            __builtin_amdgcn_fence(__ATOMIC_ACQUIRE, "agent");
            asm volatile("s_waitcnt vmcnt(0)" ::: "memory");
        }
    }
    __syncthreads();
}

namespace pg8 {
constexpr int BM = 256, BK = 64, HALF = 128, HTB = HALF * BK * 2, STAGE_BYTES = 8 * HTB, NXCD = 8, WGM = 8;
__host__ __device__ __forceinline__ int lds_byte(int r, int c) { const int st = (r >> 4) * 2 + (c >> 5), rr = r & 15, cc = c & 31, ob = rr * 64 + cc * 2; return st * 1024 + (ob ^ (((ob >> 9) & 1) << 5)); }
__host__ __device__ __forceinline__ void stage_rc(int b, int& R, int& C) { const int st = b / 1024, sb = b % 1024, swz = sb ^ (((sb >> 9) & 1) << 5); R = (st >> 1) * 16 + swz / 64; C = (st & 1) * 32 + (swz % 64) / 2; }
__host__ __device__ __forceinline__ int perm32(int rho) { const int n = rho >> 4, i = rho & 15; return 8 * (i >> 2) + 4 * n + (i & 3); }

struct Unit { int pm, pn, aux; const char* A; const char* B; };

__device__ __forceinline__ void tile_of(int L, int nM, int nN, int& pm, int& pn) {
    const int nwg = nM * nN; int wgid = L;
    { const int q = nwg / NXCD, r = nwg % NXCD, xcd = wgid % NXCD, off = wgid / NXCD; wgid = (xcd < r ? xcd * (q + 1) : r * (q + 1) + (xcd - r) * q) + off; }
    const int nig = WGM * nN, gid = wgid / nig, fm = gid * WGM, gsz = (nM - fm) < WGM ? (nM - fm) : WGM;
    pm = fm + ((wgid % nig) % gsz); pn = (wgid % nig) / gsz;
}
struct StaticOrder {
    const char* A; const char* Bt; int nM, nN, nwg, G, c; size_t tstep;
    __device__ __forceinline__ void init(const void* A_, const void* Bt_, int M, int N, int K, int G_, int c_) { A = (const char*)A_; Bt = (const char*)Bt_; nM = M / BM; nN = N / BM; nwg = nM * nN; G = G_; c = c_; tstep = (size_t)BM * K * 2; }
    __device__ __forceinline__ bool next(int i, Unit& u) const {
        const long L = (long)i * G + c; if (L >= nwg) return false;
        tile_of((int)L, nM, nN, u.pm, u.pn); u.aux = 0; u.A = A + (size_t)u.pm * tstep; u.B = Bt + (size_t)u.pn * tstep; return true;
    }
};

typedef float f32x2_t __attribute__((ext_vector_type(2))); typedef __bf16 bf16x2_t __attribute__((ext_vector_type(2)));
__device__ __forceinline__ unsigned cvt_pk_bf16(float lo, float hi) { f32x2_t v = {lo, hi}; bf16x2_t b = __builtin_convertvector(v, bf16x2_t); return __builtin_bit_cast(unsigned, b); }

template <class Epi, class Sched, bool ALIGN_EPI = true, bool SP2 = true>
__device__ __forceinline__ void gemm_phase(LAS unsigned char* lds, const int tid, const int K, const Sched& S, const Epi& E) {
    const int wid = __builtin_amdgcn_readfirstlane(tid >> 6), lane = tid & 63, wr = wid >> 2, wc = wid & 3, fr = lane & 15, fq = lane >> 4;
    const int nt = K / BK;
    unsigned voffA, voffB;
    { int R, C; stage_rc(tid * 16, R, C); const int Rb = Epi::PERM ? ((R & ~31) + perm32(R & 31)) : R;
        voffA = (unsigned)(R * K + C) * 2u; voffB = (unsigned)(Rb * K + C) * 2u; }
    const size_t pstep = (size_t)64 * K * 2;
    const size_t kstep = (size_t)(BK * 2);
    const size_t hstep = (size_t)HALF * K * 2;
    const unsigned ldsw = (unsigned)wid * 1024u;
    const int aoff = lds_byte(wr * 64 + fr, fq * 8), boff = lds_byte(wc * 32 + fr, fq * 8);
#define PG8_SA(b, h) (((b) * 2 + (h)) * HTB)
#define PG8_SB(b, h) ((4 + (b) * 2 + (h)) * HTB)
#define PG8_STAGE(bufoff, gbase, voff) do { _Pragma("unroll") for (int _i = 0; _i < 2; ++_i) \
        __builtin_amdgcn_global_load_lds((const unsigned*)((const char*)(gbase) + _i * pstep + (voff)), (LAS unsigned*)(lds + (bufoff) + ldsw + _i * 8192), 16, 0, 0); } while (0)
#define PG8_LDA(dst, b, h) do { _Pragma("unroll") for (int m = 0; m < 4; ++m) _Pragma("unroll") for (int k = 0; k < 2; ++k) dst[m][k] = *(const LAS bf16x8*)(lds + PG8_SA(b, h) + aoff + m * 2048 + k * 1024); } while (0)
#define PG8_LDB(dst, b, h) do { _Pragma("unroll") for (int n = 0; n < 2; ++n) _Pragma("unroll") for (int k = 0; k < 2; ++k) dst[n][k] = *(const LAS bf16x8*)(lds + PG8_SB(b, h) + boff + n * 2048 + k * 1024); } while (0)
#define PG8_MMA(ai, bj, At, Bt) do { __builtin_amdgcn_s_setprio(1); _Pragma("unroll") for (int m = 0; m < 4; ++m) _Pragma("unroll") for (int n = 0; n < 2; ++n) _Pragma("unroll") for (int k = 0; k < 2; ++k) \
        acc[ai][bj][m][n] = __builtin_amdgcn_mfma_f32_16x16x32_bf16(Bt[n][k], At[m][k], acc[ai][bj][m][n], 0, 0, 0); __builtin_amdgcn_s_setprio(0); } while (0)
#define PG8_WAIT_V(n) asm volatile("s_waitcnt vmcnt(" #n ")" ::: "memory")
#define PG8_WAIT_L(n) asm volatile("s_waitcnt lgkmcnt(" #n ")" ::: "memory")
#define PG8_BAR __builtin_amdgcn_s_barrier()
#define PG8_SCHED __builtin_amdgcn_sched_barrier(0)
    Unit cur, nxt; int ui = 0;
    if (!S.next(0, cur)) return;
    f32x4 acc[2][2][4][2];
#pragma unroll
    for (int a = 0; a < 2; ++a)
#pragma unroll
        for (int b = 0; b < 2; ++b)
#pragma unroll
            for (int m = 0; m < 4; ++m)
#pragma unroll
                for (int n = 0; n < 2; ++n) acc[a][b][m][n] = (f32x4){0.f, 0.f, 0.f, 0.f};
    bf16x8 At[4][2], B0[2][2], B1[2][2];
    const char* cA = cur.A; const char* cB = cur.B;
    if constexpr (SP2) {
        PG8_STAGE(PG8_SB(0, 0), cB, voffB); PG8_STAGE(PG8_SB(0, 1), cB + hstep, voffB); PG8_STAGE(PG8_SA(0, 0), cA, voffA); PG8_STAGE(PG8_SA(0, 1), cA + hstep, voffA);
        if (wr == 1) PG8_BAR;
        PG8_WAIT_V(2); PG8_BAR;
        PG8_STAGE(PG8_SB(1, 0), cB + kstep, voffB); PG8_STAGE(PG8_SA(1, 0), cA + kstep, voffA); PG8_STAGE(PG8_SB(1, 1), cB + hstep + kstep, voffB);
        PG8_WAIT_V(6); PG8_BAR;
    } else {
        PG8_STAGE(PG8_SB(0, 0), cB, voffB); PG8_STAGE(PG8_SA(0, 0), cA, voffA); PG8_STAGE(PG8_SB(0, 1), cB + hstep, voffB); PG8_STAGE(PG8_SA(0, 1), cA + hstep, voffA);
        if (wr == 1) PG8_BAR;
        PG8_WAIT_V(4); PG8_BAR;
        PG8_STAGE(PG8_SB(1, 0), cB + kstep, voffB); PG8_STAGE(PG8_SA(1, 0), cA + kstep, voffA); PG8_STAGE(PG8_SB(1, 1), cB + hstep + kstep, voffB);
        PG8_WAIT_V(6); PG8_BAR;
    }
    for (;;) {
        const bool has_next = S.next(ui + 1, nxt);
        const char* nA = has_next ? nxt.A : cA; const char* nB = has_next ? nxt.B : cB;
        for (int t = 0; t < nt; t += 2) {
            const bool last = (t == nt - 2);
            const char* a1 = cA + (size_t)(t + 1) * kstep;
            const char* a2 = last ? nA : cA + (size_t)(t + 2) * kstep; const char* b2 = last ? nB : cB + (size_t)(t + 2) * kstep;
            const char* a3 = a2 + kstep; const char* b3 = b2 + kstep;
            if constexpr (SP2) {
            PG8_LDB(B0, 0, 0); PG8_LDB(B1, 0, 1); PG8_SCHED; PG8_LDA(At, 0, 0); PG8_STAGE(PG8_SA(1, 1), a1 + hstep, voffA);
            PG8_WAIT_V(8); PG8_WAIT_L(0); PG8_BAR; PG8_MMA(0, 0, At, B0); PG8_MMA(0, 1, At, B1); PG8_BAR; PG8_SCHED;
            PG8_LDA(At, 0, 1); PG8_STAGE(PG8_SB(0, 0), b2, voffB); PG8_STAGE(PG8_SB(0, 1), b2 + hstep, voffB); PG8_STAGE(PG8_SA(0, 0), a2, voffA);
            PG8_WAIT_V(8); PG8_WAIT_L(0); PG8_BAR; PG8_MMA(1, 0, At, B0); PG8_MMA(1, 1, At, B1); PG8_BAR; PG8_SCHED;
            PG8_LDB(B0, 1, 0); PG8_LDB(B1, 1, 1); PG8_SCHED; PG8_LDA(At, 1, 0); PG8_STAGE(PG8_SA(0, 1), a2 + hstep, voffA);
            PG8_WAIT_V(8); PG8_WAIT_L(0); PG8_BAR; PG8_MMA(0, 0, At, B0); PG8_MMA(0, 1, At, B1); PG8_BAR; PG8_SCHED;
            PG8_LDA(At, 1, 1); PG8_STAGE(PG8_SB(1, 0), b3, voffB); PG8_STAGE(PG8_SB(1, 1), b3 + hstep, voffB); PG8_STAGE(PG8_SA(1, 0), a3, voffA);
            PG8_WAIT_V(8); PG8_WAIT_L(0); PG8_BAR; PG8_MMA(1, 0, At, B0); PG8_MMA(1, 1, At, B1); PG8_BAR; PG8_SCHED;
            } else {
            PG8_LDB(B0, 0, 0); PG8_SCHED; PG8_LDA(At, 0, 0); PG8_STAGE(PG8_SA(1, 1), a1 + hstep, voffA);
            PG8_WAIT_L(8); PG8_BAR; PG8_WAIT_L(0); PG8_MMA(0, 0, At, B0); PG8_BAR; PG8_SCHED;
            PG8_LDB(B1, 0, 1); PG8_STAGE(PG8_SB(0, 0), b2, voffB);
            PG8_BAR; PG8_WAIT_L(0); PG8_MMA(0, 1, At, B1); PG8_BAR;
            PG8_LDA(At, 0, 1); PG8_STAGE(PG8_SA(0, 0), a2, voffA);
            PG8_BAR; PG8_WAIT_L(0); PG8_MMA(1, 0, At, B0); PG8_BAR; PG8_SCHED;
            PG8_STAGE(PG8_SB(0, 1), b2 + hstep, voffB);
            PG8_WAIT_V(6); PG8_BAR; PG8_MMA(1, 1, At, B1); PG8_BAR;
            PG8_LDB(B0, 1, 0); PG8_SCHED; PG8_LDA(At, 1, 0); PG8_STAGE(PG8_SA(0, 1), a2 + hstep, voffA);
            PG8_WAIT_L(8); PG8_BAR; PG8_WAIT_L(0); PG8_MMA(0, 0, At, B0); PG8_BAR; PG8_SCHED;
            PG8_LDB(B1, 1, 1); PG8_STAGE(PG8_SB(1, 0), b3, voffB);
            PG8_BAR; PG8_WAIT_L(0); PG8_MMA(0, 1, At, B1); PG8_BAR;
            PG8_LDA(At, 1, 1); PG8_STAGE(PG8_SA(1, 0), a3, voffA);
            PG8_BAR; PG8_WAIT_L(0); PG8_MMA(1, 0, At, B0); PG8_BAR; PG8_SCHED;
            PG8_STAGE(PG8_SB(1, 1), b3 + hstep, voffB);
            PG8_WAIT_V(6); PG8_BAR; PG8_MMA(1, 1, At, B1); PG8_BAR;
            }
        }
        if constexpr (ALIGN_EPI) { if (wr == 0) PG8_BAR; }
        E(acc, cur, wr, wc, fr, fq);
        if (!has_next) break;
#pragma unroll
        for (int a = 0; a < 2; ++a)
#pragma unroll
            for (int b = 0; b < 2; ++b)
#pragma unroll
                for (int m = 0; m < 4; ++m)
#pragma unroll
                    for (int n = 0; n < 2; ++n) acc[a][b][m][n] = (f32x4){0.f, 0.f, 0.f, 0.f};
        cur = nxt; cA = nA; cB = nB; ++ui;
        if constexpr (ALIGN_EPI) { if (wr == 1) PG8_BAR; }
    }
    PG8_WAIT_V(0);
    if constexpr (!ALIGN_EPI) { if (wr == 0) PG8_BAR; }
    PG8_BAR;
#undef PG8_SA
#undef PG8_SB
#undef PG8_STAGE
#undef PG8_LDA
#undef PG8_LDB
#undef PG8_MMA
#undef PG8_WAIT_V
#undef PG8_WAIT_L
#undef PG8_BAR
#undef PG8_SCHED
}
}

using pg8::Unit; using pg8::cvt_pk_bf16; using pg8::HALF; using pg8::BM;

struct EpiG1a {
    static constexpr bool PERM = true;
    bf16* O;
    __device__ __forceinline__ void operator()(const f32x4 (&acc)[2][2][4][2], const Unit& u, int wr, int wc, int fr, int fq) const {
        const int row0 = u.pm * BM + wr * 64 + fr, col0 = u.pn * BM + wc * 32 + 8 * fq;
#pragma unroll
        for (int ai = 0; ai < 2; ++ai)
#pragma unroll
            for (int m = 0; m < 4; ++m) { bf16* rowp = O + (size_t)(row0 + ai * HALF + m * 16) * 1536 + col0;
#pragma unroll
                for (int bj = 0; bj < 2; ++bj) { const f32x4 v0 = acc[ai][bj][m][0], v1 = acc[ai][bj][m][1];
                    u32x4 w; w.x = cvt_pk_bf16(v0[0], v0[1]); w.y = cvt_pk_bf16(v0[2], v0[3]); w.z = cvt_pk_bf16(v1[0], v1[1]); w.w = cvt_pk_bf16(v1[2], v1[3]);
                    *(u32x4*)(rowp + bj * HALF) = w; } }
    }
};
struct EpiG1b {
    static constexpr bool PERM = true;
    unsigned char* ws;
    __device__ __forceinline__ void operator()(const f32x4 (&acc)[2][2][4][2], const Unit& u, int wr, int wc, int fr, int fq) const {
        const int pn = u.pn; size_t off; int ld, ct;
        if (pn < 2) { off = WS_PZ; ld = 512; ct = pn; } else if (pn < 4) { off = WS_PPOOL; ld = 512; ct = pn - 2; } else if (pn == 4) { off = WS_PMQ; ld = 256; ct = 0; }
        else if (pn == 5) { off = WS_PMK; ld = 256; ct = 0; } else if (pn < 8) { off = WS_PMV; ld = 512; ct = pn - 6; } else { off = WS_PMO; ld = 512; ct = pn - 8; }
        bf16* O = (bf16*)(ws + off);
        const int row0 = u.pm * BM + wr * 64 + fr, col0 = ct * BM + wc * 32 + 8 * fq;
#pragma unroll
        for (int ai = 0; ai < 2; ++ai)
#pragma unroll
            for (int m = 0; m < 4; ++m) { bf16* rowp = O + (size_t)(row0 + ai * HALF + m * 16) * ld + col0;
#pragma unroll
                for (int bj = 0; bj < 2; ++bj) { const f32x4 v0 = acc[ai][bj][m][0], v1 = acc[ai][bj][m][1];
                    u32x4 w; w.x = cvt_pk_bf16(v0[0], v0[1]); w.y = cvt_pk_bf16(v0[2], v0[3]); w.z = cvt_pk_bf16(v1[0], v1[1]); w.w = cvt_pk_bf16(v1[2], v1[3]);
                    *(u32x4*)(rowp + bj * HALF) = w; } }
    }
};
__device__ __forceinline__ float fast_sigmoid(float x) { return __builtin_amdgcn_rcpf(1.0f + __builtin_amdgcn_exp2f(-1.44269504089f * x)); }
struct EpiGate {
    static constexpr bool PERM = true;
    bf16* O;
    __device__ __forceinline__ void operator()(const f32x4 (&acc)[2][2][4][2], const Unit& u, int wr, int wc, int fr, int fq) const {
        const int row0 = u.pm * BM + wr * 64 + fr, col0 = u.pn * BM + wc * 32 + 8 * fq;
#pragma unroll
        for (int ai = 0; ai < 2; ++ai)
#pragma unroll
            for (int m = 0; m < 4; ++m) { bf16* rowp = O + (size_t)(row0 + ai * HALF + m * 16) * 3072 + col0;
#pragma unroll
                for (int bj = 0; bj < 2; ++bj) { f32x4 v0 = acc[ai][bj][m][0], v1 = acc[ai][bj][m][1];
#pragma unroll
                    for (int j = 0; j < 4; ++j) { v0[j] = fast_sigmoid(v0[j]); v1[j] = fast_sigmoid(v1[j]); }
                    u32x4 w; w.x = cvt_pk_bf16(v0[0], v0[1]); w.y = cvt_pk_bf16(v0[2], v0[3]); w.z = cvt_pk_bf16(v1[0], v1[1]); w.w = cvt_pk_bf16(v1[2], v1[3]);
                    *(u32x4*)(rowp + bj * HALF) = w; } }
    }
};
__device__ __forceinline__ void unpack8(const u32x4 w, float (&f)[8]) {
    f[0] = __uint_as_float(w.x << 16); f[1] = __uint_as_float(w.x & 0xffff0000u); f[2] = __uint_as_float(w.y << 16); f[3] = __uint_as_float(w.y & 0xffff0000u);
    f[4] = __uint_as_float(w.z << 16); f[5] = __uint_as_float(w.z & 0xffff0000u); f[6] = __uint_as_float(w.w << 16); f[7] = __uint_as_float(w.w & 0xffff0000u);
}
struct EpiMerge {
    static constexpr bool PERM = true;
    const bf16* GATE; bf16* PART; bf16* FIN;
    __device__ __forceinline__ void operator()(const f32x4 (&acc)[2][2][4][2], const Unit& u, int wr, int wc, int fr, int fq) const {
        const int r = u.aux;
        const int row0 = u.pm * BM + wr * 64 + fr, col0 = u.pn * BM + wc * 32 + 8 * fq;
#pragma unroll
        for (int ai = 0; ai < 2; ++ai)
#pragma unroll
            for (int m = 0; m < 4; ++m) { const size_t row = (size_t)(row0 + ai * HALF + m * 16);
#pragma unroll
                for (int bj = 0; bj < 2; ++bj) { const f32x4 v0 = acc[ai][bj][m][0], v1 = acc[ai][bj][m][1];
                    const int c = col0 + bj * HALF;
                    const u32x4 gw = *(const u32x4*)(GATE + row * 3072 + r * 1024 + c);
                    float g[8]; unpack8(gw, g);
                    float o[8];
                    o[0] = v0[0] * g[0]; o[1] = v0[1] * g[1]; o[2] = v0[2] * g[2]; o[3] = v0[3] * g[3];
                    o[4] = v1[0] * g[4]; o[5] = v1[1] * g[5]; o[6] = v1[2] * g[6]; o[7] = v1[3] * g[7];
                    if (r > 0) { const u32x4 pw = *(const u32x4*)(PART + row * 1024 + c); float p[8]; unpack8(pw, p);
#pragma unroll
                        for (int j = 0; j < 8; ++j) o[j] += p[j]; }
                    u32x4 w; w.x = cvt_pk_bf16(o[0], o[1]); w.y = cvt_pk_bf16(o[2], o[3]); w.z = cvt_pk_bf16(o[4], o[5]); w.w = cvt_pk_bf16(o[6], o[7]);
                    bf16* dst = (r == 2) ? FIN : PART;
                    *(u32x4*)(dst + row * 1024 + c) = w; } }
    }
};
struct EpiOut {
    static constexpr bool PERM = false;
    float* C;
    __device__ __forceinline__ void operator()(const f32x4 (&acc)[2][2][4][2], const Unit& u, int wr, int wc, int fr, int fq) const {
        const int row0 = u.pm * BM + wr * 64 + fr, col0 = u.pn * BM + wc * 32 + 4 * fq;
#pragma unroll
        for (int ai = 0; ai < 2; ++ai)
#pragma unroll
            for (int m = 0; m < 4; ++m) { float* rowp = C + (size_t)(row0 + ai * HALF + m * 16) * D + col0;
#pragma unroll
                for (int bj = 0; bj < 2; ++bj)
#pragma unroll
                    for (int n = 0; n < 2; ++n) { f32x4* p = (f32x4*)(rowp + bj * HALF + n * 16); const f32x4 old = *p; *p = old * ALPHA + acc[ai][bj][m][n]; } }
    }
};
struct EpiMoe1 {
    static constexpr bool PERM = true;
    bf16* ACT;
    __device__ __forceinline__ void operator()(const f32x4 (&acc)[2][2][4][2], const Unit& u, int wr, int wc, int fr, int fq) const {
        const int row0 = u.pm * BM + wr * 64 + fr, col0 = u.pn * 128 + wc * 32 + 8 * fq;
#pragma unroll
        for (int ai = 0; ai < 2; ++ai)
#pragma unroll
            for (int m = 0; m < 4; ++m) { bf16* rowp = ACT + (size_t)(row0 + ai * HALF + m * 16) * DEXP + col0;
                float o[8];
#pragma unroll
                for (int n = 0; n < 2; ++n)
#pragma unroll
                    for (int j = 0; j < 4; ++j) { const float a = acc[ai][0][m][n][j], b = acc[ai][1][m][n][j]; o[n * 4 + j] = a * fast_sigmoid(a) * b; }
                u32x4 w; w.x = cvt_pk_bf16(o[0], o[1]); w.y = cvt_pk_bf16(o[2], o[3]); w.z = cvt_pk_bf16(o[4], o[5]); w.w = cvt_pk_bf16(o[6], o[7]);
                *(u32x4*)rowp = w; }
    }
};
struct EpiMoe2 {
    static constexpr bool PERM = true;
    bf16* Y; const float* roww;
    __device__ __forceinline__ void operator()(const f32x4 (&acc)[2][2][4][2], const Unit& u, int wr, int wc, int fr, int fq) const {
        const int row0 = u.pm * BM + wr * 64 + fr, col0 = u.pn * BM + wc * 32 + 8 * fq;
#pragma unroll
        for (int ai = 0; ai < 2; ++ai)
#pragma unroll
            for (int m = 0; m < 4; ++m) { const int row = row0 + ai * HALF + m * 16; const float rw = roww[row]; bf16* rowp = Y + (size_t)row * D + col0;
#pragma unroll
                for (int bj = 0; bj < 2; ++bj) { const f32x4 v0 = acc[ai][bj][m][0] * rw, v1 = acc[ai][bj][m][1] * rw;
                    u32x4 w; w.x = cvt_pk_bf16(v0[0], v0[1]); w.y = cvt_pk_bf16(v0[2], v0[3]); w.z = cvt_pk_bf16(v1[0], v1[1]); w.w = cvt_pk_bf16(v1[2], v1[3]);
                    *(u32x4*)(rowp + bj * HALF) = w; } }
    }
};

struct MergeOrder {
    const char* Y[3]; const char* W; int G, c;
    __device__ __forceinline__ bool next(int i, Unit& u) const {
        const int j = i / 3, r = i - 3 * j; const int L = j * G + c; if (L >= 128 * 4) return false;
        pg8::tile_of(L, 128, 4, u.pm, u.pn); u.aux = r;
        const char* y = (r == 0) ? Y[0] : ((r == 1) ? Y[1] : Y[2]);
        u.A = y + (size_t)u.pm * (256 * 512 * 2); u.B = W + (size_t)r * (1024 * 512 * 2) + (size_t)u.pn * (256 * 512 * 2); return true;
    }
};
template <int KDIM> struct MoeOrder {
    const char* A; const char* W; const LAS int* pe; int c, NP;
    __device__ __forceinline__ bool next(int i, Unit& u) const {
        const int L = i * 256 + c; if (L >= NP * 4) return false;
        const int p = L >> 2, pn = L & 3; const int e = __builtin_amdgcn_readfirstlane(pe[p]);
        u.pm = p; u.pn = pn; u.aux = e; u.A = A + (size_t)p * (256 * KDIM * 2); u.B = W + (size_t)e * (1024 * KDIM * 2) + (size_t)pn * (256 * KDIM * 2); return true;
    }
};

struct Args {
    const float* in[23]; float* out; unsigned char* ws; int ph_lo, ph_hi;
};
struct Frame {
    LAS unsigned char* lds; int tid, lane, wave, G, wg;
    float* out; unsigned char* ws;
};
__device__ __forceinline__ const float* inp_lds(LAS unsigned char* lds, int i) {
    const unsigned long long v = ((const LAS unsigned long long*)(lds + LARG_OFF))[i];
    const unsigned lo = __builtin_amdgcn_readfirstlane((unsigned)v), hi = __builtin_amdgcn_readfirstlane((unsigned)(v >> 32));
    return (const float*)(((unsigned long long)hi << 32) | lo);
}
__device__ __forceinline__ const float* inp(const Frame& F, int i) { return inp_lds(F.lds, i); }
__device__ __forceinline__ Frame fresh(LAS unsigned char* lds, int wave) {
    Frame F; int wgx = blockIdx.x; unsigned lb = (unsigned)(unsigned long long)lds;
    asm volatile("" : "+s"(wave), "+s"(wgx), "+s"(lb));
    F.lds = (LAS unsigned char*)(unsigned long long)lb;
    F.wave = wave; F.lane = (int)__builtin_amdgcn_mbcnt_hi(~0u, __builtin_amdgcn_mbcnt_lo(~0u, 0u)); F.tid = wave * 64 + F.lane;
    F.G = 256; F.wg = wgx;
    F.out = (float*)inp_lds(F.lds, 23); F.ws = (unsigned char*)inp_lds(F.lds, 24);
    return F;
}
enum { I_X = 0, I_LN_IN_G, I_LN_IN_B, I_W_IN, I_CONV, I_A_LOG, I_DT_BIAS, I_DN_NORM, I_POOL_W, I_POOL_SCALE, I_ML_GATE_B, I_ML_NORM, I_W_BRANCH, I_W_OUT, I_LN_MIX_G, I_LN_MIX_B,
       I_ROUTER_W, I_ROUTER_B, I_MOE_W1, I_MOE_W3, I_MOE_W2, I_LN_FFN_G, I_LN_FFN_B };

__device__ __forceinline__ void tr_item(const float* W, int ldw, int k0, int n0src, bf16* WT, int dpitch, int drow0, LAS float* scr, int lane) {
#pragma unroll 8
    for (int i = 0; i < 32; ++i) { const int kk = 2 * i + (lane >> 5); scr[kk * 33 + (lane & 31)] = W[(size_t)(k0 + kk) * ldw + n0src + (lane & 31)]; }
    LDS_WAIT(); asm volatile("" ::: "memory");
    const int c = lane & 7;
#pragma unroll
    for (int j = 0; j < 4; ++j) { const int n = (lane >> 3) + 8 * j; const LAS float* s = scr + (8 * c) * 33 + n;
        u32x4 o; o.x = pk2(s[0 * 33], s[1 * 33]); o.y = pk2(s[2 * 33], s[3 * 33]); o.z = pk2(s[4 * 33], s[5 * 33]); o.w = pk2(s[6 * 33], s[7 * 33]);
        *(u32x4*)(WT + (size_t)(drow0 + n) * dpitch + k0 + 8 * c) = o; }
    LDS_WAIT(); asm volatile("" ::: "memory");
}
__device__ __forceinline__ void tr_segment(const Frame& F, const float* W, int ldw, int K, int n0src, int ncols, bf16* WT, int drow0, int& it) {
    LAS float* scr = (LAS float*)(F.lds + F.wave * 16384);
    const int gw = F.wg * NWAVES + F.wave, NGW = F.G * NWAVES;
    const int nblk = ncols / 32, nitems = (K / 64) * nblk;
    int first = (gw - (it % NGW) + NGW) % NGW;
    for (int r = first; r < nitems; r += NGW) { const int kb = r / nblk, nb = r % nblk; tr_item(W, ldw, 64 * kb, n0src + 32 * nb, WT, K, drow0 + 32 * nb, scr, F.lane); }
    it += nitems;
}
__device__ __forceinline__ void wprep_mixer(const Frame& F, int l) {
    const float* win = inp(F, I_W_IN) + (size_t)l * D * DIN; int it = 0;
    bf16* Wi = (bf16*)(F.ws + WS_WIN); bf16* Wg = (bf16*)(F.ws + WS_WGATE); bf16* Wb = (bf16*)(F.ws + WS_WBR); bf16* Wo = (bf16*)(F.ws + WS_WOUT);
    tr_segment(F, win, DIN, D, C_QKV, 1536, Wi, 0, it);
    tr_segment(F, win, DIN, D, C_Z, 512, Wi, 1536, it);
    tr_segment(F, win, DIN, D, C_POOL, 512, Wi, 2048, it);
    tr_segment(F, win, DIN, D, C_MQ, 256, Wi, 2560, it);
    tr_segment(F, win, DIN, D, C_MK, 256, Wi, 2816, it);
    tr_segment(F, win, DIN, D, C_MV, 512, Wi, 3072, it);
    tr_segment(F, win, DIN, D, C_MO, 512, Wi, 3584, it);
    tr_segment(F, win, DIN, D, C_GATE, 3072, Wg, 0, it);
    const float* wbr = inp(F, I_W_BRANCH) + (size_t)l * 3 * MIXW * D;
    tr_segment(F, wbr, D, MIXW, 0, D, Wb, 0, it);
    tr_segment(F, wbr + (size_t)2 * MIXW * D, D, MIXW, 0, D, Wb + (size_t)2 * D * MIXW, 0, it);
    tr_segment(F, inp(F, I_W_OUT) + (size_t)l * D * D, D, D, 0, D, Wo, 0, it);
    const float* pw = inp(F, I_POOL_W) + (size_t)l * 4 * 128 * 128; const float* ps = inp(F, I_POOL_SCALE) + (size_t)l * MIXW; const float* wb1 = wbr + (size_t)MIXW * D;
    bf16* W1 = Wb + (size_t)D * MIXW;
    for (int idx = F.wg * 512 + F.tid; idx < D * MIXW; idx += F.G * 512) {
        const int m = idx >> 10, d = idx & 1023, g = m >> 7, c = m & 127;
        float s = 0.f;
        for (int dd = 0; dd < 128; ++dd) s += pw[(g * 128 + c) * 128 + dd] * ps[g * 128 + dd] * wb1[(size_t)(g * 128 + dd) * D + d];
        W1[(size_t)d * MIXW + m] = (bf16)f2bf(s);
    }
}
__device__ __forceinline__ void wprep_moe(const Frame& F, int l) {
    bf16* W13 = (bf16*)(F.ws + WS_W13); bf16* W2 = (bf16*)(F.ws + WS_W2);
    LAS float* scr = (LAS float*)(F.lds + F.wave * 16384);
    const int gw = F.wg * NWAVES + F.wave, NGW = F.G * NWAVES;
    for (int r = gw; r < NEXP * 2 * 256; r += NGW) {
        const int e = r >> 9, which = (r >> 8) & 1, kb = (r >> 4) & 15, nb = r & 15, n0 = nb * 32;
        const float* W = inp(F, which ? I_MOE_W3 : I_MOE_W1) + ((size_t)l * NEXP + e) * D * DEXP;
        tr_item(W, DEXP, 64 * kb, n0, W13 + (size_t)e * D * D, D, (n0 >> 7) * 256 + which * 128 + (n0 & 127), scr, F.lane);
    }
    for (int r = gw; r < NEXP * 256; r += NGW) {
        const int e = r >> 8, kb = (r >> 5) & 7, nb = r & 31;
        const float* W = inp(F, I_MOE_W2) + ((size_t)l * NEXP + e) * DEXP * D;
        tr_item(W, D, 64 * kb, 32 * nb, W2 + (size_t)e * D * DEXP, DEXP, 32 * nb, scr, F.lane);
    }
}

__device__ __forceinline__ int w32_addr(int k, int c4) { return (k >> 1) * 256 + (((((k & 1) << 3) | c4) ^ ((k >> 1) & 15)) << 4); }
__device__ __forceinline__ void stage_w32(const Frame& F, const float* src, int ldw, bool gates) {
    for (int idx = F.tid; idx < D * 8; idx += 512) {
        const int k = idx >> 3, c4 = idx & 7;
        int col = 4 * c4;
        if (gates) col = (c4 < 2) ? (C_A + 4 * c4) : (c4 < 4) ? (C_B + 4 * (c4 - 2)) : (c4 < 6) ? (C_I + 4 * (c4 - 4)) : (C_F + 4 * (c4 - 6));
        const f32x4 v = *(const f32x4*)(src + (size_t)k * ldw + col);
        *(LAS f32x4*)(F.lds + w32_addr(k, c4)) = v;
    }
}
template <int MODE>
__device__ __forceinline__ void ln_phase(const Frame& F, const float* gam, const float* bet, const float* w32src, int w32ld, bool do_proj, bool write_hb) {
    LAS int* lhist = (LAS int*)(F.lds + LHIST_OFF);
    if (do_proj) stage_w32(F, w32src, w32ld, MODE != 1);
    if (MODE == 1 && F.tid < 32) lhist[F.tid] = 0;
    __syncthreads();
    const int lane = F.lane;
    f32x2 gv[8], bv[8];
#pragma unroll
    for (int m = 0; m < 8; ++m) { gv[m] = *(const f32x2*)(gam + 2 * lane + 128 * m); bv[m] = *(const f32x2*)(bet + 2 * lane + 128 * m); }
    bf16* hb = (bf16*)(F.ws + WS_HB);
    const int rows_per_wg = T / F.G;
    for (int i = 0; i < rows_per_wg / NWAVES; ++i) {
        const int row = F.wg * rows_per_wg + F.wave * (rows_per_wg / NWAVES) + i;
        f32x2 v[8];
        if (MODE == 0) {
#pragma unroll
            for (int m = 0; m < 8; ++m) v[m] = *(const f32x2*)(inp(F, I_X) + (size_t)row * D + 2 * lane + 128 * m);
        } else if (MODE == 1) {
#pragma unroll
            for (int m = 0; m < 8; ++m) v[m] = *(const f32x2*)(F.out + (size_t)row * D + 2 * lane + 128 * m);
        } else {
            const int* pos = (const int*)(F.ws + WS_POS); const int p0 = pos[2 * row], p1 = pos[2 * row + 1];
            const bf16* Y = (const bf16*)(F.ws + WS_YROWS);
#pragma unroll
            for (int m = 0; m < 8; ++m) {
                const f32x2 o = *(const f32x2*)(F.out + (size_t)row * D + 2 * lane + 128 * m);
                const unsigned a = *(const unsigned*)(Y + (size_t)p0 * D + 2 * lane + 128 * m), b = *(const unsigned*)(Y + (size_t)p1 * D + 2 * lane + 128 * m);
                v[m].x = ALPHA * o.x + bf2f(a & 0xffffu) + bf2f(b & 0xffffu); v[m].y = ALPHA * o.y + bf2f(a >> 16) + bf2f(b >> 16);
            }
        }
        float s = 0.f;
#pragma unroll
        for (int m = 0; m < 8; ++m) s += v[m].x + v[m].y;
        const float mean = wave_sum(s) * (1.f / D);
        float s2 = 0.f;
#pragma unroll
        for (int m = 0; m < 8; ++m) { v[m].x -= mean; v[m].y -= mean; s2 += v[m].x * v[m].x + v[m].y * v[m].y; }
        const float rstd = 1.0f / sqrtf(wave_sum(s2) * (1.f / D) + LN_EPS);
#pragma unroll
        for (int m = 0; m < 8; ++m) { v[m].x = v[m].x * rstd * gv[m].x + bv[m].x; v[m].y = v[m].y * rstd * gv[m].y + bv[m].y; }
#pragma unroll
        for (int m = 0; m < 8; ++m) *(f32x2*)(F.out + (size_t)row * D + 2 * lane + 128 * m) = v[m];
        if (write_hb) {
#pragma unroll
            for (int m = 0; m < 8; ++m) *(unsigned*)(hb + (size_t)row * D + 2 * lane + 128 * m) = pk2(v[m].x, v[m].y);
        }
        if (!do_proj) continue;
        float acc[32];
#pragma unroll
        for (int c = 0; c < 32; ++c) acc[c] = 0.f;
#pragma unroll
        for (int m = 0; m < 8; ++m) {
#pragma unroll
            for (int e = 0; e < 2; ++e) {
                asm volatile("" ::: "memory");
                const int k = 2 * lane + 128 * m + e; const float xv = e ? v[m].y : v[m].x;
#pragma unroll
                for (int c4 = 0; c4 < 8; ++c4) { const f32x4 w = *(const LAS f32x4*)(F.lds + w32_addr(k, c4));
                    acc[4 * c4 + 0] += xv * w[0]; acc[4 * c4 + 1] += xv * w[1]; acc[4 * c4 + 2] += xv * w[2]; acc[4 * c4 + 3] += xv * w[3]; }
            }
        }
        float r16[16], r8[8], r4[4], r2[2], r1;
        { const bool hi = (lane & 32) != 0;
#pragma unroll
          for (int j = 0; j < 16; ++j) { const float a = acc[j], b = acc[j + 16]; const float send = hi ? a : b, keep = hi ? b : a; r16[j] = keep + __shfl_xor(send, 32); } }
        { const bool hi = (lane & 16) != 0;
#pragma unroll
          for (int j = 0; j < 8; ++j) { const float a = r16[j], b = r16[j + 8]; const float send = hi ? a : b, keep = hi ? b : a; r8[j] = keep + __shfl_xor(send, 16); } }
        { const bool hi = (lane & 8) != 0;
#pragma unroll
          for (int j = 0; j < 4; ++j) { const float a = r8[j], b = r8[j + 4]; const float send = hi ? a : b, keep = hi ? b : a; r4[j] = keep + __shfl_xor(send, 8); } }
        { const bool hi = (lane & 4) != 0;
#pragma unroll
          for (int j = 0; j < 2; ++j) { const float a = r4[j], b = r4[j + 2]; const float send = hi ? a : b, keep = hi ? b : a; r2[j] = keep + __shfl_xor(send, 4); } }
        { const bool hi = (lane & 2) != 0; const float a = r2[0], b = r2[1]; const float send = hi ? a : b, keep = hi ? b : a; r1 = keep + __shfl_xor(send, 2); }
        r1 += __shfl_xor(r1, 1);
        if (MODE != 1) {
            if ((lane & 1) == 0) ((float*)(F.ws + WS_SG))[(size_t)row * 32 + (lane >> 1)] = r1;
        } else {
            const float score = sigmoidf_(r1);
            const float sel = score + inp(F, I_ROUTER_B)[lane >> 1];
            const int gb = lane & ~7;
            const float v0 = __shfl(sel, gb + 0), v1 = __shfl(sel, gb + 2), v2 = __shfl(sel, gb + 4), v3 = __shfl(sel, gb + 6);
            int i1 = 0; float m1 = v0;
            if (v1 > m1) { m1 = v1; i1 = 1; } if (v2 > m1) { m1 = v2; i1 = 2; } if (v3 > m1) { m1 = v3; i1 = 3; }
            int i2 = -1; float m2 = -3.0e38f;
            if (i1 != 0 && v0 > m2) { m2 = v0; i2 = 0; } if (i1 != 1 && v1 > m2) { m2 = v1; i2 = 1; } if (i1 != 2 && v2 > m2) { m2 = v2; i2 = 2; } if (i1 != 3 && v3 > m2) { m2 = v3; i2 = 3; }
            float gs = m1 + m2; int gi = lane >> 3;
#pragma unroll
            for (int o = 8; o < 64; o <<= 1) { const float og = __shfl_xor(gs, o); const int oi = __shfl_xor(gi, o); if (og > gs || (og == gs && oi < gi)) { gs = og; gi = oi; } }
            const int src = gi * 8;
            const int e1 = gi * 4 + __shfl(i1, src), e2 = gi * 4 + __shfl(i2, src);
            const float s1 = __shfl(score, 2 * e1), s2 = __shfl(score, 2 * e2);
            if (lane == 0) {
                int* eid = (int*)(F.ws + WS_EID); float* ew = (float*)(F.ws + WS_EW);
                const float inv = 1.0f / (s1 + s2);
                eid[2 * row] = e1; eid[2 * row + 1] = e2; ew[2 * row] = s1 * inv; ew[2 * row + 1] = s2 * inv;
                __hip_atomic_fetch_add(lhist + e1, 1, __ATOMIC_RELAXED, __HIP_MEMORY_SCOPE_WORKGROUP); __hip_atomic_fetch_add(lhist + e2, 1, __ATOMIC_RELAXED, __HIP_MEMORY_SCOPE_WORKGROUP);
            }
        }
    }
    if (MODE == 1) {
        __syncthreads();
        if (F.tid < 32) ((int*)(F.ws + WS_HIST))[F.wg * 32 + F.tid] = lhist[F.tid];
    }
    __syncthreads();
}

__device__ __forceinline__ int invsigma32(int w) { return 8 * ((w >> 2) & 3) + 4 * (w >> 4) + (w & 3); }
__device__ __forceinline__ float wave_incl_scan(float v, int lane) {
#pragma unroll
    for (int o = 1; o < 64; o <<= 1) { const float t = __shfl_up(v, o); if (lane >= o) v += t; }
    return v;
}
__device__ __forceinline__ float wave_incl_maxscan(float v, int lane) {
#pragma unroll
    for (int o = 1; o < 64; o <<= 1) { const float t = __shfl_up(v, o); if (lane >= o) v = fmaxf(v, t); }
    return v;
}
constexpr int DQ_OFF = 0, DK_OFF = 17408, DV_OFF = 34816, DGM_OFF = 52224, DQK_OFF = 68864, DTM_OFF = 85504, DVEC_OFF = 120320;
constexpr int QROW = 272;
__device__ __forceinline__ void dn_prep(const Frame& F, int l) {
    LAS unsigned char* L = F.lds;
    const int lane = F.lane, wave = F.wave, tid = F.tid;
    const bf16* P = (const bf16*)(F.ws + WS_PQKV);
    const float* SG = (const float*)(F.ws + WS_SG);
    const float* cw = inp(F, I_CONV) + (size_t)l * 5 * 1536;
    for (int item = F.wg; item < NB * NHEAD * NCH; item += F.G) {
        const int b = item >> 9, h = (item >> 7) & 3, n = item & 127;
        const int t0 = b * SEQ + n * CH;
        {
            float w[3][5][2];
#pragma unroll
            for (int p = 0; p < 3; ++p)
#pragma unroll
                for (int j = 0; j < 5; ++j) { const f32x2 t = *(const f32x2*)(cw + j * 1536 + p * 512 + h * 128 + 2 * lane); w[p][j][0] = t.x; w[p][j][1] = t.y; }
            for (int ii = 0; ii < 8; ++ii) {
                const int i = wave + 8 * ii;
                float y[3][2];
#pragma unroll
                for (int p = 0; p < 3; ++p) { y[p][0] = 0.f; y[p][1] = 0.f; }
#pragma unroll
                for (int j = 0; j < 5; ++j) {
                    const int sp = n * CH + i + j - 2;
                    if (sp >= 0 && sp < SEQ) {
                        const bf16* src = P + (size_t)(b * SEQ + sp) * 1536 + h * 128 + 2 * lane;
#pragma unroll
                        for (int p = 0; p < 3; ++p) { const unsigned u = *(const unsigned*)(src + p * 512); y[p][0] += bf2f(u & 0xffffu) * w[p][j][0]; y[p][1] += bf2f(u >> 16) * w[p][j][1]; }
                    }
                }
#pragma unroll
                for (int p = 0; p < 3; ++p) { y[p][0] = siluf_(y[p][0]); y[p][1] = siluf_(y[p][1]); }
                const float sq = wave_sum(y[0][0] * y[0][0] + y[0][1] * y[0][1]), sk = wave_sum(y[1][0] * y[1][0] + y[1][1] * y[1][1]);
                const float rq = (1.0f / sqrtf(sq + NORM_EPS)) * 0.08838834764831845f, rk = 1.0f / sqrtf(sk + NORM_EPS);
                *(LAS unsigned*)(L + DQ_OFF + i * QROW + 4 * lane) = pk2(y[0][0] * rq, y[0][1] * rq);
                *(LAS unsigned*)(L + DK_OFF + i * QROW + 4 * lane) = pk2(y[1][0] * rk, y[1][1] * rk);
                *(LAS unsigned*)(L + DV_OFF + i * QROW + 4 * lane) = pk2(y[2][0], y[2][1]);
            }
        }
        __syncthreads();
        {
            const int j = lane, i0 = wave * 8;
            float g[8], qk[8];
#pragma unroll
            for (int ii = 0; ii < 8; ++ii) { g[ii] = 0.f; qk[ii] = 0.f; }
            for (int c8 = 0; c8 < 16; ++c8) {
                float kj[8]; unpack8(*(const LAS u32x4*)(L + DK_OFF + j * QROW + 16 * c8), kj);
#pragma unroll
                for (int ii = 0; ii < 8; ++ii) {
                    float ki[8], qi[8]; unpack8(*(const LAS u32x4*)(L + DK_OFF + (i0 + ii) * QROW + 16 * c8), ki); unpack8(*(const LAS u32x4*)(L + DQ_OFF + (i0 + ii) * QROW + 16 * c8), qi);
#pragma unroll
                    for (int e = 0; e < 8; ++e) { g[ii] += ki[e] * kj[e]; qk[ii] += qi[e] * kj[e]; }
                }
            }
#pragma unroll
            for (int ii = 0; ii < 8; ++ii) { *(LAS float*)(L + DGM_OFF + ((i0 + ii) * 65 + j) * 4) = g[ii]; *(LAS float*)(L + DQK_OFF + ((i0 + ii) * 65 + j) * 4) = qk[ii]; }
        }
        __syncthreads();
        if (wave < 2) {
            const int d = wave;
            const int ti = d ? 63 - lane : lane;
            const float a = SG[(size_t)(t0 + ti) * 32 + d * 4 + h], bb = SG[(size_t)(t0 + ti) * 32 + 8 + d * 4 + h];
            const float beta = sigmoidf_(bb);
            const float g = -expf(inp(F, I_A_LOG)[l * 8 + d * 4 + h]) * softplusf_(a + inp(F, I_DT_BIAS)[l * 8 + d * 4 + h]);
            const float gc = wave_incl_scan(g, lane);
            LAS float* vec = (LAS float*)(L + DVEC_OFF + d * 2048);
            vec[lane] = beta; vec[64 + lane] = gc;
            LAS float* TM = (LAS float*)(L + DTM_OFF + d * 17408);
            const LAS float* GM = (const LAS float*)(L + DGM_OFF);
            for (int i = 0; i < 64; ++i) {
                const float beta_i = __shfl(beta, i), gc_i = __shfl(gc, i);
                const int tii = d ? 63 - i : i;
                const float mrow = beta_i * GM[tii * 65 + ti] * fexp(fminf(gc_i - gc, 0.f));
                float t0a = (lane == i) ? 1.f : 0.f, t1a = 0.f, t2a = 0.f, t3a = 0.f;
                int jj = 0;
                for (; jj + 4 <= i; jj += 4) {
                    t0a -= __shfl(mrow, jj) * TM[jj * 68 + lane];
                    t1a -= __shfl(mrow, jj + 1) * TM[(jj + 1) * 68 + lane];
                    t2a -= __shfl(mrow, jj + 2) * TM[(jj + 2) * 68 + lane];
                    t3a -= __shfl(mrow, jj + 3) * TM[(jj + 3) * 68 + lane];
                }
                for (; jj < i; ++jj) t0a -= __shfl(mrow, jj) * TM[jj * 68 + lane];
                TM[i * 68 + lane] = (t0a + t1a) + (t2a + t3a);
            }
            if (lane == 63) ((float*)(F.ws + WS_GL))[(size_t)item * 2 + d] = expf(gc);
        }
        __syncthreads();
        {
            const int d = tid >> 8, tt = tid & 255;
            const LAS float* vec = (const LAS float*)(L + DVEC_OFF + d * 2048);
            const LAS float* TM = (const LAS float*)(L + DTM_OFF + d * 17408);
            unsigned char* rec = F.ws + WS_R2 + ((size_t)item * 2 + d) * DNREC;
            const float gl = vec[64 + 63];
            {
                float X[64];
                const bool isv = tt < 128; const int col = isv ? tt : tt - 128;
                const int imgoff = isv ? DV_OFF : DK_OFF;
#pragma unroll
                for (int j = 0; j < 64; ++j) {
                    const int tj = d ? 63 - j : j;
                    const float x = bf2f(*(const LAS unsigned short*)(L + imgoff + tj * QROW + 2 * col));
                    const float be = vec[j], gcj = vec[64 + j];
                    X[j] = isv ? x * be : x * be * fexp(gcj);
                }
                bf16* Uf = (bf16*)(rec + DN_UF); bf16* Wp = (bf16*)(rec + DN_W);
                const int wpos = (col & ~31) + invsigma32(col & 31);
                for (int i = 0; i < 64; ++i) {
                    float s0 = 0.f, s1 = 0.f, s2 = 0.f, s3 = 0.f;
#pragma unroll
                    for (int j4 = 0; j4 < 16; ++j4) { const f32x4 t = *(const LAS f32x4*)(TM + i * 68 + 4 * j4);
                        s0 += t[0] * X[4 * j4]; s1 += t[1] * X[4 * j4 + 1]; s2 += t[2] * X[4 * j4 + 2]; s3 += t[3] * X[4 * j4 + 3]; }
                    const float o = (s0 + s1) + (s2 + s3);
                    if (isv) { const int mt = i >> 4, fq = (i >> 2) & 3, r = i & 3; Uf[(((col >> 4) * 64 + fq * 16 + (col & 15)) * 16) + mt * 4 + r] = (bf16)f2bf(o); }
                    else Wp[i * 128 + wpos] = (bf16)f2bf(o);
                }
            }
            {
                bf16* Qg = (bf16*)(rec + DN_QG); bf16* Kd = (bf16*)(rec + DN_KDT);
#pragma unroll 2
                for (int e = 0; e < 32; ++e) {
                    const int idx = tt + 256 * e, i = idx >> 7, kk = idx & 127;
                    const int ti = d ? 63 - i : i;
                    const float gci = vec[64 + i];
                    const float qv = bf2f(*(const LAS unsigned short*)(L + DQ_OFF + ti * QROW + 2 * kk));
                    const float kv = bf2f(*(const LAS unsigned short*)(L + DK_OFF + ti * QROW + 2 * kk));
                    Qg[i * 128 + (kk & ~31) + invsigma32(kk & 31)] = (bf16)f2bf(qv * fexp(gci));
                    Kd[kk * 64 + (i & ~31) + invsigma32(i & 31)] = (bf16)f2bf(kv * fexp(gl - gci));
                }
            }
            {
                bf16* At = (bf16*)(rec + DN_ATT);
                const LAS float* QKM = (const LAS float*)(L + DQK_OFF);
#pragma unroll 2
                for (int e = 0; e < 16; ++e) {
                    const int idx = tt + 256 * e, i = idx >> 6, j = idx & 63;
                    const int ti = d ? 63 - i : i, tj = d ? 63 - j : j;
                    const float v = (j <= i) ? QKM[ti * 65 + tj] * fexp(fminf(vec[64 + i] - vec[64 + j], 0.f)) : 0.f;
                    At[i * 64 + (j & ~31) + invsigma32(j & 31)] = (bf16)f2bf(v);
                }
            }
        }
        __syncthreads();
    }
}

__device__ __forceinline__ bf16x8 pack_b(const f32x4 lo, const f32x4 hi) {
    u32x4 w; w.x = cvt_pk_bf16(lo[0], lo[1]); w.y = cvt_pk_bf16(lo[2], lo[3]); w.z = cvt_pk_bf16(hi[0], hi[1]); w.w = cvt_pk_bf16(hi[2], hi[3]);
    return __builtin_bit_cast(bf16x8, w);
}
__device__ __forceinline__ int swz256(int row, int c16) { return row * 256 + ((c16 ^ (row & 15)) << 4); }
__device__ __forceinline__ int swz128(int row, int c8) { return (row >> 1) * 256 + (((((row & 1) << 3) | c8) ^ ((row >> 1) & 15)) << 4); }
constexpr int DNBUF = 57344;
__device__ __forceinline__ void dn_scan(const Frame& F) {
    if (F.wg >= 64) return;
    const int xcd = F.wg & 7, idx = F.wg >> 3;
    const int chain = xcd * 4 + (idx >> 1), hf = idx & 1;
    const int b = chain >> 3, h = (chain >> 1) & 3, d = chain & 1;
    const int lane = F.lane, fr = lane & 15, fq = lane >> 4, wave = F.wave;
    LAS unsigned char* L = F.lds;
    const unsigned char* recbase = F.ws + WS_R2;
    const int itembase = (b * NHEAD + h) * NCH;
    if (wave >= 4) {
        const int tl = F.tid - 256;
        u32x4 ra[14], rb[14];
        int woff[14];
#pragma unroll
        for (int i = 0; i < 14; ++i) { const int q = tl + 256 * i;
            if (i < 4) woff[i] = swz256(q >> 4, q & 15); else if (i < 8) woff[i] = 16384 + swz256((q - 1024) >> 4, q & 15);
            else if (i < 12) woff[i] = 32768 + swz128((q - 2048) >> 3, q & 7); else woff[i] = 49152 + swz128((q - 3072) >> 3, q & 7); }
#define DN_LOAD(R, step_) do { const int st_ = (step_) < NCH ? (step_) : NCH - 1; const int n_ = d ? (NCH - 1 - st_) : st_; \
        const u32x4* src_ = (const u32x4*)(recbase + ((size_t)(itembase + n_) * 2 + d) * DNREC) + tl; \
        _Pragma("unroll") for (int i = 0; i < 14; ++i) R[i] = src_[256 * i]; } while (0)
#define DN_WRITE(R, bufoff_) do { _Pragma("unroll") for (int i = 0; i < 14; ++i) *(LAS u32x4*)(L + (bufoff_) + woff[i]) = R[i]; } while (0)
        DN_LOAD(ra, 0); DN_LOAD(rb, 1);
        DN_WRITE(ra, 0);
        __syncthreads();
        for (int s = 0; s < NCH; s += 2) {
            DN_LOAD(ra, s + 2); DN_WRITE(rb, DNBUF);
            __syncthreads();
            DN_LOAD(rb, s + 3); DN_WRITE(ra, 0);
            __syncthreads();
        }
#undef DN_LOAD
#undef DN_WRITE
        return;
    }
    const int slice = hf * 4 + wave;
    const float* GL = (const float*)(F.ws + WS_GL);
    bf16* O = (bf16*)(F.ws + (d ? WS_OB : WS_OF));
    f32x4 S[8];
#pragma unroll
    for (int k = 0; k < 8; ++k) S[k] = (f32x4){0.f, 0.f, 0.f, 0.f};
    int offw[4], offk[8], offa[4];
#pragma unroll
    for (int t = 0; t < 4; ++t) { offw[t] = (16 * t + fr) * 256; offa[t] = ((16 * t + fr) >> 1) * 256; }
#pragma unroll
    for (int t = 0; t < 8; ++t) offk[t] = ((16 * t + fr) >> 1) * 256;
    const int x256 = fr & 15;
    const int x128 = (fr >> 1) & 15, p128 = (fr & 1) << 3;
    u32x4 un0, un1;
    { const int n0 = d ? (NCH - 1) : 0; const bf16* Uf = (const bf16*)(recbase + ((size_t)(itembase + n0) * 2 + d) * DNREC + DN_UF); un0 = *(const u32x4*)(Uf + (slice * 64 + lane) * 16); un1 = *(const u32x4*)(Uf + (slice * 64 + lane) * 16 + 8); }
    float egl_n = GL[(size_t)(itembase + (d ? (NCH - 1) : 0)) * 2 + d];
    __syncthreads();
    for (int step = 0; step < NCH; ++step) {
        const int n = d ? (NCH - 1 - step) : step;
        const int bufoff = (step & 1) ? DNBUF : 0;
        const u32x4 u0 = un0, u1 = un1; const float egl = egl_n;
        { const int st_ = (step + 1 < NCH) ? step + 1 : step; const int nn = d ? (NCH - 1 - st_) : st_;
          const bf16* Uf = (const bf16*)(recbase + ((size_t)(itembase + nn) * 2 + d) * DNREC + DN_UF); un0 = *(const u32x4*)(Uf + (slice * 64 + lane) * 16); un1 = *(const u32x4*)(Uf + (slice * 64 + lane) * 16 + 8);
          egl_n = GL[(size_t)(itembase + nn) * 2 + d]; }
        const LAS unsigned char* Bw = L + bufoff; const LAS unsigned char* Bq = Bw + 16384; const LAS unsigned char* Bk = Bw + 32768; const LAS unsigned char* Ba = Bw + 49152;
        bf16x8 SB[4];
#pragma unroll
        for (int s = 0; s < 4; ++s) SB[s] = pack_b(S[2 * s], S[2 * s + 1]);
        f32x4 V[4], Q[4];
#pragma unroll
        for (int mt = 0; mt < 4; ++mt) { V[mt] = (f32x4){0.f, 0.f, 0.f, 0.f}; Q[mt] = (f32x4){0.f, 0.f, 0.f, 0.f}; }
#pragma unroll
        for (int s = 0; s < 4; ++s)
#pragma unroll
            for (int mt = 0; mt < 4; ++mt) {
                const int o = offw[mt] + (((4 * s + fq) ^ x256) << 4);
                V[mt] = __builtin_amdgcn_mfma_f32_16x16x32_bf16(*(const LAS bf16x8*)(Bw + o), SB[s], V[mt], 0, 0, 0);
                Q[mt] = __builtin_amdgcn_mfma_f32_16x16x32_bf16(*(const LAS bf16x8*)(Bq + o), SB[s], Q[mt], 0, 0, 0);
            }
        {
            float uu[16]; { float t[8]; unpack8(u0, t);
#pragma unroll
                for (int e = 0; e < 8; ++e) uu[e] = t[e]; unpack8(u1, t);
#pragma unroll
                for (int e = 0; e < 8; ++e) uu[8 + e] = t[e]; }
#pragma unroll
            for (int mt = 0; mt < 4; ++mt)
#pragma unroll
                for (int r = 0; r < 4; ++r) V[mt][r] = uu[mt * 4 + r] - V[mt][r];
        }
        bf16x8 VB[2];
#pragma unroll
        for (int s2 = 0; s2 < 2; ++s2) VB[s2] = pack_b(V[2 * s2], V[2 * s2 + 1]);
#pragma unroll
        for (int s2 = 0; s2 < 2; ++s2)
#pragma unroll
            for (int mt = 0; mt < 4; ++mt) {
                const int xr = (8 * mt + (fr >> 1)) & 15;
                const int o = offa[mt] + (((p128 | (4 * s2 + fq)) ^ xr) << 4);
                Q[mt] = __builtin_amdgcn_mfma_f32_16x16x32_bf16(*(const LAS bf16x8*)(Ba + o), VB[s2], Q[mt], 0, 0, 0);
            }
#pragma unroll
        for (int mt = 0; mt < 4; ++mt)
#pragma unroll
            for (int r = 0; r < 4; ++r) {
                const int i = 16 * mt + 4 * fq + r; const int tok = b * SEQ + n * CH + (d ? 63 - i : i);
                O[(size_t)tok * MIXW + h * HD + slice * 16 + fr] = (bf16)f2bf(Q[mt][r]);
            }
#pragma unroll
        for (int kt = 0; kt < 8; ++kt) {
            S[kt] = S[kt] * egl;
            const int xr = (8 * kt + (fr >> 1)) & 15;
#pragma unroll
            for (int s2 = 0; s2 < 2; ++s2) {
                const int o = offk[kt] + (((p128 | (4 * s2 + fq)) ^ xr) << 4);
                S[kt] = __builtin_amdgcn_mfma_f32_16x16x32_bf16(*(const LAS bf16x8*)(Bk + o), VB[s2], S[kt], 0, 0, 0);
            }
        }
        __syncthreads();
    }
}

constexpr int MQ_OFF = 0, MK_OFF = 9216, MV_OFF = 18432, MQK_OFF = 35840, MVEC_OFF = 52480;
constexpr int MQROW = 144;
__device__ __forceinline__ void ml_prep(const Frame& F, int l) {
    LAS unsigned char* L = F.lds;
    const int lane = F.lane, wave = F.wave, tid = F.tid;
    const bf16* PQ = (const bf16*)(F.ws + WS_PMQ); const bf16* PK = (const bf16*)(F.ws + WS_PMK); const bf16* PV = (const bf16*)(F.ws + WS_PMV);
    const float* SG = (const float*)(F.ws + WS_SG);
    const float* gbias = inp(F, I_ML_GATE_B) + l * 16;
    for (int item = F.wg; item < NB * NHEAD * NCH; item += F.G) {
        const int b = item >> 9, h = (item >> 7) & 3, n = item & 127;
        const int t0 = b * SEQ + n * CH;
        {
            const int row = tid >> 3, c8 = tid & 7;
            const u32x4 q = *(const u32x4*)(PQ + (size_t)(t0 + row) * 256 + h * 64 + 8 * c8);
            u32x4 k = *(const u32x4*)(PK + (size_t)(t0 + row) * 256 + h * 64 + 8 * c8);
            { float f[8]; unpack8(k, f); k.x = pk2(f[0] * 0.125f, f[1] * 0.125f); k.y = pk2(f[2] * 0.125f, f[3] * 0.125f); k.z = pk2(f[4] * 0.125f, f[5] * 0.125f); k.w = pk2(f[6] * 0.125f, f[7] * 0.125f); }
            *(LAS u32x4*)(L + MQ_OFF + row * MQROW + 16 * c8) = q;
            *(LAS u32x4*)(L + MK_OFF + row * MQROW + 16 * c8) = k;
#pragma unroll
            for (int e = 0; e < 2; ++e) { const int idx = tid + 512 * e, r = idx >> 4, c = idx & 15;
                *(LAS u32x4*)(L + MV_OFF + r * QROW + 16 * c) = *(const u32x4*)(PV + (size_t)(t0 + r) * 512 + h * 128 + 8 * c); }
        }
        __syncthreads();
        {
            const int j = lane, i0 = wave * 8;
            float qk[8];
#pragma unroll
            for (int ii = 0; ii < 8; ++ii) qk[ii] = 0.f;
            for (int c8 = 0; c8 < 8; ++c8) {
                float kj[8]; unpack8(*(const LAS u32x4*)(L + MK_OFF + j * MQROW + 16 * c8), kj);
#pragma unroll
                for (int ii = 0; ii < 8; ++ii) { float qi[8]; unpack8(*(const LAS u32x4*)(L + MQ_OFF + (i0 + ii) * MQROW + 16 * c8), qi);
#pragma unroll
                    for (int e = 0; e < 8; ++e) qk[ii] += qi[e] * kj[e]; }
            }
#pragma unroll
            for (int ii = 0; ii < 8; ++ii) *(LAS float*)(L + MQK_OFF + ((i0 + ii) * 65 + j) * 4) = qk[ii];
        }
        if (wave < 2) {
            const int d = wave; const int ti = d ? 63 - lane : lane;
            const float ip = SG[(size_t)(t0 + ti) * 32 + 16 + d * 4 + h] + gbias[d * 4 + h];
            const float fp = SG[(size_t)(t0 + ti) * 32 + 24 + d * 4 + h] + gbias[8 + d * 4 + h];
            const float bc = wave_incl_scan(logsigmoidf_(fp), lane);
            const float bl = __shfl(bc, 63);
            const float lw = bl - bc + ip;
            const float am = wave_max(lw);
            const float wgt = expf(lw - am);
            const float ipb = ip - bc;
            const float dmax = bc + wave_incl_maxscan(ipb, lane);
            LAS float* vec = (LAS float*)(L + MVEC_OFF + d * 1024);
            vec[lane] = bc; vec[64 + lane] = dmax; vec[128 + lane] = wgt; vec[192 + lane] = ipb;
            float* row = (float*)(F.ws + WS_ML + ((size_t)item * 2 + d) * MLREC + ML_ROW);
            row[lane] = bc; row[64 + lane] = dmax; if (lane == 0) { row[128] = am; row[129] = bl; }
        }
        __syncthreads();
        {
            const int d = tid >> 8, tt = tid & 255;
            const LAS float* vec = (const LAS float*)(L + MVEC_OFF + d * 1024);
            const LAS float* QKM = (const LAS float*)(L + MQK_OFF);
            unsigned char* rec = F.ws + WS_ML + ((size_t)item * 2 + d) * MLREC;
            bf16* Qp = (bf16*)(rec + ML_Q); bf16* St = (bf16*)(rec + ML_ST); bf16* Kw = (bf16*)(rec + ML_KWT); bf16* Vf = (bf16*)(rec + ML_VF);
#pragma unroll 2
            for (int e = 0; e < 16; ++e) {
                const int idx = tt + 256 * e, i = idx >> 6, j = idx & 63;
                const int ti = d ? 63 - i : i, tj = d ? 63 - j : j;
                const float sv = (j <= i) ? QKM[ti * 65 + tj] * fexp(fminf(vec[i] + vec[192 + j] - vec[64 + i], 0.f)) : 0.f;
                St[i * 64 + j] = (bf16)f2bf(sv);
                Qp[i * 64 + (j & ~31) + invsigma32(j & 31)] = *(const LAS unsigned short*)(L + MQ_OFF + ti * MQROW + 2 * j);
                const float kv = bf2f(*(const LAS unsigned short*)(L + MK_OFF + tj * MQROW + 2 * i));
                Kw[i * 64 + j] = (bf16)f2bf(kv * vec[128 + j]);
            }
#pragma unroll 4
            for (int e = 0; e < 36; ++e) {
                const int idx = tt + 256 * e;
                const int el = idx & 7, lp = (idx >> 3) & 63, s = (idx >> 9) & 1, slice = idx >> 10;
                const int fr = lp & 15, fq = lp >> 4; const int j = 32 * s + 8 * fq + el; const int tj = d ? 63 - j : j;
                const unsigned short v = (slice < 8) ? *(const LAS unsigned short*)(L + MV_OFF + tj * QROW + 2 * (16 * slice + fr)) : (unsigned short)0x3F80;
                Vf[idx] = v;
            }
        }
        __syncthreads();
    }
}

constexpr int MLBUF = 25600;
__device__ __forceinline__ void ml_scan(const Frame& F) {
    if (F.wg >= 64) return;
    const int xcd = F.wg & 7, idx = F.wg >> 3;
    const int chain = xcd * 4 + (idx >> 1), hf = idx & 1;
    const int b = chain >> 3, h = (chain >> 1) & 3, d = chain & 1;
    const int lane = F.lane, fr = lane & 15, fq = lane >> 4, wave = F.wave;
    LAS unsigned char* L = F.lds;
    const unsigned char* recbase = F.ws + WS_ML;
    const int itembase = (b * NHEAD + h) * NCH;
    if (wave >= 5) {
        const int tl = F.tid - 320;
        u32x4 ra[9], rb[9]; int woff[9], goff[9];
#pragma unroll
        for (int i = 0; i < 9; ++i) { const int q = tl + 192 * i;
            if (q < 1536) { const int qq = q & 511; woff[i] = (q >> 9) * 8192 + swz128(qq >> 3, qq & 7); goff[i] = q; }
            else if (q < 1600) { woff[i] = 24576 + (q - 1536) * 16; goff[i] = 2688 + (q - 1536); }
            else { woff[i] = -1; goff[i] = 0; } }
#define ML_LOAD(R, step_) do { const int st_ = (step_) < NCH ? (step_) : NCH - 1; const int n_ = d ? (NCH - 1 - st_) : st_; \
        const u32x4* src_ = (const u32x4*)(recbase + ((size_t)(itembase + n_) * 2 + d) * MLREC); \
        _Pragma("unroll") for (int i = 0; i < 9; ++i) R[i] = src_[goff[i]]; } while (0)
#define ML_WRITE(R, bufoff_) do { _Pragma("unroll") for (int i = 0; i < 9; ++i) if (woff[i] >= 0) *(LAS u32x4*)(L + (bufoff_) + woff[i]) = R[i]; } while (0)
        ML_LOAD(ra, 0); ML_LOAD(rb, 1);
        ML_WRITE(ra, 0);
        __syncthreads();
        for (int s = 0; s < NCH; s += 2) {
            ML_LOAD(ra, s + 2); ML_WRITE(rb, MLBUF);
            __syncthreads();
            ML_LOAD(rb, s + 3); ML_WRITE(ra, 0);
            __syncthreads();
        }
#undef ML_LOAD
#undef ML_WRITE
        return;
    }
    const int slice = (wave < 4) ? hf * 4 + wave : 8;
    const bool active = (wave < 4) || (hf == 1);
    bf16* NUM = (bf16*)(F.ws + (d ? WS_NUMB : WS_NUMF)); float* DEN = (float*)(F.ws + WS_DEN);
    f32x4 C[4];
#pragma unroll
    for (int k = 0; k < 4; ++k) C[k] = (f32x4){0.f, 0.f, 0.f, 0.f};
    float m = 0.f;
    int offr[4];
#pragma unroll
    for (int t = 0; t < 4; ++t) offr[t] = ((16 * t + fr) >> 1) * 256;
    const int p128 = (fr & 1) << 3;
    bf16x8 vn0, vn1;
    { const int n0 = d ? (NCH - 1) : 0; const bf16* Vf = (const bf16*)(recbase + ((size_t)(itembase + n0) * 2 + d) * MLREC + ML_VF);
      vn0 = *(const bf16x8*)(Vf + ((slice * 2 + 0) * 64 + lane) * 8); vn1 = *(const bf16x8*)(Vf + ((slice * 2 + 1) * 64 + lane) * 8); }
    __syncthreads();
    for (int step = 0; step < NCH; ++step) {
        const int n = d ? (NCH - 1 - step) : step;
        const int bufoff = (step & 1) ? MLBUF : 0;
        bf16x8 VF[2]; VF[0] = vn0; VF[1] = vn1;
        { const int st_ = (step + 1 < NCH) ? step + 1 : step; const int nn = d ? (NCH - 1 - st_) : st_;
          const bf16* Vf = (const bf16*)(recbase + ((size_t)(itembase + nn) * 2 + d) * MLREC + ML_VF);
          vn0 = *(const bf16x8*)(Vf + ((slice * 2 + 0) * 64 + lane) * 8); vn1 = *(const bf16x8*)(Vf + ((slice * 2 + 1) * 64 + lane) * 8); }
        if (active) {
        const LAS unsigned char* Bq = L + bufoff; const LAS unsigned char* Bs = Bq + 8192; const LAS unsigned char* Bk = Bq + 16384; const LAS float* row = (const LAS float*)(Bq + 24576);
        const float am = row[128], bl = row[129];
        bf16x8 CB[2];
#pragma unroll
        for (int s = 0; s < 2; ++s) CB[s] = pack_b(C[2 * s], C[2 * s + 1]);
        f32x4 QC[4], SV[4], KV[4];
#pragma unroll
        for (int mt = 0; mt < 4; ++mt) { QC[mt] = (f32x4){0.f, 0.f, 0.f, 0.f}; SV[mt] = (f32x4){0.f, 0.f, 0.f, 0.f}; KV[mt] = (f32x4){0.f, 0.f, 0.f, 0.f}; }
#pragma unroll
        for (int s = 0; s < 2; ++s)
#pragma unroll
            for (int mt = 0; mt < 4; ++mt) {
                const int xr = (8 * mt + (fr >> 1)) & 15;
                const int o = offr[mt] + (((p128 | (4 * s + fq)) ^ xr) << 4);
                QC[mt] = __builtin_amdgcn_mfma_f32_16x16x32_bf16(*(const LAS bf16x8*)(Bq + o), CB[s], QC[mt], 0, 0, 0);
                SV[mt] = __builtin_amdgcn_mfma_f32_16x16x32_bf16(*(const LAS bf16x8*)(Bs + o), VF[s], SV[mt], 0, 0, 0);
                KV[mt] = __builtin_amdgcn_mfma_f32_16x16x32_bf16(*(const LAS bf16x8*)(Bk + o), VF[s], KV[mt], 0, 0, 0);
            }
#pragma unroll
        for (int mt = 0; mt < 4; ++mt) {
            const f32x4 bc4 = *(const LAS f32x4*)(row + 16 * mt + 4 * fq), dm4 = *(const LAS f32x4*)(row + 64 + 16 * mt + 4 * fq);
#pragma unroll
            for (int r = 0; r < 4; ++r) {
                const float il = bc4[r] + m, mo = fmaxf(il, dm4[r]);
                const float inter = fexp(il - mo), e2 = fexp(dm4[r] - mo);
                const float res = inter * QC[mt][r] + e2 * SV[mt][r];
                const int i = 16 * mt + 4 * fq + r; const int tok = b * SEQ + n * CH + (d ? 63 - i : i);
                if (slice < 8) NUM[(size_t)tok * MIXW + h * HD + slice * 16 + fr] = (bf16)f2bf(res);
                else if (fr == 0) DEN[(size_t)tok * 8 + h * 2 + d] = fmaxf(fabsf(res), fexp(-mo));
            }
        }
        const float mn = fmaxf(bl + m, am), sp = fexp(bl + m - mn), sc = fexp(am - mn);
#pragma unroll
        for (int kt = 0; kt < 4; ++kt) C[kt] = C[kt] * sp + KV[kt] * sc;
        m = mn;
        }
        __syncthreads();
    }
}

__device__ __forceinline__ void pool_phase(const Frame& F) {
    const bf16* U = (const bf16*)(F.ws + WS_PPOOL); bf16* Y = (bf16*)(F.ws + WS_YP);
    const int gw = F.wg * NWAVES + F.wave, NGW = F.G * NWAVES, lane = F.lane;
    const int half = 1 << (lane >> 4);
    for (int t = gw; t < T; t += NGW) {
        const int sp = t & (SEQ - 1);
        const int lo = max(sp - half, 0), hi = min(sp + half, SEQ);
        float s[8];
#pragma unroll
        for (int e = 0; e < 8; ++e) s[e] = 0.f;
        for (int o = -8; o < 8; ++o) {
            const int q = sp + o;
            if (q >= lo && q < hi) { float f[8]; unpack8(*(const u32x4*)(U + (size_t)(t + o) * MIXW + 8 * lane), f);
#pragma unroll
                for (int e = 0; e < 8; ++e) s[e] += f[e]; }
        }
        float c[8]; unpack8(*(const u32x4*)(U + (size_t)t * MIXW + 8 * lane), c);
        const float inv = 1.0f / (float)(hi - lo);
        u32x4 w; w.x = pk2(s[0] * inv - c[0], s[1] * inv - c[1]); w.y = pk2(s[2] * inv - c[2], s[3] * inv - c[3]); w.z = pk2(s[4] * inv - c[4], s[5] * inv - c[5]); w.w = pk2(s[6] * inv - c[6], s[7] * inv - c[7]);
        *(u32x4*)(Y + (size_t)t * MIXW + 8 * lane) = w;
    }
}

__device__ __forceinline__ void norm_phase(const Frame& F, int l) {
    const bf16* OF = (const bf16*)(F.ws + WS_OF); const bf16* OB = (const bf16*)(F.ws + WS_OB);
    const bf16* NF = (const bf16*)(F.ws + WS_NUMF); const bf16* NBk = (const bf16*)(F.ws + WS_NUMB); const float* DEN = (const float*)(F.ws + WS_DEN);
    bf16* Z = (bf16*)(F.ws + WS_PZ); bf16* MO = (bf16*)(F.ws + WS_PMO);
    const int gw = F.wg * NWAVES + F.wave, NGW = F.G * NWAVES, lane = F.lane, h = lane >> 4;
    float nw[8], mw[8];
#pragma unroll
    for (int e = 0; e < 8; ++e) { nw[e] = inp(F, I_DN_NORM)[l * MIXW + 8 * lane + e]; mw[e] = inp(F, I_ML_NORM)[l * MIXW + 8 * lane + e]; }
    for (int t = gw; t < T; t += NGW) {
        const size_t off = (size_t)t * MIXW + 8 * lane;
        {
            float a[8], bq[8], z[8]; unpack8(*(const u32x4*)(OF + off), a); unpack8(*(const u32x4*)(OB + off), bq); unpack8(*(const u32x4*)(Z + off), z);
            float ss = 0.f;
#pragma unroll
            for (int e = 0; e < 8; ++e) { a[e] += bq[e]; ss += a[e] * a[e]; }
            ss += __shfl_xor(ss, 1); ss += __shfl_xor(ss, 2); ss += __shfl_xor(ss, 4); ss += __shfl_xor(ss, 8);
            const float r = 1.0f / sqrtf(ss * (1.f / HD) + NORM_EPS);
            float o[8];
#pragma unroll
            for (int e = 0; e < 8; ++e) o[e] = a[e] * r * nw[e] * siluf_(z[e]);
            u32x4 w; w.x = pk2(o[0], o[1]); w.y = pk2(o[2], o[3]); w.z = pk2(o[4], o[5]); w.w = pk2(o[6], o[7]);
            *(u32x4*)(Z + off) = w;
        }
        {
            float a[8], bq[8], g[8]; unpack8(*(const u32x4*)(NF + off), a); unpack8(*(const u32x4*)(NBk + off), bq); unpack8(*(const u32x4*)(MO + off), g);
            const float df = 1.0f / DEN[(size_t)t * 8 + h * 2], db = 1.0f / DEN[(size_t)t * 8 + h * 2 + 1];
            float s = 0.f;
#pragma unroll
            for (int e = 0; e < 8; ++e) { a[e] = a[e] * df + bq[e] * db; s += a[e]; }
            s += __shfl_xor(s, 1); s += __shfl_xor(s, 2); s += __shfl_xor(s, 4); s += __shfl_xor(s, 8);
            const float mean = s * (1.f / HD); float ss = 0.f;
#pragma unroll
            for (int e = 0; e < 8; ++e) { a[e] -= mean; ss += a[e] * a[e]; }
            ss += __shfl_xor(ss, 1); ss += __shfl_xor(ss, 2); ss += __shfl_xor(ss, 4); ss += __shfl_xor(ss, 8);
            const float r = 1.0f / sqrtf(ss * (1.f / HD) + NORM_EPS);
            float o[8];
#pragma unroll
            for (int e = 0; e < 8; ++e) o[e] = a[e] * r * mw[e] * sigmoidf_(g[e]);
            u32x4 w; w.x = pk2(o[0], o[1]); w.y = pk2(o[2], o[3]); w.z = pk2(o[4], o[5]); w.w = pk2(o[6], o[7]);
            *(u32x4*)(MO + off) = w;
        }
    }
}

__device__ __forceinline__ void moe_tables(const Frame& F) {
    LAS int* cnt = (LAS int*)(F.lds + LHIST_OFF + 128); LAS int* pstart = (LAS int*)(F.lds + LHIST_OFF + 256); LAS int* mybase = (LAS int*)(F.lds + LHIST_OFF + 384);
    LAS int* pe = (LAS int*)(F.lds + LPE_OFF);
    const int* hist = (const int*)(F.ws + WS_HIST);
    if (F.tid < 32) { cnt[F.tid] = 0; mybase[F.tid] = 0; }
    __syncthreads();
    { const int e = F.tid & 31, part = F.tid >> 5; int tot = 0, base = 0;
      for (int q = 0; q < 16; ++q) { const int w = part * 16 + q; const int v = hist[w * 32 + e]; tot += v; base += v * min(max(F.wg - w, 0), 1); }
      __hip_atomic_fetch_add(cnt + e, tot, __ATOMIC_RELAXED, __HIP_MEMORY_SCOPE_WORKGROUP); __hip_atomic_fetch_add(mybase + e, base, __ATOMIC_RELAXED, __HIP_MEMORY_SCOPE_WORKGROUP); }
    __syncthreads();
    if (F.tid == 0) { int acc = 0, p = 0; for (int e = 0; e < NEXP; ++e) { pstart[e] = acc; const int np = (cnt[e] + 255) >> 8; for (int q = 0; q < np; ++q) pe[p++] = e; acc += np * 256; } pe[319] = p; }
    __syncthreads();
}
__device__ __forceinline__ void moe_dispatch(const Frame& F) {
    moe_tables(F);
    LAS int* pstart = (LAS int*)(F.lds + LHIST_OFF + 256); LAS int* mybase = (LAS int*)(F.lds + LHIST_OFF + 384);
    LAS int* lpos = (LAS int*)(F.lds);
    LAS int* le = (LAS int*)(F.lds + 1024);
    const int* eid = (const int*)(F.ws + WS_EID); const float* ew = (const float*)(F.ws + WS_EW);
    int* pos = (int*)(F.ws + WS_POS); float* roww = (float*)(F.ws + WS_ROWW);
    const int rows_per_wg = T / F.G, row0 = F.wg * rows_per_wg;
    int my_e = 0; float my_w = 0.f;
    if (F.tid < 256) { my_e = eid[2 * row0 + F.tid]; my_w = ew[2 * row0 + F.tid]; le[F.tid] = my_e; }
    __syncthreads();
    if (F.tid < 256) {
        int rank = 0;
        for (int a = 0; a < F.tid; ++a) rank += (le[a] == my_e) ? 1 : 0;
        const int p = pstart[my_e] + mybase[my_e] + rank;
        lpos[F.tid] = p; pos[2 * row0 + F.tid] = p; roww[p] = my_w;
    }
    __syncthreads();
    const bf16* hb = (const bf16*)(F.ws + WS_HB); bf16* Xs = (bf16*)(F.ws + WS_XS);
    for (int a = F.wave; a < 2 * rows_per_wg; a += NWAVES) {
        const int t = row0 + (a >> 1), p = lpos[a];
        const u32x4* src = (const u32x4*)(hb + (size_t)t * D); u32x4* dst = (u32x4*)(Xs + (size_t)p * D);
        dst[F.lane] = src[F.lane]; dst[64 + F.lane] = src[64 + F.lane];
    }
    __syncthreads();
}

constexpr int NPHASE = 1 + 15 * DEPTH;
#ifndef PHM
#define PHM 0xFFFF
#endif
#define PHON(b) ((PHM >> (b)) & 1)
__global__ void __launch_bounds__(NWAVES * 64, 2) mega_fwd(Args args) {
    extern __shared__ __attribute__((aligned(16))) unsigned char lds_raw[];
    LAS unsigned char* lds = (LAS unsigned char*)lds_raw;
    const int wave = __builtin_amdgcn_readfirstlane((int)threadIdx.x >> 6);
    for (int u = threadIdx.x; u < (LDS_BYTES - RING_BYTES) / 4; u += NWAVES * 64) ((LAS unsigned*)(lds + RING_BYTES))[u] = 0u;
    __syncthreads();
    if (threadIdx.x == 0) { LAS unsigned long long* ap = (LAS unsigned long long*)(lds + LARG_OFF);
#pragma unroll
        for (int i = 0; i < 23; ++i) ap[i] = (unsigned long long)args.in[i];
        ap[23] = (unsigned long long)args.out; ap[24] = (unsigned long long)args.ws; }
    __syncthreads();
    const int lo = args.ph_lo, hi = args.ph_hi;
    if (hi - lo > 1) { const XcdBarrier b0 = xcd_barrier_post((unsigned*)(args.ws + WS_CTL) + CW_BAR, (volatile LAS unsigned*)(lds + MISC_OFF) + 8);
        if (threadIdx.x == 0) ((volatile LAS unsigned*)(lds + MISC_OFF))[10] = b0.x; }
    __syncthreads();
#define IN(k) (lo <= (k) && (k) < hi)
#define SEAM(k) do { if (IN((k) + 1)) { XcdBarrier bar; bar.bar = (unsigned*)(F.ws + WS_CTL) + CW_BAR; bar.st = (volatile LAS unsigned*)(F.lds + MISC_OFF) + 8; bar.x = __builtin_amdgcn_readfirstlane(bar.st[2]); xcd_barrier(bar, F.tid); } } while (0)

    if (PHON(15) && IN(0)) { const Frame F = fresh(lds, wave);
        wprep_mixer(F, 0);
        __syncthreads();
        ln_phase<0>(F, inp(F, I_LN_IN_G), inp(F, I_LN_IN_B), inp(F, I_W_IN), DIN, true, true);
        SEAM(0);
    }
#pragma unroll 1
    for (int l = 0; l < DEPTH; ++l) {
        const int pb = 1 + 15 * l;
        if (PHON(0) && IN(pb + 0)) { const Frame F = fresh(lds, wave);
            pg8::StaticOrder S; S.init(F.ws + WS_HB, F.ws + WS_WIN, T, 1536, D, F.G, F.wg);
            EpiG1a E{(bf16*)(F.ws + WS_PQKV)};
            pg8::gemm_phase<EpiG1a, pg8::StaticOrder>(F.lds, F.tid, D, S, E);
            SEAM(pb + 0);
        }
        if (PHON(1) && IN(pb + 1)) { const Frame F = fresh(lds, wave); dn_prep(F, l); SEAM(pb + 1); }
        if (PHON(2) && IN(pb + 2)) { const Frame F = fresh(lds, wave); dn_scan(F); SEAM(pb + 2); }
        if (PHON(3) && IN(pb + 3)) { const Frame F = fresh(lds, wave);
            pg8::StaticOrder S; S.init(F.ws + WS_HB, F.ws + WS_WIN + (size_t)1536 * D * 2, T, 2560, D, F.G, F.wg);
            EpiG1b E{F.ws};
            pg8::gemm_phase<EpiG1b, pg8::StaticOrder>(F.lds, F.tid, D, S, E);
            SEAM(pb + 3);
        }
        if (PHON(4) && IN(pb + 4)) { const Frame F = fresh(lds, wave); pool_phase(F); ml_prep(F, l); SEAM(pb + 4); }
        if (PHON(5) && IN(pb + 5)) { const Frame F = fresh(lds, wave); ml_scan(F); SEAM(pb + 5); }
        if (PHON(6) && IN(pb + 6)) { const Frame F = fresh(lds, wave); norm_phase(F, l); SEAM(pb + 6); }
        if (PHON(7) && IN(pb + 7)) { const Frame F = fresh(lds, wave);
            pg8::StaticOrder S; S.init(F.ws + WS_HB, F.ws + WS_WGATE, T, 3072, D, F.G, F.wg);
            EpiGate E{(bf16*)(F.ws + WS_GATE)};
            pg8::gemm_phase<EpiGate, pg8::StaticOrder>(F.lds, F.tid, D, S, E);
            SEAM(pb + 7);
        }
        if (PHON(8) && IN(pb + 8)) { const Frame F = fresh(lds, wave);
            MergeOrder S; S.Y[0] = (const char*)(F.ws + WS_PZ); S.Y[1] = (const char*)(F.ws + WS_YP); S.Y[2] = (const char*)(F.ws + WS_PMO); S.W = (const char*)(F.ws + WS_WBR); S.G = F.G; S.c = F.wg;
            EpiMerge E{(const bf16*)(F.ws + WS_GATE), (bf16*)(F.ws + WS_MRGP), (bf16*)(F.ws + WS_HB)};
            pg8::gemm_phase<EpiMerge, MergeOrder>(F.lds, F.tid, MIXW, S, E);
            SEAM(pb + 8);
        }
        if (PHON(9) && IN(pb + 9)) { const Frame F = fresh(lds, wave);
            pg8::StaticOrder S; S.init(F.ws + WS_HB, F.ws + WS_WOUT, T, D, D, F.G, F.wg);
            EpiOut E{F.out};
            pg8::gemm_phase<EpiOut, pg8::StaticOrder>(F.lds, F.tid, D, S, E);
            SEAM(pb + 9);
        }
        if (PHON(10) && IN(pb + 10)) { const Frame F = fresh(lds, wave);
            wprep_moe(F, l);
            __syncthreads();
            ln_phase<1>(F, inp(F, I_LN_MIX_G) + l * D, inp(F, I_LN_MIX_B) + l * D, inp(F, I_ROUTER_W), 32, true, true);
            SEAM(pb + 10);
        }
        if (PHON(11) && IN(pb + 11)) { const Frame F = fresh(lds, wave); moe_dispatch(F); SEAM(pb + 11); }
        if (PHON(12) && IN(pb + 12)) { const Frame F = fresh(lds, wave);
            moe_tables(F);
            MoeOrder<D> S; S.A = (const char*)(F.ws + WS_XS); S.W = (const char*)(F.ws + WS_W13); S.pe = (const LAS int*)(F.lds + LPE_OFF); S.c = F.wg; S.NP = __builtin_amdgcn_readfirstlane(S.pe[319]);
            EpiMoe1 E{(bf16*)(F.ws + WS_ACT)};
            pg8::gemm_phase<EpiMoe1, MoeOrder<D>>(F.lds, F.tid, D, S, E);
            SEAM(pb + 12);
        }
        if (PHON(13) && IN(pb + 13)) { const Frame F = fresh(lds, wave);
            moe_tables(F);
            MoeOrder<DEXP> S; S.A = (const char*)(F.ws + WS_ACT); S.W = (const char*)(F.ws + WS_W2); S.pe = (const LAS int*)(F.lds + LPE_OFF); S.c = F.wg; S.NP = __builtin_amdgcn_readfirstlane(S.pe[319]);
            EpiMoe2 E{(bf16*)(F.ws + WS_YROWS), (const float*)(F.ws + WS_ROWW)};
            pg8::gemm_phase<EpiMoe2, MoeOrder<DEXP>>(F.lds, F.tid, DEXP, S, E);
            SEAM(pb + 13);
        }
        if (PHON(14) && IN(pb + 14)) { const Frame F = fresh(lds, wave);
            const bool last = (l == DEPTH - 1);
            if (!last) { wprep_mixer(F, l + 1); __syncthreads(); }
            ln_phase<2>(F, inp(F, I_LN_FFN_G) + l * D, inp(F, I_LN_FFN_B) + l * D, inp(F, I_W_IN) + (size_t)(last ? l : l + 1) * D * DIN, DIN, !last, !last);
            SEAM(pb + 14);
        }
    }
#undef IN
#undef SEAM
}

#ifndef N_LAUNCH_MODE
#define N_LAUNCH_MODE 1
#endif
extern "C" void kernel_launch(void* const* d_in, const int* in_sizes, int n_in, void* d_out, int out_size, void* d_ws, size_t ws_size, hipStream_t stream) {
    static int grid = 0;
    if (grid == 0) {
        if (n_in != 23 || out_size != T * D || ws_size < WS_END) { fprintf(stderr, "kernel_launch: unexpected shapes (n_in %d out %d ws %zu)\n", n_in, out_size, ws_size); grid = -1; return; }
        int dev = 0, cus = 0, per_cu = 0;
        if (hipGetDevice(&dev) != hipSuccess || hipDeviceGetAttribute(&cus, hipDeviceAttributeMultiprocessorCount, dev) != hipSuccess) { grid = -1; return; }
        if (hipFuncSetAttribute((const void*)mega_fwd, hipFuncAttributeMaxDynamicSharedMemorySize, LDS_BYTES) != hipSuccess) { fprintf(stderr, "kernel_launch: hipFuncSetAttribute failed\n"); grid = -1; return; }
        (void)hipOccupancyMaxActiveBlocksPerMultiprocessor(&per_cu, (const void*)mega_fwd, NWAVES * 64, LDS_BYTES);
        (void)hipGetLastError();
        grid = cus;
        if (grid != 256) { fprintf(stderr, "kernel_launch: built for 256 CUs, got %d\n", cus); grid = -1; return; }
    }
    if (grid < 0) return;
    (void)hipMemsetAsync((char*)d_ws + WS_CTL, 0, CTL_ZERO_BYTES, stream);
    Args a{};
    for (int i = 0; i < 23; ++i) a.in[i] = (const float*)d_in[i];
    a.out = (float*)d_out; a.ws = (unsigned char*)d_ws;
#ifdef DIAG
    {
        const int his[12] = {0, 2, 3, 6, 15, 10, 6, 9, 2, 2, 5, 9};
        const int grids[12] = {0, 64, 2, 2, 16, 64, 64, 64, 64, 64, 64, 64}, blocks[12] = {0, 256, 128, 128, 256, 256, 256, 256, 256, 256, 256, 256};
        a.ph_lo = 0; a.ph_hi = his[DIAG];
        hipLaunchKernelGGL(mega_fwd, dim3(grid), dim3(NWAVES * 64), LDS_BYTES, stream, a);
        static int once = 0; if (!once) { once = 1; (void)hipFuncSetAttribute((const void*)diag_kernel, hipFuncAttributeMaxDynamicSharedMemorySize, 81920); }
        DArgs da{}; for (int i = 0; i < 23; ++i) da.in[i] = (const float*)d_in[i]; da.out = (float*)d_out; da.ws = (unsigned char*)d_ws; da.mode = DIAG; da.pad = 0;
        hipLaunchKernelGGL(diag_kernel, dim3(grids[DIAG]), dim3(blocks[DIAG]), 81920, stream, da);
        if (DIAG == 2 || DIAG == 3) {
            a.ph_lo = his[DIAG]; a.ph_hi = his[DIAG] + 1;
            hipLaunchKernelGGL(mega_fwd, dim3(grid), dim3(NWAVES * 64), LDS_BYTES, stream, a);
            da.mode = DIAG + 10;
            hipLaunchKernelGGL(diag_kernel, dim3(2), dim3(128), 81920, stream, da);
        }
        hipLaunchKernelGGL(diag_fill, dim3(1024), dim3(256), 0, stream, (float*)d_out, (unsigned char*)d_ws, out_size);
    }
#elif N_LAUNCH_MODE == 1
    a.ph_lo = 0; a.ph_hi = NPHASE;
    hipLaunchKernelGGL(mega_fwd, dim3(grid), dim3(NWAVES * 64), LDS_BYTES, stream, a);
#else
    for (int p = 0; p < NPHASE; ++p) { a.ph_lo = p; a.ph_hi = p + 1; hipLaunchKernelGGL(mega_fwd, dim3(grid), dim3(NWAVES * 64), LDS_BYTES, stream, a); }
#endif
}
```

```cpp
#include <hip/hip_runtime.h>
#include <cstdio>
#include <cstdint>

#define LAS __attribute__((address_space(3)))
#define GAS __attribute__((address_space(1)))
typedef unsigned short bf16;
typedef short bf16x8 __attribute__((ext_vector_type(8)));
typedef float f32x4 __attribute__((ext_vector_type(4)));
typedef float f32x2 __attribute__((ext_vector_type(2)));
typedef unsigned u32x4 __attribute__((ext_vector_type(4)));
typedef unsigned u32x2 __attribute__((ext_vector_type(2)));
#define RLX_AGENT __ATOMIC_RELAXED, __HIP_MEMORY_SCOPE_AGENT
#define LDS_WAIT() asm volatile("s_waitcnt lgkmcnt(0)" ::: "memory")
#define VM_WAIT() asm volatile("s_waitcnt vmcnt(0)" ::: "memory")

constexpr int NB = 4, SEQ = 8192, T = NB * SEQ, D = 1024, DEPTH = 2;
constexpr int DIN = 7200;
constexpr int MIXW = 512, NHEAD = 4, HD = 128, CH = 64, NCH = SEQ / CH;
constexpr int MLQK = 64;
constexpr int NEXP = 32, DEXP = 512;
constexpr float LN_EPS = 1e-5f, NORM_EPS = 1e-6f;
constexpr float ALPHA = 1.41421356237309515f;
constexpr int NWAVES = 8;
constexpr int NREC = NB * NHEAD * NCH * 2;

constexpr int C_QKV = 0, C_Z = 1536, C_A = 2048, C_B = 2056, C_POOL = 2064, C_MQ = 2576, C_MK = 2832, C_MV = 3088, C_MO = 3600, C_I = 4112, C_F = 4120, C_GATE = 4128;

constexpr size_t MiB = 1u << 20;
constexpr size_t WS_CTL = 0, CTL_ZERO_BYTES = 64 * 1024;
constexpr int CW_BAR = 4096;
constexpr size_t WS_HIST = 1 * MiB;
constexpr size_t WS_EID = WS_HIST + 64 * 1024;
constexpr size_t WS_EW = WS_EID + 256 * 1024;
constexpr size_t WS_POS = WS_EW + 256 * 1024;
constexpr size_t WS_ROWW = WS_POS + 256 * 1024;
constexpr size_t WS_GL = WS_ROWW + 512 * 1024;
constexpr size_t WS_WIN = 4 * MiB;
constexpr size_t WS_WGATE = 12 * MiB;
constexpr size_t WS_WBR = 18 * MiB;
constexpr size_t WS_WOUT = 21 * MiB;
constexpr size_t WS_HB = 24 * MiB;
constexpr size_t WS_SG = 88 * MiB;
constexpr size_t WS_DEN = 92 * MiB;
constexpr size_t WS_R1 = 93 * MiB;
constexpr size_t WS_PQKV = WS_R1;
constexpr size_t WS_OF = WS_R1, WS_OB = WS_R1 + 32 * MiB;
constexpr size_t WS_MRGP = WS_R1;
constexpr size_t WS_W13 = WS_R1, WS_W2 = WS_R1 + 64 * MiB;
constexpr size_t WS_R2 = 189 * MiB;
constexpr size_t DNREC = 73728;
constexpr size_t DN_W = 0, DN_QG = 16384, DN_KDT = 32768, DN_ATT = 49152, DN_UF = 57344;
constexpr size_t WS_PZ = 189 * MiB, WS_PPOOL = 221 * MiB, WS_PMQ = 253 * MiB, WS_PMK = 269 * MiB, WS_PMV = 285 * MiB, WS_PMO = 317 * MiB;
constexpr size_t WS_YP = 349 * MiB;
constexpr size_t WS_NUMF = 253 * MiB, WS_NUMB = 285 * MiB;
constexpr size_t WS_ML = 381 * MiB;
constexpr size_t MLREC = 44032;
constexpr size_t ML_Q = 0, ML_ST = 8192, ML_KWT = 16384, ML_VF = 24576, ML_ROW = 43008;
constexpr size_t WS_GATE = 381 * MiB;
constexpr size_t WS_XS = 189 * MiB, WS_ACT = 333 * MiB, WS_YROWS = 405 * MiB;
constexpr size_t WS_END = 573 * MiB;
constexpr int MOE_ROWS = 73728;
static_assert(WS_ML + (size_t)NREC * MLREC <= WS_END + 15 * MiB, "ml records");
static_assert(WS_YROWS + (size_t)MOE_ROWS * 1024 * 2 <= WS_END, "moe rows");

constexpr int RING_BYTES = 131072;
constexpr int MISC_OFF = RING_BYTES + 320;
constexpr int LHIST_OFF = RING_BYTES + 1024;
constexpr int LPE_OFF = RING_BYTES + 2048;
constexpr int LARG_OFF = RING_BYTES + 4096;
constexpr int LDS_BYTES = 147456;

__device__ __forceinline__ float bf2f(unsigned b) { return __uint_as_float(b << 16); }
__device__ __forceinline__ unsigned f2bf(float f) { unsigned u = __float_as_uint(f); return (u + 0x7fffu + ((u >> 16) & 1u)) >> 16; }
__device__ __forceinline__ unsigned pk2(float lo, float hi) { return f2bf(lo) | (f2bf(hi) << 16); }
__device__ __forceinline__ float wave_sum(float v) {
#pragma unroll
    for (int o = 1; o < 64; o <<= 1) v += __shfl_xor(v, o);
    return v;
}
__device__ __forceinline__ float wave_max(float v) {
#pragma unroll
    for (int o = 1; o < 64; o <<= 1) v = fmaxf(v, __shfl_xor(v, o));
    return v;
}
__device__ __forceinline__ float fexp(float x) { return __builtin_amdgcn_exp2f(x * 1.44269504089f); }
__device__ __forceinline__ float sigmoidf_(float x) { return 1.0f / (1.0f + expf(-x)); }
__device__ __forceinline__ float siluf_(float x) { return x / (1.0f + expf(-x)); }
__device__ __forceinline__ float softplusf_(float x) { return fmaxf(x, 0.f) + log1pf(expf(-fabsf(x))); }
__device__ __forceinline__ float logsigmoidf_(float x) { return fminf(x, 0.f) - log1pf(expf(-fabsf(x))); }
__host__ __device__ __forceinline__ int sigma32(int p) { const int fq = p >> 3, j = p & 7; return 16 * (j >> 2) + 4 * fq + (j & 3); }

#define XB_TMO      128
#define XB_XCNT(j)  (256  + 64 * (j))
#define XB_XSUB(j)  (1280 + 64 * (j))
#define XB_XGEN(j)  (2304 + 64 * (j))
#define XB_TOP      3328
#define XB_TOPGEN   3392
#define XCD_BAR_WORDS 3456
#define XB_SPIN_CAP (1u << 20)
__device__ __forceinline__ unsigned xb_ld(unsigned* p)              { return __hip_atomic_load(p, __ATOMIC_RELAXED, __HIP_MEMORY_SCOPE_AGENT); }
__device__ __forceinline__ unsigned xb_add(unsigned* p, unsigned v) { return __hip_atomic_fetch_add(p, v, __ATOMIC_RELAXED, __HIP_MEMORY_SCOPE_AGENT); }
__device__ __forceinline__ unsigned xb_xcc_id() { return (unsigned)__builtin_amdgcn_s_getreg((3 << 11) | 20) & 0xFu; }
#define XB_SPIN(cond, bar) do { unsigned _sp = 0; while (cond) { __builtin_amdgcn_s_sleep(1); \
    if ((++_sp & 255u) == 0u) { if (xb_ld(&(bar)[XB_TMO])) break; if (_sp > XB_SPIN_CAP) { atomicAdd(&(bar)[XB_TMO], 1u); break; } } } } while (0)
struct XcdBarrier { unsigned* bar; unsigned x; volatile LAS unsigned* st; };
__device__ __forceinline__ XcdBarrier xcd_barrier_post(unsigned* bar, volatile LAS unsigned* st) {
    XcdBarrier b; b.bar = bar; b.x = xb_xcc_id(); b.st = st;
    if (threadIdx.x == 0) (void)xb_add(&bar[XB_XCNT(b.x)], 1u);
    return b;
}
__device__ __forceinline__ void xcd_barrier_complete(unsigned* bar, unsigned x, unsigned& nloc, unsigned& nx) {
    const unsigned G = 256u;
    unsigned sum, cnt, mine, sp = 0u;
    for (;;) {
        sum = 0u; cnt = 0u; mine = 0u;
#pragma unroll
        for (unsigned j = 0; j < 16; ++j) { const unsigned c = xb_ld(&bar[XB_XCNT(j)]); sum += c; cnt += (c > 0u) ? 1u : 0u; mine = (j == x) ? c : mine; }
        if (sum == G) break;
        __builtin_amdgcn_s_sleep(1);
        if ((++sp & 255u) == 0u) { if (xb_ld(&bar[XB_TMO])) break; if (sp > XB_SPIN_CAP) { atomicAdd(&bar[XB_TMO], 1u); break; } }
    }
    nloc = mine > 0u ? mine : 1u; nx = cnt > 0u ? cnt : 1u;
}
__device__ __forceinline__ void xcd_barrier(const XcdBarrier& b, const int tid) {
    asm volatile("s_waitcnt vmcnt(0)" ::: "memory");
    __syncthreads();
    if (tid == 0) {
        unsigned* bar = b.bar;
        __builtin_amdgcn_s_waitcnt(0);
        unsigned nloc = b.st[0], nx = b.st[1];
        if (nloc == 0u) { xcd_barrier_complete(bar, b.x, nloc, nx); b.st[0] = nloc; b.st[1] = nx; }
        const unsigned old = xb_add(&bar[XB_XSUB(b.x)], 1u);
        const unsigned gen = old / nloc;
        if (old + 1u == (gen + 1u) * nloc) {
            __builtin_amdgcn_fence(__ATOMIC_RELEASE, "agent");
            asm volatile("s_waitcnt vmcnt(0)" ::: "memory");
            const unsigned og = xb_add(&bar[XB_TOP], 1u);
            const unsigned tg = og / nx;
            if (og + 1u == (tg + 1u) * nx) xb_add(&bar[XB_TOPGEN], 1u);
            else XB_SPIN(xb_ld(&bar[XB_TOPGEN]) == tg, bar);
            __builtin_amdgcn_fence(__ATOMIC_ACQUIRE, "agent");
            xb_add(&bar[XB_XGEN(b.x)], 1u);
            asm volatile("s_waitcnt vmcnt(0)" ::: "memory");
        } else {
            XB_SPIN(xb_ld(&bar[XB_XGEN(b.x)]) == gen, bar);
            __builtin_amdgcn_fence(__ATOMIC_ACQUIRE, "agent");
            asm volatile("s_waitcnt vmcnt(0)" ::: "memory");
        }
    }
    __syncthreads();
}

namespace pg8 {
constexpr int BM = 256, BK = 64, HALF = 128, HTB = HALF * BK * 2, STAGE_BYTES = 8 * HTB, NXCD = 8, WGM = 8;
__host__ __device__ __forceinline__ int lds_byte(int r, int c) { const int st = (r >> 4) * 2 + (c >> 5), rr = r & 15, cc = c & 31, ob = rr * 64 + cc * 2; return st * 1024 + (ob ^ (((ob >> 9) & 1) << 5)); }
__host__ __device__ __forceinline__ void stage_rc(int b, int& R, int& C) { const int st = b / 1024, sb = b % 1024, swz = sb ^ (((sb >> 9) & 1) << 5); R = (st >> 1) * 16 + swz / 64; C = (st & 1) * 32 + (swz % 64) / 2; }
__host__ __device__ __forceinline__ int perm32(int rho) { const int n = rho >> 4, i = rho & 15; return 8 * (i >> 2) + 4 * n + (i & 3); }

struct Unit { int pm, pn, aux; const char* A; const char* B; };

__device__ __forceinline__ void tile_of(int L, int nM, int nN, int& pm, int& pn) {
    const int nwg = nM * nN; int wgid = L;
    { const int q = nwg / NXCD, r = nwg % NXCD, xcd = wgid % NXCD, off = wgid / NXCD; wgid = (xcd < r ? xcd * (q + 1) : r * (q + 1) + (xcd - r) * q) + off; }
    const int nig = WGM * nN, gid = wgid / nig, fm = gid * WGM, gsz = (nM - fm) < WGM ? (nM - fm) : WGM;
    pm = fm + ((wgid % nig) % gsz); pn = (wgid % nig) / gsz;
}
struct StaticOrder {
    const char* A; const char* Bt; int nM, nN, nwg, G, c; size_t tstep;
    __device__ __forceinline__ void init(const void* A_, const void* Bt_, int M, int N, int K, int G_, int c_) { A = (const char*)A_; Bt = (const char*)Bt_; nM = M / BM; nN = N / BM; nwg = nM * nN; G = G_; c = c_; tstep = (size_t)BM * K * 2; }
    __device__ __forceinline__ bool next(int i, Unit& u) const {
        const long L = (long)i * G + c; if (L >= nwg) return false;
        tile_of((int)L, nM, nN, u.pm, u.pn); u.aux = 0; u.A = A + (size_t)u.pm * tstep; u.B = Bt + (size_t)u.pn * tstep; return true;
    }
};

typedef float f32x2_t __attribute__((ext_vector_type(2))); typedef __bf16 bf16x2_t __attribute__((ext_vector_type(2)));
__device__ __forceinline__ unsigned cvt_pk_bf16(float lo, float hi) { f32x2_t v = {lo, hi}; bf16x2_t b = __builtin_convertvector(v, bf16x2_t); return __builtin_bit_cast(unsigned, b); }

template <class Epi, class Sched, bool ALIGN_EPI = true, bool SP2 = true>
__device__ __forceinline__ void gemm_phase(LAS unsigned char* lds, const int tid, const int K, const Sched& S, const Epi& E) {
    const int wid = __builtin_amdgcn_readfirstlane(tid >> 6), lane = tid & 63, wr = wid >> 2, wc = wid & 3, fr = lane & 15, fq = lane >> 4;
    const int nt = K / BK;
    unsigned voffA, voffB;
    { int R, C; stage_rc(tid * 16, R, C); const int Rb = Epi::PERM ? ((R & ~31) + perm32(R & 31)) : R;
        voffA = (unsigned)(R * K + C) * 2u; voffB = (unsigned)(Rb * K + C) * 2u; }
    const size_t pstep = (size_t)64 * K * 2;
    const size_t kstep = (size_t)(BK * 2);
    const size_t hstep = (size_t)HALF * K * 2;
    const unsigned ldsw = (unsigned)wid * 1024u;
    const int aoff = lds_byte(wr * 64 + fr, fq * 8), boff = lds_byte(wc * 32 + fr, fq * 8);
#define PG8_SA(b, h) (((b) * 2 + (h)) * HTB)
#define PG8_SB(b, h) ((4 + (b) * 2 + (h)) * HTB)
#define PG8_STAGE(bufoff, gbase, voff) do { _Pragma("unroll") for (int _i = 0; _i < 2; ++_i) \
        __builtin_amdgcn_global_load_lds((const unsigned*)((const char*)(gbase) + _i * pstep + (voff)), (LAS unsigned*)(lds + (bufoff) + ldsw + _i * 8192), 16, 0, 0); } while (0)
#define PG8_LDA(dst, b, h) do { _Pragma("unroll") for (int m = 0; m < 4; ++m) _Pragma("unroll") for (int k = 0; k < 2; ++k) dst[m][k] = *(const LAS bf16x8*)(lds + PG8_SA(b, h) + aoff + m * 2048 + k * 1024); } while (0)
#define PG8_LDB(dst, b, h) do { _Pragma("unroll") for (int n = 0; n < 2; ++n) _Pragma("unroll") for (int k = 0; k < 2; ++k) dst[n][k] = *(const LAS bf16x8*)(lds + PG8_SB(b, h) + boff + n * 2048 + k * 1024); } while (0)
#define PG8_MMA(ai, bj, At, Bt) do { __builtin_amdgcn_s_setprio(1); _Pragma("unroll") for (int m = 0; m < 4; ++m) _Pragma("unroll") for (int n = 0; n < 2; ++n) _Pragma("unroll") for (int k = 0; k < 2; ++k) \
        acc[ai][bj][m][n] = __builtin_amdgcn_mfma_f32_16x16x32_bf16(Bt[n][k], At[m][k], acc[ai][bj][m][n], 0, 0, 0); __builtin_amdgcn_s_setprio(0); } while (0)
#define PG8_WAIT_V(n) asm volatile("s_waitcnt vmcnt(" #n ")" ::: "memory")
#define PG8_WAIT_L(n) asm volatile("s_waitcnt lgkmcnt(" #n ")" ::: "memory")
#define PG8_BAR __builtin_amdgcn_s_barrier()
#define PG8_SCHED __builtin_amdgcn_sched_barrier(0)
    Unit cur, nxt; int ui = 0;
    if (!S.next(0, cur)) return;
    f32x4 acc[2][2][4][2];
#pragma unroll
    for (int a = 0; a < 2; ++a)
#pragma unroll
        for (int b = 0; b < 2; ++b)
#pragma unroll
            for (int m = 0; m < 4; ++m)
#pragma unroll
                for (int n = 0; n < 2; ++n) acc[a][b][m][n] = (f32x4){0.f, 0.f, 0.f, 0.f};
    bf16x8 At[4][2], B0[2][2], B1[2][2];
    const char* cA = cur.A; const char* cB = cur.B;
    if constexpr (SP2) {
        PG8_STAGE(PG8_SB(0, 0), cB, voffB); PG8_STAGE(PG8_SB(0, 1), cB + hstep, voffB); PG8_STAGE(PG8_SA(0, 0), cA, voffA); PG8_STAGE(PG8_SA(0, 1), cA + hstep, voffA);
        if (wr == 1) PG8_BAR;
        PG8_WAIT_V(2); PG8_BAR;
        PG8_STAGE(PG8_SB(1, 0), cB + kstep, voffB); PG8_STAGE(PG8_SA(1, 0), cA + kstep, voffA); PG8_STAGE(PG8_SB(1, 1), cB + hstep + kstep, voffB);
        PG8_WAIT_V(6); PG8_BAR;
    } else {
        PG8_STAGE(PG8_SB(0, 0), cB, voffB); PG8_STAGE(PG8_SA(0, 0), cA, voffA); PG8_STAGE(PG8_SB(0, 1), cB + hstep, voffB); PG8_STAGE(PG8_SA(0, 1), cA + hstep, voffA);
        if (wr == 1) PG8_BAR;
        PG8_WAIT_V(4); PG8_BAR;
        PG8_STAGE(PG8_SB(1, 0), cB + kstep, voffB); PG8_STAGE(PG8_SA(1, 0), cA + kstep, voffA); PG8_STAGE(PG8_SB(1, 1), cB + hstep + kstep, voffB);
        PG8_WAIT_V(6); PG8_BAR;
    }
    for (;;) {
        const bool has_next = S.next(ui + 1, nxt);
        const char* nA = has_next ? nxt.A : cA; const char* nB = has_next ? nxt.B : cB;
        for (int t = 0; t < nt; t += 2) {
            const bool last = (t == nt - 2);
            const char* a1 = cA + (size_t)(t + 1) * kstep;
            const char* a2 = last ? nA : cA + (size_t)(t + 2) * kstep; const char* b2 = last ? nB : cB + (size_t)(t + 2) * kstep;
            const char* a3 = a2 + kstep; const char* b3 = b2 + kstep;
            if constexpr (SP2) {
            PG8_LDB(B0, 0, 0); PG8_LDB(B1, 0, 1); PG8_SCHED; PG8_LDA(At, 0, 0); PG8_STAGE(PG8_SA(1, 1), a1 + hstep, voffA);
            PG8_WAIT_V(8); PG8_WAIT_L(0); PG8_BAR; PG8_MMA(0, 0, At, B0); PG8_MMA(0, 1, At, B1); PG8_BAR; PG8_SCHED;
            PG8_LDA(At, 0, 1); PG8_STAGE(PG8_SB(0, 0), b2, voffB); PG8_STAGE(PG8_SB(0, 1), b2 + hstep, voffB); PG8_STAGE(PG8_SA(0, 0), a2, voffA);
            PG8_WAIT_V(8); PG8_WAIT_L(0); PG8_BAR; PG8_MMA(1, 0, At, B0); PG8_MMA(1, 1, At, B1); PG8_BAR; PG8_SCHED;
            PG8_LDB(B0, 1, 0); PG8_LDB(B1, 1, 1); PG8_SCHED; PG8_LDA(At, 1, 0); PG8_STAGE(PG8_SA(0, 1), a2 + hstep, voffA);
            PG8_WAIT_V(8); PG8_WAIT_L(0); PG8_BAR; PG8_MMA(0, 0, At, B0); PG8_MMA(0, 1, At, B1); PG8_BAR; PG8_SCHED;
            PG8_LDA(At, 1, 1); PG8_STAGE(PG8_SB(1, 0), b3, voffB); PG8_STAGE(PG8_SB(1, 1), b3 + hstep, voffB); PG8_STAGE(PG8_SA(1, 0), a3, voffA);
            PG8_WAIT_V(8); PG8_WAIT_L(0); PG8_BAR; PG8_MMA(1, 0, At, B0); PG8_MMA(1, 1, At, B1); PG8_BAR; PG8_SCHED;
            } else {
            PG8_LDB(B0, 0, 0); PG8_SCHED; PG8_LDA(At, 0, 0); PG8_STAGE(PG8_SA(1, 1), a1 + hstep, voffA);
            PG8_WAIT_L(8); PG8_BAR; PG8_WAIT_L(0); PG8_MMA(0, 0, At, B0); PG8_BAR; PG8_SCHED;
            PG8_LDB(B1, 0, 1); PG8_STAGE(PG8_SB(0, 0), b2, voffB);
            PG8_BAR; PG8_WAIT_L(0); PG8_MMA(0, 1, At, B1); PG8_BAR;
            PG8_LDA(At, 0, 1); PG8_STAGE(PG8_SA(0, 0), a2, voffA);
            PG8_BAR; PG8_WAIT_L(0); PG8_MMA(1, 0, At, B0); PG8_BAR; PG8_SCHED;
            PG8_STAGE(PG8_SB(0, 1), b2 + hstep, voffB);
            PG8_WAIT_V(6); PG8_BAR; PG8_MMA(1, 1, At, B1); PG8_BAR;
            PG8_LDB(B0, 1, 0); PG8_SCHED; PG8_LDA(At, 1, 0); PG8_STAGE(PG8_SA(0, 1), a2 + hstep, voffA);
            PG8_WAIT_L(8); PG8_BAR; PG8_WAIT_L(0); PG8_MMA(0, 0, At, B0); PG8_BAR; PG8_SCHED;
            PG8_LDB(B1, 1, 1); PG8_STAGE(PG8_SB(1, 0), b3, voffB);
            PG8_BAR; PG8_WAIT_L(0); PG8_MMA(0, 1, At, B1); PG8_BAR;
            PG8_LDA(At, 1, 1); PG8_STAGE(PG8_SA(1, 0), a3, voffA);
            PG8_BAR; PG8_WAIT_L(0); PG8_MMA(1, 0, At, B0); PG8_BAR; PG8_SCHED;
            PG8_STAGE(PG8_SB(1, 1), b3 + hstep, voffB);
            PG8_WAIT_V(6); PG8_BAR; PG8_MMA(1, 1, At, B1); PG8_BAR;
            }
        }
        if constexpr (ALIGN_EPI) { if (wr == 0) PG8_BAR; }
        E(acc, cur, wr, wc, fr, fq);
        if (!has_next) break;
#pragma unroll
        for (int a = 0; a < 2; ++a)
#pragma unroll
            for (int b = 0; b < 2; ++b)
#pragma unroll
                for (int m = 0; m < 4; ++m)
#pragma unroll
                    for (int n = 0; n < 2; ++n) acc[a][b][m][n] = (f32x4){0.f, 0.f, 0.f, 0.f};
        cur = nxt; cA = nA; cB = nB; ++ui;
        if constexpr (ALIGN_EPI) { if (wr == 1) PG8_BAR; }
    }
    PG8_WAIT_V(0);
    if constexpr (!ALIGN_EPI) { if (wr == 0) PG8_BAR; }
    PG8_BAR;
#undef PG8_SA
#undef PG8_SB
#undef PG8_STAGE
#undef PG8_LDA
#undef PG8_LDB
#undef PG8_MMA
#undef PG8_WAIT_V
#undef PG8_WAIT_L
#undef PG8_BAR
#undef PG8_SCHED
}
}

using pg8::Unit; using pg8::cvt_pk_bf16; using pg8::HALF; using pg8::BM;

struct EpiG1a {
    static constexpr bool PERM = true;
    bf16* O;
    __device__ __forceinline__ void operator()(const f32x4 (&acc)[2][2][4][2], const Unit& u, int wr, int wc, int fr, int fq) const {
        const int row0 = u.pm * BM + wr * 64 + fr, col0 = u.pn * BM + wc * 32 + 8 * fq;
#pragma unroll
        for (int ai = 0; ai < 2; ++ai)
#pragma unroll
            for (int m = 0; m < 4; ++m) { bf16* rowp = O + (size_t)(row0 + ai * HALF + m * 16) * 1536 + col0;
#pragma unroll
                for (int bj = 0; bj < 2; ++bj) { const f32x4 v0 = acc[ai][bj][m][0], v1 = acc[ai][bj][m][1];
                    u32x4 w; w.x = cvt_pk_bf16(v0[0], v0[1]); w.y = cvt_pk_bf16(v0[2], v0[3]); w.z = cvt_pk_bf16(v1[0], v1[1]); w.w = cvt_pk_bf16(v1[2], v1[3]);
                    *(u32x4*)(rowp + bj * HALF) = w; } }
    }
};
struct EpiG1b {
    static constexpr bool PERM = true;
    unsigned char* ws;
    __device__ __forceinline__ void operator()(const f32x4 (&acc)[2][2][4][2], const Unit& u, int wr, int wc, int fr, int fq) const {
        const int pn = u.pn; size_t off; int ld, ct;
        if (pn < 2) { off = WS_PZ; ld = 512; ct = pn; } else if (pn < 4) { off = WS_PPOOL; ld = 512; ct = pn - 2; } else if (pn == 4) { off = WS_PMQ; ld = 256; ct = 0; }
        else if (pn == 5) { off = WS_PMK; ld = 256; ct = 0; } else if (pn < 8) { off = WS_PMV; ld = 512; ct = pn - 6; } else { off = WS_PMO; ld = 512; ct = pn - 8; }
        bf16* O = (bf16*)(ws + off);
        const int row0 = u.pm * BM + wr * 64 + fr, col0 = ct * BM + wc * 32 + 8 * fq;
#pragma unroll
        for (int ai = 0; ai < 2; ++ai)
#pragma unroll
            for (int m = 0; m < 4; ++m) { bf16* rowp = O + (size_t)(row0 + ai * HALF + m * 16) * ld + col0;
#pragma unroll
                for (int bj = 0; bj < 2; ++bj) { const f32x4 v0 = acc[ai][bj][m][0], v1 = acc[ai][bj][m][1];
                    u32x4 w; w.x = cvt_pk_bf16(v0[0], v0[1]); w.y = cvt_pk_bf16(v0[2], v0[3]); w.z = cvt_pk_bf16(v1[0], v1[1]); w.w = cvt_pk_bf16(v1[2], v1[3]);
                    *(u32x4*)(rowp + bj * HALF) = w; } }
    }
};
__device__ __forceinline__ float fast_sigmoid(float x) { return __builtin_amdgcn_rcpf(1.0f + __builtin_amdgcn_exp2f(-1.44269504089f * x)); }
struct EpiGate {
    static constexpr bool PERM = true;
    bf16* O;
    __device__ __forceinline__ void operator()(const f32x4 (&acc)[2][2][4][2], const Unit& u, int wr, int wc, int fr, int fq) const {
        const int row0 = u.pm * BM + wr * 64 + fr, col0 = u.pn * BM + wc * 32 + 8 * fq;
#pragma unroll
        for (int ai = 0; ai < 2; ++ai)
#pragma unroll
            for (int m = 0; m < 4; ++m) { bf16* rowp = O + (size_t)(row0 + ai * HALF + m * 16) * 3072 + col0;
#pragma unroll
                for (int bj = 0; bj < 2; ++bj) { f32x4 v0 = acc[ai][bj][m][0], v1 = acc[ai][bj][m][1];
#pragma unroll
                    for (int j = 0; j < 4; ++j) { v0[j] = fast_sigmoid(v0[j]); v1[j] = fast_sigmoid(v1[j]); }
                    u32x4 w; w.x = cvt_pk_bf16(v0[0], v0[1]); w.y = cvt_pk_bf16(v0[2], v0[3]); w.z = cvt_pk_bf16(v1[0], v1[1]); w.w = cvt_pk_bf16(v1[2], v1[3]);
                    *(u32x4*)(rowp + bj * HALF) = w; } }
    }
};
__device__ __forceinline__ void unpack8(const u32x4 w, float (&f)[8]) {
    f[0] = __uint_as_float(w.x << 16); f[1] = __uint_as_float(w.x & 0xffff0000u); f[2] = __uint_as_float(w.y << 16); f[3] = __uint_as_float(w.y & 0xffff0000u);
    f[4] = __uint_as_float(w.z << 16); f[5] = __uint_as_float(w.z & 0xffff0000u); f[6] = __uint_as_float(w.w << 16); f[7] = __uint_as_float(w.w & 0xffff0000u);
}
struct EpiMerge {
    static constexpr bool PERM = true;
    const bf16* GATE; bf16* PART; bf16* FIN;
    __device__ __forceinline__ void operator()(const f32x4 (&acc)[2][2][4][2], const Unit& u, int wr, int wc, int fr, int fq) const {
        const int r = u.aux;
        const int row0 = u.pm * BM + wr * 64 + fr, col0 = u.pn * BM + wc * 32 + 8 * fq;
#pragma unroll
        for (int ai = 0; ai < 2; ++ai)
#pragma unroll
            for (int m = 0; m < 4; ++m) { const size_t row = (size_t)(row0 + ai * HALF + m * 16);
#pragma unroll
                for (int bj = 0; bj < 2; ++bj) { const f32x4 v0 = acc[ai][bj][m][0], v1 = acc[ai][bj][m][1];
                    const int c = col0 + bj * HALF;
                    const u32x4 gw = *(const u32x4*)(GATE + row * 3072 + r * 1024 + c);
                    float g[8]; unpack8(gw, g);
                    float o[8];
                    o[0] = v0[0] * g[0]; o[1] = v0[1] * g[1]; o[2] = v0[2] * g[2]; o[3] = v0[3] * g[3];
                    o[4] = v1[0] * g[4]; o[5] = v1[1] * g[5]; o[6] = v1[2] * g[6]; o[7] = v1[3] * g[7];
                    if (r > 0) { const u32x4 pw = *(const u32x4*)(PART + row * 1024 + c); float p[8]; unpack8(pw, p);
#pragma unroll
                        for (int j = 0; j < 8; ++j) o[j] += p[j]; }
                    u32x4 w; w.x = cvt_pk_bf16(o[0], o[1]); w.y = cvt_pk_bf16(o[2], o[3]); w.z = cvt_pk_bf16(o[4], o[5]); w.w = cvt_pk_bf16(o[6], o[7]);
                    bf16* dst = (r == 2) ? FIN : PART;
                    *(u32x4*)(dst + row * 1024 + c) = w; } }
    }
};
struct EpiOut {
    static constexpr bool PERM = false;
    float* C;
    __device__ __forceinline__ void operator()(const f32x4 (&acc)[2][2][4][2], const Unit& u, int wr, int wc, int fr, int fq) const {
        const int row0 = u.pm * BM + wr * 64 + fr, col0 = u.pn * BM + wc * 32 + 4 * fq;
#pragma unroll
        for (int ai = 0; ai < 2; ++ai)
#pragma unroll
            for (int m = 0; m < 4; ++m) { float* rowp = C + (size_t)(row0 + ai * HALF + m * 16) * D + col0;
#pragma unroll
                for (int bj = 0; bj < 2; ++bj)
#pragma unroll
                    for (int n = 0; n < 2; ++n) { f32x4* p = (f32x4*)(rowp + bj * HALF + n * 16); const f32x4 old = *p; *p = old * ALPHA + acc[ai][bj][m][n]; } }
    }
};
struct EpiMoe1 {
    static constexpr bool PERM = true;
    bf16* ACT;
    __device__ __forceinline__ void operator()(const f32x4 (&acc)[2][2][4][2], const Unit& u, int wr, int wc, int fr, int fq) const {
        const int row0 = u.pm * BM + wr * 64 + fr, col0 = u.pn * 128 + wc * 32 + 8 * fq;
#pragma unroll
        for (int ai = 0; ai < 2; ++ai)
#pragma unroll
            for (int m = 0; m < 4; ++m) { bf16* rowp = ACT + (size_t)(row0 + ai * HALF + m * 16) * DEXP + col0;
                float o[8];
#pragma unroll
                for (int n = 0; n < 2; ++n)
#pragma unroll
                    for (int j = 0; j < 4; ++j) { const float a = acc[ai][0][m][n][j], b = acc[ai][1][m][n][j]; o[n * 4 + j] = a * fast_sigmoid(a) * b; }
                u32x4 w; w.x = cvt_pk_bf16(o[0], o[1]); w.y = cvt_pk_bf16(o[2], o[3]); w.z = cvt_pk_bf16(o[4], o[5]); w.w = cvt_pk_bf16(o[6], o[7]);
                *(u32x4*)rowp = w; }
    }
};
struct EpiMoe2 {
    static constexpr bool PERM = true;
    bf16* Y; const float* roww;
    __device__ __forceinline__ void operator()(const f32x4 (&acc)[2][2][4][2], const Unit& u, int wr, int wc, int fr, int fq) const {
        const int row0 = u.pm * BM + wr * 64 + fr, col0 = u.pn * BM + wc * 32 + 8 * fq;
#pragma unroll
        for (int ai = 0; ai < 2; ++ai)
#pragma unroll
            for (int m = 0; m < 4; ++m) { const int row = row0 + ai * HALF + m * 16; const float rw = roww[row]; bf16* rowp = Y + (size_t)row * D + col0;
#pragma unroll
                for (int bj = 0; bj < 2; ++bj) { const f32x4 v0 = acc[ai][bj][m][0] * rw, v1 = acc[ai][bj][m][1] * rw;
                    u32x4 w; w.x = cvt_pk_bf16(v0[0], v0[1]); w.y = cvt_pk_bf16(v0[2], v0[3]); w.z = cvt_pk_bf16(v1[0], v1[1]); w.w = cvt_pk_bf16(v1[2], v1[3]);
                    *(u32x4*)(rowp + bj * HALF) = w; } }
    }
};

struct MergeOrder {
    const char* Y[3]; const char* W; int G, c;
    __device__ __forceinline__ bool next(int i, Unit& u) const {
        const int j = i / 3, r = i - 3 * j; const int L = j * G + c; if (L >= 128 * 4) return false;
        pg8::tile_of(L, 128, 4, u.pm, u.pn); u.aux = r;
        const char* y = (r == 0) ? Y[0] : ((r == 1) ? Y[1] : Y[2]);
        u.A = y + (size_t)u.pm * (256 * 512 * 2); u.B = W + (size_t)r * (1024 * 512 * 2) + (size_t)u.pn * (256 * 512 * 2); return true;
    }
};
template <int KDIM> struct MoeOrder {
    const char* A; const char* W; const LAS int* pe; int c, NP;
    __device__ __forceinline__ bool next(int i, Unit& u) const {
        const int L = i * 256 + c; if (L >= NP * 4) return false;
        const int p = L >> 2, pn = L & 3; const int e = __builtin_amdgcn_readfirstlane(pe[p]);
        u.pm = p; u.pn = pn; u.aux = e; u.A = A + (size_t)p * (256 * KDIM * 2); u.B = W + (size_t)e * (1024 * KDIM * 2) + (size_t)pn * (256 * KDIM * 2); return true;
    }
};

struct Args {
    const float* in[23]; float* out; unsigned char* ws; int ph_lo, ph_hi;
};
struct Frame {
    LAS unsigned char* lds; int tid, lane, wave, G, wg;
    float* out; unsigned char* ws;
};
__device__ __forceinline__ const float* inp_lds(LAS unsigned char* lds, int i) {
    const unsigned long long v = ((const LAS unsigned long long*)(lds + LARG_OFF))[i];
    const unsigned lo = __builtin_amdgcn_readfirstlane((unsigned)v), hi = __builtin_amdgcn_readfirstlane((unsigned)(v >> 32));
    return (const float*)(((unsigned long long)hi << 32) | lo);
}
__device__ __forceinline__ const float* inp(const Frame& F, int i) { return inp_lds(F.lds, i); }
__device__ __forceinline__ Frame fresh(LAS unsigned char* lds, int wave) {
    Frame F; int wgx = blockIdx.x; unsigned lb = (unsigned)(unsigned long long)lds;
    asm volatile("" : "+s"(wave), "+s"(wgx), "+s"(lb));
    F.lds = (LAS unsigned char*)(unsigned long long)lb;
    F.wave = wave; F.lane = (int)__builtin_amdgcn_mbcnt_hi(~0u, __builtin_amdgcn_mbcnt_lo(~0u, 0u)); F.tid = wave * 64 + F.lane;
    F.G = 256; F.wg = wgx;
    F.out = (float*)inp_lds(F.lds, 23); F.ws = (unsigned char*)inp_lds(F.lds, 24);
    return F;
}
enum { I_X = 0, I_LN_IN_G, I_LN_IN_B, I_W_IN, I_CONV, I_A_LOG, I_DT_BIAS, I_DN_NORM, I_POOL_W, I_POOL_SCALE, I_ML_GATE_B, I_ML_NORM, I_W_BRANCH, I_W_OUT, I_LN_MIX_G, I_LN_MIX_B,
       I_ROUTER_W, I_ROUTER_B, I_MOE_W1, I_MOE_W3, I_MOE_W2, I_LN_FFN_G, I_LN_FFN_B };

__device__ __forceinline__ void tr_item(const float* W, int ldw, int k0, int n0src, bf16* WT, int dpitch, int drow0, LAS float* scr, int lane) {
#pragma unroll 8
    for (int i = 0; i < 32; ++i) { const int kk = 2 * i + (lane >> 5); scr[kk * 33 + (lane & 31)] = W[(size_t)(k0 + kk) * ldw + n0src + (lane & 31)]; }
    LDS_WAIT(); asm volatile("" ::: "memory");
    const int c = lane & 7;
#pragma unroll
    for (int j = 0; j < 4; ++j) { const int n = (lane >> 3) + 8 * j; const LAS float* s = scr + (8 * c) * 33 + n;
        u32x4 o; o.x = pk2(s[0 * 33], s[1 * 33]); o.y = pk2(s[2 * 33], s[3 * 33]); o.z = pk2(s[4 * 33], s[5 * 33]); o.w = pk2(s[6 * 33], s[7 * 33]);
        *(u32x4*)(WT + (size_t)(drow0 + n) * dpitch + k0 + 8 * c) = o; }
    LDS_WAIT(); asm volatile("" ::: "memory");
}
__device__ __forceinline__ void tr_segment(const Frame& F, const float* W, int ldw, int K, int n0src, int ncols, bf16* WT, int drow0, int& it) {
    LAS float* scr = (LAS float*)(F.lds + F.wave * 16384);
    const int gw = F.wg * NWAVES + F.wave, NGW = F.G * NWAVES;
    const int nblk = ncols / 32, nitems = (K / 64) * nblk;
    int first = (gw - (it % NGW) + NGW) % NGW;
    for (int r = first; r < nitems; r += NGW) { const int kb = r / nblk, nb = r % nblk; tr_item(W, ldw, 64 * kb, n0src + 32 * nb, WT, K, drow0 + 32 * nb, scr, F.lane); }
    it += nitems;
}
__device__ __forceinline__ void wprep_mixer(const Frame& F, int l) {
    const float* win = inp(F, I_W_IN) + (size_t)l * D * DIN; int it = 0;
    bf16* Wi = (bf16*)(F.ws + WS_WIN); bf16* Wg = (bf16*)(F.ws + WS_WGATE); bf16* Wb = (bf16*)(F.ws + WS_WBR); bf16* Wo = (bf16*)(F.ws + WS_WOUT);
    tr_segment(F, win, DIN, D, C_QKV, 1536, Wi, 0, it);
    tr_segment(F, win, DIN, D, C_Z, 512, Wi, 1536, it);
    tr_segment(F, win, DIN, D, C_POOL, 512, Wi, 2048, it);
    tr_segment(F, win, DIN, D, C_MQ, 256, Wi, 2560, it);
    tr_segment(F, win, DIN, D, C_MK, 256, Wi, 2816, it);
    tr_segment(F, win, DIN, D, C_MV, 512, Wi, 3072, it);
    tr_segment(F, win, DIN, D, C_MO, 512, Wi, 3584, it);
    tr_segment(F, win, DIN, D, C_GATE, 3072, Wg, 0, it);
    const float* wbr = inp(F, I_W_BRANCH) + (size_t)l * 3 * MIXW * D;
    tr_segment(F, wbr, D, MIXW, 0, D, Wb, 0, it);
    tr_segment(F, wbr + (size_t)2 * MIXW * D, D, MIXW, 0, D, Wb + (size_t)2 * D * MIXW, 0, it);
    tr_segment(F, inp(F, I_W_OUT) + (size_t)l * D * D, D, D, 0, D, Wo, 0, it);
    const float* pw = inp(F, I_POOL_W) + (size_t)l * 4 * 128 * 128; const float* ps = inp(F, I_POOL_SCALE) + (size_t)l * MIXW; const float* wb1 = wbr + (size_t)MIXW * D;
    bf16* W1 = Wb + (size_t)D * MIXW;
    for (int idx = F.wg * 512 + F.tid; idx < D * MIXW; idx += F.G * 512) {
        const int m = idx >> 10, d = idx & 1023, g = m >> 7, c = m & 127;
        float s = 0.f;
        for (int dd = 0; dd < 128; ++dd) s += pw[(g * 128 + c) * 128 + dd] * ps[g * 128 + dd] * wb1[(size_t)(g * 128 + dd) * D + d];
        W1[(size_t)d * MIXW + m] = (bf16)f2bf(s);
    }
}
__device__ __forceinline__ void wprep_moe(const Frame& F, int l) {
    bf16* W13 = (bf16*)(F.ws + WS_W13); bf16* W2 = (bf16*)(F.ws + WS_W2);
    LAS float* scr = (LAS float*)(F.lds + F.wave * 16384);
    const int gw = F.wg * NWAVES + F.wave, NGW = F.G * NWAVES;
    for (int r = gw; r < NEXP * 2 * 256; r += NGW) {
        const int e = r >> 9, which = (r >> 8) & 1, kb = (r >> 4) & 15, nb = r & 15, n0 = nb * 32;
        const float* W = inp(F, which ? I_MOE_W3 : I_MOE_W1) + ((size_t)l * NEXP + e) * D * DEXP;
        tr_item(W, DEXP, 64 * kb, n0, W13 + (size_t)e * D * D, D, (n0 >> 7) * 256 + which * 128 + (n0 & 127), scr, F.lane);
    }
    for (int r = gw; r < NEXP * 256; r += NGW) {
        const int e = r >> 8, kb = (r >> 5) & 7, nb = r & 31;
        const float* W = inp(F, I_MOE_W2) + ((size_t)l * NEXP + e) * DEXP * D;
        tr_item(W, D, 64 * kb, 32 * nb, W2 + (size_t)e * D * DEXP, DEXP, 32 * nb, scr, F.lane);
    }
}

__device__ __forceinline__ int w32_addr(int k, int c4) { return (k >> 1) * 256 + (((((k & 1) << 3) | c4) ^ ((k >> 1) & 15)) << 4); }
__device__ __forceinline__ void stage_w32(const Frame& F, const float* src, int ldw, bool gates) {
    for (int idx = F.tid; idx < D * 8; idx += 512) {
        const int k = idx >> 3, c4 = idx & 7;
        int col = 4 * c4;
        if (gates) col = (c4 < 2) ? (C_A + 4 * c4) : (c4 < 4) ? (C_B + 4 * (c4 - 2)) : (c4 < 6) ? (C_I + 4 * (c4 - 4)) : (C_F + 4 * (c4 - 6));
        const f32x4 v = *(const f32x4*)(src + (size_t)k * ldw + col);
        *(LAS f32x4*)(F.lds + w32_addr(k, c4)) = v;
    }
}
template <int MODE>
__device__ __forceinline__ void ln_phase(const Frame& F, const float* gam, const float* bet, const float* w32src, int w32ld, bool do_proj, bool write_hb, bool dummy = false) {
    float* OUTP = dummy ? (float*)(F.ws + WS_R2) : F.out; unsigned char* WSO = dummy ? (F.ws + WS_R2 + 40 * MiB) : F.ws;
    LAS int* lhist = (LAS int*)(F.lds + LHIST_OFF);
    if (do_proj) stage_w32(F, w32src, w32ld, MODE != 1);
    if (MODE == 1 && F.tid < 32) lhist[F.tid] = 0;
    __syncthreads();
    const int lane = F.lane;
    f32x2 gv[8], bv[8];
#pragma unroll
    for (int m = 0; m < 8; ++m) { gv[m] = *(const f32x2*)(gam + 2 * lane + 128 * m); bv[m] = *(const f32x2*)(bet + 2 * lane + 128 * m); }
    bf16* hb = dummy ? (bf16*)(F.ws + WS_R2 + 128 * MiB) : (bf16*)(F.ws + WS_HB);
    const int rows_per_wg = T / F.G;
    for (int i = 0; i < rows_per_wg / NWAVES; ++i) {
        const int row = F.wg * rows_per_wg + F.wave * (rows_per_wg / NWAVES) + i;
        f32x2 v[8];
        if (MODE == 0) {
#pragma unroll
            for (int m = 0; m < 8; ++m) v[m] = *(const f32x2*)(inp(F, I_X) + (size_t)row * D + 2 * lane + 128 * m);
        } else if (MODE == 1) {
#pragma unroll
            for (int m = 0; m < 8; ++m) v[m] = *(const f32x2*)(F.out + (size_t)row * D + 2 * lane + 128 * m);
        } else {
            const int* pos = (const int*)(F.ws + WS_POS); const int p0 = pos[2 * row], p1 = pos[2 * row + 1];
            const bf16* Y = (const bf16*)(F.ws + WS_YROWS);
#pragma unroll
            for (int m = 0; m < 8; ++m) {
                const f32x2 o = *(const f32x2*)(F.out + (size_t)row * D + 2 * lane + 128 * m);
                const unsigned a = *(const unsigned*)(Y + (size_t)p0 * D + 2 * lane + 128 * m), b = *(const unsigned*)(Y + (size_t)p1 * D + 2 * lane + 128 * m);
                v[m].x = ALPHA * o.x + bf2f(a & 0xffffu) + bf2f(b & 0xffffu); v[m].y = ALPHA * o.y + bf2f(a >> 16) + bf2f(b >> 16);
            }
        }
        float s = 0.f;
#pragma unroll
        for (int m = 0; m < 8; ++m) s += v[m].x + v[m].y;
        const float mean = wave_sum(s) * (1.f / D);
        float s2 = 0.f;
#pragma unroll
        for (int m = 0; m < 8; ++m) { v[m].x -= mean; v[m].y -= mean; s2 += v[m].x * v[m].x + v[m].y * v[m].y; }
        const float rstd = 1.0f / sqrtf(wave_sum(s2) * (1.f / D) + LN_EPS);
#pragma unroll
        for (int m = 0; m < 8; ++m) { v[m].x = v[m].x * rstd * gv[m].x + bv[m].x; v[m].y = v[m].y * rstd * gv[m].y + bv[m].y; }
#pragma unroll
        for (int m = 0; m < 8; ++m) *(f32x2*)(OUTP + (size_t)row * D + 2 * lane + 128 * m) = v[m];
        if (write_hb) {
#pragma unroll
            for (int m = 0; m < 8; ++m) *(unsigned*)(hb + (size_t)row * D + 2 * lane + 128 * m) = pk2(v[m].x, v[m].y);
        }
        if (!do_proj) continue;
        float acc[32];
#pragma unroll
        for (int c = 0; c < 32; ++c) acc[c] = 0.f;
#pragma unroll
        for (int m = 0; m < 8; ++m) {
#pragma unroll
            for (int e = 0; e < 2; ++e) {
                asm volatile("" ::: "memory");
                const int k = 2 * lane + 128 * m + e; const float xv = e ? v[m].y : v[m].x;
#pragma unroll
                for (int c4 = 0; c4 < 8; ++c4) { const f32x4 w = *(const LAS f32x4*)(F.lds + w32_addr(k, c4));
                    acc[4 * c4 + 0] += xv * w[0]; acc[4 * c4 + 1] += xv * w[1]; acc[4 * c4 + 2] += xv * w[2]; acc[4 * c4 + 3] += xv * w[3]; }
            }
        }
        float r16[16], r8[8], r4[4], r2[2], r1;
        { const bool hi = (lane & 32) != 0;
#pragma unroll
          for (int j = 0; j < 16; ++j) { const float a = acc[j], b = acc[j + 16]; const float send = hi ? a : b, keep = hi ? b : a; r16[j] = keep + __shfl_xor(send, 32); } }
        { const bool hi = (lane & 16) != 0;
#pragma unroll
          for (int j = 0; j < 8; ++j) { const float a = r16[j], b = r16[j + 8]; const float send = hi ? a : b, keep = hi ? b : a; r8[j] = keep + __shfl_xor(send, 16); } }
        { const bool hi = (lane & 8) != 0;
#pragma unroll
          for (int j = 0; j < 4; ++j) { const float a = r8[j], b = r8[j + 4]; const float send = hi ? a : b, keep = hi ? b : a; r4[j] = keep + __shfl_xor(send, 8); } }
        { const bool hi = (lane & 4) != 0;
#pragma unroll
          for (int j = 0; j < 2; ++j) { const float a = r4[j], b = r4[j + 2]; const float send = hi ? a : b, keep = hi ? b : a; r2[j] = keep + __shfl_xor(send, 4); } }
        { const bool hi = (lane & 2) != 0; const float a = r2[0], b = r2[1]; const float send = hi ? a : b, keep = hi ? b : a; r1 = keep + __shfl_xor(send, 2); }
        r1 += __shfl_xor(r1, 1);
        if (MODE != 1) {
            if ((lane & 1) == 0) ((float*)(WSO + WS_SG))[(size_t)row * 32 + (lane >> 1)] = r1;
        } else {
            const float score = sigmoidf_(r1);
            const float sel = score + inp(F, I_ROUTER_B)[lane >> 1];
            const int gb = lane & ~7;
            const float v0 = __shfl(sel, gb + 0), v1 = __shfl(sel, gb + 2), v2 = __shfl(sel, gb + 4), v3 = __shfl(sel, gb + 6);
            int i1 = 0; float m1 = v0;
            if (v1 > m1) { m1 = v1; i1 = 1; } if (v2 > m1) { m1 = v2; i1 = 2; } if (v3 > m1) { m1 = v3; i1 = 3; }
            int i2 = -1; float m2 = -3.0e38f;
            if (i1 != 0 && v0 > m2) { m2 = v0; i2 = 0; } if (i1 != 1 && v1 > m2) { m2 = v1; i2 = 1; } if (i1 != 2 && v2 > m2) { m2 = v2; i2 = 2; } if (i1 != 3 && v3 > m2) { m2 = v3; i2 = 3; }
            float gs = m1 + m2; int gi = lane >> 3;
#pragma unroll
            for (int o = 8; o < 64; o <<= 1) { const float og = __shfl_xor(gs, o); const int oi = __shfl_xor(gi, o); if (og > gs || (og == gs && oi < gi)) { gs = og; gi = oi; } }
            const int src = gi * 8;
            const int e1 = gi * 4 + __shfl(i1, src), e2 = gi * 4 + __shfl(i2, src);
            const float s1 = __shfl(score, 2 * e1), s2 = __shfl(score, 2 * e2);
            if (lane == 0) {
                int* eid = (int*)(WSO + WS_EID); float* ew = (float*)(WSO + WS_EW);
                const float inv = 1.0f / (s1 + s2);
                eid[2 * row] = e1; eid[2 * row + 1] = e2; ew[2 * row] = s1 * inv; ew[2 * row + 1] = s2 * inv;
                __hip_atomic_fetch_add(lhist + e1, 1, __ATOMIC_RELAXED, __HIP_MEMORY_SCOPE_WORKGROUP); __hip_atomic_fetch_add(lhist + e2, 1, __ATOMIC_RELAXED, __HIP_MEMORY_SCOPE_WORKGROUP);
            }
        }
    }
    if (MODE == 1) {
        __syncthreads();
        if (F.tid < 32) ((int*)(WSO + WS_HIST))[F.wg * 32 + F.tid] = lhist[F.tid];
    }
    __syncthreads();
}

__device__ __forceinline__ int invsigma32(int w) { return 8 * ((w >> 2) & 3) + 4 * (w >> 4) + (w & 3); }
__device__ __forceinline__ float wave_incl_scan(float v, int lane) {
#pragma unroll
    for (int o = 1; o < 64; o <<= 1) { const float t = __shfl_up(v, o); if (lane >= o) v += t; }
    return v;
}
__device__ __forceinline__ float wave_incl_maxscan(float v, int lane) {
#pragma unroll
    for (int o = 1; o < 64; o <<= 1) { const float t = __shfl_up(v, o); if (lane >= o) v = fmaxf(v, t); }
    return v;
}
constexpr int DQ_OFF = 0, DK_OFF = 17408, DV_OFF = 34816, DGM_OFF = 52224, DQK_OFF = 69632, DTM_OFF = 87040, DVEC_OFF = 121856;
constexpr int QROW = 272;
constexpr int FROW = 68;
__device__ __forceinline__ bf16x8 pack_b(const f32x4 lo, const f32x4 hi) {
    u32x4 w; w.x = cvt_pk_bf16(lo[0], lo[1]); w.y = cvt_pk_bf16(lo[2], lo[3]); w.z = cvt_pk_bf16(hi[0], hi[1]); w.w = cvt_pk_bf16(hi[2], hi[3]);
    return __builtin_bit_cast(bf16x8, w);
}
__device__ __forceinline__ bf16x8 pack8f(const float (&f)[8]) {
    u32x4 w; w.x = cvt_pk_bf16(f[0], f[1]); w.y = cvt_pk_bf16(f[2], f[3]); w.z = cvt_pk_bf16(f[4], f[5]); w.w = cvt_pk_bf16(f[6], f[7]);
    return __builtin_bit_cast(bf16x8, w);
}
#define PREP_BAR() do { asm volatile("s_waitcnt lgkmcnt(0)" ::: "memory"); __builtin_amdgcn_s_barrier(); asm volatile("" ::: "memory"); } while (0)
__device__ __forceinline__ void dn_prep(const Frame& F, int l) {
    LAS unsigned char* L = F.lds;
    const int lane = F.lane, wave = F.wave, tid = F.tid, fr = lane & 15, fq = lane >> 4;
    const bf16* P = (const bf16*)(F.ws + WS_PQKV);
    const float* SG = (const float*)(F.ws + WS_SG);
    const float* cw = inp(F, I_CONV) + (size_t)l * 5 * 1536;
    LAS float* GM = (LAS float*)(L + DGM_OFF); LAS float* QKM = (LAS float*)(L + DQK_OFF);
    for (int item = F.wg; item < NB * NHEAD * NCH; item += F.G) {
        const int b = item >> 9, h = (item >> 7) & 3, n = item & 127;
        const int t0 = b * SEQ + n * CH;
        {
            float w[3][5][2];
#pragma unroll
            for (int p = 0; p < 3; ++p)
#pragma unroll
                for (int j = 0; j < 5; ++j) { const f32x2 t = *(const f32x2*)(cw + j * 1536 + p * 512 + h * 128 + 2 * lane); w[p][j][0] = t.x; w[p][j][1] = t.y; }
            unsigned raw[12][3];
#pragma unroll
            for (int rr = 0; rr < 12; ++rr) {
                const int sp = n * CH + 8 * wave + rr - 2;
                const bool ok = (sp >= 0 && sp < SEQ);
                const bf16* src = P + (size_t)(b * SEQ + (ok ? sp : 0)) * 1536 + h * 128 + 2 * lane;
#pragma unroll
                for (int p = 0; p < 3; ++p) { const unsigned u = *(const unsigned*)(src + p * 512); raw[rr][p] = ok ? u : 0u; }
            }
#pragma unroll
            for (int ii = 0; ii < 8; ++ii) {
                const int i = 8 * wave + ii;
                float y[3][2];
#pragma unroll
                for (int p = 0; p < 3; ++p) { y[p][0] = 0.f; y[p][1] = 0.f; }
#pragma unroll
                for (int j = 0; j < 5; ++j)
#pragma unroll
                    for (int p = 0; p < 3; ++p) { const unsigned u = raw[ii + j][p]; y[p][0] += bf2f(u & 0xffffu) * w[p][j][0]; y[p][1] += bf2f(u >> 16) * w[p][j][1]; }
#pragma unroll
                for (int p = 0; p < 3; ++p) { y[p][0] = y[p][0] * fast_sigmoid(y[p][0]); y[p][1] = y[p][1] * fast_sigmoid(y[p][1]); }
                const float sq = wave_sum(y[0][0] * y[0][0] + y[0][1] * y[0][1]), sk = wave_sum(y[1][0] * y[1][0] + y[1][1] * y[1][1]);
                const float rq = (1.0f / sqrtf(sq + NORM_EPS)) * 0.08838834764831845f, rk = 1.0f / sqrtf(sk + NORM_EPS);
                *(LAS unsigned*)(L + DQ_OFF + i * QROW + 4 * lane) = pk2(y[0][0] * rq, y[0][1] * rq);
                *(LAS unsigned*)(L + DK_OFF + i * QROW + 4 * lane) = pk2(y[1][0] * rk, y[1][1] * rk);
                *(LAS unsigned*)(L + DV_OFF + i * QROW + 4 * lane) = pk2(y[2][0], y[2][1]);
            }
            if (wave < 2) {
                const int d = wave; const int ti = d ? 63 - lane : lane;
                const float a = SG[(size_t)(t0 + ti) * 32 + d * 4 + h], bb = SG[(size_t)(t0 + ti) * 32 + 8 + d * 4 + h];
                const float beta = sigmoidf_(bb);
                const float g = -expf(inp(F, I_A_LOG)[l * 8 + d * 4 + h]) * softplusf_(a + inp(F, I_DT_BIAS)[l * 8 + d * 4 + h]);
                const float gc = wave_incl_scan(g, lane);
                const float gl = __shfl(gc, 63);
                LAS float* vec = (LAS float*)(L + DVEC_OFF + d * 1024);
                vec[lane] = beta; vec[64 + lane] = gc; vec[128 + lane] = expf(gc); vec[192 + lane] = expf(gl - gc);
                if (lane == 63) ((float*)(F.ws + WS_GL))[(size_t)item * 2 + d] = expf(gc);
            }
        }
        PREP_BAR();
        {
#pragma unroll
            for (int tt = 0; tt < 2; ++tt) {
                const int t = 2 * wave + tt, mt = t >> 2, nt = t & 3;
                f32x4 ag = (f32x4){0.f, 0.f, 0.f, 0.f}, aq = (f32x4){0.f, 0.f, 0.f, 0.f};
#pragma unroll
                for (int s = 0; s < 4; ++s) {
                    const bf16x8 ka = *(const LAS bf16x8*)(L + DK_OFF + (16 * mt + fr) * QROW + 64 * s + 16 * fq);
                    const bf16x8 qa = *(const LAS bf16x8*)(L + DQ_OFF + (16 * mt + fr) * QROW + 64 * s + 16 * fq);
                    const bf16x8 kb = *(const LAS bf16x8*)(L + DK_OFF + (16 * nt + fr) * QROW + 64 * s + 16 * fq);
                    ag = __builtin_amdgcn_mfma_f32_16x16x32_bf16(ka, kb, ag, 0, 0, 0);
                    aq = __builtin_amdgcn_mfma_f32_16x16x32_bf16(qa, kb, aq, 0, 0, 0);
                }
#pragma unroll
                for (int r = 0; r < 4; ++r) { GM[(16 * mt + 4 * fq + r) * FROW + 16 * nt + fr] = ag[r]; QKM[(16 * mt + 4 * fq + r) * FROW + 16 * nt + fr] = aq[r]; }
            }
        }
        PREP_BAR();
        {
#pragma unroll 4
            for (int e = 0; e < 16; ++e) {
                const int idx = tid + 512 * e, d = idx >> 12, i = (idx >> 6) & 63, j = idx & 63;
                const LAS float* vec = (const LAS float*)(L + DVEC_OFF + d * 1024);
                const int ti = d ? 63 - i : i, tj = d ? 63 - j : j;
                float v = (j < i) ? vec[i] * GM[ti * FROW + tj] * fexp(fminf(vec[64 + i] - vec[64 + j], 0.f)) : 0.f;
                if (i == 0) v = (j == 0) ? 1.f : 0.f;
                *(LAS float*)(L + DTM_OFF + d * 17408 + (i * FROW + j) * 4) = v;
            }
        }
        PREP_BAR();
        if (wave < 2) {
            LAS float* TM = (LAS float*)(L + DTM_OFF + wave * 17408);
#define SUBST_PART(NB4, BASE) do { f32x4 m4[NB4]; float tv_[4 * NB4]; \
                _Pragma("unroll") for (int q = 0; q < NB4; ++q) m4[q] = *(const LAS f32x4*)(TM + i * FROW + (BASE) + 4 * q); \
                _Pragma("unroll") for (int q = 0; q < 4 * NB4; ++q) tv_[q] = TM[((BASE) + q) * FROW + lane]; \
                _Pragma("unroll") for (int q = 0; q < NB4; ++q) { a0 -= m4[q][0] * tv_[4 * q]; a1 -= m4[q][1] * tv_[4 * q + 1]; a2 -= m4[q][2] * tv_[4 * q + 2]; a3 -= m4[q][3] * tv_[4 * q + 3]; } } while (0)
#define SUBST_END() do { const float tv = ((lane == i) ? 1.f : 0.f) + ((a0 + a1) + (a2 + a3)); asm volatile("s_waitcnt lgkmcnt(0)" ::: "memory"); TM[i * FROW + lane] = tv; } while (0)
#pragma unroll 1
            for (int i = 1; i < 16; ++i) { float a0 = 0.f, a1 = 0.f, a2 = 0.f, a3 = 0.f; SUBST_PART(4, 0); SUBST_END(); }
#pragma unroll 1
            for (int i = 16; i < 32; ++i) { float a0 = 0.f, a1 = 0.f, a2 = 0.f, a3 = 0.f; SUBST_PART(4, 0); asm volatile("" ::: "memory"); SUBST_PART(4, 16); SUBST_END(); }
#pragma unroll 1
            for (int i = 32; i < 64; ++i) { float a0 = 0.f, a1 = 0.f, a2 = 0.f, a3 = 0.f; SUBST_PART(4, 0); asm volatile("" ::: "memory"); SUBST_PART(4, 16); asm volatile("" ::: "memory"); SUBST_PART(4, 32); asm volatile("" ::: "memory"); SUBST_PART(4, 48); SUBST_END(); }
#undef SUBST_PART
#undef SUBST_END
        } else {
            const int t2 = tid - 128;
            for (int idx = t2; idx < 40960; idx += 384) {
                if (idx < 16384) {
                    const int d = idx >> 13, i = (idx >> 7) & 63, p = idx & 127; const int kk = (p & ~31) + sigma32(p & 31), ti = d ? 63 - i : i;
                    const LAS float* vec = (const LAS float*)(L + DVEC_OFF + d * 1024);
                    const float v = bf2f(*(const LAS unsigned short*)(L + DQ_OFF + ti * QROW + 2 * kk)) * vec[128 + i];
                    ((bf16*)(F.ws + WS_R2 + ((size_t)item * 2 + d) * DNREC + DN_QG))[i * 128 + p] = (bf16)f2bf(v);
                } else if (idx < 32768) {
                    const int q = idx - 16384, d = q >> 13, kk = (q >> 6) & 127, p = q & 63; const int j = (p & ~31) + sigma32(p & 31), tj = d ? 63 - j : j;
                    const LAS float* vec = (const LAS float*)(L + DVEC_OFF + d * 1024);
                    const float v = bf2f(*(const LAS unsigned short*)(L + DK_OFF + tj * QROW + 2 * kk)) * vec[192 + j];
                    ((bf16*)(F.ws + WS_R2 + ((size_t)item * 2 + d) * DNREC + DN_KDT))[kk * 64 + p] = (bf16)f2bf(v);
                } else {
                    const int q = idx - 32768, d = q >> 12, i = (q >> 6) & 63, p = q & 63; const int j = (p & ~31) + sigma32(p & 31), ti = d ? 63 - i : i, tj = d ? 63 - j : j;
                    const LAS float* vec = (const LAS float*)(L + DVEC_OFF + d * 1024);
                    const float v = (j <= i) ? QKM[ti * FROW + tj] * fexp(fminf(vec[64 + i] - vec[64 + j], 0.f)) : 0.f;
                    ((bf16*)(F.ws + WS_R2 + ((size_t)item * 2 + d) * DNREC + DN_ATT))[i * 64 + p] = (bf16)f2bf(v);
                }
            }
        }
        PREP_BAR();
#pragma unroll 1
        for (int d = 0; d < 2; ++d) {
            const LAS float* TM = (const LAS float*)(L + DTM_OFF + d * 17408);
            const LAS float* vec = (const LAS float*)(L + DVEC_OFF + d * 1024);
            unsigned char* rec = F.ws + WS_R2 + ((size_t)item * 2 + d) * DNREC;
            bf16x8 ta[4][2];
#pragma unroll
            for (int mt = 0; mt < 4; ++mt)
#pragma unroll
                for (int s = 0; s < 2; ++s) { const f32x4 lo = *(const LAS f32x4*)(TM + (16 * mt + fr) * FROW + 32 * s + 8 * fq), hi = *(const LAS f32x4*)(TM + (16 * mt + fr) * FROW + 32 * s + 8 * fq + 4); ta[mt][s] = pack_b(lo, hi); }
#pragma unroll 1
            for (int tt = 0; tt < 2; ++tt) {
                const int nt = 2 * wave + tt; const bool isv = nt < 8; const int col = 16 * (nt & 7) + fr;
                const int imgoff = isv ? DV_OFF : DK_OFF;
                bf16x8 xb[2];
#pragma unroll
                for (int s = 0; s < 2; ++s) { float xf[8];
#pragma unroll
                    for (int e = 0; e < 8; ++e) { const int j = 32 * s + 8 * fq + e, tj = d ? 63 - j : j;
                        const float x = bf2f(*(const LAS unsigned short*)(L + imgoff + tj * QROW + 2 * col));
                        xf[e] = x * vec[j] * (isv ? 1.f : vec[128 + j]); }
                    xb[s] = pack8f(xf); }
                f32x4 acc[4];
#pragma unroll
                for (int mt = 0; mt < 4; ++mt) { acc[mt] = (f32x4){0.f, 0.f, 0.f, 0.f};
#pragma unroll
                    for (int s = 0; s < 2; ++s) acc[mt] = __builtin_amdgcn_mfma_f32_16x16x32_bf16(ta[mt][s], xb[s], acc[mt], 0, 0, 0); }
                if (isv) {
                    bf16* Uf = (bf16*)(rec + DN_UF) + ((nt * 64 + lane) * 16);
#pragma unroll
                    for (int mt = 0; mt < 4; ++mt) { u32x2 w2; w2.x = cvt_pk_bf16(acc[mt][0], acc[mt][1]); w2.y = cvt_pk_bf16(acc[mt][2], acc[mt][3]); *(u32x2*)(Uf + mt * 4) = w2; }
                } else {
                    bf16* Wp = (bf16*)(rec + DN_W); const int pos = (col & ~31) + invsigma32(col & 31);
#pragma unroll
                    for (int mt = 0; mt < 4; ++mt)
#pragma unroll
                        for (int r = 0; r < 4; ++r) Wp[(16 * mt + 4 * fq + r) * 128 + pos] = (bf16)f2bf(acc[mt][r]);
                }
            }
        }
        PREP_BAR();
    }
}

__device__ __forceinline__ int swz256(int row, int c16) { return row * 256 + ((c16 ^ (row & 15)) << 4); }
__device__ __forceinline__ int swz128(int row, int c8) { return (row >> 1) * 256 + (((((row & 1) << 3) | c8) ^ ((row >> 1) & 15)) << 4); }
constexpr int DNBUF = 57344;
#define SCAN_BAR() do { asm volatile("s_waitcnt lgkmcnt(0)" ::: "memory"); __builtin_amdgcn_s_barrier(); asm volatile("" ::: "memory"); } while (0)
__device__ __forceinline__ void dn_scan(const Frame& F) {
    if (F.wg >= 64) return;
    const int xcd = F.wg & 7, idx = F.wg >> 3;
    const int chain = xcd * 4 + (idx >> 1), hf = idx & 1;
    const int b = chain >> 3, h = (chain >> 1) & 3, d = chain & 1;
    const int lane = F.lane, fr = lane & 15, fq = lane >> 4, wave = F.wave;
    LAS unsigned char* L = F.lds;
    const unsigned char* recbase = F.ws + WS_R2;
    const int itembase = (b * NHEAD + h) * NCH;
    if (wave >= 4) {
        const int tl = F.tid - 256;
        u32x4 ra[14], rb[14];
        int woff[14];
#pragma unroll
        for (int i = 0; i < 14; ++i) { const int q = tl + 256 * i;
            if (i < 4) woff[i] = swz256(q >> 4, q & 15); else if (i < 8) woff[i] = 16384 + swz256((q - 1024) >> 4, q & 15);
            else if (i < 12) woff[i] = 32768 + swz128((q - 2048) >> 3, q & 7); else woff[i] = 49152 + swz128((q - 3072) >> 3, q & 7); }
#define DN_LOAD(R, step_) do { const int st_ = (step_) < NCH ? (step_) : NCH - 1; const int n_ = d ? (NCH - 1 - st_) : st_; \
        const u32x4* src_ = (const u32x4*)(recbase + ((size_t)(itembase + n_) * 2 + d) * DNREC) + tl; \
        _Pragma("unroll") for (int i = 0; i < 14; ++i) R[i] = src_[256 * i]; } while (0)
#define DN_WRITE(R, bufoff_) do { _Pragma("unroll") for (int i = 0; i < 14; ++i) *(LAS u32x4*)(L + (bufoff_) + woff[i]) = R[i]; } while (0)
        DN_LOAD(ra, 0); DN_LOAD(rb, 1);
        DN_WRITE(ra, 0);
        SCAN_BAR();
        for (int s = 0; s < NCH; s += 2) {
            DN_LOAD(ra, s + 2); DN_WRITE(rb, DNBUF); SCAN_BAR();
            DN_LOAD(rb, s + 3); DN_WRITE(ra, 0);     SCAN_BAR();
        }
#undef DN_LOAD
#undef DN_WRITE
        return;
    }
    const int slice = hf * 4 + wave;
    const float* GL = (const float*)(F.ws + WS_GL);
    bf16* O = (bf16*)(F.ws + (d ? WS_OB : WS_OF));
    f32x4 S[8];
#pragma unroll
    for (int k = 0; k < 8; ++k) S[k] = (f32x4){0.f, 0.f, 0.f, 0.f};
    int offw[4], offk[8], offa[4];
#pragma unroll
    for (int t = 0; t < 4; ++t) { offw[t] = (16 * t + fr) * 256; offa[t] = ((16 * t + fr) >> 1) * 256; }
#pragma unroll
    for (int t = 0; t < 8; ++t) offk[t] = ((16 * t + fr) >> 1) * 256;
    const int x256 = fr & 15;
    const int x128 = (fr >> 1) & 15, p128 = (fr & 1) << 3;
    u32x4 uc0, uc1, un0, un1; float egl_c, egl_n;
#define DN_UFETCH(A0, A1, EG, step_) do { const int st_ = (step_) < NCH ? (step_) : NCH - 1; const int nn_ = d ? (NCH - 1 - st_) : st_; \
        const bf16* Uf_ = (const bf16*)(recbase + ((size_t)(itembase + nn_) * 2 + d) * DNREC + DN_UF); A0 = *(const u32x4*)(Uf_ + (slice * 64 + lane) * 16); A1 = *(const u32x4*)(Uf_ + (slice * 64 + lane) * 16 + 8); \
        EG = GL[(size_t)(itembase + nn_) * 2 + d]; } while (0)
    DN_UFETCH(uc0, uc1, egl_c, 0); DN_UFETCH(un0, un1, egl_n, 1);
    SCAN_BAR();
    for (int step = 0; step < NCH; ++step) {
        const int n = d ? (NCH - 1 - step) : step;
        const int bufoff = (step & 1) ? DNBUF : 0;
        const u32x4 u0 = uc0, u1 = uc1; const float egl = egl_c;
        uc0 = un0; uc1 = un1; egl_c = egl_n;
        DN_UFETCH(un0, un1, egl_n, step + 2);
        const LAS unsigned char* Bw = L + bufoff; const LAS unsigned char* Bq = Bw + 16384; const LAS unsigned char* Bk = Bw + 32768; const LAS unsigned char* Ba = Bw + 49152;
#define LD_WQ(G, s_) do { _Pragma("unroll") for (int mt = 0; mt < 4; ++mt) { const int o_ = offw[mt] + (((4 * (s_) + fq) ^ x256) << 4); G[mt] = *(const LAS bf16x8*)(Bw + o_); G[4 + mt] = *(const LAS bf16x8*)(Bq + o_); } } while (0)
#define MM_WQ(G, s_) do { _Pragma("unroll") for (int mt = 0; mt < 4; ++mt) { V[mt] = __builtin_amdgcn_mfma_f32_16x16x32_bf16(G[mt], SB[s_], V[mt], 0, 0, 0); Q[mt] = __builtin_amdgcn_mfma_f32_16x16x32_bf16(SB[s_], G[4 + mt], Q[mt], 0, 0, 0); } } while (0)
#define LD_K(G, s2_) do { _Pragma("unroll") for (int kt = 0; kt < 8; ++kt) { const int xr_ = (8 * kt + (fr >> 1)) & 15; G[kt] = *(const LAS bf16x8*)(Bk + offk[kt] + (((p128 | (4 * (s2_) + fq)) ^ xr_) << 4)); } } while (0)
#define SCHED_() __builtin_amdgcn_sched_barrier(0)
        bf16x8 g0[8], g1[8];
        LD_WQ(g0, 0);
        bf16x8 SB[4];
#pragma unroll
        for (int s = 0; s < 4; ++s) SB[s] = pack_b(S[2 * s], S[2 * s + 1]);
        f32x4 V[4], Q[4];
#pragma unroll
        for (int mt = 0; mt < 4; ++mt) { V[mt] = (f32x4){0.f, 0.f, 0.f, 0.f}; Q[mt] = (f32x4){0.f, 0.f, 0.f, 0.f}; }
        SCHED_(); LD_WQ(g1, 1); SCHED_(); MM_WQ(g0, 0); SCHED_();
        LD_WQ(g0, 2); SCHED_(); MM_WQ(g1, 1); SCHED_();
        LD_WQ(g1, 3); SCHED_(); MM_WQ(g0, 2); SCHED_();
#pragma unroll
        for (int s2 = 0; s2 < 2; ++s2)
#pragma unroll
            for (int mt = 0; mt < 4; ++mt) { const int xr = (8 * mt + (fr >> 1)) & 15; g0[s2 * 4 + mt] = *(const LAS bf16x8*)(Ba + offa[mt] + (((p128 | (4 * s2 + fq)) ^ xr) << 4)); }
        SCHED_(); MM_WQ(g1, 3); SCHED_();
        LD_K(g1, 0); SCHED_();
        {
            float uu[16]; { float t[8]; unpack8(u0, t);
#pragma unroll
                for (int e = 0; e < 8; ++e) uu[e] = t[e]; unpack8(u1, t);
#pragma unroll
                for (int e = 0; e < 8; ++e) uu[8 + e] = t[e]; }
#pragma unroll
            for (int mt = 0; mt < 4; ++mt)
#pragma unroll
                for (int r = 0; r < 4; ++r) V[mt][r] = uu[mt * 4 + r] - V[mt][r];
        }
        bf16x8 VB[2];
#pragma unroll
        for (int s2 = 0; s2 < 2; ++s2) VB[s2] = pack_b(V[2 * s2], V[2 * s2 + 1]);
#pragma unroll
        for (int kt = 0; kt < 8; ++kt) S[kt] = S[kt] * egl;
        SCHED_();
#pragma unroll
        for (int s2 = 0; s2 < 2; ++s2)
#pragma unroll
            for (int mt = 0; mt < 4; ++mt) Q[mt] = __builtin_amdgcn_mfma_f32_16x16x32_bf16(VB[s2], g0[s2 * 4 + mt], Q[mt], 0, 0, 0);
        SCHED_(); LD_K(g0, 1); SCHED_();
#pragma unroll
        for (int kt = 0; kt < 8; ++kt) S[kt] = __builtin_amdgcn_mfma_f32_16x16x32_bf16(g1[kt], VB[0], S[kt], 0, 0, 0);
        SCHED_();
#pragma unroll
        for (int kt = 0; kt < 8; ++kt) S[kt] = __builtin_amdgcn_mfma_f32_16x16x32_bf16(g0[kt], VB[1], S[kt], 0, 0, 0);
        SCHED_();
#undef LD_WQ
#undef MM_WQ
#undef LD_K
#undef SCHED_
#pragma unroll
        for (int mt = 0; mt < 4; ++mt) {
            const int i = 16 * mt + fr; const int tok = b * SEQ + n * CH + (d ? 63 - i : i);
            u32x2 w2; w2.x = cvt_pk_bf16(Q[mt][0], Q[mt][1]); w2.y = cvt_pk_bf16(Q[mt][2], Q[mt][3]);
            *(u32x2*)(O + (size_t)tok * MIXW + h * HD + slice * 16 + 4 * fq) = w2;
        }
        SCAN_BAR();
    }
}

constexpr int MQ_OFF = 0, MK_OFF = 9216, MV_OFF = 18432, MQK_OFF = 35840, MVEC_OFF = 52480;
constexpr int MQROW = 144;
__device__ __forceinline__ void ml_prep(const Frame& F, int l) {
    LAS unsigned char* L = F.lds;
    const int lane = F.lane, wave = F.wave, tid = F.tid;
    const bf16* PQ = (const bf16*)(F.ws + WS_PMQ); const bf16* PK = (const bf16*)(F.ws + WS_PMK); const bf16* PV = (const bf16*)(F.ws + WS_PMV);
    const float* SG = (const float*)(F.ws + WS_SG);
    const float* gbias = inp(F, I_ML_GATE_B) + l * 16;
    for (int item = F.wg; item < NB * NHEAD * NCH; item += F.G) {
        const int b = item >> 9, h = (item >> 7) & 3, n = item & 127;
        const int t0 = b * SEQ + n * CH;
        {
            const int row = tid >> 3, c8 = tid & 7;
            const u32x4 q = *(const u32x4*)(PQ + (size_t)(t0 + row) * 256 + h * 64 + 8 * c8);
            u32x4 k = *(const u32x4*)(PK + (size_t)(t0 + row) * 256 + h * 64 + 8 * c8);
            { float f[8]; unpack8(k, f); k.x = pk2(f[0] * 0.125f, f[1] * 0.125f); k.y = pk2(f[2] * 0.125f, f[3] * 0.125f); k.z = pk2(f[4] * 0.125f, f[5] * 0.125f); k.w = pk2(f[6] * 0.125f, f[7] * 0.125f); }
            *(LAS u32x4*)(L + MQ_OFF + row * MQROW + 16 * c8) = q;
            *(LAS u32x4*)(L + MK_OFF + row * MQROW + 16 * c8) = k;
#pragma unroll
            for (int e = 0; e < 2; ++e) { const int idx = tid + 512 * e, r = idx >> 4, c = idx & 15;
                *(LAS u32x4*)(L + MV_OFF + r * QROW + 16 * c) = *(const u32x4*)(PV + (size_t)(t0 + r) * 512 + h * 128 + 8 * c); }
        }
        __syncthreads();
        {
            const int j = lane, i0 = wave * 8;
            float qk[8];
#pragma unroll
            for (int ii = 0; ii < 8; ++ii) qk[ii] = 0.f;
            for (int c8 = 0; c8 < 8; ++c8) {
                float kj[8]; unpack8(*(const LAS u32x4*)(L + MK_OFF + j * MQROW + 16 * c8), kj);
#pragma unroll
                for (int ii = 0; ii < 8; ++ii) { float qi[8]; unpack8(*(const LAS u32x4*)(L + MQ_OFF + (i0 + ii) * MQROW + 16 * c8), qi);
#pragma unroll
                    for (int e = 0; e < 8; ++e) qk[ii] += qi[e] * kj[e]; }
            }
#pragma unroll
            for (int ii = 0; ii < 8; ++ii) *(LAS float*)(L + MQK_OFF + ((i0 + ii) * 65 + j) * 4) = qk[ii];
        }
        if (wave < 2) {
            const int d = wave; const int ti = d ? 63 - lane : lane;
            const float ip = SG[(size_t)(t0 + ti) * 32 + 16 + d * 4 + h] + gbias[d * 4 + h];
            const float fp = SG[(size_t)(t0 + ti) * 32 + 24 + d * 4 + h] + gbias[8 + d * 4 + h];
            const float bc = wave_incl_scan(logsigmoidf_(fp), lane);
            const float bl = __shfl(bc, 63);
            const float lw = bl - bc + ip;
            const float am = wave_max(lw);
            const float wgt = expf(lw - am);
            const float ipb = ip - bc;
            const float dmax = bc + wave_incl_maxscan(ipb, lane);
            LAS float* vec = (LAS float*)(L + MVEC_OFF + d * 1024);
            vec[lane] = bc; vec[64 + lane] = dmax; vec[128 + lane] = wgt; vec[192 + lane] = ipb;
            float* row = (float*)(F.ws + WS_ML + ((size_t)item * 2 + d) * MLREC + ML_ROW);
            row[lane] = bc; row[64 + lane] = dmax; if (lane == 0) { row[128] = am; row[129] = bl; }
        }
        __syncthreads();
        {
            const int d = tid >> 8, tt = tid & 255;
            const LAS float* vec = (const LAS float*)(L + MVEC_OFF + d * 1024);
            const LAS float* QKM = (const LAS float*)(L + MQK_OFF);
            unsigned char* rec = F.ws + WS_ML + ((size_t)item * 2 + d) * MLREC;
            bf16* Qp = (bf16*)(rec + ML_Q); bf16* St = (bf16*)(rec + ML_ST); bf16* Kw = (bf16*)(rec + ML_KWT); bf16* Vf = (bf16*)(rec + ML_VF);
#pragma unroll 2
            for (int e = 0; e < 16; ++e) {
                const int idx = tt + 256 * e, i = idx >> 6, j = idx & 63;
                const int ti = d ? 63 - i : i, tj = d ? 63 - j : j;
                const float sv = (j <= i) ? QKM[ti * 65 + tj] * fexp(fminf(vec[i] + vec[192 + j] - vec[64 + i], 0.f)) : 0.f;
                St[i * 64 + j] = (bf16)f2bf(sv);
                Qp[i * 64 + (j & ~31) + invsigma32(j & 31)] = *(const LAS unsigned short*)(L + MQ_OFF + ti * MQROW + 2 * j);
                const float kv = bf2f(*(const LAS unsigned short*)(L + MK_OFF + tj * MQROW + 2 * i));
                Kw[i * 64 + j] = (bf16)f2bf(kv * vec[128 + j]);
            }
#pragma unroll 4
            for (int e = 0; e < 36; ++e) {
                const int idx = tt + 256 * e;
                const int el = idx & 7, lp = (idx >> 3) & 63, s = (idx >> 9) & 1, slice = idx >> 10;
                const int fr = lp & 15, fq = lp >> 4; const int j = 32 * s + 8 * fq + el; const int tj = d ? 63 - j : j;
                const unsigned short v = (slice < 8) ? *(const LAS unsigned short*)(L + MV_OFF + tj * QROW + 2 * (16 * slice + fr)) : (unsigned short)0x3F80;
                Vf[idx] = v;
            }
        }
        __syncthreads();
    }
}

constexpr int MLBUF = 25600;
__device__ __forceinline__ void ml_scan(const Frame& F) {
    if (F.wg >= 64) return;
    const int xcd = F.wg & 7, idx = F.wg >> 3;
    const int chain = xcd * 4 + (idx >> 1), hf = idx & 1;
    const int b = chain >> 3, h = (chain >> 1) & 3, d = chain & 1;
    const int lane = F.lane, fr = lane & 15, fq = lane >> 4, wave = F.wave;
    LAS unsigned char* L = F.lds;
    const unsigned char* recbase = F.ws + WS_ML;
    const int itembase = (b * NHEAD + h) * NCH;
    if (wave >= 5) {
        const int tl = F.tid - 320;
        u32x4 ra[9], rb[9]; int woff[9], goff[9];
#pragma unroll
        for (int i = 0; i < 9; ++i) { const int q = tl + 192 * i;
            if (q < 1536) { const int qq = q & 511; woff[i] = (q >> 9) * 8192 + swz128(qq >> 3, qq & 7); goff[i] = q; }
            else if (q < 1600) { woff[i] = 24576 + (q - 1536) * 16; goff[i] = 2688 + (q - 1536); }
            else { woff[i] = -1; goff[i] = 0; } }
#define ML_LOAD(R, step_) do { const int st_ = (step_) < NCH ? (step_) : NCH - 1; const int n_ = d ? (NCH - 1 - st_) : st_; \
        const u32x4* src_ = (const u32x4*)(recbase + ((size_t)(itembase + n_) * 2 + d) * MLREC); \
        _Pragma("unroll") for (int i = 0; i < 9; ++i) R[i] = src_[goff[i]]; } while (0)
#define ML_WRITE(R, bufoff_) do { _Pragma("unroll") for (int i = 0; i < 9; ++i) if (woff[i] >= 0) *(LAS u32x4*)(L + (bufoff_) + woff[i]) = R[i]; } while (0)
        ML_LOAD(ra, 0); ML_LOAD(rb, 1);
        ML_WRITE(ra, 0);
        SCAN_BAR();
        for (int s = 0; s < NCH; s += 2) {
            ML_LOAD(ra, s + 2); ML_WRITE(rb, MLBUF); SCAN_BAR();
            ML_LOAD(rb, s + 3); ML_WRITE(ra, 0);     SCAN_BAR();
        }
#undef ML_LOAD
#undef ML_WRITE
        return;
    }
    const int slice = (wave < 4) ? hf * 4 + wave : 8;
    const bool active = (wave < 4) || (hf == 1);
    bf16* NUM = (bf16*)(F.ws + (d ? WS_NUMB : WS_NUMF)); float* DEN = (float*)(F.ws + WS_DEN);
    f32x4 C[4];
#pragma unroll
    for (int k = 0; k < 4; ++k) C[k] = (f32x4){0.f, 0.f, 0.f, 0.f};
    float m = 0.f;
    int offr[4];
#pragma unroll
    for (int t = 0; t < 4; ++t) offr[t] = ((16 * t + fr) >> 1) * 256;
    const int p128 = (fr & 1) << 3;
    bf16x8 vc0, vc1, vn0, vn1;
#define ML_VFETCH(A0, A1, step_) do { const int st_ = (step_) < NCH ? (step_) : NCH - 1; const int nn_ = d ? (NCH - 1 - st_) : st_; \
        const bf16* Vf_ = (const bf16*)(recbase + ((size_t)(itembase + nn_) * 2 + d) * MLREC + ML_VF); \
        A0 = *(const bf16x8*)(Vf_ + ((slice * 2 + 0) * 64 + lane) * 8); A1 = *(const bf16x8*)(Vf_ + ((slice * 2 + 1) * 64 + lane) * 8); } while (0)
    ML_VFETCH(vc0, vc1, 0); ML_VFETCH(vn0, vn1, 1);
    SCAN_BAR();
    for (int step = 0; step < NCH; ++step) {
        const int n = d ? (NCH - 1 - step) : step;
        const int bufoff = (step & 1) ? MLBUF : 0;
        bf16x8 VF[2]; VF[0] = vc0; VF[1] = vc1;
        vc0 = vn0; vc1 = vn1;
        ML_VFETCH(vn0, vn1, step + 2);
        if (active) {
        const LAS unsigned char* Bq = L + bufoff; const LAS unsigned char* Bs = Bq + 8192; const LAS unsigned char* Bk = Bq + 16384; const LAS float* row = (const LAS float*)(Bq + 24576);
        const float am = row[128], bl = row[129];
        bf16x8 CB[2];
#pragma unroll
        for (int s = 0; s < 2; ++s) CB[s] = pack_b(C[2 * s], C[2 * s + 1]);
        bf16x8 fq_[8], fs_[8], fk_[8];
#pragma unroll
        for (int s = 0; s < 2; ++s)
#pragma unroll
            for (int mt = 0; mt < 4; ++mt) { const int xr = (8 * mt + (fr >> 1)) & 15; const int o = offr[mt] + (((p128 | (4 * s + fq)) ^ xr) << 4);
                fq_[s * 4 + mt] = *(const LAS bf16x8*)(Bq + o); fs_[s * 4 + mt] = *(const LAS bf16x8*)(Bs + o); fk_[s * 4 + mt] = *(const LAS bf16x8*)(Bk + o); }
        f32x4 QC[4], SV[4], KV[4];
#pragma unroll
        for (int mt = 0; mt < 4; ++mt) { QC[mt] = (f32x4){0.f, 0.f, 0.f, 0.f}; SV[mt] = (f32x4){0.f, 0.f, 0.f, 0.f}; KV[mt] = (f32x4){0.f, 0.f, 0.f, 0.f}; }
#pragma unroll
        for (int s = 0; s < 2; ++s)
#pragma unroll
            for (int mt = 0; mt < 4; ++mt) {
                QC[mt] = __builtin_amdgcn_mfma_f32_16x16x32_bf16(CB[s], fq_[s * 4 + mt], QC[mt], 0, 0, 0);
                SV[mt] = __builtin_amdgcn_mfma_f32_16x16x32_bf16(VF[s], fs_[s * 4 + mt], SV[mt], 0, 0, 0);
                KV[mt] = __builtin_amdgcn_mfma_f32_16x16x32_bf16(fk_[s * 4 + mt], VF[s], KV[mt], 0, 0, 0);
            }
#pragma unroll
        for (int mt = 0; mt < 4; ++mt) {
            const int i = 16 * mt + fr; const int tok = b * SEQ + n * CH + (d ? 63 - i : i);
            const float bci = row[i], dmi = row[64 + i];
            const float il = bci + m, mo = fmaxf(il, dmi);
            const float inter = fexp(il - mo), e2 = fexp(dmi - mo);
            const f32x4 res = QC[mt] * inter + SV[mt] * e2;
            if (slice < 8) { u32x2 w2; w2.x = cvt_pk_bf16(res[0], res[1]); w2.y = cvt_pk_bf16(res[2], res[3]); *(u32x2*)(NUM + (size_t)tok * MIXW + h * HD + slice * 16 + 4 * fq) = w2; }
            else if (fq == 0) DEN[(size_t)tok * 8 + h * 2 + d] = fmaxf(fabsf(res[0]), fexp(-mo));
        }
        const float mn = fmaxf(bl + m, am), sp = fexp(bl + m - mn), sc = fexp(am - mn);
#pragma unroll
        for (int kt = 0; kt < 4; ++kt) C[kt] = C[kt] * sp + KV[kt] * sc;
        m = mn;
        }
        SCAN_BAR();
    }
}

__device__ __forceinline__ void pool_phase(const Frame& F) {
    const bf16* U = (const bf16*)(F.ws + WS_PPOOL); bf16* Y = (bf16*)(F.ws + WS_YP);
    const int gw = F.wg * NWAVES + F.wave, NGW = F.G * NWAVES, lane = F.lane;
    const int half = 1 << (lane >> 4);
    for (int t = gw; t < T; t += NGW) {
        const int sp = t & (SEQ - 1);
        const int lo = max(sp - half, 0), hi = min(sp + half, SEQ);
        float s[8];
#pragma unroll
        for (int e = 0; e < 8; ++e) s[e] = 0.f;
        for (int o = -8; o < 8; ++o) {
            const int q = sp + o;
            if (q >= lo && q < hi) { float f[8]; unpack8(*(const u32x4*)(U + (size_t)(t + o) * MIXW + 8 * lane), f);
#pragma unroll
                for (int e = 0; e < 8; ++e) s[e] += f[e]; }
        }
        float c[8]; unpack8(*(const u32x4*)(U + (size_t)t * MIXW + 8 * lane), c);
        const float inv = 1.0f / (float)(hi - lo);
        u32x4 w; w.x = pk2(s[0] * inv - c[0], s[1] * inv - c[1]); w.y = pk2(s[2] * inv - c[2], s[3] * inv - c[3]); w.z = pk2(s[4] * inv - c[4], s[5] * inv - c[5]); w.w = pk2(s[6] * inv - c[6], s[7] * inv - c[7]);
        *(u32x4*)(Y + (size_t)t * MIXW + 8 * lane) = w;
    }
}

__device__ __forceinline__ void norm_phase(const Frame& F, int l, bool dummy = false) {
    const bf16* OF = (const bf16*)(F.ws + WS_OF); const bf16* OB = (const bf16*)(F.ws + WS_OB);
    const bf16* NF = (const bf16*)(F.ws + WS_NUMF); const bf16* NBk = (const bf16*)(F.ws + WS_NUMB); const float* DEN = (const float*)(F.ws + WS_DEN);
    bf16* Z = (bf16*)(F.ws + WS_PZ); bf16* MO = (bf16*)(F.ws + WS_PMO);
    bf16* ZO = dummy ? (bf16*)(F.ws + WS_GATE) : Z; bf16* MOO = dummy ? (bf16*)(F.ws + WS_GATE + 32 * MiB) : MO;
    const int gw = F.wg * NWAVES + F.wave, NGW = F.G * NWAVES, lane = F.lane, h = lane >> 4;
    float nw[8], mw[8];
#pragma unroll
    for (int e = 0; e < 8; ++e) { nw[e] = inp(F, I_DN_NORM)[l * MIXW + 8 * lane + e]; mw[e] = inp(F, I_ML_NORM)[l * MIXW + 8 * lane + e]; }
    for (int t = gw; t < T; t += NGW) {
        const size_t off = (size_t)t * MIXW + 8 * lane;
        {
            float a[8], bq[8], z[8]; unpack8(*(const u32x4*)(OF + off), a); unpack8(*(const u32x4*)(OB + off), bq); unpack8(*(const u32x4*)(Z + off), z);
            float ss = 0.f;
#pragma unroll
            for (int e = 0; e < 8; ++e) { a[e] += bq[e]; ss += a[e] * a[e]; }
            ss += __shfl_xor(ss, 1); ss += __shfl_xor(ss, 2); ss += __shfl_xor(ss, 4); ss += __shfl_xor(ss, 8);
            const float r = 1.0f / sqrtf(ss * (1.f / HD) + NORM_EPS);
            float o[8];
#pragma unroll
            for (int e = 0; e < 8; ++e) o[e] = a[e] * r * nw[e] * siluf_(z[e]);
            u32x4 w; w.x = pk2(o[0], o[1]); w.y = pk2(o[2], o[3]); w.z = pk2(o[4], o[5]); w.w = pk2(o[6], o[7]);
            *(u32x4*)(ZO + off) = w;
        }
        {
            float a[8], bq[8], g[8]; unpack8(*(const u32x4*)(NF + off), a); unpack8(*(const u32x4*)(NBk + off), bq); unpack8(*(const u32x4*)(MO + off), g);
            const float df = 1.0f / DEN[(size_t)t * 8 + h * 2], db = 1.0f / DEN[(size_t)t * 8 + h * 2 + 1];
            float s = 0.f;
#pragma unroll
            for (int e = 0; e < 8; ++e) { a[e] = a[e] * df + bq[e] * db; s += a[e]; }
            s += __shfl_xor(s, 1); s += __shfl_xor(s, 2); s += __shfl_xor(s, 4); s += __shfl_xor(s, 8);
            const float mean = s * (1.f / HD); float ss = 0.f;
#pragma unroll
            for (int e = 0; e < 8; ++e) { a[e] -= mean; ss += a[e] * a[e]; }
            ss += __shfl_xor(ss, 1); ss += __shfl_xor(ss, 2); ss += __shfl_xor(ss, 4); ss += __shfl_xor(ss, 8);
            const float r = 1.0f / sqrtf(ss * (1.f / HD) + NORM_EPS);
            float o[8];
#pragma unroll
            for (int e = 0; e < 8; ++e) o[e] = a[e] * r * mw[e] * sigmoidf_(g[e]);
            u32x4 w; w.x = pk2(o[0], o[1]); w.y = pk2(o[2], o[3]); w.z = pk2(o[4], o[5]); w.w = pk2(o[6], o[7]);
            *(u32x4*)(MOO + off) = w;
        }
    }
}

__device__ __forceinline__ void moe_tables(const Frame& F) {
    LAS int* cnt = (LAS int*)(F.lds + LHIST_OFF + 128); LAS int* pstart = (LAS int*)(F.lds + LHIST_OFF + 256); LAS int* mybase = (LAS int*)(F.lds + LHIST_OFF + 384);
    LAS int* pe = (LAS int*)(F.lds + LPE_OFF);
    const int* hist = (const int*)(F.ws + WS_HIST);
    if (F.tid < 32) { cnt[F.tid] = 0; mybase[F.tid] = 0; }
    __syncthreads();
    { const int e = F.tid & 31, part = F.tid >> 5; int tot = 0, base = 0;
      for (int q = 0; q < 16; ++q) { const int w = part * 16 + q; const int v = hist[w * 32 + e]; tot += v; base += v * min(max(F.wg - w, 0), 1); }
      __hip_atomic_fetch_add(cnt + e, tot, __ATOMIC_RELAXED, __HIP_MEMORY_SCOPE_WORKGROUP); __hip_atomic_fetch_add(mybase + e, base, __ATOMIC_RELAXED, __HIP_MEMORY_SCOPE_WORKGROUP); }
    __syncthreads();
    if (F.tid == 0) { int acc = 0, p = 0; for (int e = 0; e < NEXP; ++e) { pstart[e] = acc; const int np = (cnt[e] + 255) >> 8; for (int q = 0; q < np; ++q) pe[p++] = e; acc += np * 256; } pe[319] = p; }
    __syncthreads();
}
__device__ __forceinline__ void moe_dispatch(const Frame& F) {
    moe_tables(F);
    LAS int* pstart = (LAS int*)(F.lds + LHIST_OFF + 256); LAS int* mybase = (LAS int*)(F.lds + LHIST_OFF + 384);
    LAS int* lpos = (LAS int*)(F.lds);
    LAS int* le = (LAS int*)(F.lds + 1024);
    const int* eid = (const int*)(F.ws + WS_EID); const float* ew = (const float*)(F.ws + WS_EW);
    int* pos = (int*)(F.ws + WS_POS); float* roww = (float*)(F.ws + WS_ROWW);
    const int rows_per_wg = T / F.G, row0 = F.wg * rows_per_wg;
    int my_e = 0; float my_w = 0.f;
    if (F.tid < 256) { my_e = eid[2 * row0 + F.tid]; my_w = ew[2 * row0 + F.tid]; le[F.tid] = my_e; }
    __syncthreads();
    if (F.tid < 256) {
        int rank = 0;
        for (int a = 0; a < F.tid; ++a) rank += (le[a] == my_e) ? 1 : 0;
        const int p = pstart[my_e] + mybase[my_e] + rank;
        lpos[F.tid] = p; pos[2 * row0 + F.tid] = p; roww[p] = my_w;
    }
    __syncthreads();
    const bf16* hb = (const bf16*)(F.ws + WS_HB); bf16* Xs = (bf16*)(F.ws + WS_XS);
    for (int a = F.wave; a < 2 * rows_per_wg; a += NWAVES) {
        const int t = row0 + (a >> 1), p = lpos[a];
        const u32x4* src = (const u32x4*)(hb + (size_t)t * D); u32x4* dst = (u32x4*)(Xs + (size_t)p * D);
        dst[F.lane] = src[F.lane]; dst[64 + F.lane] = src[64 + F.lane];
    }
    __syncthreads();
}

constexpr int NPHASE = 1 + 15 * DEPTH;
#ifndef PHM
#define PHM 0xFFFF
#endif
#define PHON(b) ((PHM >> (b)) & 1)
#ifndef REPEAT_PHASE
#define REPEAT_PHASE -1
#endif
#define NREP(k) (((k) == REPEAT_PHASE) ? 2 : 1)
__global__ void __launch_bounds__(NWAVES * 64, 2) mega_fwd(Args args) {
    extern __shared__ __attribute__((aligned(16))) unsigned char lds_raw[];
    LAS unsigned char* lds = (LAS unsigned char*)lds_raw;
    const int wave = __builtin_amdgcn_readfirstlane((int)threadIdx.x >> 6);
    for (int u = threadIdx.x; u < (LDS_BYTES - RING_BYTES) / 4; u += NWAVES * 64) ((LAS unsigned*)(lds + RING_BYTES))[u] = 0u;
    __syncthreads();
    if (threadIdx.x == 0) { LAS unsigned long long* ap = (LAS unsigned long long*)(lds + LARG_OFF);
#pragma unroll
        for (int i = 0; i < 23; ++i) ap[i] = (unsigned long long)args.in[i];
        ap[23] = (unsigned long long)args.out; ap[24] = (unsigned long long)args.ws; }
    __syncthreads();
    const int lo = args.ph_lo, hi = args.ph_hi;
    if (hi - lo > 1) { const XcdBarrier b0 = xcd_barrier_post((unsigned*)(args.ws + WS_CTL) + CW_BAR, (volatile LAS unsigned*)(lds + MISC_OFF) + 8);
        if (threadIdx.x == 0) ((volatile LAS unsigned*)(lds + MISC_OFF))[10] = b0.x; }
    __syncthreads();
#ifdef DIAG
    if (threadIdx.x == 0 && blockIdx.x == 0 && lo == 0) ((unsigned long long*)(args.ws + WS_CTL + 1024))[0] = __builtin_amdgcn_s_memrealtime();
#endif
    int ph = lo, rep = 0;
#pragma unroll 1
    while (ph < hi) {
        const Frame F = fresh(lds, wave);
        const bool DRY = (REPEAT_PHASE >= 0) && (rep == 0) && (((ph >= 1) ? ((ph - 1) % 15) : 15) == REPEAT_PHASE);
        const int l = (ph >= 1) ? (ph - 1) / 15 : 0;
        const int k = (ph >= 1) ? (ph - 1) - 15 * l : 15;
        if (PHON(15) && k == 15) {
            wprep_mixer(F, 0);
            __syncthreads();
            ln_phase<0>(F, inp(F, I_LN_IN_G), inp(F, I_LN_IN_B), inp(F, I_W_IN), DIN, true, true, DRY);
        } else if (PHON(0) && k == 0) {
            pg8::StaticOrder S; S.init(F.ws + WS_HB, F.ws + WS_WIN, T, 1536, D, F.G, F.wg);
            EpiG1a E{(bf16*)(F.ws + WS_PQKV)};
            pg8::gemm_phase<EpiG1a, pg8::StaticOrder>(F.lds, F.tid, D, S, E);
        } else if (PHON(1) && k == 1) { dn_prep(F, l);
        } else if (PHON(2) && k == 2) { dn_scan(F);
        } else if (PHON(3) && k == 3) {
            pg8::StaticOrder S; S.init(F.ws + WS_HB, F.ws + WS_WIN + (size_t)1536 * D * 2, T, 2560, D, F.G, F.wg);
            EpiG1b E{F.ws};
            pg8::gemm_phase<EpiG1b, pg8::StaticOrder>(F.lds, F.tid, D, S, E);
        } else if (PHON(4) && k == 4) { pool_phase(F); ml_prep(F, l);
        } else if (PHON(5) && k == 5) { ml_scan(F);
        } else if (PHON(6) && k == 6) { norm_phase(F, l, DRY);
        } else if (PHON(7) && k == 7) {
            pg8::StaticOrder S; S.init(F.ws + WS_HB, F.ws + WS_WGATE, T, 3072, D, F.G, F.wg);
            EpiGate E{(bf16*)(F.ws + WS_GATE)};
            pg8::gemm_phase<EpiGate, pg8::StaticOrder>(F.lds, F.tid, D, S, E);
        } else if (PHON(8) && k == 8) {
            MergeOrder S; S.Y[0] = (const char*)(F.ws + WS_PZ); S.Y[1] = (const char*)(F.ws + WS_YP); S.Y[2] = (const char*)(F.ws + WS_PMO); S.W = (const char*)(F.ws + WS_WBR); S.G = F.G; S.c = F.wg;
            EpiMerge E{(const bf16*)(F.ws + WS_GATE), (bf16*)(F.ws + WS_MRGP), (bf16*)(F.ws + WS_HB)};
            pg8::gemm_phase<EpiMerge, MergeOrder>(F.lds, F.tid, MIXW, S, E);
        } else if (PHON(9) && k == 9) {
            pg8::StaticOrder S; S.init(F.ws + WS_HB, F.ws + WS_WOUT, T, D, D, F.G, F.wg);
            EpiOut E{DRY ? (float*)(F.ws + WS_R2) : F.out};
            pg8::gemm_phase<EpiOut, pg8::StaticOrder>(F.lds, F.tid, D, S, E);
        } else if (PHON(10) && k == 10) {
            wprep_moe(F, l);
            __syncthreads();
            ln_phase<1>(F, inp(F, I_LN_MIX_G) + l * D, inp(F, I_LN_MIX_B) + l * D, inp(F, I_ROUTER_W), 32, true, true, DRY);
        } else if (PHON(11) && k == 11) { moe_dispatch(F);
        } else if (PHON(12) && k == 12) {
            moe_tables(F);
            MoeOrder<D> S; S.A = (const char*)(F.ws + WS_XS); S.W = (const char*)(F.ws + WS_W13); S.pe = (const LAS int*)(F.lds + LPE_OFF); S.c = F.wg; S.NP = __builtin_amdgcn_readfirstlane(S.pe[319]);
            EpiMoe1 E{(bf16*)(F.ws + WS_ACT)};
            pg8::gemm_phase<EpiMoe1, MoeOrder<D>>(F.lds, F.tid, D, S, E);
        } else if (PHON(13) && k == 13) {
            moe_tables(F);
            MoeOrder<DEXP> S; S.A = (const char*)(F.ws + WS_ACT); S.W = (const char*)(F.ws + WS_W2); S.pe = (const LAS int*)(F.lds + LPE_OFF); S.c = F.wg; S.NP = __builtin_amdgcn_readfirstlane(S.pe[319]);
            EpiMoe2 E{(bf16*)(F.ws + WS_YROWS), (const float*)(F.ws + WS_ROWW)};
            pg8::gemm_phase<EpiMoe2, MoeOrder<DEXP>>(F.lds, F.tid, DEXP, S, E);
        } else if (PHON(14)) {
            const bool last = (l == DEPTH - 1);
            if (!last) { wprep_mixer(F, l + 1); __syncthreads(); }
            ln_phase<2>(F, inp(F, I_LN_FFN_G) + l * D, inp(F, I_LN_FFN_B) + l * D, inp(F, I_W_IN) + (size_t)(last ? l : l + 1) * D * DIN, DIN, !last, !last, DRY);
        }
        const bool again = (k == REPEAT_PHASE) && (rep == 0);
        if (again) rep = 1; else { rep = 0; ++ph; }
        if (ph < hi) { XcdBarrier bar; bar.bar = (unsigned*)(F.ws + WS_CTL) + CW_BAR; bar.st = (volatile LAS unsigned*)(F.lds + MISC_OFF) + 8; bar.x = __builtin_amdgcn_readfirstlane(bar.st[2]); xcd_barrier(bar, F.tid); }
#ifdef DIAG
        if (!again && F.tid == 0 && F.wg == 0) ((unsigned long long*)(F.ws + WS_CTL + 1024))[ph] = __builtin_amdgcn_s_memrealtime();
#endif
    }
}

#ifndef N_LAUNCH_MODE
#define N_LAUNCH_MODE 1
#endif
extern "C" void kernel_launch(void* const* d_in, const int* in_sizes, int n_in, void* d_out, int out_size, void* d_ws, size_t ws_size, hipStream_t stream) {
    static int grid = 0;
    if (grid == 0) {
        if (n_in != 23 || out_size != T * D || ws_size < WS_END) { fprintf(stderr, "kernel_launch: unexpected shapes (n_in %d out %d ws %zu)\n", n_in, out_size, ws_size); grid = -1; return; }
        int dev = 0, cus = 0, per_cu = 0;
        if (hipGetDevice(&dev) != hipSuccess || hipDeviceGetAttribute(&cus, hipDeviceAttributeMultiprocessorCount, dev) != hipSuccess) { grid = -1; return; }
        if (hipFuncSetAttribute((const void*)mega_fwd, hipFuncAttributeMaxDynamicSharedMemorySize, LDS_BYTES) != hipSuccess) { fprintf(stderr, "kernel_launch: hipFuncSetAttribute failed\n"); grid = -1; return; }
        (void)hipOccupancyMaxActiveBlocksPerMultiprocessor(&per_cu, (const void*)mega_fwd, NWAVES * 64, LDS_BYTES);
        (void)hipGetLastError();
        grid = cus;
        if (grid != 256) { fprintf(stderr, "kernel_launch: built for 256 CUs, got %d\n", cus); grid = -1; return; }
    }
    if (grid < 0) return;
    (void)hipMemsetAsync((char*)d_ws + WS_CTL, 0, CTL_ZERO_BYTES, stream);
    Args a{};
    for (int i = 0; i < 23; ++i) a.in[i] = (const float*)d_in[i];
    a.out = (float*)d_out; a.ws = (unsigned char*)d_ws;
#if defined(DIAG) && DIAG >= 100
    {
        a.ph_lo = 0; a.ph_hi = NPHASE;
        hipLaunchKernelGGL(mega_fwd, dim3(grid), dim3(NWAVES * 64), LDS_BYTES, stream, a);
        hipLaunchKernelGGL(diag_fill_t, dim3(1024), dim3(256), 0, stream, (float*)d_out, (unsigned char*)d_ws, out_size, (int)(DIAG - 100));
    }
#elif defined(DIAG)
    {
        const int his[12] = {0, 2, 3, 6, 15, 10, 6, 9, 2, 2, 5, 9};
        const int grids[12] = {0, 64, 2, 2, 16, 64, 64, 64, 64, 64, 64, 64}, blocks[12] = {0, 256, 128, 128, 256, 256, 256, 256, 256, 256, 256, 256};
        a.ph_lo = 0; a.ph_hi = his[DIAG];
        hipLaunchKernelGGL(mega_fwd, dim3(grid), dim3(NWAVES * 64), LDS_BYTES, stream, a);
        static int once = 0; if (!once) { once = 1; (void)hipFuncSetAttribute((const void*)diag_kernel, hipFuncAttributeMaxDynamicSharedMemorySize, 81920); }
        DArgs da{}; for (int i = 0; i < 23; ++i) da.in[i] = (const float*)d_in[i]; da.out = (float*)d_out; da.ws = (unsigned char*)d_ws; da.mode = DIAG; da.pad = 0;
        hipLaunchKernelGGL(diag_kernel, dim3(grids[DIAG]), dim3(blocks[DIAG]), 81920, stream, da);
        if (DIAG == 2 || DIAG == 3) {
            a.ph_lo = his[DIAG]; a.ph_hi = his[DIAG] + 1;
            hipLaunchKernelGGL(mega_fwd, dim3(grid), dim3(NWAVES * 64), LDS_BYTES, stream, a);
            da.mode = DIAG + 10;
            hipLaunchKernelGGL(diag_kernel, dim3(2), dim3(128), 81920, stream, da);
        }
        hipLaunchKernelGGL(diag_fill, dim3(1024), dim3(256), 0, stream, (float*)d_out, (unsigned char*)d_ws, out_size);
    }
#elif N_LAUNCH_MODE == 1
    a.ph_lo = 0; a.ph_hi = NPHASE;
    hipLaunchKernelGGL(mega_fwd, dim3(grid), dim3(NWAVES * 64), LDS_BYTES, stream, a);
#else
    for (int p = 0; p < NPHASE; ++p) { a.ph_lo = p; a.ph_hi = p + 1; hipLaunchKernelGGL(mega_fwd, dim3(grid), dim3(NWAVES * 64), LDS_BYTES, stream, a); }
#endif
}
```

```cpp
#include <hip/hip_runtime.h>
#include <cstdio>
#include <cstdint>

#define LAS __attribute__((address_space(3)))
#define GAS __attribute__((address_space(1)))
typedef unsigned short bf16;
typedef short bf16x8 __attribute__((ext_vector_type(8)));
typedef float f32x4 __attribute__((ext_vector_type(4)));
typedef float f32x2 __attribute__((ext_vector_type(2)));
typedef unsigned u32x4 __attribute__((ext_vector_type(4)));
typedef unsigned u32x2 __attribute__((ext_vector_type(2)));
#define RLX_AGENT __ATOMIC_RELAXED, __HIP_MEMORY_SCOPE_AGENT
#define LDS_WAIT() asm volatile("s_waitcnt lgkmcnt(0)" ::: "memory")
#define VM_WAIT() asm volatile("s_waitcnt vmcnt(0)" ::: "memory")

constexpr int NB = 4, SEQ = 8192, T = NB * SEQ, D = 1024, DEPTH = 2;
constexpr int DIN = 7200;
constexpr int MIXW = 512, NHEAD = 4, HD = 128, CH = 64, NCH = SEQ / CH;
constexpr int MLQK = 64;
constexpr int NEXP = 32, DEXP = 512;
constexpr float LN_EPS = 1e-5f, NORM_EPS = 1e-6f;
constexpr float ALPHA = 1.41421356237309515f;
constexpr int NWAVES = 8;
constexpr int NREC = NB * NHEAD * NCH * 2;

constexpr int C_QKV = 0, C_Z = 1536, C_A = 2048, C_B = 2056, C_POOL = 2064, C_MQ = 2576, C_MK = 2832, C_MV = 3088, C_MO = 3600, C_I = 4112, C_F = 4120, C_GATE = 4128;

constexpr size_t MiB = 1u << 20;
constexpr size_t WS_CTL = 0, CTL_ZERO_BYTES = 64 * 1024;
constexpr int CW_BAR = 4096;
constexpr size_t WS_HIST = 1 * MiB;
constexpr size_t WS_EID = WS_HIST + 64 * 1024;
constexpr size_t WS_EW = WS_EID + 256 * 1024;
constexpr size_t WS_POS = WS_EW + 256 * 1024;
constexpr size_t WS_ROWW = WS_POS + 256 * 1024;
constexpr size_t WS_GL = WS_ROWW + 512 * 1024;
constexpr size_t WS_WIN = 4 * MiB;
constexpr size_t WS_WGATE = 12 * MiB;
constexpr size_t WS_WBR = 18 * MiB;
constexpr size_t WS_WOUT = 21 * MiB;
constexpr size_t WS_HB = 24 * MiB;
constexpr size_t WS_SG = 88 * MiB;
constexpr size_t WS_DEN = 92 * MiB;
constexpr size_t WS_R1 = 93 * MiB;
constexpr size_t WS_PQKV = WS_R1;
constexpr size_t WS_OF = WS_R1, WS_OB = WS_R1 + 32 * MiB;
constexpr size_t WS_MRGP = WS_R1;
constexpr size_t WS_W13 = WS_R1, WS_W2 = WS_R1 + 64 * MiB;
constexpr size_t WS_R2 = 189 * MiB;
constexpr size_t DNREC = 73728;
constexpr size_t DN_W = 0, DN_QG = 16384, DN_KDT = 32768, DN_ATT = 49152, DN_UF = 57344;
constexpr size_t WS_PZ = 189 * MiB, WS_PPOOL = 221 * MiB, WS_PMQ = 253 * MiB, WS_PMK = 269 * MiB, WS_PMV = 285 * MiB, WS_PMO = 317 * MiB;
constexpr size_t WS_YP = 349 * MiB;
constexpr size_t WS_NUMF = 253 * MiB, WS_NUMB = 285 * MiB;
constexpr size_t WS_ML = 381 * MiB;
constexpr size_t MLREC = 44032;
constexpr size_t ML_Q = 0, ML_ST = 8192, ML_KWT = 16384, ML_VF = 24576, ML_ROW = 43008;
constexpr size_t WS_GATE = 381 * MiB;
constexpr size_t WS_XS = 189 * MiB, WS_ACT = 333 * MiB, WS_YROWS = 405 * MiB;
constexpr size_t WS_END = 573 * MiB;
constexpr int MOE_ROWS = 73728;
static_assert(WS_ML + (size_t)NREC * MLREC <= WS_END + 15 * MiB, "ml records");
static_assert(WS_YROWS + (size_t)MOE_ROWS * 1024 * 2 <= WS_END, "moe rows");

constexpr int RING_BYTES = 131072;
constexpr int MISC_OFF = RING_BYTES + 320;
constexpr int LHIST_OFF = RING_BYTES + 1024;
constexpr int LPE_OFF = RING_BYTES + 2048;
constexpr int LARG_OFF = RING_BYTES + 4096;
constexpr int LDS_BYTES = 147456;

__device__ __forceinline__ float bf2f(unsigned b) { return __uint_as_float(b << 16); }
__device__ __forceinline__ unsigned f2bf(float f) { unsigned u = __float_as_uint(f); return (u + 0x7fffu + ((u >> 16) & 1u)) >> 16; }
__device__ __forceinline__ unsigned pk2(float lo, float hi) { return f2bf(lo) | (f2bf(hi) << 16); }
__device__ __forceinline__ float wave_sum(float v) {
    v += __int_as_float(__builtin_amdgcn_update_dpp(0, __float_as_int(v), 0xB1, 0xf, 0xf, true));
    v += __int_as_float(__builtin_amdgcn_update_dpp(0, __float_as_int(v), 0x4E, 0xf, 0xf, true));
    v += __int_as_float(__builtin_amdgcn_update_dpp(0, __float_as_int(v), 0x141, 0xf, 0xf, true));
    v += __int_as_float(__builtin_amdgcn_update_dpp(0, __float_as_int(v), 0x140, 0xf, 0xf, true));
    const int iv = __float_as_int(v);
    return (__int_as_float(__builtin_amdgcn_readlane(iv, 0)) + __int_as_float(__builtin_amdgcn_readlane(iv, 16))) + (__int_as_float(__builtin_amdgcn_readlane(iv, 32)) + __int_as_float(__builtin_amdgcn_readlane(iv, 48)));
}
__device__ __forceinline__ float wave_max(float v) {
    v = fmaxf(v, __int_as_float(__builtin_amdgcn_update_dpp(0, __float_as_int(v), 0xB1, 0xf, 0xf, true)));
    v = fmaxf(v, __int_as_float(__builtin_amdgcn_update_dpp(0, __float_as_int(v), 0x4E, 0xf, 0xf, true)));
    v = fmaxf(v, __int_as_float(__builtin_amdgcn_update_dpp(0, __float_as_int(v), 0x141, 0xf, 0xf, true)));
    v = fmaxf(v, __int_as_float(__builtin_amdgcn_update_dpp(0, __float_as_int(v), 0x140, 0xf, 0xf, true)));
    const int iv = __float_as_int(v);
    return fmaxf(fmaxf(__int_as_float(__builtin_amdgcn_readlane(iv, 0)), __int_as_float(__builtin_amdgcn_readlane(iv, 16))), fmaxf(__int_as_float(__builtin_amdgcn_readlane(iv, 32)), __int_as_float(__builtin_amdgcn_readlane(iv, 48))));
}
__device__ __forceinline__ float fexp(float x) { return __builtin_amdgcn_exp2f(x * 1.44269504089f); }
__device__ __forceinline__ float sigmoidf_(float x) { return 1.0f / (1.0f + expf(-x)); }
__device__ __forceinline__ float siluf_(float x) { return x / (1.0f + expf(-x)); }
__device__ __forceinline__ float softplusf_(float x) { return fmaxf(x, 0.f) + log1pf(expf(-fabsf(x))); }
__device__ __forceinline__ float logsigmoidf_(float x) { return fminf(x, 0.f) - log1pf(expf(-fabsf(x))); }
__host__ __device__ __forceinline__ int sigma32(int p) { const int fq = p >> 3, j = p & 7; return 16 * (j >> 2) + 4 * fq + (j & 3); }

#define XB_TMO      128
#define XB_XCNT(j)  (256  + 64 * (j))
#define XB_XSUB(j)  (1280 + 64 * (j))
#define XB_XGEN(j)  (2304 + 64 * (j))
#define XB_TOP      3328
#define XB_TOPGEN   3392
#define XCD_BAR_WORDS 3456
#define XB_SPIN_CAP (1u << 20)
__device__ __forceinline__ unsigned xb_ld(unsigned* p)              { return __hip_atomic_load(p, __ATOMIC_RELAXED, __HIP_MEMORY_SCOPE_AGENT); }
__device__ __forceinline__ unsigned xb_add(unsigned* p, unsigned v) { return __hip_atomic_fetch_add(p, v, __ATOMIC_RELAXED, __HIP_MEMORY_SCOPE_AGENT); }
__device__ __forceinline__ unsigned xb_xcc_id() { return (unsigned)__builtin_amdgcn_s_getreg((3 << 11) | 20) & 0xFu; }
#define XB_SPIN(cond, bar) do { unsigned _sp = 0; while (cond) { __builtin_amdgcn_s_sleep(1); \
    if ((++_sp & 255u) == 0u) { if (xb_ld(&(bar)[XB_TMO])) break; if (_sp > XB_SPIN_CAP) { atomicAdd(&(bar)[XB_TMO], 1u); break; } } } } while (0)
struct XcdBarrier { unsigned* bar; unsigned x; volatile LAS unsigned* st; };
__device__ __forceinline__ XcdBarrier xcd_barrier_post(unsigned* bar, volatile LAS unsigned* st) {
    XcdBarrier b; b.bar = bar; b.x = xb_xcc_id(); b.st = st;
    if (threadIdx.x == 0) (void)xb_add(&bar[XB_XCNT(b.x)], 1u);
    return b;
}
__device__ __forceinline__ void xcd_barrier_complete(unsigned* bar, unsigned x, unsigned& nloc, unsigned& nx) {
    const unsigned G = 256u;
    unsigned sum, cnt, mine, sp = 0u;
    for (;;) {
        sum = 0u; cnt = 0u; mine = 0u;
#pragma unroll
        for (unsigned j = 0; j < 16; ++j) { const unsigned c = xb_ld(&bar[XB_XCNT(j)]); sum += c; cnt += (c > 0u) ? 1u : 0u; mine = (j == x) ? c : mine; }
        if (sum == G) break;
        __builtin_amdgcn_s_sleep(1);
        if ((++sp & 255u) == 0u) { if (xb_ld(&bar[XB_TMO])) break; if (sp > XB_SPIN_CAP) { atomicAdd(&bar[XB_TMO], 1u); break; } }
    }
    nloc = mine > 0u ? mine : 1u; nx = cnt > 0u ? cnt : 1u;
}
__device__ __forceinline__ void xcd_barrier(const XcdBarrier& b, const int tid) {
    asm volatile("s_waitcnt vmcnt(0)" ::: "memory");
    __syncthreads();
    if (tid == 0) {
        unsigned* bar = b.bar;
        __builtin_amdgcn_s_waitcnt(0);
        unsigned nloc = b.st[0], nx = b.st[1];
        if (nloc == 0u) { xcd_barrier_complete(bar, b.x, nloc, nx); b.st[0] = nloc; b.st[1] = nx; }
        const unsigned old = xb_add(&bar[XB_XSUB(b.x)], 1u);
        const unsigned gen = old / nloc;
        if (old + 1u == (gen + 1u) * nloc) {
            __builtin_amdgcn_fence(__ATOMIC_RELEASE, "agent");
            asm volatile("s_waitcnt vmcnt(0)" ::: "memory");
            const unsigned og = xb_add(&bar[XB_TOP], 1u);
            const unsigned tg = og / nx;
            if (og + 1u == (tg + 1u) * nx) xb_add(&bar[XB_TOPGEN], 1u);
            else XB_SPIN(xb_ld(&bar[XB_TOPGEN]) == tg, bar);
            __builtin_amdgcn_fence(__ATOMIC_ACQUIRE, "agent");
            xb_add(&bar[XB_XGEN(b.x)], 1u);
            asm volatile("s_waitcnt vmcnt(0)" ::: "memory");
        } else {
            XB_SPIN(xb_ld(&bar[XB_XGEN(b.x)]) == gen, bar);
            __builtin_amdgcn_fence(__ATOMIC_ACQUIRE, "agent");
            asm volatile("s_waitcnt vmcnt(0)" ::: "memory");
        }
    }
    __syncthreads();
}

namespace pg8 {
constexpr int BM = 256, BK = 64, HALF = 128, HTB = HALF * BK * 2, STAGE_BYTES = 8 * HTB, NXCD = 8, WGM = 8;
__host__ __device__ __forceinline__ int lds_byte(int r, int c) { const int st = (r >> 4) * 2 + (c >> 5), rr = r & 15, cc = c & 31, ob = rr * 64 + cc * 2; return st * 1024 + (ob ^ (((ob >> 9) & 1) << 5)); }
__host__ __device__ __forceinline__ void stage_rc(int b, int& R, int& C) { const int st = b / 1024, sb = b % 1024, swz = sb ^ (((sb >> 9) & 1) << 5); R = (st >> 1) * 16 + swz / 64; C = (st & 1) * 32 + (swz % 64) / 2; }
__host__ __device__ __forceinline__ int perm32(int rho) { const int n = rho >> 4, i = rho & 15; return 8 * (i >> 2) + 4 * n + (i & 3); }

struct Unit { int pm, pn, aux; const GAS char* A; const GAS char* B; };

__device__ __forceinline__ void tile_of(int L, int nM, int nN, int& pm, int& pn) {
    const int nwg = nM * nN; int wgid = L;
    { const int q = nwg / NXCD, r = nwg % NXCD, xcd = wgid % NXCD, off = wgid / NXCD; wgid = (xcd < r ? xcd * (q + 1) : r * (q + 1) + (xcd - r) * q) + off; }
    const int nig = WGM * nN, gid = wgid / nig, fm = gid * WGM, gsz = (nM - fm) < WGM ? (nM - fm) : WGM;
    pm = fm + ((wgid % nig) % gsz); pn = (wgid % nig) / gsz;
}
struct StaticOrder {
    const GAS char* A; const GAS char* Bt; int nM, nN, nwg, G, c; size_t tstep;
    __device__ __forceinline__ void init(const GAS void* A_, const GAS void* Bt_, int M, int N, int K, int G_, int c_) { A = (const GAS char*)A_; Bt = (const GAS char*)Bt_; nM = M / BM; nN = N / BM; nwg = nM * nN; G = G_; c = c_; tstep = (size_t)BM * K * 2; }
    __device__ __forceinline__ bool next(int i, Unit& u) const {
        const long L = (long)i * G + c; if (L >= nwg) return false;
        tile_of((int)L, nM, nN, u.pm, u.pn); u.aux = 0; u.A = A + (size_t)u.pm * tstep; u.B = Bt + (size_t)u.pn * tstep; return true;
    }
};

typedef float f32x2_t __attribute__((ext_vector_type(2))); typedef __bf16 bf16x2_t __attribute__((ext_vector_type(2)));
__device__ __forceinline__ unsigned cvt_pk_bf16(float lo, float hi) { f32x2_t v = {lo, hi}; bf16x2_t b = __builtin_convertvector(v, bf16x2_t); return __builtin_bit_cast(unsigned, b); }

template <class Epi, class Sched, bool ALIGN_EPI = true, bool SP2 = true>
__device__ __forceinline__ void gemm_phase(LAS unsigned char* lds, const int tid, const int K, const Sched& S, const Epi& E) {
    const int wid = __builtin_amdgcn_readfirstlane(tid >> 6), lane = tid & 63, wr = wid >> 2, wc = wid & 3, fr = lane & 15, fq = lane >> 4;
    const int nt = K / BK;
    unsigned voffA, voffB;
    { int R, C; stage_rc(tid * 16, R, C); const int Rb = Epi::PERM ? ((R & ~31) + perm32(R & 31)) : R;
        voffA = (unsigned)(R * K + C) * 2u; voffB = (unsigned)(Rb * K + C) * 2u; }
    const size_t pstep = (size_t)64 * K * 2;
    const size_t kstep = (size_t)(BK * 2);
    const size_t hstep = (size_t)HALF * K * 2;
    const unsigned ldsw = (unsigned)wid * 1024u;
    const int aoff = lds_byte(wr * 64 + fr, fq * 8), boff = lds_byte(wc * 32 + fr, fq * 8);
#define PG8_SA(b, h) (((b) * 2 + (h)) * HTB)
#define PG8_SB(b, h) ((4 + (b) * 2 + (h)) * HTB)
#define PG8_STAGE(bufoff, gbase, voff) do { _Pragma("unroll") for (int _i = 0; _i < 2; ++_i) \
        __builtin_amdgcn_global_load_lds((const GAS unsigned*)((const GAS char*)(gbase) + _i * pstep + (voff)), (LAS unsigned*)(lds + (bufoff) + ldsw + _i * 8192), 16, 0, 0); } while (0)
#define PG8_LDA(dst, b, h) do { _Pragma("unroll") for (int m = 0; m < 4; ++m) _Pragma("unroll") for (int k = 0; k < 2; ++k) dst[m][k] = *(const LAS bf16x8*)(lds + PG8_SA(b, h) + aoff + m * 2048 + k * 1024); } while (0)
#define PG8_LDB(dst, b, h) do { _Pragma("unroll") for (int n = 0; n < 2; ++n) _Pragma("unroll") for (int k = 0; k < 2; ++k) dst[n][k] = *(const LAS bf16x8*)(lds + PG8_SB(b, h) + boff + n * 2048 + k * 1024); } while (0)
#define PG8_MMA(ai, bj, At, Bt) do { __builtin_amdgcn_s_setprio(1); _Pragma("unroll") for (int m = 0; m < 4; ++m) _Pragma("unroll") for (int n = 0; n < 2; ++n) _Pragma("unroll") for (int k = 0; k < 2; ++k) \
        acc[ai][bj][m][n] = __builtin_amdgcn_mfma_f32_16x16x32_bf16(Bt[n][k], At[m][k], acc[ai][bj][m][n], 0, 0, 0); __builtin_amdgcn_s_setprio(0); } while (0)
#define PG8_WAIT_V(n) asm volatile("s_waitcnt vmcnt(" #n ")" ::: "memory")
#define PG8_WAIT_L(n) asm volatile("s_waitcnt lgkmcnt(" #n ")" ::: "memory")
#define PG8_BAR __builtin_amdgcn_s_barrier()
#define PG8_SCHED __builtin_amdgcn_sched_barrier(0)
    Unit cur, nxt; int ui = 0;
    if (!S.next(0, cur)) return;
    f32x4 acc[2][2][4][2];
#pragma unroll
    for (int a = 0; a < 2; ++a)
#pragma unroll
        for (int b = 0; b < 2; ++b)
#pragma unroll
            for (int m = 0; m < 4; ++m)
#pragma unroll
                for (int n = 0; n < 2; ++n) acc[a][b][m][n] = (f32x4){0.f, 0.f, 0.f, 0.f};
    bf16x8 At[4][2], B0[2][2], B1[2][2];
    const GAS char* cA = cur.A; const GAS char* cB = cur.B;
    if constexpr (SP2) {
        PG8_STAGE(PG8_SB(0, 0), cB, voffB); PG8_STAGE(PG8_SB(0, 1), cB + hstep, voffB); PG8_STAGE(PG8_SA(0, 0), cA, voffA); PG8_STAGE(PG8_SA(0, 1), cA + hstep, voffA);
        if (wr == 1) PG8_BAR;
        PG8_WAIT_V(2); PG8_BAR;
        PG8_STAGE(PG8_SB(1, 0), cB + kstep, voffB); PG8_STAGE(PG8_SA(1, 0), cA + kstep, voffA); PG8_STAGE(PG8_SB(1, 1), cB + hstep + kstep, voffB);
        PG8_WAIT_V(6); PG8_BAR;
    } else {
        PG8_STAGE(PG8_SB(0, 0), cB, voffB); PG8_STAGE(PG8_SA(0, 0), cA, voffA); PG8_STAGE(PG8_SB(0, 1), cB + hstep, voffB); PG8_STAGE(PG8_SA(0, 1), cA + hstep, voffA);
        if (wr == 1) PG8_BAR;
        PG8_WAIT_V(4); PG8_BAR;
        PG8_STAGE(PG8_SB(1, 0), cB + kstep, voffB); PG8_STAGE(PG8_SA(1, 0), cA + kstep, voffA); PG8_STAGE(PG8_SB(1, 1), cB + hstep + kstep, voffB);
        PG8_WAIT_V(6); PG8_BAR;
    }
    for (;;) {
        const bool has_next = S.next(ui + 1, nxt);
        const GAS char* nA = has_next ? nxt.A : cA; const GAS char* nB = has_next ? nxt.B : cB;
        for (int t = 0; t < nt; t += 2) {
            const bool last = (t == nt - 2);
            const GAS char* a1 = cA + (size_t)(t + 1) * kstep;
            const GAS char* a2 = last ? nA : cA + (size_t)(t + 2) * kstep; const GAS char* b2 = last ? nB : cB + (size_t)(t + 2) * kstep;
            const GAS char* a3 = a2 + kstep; const GAS char* b3 = b2 + kstep;
            if constexpr (SP2) {
            PG8_LDB(B0, 0, 0); PG8_LDB(B1, 0, 1); PG8_SCHED; PG8_LDA(At, 0, 0); PG8_STAGE(PG8_SA(1, 1), a1 + hstep, voffA);
            PG8_WAIT_V(8); PG8_WAIT_L(0); PG8_BAR; PG8_MMA(0, 0, At, B0); PG8_MMA(0, 1, At, B1); PG8_BAR; PG8_SCHED;
            PG8_LDA(At, 0, 1); PG8_STAGE(PG8_SB(0, 0), b2, voffB); PG8_STAGE(PG8_SB(0, 1), b2 + hstep, voffB); PG8_STAGE(PG8_SA(0, 0), a2, voffA);
            PG8_WAIT_V(8); PG8_WAIT_L(0); PG8_BAR; PG8_MMA(1, 0, At, B0); PG8_MMA(1, 1, At, B1); PG8_BAR; PG8_SCHED;
            PG8_LDB(B0, 1, 0); PG8_LDB(B1, 1, 1); PG8_SCHED; PG8_LDA(At, 1, 0); PG8_STAGE(PG8_SA(0, 1), a2 + hstep, voffA);
            PG8_WAIT_V(8); PG8_WAIT_L(0); PG8_BAR; PG8_MMA(0, 0, At, B0); PG8_MMA(0, 1, At, B1); PG8_BAR; PG8_SCHED;
            PG8_LDA(At, 1, 1); PG8_STAGE(PG8_SB(1, 0), b3, voffB); PG8_STAGE(PG8_SB(1, 1), b3 + hstep, voffB); PG8_STAGE(PG8_SA(1, 0), a3, voffA);
            PG8_WAIT_V(8); PG8_WAIT_L(0); PG8_BAR; PG8_MMA(1, 0, At, B0); PG8_MMA(1, 1, At, B1); PG8_BAR; PG8_SCHED;
            } else {
            PG8_LDB(B0, 0, 0); PG8_SCHED; PG8_LDA(At, 0, 0); PG8_STAGE(PG8_SA(1, 1), a1 + hstep, voffA);
            PG8_WAIT_L(8); PG8_BAR; PG8_WAIT_L(0); PG8_MMA(0, 0, At, B0); PG8_BAR; PG8_SCHED;
            PG8_LDB(B1, 0, 1); PG8_STAGE(PG8_SB(0, 0), b2, voffB);
            PG8_BAR; PG8_WAIT_L(0); PG8_MMA(0, 1, At, B1); PG8_BAR;
            PG8_LDA(At, 0, 1); PG8_STAGE(PG8_SA(0, 0), a2, voffA);
            PG8_BAR; PG8_WAIT_L(0); PG8_MMA(1, 0, At, B0); PG8_BAR; PG8_SCHED;
            PG8_STAGE(PG8_SB(0, 1), b2 + hstep, voffB);
            PG8_WAIT_V(6); PG8_BAR; PG8_MMA(1, 1, At, B1); PG8_BAR;
            PG8_LDB(B0, 1, 0); PG8_SCHED; PG8_LDA(At, 1, 0); PG8_STAGE(PG8_SA(0, 1), a2 + hstep, voffA);
            PG8_WAIT_L(8); PG8_BAR; PG8_WAIT_L(0); PG8_MMA(0, 0, At, B0); PG8_BAR; PG8_SCHED;
            PG8_LDB(B1, 1, 1); PG8_STAGE(PG8_SB(1, 0), b3, voffB);
            PG8_BAR; PG8_WAIT_L(0); PG8_MMA(0, 1, At, B1); PG8_BAR;
            PG8_LDA(At, 1, 1); PG8_STAGE(PG8_SA(1, 0), a3, voffA);
            PG8_BAR; PG8_WAIT_L(0); PG8_MMA(1, 0, At, B0); PG8_BAR; PG8_SCHED;
            PG8_STAGE(PG8_SB(1, 1), b3 + hstep, voffB);
            PG8_WAIT_V(6); PG8_BAR; PG8_MMA(1, 1, At, B1); PG8_BAR;
            }
        }
        if constexpr (ALIGN_EPI) { if (wr == 0) PG8_BAR; }
        E(acc, cur, wr, wc, fr, fq);
        if (!has_next) break;
#pragma unroll
        for (int a = 0; a < 2; ++a)
#pragma unroll
            for (int b = 0; b < 2; ++b)
#pragma unroll
                for (int m = 0; m < 4; ++m)
#pragma unroll
                    for (int n = 0; n < 2; ++n) acc[a][b][m][n] = (f32x4){0.f, 0.f, 0.f, 0.f};
        cur = nxt; cA = nA; cB = nB; ++ui;
        if constexpr (ALIGN_EPI) { if (wr == 1) PG8_BAR; }
    }
    PG8_WAIT_V(0);
    if constexpr (!ALIGN_EPI) { if (wr == 0) PG8_BAR; }
    PG8_BAR;
#undef PG8_SA
#undef PG8_SB
#undef PG8_STAGE
#undef PG8_LDA
#undef PG8_LDB
#undef PG8_MMA
#undef PG8_WAIT_V
#undef PG8_WAIT_L
#undef PG8_BAR
#undef PG8_SCHED
}
}

using pg8::Unit; using pg8::cvt_pk_bf16; using pg8::HALF; using pg8::BM;

struct EpiG1a {
    static constexpr bool PERM = true;
    GAS bf16* O;
    __device__ __forceinline__ void operator()(const f32x4 (&acc)[2][2][4][2], const Unit& u, int wr, int wc, int fr, int fq) const {
        const int row0 = u.pm * BM + wr * 64 + fr, col0 = u.pn * BM + wc * 32 + 8 * fq;
#pragma unroll
        for (int ai = 0; ai < 2; ++ai)
#pragma unroll
            for (int m = 0; m < 4; ++m) { GAS bf16* rowp = O + (size_t)(row0 + ai * HALF + m * 16) * 1536 + col0;
#pragma unroll
                for (int bj = 0; bj < 2; ++bj) { const f32x4 v0 = acc[ai][bj][m][0], v1 = acc[ai][bj][m][1];
                    u32x4 w; w.x = cvt_pk_bf16(v0[0], v0[1]); w.y = cvt_pk_bf16(v0[2], v0[3]); w.z = cvt_pk_bf16(v1[0], v1[1]); w.w = cvt_pk_bf16(v1[2], v1[3]);
                    *(GAS u32x4*)(rowp + bj * HALF) = w; } }
    }
};
struct EpiG1b {
    static constexpr bool PERM = true;
    GAS unsigned char* ws;
    __device__ __forceinline__ void operator()(const f32x4 (&acc)[2][2][4][2], const Unit& u, int wr, int wc, int fr, int fq) const {
        const int pn = u.pn; size_t off; int ld, ct;
        if (pn < 2) { off = WS_PZ; ld = 512; ct = pn; } else if (pn < 4) { off = WS_PPOOL; ld = 512; ct = pn - 2; } else if (pn == 4) { off = WS_PMQ; ld = 256; ct = 0; }
        else if (pn == 5) { off = WS_PMK; ld = 256; ct = 0; } else if (pn < 8) { off = WS_PMV; ld = 512; ct = pn - 6; } else { off = WS_PMO; ld = 512; ct = pn - 8; }
        GAS bf16* O = (GAS bf16*)(ws + off);
        const int row0 = u.pm * BM + wr * 64 + fr, col0 = ct * BM + wc * 32 + 8 * fq;
#pragma unroll
        for (int ai = 0; ai < 2; ++ai)
#pragma unroll
            for (int m = 0; m < 4; ++m) { GAS bf16* rowp = O + (size_t)(row0 + ai * HALF + m * 16) * ld + col0;
#pragma unroll
                for (int bj = 0; bj < 2; ++bj) { const f32x4 v0 = acc[ai][bj][m][0], v1 = acc[ai][bj][m][1];
                    u32x4 w; w.x = cvt_pk_bf16(v0[0], v0[1]); w.y = cvt_pk_bf16(v0[2], v0[3]); w.z = cvt_pk_bf16(v1[0], v1[1]); w.w = cvt_pk_bf16(v1[2], v1[3]);
                    *(GAS u32x4*)(rowp + bj * HALF) = w; } }
    }
};
__device__ __forceinline__ float fast_sigmoid(float x) { return __builtin_amdgcn_rcpf(1.0f + __builtin_amdgcn_exp2f(-1.44269504089f * x)); }
struct EpiGate {
    static constexpr bool PERM = true;
    GAS bf16* O;
    __device__ __forceinline__ void operator()(const f32x4 (&acc)[2][2][4][2], const Unit& u, int wr, int wc, int fr, int fq) const {
        const int row0 = u.pm * BM + wr * 64 + fr, col0 = u.pn * BM + wc * 32 + 8 * fq;
#pragma unroll
        for (int ai = 0; ai < 2; ++ai)
#pragma unroll
            for (int m = 0; m < 4; ++m) { GAS bf16* rowp = O + (size_t)(row0 + ai * HALF + m * 16) * 3072 + col0;
#pragma unroll
                for (int bj = 0; bj < 2; ++bj) { f32x4 v0 = acc[ai][bj][m][0], v1 = acc[ai][bj][m][1];
#pragma unroll
                    for (int j = 0; j < 4; ++j) { v0[j] = fast_sigmoid(v0[j]); v1[j] = fast_sigmoid(v1[j]); }
                    u32x4 w; w.x = cvt_pk_bf16(v0[0], v0[1]); w.y = cvt_pk_bf16(v0[2], v0[3]); w.z = cvt_pk_bf16(v1[0], v1[1]); w.w = cvt_pk_bf16(v1[2], v1[3]);
                    *(GAS u32x4*)(rowp + bj * HALF) = w; } }
    }
};
__device__ __forceinline__ void unpack8(const u32x4 w, float (&f)[8]) {
    f[0] = __uint_as_float(w.x << 16); f[1] = __uint_as_float(w.x & 0xffff0000u); f[2] = __uint_as_float(w.y << 16); f[3] = __uint_as_float(w.y & 0xffff0000u);
    f[4] = __uint_as_float(w.z << 16); f[5] = __uint_as_float(w.z & 0xffff0000u); f[6] = __uint_as_float(w.w << 16); f[7] = __uint_as_float(w.w & 0xffff0000u);
}
struct EpiMerge {
    static constexpr bool PERM = true;
    const GAS bf16* GATE; GAS bf16* PART; GAS bf16* FIN;
    __device__ __forceinline__ void operator()(const f32x4 (&acc)[2][2][4][2], const Unit& u, int wr, int wc, int fr, int fq) const {
        const int r = u.aux;
        const int row0 = u.pm * BM + wr * 64 + fr, col0 = u.pn * BM + wc * 32 + 8 * fq;
#pragma unroll
        for (int ai = 0; ai < 2; ++ai)
#pragma unroll
            for (int m = 0; m < 4; ++m) { const size_t row = (size_t)(row0 + ai * HALF + m * 16);
#pragma unroll
                for (int bj = 0; bj < 2; ++bj) { const f32x4 v0 = acc[ai][bj][m][0], v1 = acc[ai][bj][m][1];
                    const int c = col0 + bj * HALF;
                    const u32x4 gw = *(const GAS u32x4*)(GATE + row * 3072 + r * 1024 + c);
                    float g[8]; unpack8(gw, g);
                    float o[8];
                    o[0] = v0[0] * g[0]; o[1] = v0[1] * g[1]; o[2] = v0[2] * g[2]; o[3] = v0[3] * g[3];
                    o[4] = v1[0] * g[4]; o[5] = v1[1] * g[5]; o[6] = v1[2] * g[6]; o[7] = v1[3] * g[7];
                    if (r > 0) { const u32x4 pw = *(const GAS u32x4*)(PART + row * 1024 + c); float p[8]; unpack8(pw, p);
#pragma unroll
                        for (int j = 0; j < 8; ++j) o[j] += p[j]; }
                    u32x4 w; w.x = cvt_pk_bf16(o[0], o[1]); w.y = cvt_pk_bf16(o[2], o[3]); w.z = cvt_pk_bf16(o[4], o[5]); w.w = cvt_pk_bf16(o[6], o[7]);
                    GAS bf16* dst = (r == 2) ? FIN : PART;
                    *(GAS u32x4*)(dst + row * 1024 + c) = w; } }
    }
};
struct EpiOut {
    static constexpr bool PERM = false;
    GAS float* C;
    __device__ __forceinline__ void operator()(const f32x4 (&acc)[2][2][4][2], const Unit& u, int wr, int wc, int fr, int fq) const {
        const int row0 = u.pm * BM + wr * 64 + fr, col0 = u.pn * BM + wc * 32 + 4 * fq;
#pragma unroll
        for (int ai = 0; ai < 2; ++ai)
#pragma unroll
            for (int m = 0; m < 4; ++m) { GAS float* rowp = C + (size_t)(row0 + ai * HALF + m * 16) * D + col0;
#pragma unroll
                for (int bj = 0; bj < 2; ++bj)
#pragma unroll
                    for (int n = 0; n < 2; ++n) { GAS f32x4* p = (GAS f32x4*)(rowp + bj * HALF + n * 16); const f32x4 old = *p; *p = old * ALPHA + acc[ai][bj][m][n]; } }
    }
};
struct EpiMoe1 {
    static constexpr bool PERM = true;
    GAS bf16* ACT;
    __device__ __forceinline__ void operator()(const f32x4 (&acc)[2][2][4][2], const Unit& u, int wr, int wc, int fr, int fq) const {
        const int row0 = u.pm * BM + wr * 64 + fr, col0 = u.pn * 128 + wc * 32 + 8 * fq;
#pragma unroll
        for (int ai = 0; ai < 2; ++ai)
#pragma unroll
            for (int m = 0; m < 4; ++m) { GAS bf16* rowp = ACT + (size_t)(row0 + ai * HALF + m * 16) * DEXP + col0;
                float o[8];
#pragma unroll
                for (int n = 0; n < 2; ++n)
#pragma unroll
                    for (int j = 0; j < 4; ++j) { const float a = acc[ai][0][m][n][j], b = acc[ai][1][m][n][j]; o[n * 4 + j] = a * fast_sigmoid(a) * b; }
                u32x4 w; w.x = cvt_pk_bf16(o[0], o[1]); w.y = cvt_pk_bf16(o[2], o[3]); w.z = cvt_pk_bf16(o[4], o[5]); w.w = cvt_pk_bf16(o[6], o[7]);
                *(GAS u32x4*)rowp = w; }
    }
};
struct EpiMoe2 {
    static constexpr bool PERM = true;
    GAS bf16* Y; const GAS float* roww;
    __device__ __forceinline__ void operator()(const f32x4 (&acc)[2][2][4][2], const Unit& u, int wr, int wc, int fr, int fq) const {
        const int row0 = u.pm * BM + wr * 64 + fr, col0 = u.pn * BM + wc * 32 + 8 * fq;
#pragma unroll
        for (int ai = 0; ai < 2; ++ai)
#pragma unroll
            for (int m = 0; m < 4; ++m) { const int row = row0 + ai * HALF + m * 16; const float rw = roww[row]; GAS bf16* rowp = Y + (size_t)row * D + col0;
#pragma unroll
                for (int bj = 0; bj < 2; ++bj) { const f32x4 v0 = acc[ai][bj][m][0] * rw, v1 = acc[ai][bj][m][1] * rw;
                    u32x4 w; w.x = cvt_pk_bf16(v0[0], v0[1]); w.y = cvt_pk_bf16(v0[2], v0[3]); w.z = cvt_pk_bf16(v1[0], v1[1]); w.w = cvt_pk_bf16(v1[2], v1[3]);
                    *(GAS u32x4*)(rowp + bj * HALF) = w; } }
    }
};

struct MergeOrder {
    const GAS char* Y[3]; const GAS char* W; int G, c;
    __device__ __forceinline__ bool next(int i, Unit& u) const {
        const int j = i / 3, r = i - 3 * j; const int L = j * G + c; if (L >= 128 * 4) return false;
        pg8::tile_of(L, 128, 4, u.pm, u.pn); u.aux = r;
        const GAS char* y = (r == 0) ? Y[0] : ((r == 1) ? Y[1] : Y[2]);
        u.A = y + (size_t)u.pm * (256 * 512 * 2); u.B = W + (size_t)r * (1024 * 512 * 2) + (size_t)u.pn * (256 * 512 * 2); return true;
    }
};
template <int KDIM> struct MoeOrder {
    const GAS char* A; const GAS char* W; const LAS int* pe; int c, NP;
    __device__ __forceinline__ bool next(int i, Unit& u) const {
        const int L = i * 256 + c; if (L >= NP * 4) return false;
        const int p = L >> 2, pn = L & 3; const int e = __builtin_amdgcn_readfirstlane(pe[p]);
        u.pm = p; u.pn = pn; u.aux = e; u.A = A + (size_t)p * (256 * KDIM * 2); u.B = W + (size_t)e * (1024 * KDIM * 2) + (size_t)pn * (256 * KDIM * 2); return true;
    }
};

struct Args {
    const float* in[23]; float* out; unsigned char* ws; int ph_lo, ph_hi;
};
struct Frame {
    LAS unsigned char* lds; int tid, lane, wave, G, wg;
    GAS float* out; GAS unsigned char* ws;
};
__device__ __forceinline__ const GAS float* inp_lds(LAS unsigned char* lds, int i) {
    const unsigned long long v = ((const LAS unsigned long long*)(lds + LARG_OFF))[i];
    const unsigned lo = __builtin_amdgcn_readfirstlane((unsigned)v), hi = __builtin_amdgcn_readfirstlane((unsigned)(v >> 32));
    return (const GAS float*)(((unsigned long long)hi << 32) | lo);
}
__device__ __forceinline__ const GAS float* inp(const Frame& F, int i) { return inp_lds(F.lds, i); }
__device__ __forceinline__ Frame fresh(LAS unsigned char* lds, int wave) {
    Frame F; int wgx = blockIdx.x; unsigned lb = (unsigned)(unsigned long long)lds;
    asm volatile("" : "+s"(wave), "+s"(wgx), "+s"(lb));
    F.lds = (LAS unsigned char*)(unsigned long long)lb;
    int ln = (int)__builtin_amdgcn_mbcnt_hi(~0u, __builtin_amdgcn_mbcnt_lo(~0u, 0u)); asm volatile("" : "+v"(ln));
    F.wave = wave; F.lane = ln; F.tid = wave * 64 + ln;
    F.G = 256; F.wg = wgx;
    F.out = (GAS float*)inp_lds(F.lds, 23); F.ws = (GAS unsigned char*)inp_lds(F.lds, 24);
    return F;
}
enum { I_X = 0, I_LN_IN_G, I_LN_IN_B, I_W_IN, I_CONV, I_A_LOG, I_DT_BIAS, I_DN_NORM, I_POOL_W, I_POOL_SCALE, I_ML_GATE_B, I_ML_NORM, I_W_BRANCH, I_W_OUT, I_LN_MIX_G, I_LN_MIX_B,
       I_ROUTER_W, I_ROUTER_B, I_MOE_W1, I_MOE_W3, I_MOE_W2, I_LN_FFN_G, I_LN_FFN_B };

__device__ __forceinline__ void tr_load(float (&r)[32], const GAS float* W, int ldw, int k0, int n0src, int lane) {
#pragma unroll
    for (int i = 0; i < 32; ++i) { const int kk = 2 * i + (lane >> 5); r[i] = W[(size_t)(k0 + kk) * ldw + n0src + (lane & 31)]; }
}
__device__ __forceinline__ void tr_store(const float (&r)[32], GAS bf16* WT, int dpitch, int k0, int drow0, LAS float* scr, int lane) {
#pragma unroll
    for (int i = 0; i < 32; ++i) { const int kk = 2 * i + (lane >> 5); scr[kk * 33 + (lane & 31)] = r[i]; }
    LDS_WAIT(); asm volatile("" ::: "memory");
    const int c = lane & 7;
#pragma unroll
    for (int j = 0; j < 4; ++j) { const int n = (lane >> 3) + 8 * j; const LAS float* s = scr + (8 * c) * 33 + n;
        u32x4 o; o.x = pk2(s[0 * 33], s[1 * 33]); o.y = pk2(s[2 * 33], s[3 * 33]); o.z = pk2(s[4 * 33], s[5 * 33]); o.w = pk2(s[6 * 33], s[7 * 33]);
        *(GAS u32x4*)(WT + (size_t)(drow0 + n) * dpitch + k0 + 8 * c) = o; }
    LDS_WAIT(); asm volatile("" ::: "memory");
}
__device__ __forceinline__ void tr_item(const GAS float* W, int ldw, int k0, int n0src, GAS bf16* WT, int dpitch, int drow0, LAS float* scr, int lane) {
    float r[32]; tr_load(r, W, ldw, k0, n0src, lane); tr_store(r, WT, dpitch, k0, drow0, scr, lane);
}
__device__ __forceinline__ void tr_segment(const Frame& F, const GAS float* W, int ldw, int K, int n0src, int ncols, GAS bf16* WT, int drow0, int& it) {
    LAS float* scr = (LAS float*)(F.lds + F.wave * 16384);
    const int gw = F.wg * NWAVES + F.wave, NGW = F.G * NWAVES;
    const int nblk = ncols / 32, nitems = (K / 64) * nblk;
    int first = (gw - (it % NGW) + NGW) % NGW;
    for (int r = first; r < nitems; r += NGW) { const int kb = r / nblk, nb = r % nblk; tr_item(W, ldw, 64 * kb, n0src + 32 * nb, WT, K, drow0 + 32 * nb, scr, F.lane); }
    it += nitems;
}
__device__ __forceinline__ void wprep_mixer(const Frame& F, int l) {
    const GAS float* win = inp(F, I_W_IN) + (size_t)l * D * DIN; int it = 0;
    GAS bf16* Wi = (GAS bf16*)(F.ws + WS_WIN); GAS bf16* Wg = (GAS bf16*)(F.ws + WS_WGATE); GAS bf16* Wb = (GAS bf16*)(F.ws + WS_WBR); GAS bf16* Wo = (GAS bf16*)(F.ws + WS_WOUT);
    tr_segment(F, win, DIN, D, C_QKV, 1536, Wi, 0, it);
    tr_segment(F, win, DIN, D, C_Z, 512, Wi, 1536, it);
    tr_segment(F, win, DIN, D, C_POOL, 512, Wi, 2048, it);
    tr_segment(F, win, DIN, D, C_MQ, 256, Wi, 2560, it);
    tr_segment(F, win, DIN, D, C_MK, 256, Wi, 2816, it);
    tr_segment(F, win, DIN, D, C_MV, 512, Wi, 3072, it);
    tr_segment(F, win, DIN, D, C_MO, 512, Wi, 3584, it);
    tr_segment(F, win, DIN, D, C_GATE, 3072, Wg, 0, it);
    const GAS float* wbr = inp(F, I_W_BRANCH) + (size_t)l * 3 * MIXW * D;
    tr_segment(F, wbr, D, MIXW, 0, D, Wb, 0, it);
    tr_segment(F, wbr + (size_t)2 * MIXW * D, D, MIXW, 0, D, Wb + (size_t)2 * D * MIXW, 0, it);
    tr_segment(F, inp(F, I_W_OUT) + (size_t)l * D * D, D, D, 0, D, Wo, 0, it);
    const GAS float* pw = inp(F, I_POOL_W) + (size_t)l * 4 * 128 * 128; const GAS float* ps = inp(F, I_POOL_SCALE) + (size_t)l * MIXW; const GAS float* wb1 = wbr + (size_t)MIXW * D;
    GAS bf16* W1 = Wb + (size_t)D * MIXW;
    for (int idx = F.wg * 512 + F.tid; idx < D * MIXW; idx += F.G * 512) {
        const int m = idx >> 10, d = idx & 1023, g = m >> 7, c = m & 127;
        float s = 0.f;
        for (int dd = 0; dd < 128; ++dd) s += pw[(g * 128 + c) * 128 + dd] * ps[g * 128 + dd] * wb1[(size_t)(g * 128 + dd) * D + d];
        W1[(size_t)d * MIXW + m] = (bf16)f2bf(s);
    }
}
__device__ __forceinline__ void wprep_moe(const Frame& F, int l) {
    GAS bf16* W13 = (GAS bf16*)(F.ws + WS_W13); GAS bf16* W2 = (GAS bf16*)(F.ws + WS_W2);
    LAS float* scr = (LAS float*)(F.lds + F.wave * 16384);
    const int gw = F.wg * NWAVES + F.wave, NGW = F.G * NWAVES;
    const GAS float* w1 = inp(F, I_MOE_W1); const GAS float* w3 = inp(F, I_MOE_W3); const GAS float* w2 = inp(F, I_MOE_W2);
#define MOE_ITEM_LOAD(R, r_) do { const int ri_ = (r_); if (ri_ < 16384) { const int e = ri_ >> 9, which = (ri_ >> 8) & 1, kb = (ri_ >> 4) & 15, nb = ri_ & 15; \
            tr_load(R, (which ? w3 : w1) + ((size_t)l * NEXP + e) * D * DEXP, DEXP, 64 * kb, nb * 32, F.lane); } \
        else if (ri_ < 24576) { const int q = ri_ - 16384, e = q >> 8, kb = (q >> 5) & 7, nb = q & 31; tr_load(R, w2 + ((size_t)l * NEXP + e) * DEXP * D, D, 64 * kb, 32 * nb, F.lane); } } while (0)
#define MOE_ITEM_STORE(R, r_) do { const int ri_ = (r_); if (ri_ < 16384) { const int e = ri_ >> 9, which = (ri_ >> 8) & 1, kb = (ri_ >> 4) & 15, nb = ri_ & 15, n0 = nb * 32; \
            tr_store(R, W13 + (size_t)e * D * D, D, 64 * kb, (n0 >> 7) * 256 + which * 128 + (n0 & 127), scr, F.lane); } \
        else if (ri_ < 24576) { const int q = ri_ - 16384, e = q >> 8, kb = (q >> 5) & 7, nb = q & 31; tr_store(R, W2 + (size_t)e * D * DEXP, DEXP, 64 * kb, 32 * nb, scr, F.lane); } } while (0)
    float ra[32], rb[32];
    MOE_ITEM_LOAD(ra, gw);
    for (int r = gw; r < 24576; r += 2 * NGW) {
        MOE_ITEM_LOAD(rb, r + NGW); MOE_ITEM_STORE(ra, r);
        MOE_ITEM_LOAD(ra, r + 2 * NGW); MOE_ITEM_STORE(rb, r + NGW);
    }
#undef MOE_ITEM_LOAD
#undef MOE_ITEM_STORE
}

__device__ __forceinline__ int w32_addr(int k, int c4) { return (k >> 1) * 256 + (((((k & 1) << 3) | c4) ^ ((k >> 1) & 15)) << 4); }
__device__ __forceinline__ void stage_w32(const Frame& F, const GAS float* src, int ldw, bool gates) {
    for (int idx = F.tid; idx < D * 8; idx += 512) {
        const int k = idx >> 3, c4 = idx & 7;
        int col = 4 * c4;
        if (gates) col = (c4 < 2) ? (C_A + 4 * c4) : (c4 < 4) ? (C_B + 4 * (c4 - 2)) : (c4 < 6) ? (C_I + 4 * (c4 - 4)) : (C_F + 4 * (c4 - 6));
        const f32x4 v = *(const GAS f32x4*)(src + (size_t)k * ldw + col);
        *(LAS f32x4*)(F.lds + w32_addr(k, c4)) = v;
    }
}
template <int MODE>
__device__ __forceinline__ void ln_phase(const Frame& F, const GAS float* gam, const GAS float* bet, const GAS float* w32src, int w32ld, bool do_proj, bool write_hb, bool dummy = false) {
    GAS float* OUTP = dummy ? (GAS float*)(F.ws + WS_R2) : F.out; GAS unsigned char* WSO = dummy ? (F.ws + WS_R2 + 40 * MiB) : F.ws;
    LAS int* lhist = (LAS int*)(F.lds + LHIST_OFF);
    if (do_proj) stage_w32(F, w32src, w32ld, MODE != 1);
    if (MODE == 1 && F.tid < 32) lhist[F.tid] = 0;
    __syncthreads();
    const int lane = F.lane;
    f32x2 gv[8], bv[8];
#pragma unroll
    for (int m = 0; m < 8; ++m) { gv[m] = *(const GAS f32x2*)(gam + 2 * lane + 128 * m); bv[m] = *(const GAS f32x2*)(bet + 2 * lane + 128 * m); }
    GAS bf16* hb = dummy ? (GAS bf16*)(F.ws + WS_R2 + 128 * MiB) : (GAS bf16*)(F.ws + WS_HB);
    const int rows_per_wg = T / F.G;
    const GAS int* posp = (const GAS int*)(F.ws + WS_POS); const GAS bf16* Yr = (const GAS bf16*)(F.ws + WS_YROWS);
    const GAS float* srcp = (MODE == 0) ? inp(F, I_X) : (const GAS float*)F.out;
#define LN_FETCH(V, Y0, Y1, row_) do { const int rw_ = (row_); \
        _Pragma("unroll") for (int m = 0; m < 8; ++m) V[m] = *(const GAS f32x2*)(srcp + (size_t)rw_ * D + 2 * lane + 128 * m); \
        if (MODE == 2) { const int p0_ = posp[2 * rw_], p1_ = posp[2 * rw_ + 1]; \
            _Pragma("unroll") for (int m = 0; m < 8; ++m) { Y0[m] = *(const GAS unsigned*)(Yr + (size_t)p0_ * D + 2 * lane + 128 * m); Y1[m] = *(const GAS unsigned*)(Yr + (size_t)p1_ * D + 2 * lane + 128 * m); } } } while (0)
    const int nrow = rows_per_wg / NWAVES, row0 = F.wg * rows_per_wg + F.wave * nrow;
    f32x2 vA[8], vB[8]; unsigned yA0[8], yA1[8], yB0[8], yB1[8];
    LN_FETCH(vA, yA0, yA1, row0);
#pragma unroll 1
    for (int i2 = 0; i2 < nrow; i2 += 2) {
#pragma unroll
      for (int half = 0; half < 2; ++half) {
        const int i = i2 + half; const int row = row0 + i;
        const int nrw = row0 + ((i + 1 < nrow) ? i + 1 : i);
        if (half == 0) LN_FETCH(vB, yB0, yB1, nrw); else LN_FETCH(vA, yA0, yA1, nrw);
        f32x2 v[8];
#pragma unroll
        for (int m = 0; m < 8; ++m) {
            const f32x2 o = half ? vB[m] : vA[m];
            if (MODE == 2) { const unsigned ya = half ? yB0[m] : yA0[m], yb = half ? yB1[m] : yA1[m];
                v[m].x = ALPHA * o.x + bf2f(ya & 0xffffu) + bf2f(yb & 0xffffu); v[m].y = ALPHA * o.y + bf2f(ya >> 16) + bf2f(yb >> 16); }
            else v[m] = o;
        }
        float s = 0.f;
#pragma unroll
        for (int m = 0; m < 8; ++m) s += v[m].x + v[m].y;
        const float mean = wave_sum(s) * (1.f / D);
        float s2 = 0.f;
#pragma unroll
        for (int m = 0; m < 8; ++m) { v[m].x -= mean; v[m].y -= mean; s2 += v[m].x * v[m].x + v[m].y * v[m].y; }
        const float rstd = 1.0f / sqrtf(wave_sum(s2) * (1.f / D) + LN_EPS);
#pragma unroll
        for (int m = 0; m < 8; ++m) { v[m].x = v[m].x * rstd * gv[m].x + bv[m].x; v[m].y = v[m].y * rstd * gv[m].y + bv[m].y; }
#pragma unroll
        for (int m = 0; m < 8; ++m) *(GAS f32x2*)(OUTP + (size_t)row * D + 2 * lane + 128 * m) = v[m];
        if (write_hb) {
#pragma unroll
            for (int m = 0; m < 8; ++m) *(GAS unsigned*)(hb + (size_t)row * D + 2 * lane + 128 * m) = pk2(v[m].x, v[m].y);
        }
        if (!do_proj) continue;
        float acc[32];
#pragma unroll
        for (int c = 0; c < 32; ++c) acc[c] = 0.f;
#pragma unroll
        for (int m = 0; m < 8; ++m) {
#pragma unroll
            for (int e = 0; e < 2; ++e) {
                asm volatile("" ::: "memory");
                const int k = 2 * lane + 128 * m + e; const float xv = e ? v[m].y : v[m].x;
#pragma unroll
                for (int c4 = 0; c4 < 8; ++c4) { const f32x4 w = *(const LAS f32x4*)(F.lds + w32_addr(k, c4));
                    acc[4 * c4 + 0] += xv * w[0]; acc[4 * c4 + 1] += xv * w[1]; acc[4 * c4 + 2] += xv * w[2]; acc[4 * c4 + 3] += xv * w[3]; }
            }
        }
        float r16[16], r8[8], r4[4], r2[2], r1;
        { const bool hi = (lane & 32) != 0;
#pragma unroll
          for (int j = 0; j < 16; ++j) { const float a = acc[j], b = acc[j + 16]; const float send = hi ? a : b, keep = hi ? b : a; r16[j] = keep + __shfl_xor(send, 32); } }
        { const bool hi = (lane & 16) != 0;
#pragma unroll
          for (int j = 0; j < 8; ++j) { const float a = r16[j], b = r16[j + 8]; const float send = hi ? a : b, keep = hi ? b : a; r8[j] = keep + __shfl_xor(send, 16); } }
        { const bool hi = (lane & 8) != 0;
#pragma unroll
          for (int j = 0; j < 4; ++j) { const float a = r8[j], b = r8[j + 4]; const float send = hi ? a : b, keep = hi ? b : a; r4[j] = keep + __shfl_xor(send, 8); } }
        { const bool hi = (lane & 4) != 0;
#pragma unroll
          for (int j = 0; j < 2; ++j) { const float a = r4[j], b = r4[j + 2]; const float send = hi ? a : b, keep = hi ? b : a; r2[j] = keep + __shfl_xor(send, 4); } }
        { const bool hi = (lane & 2) != 0; const float a = r2[0], b = r2[1]; const float send = hi ? a : b, keep = hi ? b : a; r1 = keep + __shfl_xor(send, 2); }
        r1 += __shfl_xor(r1, 1);
        if (MODE != 1) {
            if ((lane & 1) == 0) ((GAS float*)(WSO + WS_SG))[(size_t)row * 32 + (lane >> 1)] = r1;
        } else {
            const float score = sigmoidf_(r1);
            const float sel = score + inp(F, I_ROUTER_B)[lane >> 1];
            const int gb = lane & ~7;
            const float v0 = __shfl(sel, gb + 0), v1 = __shfl(sel, gb + 2), v2 = __shfl(sel, gb + 4), v3 = __shfl(sel, gb + 6);
            int i1 = 0; float m1 = v0;
            if (v1 > m1) { m1 = v1; i1 = 1; } if (v2 > m1) { m1 = v2; i1 = 2; } if (v3 > m1) { m1 = v3; i1 = 3; }
            int i2 = -1; float m2 = -3.0e38f;
            if (i1 != 0 && v0 > m2) { m2 = v0; i2 = 0; } if (i1 != 1 && v1 > m2) { m2 = v1; i2 = 1; } if (i1 != 2 && v2 > m2) { m2 = v2; i2 = 2; } if (i1 != 3 && v3 > m2) { m2 = v3; i2 = 3; }
            float gs = m1 + m2; int gi = lane >> 3;
#pragma unroll
            for (int o = 8; o < 64; o <<= 1) { const float og = __shfl_xor(gs, o); const int oi = __shfl_xor(gi, o); if (og > gs || (og == gs && oi < gi)) { gs = og; gi = oi; } }
            const int src = gi * 8;
            const int e1 = gi * 4 + __shfl(i1, src), e2 = gi * 4 + __shfl(i2, src);
            const float s1 = __shfl(score, 2 * e1), s2 = __shfl(score, 2 * e2);
            if (lane == 0) {
                GAS int* eid = (GAS int*)(WSO + WS_EID); GAS float* ew = (GAS float*)(WSO + WS_EW);
                const float inv = 1.0f / (s1 + s2);
                eid[2 * row] = e1; eid[2 * row + 1] = e2; ew[2 * row] = s1 * inv; ew[2 * row + 1] = s2 * inv;
                __hip_atomic_fetch_add(lhist + e1, 1, __ATOMIC_RELAXED, __HIP_MEMORY_SCOPE_WORKGROUP); __hip_atomic_fetch_add(lhist + e2, 1, __ATOMIC_RELAXED, __HIP_MEMORY_SCOPE_WORKGROUP);
            }
        }
      }
    }
#undef LN_FETCH
    if (MODE == 1) {
        __syncthreads();
        if (F.tid < 32) ((GAS int*)(WSO + WS_HIST))[F.wg * 32 + F.tid] = lhist[F.tid];
    }
    __syncthreads();
}

__device__ __forceinline__ int invsigma32(int w) { return 8 * ((w >> 2) & 3) + 4 * (w >> 4) + (w & 3); }
__device__ __forceinline__ float wave_incl_scan(float v, int lane) {
#pragma unroll
    for (int o = 1; o < 64; o <<= 1) { const float t = __shfl_up(v, o); if (lane >= o) v += t; }
    return v;
}
__device__ __forceinline__ float wave_incl_maxscan(float v, int lane) {
#pragma unroll
    for (int o = 1; o < 64; o <<= 1) { const float t = __shfl_up(v, o); if (lane >= o) v = fmaxf(v, t); }
    return v;
}
constexpr int DQ_OFF = 0, DK_OFF = 17408, DV_OFF = 34816, DGM_OFF = 52224, DQK_OFF = 69632, DTM_OFF = 87040, DVEC_OFF = 121856;
constexpr int QROW = 272;
constexpr int FROW = 68;
__device__ __forceinline__ bf16x8 pack_b(const f32x4 lo, const f32x4 hi) {
    u32x4 w; w.x = cvt_pk_bf16(lo[0], lo[1]); w.y = cvt_pk_bf16(lo[2], lo[3]); w.z = cvt_pk_bf16(hi[0], hi[1]); w.w = cvt_pk_bf16(hi[2], hi[3]);
    return __builtin_bit_cast(bf16x8, w);
}
__device__ __forceinline__ bf16x8 pack8f(const float (&f)[8]) {
    u32x4 w; w.x = cvt_pk_bf16(f[0], f[1]); w.y = cvt_pk_bf16(f[2], f[3]); w.z = cvt_pk_bf16(f[4], f[5]); w.w = cvt_pk_bf16(f[6], f[7]);
    return __builtin_bit_cast(bf16x8, w);
}
#define PREP_BAR() do { asm volatile("s_waitcnt lgkmcnt(0)" ::: "memory"); __builtin_amdgcn_s_barrier(); asm volatile("" ::: "memory"); } while (0)
#ifndef DNREP_A
#define DNREP_A 1
#endif
#ifndef DNREP_B
#define DNREP_B 1
#endif
#ifndef DNREP_C
#define DNREP_C 1
#endif
#ifndef DNREP_D
#define DNREP_D 1
#endif
__device__ __forceinline__ void dn_prep(const Frame& F, int l) {
    LAS unsigned char* L = F.lds;
    const int lane = F.lane, wave = F.wave, tid = F.tid, fr = lane & 15, fq = lane >> 4;
    const GAS bf16* P = (const GAS bf16*)(F.ws + WS_PQKV);
    const GAS float* SG = (const GAS float*)(F.ws + WS_SG);
    const GAS float* cw = inp(F, I_CONV) + (size_t)l * 5 * 1536;
    LAS float* GM = (LAS float*)(L + DGM_OFF); LAS float* QKM = (LAS float*)(L + DQK_OFF);
#ifdef DIAG
    unsigned long long tacc[7] = {0, 0, 0, 0, 0, 0, 0}; unsigned long long tprev = __builtin_amdgcn_s_memrealtime();
#define DSTAMP(k) do { const unsigned long long tn_ = __builtin_amdgcn_s_memrealtime(); tacc[k] += tn_ - tprev; tprev = tn_; } while (0)
#else
#define DSTAMP(k) do {} while (0)
#endif
    unsigned praw[12][3]; float pga = 0.f, pgb = 0.f;
#define DN_PF(item_) do { const int it_ = (item_) < NB * NHEAD * NCH ? (item_) : F.wg; const int b_ = it_ >> 9, h_ = (it_ >> 7) & 3, n_ = it_ & 127; \
        _Pragma("unroll") for (int rr = 0; rr < 12; ++rr) { const int sp_ = n_ * CH + 8 * wave + rr - 2; const bool ok_ = (sp_ >= 0 && sp_ < SEQ); \
            const GAS bf16* src_ = P + (size_t)(b_ * SEQ + (ok_ ? sp_ : 0)) * 1536 + h_ * 128 + 2 * lane; \
            _Pragma("unroll") for (int p = 0; p < 3; ++p) { const unsigned u_ = *(const GAS unsigned*)(src_ + p * 512); praw[rr][p] = ok_ ? u_ : 0u; } } \
        if (wave < 2) { const int ti_ = wave ? 63 - lane : lane; const int t0_ = b_ * SEQ + n_ * CH; pga = SG[(size_t)(t0_ + ti_) * 32 + wave * 4 + h_]; pgb = SG[(size_t)(t0_ + ti_) * 32 + 8 + wave * 4 + h_]; } } while (0)
    DN_PF(F.wg);
    for (int item = F.wg; item < NB * NHEAD * NCH; item += F.G) {
        const int b = item >> 9, h = (item >> 7) & 3, n = item & 127;
        const int t0 = b * SEQ + n * CH;
        for (int repA = 0; repA < DNREP_A; ++repA) {
        {
            float w[3][5][2];
#pragma unroll
            for (int p = 0; p < 3; ++p)
#pragma unroll
                for (int j = 0; j < 5; ++j) { const f32x2 t = *(const GAS f32x2*)(cw + j * 1536 + p * 512 + h * 128 + 2 * lane); w[p][j][0] = t.x; w[p][j][1] = t.y; }
#pragma unroll
            for (int ii = 0; ii < 8; ++ii) {
                const int i = 8 * wave + ii;
                float y[3][2];
#pragma unroll
                for (int p = 0; p < 3; ++p) { y[p][0] = 0.f; y[p][1] = 0.f; }
#pragma unroll
                for (int j = 0; j < 5; ++j)
#pragma unroll
                    for (int p = 0; p < 3; ++p) { const unsigned u = praw[ii + j][p]; y[p][0] += bf2f(u & 0xffffu) * w[p][j][0]; y[p][1] += bf2f(u >> 16) * w[p][j][1]; }
#pragma unroll
                for (int p = 0; p < 3; ++p) { y[p][0] = y[p][0] * fast_sigmoid(y[p][0]); y[p][1] = y[p][1] * fast_sigmoid(y[p][1]); }
                const float sq = wave_sum(y[0][0] * y[0][0] + y[0][1] * y[0][1]), sk = wave_sum(y[1][0] * y[1][0] + y[1][1] * y[1][1]);
                const float rq = __builtin_amdgcn_rsqf(sq + NORM_EPS) * 0.08838834764831845f, rk = __builtin_amdgcn_rsqf(sk + NORM_EPS);
                *(LAS unsigned*)(L + DQ_OFF + i * QROW + 4 * lane) = cvt_pk_bf16(y[0][0] * rq, y[0][1] * rq);
                *(LAS unsigned*)(L + DK_OFF + i * QROW + 4 * lane) = cvt_pk_bf16(y[1][0] * rk, y[1][1] * rk);
                *(LAS unsigned*)(L + DV_OFF + i * QROW + 4 * lane) = cvt_pk_bf16(y[2][0], y[2][1]);
            }
            if (wave < 2) {
                const int d = wave; const int ti = d ? 63 - lane : lane;
                const float a = pga, bb = pgb;
                const float beta = sigmoidf_(bb);
                const float g = -expf(inp(F, I_A_LOG)[l * 8 + d * 4 + h]) * softplusf_(a + inp(F, I_DT_BIAS)[l * 8 + d * 4 + h]);
                const float gc = wave_incl_scan(g, lane);
                const float gl = __shfl(gc, 63);
                LAS float* vec = (LAS float*)(L + DVEC_OFF + d * 1024);
                vec[lane] = beta; vec[64 + lane] = gc; vec[128 + lane] = expf(gc); vec[192 + lane] = expf(gl - gc);
                if (lane == 63) ((GAS float*)(F.ws + WS_GL))[(size_t)item * 2 + d] = expf(gc);
            }
        }
        PREP_BAR();
        DSTAMP(0);
        }
        for (int repB = 0; repB < DNREP_B; ++repB) {
        {
#pragma unroll
            for (int tt = 0; tt < 2; ++tt) {
                const int t = 2 * wave + tt, mt = t >> 2, nt = t & 3;
                f32x4 ag = (f32x4){0.f, 0.f, 0.f, 0.f}, aq = (f32x4){0.f, 0.f, 0.f, 0.f};
#pragma unroll
                for (int s = 0; s < 4; ++s) {
                    const bf16x8 ka = *(const LAS bf16x8*)(L + DK_OFF + (16 * mt + fr) * QROW + 64 * s + 16 * fq);
                    const bf16x8 qa = *(const LAS bf16x8*)(L + DQ_OFF + (16 * mt + fr) * QROW + 64 * s + 16 * fq);
                    const bf16x8 kb = *(const LAS bf16x8*)(L + DK_OFF + (16 * nt + fr) * QROW + 64 * s + 16 * fq);
                    ag = __builtin_amdgcn_mfma_f32_16x16x32_bf16(ka, kb, ag, 0, 0, 0);
                    aq = __builtin_amdgcn_mfma_f32_16x16x32_bf16(qa, kb, aq, 0, 0, 0);
                }
#pragma unroll
                for (int r = 0; r < 4; ++r) { GM[(16 * mt + 4 * fq + r) * FROW + 16 * nt + fr] = ag[r]; QKM[(16 * mt + 4 * fq + r) * FROW + 16 * nt + fr] = aq[r]; }
            }
        }
        PREP_BAR();
        DSTAMP(1);
        }
        for (int repC = 0; repC < DNREP_C; ++repC) {
        {
#pragma unroll 4
            for (int e = 0; e < 16; ++e) {
                const int idx = tid + 512 * e, d = idx >> 12, i = (idx >> 6) & 63, j = idx & 63;
                const LAS float* vec = (const LAS float*)(L + DVEC_OFF + d * 1024);
                const int ti = d ? 63 - i : i, tj = d ? 63 - j : j;
                float v = (j < i) ? vec[i] * GM[ti * FROW + tj] * fexp(fminf(vec[64 + i] - vec[64 + j], 0.f)) : 0.f;
                if ((i & 31) == 0 && j >= (i & 32)) v = (j == i) ? 1.f : 0.f;
                *(LAS float*)(L + DTM_OFF + d * 17408 + (i * FROW + j) * 4) = v;
            }
        }
        PREP_BAR();
        DSTAMP(2);
        if (wave < 4) {
            const int d = wave >> 1, hb = wave & 1, c = lane & 31;
            LAS float* TM = (LAS float*)(L + DTM_OFF + d * 17408) + (32 * hb) * FROW + 32 * hb;
#define SUBST_PART(NB4, BASE) do { f32x4 m4[NB4]; float tv_[4 * NB4]; \
                _Pragma("unroll") for (int q = 0; q < NB4; ++q) m4[q] = *(const LAS f32x4*)(TM + i * FROW + (BASE) + 4 * q); \
                _Pragma("unroll") for (int q = 0; q < 4 * NB4; ++q) tv_[q] = TM[((BASE) + q) * FROW + c]; \
                _Pragma("unroll") for (int q = 0; q < NB4; ++q) { a0 -= m4[q][0] * tv_[4 * q]; a1 -= m4[q][1] * tv_[4 * q + 1]; a2 -= m4[q][2] * tv_[4 * q + 2]; a3 -= m4[q][3] * tv_[4 * q + 3]; } } while (0)
#define SUBST_END() do { const float tv = ((c == i) ? 1.f : 0.f) + ((a0 + a1) + (a2 + a3)); asm volatile("s_waitcnt lgkmcnt(0)" ::: "memory"); TM[i * FROW + c] = tv; } while (0)
#pragma unroll 1
            for (int i = 1; i < 16; ++i) { float a0 = 0.f, a1 = 0.f, a2 = 0.f, a3 = 0.f; SUBST_PART(4, 0); SUBST_END(); }
#pragma unroll 1
            for (int i = 16; i < 32; ++i) { float a0 = 0.f, a1 = 0.f, a2 = 0.f, a3 = 0.f; SUBST_PART(4, 0); asm volatile("" ::: "memory"); SUBST_PART(4, 16); SUBST_END(); }
#undef SUBST_PART
#undef SUBST_END
        } else {
            const int tw = wave - 4;
            for (int it = tw; it < 128; it += 4) {
                const int d = it >> 6, i = it & 63, ti = d ? 63 - i : i;
                const LAS float* vec = (const LAS float*)(L + DVEC_OFF + d * 1024);
                GAS unsigned char* rec = F.ws + WS_R2 + ((size_t)item * 2 + d) * DNREC;
                { const int p = 2 * lane; const int kk = (p & ~31) + sigma32(p & 31);
                  const unsigned u = *(const LAS unsigned*)(L + DQ_OFF + ti * QROW + 2 * kk); const float e = vec[128 + i];
                  *(GAS unsigned*)(rec + DN_QG + (i * 128 + p) * 2) = cvt_pk_bf16(bf2f(u & 0xffffu) * e, bf2f(u >> 16) * e); }
                { const int p = lane; const int j = (p & ~31) + sigma32(p & 31), tj = d ? 63 - j : j;
                  const float v = (j <= i) ? QKM[ti * FROW + tj] * fexp(fminf(vec[64 + i] - vec[64 + j], 0.f)) : 0.f;
                  ((GAS bf16*)(rec + DN_ATT))[i * 64 + p] = (bf16)f2bf(v); }
            }
            for (int it = tw; it < 128; it += 4) {
                const int d = it >> 6, kk = 2 * (it & 63);
                const LAS float* vec = (const LAS float*)(L + DVEC_OFF + d * 1024);
                GAS bf16* Kd = (GAS bf16*)(F.ws + WS_R2 + ((size_t)item * 2 + d) * DNREC + DN_KDT);
                const int p = lane; const int j = (p & ~31) + sigma32(p & 31), tj = d ? 63 - j : j;
                const unsigned u = *(const LAS unsigned*)(L + DK_OFF + tj * QROW + 2 * kk); const float e = vec[192 + j];
                Kd[kk * 64 + p] = (bf16)f2bf(bf2f(u & 0xffffu) * e); Kd[(kk + 1) * 64 + p] = (bf16)f2bf(bf2f(u >> 16) * e);
            }
        }
        PREP_BAR();
        DSTAMP(3);
        if (wave < 2) {
            LAS float* TM = (LAS float*)(L + DTM_OFF + wave * 17408);
            bf16x8 am[2], bt[2];
#pragma unroll
            for (int mt = 0; mt < 2; ++mt) { const f32x4 lo = *(const LAS f32x4*)(TM + (32 + 16 * mt + fr) * FROW + 8 * fq), hi = *(const LAS f32x4*)(TM + (32 + 16 * mt + fr) * FROW + 8 * fq + 4); am[mt] = pack_b(lo, hi); }
#pragma unroll
            for (int nt = 0; nt < 2; ++nt) { float xf[8];
#pragma unroll
                for (int e = 0; e < 8; ++e) xf[e] = TM[(8 * fq + e) * FROW + 16 * nt + fr];
                bt[nt] = pack8f(xf); }
            f32x4 X[2][2];
#pragma unroll
            for (int mt = 0; mt < 2; ++mt)
#pragma unroll
                for (int nt = 0; nt < 2; ++nt) X[mt][nt] = __builtin_amdgcn_mfma_f32_16x16x32_bf16(am[mt], bt[nt], (f32x4){0.f, 0.f, 0.f, 0.f}, 0, 0, 0);
            bf16x8 xb[2], a2[2];
#pragma unroll
            for (int nt = 0; nt < 2; ++nt) xb[nt] = pack_b(X[0][nt], X[1][nt]);
#pragma unroll
            for (int mt = 0; mt < 2; ++mt) { const f32x4 lo = *(const LAS f32x4*)(TM + (32 + 16 * mt + fr) * FROW + 32 + 4 * fq), hi = *(const LAS f32x4*)(TM + (32 + 16 * mt + fr) * FROW + 32 + 16 + 4 * fq); a2[mt] = pack_b(lo, hi); }
#pragma unroll
            for (int mt = 0; mt < 2; ++mt)
#pragma unroll
                for (int nt = 0; nt < 2; ++nt) { const f32x4 t21 = __builtin_amdgcn_mfma_f32_16x16x32_bf16(a2[mt], xb[nt], (f32x4){0.f, 0.f, 0.f, 0.f}, 0, 0, 0);
#pragma unroll
                    for (int r = 0; r < 4; ++r) TM[(32 + 16 * mt + 4 * fq + r) * FROW + 16 * nt + fr] = -t21[r]; }
        }
        PREP_BAR();
        DSTAMP(4);
        }
        DN_PF(item + F.G);
        for (int repD = 0; repD < DNREP_D; ++repD) {
#pragma unroll 1
        for (int d = 0; d < 2; ++d) {
            const LAS float* TM = (const LAS float*)(L + DTM_OFF + d * 17408);
            const LAS float* vec = (const LAS float*)(L + DVEC_OFF + d * 1024);
            GAS unsigned char* rec = F.ws + WS_R2 + ((size_t)item * 2 + d) * DNREC;
            bf16x8 ta[4][2];
#pragma unroll
            for (int mt = 0; mt < 4; ++mt)
#pragma unroll
                for (int s = 0; s < 2; ++s) { const f32x4 lo = *(const LAS f32x4*)(TM + (16 * mt + fr) * FROW + 32 * s + 8 * fq), hi = *(const LAS f32x4*)(TM + (16 * mt + fr) * FROW + 32 * s + 8 * fq + 4); ta[mt][s] = pack_b(lo, hi); }
#pragma unroll 1
            for (int tt = 0; tt < 2; ++tt) {
                const int nt = 2 * wave + tt; const bool isv = nt < 8; const int col = 16 * (nt & 7) + fr;
                const int imgoff = isv ? DV_OFF : DK_OFF;
                bf16x8 xb[2];
#pragma unroll
                for (int s = 0; s < 2; ++s) { float xf[8];
#pragma unroll
                    for (int e = 0; e < 8; ++e) { const int j = 32 * s + 8 * fq + e, tj = d ? 63 - j : j;
                        const float x = bf2f(*(const LAS unsigned short*)(L + imgoff + tj * QROW + 2 * col));
                        xf[e] = x * vec[j] * (isv ? 1.f : vec[128 + j]); }
                    xb[s] = pack8f(xf); }
                f32x4 acc[4];
#pragma unroll
                for (int mt = 0; mt < 4; ++mt) { acc[mt] = (f32x4){0.f, 0.f, 0.f, 0.f};
#pragma unroll
                    for (int s = 0; s < 2; ++s) acc[mt] = __builtin_amdgcn_mfma_f32_16x16x32_bf16(ta[mt][s], xb[s], acc[mt], 0, 0, 0); }
                if (isv) {
                    GAS bf16* Uf = (GAS bf16*)(rec + DN_UF) + ((nt * 64 + lane) * 16);
#pragma unroll
                    for (int mt = 0; mt < 4; ++mt) { u32x2 w2; w2.x = cvt_pk_bf16(acc[mt][0], acc[mt][1]); w2.y = cvt_pk_bf16(acc[mt][2], acc[mt][3]); *(GAS u32x2*)(Uf + mt * 4) = w2; }
                } else {
                    GAS bf16* Wp = (GAS bf16*)(rec + DN_W); const int pos = (col & ~31) + invsigma32(col & 31);
#pragma unroll
                    for (int mt = 0; mt < 4; ++mt)
#pragma unroll
                        for (int r = 0; r < 4; ++r) Wp[(16 * mt + 4 * fq + r) * 128 + pos] = (bf16)f2bf(acc[mt][r]);
                }
            }
        }
        PREP_BAR();
        DSTAMP(5);
        }
    }
#ifdef DIAG
    if (F.tid == 0 && F.wg == 0 && l == 0) { for (int k = 0; k < 6; ++k) ((GAS unsigned long long*)(F.ws + WS_CTL + 1024))[48 + k] = tacc[k]; }
#endif
}

__device__ __forceinline__ int swz256(int row, int c16) { return row * 256 + ((c16 ^ (row & 15)) << 4); }
__device__ __forceinline__ int swz128(int row, int c8) { return (row >> 1) * 256 + (((((row & 1) << 3) | c8) ^ ((row >> 1) & 15)) << 4); }
constexpr int DNBUF = 57344;
#define SCAN_BAR() do { asm volatile("s_waitcnt lgkmcnt(0)" ::: "memory"); __builtin_amdgcn_s_barrier(); asm volatile("" ::: "memory"); } while (0)
__device__ __forceinline__ void dn_scan(const Frame& F) {
    if (F.wg >= 64) return;
    const int xcd = F.wg & 7, idx = F.wg >> 3;
    const int chain = xcd * 4 + (idx >> 1), hf = idx & 1;
    const int b = chain >> 3, h = (chain >> 1) & 3, d = chain & 1;
    const int lane = F.lane, fr = lane & 15, fq = lane >> 4, wave = F.wave;
    LAS unsigned char* L = F.lds;
    const GAS unsigned char* recbase = F.ws + WS_R2;
    const int itembase = (b * NHEAD + h) * NCH;
    if (wave >= 4) {
        const int tl = F.tid - 256;
        u32x4 ra[14], rb[14];
        int woff[14];
#pragma unroll
        for (int i = 0; i < 14; ++i) { const int q = tl + 256 * i;
            if (i < 4) woff[i] = swz256(q >> 4, q & 15); else if (i < 8) woff[i] = 16384 + swz256((q - 1024) >> 4, q & 15);
            else if (i < 12) woff[i] = 32768 + swz128((q - 2048) >> 3, q & 7); else woff[i] = 49152 + swz128((q - 3072) >> 3, q & 7); }
#define DN_LOAD(R, step_) do { const int st_ = (step_) < NCH ? (step_) : NCH - 1; const int n_ = d ? (NCH - 1 - st_) : st_; \
        const GAS u32x4* src_ = (const GAS u32x4*)(recbase + ((size_t)(itembase + n_) * 2 + d) * DNREC) + tl; \
        _Pragma("unroll") for (int i = 0; i < 14; ++i) R[i] = src_[256 * i]; } while (0)
#define DN_WRITE(R, bufoff_) do { _Pragma("unroll") for (int i = 0; i < 14; ++i) *(LAS u32x4*)(L + (bufoff_) + woff[i]) = R[i]; } while (0)
        u32x4 rc[14];
        DN_LOAD(ra, 0); DN_LOAD(rb, 1); DN_LOAD(rc, 2);
        DN_WRITE(ra, 0);
        SCAN_BAR();
        for (int s = 0; s < 126; s += 6) {
            DN_LOAD(ra, s + 3); DN_WRITE(rb, DNBUF); SCAN_BAR();
            DN_LOAD(rb, s + 4); DN_WRITE(rc, 0);     SCAN_BAR();
            DN_LOAD(rc, s + 5); DN_WRITE(ra, DNBUF); SCAN_BAR();
            DN_LOAD(ra, s + 6); DN_WRITE(rb, 0);     SCAN_BAR();
            DN_LOAD(rb, s + 7); DN_WRITE(rc, DNBUF); SCAN_BAR();
            DN_LOAD(rc, s + 8); DN_WRITE(ra, 0);     SCAN_BAR();
        }
        DN_WRITE(rb, DNBUF); SCAN_BAR();
        SCAN_BAR();
#undef DN_LOAD
#undef DN_WRITE
        return;
    }
    const int slice = hf * 4 + wave;
    const GAS float* GL = (const GAS float*)(F.ws + WS_GL);
    GAS bf16* O = (GAS bf16*)(F.ws + (d ? WS_OB : WS_OF));
    f32x4 S[8];
#pragma unroll
    for (int k = 0; k < 8; ++k) S[k] = (f32x4){0.f, 0.f, 0.f, 0.f};
    int offw[4], offk[8], offa[4];
#pragma unroll
    for (int t = 0; t < 4; ++t) { offw[t] = (16 * t + fr) * 256; offa[t] = ((16 * t + fr) >> 1) * 256; }
#pragma unroll
    for (int t = 0; t < 8; ++t) offk[t] = ((16 * t + fr) >> 1) * 256;
    const int x256 = fr & 15;
    const int x128 = (fr >> 1) & 15, p128 = (fr & 1) << 3;
    u32x4 uc0, uc1, un0, un1; float egl_c, egl_n;
#define DN_UFETCH(A0, A1, EG, step_) do { const int st_ = (step_) < NCH ? (step_) : NCH - 1; const int nn_ = d ? (NCH - 1 - st_) : st_; \
        const GAS bf16* Uf_ = (const GAS bf16*)(recbase + ((size_t)(itembase + nn_) * 2 + d) * DNREC + DN_UF); A0 = *(const GAS u32x4*)(Uf_ + (slice * 64 + lane) * 16); A1 = *(const GAS u32x4*)(Uf_ + (slice * 64 + lane) * 16 + 8); \
        EG = GL[(size_t)(itembase + nn_) * 2 + d]; } while (0)
    DN_UFETCH(uc0, uc1, egl_c, 0); DN_UFETCH(un0, un1, egl_n, 1);
    SCAN_BAR();
    for (int step = 0; step < NCH; ++step) {
        const int n = d ? (NCH - 1 - step) : step;
        const int bufoff = (step & 1) ? DNBUF : 0;
        const u32x4 u0 = uc0, u1 = uc1; const float egl = egl_c;
        uc0 = un0; uc1 = un1; egl_c = egl_n;
        DN_UFETCH(un0, un1, egl_n, step + 2);
        const LAS unsigned char* Bw = L + bufoff; const LAS unsigned char* Bq = Bw + 16384; const LAS unsigned char* Bk = Bw + 32768; const LAS unsigned char* Ba = Bw + 49152;
#define LD_WQ(G, s_) do { _Pragma("unroll") for (int mt = 0; mt < 4; ++mt) { const int o_ = offw[mt] + (((4 * (s_) + fq) ^ x256) << 4); G[mt] = *(const LAS bf16x8*)(Bw + o_); G[4 + mt] = *(const LAS bf16x8*)(Bq + o_); } } while (0)
#define MM_WQ(G, s_) do { _Pragma("unroll") for (int mt = 0; mt < 4; ++mt) { V[mt] = __builtin_amdgcn_mfma_f32_16x16x32_bf16(G[mt], SB[s_], V[mt], 0, 0, 0); Q[mt] = __builtin_amdgcn_mfma_f32_16x16x32_bf16(SB[s_], G[4 + mt], Q[mt], 0, 0, 0); } } while (0)
#define LD_K(G, s2_) do { _Pragma("unroll") for (int kt = 0; kt < 8; ++kt) { const int xr_ = (8 * kt + (fr >> 1)) & 15; G[kt] = *(const LAS bf16x8*)(Bk + offk[kt] + (((p128 | (4 * (s2_) + fq)) ^ xr_) << 4)); } } while (0)
#define SCHED_() __builtin_amdgcn_sched_barrier(0)
        bf16x8 g0[8], g1[8];
        LD_WQ(g0, 0);
        bf16x8 SB[4];
#pragma unroll
        for (int s = 0; s < 4; ++s) SB[s] = pack_b(S[2 * s], S[2 * s + 1]);
        f32x4 V[4], Q[4];
#pragma unroll
        for (int mt = 0; mt < 4; ++mt) { V[mt] = (f32x4){0.f, 0.f, 0.f, 0.f}; Q[mt] = (f32x4){0.f, 0.f, 0.f, 0.f}; }
        SCHED_(); LD_WQ(g1, 1); SCHED_(); MM_WQ(g0, 0); SCHED_();
        LD_WQ(g0, 2); SCHED_(); MM_WQ(g1, 1); SCHED_();
        LD_WQ(g1, 3); SCHED_(); MM_WQ(g0, 2); SCHED_();
#pragma unroll
        for (int s2 = 0; s2 < 2; ++s2)
#pragma unroll
            for (int mt = 0; mt < 4; ++mt) { const int xr = (8 * mt + (fr >> 1)) & 15; g0[s2 * 4 + mt] = *(const LAS bf16x8*)(Ba + offa[mt] + (((p128 | (4 * s2 + fq)) ^ xr) << 4)); }
        SCHED_(); MM_WQ(g1, 3); SCHED_();
        LD_K(g1, 0); SCHED_();
        {
            float uu[16]; { float t[8]; unpack8(u0, t);
#pragma unroll
                for (int e = 0; e < 8; ++e) uu[e] = t[e]; unpack8(u1, t);
#pragma unroll
                for (int e = 0; e < 8; ++e) uu[8 + e] = t[e]; }
#pragma unroll
            for (int mt = 0; mt < 4; ++mt)
#pragma unroll
                for (int r = 0; r < 4; ++r) V[mt][r] = uu[mt * 4 + r] - V[mt][r];
        }
        bf16x8 VB[2];
#pragma unroll
        for (int s2 = 0; s2 < 2; ++s2) VB[s2] = pack_b(V[2 * s2], V[2 * s2 + 1]);
#pragma unroll
        for (int kt = 0; kt < 8; ++kt) S[kt] = S[kt] * egl;
        SCHED_();
#pragma unroll
        for (int s2 = 0; s2 < 2; ++s2)
#pragma unroll
            for (int mt = 0; mt < 4; ++mt) Q[mt] = __builtin_amdgcn_mfma_f32_16x16x32_bf16(VB[s2], g0[s2 * 4 + mt], Q[mt], 0, 0, 0);
        SCHED_(); LD_K(g0, 1); SCHED_();
#pragma unroll
        for (int kt = 0; kt < 8; ++kt) S[kt] = __builtin_amdgcn_mfma_f32_16x16x32_bf16(g1[kt], VB[0], S[kt], 0, 0, 0);
        SCHED_();
#pragma unroll
        for (int kt = 0; kt < 8; ++kt) S[kt] = __builtin_amdgcn_mfma_f32_16x16x32_bf16(g0[kt], VB[1], S[kt], 0, 0, 0);
        SCHED_();
#undef LD_WQ
#undef MM_WQ
#undef LD_K
#undef SCHED_
#pragma unroll
        for (int mt = 0; mt < 4; ++mt) {
            const int i = 16 * mt + fr; const int tok = b * SEQ + n * CH + (d ? 63 - i : i);
            u32x2 w2; w2.x = cvt_pk_bf16(Q[mt][0], Q[mt][1]); w2.y = cvt_pk_bf16(Q[mt][2], Q[mt][3]);
            *(GAS u32x2*)(O + (size_t)tok * MIXW + h * HD + slice * 16 + 4 * fq) = w2;
        }
        SCAN_BAR();
    }
}

constexpr int MQ_OFF = 0, MK_OFF = 9216, MV_OFF = 18432, MQK_OFF = 35840, MVEC_OFF = 52480;
constexpr int MQROW = 144;
#ifndef MLREP_1
#define MLREP_1 1
#endif
#ifndef MLREP_2
#define MLREP_2 1
#endif
#ifndef MLREP_3
#define MLREP_3 1
#endif
#ifndef MLREP_4
#define MLREP_4 1
#endif
#ifndef POOLREP
#define POOLREP 1
#endif
__device__ __forceinline__ void ml_prep(const Frame& F, int l) {
    LAS unsigned char* L = F.lds;
    const int lane = F.lane, wave = F.wave, tid = F.tid;
    const GAS bf16* PQ = (const GAS bf16*)(F.ws + WS_PMQ); const GAS bf16* PK = (const GAS bf16*)(F.ws + WS_PMK); const GAS bf16* PV = (const GAS bf16*)(F.ws + WS_PMV);
    const GAS float* SG = (const GAS float*)(F.ws + WS_SG);
    const GAS float* gbias = inp(F, I_ML_GATE_B) + l * 16;
    u32x4 pq, pk, pv0, pv1; float pip = 0.f, pfp = 0.f;
#define ML_PF(item_) do { const int it_ = (item_) < NB * NHEAD * NCH ? (item_) : F.wg; const int b_ = it_ >> 9, h_ = (it_ >> 7) & 3, n_ = it_ & 127; const int t0_ = b_ * SEQ + n_ * CH; \
        const int row_ = tid >> 3, c8_ = tid & 7; \
        pq = *(const GAS u32x4*)(PQ + (size_t)(t0_ + row_) * 256 + h_ * 64 + 8 * c8_); pk = *(const GAS u32x4*)(PK + (size_t)(t0_ + row_) * 256 + h_ * 64 + 8 * c8_); \
        pv0 = *(const GAS u32x4*)(PV + (size_t)(t0_ + (tid >> 4)) * 512 + h_ * 128 + 8 * (tid & 15)); pv1 = *(const GAS u32x4*)(PV + (size_t)(t0_ + 32 + (tid >> 4)) * 512 + h_ * 128 + 8 * (tid & 15)); \
        if (wave < 2) { const int ti_ = wave ? 63 - lane : lane; pip = SG[(size_t)(t0_ + ti_) * 32 + 16 + wave * 4 + h_]; pfp = SG[(size_t)(t0_ + ti_) * 32 + 24 + wave * 4 + h_]; } } while (0)
    ML_PF(F.wg);
    for (int item = F.wg; item < NB * NHEAD * NCH; item += F.G) {
        const int b = item >> 9, h = (item >> 7) & 3, n = item & 127;
        const int t0 = b * SEQ + n * CH;
        float ip_raw = pip, fp_raw = pfp;
        for (int rep1 = 0; rep1 < MLREP_1; ++rep1) {
        {
            const int row = tid >> 3, c8 = tid & 7;
            u32x4 k = pk;
            { float f[8]; unpack8(k, f); k.x = pk2(f[0] * 0.125f, f[1] * 0.125f); k.y = pk2(f[2] * 0.125f, f[3] * 0.125f); k.z = pk2(f[4] * 0.125f, f[5] * 0.125f); k.w = pk2(f[6] * 0.125f, f[7] * 0.125f); }
            *(LAS u32x4*)(L + MQ_OFF + row * MQROW + 16 * c8) = pq;
            *(LAS u32x4*)(L + MK_OFF + row * MQROW + 16 * c8) = k;
            *(LAS u32x4*)(L + MV_OFF + (tid >> 4) * QROW + 16 * (tid & 15)) = pv0;
            *(LAS u32x4*)(L + MV_OFF + (32 + (tid >> 4)) * QROW + 16 * (tid & 15)) = pv1;
            ML_PF(item + F.G);
        }
        PREP_BAR();
        }
        for (int rep2 = 0; rep2 < MLREP_2; ++rep2) {
        {
            const int fr = lane & 15, fq = lane >> 4;
#pragma unroll
            for (int tt = 0; tt < 2; ++tt) {
                const int t = 2 * wave + tt, mt = t >> 2, nt = t & 3;
                f32x4 aq = (f32x4){0.f, 0.f, 0.f, 0.f};
#pragma unroll
                for (int s2 = 0; s2 < 2; ++s2) {
                    const bf16x8 qa = *(const LAS bf16x8*)(L + MQ_OFF + (16 * mt + fr) * MQROW + 64 * s2 + 16 * fq);
                    const bf16x8 kb = *(const LAS bf16x8*)(L + MK_OFF + (16 * nt + fr) * MQROW + 64 * s2 + 16 * fq);
                    aq = __builtin_amdgcn_mfma_f32_16x16x32_bf16(qa, kb, aq, 0, 0, 0);
                }
#pragma unroll
                for (int r = 0; r < 4; ++r) *(LAS float*)(L + MQK_OFF + ((16 * mt + 4 * fq + r) * 65 + 16 * nt + fr) * 4) = aq[r];
            }
        }
        }
        for (int rep3 = 0; rep3 < MLREP_3; ++rep3) {
        if (wave < 2) {
            const int d = wave; const int ti = d ? 63 - lane : lane;
            const float ip = ip_raw + gbias[d * 4 + h];
            const float fp = fp_raw + gbias[8 + d * 4 + h];
            const float bc = wave_incl_scan(logsigmoidf_(fp), lane);
            const float bl = __shfl(bc, 63);
            const float lw = bl - bc + ip;
            const float am = wave_max(lw);
            const float wgt = expf(lw - am);
            const float ipb = ip - bc;
            const float dmax = bc + wave_incl_maxscan(ipb, lane);
            LAS float* vec = (LAS float*)(L + MVEC_OFF + d * 1024);
            vec[lane] = bc; vec[64 + lane] = dmax; vec[128 + lane] = wgt; vec[192 + lane] = ipb;
            GAS float* row = (GAS float*)(F.ws + WS_ML + ((size_t)item * 2 + d) * MLREC + ML_ROW);
            row[lane] = bc; row[64 + lane] = dmax; if (lane == 0) { row[128] = am; row[129] = bl; }
        }
        PREP_BAR();
        }
        for (int rep4 = 0; rep4 < MLREP_4; ++rep4) {
        {
            const LAS float* QKM = (const LAS float*)(L + MQK_OFF);
            for (int it = wave; it < 128; it += NWAVES) {
                const int d = it >> 6, i = it & 63, j = lane;
                const LAS float* vec = (const LAS float*)(L + MVEC_OFF + d * 1024);
                GAS unsigned char* rec = F.ws + WS_ML + ((size_t)item * 2 + d) * MLREC;
                const int ti = d ? 63 - i : i, tj = d ? 63 - j : j;
                const float sv = (j <= i) ? QKM[ti * 65 + tj] * fexp(fminf(vec[i] + vec[192 + j] - vec[64 + i], 0.f)) : 0.f;
                ((GAS bf16*)(rec + ML_ST))[i * 64 + j] = (bf16)f2bf(sv);
                ((GAS bf16*)(rec + ML_Q))[i * 64 + j] = *(const LAS unsigned short*)(L + MQ_OFF + ti * MQROW + 2 * ((j & ~31) + sigma32(j & 31)));
                const float kv = bf2f(*(const LAS unsigned short*)(L + MK_OFF + tj * MQROW + 2 * i));
                ((GAS bf16*)(rec + ML_KWT))[i * 64 + j] = (bf16)f2bf(kv * vec[128 + j]);
            }
            for (int it = wave; it < 36; it += NWAVES) {
                const int d = it / 18, q = it - 18 * d, slice = q >> 1, s2 = q & 1;
                GAS unsigned char* rec = F.ws + WS_ML + ((size_t)item * 2 + d) * MLREC;
                const int fr = lane & 15, fq = lane >> 4;
                unsigned short e8[8];
#pragma unroll
                for (int el = 0; el < 8; ++el) { const int j = 32 * s2 + 8 * fq + el; const int tj = d ? 63 - j : j;
                    e8[el] = (slice < 8) ? *(const LAS unsigned short*)(L + MV_OFF + tj * QROW + 2 * (16 * slice + fr)) : (unsigned short)0x3F80; }
                u32x4 w; w.x = e8[0] | ((unsigned)e8[1] << 16); w.y = e8[2] | ((unsigned)e8[3] << 16); w.z = e8[4] | ((unsigned)e8[5] << 16); w.w = e8[6] | ((unsigned)e8[7] << 16);
                *(GAS u32x4*)(rec + ML_VF + (((slice * 2 + s2) * 64 + lane) * 8) * 2) = w;
            }
        }
        PREP_BAR();
        }
    }
}
constexpr int MLBUF = 25600;
__device__ __forceinline__ void ml_scan(const Frame& F) {
    if (F.wg >= 64) return;
    const int xcd = F.wg & 7, idx = F.wg >> 3;
    const int chain = xcd * 4 + (idx >> 1), hf = idx & 1;
    const int b = chain >> 3, h = (chain >> 1) & 3, d = chain & 1;
    const int lane = F.lane, fr = lane & 15, fq = lane >> 4, wave = F.wave;
    LAS unsigned char* L = F.lds;
    const GAS unsigned char* recbase = F.ws + WS_ML;
    const int itembase = (b * NHEAD + h) * NCH;
    if (wave >= 5) {
        const int tl = F.tid - 320;
        u32x4 ra[9], rb[9]; int woff[9], goff[9];
#pragma unroll
        for (int i = 0; i < 9; ++i) { const int q = tl + 192 * i;
            if (q < 1536) { const int qq = q & 511; woff[i] = (q >> 9) * 8192 + swz128(qq >> 3, qq & 7); goff[i] = q; }
            else if (q < 1600) { woff[i] = 24576 + (q - 1536) * 16; goff[i] = 2688 + (q - 1536); }
            else { woff[i] = -1; goff[i] = 0; } }
#define ML_LOAD(R, step_) do { const int st_ = (step_) < NCH ? (step_) : NCH - 1; const int n_ = d ? (NCH - 1 - st_) : st_; \
        const GAS u32x4* src_ = (const GAS u32x4*)(recbase + ((size_t)(itembase + n_) * 2 + d) * MLREC); \
        _Pragma("unroll") for (int i = 0; i < 9; ++i) R[i] = src_[goff[i]]; } while (0)
#define ML_WRITE(R, bufoff_) do { _Pragma("unroll") for (int i = 0; i < 9; ++i) if (woff[i] >= 0) *(LAS u32x4*)(L + (bufoff_) + woff[i]) = R[i]; } while (0)
        ML_LOAD(ra, 0); ML_LOAD(rb, 1);
        ML_WRITE(ra, 0);
        SCAN_BAR();
        for (int s = 0; s < NCH; s += 2) {
            ML_LOAD(ra, s + 2); ML_WRITE(rb, MLBUF); SCAN_BAR();
            ML_LOAD(rb, s + 3); ML_WRITE(ra, 0);     SCAN_BAR();
        }
#undef ML_LOAD
#undef ML_WRITE
        return;
    }
    const int slice = (wave < 4) ? hf * 4 + wave : 8;
    const bool active = (wave < 4) || (hf == 1);
    GAS bf16* NUM = (GAS bf16*)(F.ws + (d ? WS_NUMB : WS_NUMF)); GAS float* DEN = (GAS float*)(F.ws + WS_DEN);
    f32x4 C[4];
#pragma unroll
    for (int k = 0; k < 4; ++k) C[k] = (f32x4){0.f, 0.f, 0.f, 0.f};
    float m = 0.f;
    int offr[4];
#pragma unroll
    for (int t = 0; t < 4; ++t) offr[t] = ((16 * t + fr) >> 1) * 256;
    const int p128 = (fr & 1) << 3;
    bf16x8 vc0, vc1, vn0, vn1;
#define ML_VFETCH(A0, A1, step_) do { const int st_ = (step_) < NCH ? (step_) : NCH - 1; const int nn_ = d ? (NCH - 1 - st_) : st_; \
        const GAS bf16* Vf_ = (const GAS bf16*)(recbase + ((size_t)(itembase + nn_) * 2 + d) * MLREC + ML_VF); \
        A0 = *(const GAS bf16x8*)(Vf_ + ((slice * 2 + 0) * 64 + lane) * 8); A1 = *(const GAS bf16x8*)(Vf_ + ((slice * 2 + 1) * 64 + lane) * 8); } while (0)
    ML_VFETCH(vc0, vc1, 0); ML_VFETCH(vn0, vn1, 1);
    SCAN_BAR();
    for (int step = 0; step < NCH; ++step) {
        const int n = d ? (NCH - 1 - step) : step;
        const int bufoff = (step & 1) ? MLBUF : 0;
        bf16x8 VF[2]; VF[0] = vc0; VF[1] = vc1;
        vc0 = vn0; vc1 = vn1;
        ML_VFETCH(vn0, vn1, step + 2);
        if (active) {
        const LAS unsigned char* Bq = L + bufoff; const LAS unsigned char* Bs = Bq + 8192; const LAS unsigned char* Bk = Bq + 16384; const LAS float* row = (const LAS float*)(Bq + 24576);
        const float am = row[128], bl = row[129];
        bf16x8 CB[2];
#pragma unroll
        for (int s = 0; s < 2; ++s) CB[s] = pack_b(C[2 * s], C[2 * s + 1]);
        bf16x8 fq_[8], fs_[8], fk_[8];
#pragma unroll
        for (int s = 0; s < 2; ++s)
#pragma unroll
            for (int mt = 0; mt < 4; ++mt) { const int xr = (8 * mt + (fr >> 1)) & 15; const int o = offr[mt] + (((p128 | (4 * s + fq)) ^ xr) << 4);
                fq_[s * 4 + mt] = *(const LAS bf16x8*)(Bq + o); fs_[s * 4 + mt] = *(const LAS bf16x8*)(Bs + o); fk_[s * 4 + mt] = *(const LAS bf16x8*)(Bk + o); }
        f32x4 QC[4], SV[4], KV[4];
#pragma unroll
        for (int mt = 0; mt < 4; ++mt) { QC[mt] = (f32x4){0.f, 0.f, 0.f, 0.f}; SV[mt] = (f32x4){0.f, 0.f, 0.f, 0.f}; KV[mt] = (f32x4){0.f, 0.f, 0.f, 0.f}; }
#pragma unroll
        for (int s = 0; s < 2; ++s)
#pragma unroll
            for (int mt = 0; mt < 4; ++mt) {
                QC[mt] = __builtin_amdgcn_mfma_f32_16x16x32_bf16(CB[s], fq_[s * 4 + mt], QC[mt], 0, 0, 0);
                SV[mt] = __builtin_amdgcn_mfma_f32_16x16x32_bf16(VF[s], fs_[s * 4 + mt], SV[mt], 0, 0, 0);
                KV[mt] = __builtin_amdgcn_mfma_f32_16x16x32_bf16(fk_[s * 4 + mt], VF[s], KV[mt], 0, 0, 0);
            }
#pragma unroll
        for (int mt = 0; mt < 4; ++mt) {
            const int i = 16 * mt + fr; const int tok = b * SEQ + n * CH + (d ? 63 - i : i);
            const float bci = row[i], dmi = row[64 + i];
            const float il = bci + m, mo = fmaxf(il, dmi);
            const float inter = fexp(il - mo), e2 = fexp(dmi - mo);
            const f32x4 res = QC[mt] * inter + SV[mt] * e2;
            if (slice < 8) { u32x2 w2; w2.x = cvt_pk_bf16(res[0], res[1]); w2.y = cvt_pk_bf16(res[2], res[3]); *(GAS u32x2*)(NUM + (size_t)tok * MIXW + h * HD + slice * 16 + 4 * fq) = w2; }
            else if (fq == 0) DEN[(size_t)tok * 8 + h * 2 + d] = fmaxf(fabsf(res[0]), fexp(-mo));
        }
        const float mn = fmaxf(bl + m, am), sp = fexp(bl + m - mn), sc = fexp(am - mn);
#pragma unroll
        for (int kt = 0; kt < 4; ++kt) C[kt] = C[kt] * sp + KV[kt] * sc;
        m = mn;
        }
        SCAN_BAR();
    }
}

template <int H>
__device__ __forceinline__ void pool_block(const GAS bf16* U, GAS bf16* Y, int t0, int g, int lane) {
    constexpr int NR = 32 + 2 * H;
    const int sp0 = t0 & (SEQ - 1);
    float x0[NR], x1[NR];
#pragma unroll
    for (int r = 0; r < NR; ++r) {
        const int sp = sp0 - H + r; const bool ok = (sp >= 0 && sp < SEQ);
        const unsigned u = ok ? *(const GAS unsigned*)(U + (size_t)(t0 - H + r) * MIXW + 128 * g + 2 * lane) : 0u;
        x0[r] = bf2f(u & 0xffffu); x1[r] = bf2f(u >> 16);
    }
    float s0 = 0.f, s1 = 0.f;
#pragma unroll
    for (int r = 0; r < 2 * H; ++r) { s0 += x0[r]; s1 += x1[r]; }
#pragma unroll
    for (int t = 0; t < 32; ++t) {
        const int sp = sp0 + t; const int cnt = min(sp + H, SEQ) - max(sp - H, 0);
        const float inv = 1.0f / (float)cnt;
        *(GAS unsigned*)(Y + (size_t)(t0 + t) * MIXW + 128 * g + 2 * lane) = cvt_pk_bf16(s0 * inv - x0[t + H], s1 * inv - x1[t + H]);
        if (t < 31) { s0 += x0[t + 2 * H] - x0[t]; s1 += x1[t + 2 * H] - x1[t]; }
    }
}
__device__ __forceinline__ void pool_phase(const Frame& F) {
    const GAS bf16* U = (const GAS bf16*)(F.ws + WS_PPOOL); GAS bf16* Y = (GAS bf16*)(F.ws + WS_YP);
    const int gw = F.wg * NWAVES + F.wave, NGW = F.G * NWAVES, lane = F.lane;
    for (int prep = 0; prep < POOLREP; ++prep)
    for (int task = gw; task < (T / 32) * 4; task += NGW) {
        const int g = task & 3, t0 = (task >> 2) * 32;
        if (g == 0) pool_block<1>(U, Y, t0, g, lane); else if (g == 1) pool_block<2>(U, Y, t0, g, lane); else if (g == 2) pool_block<4>(U, Y, t0, g, lane); else pool_block<8>(U, Y, t0, g, lane);
    }
}

__device__ __forceinline__ void norm_phase(const Frame& F, int l, bool dummy = false) {
    const GAS bf16* OF = (const GAS bf16*)(F.ws + WS_OF); const GAS bf16* OB = (const GAS bf16*)(F.ws + WS_OB);
    const GAS bf16* NF = (const GAS bf16*)(F.ws + WS_NUMF); const GAS bf16* NBk = (const GAS bf16*)(F.ws + WS_NUMB); const GAS float* DEN = (const GAS float*)(F.ws + WS_DEN);
    GAS bf16* Z = (GAS bf16*)(F.ws + WS_PZ); GAS bf16* MO = (GAS bf16*)(F.ws + WS_PMO);
    GAS bf16* ZO = dummy ? (GAS bf16*)(F.ws + WS_GATE) : Z; GAS bf16* MOO = dummy ? (GAS bf16*)(F.ws + WS_GATE + 32 * MiB) : MO;
    const int gw = F.wg * NWAVES + F.wave, NGW = F.G * NWAVES, lane = F.lane, h = lane >> 4;
    float nw[8], mw[8];
#pragma unroll
    for (int e = 0; e < 8; ++e) { nw[e] = inp(F, I_DN_NORM)[l * MIXW + 8 * lane + e]; mw[e] = inp(F, I_ML_NORM)[l * MIXW + 8 * lane + e]; }
    for (int t = gw; t < T; t += NGW) {
        const size_t off = (size_t)t * MIXW + 8 * lane;
        {
            float a[8], bq[8], z[8]; unpack8(*(const GAS u32x4*)(OF + off), a); unpack8(*(const GAS u32x4*)(OB + off), bq); unpack8(*(const GAS u32x4*)(Z + off), z);
            float ss = 0.f;
#pragma unroll
            for (int e = 0; e < 8; ++e) { a[e] += bq[e]; ss += a[e] * a[e]; }
            ss += __shfl_xor(ss, 1); ss += __shfl_xor(ss, 2); ss += __shfl_xor(ss, 4); ss += __shfl_xor(ss, 8);
            const float r = 1.0f / sqrtf(ss * (1.f / HD) + NORM_EPS);
            float o[8];
#pragma unroll
            for (int e = 0; e < 8; ++e) o[e] = a[e] * r * nw[e] * siluf_(z[e]);
            u32x4 w; w.x = pk2(o[0], o[1]); w.y = pk2(o[2], o[3]); w.z = pk2(o[4], o[5]); w.w = pk2(o[6], o[7]);
            *(GAS u32x4*)(ZO + off) = w;
        }
        {
            float a[8], bq[8], g[8]; unpack8(*(const GAS u32x4*)(NF + off), a); unpack8(*(const GAS u32x4*)(NBk + off), bq); unpack8(*(const GAS u32x4*)(MO + off), g);
            const float df = 1.0f / DEN[(size_t)t * 8 + h * 2], db = 1.0f / DEN[(size_t)t * 8 + h * 2 + 1];
            float s = 0.f;
#pragma unroll
            for (int e = 0; e < 8; ++e) { a[e] = a[e] * df + bq[e] * db; s += a[e]; }
            s += __shfl_xor(s, 1); s += __shfl_xor(s, 2); s += __shfl_xor(s, 4); s += __shfl_xor(s, 8);
            const float mean = s * (1.f / HD); float ss = 0.f;
#pragma unroll
            for (int e = 0; e < 8; ++e) { a[e] -= mean; ss += a[e] * a[e]; }
            ss += __shfl_xor(ss, 1); ss += __shfl_xor(ss, 2); ss += __shfl_xor(ss, 4); ss += __shfl_xor(ss, 8);
            const float r = 1.0f / sqrtf(ss * (1.f / HD) + NORM_EPS);
            float o[8];
#pragma unroll
            for (int e = 0; e < 8; ++e) o[e] = a[e] * r * mw[e] * sigmoidf_(g[e]);
            u32x4 w; w.x = pk2(o[0], o[1]); w.y = pk2(o[2], o[3]); w.z = pk2(o[4], o[5]); w.w = pk2(o[6], o[7]);
            *(GAS u32x4*)(MOO + off) = w;
        }
    }
}

__device__ __forceinline__ void moe_tables(const Frame& F) {
    LAS int* cnt = (LAS int*)(F.lds + LHIST_OFF + 128); LAS int* pstart = (LAS int*)(F.lds + LHIST_OFF + 256); LAS int* mybase = (LAS int*)(F.lds + LHIST_OFF + 384);
    LAS int* pe = (LAS int*)(F.lds + LPE_OFF);
    const GAS int* hist = (const GAS int*)(F.ws + WS_HIST);
    if (F.tid < 32) { cnt[F.tid] = 0; mybase[F.tid] = 0; }
    __syncthreads();
    { const int e = F.tid & 31, part = F.tid >> 5; int tot = 0, base = 0;
      for (int q = 0; q < 16; ++q) { const int w = part * 16 + q; const int v = hist[w * 32 + e]; tot += v; base += v * min(max(F.wg - w, 0), 1); }
      __hip_atomic_fetch_add(cnt + e, tot, __ATOMIC_RELAXED, __HIP_MEMORY_SCOPE_WORKGROUP); __hip_atomic_fetch_add(mybase + e, base, __ATOMIC_RELAXED, __HIP_MEMORY_SCOPE_WORKGROUP); }
    __syncthreads();
    if (F.tid == 0) { int acc = 0, p = 0; for (int e = 0; e < NEXP; ++e) { pstart[e] = acc; const int np = (cnt[e] + 255) >> 8; for (int q = 0; q < np; ++q) pe[p++] = e; acc += np * 256; } pe[319] = p; }
    __syncthreads();
}
__device__ __forceinline__ void moe_dispatch(const Frame& F) {
    moe_tables(F);
    LAS int* pstart = (LAS int*)(F.lds + LHIST_OFF + 256); LAS int* mybase = (LAS int*)(F.lds + LHIST_OFF + 384);
    LAS int* lpos = (LAS int*)(F.lds);
    LAS int* le = (LAS int*)(F.lds + 1024);
    const GAS int* eid = (const GAS int*)(F.ws + WS_EID); const GAS float* ew = (const GAS float*)(F.ws + WS_EW);
    GAS int* pos = (GAS int*)(F.ws + WS_POS); GAS float* roww = (GAS float*)(F.ws + WS_ROWW);
    const int rows_per_wg = T / F.G, row0 = F.wg * rows_per_wg;
    int my_e = 0; float my_w = 0.f;
    if (F.tid < 256) { my_e = eid[2 * row0 + F.tid]; my_w = ew[2 * row0 + F.tid]; le[F.tid] = my_e; }
    __syncthreads();
    if (F.tid < 256) {
        int rank = 0;
        for (int a = 0; a < F.tid; ++a) rank += (le[a] == my_e) ? 1 : 0;
        const int p = pstart[my_e] + mybase[my_e] + rank;
        lpos[F.tid] = p; pos[2 * row0 + F.tid] = p; roww[p] = my_w;
    }
    __syncthreads();
    const GAS bf16* hb = (const GAS bf16*)(F.ws + WS_HB); GAS bf16* Xs = (GAS bf16*)(F.ws + WS_XS);
    for (int a = F.wave; a < 2 * rows_per_wg; a += NWAVES) {
        const int t = row0 + (a >> 1), p = lpos[a];
        const GAS u32x4* src = (const GAS u32x4*)(hb + (size_t)t * D); GAS u32x4* dst = (GAS u32x4*)(Xs + (size_t)p * D);
        dst[F.lane] = src[F.lane]; dst[64 + F.lane] = src[64 + F.lane];
    }
    __syncthreads();
}

constexpr int NPHASE = 1 + 15 * DEPTH;
#ifndef PHM
#define PHM 0xFFFF
#endif
#define PHON(b) ((PHM >> (b)) & 1)
#ifndef REPEAT_PHASE
#define REPEAT_PHASE -1
#endif
#define NREP(k) (((k) == REPEAT_PHASE) ? 2 : 1)
__global__ void __launch_bounds__(NWAVES * 64, 2) mega_fwd(Args args) {
    extern __shared__ __attribute__((aligned(16))) unsigned char lds_raw[];
    LAS unsigned char* lds = (LAS unsigned char*)lds_raw;
    const int wave = __builtin_amdgcn_readfirstlane((int)threadIdx.x >> 6);
    for (int u = threadIdx.x; u < (LDS_BYTES - RING_BYTES) / 4; u += NWAVES * 64) ((LAS unsigned*)(lds + RING_BYTES))[u] = 0u;
    __syncthreads();
    if (threadIdx.x == 0) { LAS unsigned long long* ap = (LAS unsigned long long*)(lds + LARG_OFF);
#pragma unroll
        for (int i = 0; i < 23; ++i) ap[i] = (unsigned long long)args.in[i];
        ap[23] = (unsigned long long)args.out; ap[24] = (unsigned long long)args.ws; }
    __syncthreads();
    const int lo = args.ph_lo, hi = args.ph_hi;
    if (hi - lo > 1) { const XcdBarrier b0 = xcd_barrier_post((unsigned*)(args.ws + WS_CTL) + CW_BAR, (volatile LAS unsigned*)(lds + MISC_OFF) + 8);
        if (threadIdx.x == 0) ((volatile LAS unsigned*)(lds + MISC_OFF))[10] = b0.x; }
    __syncthreads();
#ifdef DIAG
    if (threadIdx.x == 0 && blockIdx.x == 0 && lo == 0) ((unsigned long long*)(args.ws + WS_CTL + 1024))[0] = __builtin_amdgcn_s_memrealtime();
#endif
    int ph = lo, rep = 0;
#pragma unroll 1
    while (ph < hi) {
        const Frame F = fresh(lds, wave);
        const bool DRY = (REPEAT_PHASE >= 0) && (rep == 0) && (((ph >= 1) ? ((ph - 1) % 15) : 15) == REPEAT_PHASE);
        const int l = (ph >= 1) ? (ph - 1) / 15 : 0;
        const int k = (ph >= 1) ? (ph - 1) - 15 * l : 15;
        if (PHON(15) && k == 15) {
            wprep_mixer(F, 0);
            __syncthreads();
            ln_phase<0>(F, inp(F, I_LN_IN_G), inp(F, I_LN_IN_B), inp(F, I_W_IN), DIN, true, true, DRY);
        } else if (PHON(0) && k == 0) {
            pg8::StaticOrder S; S.init(F.ws + WS_HB, F.ws + WS_WIN, T, 1536, D, F.G, F.wg);
            EpiG1a E{(GAS bf16*)(F.ws + WS_PQKV)};
            pg8::gemm_phase<EpiG1a, pg8::StaticOrder>(F.lds, F.tid, D, S, E);
        } else if (PHON(1) && k == 1) { dn_prep(F, l);
        } else if (PHON(2) && k == 2) { dn_scan(F);
        } else if (PHON(3) && k == 3) {
            pg8::StaticOrder S; S.init(F.ws + WS_HB, F.ws + WS_WIN + (size_t)1536 * D * 2, T, 2560, D, F.G, F.wg);
            EpiG1b E{F.ws};
            pg8::gemm_phase<EpiG1b, pg8::StaticOrder>(F.lds, F.tid, D, S, E);
        } else if (PHON(4) && k == 4) { pool_phase(F); ml_prep(F, l);
        } else if (PHON(5) && k == 5) { ml_scan(F);
        } else if (PHON(6) && k == 6) { norm_phase(F, l, DRY);
        } else if (PHON(7) && k == 7) {
            pg8::StaticOrder S; S.init(F.ws + WS_HB, F.ws + WS_WGATE, T, 3072, D, F.G, F.wg);
            EpiGate E{(GAS bf16*)(F.ws + WS_GATE)};
            pg8::gemm_phase<EpiGate, pg8::StaticOrder>(F.lds, F.tid, D, S, E);
        } else if (PHON(8) && k == 8) {
            MergeOrder S; S.Y[0] = (const GAS char*)(F.ws + WS_PZ); S.Y[1] = (const GAS char*)(F.ws + WS_YP); S.Y[2] = (const GAS char*)(F.ws + WS_PMO); S.W = (const GAS char*)(F.ws + WS_WBR); S.G = F.G; S.c = F.wg;
            EpiMerge E{(const GAS bf16*)(F.ws + WS_GATE), (GAS bf16*)(F.ws + WS_MRGP), (GAS bf16*)(F.ws + WS_HB)};
            pg8::gemm_phase<EpiMerge, MergeOrder>(F.lds, F.tid, MIXW, S, E);
        } else if (PHON(9) && k == 9) {
            pg8::StaticOrder S; S.init(F.ws + WS_HB, F.ws + WS_WOUT, T, D, D, F.G, F.wg);
            EpiOut E{DRY ? (GAS float*)(F.ws + WS_R2) : F.out};
            pg8::gemm_phase<EpiOut, pg8::StaticOrder>(F.lds, F.tid, D, S, E);
        } else if (PHON(10) && k == 10) {
            wprep_moe(F, l);
            __syncthreads();
            ln_phase<1>(F, inp(F, I_LN_MIX_G) + l * D, inp(F, I_LN_MIX_B) + l * D, inp(F, I_ROUTER_W), 32, true, true, DRY);
        } else if (PHON(11) && k == 11) { moe_dispatch(F);
        } else if (PHON(12) && k == 12) {
            moe_tables(F);
            MoeOrder<D> S; S.A = (const GAS char*)(F.ws + WS_XS); S.W = (const GAS char*)(F.ws + WS_W13); S.pe = (const LAS int*)(F.lds + LPE_OFF); S.c = F.wg; S.NP = __builtin_amdgcn_readfirstlane(S.pe[319]);
            EpiMoe1 E{(GAS bf16*)(F.ws + WS_ACT)};
            pg8::gemm_phase<EpiMoe1, MoeOrder<D>>(F.lds, F.tid, D, S, E);
        } else if (PHON(13) && k == 13) {
            moe_tables(F);
            MoeOrder<DEXP> S; S.A = (const GAS char*)(F.ws + WS_ACT); S.W = (const GAS char*)(F.ws + WS_W2); S.pe = (const LAS int*)(F.lds + LPE_OFF); S.c = F.wg; S.NP = __builtin_amdgcn_readfirstlane(S.pe[319]);
            EpiMoe2 E{(GAS bf16*)(F.ws + WS_YROWS), (const GAS float*)(F.ws + WS_ROWW)};
            pg8::gemm_phase<EpiMoe2, MoeOrder<DEXP>>(F.lds, F.tid, DEXP, S, E);
        } else if (PHON(14)) {
            const bool last = (l == DEPTH - 1);
            if (!last) { wprep_mixer(F, l + 1); __syncthreads(); }
            ln_phase<2>(F, inp(F, I_LN_FFN_G) + l * D, inp(F, I_LN_FFN_B) + l * D, inp(F, I_W_IN) + (size_t)(last ? l : l + 1) * D * DIN, DIN, !last, !last, DRY);
        }
        const bool again = (k == REPEAT_PHASE) && (rep == 0);
        if (again) rep = 1; else { rep = 0; ++ph; }
        if (ph < hi) { XcdBarrier bar; bar.bar = (unsigned*)(unsigned char*)(F.ws + WS_CTL) + CW_BAR; bar.st = (volatile LAS unsigned*)(F.lds + MISC_OFF) + 8; bar.x = __builtin_amdgcn_readfirstlane(bar.st[2]); xcd_barrier(bar, F.tid); }
#ifdef DIAG
        if (!again && F.tid == 0 && F.wg == 0) ((unsigned long long*)(F.ws + WS_CTL + 1024))[ph] = __builtin_amdgcn_s_memrealtime();
#endif
    }
}

#ifndef N_LAUNCH_MODE
#define N_LAUNCH_MODE 1
#endif
extern "C" void kernel_launch(void* const* d_in, const int* in_sizes, int n_in, void* d_out, int out_size, void* d_ws, size_t ws_size, hipStream_t stream) {
    static int grid = 0;
    if (grid == 0) {
        if (n_in != 23 || out_size != T * D || ws_size < WS_END) { fprintf(stderr, "kernel_launch: unexpected shapes (n_in %d out %d ws %zu)\n", n_in, out_size, ws_size); grid = -1; return; }
        int dev = 0, cus = 0, per_cu = 0;
        if (hipGetDevice(&dev) != hipSuccess || hipDeviceGetAttribute(&cus, hipDeviceAttributeMultiprocessorCount, dev) != hipSuccess) { grid = -1; return; }
        if (hipFuncSetAttribute((const void*)mega_fwd, hipFuncAttributeMaxDynamicSharedMemorySize, LDS_BYTES) != hipSuccess) { fprintf(stderr, "kernel_launch: hipFuncSetAttribute failed\n"); grid = -1; return; }
        (void)hipOccupancyMaxActiveBlocksPerMultiprocessor(&per_cu, (const void*)mega_fwd, NWAVES * 64, LDS_BYTES);
        (void)hipGetLastError();
        grid = cus;
        if (grid != 256) { fprintf(stderr, "kernel_launch: built for 256 CUs, got %d\n", cus); grid = -1; return; }
    }
    if (grid < 0) return;
    (void)hipMemsetAsync((char*)d_ws + WS_CTL, 0, CTL_ZERO_BYTES, stream);
    Args a{};
    for (int i = 0; i < 23; ++i) a.in[i] = (const float*)d_in[i];
    a.out = (float*)d_out; a.ws = (unsigned char*)d_ws;
#if defined(DIAG) && DIAG >= 100
    {
        a.ph_lo = 0; a.ph_hi = NPHASE;
        hipLaunchKernelGGL(mega_fwd, dim3(grid), dim3(NWAVES * 64), LDS_BYTES, stream, a);
        hipLaunchKernelGGL(diag_fill_t, dim3(1024), dim3(256), 0, stream, (float*)d_out, (unsigned char*)d_ws, out_size, (int)(DIAG - 100));
    }
#elif defined(DIAG)
    {
        const int his[12] = {0, 2, 3, 6, 15, 10, 6, 9, 2, 2, 5, 9};
        const int grids[12] = {0, 64, 2, 2, 16, 64, 64, 64, 64, 64, 64, 64}, blocks[12] = {0, 256, 128, 128, 256, 256, 256, 256, 256, 256, 256, 256};
        a.ph_lo = 0; a.ph_hi = his[DIAG];
        hipLaunchKernelGGL(mega_fwd, dim3(grid), dim3(NWAVES * 64), LDS_BYTES, stream, a);
        static int once = 0; if (!once) { once = 1; (void)hipFuncSetAttribute((const void*)diag_kernel, hipFuncAttributeMaxDynamicSharedMemorySize, 81920); }
        DArgs da{}; for (int i = 0; i < 23; ++i) da.in[i] = (const float*)d_in[i]; da.out = (float*)d_out; da.ws = (unsigned char*)d_ws; da.mode = DIAG; da.pad = 0;
        hipLaunchKernelGGL(diag_kernel, dim3(grids[DIAG]), dim3(blocks[DIAG]), 81920, stream, da);
        if (DIAG == 2 || DIAG == 3) {
            a.ph_lo = his[DIAG]; a.ph_hi = his[DIAG] + 1;
            hipLaunchKernelGGL(mega_fwd, dim3(grid), dim3(NWAVES * 64), LDS_BYTES, stream, a);
            da.mode = DIAG + 10;
            hipLaunchKernelGGL(diag_kernel, dim3(2), dim3(128), 81920, stream, da);
        }
        hipLaunchKernelGGL(diag_fill, dim3(1024), dim3(256), 0, stream, (float*)d_out, (unsigned char*)d_ws, out_size);
    }
#elif N_LAUNCH_MODE == 1
    a.ph_lo = 0; a.ph_hi = NPHASE;
    hipLaunchKernelGGL(mega_fwd, dim3(grid), dim3(NWAVES * 64), LDS_BYTES, stream, a);
#else
    for (int p = 0; p < NPHASE; ++p) { a.ph_lo = p; a.ph_hi = p + 1; hipLaunchKernelGGL(mega_fwd, dim3(grid), dim3(NWAVES * 64), LDS_BYTES, stream, a); }
#endif
}
```

```cpp
#include <hip/hip_runtime.h>
#include <cstdio>
#include <cstdint>

#define LAS __attribute__((address_space(3)))
#define GAS __attribute__((address_space(1)))
typedef unsigned short bf16;
typedef short bf16x8 __attribute__((ext_vector_type(8)));
typedef float f32x4 __attribute__((ext_vector_type(4)));
typedef float f32x2 __attribute__((ext_vector_type(2)));
typedef unsigned u32x4 __attribute__((ext_vector_type(4)));
typedef unsigned u32x2 __attribute__((ext_vector_type(2)));
#define RLX_AGENT __ATOMIC_RELAXED, __HIP_MEMORY_SCOPE_AGENT
#define LDS_WAIT() asm volatile("s_waitcnt lgkmcnt(0)" ::: "memory")
#define VM_WAIT() asm volatile("s_waitcnt vmcnt(0)" ::: "memory")

constexpr int NB = 4, SEQ = 8192, T = NB * SEQ, D = 1024, DEPTH = 2;
constexpr int DIN = 7200;
constexpr int MIXW = 512, NHEAD = 4, HD = 128, CH = 64, NCH = SEQ / CH;
constexpr int MLQK = 64;
constexpr int NEXP = 32, DEXP = 512;
constexpr float LN_EPS = 1e-5f, NORM_EPS = 1e-6f;
constexpr float ALPHA = 1.41421356237309515f;
constexpr int NWAVES = 8;
constexpr int NREC = NB * NHEAD * NCH * 2;

constexpr int C_QKV = 0, C_Z = 1536, C_A = 2048, C_B = 2056, C_POOL = 2064, C_MQ = 2576, C_MK = 2832, C_MV = 3088, C_MO = 3600, C_I = 4112, C_F = 4120, C_GATE = 4128;

constexpr size_t MiB = 1u << 20;
constexpr size_t WS_CTL = 0, CTL_ZERO_BYTES = 64 * 1024;
constexpr int CW_BAR = 4096;
constexpr size_t WS_HIST = 1 * MiB;
constexpr size_t WS_EID = WS_HIST + 64 * 1024;
constexpr size_t WS_EW = WS_EID + 256 * 1024;
constexpr size_t WS_POS = WS_EW + 256 * 1024;
constexpr size_t WS_ROWW = WS_POS + 256 * 1024;
constexpr size_t WS_GL = WS_ROWW + 512 * 1024;
constexpr size_t WS_ROWTOK = 3 * MiB;
constexpr size_t WS_WIN = 4 * MiB;
constexpr size_t WS_WGATE = 12 * MiB;
constexpr size_t WS_WBR = 18 * MiB;
constexpr size_t WS_WOUT = 21 * MiB;
constexpr size_t WS_HB = 24 * MiB;
constexpr size_t WS_SG = 88 * MiB;
constexpr size_t WS_DEN = 92 * MiB;
constexpr size_t WS_R1 = 93 * MiB;
constexpr size_t WS_PQKV = WS_R1;
constexpr size_t WS_OF = WS_R1, WS_OB = WS_R1 + 32 * MiB;
constexpr size_t WS_MRGP = WS_R1;
constexpr size_t WS_W13 = WS_R1, WS_W2 = WS_R1 + 64 * MiB;
constexpr size_t WS_R2 = 189 * MiB;
constexpr size_t DNREC = 73728;
constexpr size_t DN_W = 0, DN_QG = 16384, DN_KDT = 32768, DN_ATT = 49152, DN_UF = 57344;
constexpr size_t WS_PZ = 189 * MiB, WS_PPOOL = 221 * MiB, WS_PMQ = 253 * MiB, WS_PMK = 269 * MiB, WS_PMV = 285 * MiB, WS_PMO = 317 * MiB;
constexpr size_t WS_YP = 349 * MiB;
constexpr size_t WS_NUMF = 253 * MiB, WS_NUMB = 285 * MiB;
constexpr size_t WS_FIN = 253 * MiB;
constexpr size_t WS_ML = 381 * MiB;
constexpr size_t MLREC = 44032;
constexpr size_t ML_Q = 0, ML_ST = 8192, ML_KWT = 16384, ML_VF = 24576, ML_ROW = 43008;
constexpr size_t WS_GATE = 381 * MiB;
constexpr size_t WS_XS = 189 * MiB, WS_ACT = 333 * MiB, WS_YROWS = 405 * MiB;
constexpr size_t WS_END = 573 * MiB;
constexpr int MOE_ROWS = 73728;
static_assert(WS_ML + (size_t)NREC * MLREC <= WS_END + 15 * MiB, "ml records");
static_assert(WS_YROWS + (size_t)MOE_ROWS * 1024 * 2 <= WS_END, "moe rows");

constexpr int RING_BYTES = 131072;
constexpr int MISC_OFF = RING_BYTES + 320;
constexpr int LHIST_OFF = RING_BYTES + 1024;
constexpr int LPE_OFF = RING_BYTES + 2048;
constexpr int LARG_OFF = RING_BYTES + 4096;
constexpr int LDS_BYTES = 147456;

__device__ __forceinline__ float bf2f(unsigned b) { return __uint_as_float(b << 16); }
__device__ __forceinline__ unsigned f2bf(float f) { unsigned u = __float_as_uint(f); return (u + 0x7fffu + ((u >> 16) & 1u)) >> 16; }
__device__ __forceinline__ unsigned pk2(float lo, float hi) { return f2bf(lo) | (f2bf(hi) << 16); }
__device__ __forceinline__ float wave_sum(float v) {
    v += __int_as_float(__builtin_amdgcn_update_dpp(0, __float_as_int(v), 0xB1, 0xf, 0xf, true));
    v += __int_as_float(__builtin_amdgcn_update_dpp(0, __float_as_int(v), 0x4E, 0xf, 0xf, true));
    v += __int_as_float(__builtin_amdgcn_update_dpp(0, __float_as_int(v), 0x141, 0xf, 0xf, true));
    v += __int_as_float(__builtin_amdgcn_update_dpp(0, __float_as_int(v), 0x140, 0xf, 0xf, true));
    const int iv = __float_as_int(v);
    return (__int_as_float(__builtin_amdgcn_readlane(iv, 0)) + __int_as_float(__builtin_amdgcn_readlane(iv, 16))) + (__int_as_float(__builtin_amdgcn_readlane(iv, 32)) + __int_as_float(__builtin_amdgcn_readlane(iv, 48)));
}
__device__ __forceinline__ float wave_max(float v) {
    v = fmaxf(v, __int_as_float(__builtin_amdgcn_update_dpp(0, __float_as_int(v), 0xB1, 0xf, 0xf, true)));
    v = fmaxf(v, __int_as_float(__builtin_amdgcn_update_dpp(0, __float_as_int(v), 0x4E, 0xf, 0xf, true)));
    v = fmaxf(v, __int_as_float(__builtin_amdgcn_update_dpp(0, __float_as_int(v), 0x141, 0xf, 0xf, true)));
    v = fmaxf(v, __int_as_float(__builtin_amdgcn_update_dpp(0, __float_as_int(v), 0x140, 0xf, 0xf, true)));
    const int iv = __float_as_int(v);
    return fmaxf(fmaxf(__int_as_float(__builtin_amdgcn_readlane(iv, 0)), __int_as_float(__builtin_amdgcn_readlane(iv, 16))), fmaxf(__int_as_float(__builtin_amdgcn_readlane(iv, 32)), __int_as_float(__builtin_amdgcn_readlane(iv, 48))));
}
__device__ __forceinline__ float fexp(float x) { return __builtin_amdgcn_exp2f(x * 1.44269504089f); }
__device__ __forceinline__ float sigmoidf_(float x) { return 1.0f / (1.0f + expf(-x)); }
__device__ __forceinline__ float siluf_(float x) { return x / (1.0f + expf(-x)); }
__device__ __forceinline__ float softplusf_(float x) { return fmaxf(x, 0.f) + log1pf(expf(-fabsf(x))); }
__device__ __forceinline__ float logsigmoidf_(float x) { return fminf(x, 0.f) - log1pf(expf(-fabsf(x))); }
__host__ __device__ __forceinline__ int sigma32(int p) { const int fq = p >> 3, j = p & 7; return 16 * (j >> 2) + 4 * fq + (j & 3); }

#define XB_TMO      128
#define XB_XCNT(j)  (256  + 64 * (j))
#define XB_XSUB(j)  (1280 + 64 * (j))
#define XB_XGEN(j)  (2304 + 64 * (j))
#define XB_TOP      3328
#define XB_TOPGEN   3392
#define XCD_BAR_WORDS 3456
#define XB_SPIN_CAP (1u << 20)
__device__ __forceinline__ unsigned xb_ld(unsigned* p)              { return __hip_atomic_load(p, __ATOMIC_RELAXED, __HIP_MEMORY_SCOPE_AGENT); }
__device__ __forceinline__ unsigned xb_add(unsigned* p, unsigned v) { return __hip_atomic_fetch_add(p, v, __ATOMIC_RELAXED, __HIP_MEMORY_SCOPE_AGENT); }
__device__ __forceinline__ unsigned xb_xcc_id() { return (unsigned)__builtin_amdgcn_s_getreg((3 << 11) | 20) & 0xFu; }
#define XB_SPIN(cond, bar) do { unsigned _sp = 0; while (cond) { __builtin_amdgcn_s_sleep(1); \
    if ((++_sp & 255u) == 0u) { if (xb_ld(&(bar)[XB_TMO])) break; if (_sp > XB_SPIN_CAP) { atomicAdd(&(bar)[XB_TMO], 1u); break; } } } } while (0)
struct XcdBarrier { unsigned* bar; unsigned x; volatile LAS unsigned* st; };
__device__ __forceinline__ XcdBarrier xcd_barrier_post(unsigned* bar, volatile LAS unsigned* st) {
    XcdBarrier b; b.bar = bar; b.x = xb_xcc_id(); b.st = st;
    if (threadIdx.x == 0) (void)xb_add(&bar[XB_XCNT(b.x)], 1u);
    return b;
}
__device__ __forceinline__ void xcd_barrier_complete(unsigned* bar, unsigned x, unsigned& nloc, unsigned& nx) {
    const unsigned G = 256u;
    unsigned sum, cnt, mine, sp = 0u;
    for (;;) {
        sum = 0u; cnt = 0u; mine = 0u;
#pragma unroll
        for (unsigned j = 0; j < 16; ++j) { const unsigned c = xb_ld(&bar[XB_XCNT(j)]); sum += c; cnt += (c > 0u) ? 1u : 0u; mine = (j == x) ? c : mine; }
        if (sum == G) break;
        __builtin_amdgcn_s_sleep(1);
        if ((++sp & 255u) == 0u) { if (xb_ld(&bar[XB_TMO])) break; if (sp > XB_SPIN_CAP) { atomicAdd(&bar[XB_TMO], 1u); break; } }
    }
    nloc = mine > 0u ? mine : 1u; nx = cnt > 0u ? cnt : 1u;
}
__device__ __forceinline__ void xcd_barrier(const XcdBarrier& b, const int tid) {
    asm volatile("s_waitcnt vmcnt(0)" ::: "memory");
    __syncthreads();
    if (tid == 0) {
        unsigned* bar = b.bar;
        __builtin_amdgcn_s_waitcnt(0);
        unsigned nloc = b.st[0], nx = b.st[1];
        if (nloc == 0u) { xcd_barrier_complete(bar, b.x, nloc, nx); b.st[0] = nloc; b.st[1] = nx; }
        const unsigned old = xb_add(&bar[XB_XSUB(b.x)], 1u);
        const unsigned gen = old / nloc;
        if (old + 1u == (gen + 1u) * nloc) {
            __builtin_amdgcn_fence(__ATOMIC_RELEASE, "agent");
            asm volatile("s_waitcnt vmcnt(0)" ::: "memory");
            const unsigned og = xb_add(&bar[XB_TOP], 1u);
            const unsigned tg = og / nx;
            if (og + 1u == (tg + 1u) * nx) xb_add(&bar[XB_TOPGEN], 1u);
            else XB_SPIN(xb_ld(&bar[XB_TOPGEN]) == tg, bar);
            __builtin_amdgcn_fence(__ATOMIC_ACQUIRE, "agent");
            xb_add(&bar[XB_XGEN(b.x)], 1u);
            asm volatile("s_waitcnt vmcnt(0)" ::: "memory");
        } else {
            XB_SPIN(xb_ld(&bar[XB_XGEN(b.x)]) == gen, bar);
            __builtin_amdgcn_fence(__ATOMIC_ACQUIRE, "agent");
            asm volatile("s_waitcnt vmcnt(0)" ::: "memory");
        }
    }
    __syncthreads();
}

namespace pg8 {
constexpr int BM = 256, BK = 64, HALF = 128, HTB = HALF * BK * 2, STAGE_BYTES = 8 * HTB, NXCD = 8, WGM = 8;
__host__ __device__ __forceinline__ int lds_byte(int r, int c) { const int st = (r >> 4) * 2 + (c >> 5), rr = r & 15, cc = c & 31, ob = rr * 64 + cc * 2; return st * 1024 + (ob ^ (((ob >> 9) & 1) << 5)); }
__host__ __device__ __forceinline__ void stage_rc(int b, int& R, int& C) { const int st = b / 1024, sb = b % 1024, swz = sb ^ (((sb >> 9) & 1) << 5); R = (st >> 1) * 16 + swz / 64; C = (st & 1) * 32 + (swz % 64) / 2; }
__host__ __device__ __forceinline__ int perm32(int rho) { const int n = rho >> 4, i = rho & 15; return 8 * (i >> 2) + 4 * n + (i & 3); }

struct Unit { int pm, pn, aux; const GAS char* A; const GAS char* B; };

__device__ __forceinline__ void tile_of(int L, int nM, int nN, int& pm, int& pn) {
    const int nwg = nM * nN; int wgid = L;
    { const int q = nwg / NXCD, r = nwg % NXCD, xcd = wgid % NXCD, off = wgid / NXCD; wgid = (xcd < r ? xcd * (q + 1) : r * (q + 1) + (xcd - r) * q) + off; }
    const int nig = WGM * nN, gid = wgid / nig, fm = gid * WGM, gsz = (nM - fm) < WGM ? (nM - fm) : WGM;
    pm = fm + ((wgid % nig) % gsz); pn = (wgid % nig) / gsz;
}
struct StaticOrder {
    static constexpr bool GATHER = false;
    const GAS char* A; const GAS char* Bt; int nM, nN, nwg, G, c; size_t tstep;
    __device__ __forceinline__ void init(const GAS void* A_, const GAS void* Bt_, int M, int N, int K, int G_, int c_) { A = (const GAS char*)A_; Bt = (const GAS char*)Bt_; nM = M / BM; nN = N / BM; nwg = nM * nN; G = G_; c = c_; tstep = (size_t)BM * K * 2; }
    __device__ __forceinline__ bool next(int i, Unit& u) const {
        const long L = (long)i * G + c; if (L >= nwg) return false;
        tile_of((int)L, nM, nN, u.pm, u.pn); u.aux = 0; u.A = A + (size_t)u.pm * tstep; u.B = Bt + (size_t)u.pn * tstep; return true;
    }
};

typedef float f32x2_t __attribute__((ext_vector_type(2))); typedef __bf16 bf16x2_t __attribute__((ext_vector_type(2)));
__device__ __forceinline__ unsigned cvt_pk_bf16(float lo, float hi) { f32x2_t v = {lo, hi}; bf16x2_t b = __builtin_convertvector(v, bf16x2_t); return __builtin_bit_cast(unsigned, b); }

template <class Epi, class Sched, bool ALIGN_EPI = true, bool SP2 = true>
__device__ __forceinline__ void gemm_phase(LAS unsigned char* lds, const int tid, const int K, const Sched& S, const Epi& E) {
    const int wid = __builtin_amdgcn_readfirstlane(tid >> 6), lane = tid & 63, wr = wid >> 2, wc = wid & 3, fr = lane & 15, fq = lane >> 4;
    const int nt = K / BK;
    unsigned voffA, voffB;
    { int R, C; stage_rc(tid * 16, R, C); const int Rb = Epi::PERM ? ((R & ~31) + perm32(R & 31)) : R;
        voffA = (unsigned)(R * K + C) * 2u; voffB = (unsigned)(Rb * K + C) * 2u; }
    const size_t pstep = (size_t)64 * K * 2;
    const size_t kstep = (size_t)(BK * 2);
    const size_t hstep = (size_t)HALF * K * 2;
    const unsigned ldsw = (unsigned)wid * 1024u;
    const int aoff = lds_byte(wr * 64 + fr, fq * 8), boff = lds_byte(wc * 32 + fr, fq * 8);
#define PG8_SA(b, h) (((b) * 2 + (h)) * HTB)
#define PG8_SB(b, h) ((4 + (b) * 2 + (h)) * HTB)
#define PG8_STAGE(bufoff, gbase, voff) do { _Pragma("unroll") for (int _i = 0; _i < 2; ++_i) \
        __builtin_amdgcn_global_load_lds((const GAS unsigned*)((const GAS char*)(gbase) + _i * pstep + (voff)), (LAS unsigned*)(lds + (bufoff) + ldsw + _i * 8192), 16, 0, 0); } while (0)
#define PG8_STAGE_A(bufoff, kbase, h_, useNext) do { if constexpr (GATHER) { _Pragma("unroll") for (int _i = 0; _i < 2; ++_i) { const unsigned _o = (useNext) ? gaN[h_][_i] : gaC[h_][_i]; \
        __builtin_amdgcn_global_load_lds((const GAS unsigned*)((const GAS char*)(kbase) + _o), (LAS unsigned*)(lds + (bufoff) + ldsw + _i * 8192), 16, 0, 0); } } \
        else { PG8_STAGE(bufoff, (kbase) + (h_) * hstep, voffA); } } while (0)
#define PG8_LDA(dst, b, h) do { _Pragma("unroll") for (int m = 0; m < 4; ++m) _Pragma("unroll") for (int k = 0; k < 2; ++k) dst[m][k] = *(const LAS bf16x8*)(lds + PG8_SA(b, h) + aoff + m * 2048 + k * 1024); } while (0)
#define PG8_LDB(dst, b, h) do { _Pragma("unroll") for (int n = 0; n < 2; ++n) _Pragma("unroll") for (int k = 0; k < 2; ++k) dst[n][k] = *(const LAS bf16x8*)(lds + PG8_SB(b, h) + boff + n * 2048 + k * 1024); } while (0)
#define PG8_MMA(ai, bj, At, Bt) do { __builtin_amdgcn_s_setprio(1); _Pragma("unroll") for (int m = 0; m < 4; ++m) _Pragma("unroll") for (int n = 0; n < 2; ++n) _Pragma("unroll") for (int k = 0; k < 2; ++k) \
        acc[ai][bj][m][n] = __builtin_amdgcn_mfma_f32_16x16x32_bf16(Bt[n][k], At[m][k], acc[ai][bj][m][n], 0, 0, 0); __builtin_amdgcn_s_setprio(0); } while (0)
#define PG8_WAIT_V(n) asm volatile("s_waitcnt vmcnt(" #n ")" ::: "memory")
#define PG8_WAIT_L(n) asm volatile("s_waitcnt lgkmcnt(" #n ")" ::: "memory")
#define PG8_BAR __builtin_amdgcn_s_barrier()
#define PG8_SCHED __builtin_amdgcn_sched_barrier(0)
    Unit cur, nxt; int ui = 0;
    if (!S.next(0, cur)) return;
    constexpr bool GATHER = Sched::GATHER;
    unsigned gaC[2][2], gaN[2][2];
    int gR = 0, gC = 0; if constexpr (GATHER) { stage_rc(tid * 16, gR, gC); }
#define PG8_GATHER_OFFS(dst, u_) do { if constexpr (GATHER) { _Pragma("unroll") for (int h_ = 0; h_ < 2; ++h_) _Pragma("unroll") for (int i_ = 0; i_ < 2; ++i_) \
        dst[h_][i_] = (unsigned)S.rowtok[(u_).pm * 256 + 128 * h_ + 64 * i_ + gR] * (unsigned)(K * 2) + (unsigned)(gC * 2); } } while (0)
    PG8_GATHER_OFFS(gaC, cur);
#pragma unroll
    for (int h_ = 0; h_ < 2; ++h_)
#pragma unroll
        for (int i_ = 0; i_ < 2; ++i_) gaN[h_][i_] = gaC[h_][i_];
    f32x4 acc[2][2][4][2];
#pragma unroll
    for (int a = 0; a < 2; ++a)
#pragma unroll
        for (int b = 0; b < 2; ++b)
#pragma unroll
            for (int m = 0; m < 4; ++m)
#pragma unroll
                for (int n = 0; n < 2; ++n) acc[a][b][m][n] = (f32x4){0.f, 0.f, 0.f, 0.f};
    bf16x8 At[4][2], B0[2][2], B1[2][2];
    const GAS char* cA = cur.A; const GAS char* cB = cur.B;
    if constexpr (SP2) {
        PG8_STAGE(PG8_SB(0, 0), cB, voffB); PG8_STAGE(PG8_SB(0, 1), cB + hstep, voffB); PG8_STAGE_A(PG8_SA(0, 0), cA, 0, false); PG8_STAGE_A(PG8_SA(0, 1), cA, 1, false);
        if (wr == 1) PG8_BAR;
        PG8_WAIT_V(2); PG8_BAR;
        PG8_STAGE(PG8_SB(1, 0), cB + kstep, voffB); PG8_STAGE_A(PG8_SA(1, 0), cA + kstep, 0, false); PG8_STAGE(PG8_SB(1, 1), cB + hstep + kstep, voffB);
        PG8_WAIT_V(6); PG8_BAR;
    } else {
        PG8_STAGE(PG8_SB(0, 0), cB, voffB); PG8_STAGE(PG8_SA(0, 0), cA, voffA); PG8_STAGE(PG8_SB(0, 1), cB + hstep, voffB); PG8_STAGE(PG8_SA(0, 1), cA + hstep, voffA);
        if (wr == 1) PG8_BAR;
        PG8_WAIT_V(4); PG8_BAR;
        PG8_STAGE(PG8_SB(1, 0), cB + kstep, voffB); PG8_STAGE(PG8_SA(1, 0), cA + kstep, voffA); PG8_STAGE(PG8_SB(1, 1), cB + hstep + kstep, voffB);
        PG8_WAIT_V(6); PG8_BAR;
    }
    for (;;) {
        const bool has_next = S.next(ui + 1, nxt);
        if (has_next) PG8_GATHER_OFFS(gaN, nxt);
        const GAS char* nA = has_next ? nxt.A : cA; const GAS char* nB = has_next ? nxt.B : cB;
        for (int t = 0; t < nt; t += 2) {
            const bool last = (t == nt - 2);
            const GAS char* a1 = cA + (size_t)(t + 1) * kstep;
            const GAS char* a2 = last ? nA : cA + (size_t)(t + 2) * kstep; const GAS char* b2 = last ? nB : cB + (size_t)(t + 2) * kstep;
            const GAS char* a3 = a2 + kstep; const GAS char* b3 = b2 + kstep;
            if constexpr (SP2) {
            PG8_LDB(B0, 0, 0); PG8_LDB(B1, 0, 1); PG8_SCHED; PG8_LDA(At, 0, 0); PG8_STAGE_A(PG8_SA(1, 1), a1, 1, false);
            PG8_WAIT_V(8); PG8_WAIT_L(0); PG8_BAR; PG8_MMA(0, 0, At, B0); PG8_MMA(0, 1, At, B1); PG8_BAR; PG8_SCHED;
            PG8_LDA(At, 0, 1); PG8_STAGE(PG8_SB(0, 0), b2, voffB); PG8_STAGE(PG8_SB(0, 1), b2 + hstep, voffB); PG8_STAGE_A(PG8_SA(0, 0), a2, 0, last && has_next);
            PG8_WAIT_V(8); PG8_WAIT_L(0); PG8_BAR; PG8_MMA(1, 0, At, B0); PG8_MMA(1, 1, At, B1); PG8_BAR; PG8_SCHED;
            PG8_LDB(B0, 1, 0); PG8_LDB(B1, 1, 1); PG8_SCHED; PG8_LDA(At, 1, 0); PG8_STAGE_A(PG8_SA(0, 1), a2, 1, last && has_next);
            PG8_WAIT_V(8); PG8_WAIT_L(0); PG8_BAR; PG8_MMA(0, 0, At, B0); PG8_MMA(0, 1, At, B1); PG8_BAR; PG8_SCHED;
            PG8_LDA(At, 1, 1); PG8_STAGE(PG8_SB(1, 0), b3, voffB); PG8_STAGE(PG8_SB(1, 1), b3 + hstep, voffB); PG8_STAGE_A(PG8_SA(1, 0), a3, 0, last && has_next);
            PG8_WAIT_V(8); PG8_WAIT_L(0); PG8_BAR; PG8_MMA(1, 0, At, B0); PG8_MMA(1, 1, At, B1); PG8_BAR; PG8_SCHED;
            } else {
            PG8_LDB(B0, 0, 0); PG8_SCHED; PG8_LDA(At, 0, 0); PG8_STAGE(PG8_SA(1, 1), a1 + hstep, voffA);
            PG8_WAIT_L(8); PG8_BAR; PG8_WAIT_L(0); PG8_MMA(0, 0, At, B0); PG8_BAR; PG8_SCHED;
            PG8_LDB(B1, 0, 1); PG8_STAGE(PG8_SB(0, 0), b2, voffB);
            PG8_BAR; PG8_WAIT_L(0); PG8_MMA(0, 1, At, B1); PG8_BAR;
            PG8_LDA(At, 0, 1); PG8_STAGE(PG8_SA(0, 0), a2, voffA);
            PG8_BAR; PG8_WAIT_L(0); PG8_MMA(1, 0, At, B0); PG8_BAR; PG8_SCHED;
            PG8_STAGE(PG8_SB(0, 1), b2 + hstep, voffB);
            PG8_WAIT_V(6); PG8_BAR; PG8_MMA(1, 1, At, B1); PG8_BAR;
            PG8_LDB(B0, 1, 0); PG8_SCHED; PG8_LDA(At, 1, 0); PG8_STAGE(PG8_SA(0, 1), a2 + hstep, voffA);
            PG8_WAIT_L(8); PG8_BAR; PG8_WAIT_L(0); PG8_MMA(0, 0, At, B0); PG8_BAR; PG8_SCHED;
            PG8_LDB(B1, 1, 1); PG8_STAGE(PG8_SB(1, 0), b3, voffB);
            PG8_BAR; PG8_WAIT_L(0); PG8_MMA(0, 1, At, B1); PG8_BAR;
            PG8_LDA(At, 1, 1); PG8_STAGE(PG8_SA(1, 0), a3, voffA);
            PG8_BAR; PG8_WAIT_L(0); PG8_MMA(1, 0, At, B0); PG8_BAR; PG8_SCHED;
            PG8_STAGE(PG8_SB(1, 1), b3 + hstep, voffB);
            PG8_WAIT_V(6); PG8_BAR; PG8_MMA(1, 1, At, B1); PG8_BAR;
            }
        }
        if constexpr (ALIGN_EPI) { if (wr == 0) PG8_BAR; }
        E(acc, cur, wr, wc, fr, fq);
        if (!has_next) break;
#pragma unroll
        for (int a = 0; a < 2; ++a)
#pragma unroll
            for (int b = 0; b < 2; ++b)
#pragma unroll
                for (int m = 0; m < 4; ++m)
#pragma unroll
                    for (int n = 0; n < 2; ++n) acc[a][b][m][n] = (f32x4){0.f, 0.f, 0.f, 0.f};
        cur = nxt; cA = nA; cB = nB; ++ui;
#pragma unroll
        for (int h_ = 0; h_ < 2; ++h_)
#pragma unroll
            for (int i_ = 0; i_ < 2; ++i_) gaC[h_][i_] = gaN[h_][i_];
        if constexpr (ALIGN_EPI) { if (wr == 1) PG8_BAR; }
    }
    PG8_WAIT_V(0);
    if constexpr (!ALIGN_EPI) { if (wr == 0) PG8_BAR; }
    PG8_BAR;
#undef PG8_SA
#undef PG8_SB
#undef PG8_STAGE
#undef PG8_LDA
#undef PG8_STAGE_A
#undef PG8_GATHER_OFFS
#undef PG8_LDB
#undef PG8_MMA
#undef PG8_WAIT_V
#undef PG8_WAIT_L
#undef PG8_BAR
#undef PG8_SCHED
}
}

using pg8::Unit; using pg8::cvt_pk_bf16; using pg8::HALF; using pg8::BM;

struct EpiG1a {
    static constexpr bool PERM = true;
    GAS bf16* O;
    __device__ __forceinline__ void operator()(const f32x4 (&acc)[2][2][4][2], const Unit& u, int wr, int wc, int fr, int fq) const {
        const int row0 = u.pm * BM + wr * 64 + fr, col0 = u.pn * BM + wc * 32 + 8 * fq;
#pragma unroll
        for (int ai = 0; ai < 2; ++ai)
#pragma unroll
            for (int m = 0; m < 4; ++m) { GAS bf16* rowp = O + (size_t)(row0 + ai * HALF + m * 16) * 1536 + col0;
#pragma unroll
                for (int bj = 0; bj < 2; ++bj) { const f32x4 v0 = acc[ai][bj][m][0], v1 = acc[ai][bj][m][1];
                    u32x4 w; w.x = cvt_pk_bf16(v0[0], v0[1]); w.y = cvt_pk_bf16(v0[2], v0[3]); w.z = cvt_pk_bf16(v1[0], v1[1]); w.w = cvt_pk_bf16(v1[2], v1[3]);
                    *(GAS u32x4*)(rowp + bj * HALF) = w; } }
    }
};
struct EpiG1b {
    static constexpr bool PERM = true;
    GAS unsigned char* ws;
    __device__ __forceinline__ void operator()(const f32x4 (&acc)[2][2][4][2], const Unit& u, int wr, int wc, int fr, int fq) const {
        const int pn = u.pn; size_t off; int ld, ct;
        if (pn < 2) { off = WS_PZ; ld = 512; ct = pn; } else if (pn < 4) { off = WS_PPOOL; ld = 512; ct = pn - 2; } else if (pn == 4) { off = WS_PMQ; ld = 256; ct = 0; }
        else if (pn == 5) { off = WS_PMK; ld = 256; ct = 0; } else if (pn < 8) { off = WS_PMV; ld = 512; ct = pn - 6; } else { off = WS_PMO; ld = 512; ct = pn - 8; }
        GAS bf16* O = (GAS bf16*)(ws + off);
        const int row0 = u.pm * BM + wr * 64 + fr, col0 = ct * BM + wc * 32 + 8 * fq;
#pragma unroll
        for (int ai = 0; ai < 2; ++ai)
#pragma unroll
            for (int m = 0; m < 4; ++m) { GAS bf16* rowp = O + (size_t)(row0 + ai * HALF + m * 16) * ld + col0;
#pragma unroll
                for (int bj = 0; bj < 2; ++bj) { const f32x4 v0 = acc[ai][bj][m][0], v1 = acc[ai][bj][m][1];
                    u32x4 w; w.x = cvt_pk_bf16(v0[0], v0[1]); w.y = cvt_pk_bf16(v0[2], v0[3]); w.z = cvt_pk_bf16(v1[0], v1[1]); w.w = cvt_pk_bf16(v1[2], v1[3]);
                    *(GAS u32x4*)(rowp + bj * HALF) = w; } }
    }
};
__device__ __forceinline__ float fast_sigmoid(float x) { return __builtin_amdgcn_rcpf(1.0f + __builtin_amdgcn_exp2f(-1.44269504089f * x)); }
struct EpiGate {
    static constexpr bool PERM = true;
    GAS bf16* O;
    __device__ __forceinline__ void operator()(const f32x4 (&acc)[2][2][4][2], const Unit& u, int wr, int wc, int fr, int fq) const {
        const int row0 = u.pm * BM + wr * 64 + fr, col0 = u.pn * BM + wc * 32 + 8 * fq;
#pragma unroll
        for (int ai = 0; ai < 2; ++ai)
#pragma unroll
            for (int m = 0; m < 4; ++m) { GAS bf16* rowp = O + (size_t)(row0 + ai * HALF + m * 16) * 3072 + col0;
#pragma unroll
                for (int bj = 0; bj < 2; ++bj) { f32x4 v0 = acc[ai][bj][m][0], v1 = acc[ai][bj][m][1];
#pragma unroll
                    for (int j = 0; j < 4; ++j) { v0[j] = fast_sigmoid(v0[j]); v1[j] = fast_sigmoid(v1[j]); }
                    u32x4 w; w.x = cvt_pk_bf16(v0[0], v0[1]); w.y = cvt_pk_bf16(v0[2], v0[3]); w.z = cvt_pk_bf16(v1[0], v1[1]); w.w = cvt_pk_bf16(v1[2], v1[3]);
                    *(GAS u32x4*)(rowp + bj * HALF) = w; } }
    }
};
__device__ __forceinline__ void unpack8(const u32x4 w, float (&f)[8]) {
    f[0] = __uint_as_float(w.x << 16); f[1] = __uint_as_float(w.x & 0xffff0000u); f[2] = __uint_as_float(w.y << 16); f[3] = __uint_as_float(w.y & 0xffff0000u);
    f[4] = __uint_as_float(w.z << 16); f[5] = __uint_as_float(w.z & 0xffff0000u); f[6] = __uint_as_float(w.w << 16); f[7] = __uint_as_float(w.w & 0xffff0000u);
}
struct EpiMerge {
    static constexpr bool PERM = true;
    const GAS bf16* GATE; GAS bf16* PART; GAS bf16* FIN;
    __device__ __forceinline__ void operator()(const f32x4 (&acc)[2][2][4][2], const Unit& u, int wr, int wc, int fr, int fq) const {
        const int r = u.aux;
        const int row0 = u.pm * BM + wr * 64 + fr, col0 = u.pn * BM + wc * 32 + 8 * fq;
#pragma unroll
        for (int ai = 0; ai < 2; ++ai)
#pragma unroll
            for (int m = 0; m < 4; ++m) { const size_t row = (size_t)(row0 + ai * HALF + m * 16);
#pragma unroll
                for (int bj = 0; bj < 2; ++bj) { const f32x4 v0 = acc[ai][bj][m][0], v1 = acc[ai][bj][m][1];
                    const int c = col0 + bj * HALF;
                    const u32x4 gw = *(const GAS u32x4*)(GATE + row * 3072 + r * 1024 + c);
                    float g[8]; unpack8(gw, g);
                    float o[8];
                    o[0] = v0[0] * g[0]; o[1] = v0[1] * g[1]; o[2] = v0[2] * g[2]; o[3] = v0[3] * g[3];
                    o[4] = v1[0] * g[4]; o[5] = v1[1] * g[5]; o[6] = v1[2] * g[6]; o[7] = v1[3] * g[7];
                    if (r > 0) { const u32x4 pw = *(const GAS u32x4*)(PART + row * 1024 + c); float p[8]; unpack8(pw, p);
#pragma unroll
                        for (int j = 0; j < 8; ++j) o[j] += p[j]; }
                    u32x4 w; w.x = cvt_pk_bf16(o[0], o[1]); w.y = cvt_pk_bf16(o[2], o[3]); w.z = cvt_pk_bf16(o[4], o[5]); w.w = cvt_pk_bf16(o[6], o[7]);
                    GAS bf16* dst = (r == 2) ? FIN : PART;
                    *(GAS u32x4*)(dst + row * 1024 + c) = w; } }
    }
};
struct EpiOut {
    static constexpr bool PERM = false;
    const GAS bf16* H; GAS bf16* PRE;
    __device__ __forceinline__ void operator()(const f32x4 (&acc)[2][2][4][2], const Unit& u, int wr, int wc, int fr, int fq) const {
        const int row0 = u.pm * BM + wr * 64 + fr, col0 = u.pn * BM + wc * 32 + 4 * fq;
#pragma unroll
        for (int ai = 0; ai < 2; ++ai)
#pragma unroll
            for (int m = 0; m < 4; ++m) { const size_t ro = (size_t)(row0 + ai * HALF + m * 16) * D + col0;
#pragma unroll
                for (int bj = 0; bj < 2; ++bj)
#pragma unroll
                    for (int n = 0; n < 2; ++n) { const size_t o = ro + bj * HALF + n * 16; const u32x2 hv = *(const GAS u32x2*)(H + o); const f32x4 a = acc[ai][bj][m][n];
                        u32x2 w; w.x = cvt_pk_bf16(ALPHA * bf2f(hv.x & 0xffffu) + a[0], ALPHA * bf2f(hv.x >> 16) + a[1]); w.y = cvt_pk_bf16(ALPHA * bf2f(hv.y & 0xffffu) + a[2], ALPHA * bf2f(hv.y >> 16) + a[3]);
                        *(GAS u32x2*)(PRE + o) = w; } }
    }
};
struct EpiMoe1 {
    static constexpr bool PERM = true;
    GAS bf16* ACT;
    __device__ __forceinline__ void operator()(const f32x4 (&acc)[2][2][4][2], const Unit& u, int wr, int wc, int fr, int fq) const {
        const int row0 = u.pm * BM + wr * 64 + fr, col0 = u.pn * 128 + wc * 32 + 8 * fq;
#pragma unroll
        for (int ai = 0; ai < 2; ++ai)
#pragma unroll
            for (int m = 0; m < 4; ++m) { GAS bf16* rowp = ACT + (size_t)(row0 + ai * HALF + m * 16) * DEXP + col0;
                float o[8];
#pragma unroll
                for (int n = 0; n < 2; ++n)
#pragma unroll
                    for (int j = 0; j < 4; ++j) { const float a = acc[ai][0][m][n][j], b = acc[ai][1][m][n][j]; o[n * 4 + j] = a * fast_sigmoid(a) * b; }
                u32x4 w; w.x = cvt_pk_bf16(o[0], o[1]); w.y = cvt_pk_bf16(o[2], o[3]); w.z = cvt_pk_bf16(o[4], o[5]); w.w = cvt_pk_bf16(o[6], o[7]);
                *(GAS u32x4*)rowp = w; }
    }
};
struct EpiMoe2 {
    static constexpr bool PERM = true;
    GAS bf16* Y; const GAS float* roww;
    __device__ __forceinline__ void operator()(const f32x4 (&acc)[2][2][4][2], const Unit& u, int wr, int wc, int fr, int fq) const {
        const int row0 = u.pm * BM + wr * 64 + fr, col0 = u.pn * BM + wc * 32 + 8 * fq;
#pragma unroll
        for (int ai = 0; ai < 2; ++ai)
#pragma unroll
            for (int m = 0; m < 4; ++m) { const int row = row0 + ai * HALF + m * 16; const float rw = roww[row]; GAS bf16* rowp = Y + (size_t)row * D + col0;
#pragma unroll
                for (int bj = 0; bj < 2; ++bj) { const f32x4 v0 = acc[ai][bj][m][0] * rw, v1 = acc[ai][bj][m][1] * rw;
                    u32x4 w; w.x = cvt_pk_bf16(v0[0], v0[1]); w.y = cvt_pk_bf16(v0[2], v0[3]); w.z = cvt_pk_bf16(v1[0], v1[1]); w.w = cvt_pk_bf16(v1[2], v1[3]);
                    *(GAS u32x4*)(rowp + bj * HALF) = w; } }
    }
};

struct MergeOrder {
    static constexpr bool GATHER = false;
    const GAS char* Y[3]; const GAS char* W; int G, c;
    __device__ __forceinline__ bool next(int i, Unit& u) const {
        const int j = i / 3, r = i - 3 * j; const int L = j * G + c; if (L >= 128 * 4) return false;
        pg8::tile_of(L, 128, 4, u.pm, u.pn); u.aux = r;
        const GAS char* y = (r == 0) ? Y[0] : ((r == 1) ? Y[1] : Y[2]);
        u.A = y + (size_t)u.pm * (256 * 512 * 2); u.B = W + (size_t)r * (1024 * 512 * 2) + (size_t)u.pn * (256 * 512 * 2); return true;
    }
};
template <int KDIM, bool GATHER_> struct MoeOrder {
    static constexpr bool GATHER = GATHER_;
    const GAS int* rowtok;
    const GAS char* A; const GAS char* W; const LAS int* pe; int c, NP;
    __device__ __forceinline__ bool next(int i, Unit& u) const {
        const int L = i * 256 + c; if (L >= NP * 4) return false;
        const int p = L >> 2, pn = L & 3; const int e = __builtin_amdgcn_readfirstlane(pe[p]);
        u.pm = p; u.pn = pn; u.aux = e; u.A = GATHER_ ? A : A + (size_t)p * (256 * KDIM * 2); u.B = W + (size_t)e * (1024 * KDIM * 2) + (size_t)pn * (256 * KDIM * 2); return true;
    }
};

struct Args {
    const float* in[23]; float* out; unsigned char* ws; int ph_lo, ph_hi;
};
struct Frame {
    LAS unsigned char* lds; int tid, lane, wave, G, wg;
    GAS float* out; GAS unsigned char* ws;
};
__device__ __forceinline__ const GAS float* inp_lds(LAS unsigned char* lds, int i) {
    const unsigned long long v = ((const LAS unsigned long long*)(lds + LARG_OFF))[i];
    const unsigned lo = __builtin_amdgcn_readfirstlane((unsigned)v), hi = __builtin_amdgcn_readfirstlane((unsigned)(v >> 32));
    return (const GAS float*)(((unsigned long long)hi << 32) | lo);
}
__device__ __forceinline__ const GAS float* inp(const Frame& F, int i) { return inp_lds(F.lds, i); }
__device__ __forceinline__ Frame fresh(LAS unsigned char* lds, int wave) {
    Frame F; int wgx = blockIdx.x; unsigned lb = (unsigned)(unsigned long long)lds;
    asm volatile("" : "+s"(wave), "+s"(wgx), "+s"(lb));
    F.lds = (LAS unsigned char*)(unsigned long long)lb;
    int ln = (int)__builtin_amdgcn_mbcnt_hi(~0u, __builtin_amdgcn_mbcnt_lo(~0u, 0u)); asm volatile("" : "+v"(ln));
    F.wave = wave; F.lane = ln; F.tid = wave * 64 + ln;
    F.G = 256; F.wg = wgx;
    F.out = (GAS float*)inp_lds(F.lds, 23); F.ws = (GAS unsigned char*)inp_lds(F.lds, 24);
    return F;
}
enum { I_X = 0, I_LN_IN_G, I_LN_IN_B, I_W_IN, I_CONV, I_A_LOG, I_DT_BIAS, I_DN_NORM, I_POOL_W, I_POOL_SCALE, I_ML_GATE_B, I_ML_NORM, I_W_BRANCH, I_W_OUT, I_LN_MIX_G, I_LN_MIX_B,
       I_ROUTER_W, I_ROUTER_B, I_MOE_W1, I_MOE_W3, I_MOE_W2, I_LN_FFN_G, I_LN_FFN_B };

__device__ __forceinline__ void tr_load(float (&r)[32], const GAS float* W, int ldw, int k0, int n0src, int lane) {
#pragma unroll
    for (int i = 0; i < 32; ++i) { const int kk = 2 * i + (lane >> 5); r[i] = W[(size_t)(k0 + kk) * ldw + n0src + (lane & 31)]; }
}
__device__ __forceinline__ void tr_store(const float (&r)[32], GAS bf16* WT, int dpitch, int k0, int drow0, LAS float* scr, int lane) {
#pragma unroll
    for (int i = 0; i < 32; ++i) { const int kk = 2 * i + (lane >> 5); scr[kk * 33 + (lane & 31)] = r[i]; }
    LDS_WAIT(); asm volatile("" ::: "memory");
    const int c = lane & 7;
#pragma unroll
    for (int j = 0; j < 4; ++j) { const int n = (lane >> 3) + 8 * j; const LAS float* s = scr + (8 * c) * 33 + n;
        u32x4 o; o.x = pk2(s[0 * 33], s[1 * 33]); o.y = pk2(s[2 * 33], s[3 * 33]); o.z = pk2(s[4 * 33], s[5 * 33]); o.w = pk2(s[6 * 33], s[7 * 33]);
        *(GAS u32x4*)(WT + (size_t)(drow0 + n) * dpitch + k0 + 8 * c) = o; }
    LDS_WAIT(); asm volatile("" ::: "memory");
}
__device__ __forceinline__ void tr_item(const GAS float* W, int ldw, int k0, int n0src, GAS bf16* WT, int dpitch, int drow0, LAS float* scr, int lane) {
    float r[32]; tr_load(r, W, ldw, k0, n0src, lane); tr_store(r, WT, dpitch, k0, drow0, scr, lane);
}
__device__ __forceinline__ void tr_segment(const Frame& F, const GAS float* W, int ldw, int K, int n0src, int ncols, GAS bf16* WT, int drow0, int& it) {
    LAS float* scr = (LAS float*)(F.lds + F.wave * 16384);
    const int gw = F.wg * NWAVES + F.wave, NGW = F.G * NWAVES;
    const int nblk = ncols / 32, nitems = (K / 64) * nblk;
    int first = (gw - (it % NGW) + NGW) % NGW;
    for (int r = first; r < nitems; r += NGW) { const int kb = r / nblk, nb = r % nblk; tr_item(W, ldw, 64 * kb, n0src + 32 * nb, WT, K, drow0 + 32 * nb, scr, F.lane); }
    it += nitems;
}
__device__ __forceinline__ void wprep_mixer(const Frame& F, int l) {
    const GAS float* win = inp(F, I_W_IN) + (size_t)l * D * DIN; int it = 0;
    GAS bf16* Wi = (GAS bf16*)(F.ws + WS_WIN); GAS bf16* Wg = (GAS bf16*)(F.ws + WS_WGATE); GAS bf16* Wb = (GAS bf16*)(F.ws + WS_WBR); GAS bf16* Wo = (GAS bf16*)(F.ws + WS_WOUT);
    tr_segment(F, win, DIN, D, C_QKV, 1536, Wi, 0, it);
    tr_segment(F, win, DIN, D, C_Z, 512, Wi, 1536, it);
    tr_segment(F, win, DIN, D, C_POOL, 512, Wi, 2048, it);
    tr_segment(F, win, DIN, D, C_MQ, 256, Wi, 2560, it);
    tr_segment(F, win, DIN, D, C_MK, 256, Wi, 2816, it);
    tr_segment(F, win, DIN, D, C_MV, 512, Wi, 3072, it);
    tr_segment(F, win, DIN, D, C_MO, 512, Wi, 3584, it);
    tr_segment(F, win, DIN, D, C_GATE, 3072, Wg, 0, it);
    const GAS float* wbr = inp(F, I_W_BRANCH) + (size_t)l * 3 * MIXW * D;
    tr_segment(F, wbr, D, MIXW, 0, D, Wb, 0, it);
    tr_segment(F, wbr + (size_t)2 * MIXW * D, D, MIXW, 0, D, Wb + (size_t)2 * D * MIXW, 0, it);
    tr_segment(F, inp(F, I_W_OUT) + (size_t)l * D * D, D, D, 0, D, Wo, 0, it);
    const GAS float* pw = inp(F, I_POOL_W) + (size_t)l * 4 * 128 * 128; const GAS float* ps = inp(F, I_POOL_SCALE) + (size_t)l * MIXW; const GAS float* wb1 = wbr + (size_t)MIXW * D;
    GAS bf16* W1 = Wb + (size_t)D * MIXW;
    for (int idx = F.wg * 512 + F.tid; idx < D * MIXW; idx += F.G * 512) {
        const int m = idx >> 10, d = idx & 1023, g = m >> 7, c = m & 127;
        float s = 0.f;
        for (int dd = 0; dd < 128; ++dd) s += pw[(g * 128 + c) * 128 + dd] * ps[g * 128 + dd] * wb1[(size_t)(g * 128 + dd) * D + d];
        W1[(size_t)d * MIXW + m] = (bf16)f2bf(s);
    }
}
__device__ __forceinline__ void wprep_moe(const Frame& F, int l, int wg0, int nwg) {
    GAS bf16* W13 = (GAS bf16*)((GAS unsigned char*)F.out + 64 * MiB); GAS bf16* W2 = (GAS bf16*)(F.ws + WS_W2);
    LAS float* scr = (LAS float*)(F.lds + F.wave * 16384);
    const int gw = (F.wg - wg0) * NWAVES + F.wave, NGW = nwg * NWAVES;
    const GAS float* w1 = inp(F, I_MOE_W1); const GAS float* w3 = inp(F, I_MOE_W3); const GAS float* w2 = inp(F, I_MOE_W2);
#define MOE_ITEM_LOAD(R, r_) do { const int ri_ = (r_); if (ri_ < 16384) { const int e = ri_ >> 9, which = (ri_ >> 8) & 1, kb = (ri_ >> 4) & 15, nb = ri_ & 15; \
            tr_load(R, (which ? w3 : w1) + ((size_t)l * NEXP + e) * D * DEXP, DEXP, 64 * kb, nb * 32, F.lane); } \
        else if (ri_ < 24576) { const int q = ri_ - 16384, e = q >> 8, kb = (q >> 5) & 7, nb = q & 31; tr_load(R, w2 + ((size_t)l * NEXP + e) * DEXP * D, D, 64 * kb, 32 * nb, F.lane); } } while (0)
#define MOE_ITEM_STORE(R, r_) do { const int ri_ = (r_); if (ri_ < 16384) { const int e = ri_ >> 9, which = (ri_ >> 8) & 1, kb = (ri_ >> 4) & 15, nb = ri_ & 15, n0 = nb * 32; \
            tr_store(R, W13 + (size_t)e * D * D, D, 64 * kb, (n0 >> 7) * 256 + which * 128 + (n0 & 127), scr, F.lane); } \
        else if (ri_ < 24576) { const int q = ri_ - 16384, e = q >> 8, kb = (q >> 5) & 7, nb = q & 31; tr_store(R, W2 + (size_t)e * D * DEXP, DEXP, 64 * kb, 32 * nb, scr, F.lane); } } while (0)
    float ra[32], rb[32];
    MOE_ITEM_LOAD(ra, gw);
    for (int r = gw; r < 24576; r += 2 * NGW) {
        MOE_ITEM_LOAD(rb, r + NGW); MOE_ITEM_STORE(ra, r);
        MOE_ITEM_LOAD(ra, r + 2 * NGW); MOE_ITEM_STORE(rb, r + NGW);
    }
#undef MOE_ITEM_LOAD
#undef MOE_ITEM_STORE
}

__device__ __forceinline__ int w32_addr(int k, int c4) { return (k >> 1) * 256 + (((((k & 1) << 3) | c4) ^ ((k >> 1) & 15)) << 4); }
__device__ __forceinline__ void stage_w32(const Frame& F, const GAS float* src, int ldw, bool gates) {
    for (int idx = F.tid; idx < D * 8; idx += 512) {
        const int k = idx >> 3, c4 = idx & 7;
        int col = 4 * c4;
        if (gates) col = (c4 < 2) ? (C_A + 4 * c4) : (c4 < 4) ? (C_B + 4 * (c4 - 2)) : (c4 < 6) ? (C_I + 4 * (c4 - 4)) : (C_F + 4 * (c4 - 6));
        const f32x4 v = *(const GAS f32x4*)(src + (size_t)k * ldw + col);
        *(LAS f32x4*)(F.lds + w32_addr(k, c4)) = v;
    }
}
template <int MODE>
__device__ __forceinline__ void ln_phase(const Frame& F, const GAS float* gam, const GAS float* bet, const GAS float* w32src, int w32ld, bool do_proj, bool write_hb, bool dummy = false) {
    GAS float* OUTP = dummy ? (GAS float*)(F.ws + WS_R2) : F.out; GAS unsigned char* WSO = dummy ? (F.ws + WS_R2 + 40 * MiB) : F.ws;
    LAS int* lhist = (LAS int*)(F.lds + LHIST_OFF);
    if (do_proj) stage_w32(F, w32src, w32ld, MODE != 1);
    if (MODE == 1 && F.tid < 32) lhist[F.tid] = 0;
    __syncthreads();
    const int lane = F.lane;
    f32x2 gv[8], bv[8];
#pragma unroll
    for (int m = 0; m < 8; ++m) { gv[m] = *(const GAS f32x2*)(gam + 2 * lane + 128 * m); bv[m] = *(const GAS f32x2*)(bet + 2 * lane + 128 * m); }
    GAS bf16* hb = dummy ? (GAS bf16*)(F.ws + WS_R2 + 128 * MiB) : (GAS bf16*)(F.ws + WS_HB);
    const int rows_per_wg = T / F.G;
    const GAS int* posp = (const GAS int*)(F.ws + WS_POS); const GAS bf16* Yr = (const GAS bf16*)(F.ws + WS_YROWS);
    const GAS float* srcp = inp(F, I_X);
    const GAS bf16* preb = (MODE == 1) ? (const GAS bf16*)F.out : (const GAS bf16*)(F.ws + WS_HB);
#define LN_FETCH(V, Y0, Y1, row_) do { const int rw_ = (row_); \
        if (MODE == 0) { _Pragma("unroll") for (int m = 0; m < 8; ++m) V[m] = *(const GAS f32x2*)(srcp + (size_t)rw_ * D + 2 * lane + 128 * m); } \
        else { _Pragma("unroll") for (int m = 0; m < 8; ++m) { const unsigned u_ = *(const GAS unsigned*)(preb + (size_t)rw_ * D + 2 * lane + 128 * m); V[m].x = bf2f(u_ & 0xffffu); V[m].y = bf2f(u_ >> 16); } } \
        if (MODE == 2) { const int p0_ = posp[2 * rw_], p1_ = posp[2 * rw_ + 1]; \
            _Pragma("unroll") for (int m = 0; m < 8; ++m) { Y0[m] = *(const GAS unsigned*)(Yr + (size_t)p0_ * D + 2 * lane + 128 * m); Y1[m] = *(const GAS unsigned*)(Yr + (size_t)p1_ * D + 2 * lane + 128 * m); } } } while (0)
    const int nrow = rows_per_wg / NWAVES, row0 = F.wg * rows_per_wg + F.wave * nrow;
    f32x2 vA[8], vB[8]; unsigned yA0[8], yA1[8], yB0[8], yB1[8];
    LN_FETCH(vA, yA0, yA1, row0);
#pragma unroll 1
    for (int i2 = 0; i2 < nrow; i2 += 2) {
#pragma unroll
      for (int half = 0; half < 2; ++half) {
        const int i = i2 + half; const int row = row0 + i;
        const int nrw = row0 + ((i + 1 < nrow) ? i + 1 : i);
        if (half == 0) LN_FETCH(vB, yB0, yB1, nrw); else LN_FETCH(vA, yA0, yA1, nrw);
        f32x2 v[8];
#pragma unroll
        for (int m = 0; m < 8; ++m) {
            const f32x2 o = half ? vB[m] : vA[m];
            if (MODE == 2) { const unsigned ya = half ? yB0[m] : yA0[m], yb = half ? yB1[m] : yA1[m];
                v[m].x = ALPHA * o.x + bf2f(ya & 0xffffu) + bf2f(yb & 0xffffu); v[m].y = ALPHA * o.y + bf2f(ya >> 16) + bf2f(yb >> 16); }
            else v[m] = o;
        }
        float s = 0.f;
#pragma unroll
        for (int m = 0; m < 8; ++m) s += v[m].x + v[m].y;
        const float mean = wave_sum(s) * (1.f / D);
        float s2 = 0.f;
#pragma unroll
        for (int m = 0; m < 8; ++m) { v[m].x -= mean; v[m].y -= mean; s2 += v[m].x * v[m].x + v[m].y * v[m].y; }
        const float rstd = 1.0f / sqrtf(wave_sum(s2) * (1.f / D) + LN_EPS);
#pragma unroll
        for (int m = 0; m < 8; ++m) { v[m].x = v[m].x * rstd * gv[m].x + bv[m].x; v[m].y = v[m].y * rstd * gv[m].y + bv[m].y; }
        if (!write_hb) {
#pragma unroll
            for (int m = 0; m < 8; ++m) *(GAS f32x2*)(OUTP + (size_t)row * D + 2 * lane + 128 * m) = v[m];
        }
        if (write_hb) {
#pragma unroll
            for (int m = 0; m < 8; ++m) *(GAS unsigned*)(hb + (size_t)row * D + 2 * lane + 128 * m) = pk2(v[m].x, v[m].y);
        }
        if (!do_proj) continue;
        float acc[32];
#pragma unroll
        for (int c = 0; c < 32; ++c) acc[c] = 0.f;
#pragma unroll
        for (int m = 0; m < 8; ++m) {
#pragma unroll
            for (int e = 0; e < 2; ++e) {
                asm volatile("" ::: "memory");
                const int k = 2 * lane + 128 * m + e; const float xv = e ? v[m].y : v[m].x;
#pragma unroll
                for (int c4 = 0; c4 < 8; ++c4) { const f32x4 w = *(const LAS f32x4*)(F.lds + w32_addr(k, c4));
                    acc[4 * c4 + 0] += xv * w[0]; acc[4 * c4 + 1] += xv * w[1]; acc[4 * c4 + 2] += xv * w[2]; acc[4 * c4 + 3] += xv * w[3]; }
            }
        }
        float r16[16], r8[8], r4[4], r2[2], r1;
        { const bool hi = (lane & 32) != 0;
#pragma unroll
          for (int j = 0; j < 16; ++j) { const float a = acc[j], b = acc[j + 16]; const float send = hi ? a : b, keep = hi ? b : a; r16[j] = keep + __shfl_xor(send, 32); } }
        { const bool hi = (lane & 16) != 0;
#pragma unroll
          for (int j = 0; j < 8; ++j) { const float a = r16[j], b = r16[j + 8]; const float send = hi ? a : b, keep = hi ? b : a; r8[j] = keep + __shfl_xor(send, 16); } }
        { const bool hi = (lane & 8) != 0;
#pragma unroll
          for (int j = 0; j < 4; ++j) { const float a = r8[j], b = r8[j + 4]; const float send = hi ? a : b, keep = hi ? b : a; r4[j] = keep + __shfl_xor(send, 8); } }
        { const bool hi = (lane & 4) != 0;
#pragma unroll
          for (int j = 0; j < 2; ++j) { const float a = r4[j], b = r4[j + 2]; const float send = hi ? a : b, keep = hi ? b : a; r2[j] = keep + __shfl_xor(send, 4); } }
        { const bool hi = (lane & 2) != 0; const float a = r2[0], b = r2[1]; const float send = hi ? a : b, keep = hi ? b : a; r1 = keep + __shfl_xor(send, 2); }
        r1 += __shfl_xor(r1, 1);
        if (MODE != 1) {
            if ((lane & 1) == 0) ((GAS float*)(WSO + WS_SG))[(size_t)row * 32 + (lane >> 1)] = r1;
        } else {
            const float score = sigmoidf_(r1);
            const float sel = score + inp(F, I_ROUTER_B)[lane >> 1];
            const int gb = lane & ~7;
            const float v0 = __shfl(sel, gb + 0), v1 = __shfl(sel, gb + 2), v2 = __shfl(sel, gb + 4), v3 = __shfl(sel, gb + 6);
            int i1 = 0; float m1 = v0;
            if (v1 > m1) { m1 = v1; i1 = 1; } if (v2 > m1) { m1 = v2; i1 = 2; } if (v3 > m1) { m1 = v3; i1 = 3; }
            int i2 = -1; float m2 = -3.0e38f;
            if (i1 != 0 && v0 > m2) { m2 = v0; i2 = 0; } if (i1 != 1 && v1 > m2) { m2 = v1; i2 = 1; } if (i1 != 2 && v2 > m2) { m2 = v2; i2 = 2; } if (i1 != 3 && v3 > m2) { m2 = v3; i2 = 3; }
            float gs = m1 + m2; int gi = lane >> 3;
#pragma unroll
            for (int o = 8; o < 64; o <<= 1) { const float og = __shfl_xor(gs, o); const int oi = __shfl_xor(gi, o); if (og > gs || (og == gs && oi < gi)) { gs = og; gi = oi; } }
            const int src = gi * 8;
            const int e1 = gi * 4 + __shfl(i1, src), e2 = gi * 4 + __shfl(i2, src);
            const float s1 = __shfl(score, 2 * e1), s2 = __shfl(score, 2 * e2);
            if (lane == 0) {
                GAS int* eid = (GAS int*)(WSO + WS_EID); GAS float* ew = (GAS float*)(WSO + WS_EW);
                const float inv = 1.0f / (s1 + s2);
                eid[2 * row] = e1; eid[2 * row + 1] = e2; ew[2 * row] = s1 * inv; ew[2 * row + 1] = s2 * inv;
                __hip_atomic_fetch_add(lhist + e1, 1, __ATOMIC_RELAXED, __HIP_MEMORY_SCOPE_WORKGROUP); __hip_atomic_fetch_add(lhist + e2, 1, __ATOMIC_RELAXED, __HIP_MEMORY_SCOPE_WORKGROUP);
            }
        }
      }
    }
#undef LN_FETCH
    if (MODE == 1) {
        __syncthreads();
        if (F.tid < 32) ((GAS int*)(WSO + WS_HIST))[F.wg * 32 + F.tid] = lhist[F.tid];
    }
    __syncthreads();
}

__device__ __forceinline__ int invsigma32(int w) { return 8 * ((w >> 2) & 3) + 4 * (w >> 4) + (w & 3); }
__device__ __forceinline__ float wave_incl_scan(float v, int lane) {
#pragma unroll
    for (int o = 1; o < 64; o <<= 1) { const float t = __shfl_up(v, o); if (lane >= o) v += t; }
    return v;
}
__device__ __forceinline__ float wave_incl_maxscan(float v, int lane) {
#pragma unroll
    for (int o = 1; o < 64; o <<= 1) { const float t = __shfl_up(v, o); if (lane >= o) v = fmaxf(v, t); }
    return v;
}
constexpr int DQ_OFF = 0, DK_OFF = 17408, DV_OFF = 34816, DGM_OFF = 52224, DQK_OFF = 69632, DTM_OFF = 87040, DVEC_OFF = 121856;
constexpr int QROW = 272;
constexpr int FROW = 68;
__device__ __forceinline__ bf16x8 pack_b(const f32x4 lo, const f32x4 hi) {
    u32x4 w; w.x = cvt_pk_bf16(lo[0], lo[1]); w.y = cvt_pk_bf16(lo[2], lo[3]); w.z = cvt_pk_bf16(hi[0], hi[1]); w.w = cvt_pk_bf16(hi[2], hi[3]);
    return __builtin_bit_cast(bf16x8, w);
}
__device__ __forceinline__ bf16x8 pack8f(const float (&f)[8]) {
    u32x4 w; w.x = cvt_pk_bf16(f[0], f[1]); w.y = cvt_pk_bf16(f[2], f[3]); w.z = cvt_pk_bf16(f[4], f[5]); w.w = cvt_pk_bf16(f[6], f[7]);
    return __builtin_bit_cast(bf16x8, w);
}
#define PREP_BAR() do { asm volatile("s_waitcnt lgkmcnt(0)" ::: "memory"); __builtin_amdgcn_s_barrier(); asm volatile("" ::: "memory"); } while (0)
#ifndef DNREP_A
#define DNREP_A 1
#endif
#ifndef DNREP_B
#define DNREP_B 1
#endif
#ifndef DNREP_C
#define DNREP_C 1
#endif
#ifndef DNREP_D
#define DNREP_D 1
#endif
__device__ __forceinline__ void dn_prep(const Frame& F, int l) {
    LAS unsigned char* L = F.lds;
    const int lane = F.lane, wave = F.wave, tid = F.tid, fr = lane & 15, fq = lane >> 4;
    const GAS bf16* P = (const GAS bf16*)(F.ws + WS_PQKV);
    const GAS float* SG = (const GAS float*)(F.ws + WS_SG);
    const GAS float* cw = inp(F, I_CONV) + (size_t)l * 5 * 1536;
    LAS float* GM = (LAS float*)(L + DGM_OFF); LAS float* QKM = (LAS float*)(L + DQK_OFF);
#ifdef DIAG
    unsigned long long tacc[7] = {0, 0, 0, 0, 0, 0, 0}; unsigned long long tprev = __builtin_amdgcn_s_memrealtime();
#define DSTAMP(k) do { const unsigned long long tn_ = __builtin_amdgcn_s_memrealtime(); tacc[k] += tn_ - tprev; tprev = tn_; } while (0)
#else
#define DSTAMP(k) do {} while (0)
#endif
    unsigned praw[12][3]; float pga = 0.f, pgb = 0.f;
#define DN_PF(item_) do { const int it_ = (item_) < NB * NHEAD * NCH ? (item_) : F.wg; const int b_ = it_ >> 9, h_ = (it_ >> 7) & 3, n_ = it_ & 127; \
        _Pragma("unroll") for (int rr = 0; rr < 12; ++rr) { const int sp_ = n_ * CH + 8 * wave + rr - 2; const bool ok_ = (sp_ >= 0 && sp_ < SEQ); \
            const GAS bf16* src_ = P + (size_t)(b_ * SEQ + (ok_ ? sp_ : 0)) * 1536 + h_ * 128 + 2 * lane; \
            _Pragma("unroll") for (int p = 0; p < 3; ++p) { const unsigned u_ = *(const GAS unsigned*)(src_ + p * 512); praw[rr][p] = ok_ ? u_ : 0u; } } \
        if (wave < 2) { const int ti_ = wave ? 63 - lane : lane; const int t0_ = b_ * SEQ + n_ * CH; pga = SG[(size_t)(t0_ + ti_) * 32 + wave * 4 + h_]; pgb = SG[(size_t)(t0_ + ti_) * 32 + 8 + wave * 4 + h_]; } } while (0)
    DN_PF(F.wg);
    for (int item = F.wg; item < NB * NHEAD * NCH; item += F.G) {
        const int b = item >> 9, h = (item >> 7) & 3, n = item & 127;
        const int t0 = b * SEQ + n * CH;
        for (int repA = 0; repA < DNREP_A; ++repA) {
        {
            float w[3][5][2];
#pragma unroll
            for (int p = 0; p < 3; ++p)
#pragma unroll
                for (int j = 0; j < 5; ++j) { const f32x2 t = *(const GAS f32x2*)(cw + j * 1536 + p * 512 + h * 128 + 2 * lane); w[p][j][0] = t.x; w[p][j][1] = t.y; }
#pragma unroll
            for (int ii = 0; ii < 8; ++ii) {
                const int i = 8 * wave + ii;
                float y[3][2];
#pragma unroll
                for (int p = 0; p < 3; ++p) { y[p][0] = 0.f; y[p][1] = 0.f; }
#pragma unroll
                for (int j = 0; j < 5; ++j)
#pragma unroll
                    for (int p = 0; p < 3; ++p) { const unsigned u = praw[ii + j][p]; y[p][0] += bf2f(u & 0xffffu) * w[p][j][0]; y[p][1] += bf2f(u >> 16) * w[p][j][1]; }
#pragma unroll
                for (int p = 0; p < 3; ++p) { y[p][0] = y[p][0] * fast_sigmoid(y[p][0]); y[p][1] = y[p][1] * fast_sigmoid(y[p][1]); }
                const float sq = wave_sum(y[0][0] * y[0][0] + y[0][1] * y[0][1]), sk = wave_sum(y[1][0] * y[1][0] + y[1][1] * y[1][1]);
                const float rq = __builtin_amdgcn_rsqf(sq + NORM_EPS) * 0.08838834764831845f, rk = __builtin_amdgcn_rsqf(sk + NORM_EPS);
                *(LAS unsigned*)(L + DQ_OFF + i * QROW + 4 * lane) = cvt_pk_bf16(y[0][0] * rq, y[0][1] * rq);
                *(LAS unsigned*)(L + DK_OFF + i * QROW + 4 * lane) = cvt_pk_bf16(y[1][0] * rk, y[1][1] * rk);
                *(LAS unsigned*)(L + DV_OFF + i * QROW + 4 * lane) = cvt_pk_bf16(y[2][0], y[2][1]);
            }
            if (wave < 2) {
                const int d = wave; const int ti = d ? 63 - lane : lane;
                const float a = pga, bb = pgb;
                const float beta = sigmoidf_(bb);
                const float g = -expf(inp(F, I_A_LOG)[l * 8 + d * 4 + h]) * softplusf_(a + inp(F, I_DT_BIAS)[l * 8 + d * 4 + h]);
                const float gc = wave_incl_scan(g, lane);
                const float gl = __shfl(gc, 63);
                LAS float* vec = (LAS float*)(L + DVEC_OFF + d * 1024);
                vec[lane] = beta; vec[64 + lane] = gc; vec[128 + lane] = expf(gc); vec[192 + lane] = expf(gl - gc);
                if (lane == 63) ((GAS float*)(F.ws + WS_GL))[(size_t)item * 2 + d] = expf(gc);
            }
        }
        PREP_BAR();
        DSTAMP(0);
        }
        for (int repB = 0; repB < DNREP_B; ++repB) {
        {
#pragma unroll
            for (int tt = 0; tt < 2; ++tt) {
                const int t = 2 * wave + tt, mt = t >> 2, nt = t & 3;
                f32x4 ag = (f32x4){0.f, 0.f, 0.f, 0.f}, aq = (f32x4){0.f, 0.f, 0.f, 0.f};
#pragma unroll
                for (int s = 0; s < 4; ++s) {
                    const bf16x8 ka = *(const LAS bf16x8*)(L + DK_OFF + (16 * mt + fr) * QROW + 64 * s + 16 * fq);
                    const bf16x8 qa = *(const LAS bf16x8*)(L + DQ_OFF + (16 * mt + fr) * QROW + 64 * s + 16 * fq);
                    const bf16x8 kb = *(const LAS bf16x8*)(L + DK_OFF + (16 * nt + fr) * QROW + 64 * s + 16 * fq);
                    ag = __builtin_amdgcn_mfma_f32_16x16x32_bf16(ka, kb, ag, 0, 0, 0);
                    aq = __builtin_amdgcn_mfma_f32_16x16x32_bf16(qa, kb, aq, 0, 0, 0);
                }
#pragma unroll
                for (int r = 0; r < 4; ++r) { GM[(16 * mt + 4 * fq + r) * FROW + 16 * nt + fr] = ag[r]; QKM[(16 * mt + 4 * fq + r) * FROW + 16 * nt + fr] = aq[r]; }
            }
        }
        PREP_BAR();
        DSTAMP(1);
        }
        for (int repC = 0; repC < DNREP_C; ++repC) {
        {
#pragma unroll 4
            for (int e = 0; e < 16; ++e) {
                const int idx = tid + 512 * e, d = idx >> 12, i = (idx >> 6) & 63, j = idx & 63;
                const LAS float* vec = (const LAS float*)(L + DVEC_OFF + d * 1024);
                const int ti = d ? 63 - i : i, tj = d ? 63 - j : j;
                float v = (j < i) ? vec[i] * GM[ti * FROW + tj] * fexp(fminf(vec[64 + i] - vec[64 + j], 0.f)) : 0.f;
                if ((i & 31) == 0 && j >= (i & 32)) v = (j == i) ? 1.f : 0.f;
                *(LAS float*)(L + DTM_OFF + d * 17408 + (i * FROW + j) * 4) = v;
            }
        }
        PREP_BAR();
        DSTAMP(2);
        if (wave < 4) {
            const int d = wave >> 1, hb = wave & 1, c = lane & 31;
            LAS float* TM = (LAS float*)(L + DTM_OFF + d * 17408) + (32 * hb) * FROW + 32 * hb;
#define SUBST_PART(NB4, BASE) do { f32x4 m4[NB4]; float tv_[4 * NB4]; \
                _Pragma("unroll") for (int q = 0; q < NB4; ++q) m4[q] = *(const LAS f32x4*)(TM + i * FROW + (BASE) + 4 * q); \
                _Pragma("unroll") for (int q = 0; q < 4 * NB4; ++q) tv_[q] = TM[((BASE) + q) * FROW + c]; \
                _Pragma("unroll") for (int q = 0; q < NB4; ++q) { a0 -= m4[q][0] * tv_[4 * q]; a1 -= m4[q][1] * tv_[4 * q + 1]; a2 -= m4[q][2] * tv_[4 * q + 2]; a3 -= m4[q][3] * tv_[4 * q + 3]; } } while (0)
#define SUBST_END() do { const float tv = ((c == i) ? 1.f : 0.f) + ((a0 + a1) + (a2 + a3)); asm volatile("s_waitcnt lgkmcnt(0)" ::: "memory"); TM[i * FROW + c] = tv; } while (0)
#pragma unroll 1
            for (int i = 1; i < 16; ++i) { float a0 = 0.f, a1 = 0.f, a2 = 0.f, a3 = 0.f; SUBST_PART(4, 0); SUBST_END(); }
#pragma unroll 1
            for (int i = 16; i < 32; ++i) { float a0 = 0.f, a1 = 0.f, a2 = 0.f, a3 = 0.f; SUBST_PART(4, 0); asm volatile("" ::: "memory"); SUBST_PART(4, 16); SUBST_END(); }
#undef SUBST_PART
#undef SUBST_END
        } else {
            const int tw = wave - 4;
            for (int it = tw; it < 128; it += 4) {
                const int d = it >> 6, i = it & 63, ti = d ? 63 - i : i;
                const LAS float* vec = (const LAS float*)(L + DVEC_OFF + d * 1024);
                GAS unsigned char* rec = F.ws + WS_R2 + ((size_t)item * 2 + d) * DNREC;
                { const int p = 2 * lane; const int kk = (p & ~31) + sigma32(p & 31);
                  const unsigned u = *(const LAS unsigned*)(L + DQ_OFF + ti * QROW + 2 * kk); const float e = vec[128 + i];
                  *(GAS unsigned*)(rec + DN_QG + (i * 128 + p) * 2) = cvt_pk_bf16(bf2f(u & 0xffffu) * e, bf2f(u >> 16) * e); }
                { const int p = lane; const int j = (p & ~31) + sigma32(p & 31), tj = d ? 63 - j : j;
                  const float v = (j <= i) ? QKM[ti * FROW + tj] * fexp(fminf(vec[64 + i] - vec[64 + j], 0.f)) : 0.f;
                  ((GAS bf16*)(rec + DN_ATT))[i * 64 + p] = (bf16)f2bf(v); }
            }
            for (int it = tw; it < 128; it += 4) {
                const int d = it >> 6, kk = 2 * (it & 63);
                const LAS float* vec = (const LAS float*)(L + DVEC_OFF + d * 1024);
                GAS bf16* Kd = (GAS bf16*)(F.ws + WS_R2 + ((size_t)item * 2 + d) * DNREC + DN_KDT);
                const int p = lane; const int j = (p & ~31) + sigma32(p & 31), tj = d ? 63 - j : j;
                const unsigned u = *(const LAS unsigned*)(L + DK_OFF + tj * QROW + 2 * kk); const float e = vec[192 + j];
                Kd[kk * 64 + p] = (bf16)f2bf(bf2f(u & 0xffffu) * e); Kd[(kk + 1) * 64 + p] = (bf16)f2bf(bf2f(u >> 16) * e);
            }
        }
        PREP_BAR();
        DSTAMP(3);
        if (wave < 2) {
            LAS float* TM = (LAS float*)(L + DTM_OFF + wave * 17408);
            bf16x8 am[2], bt[2];
#pragma unroll
            for (int mt = 0; mt < 2; ++mt) { const f32x4 lo = *(const LAS f32x4*)(TM + (32 + 16 * mt + fr) * FROW + 8 * fq), hi = *(const LAS f32x4*)(TM + (32 + 16 * mt + fr) * FROW + 8 * fq + 4); am[mt] = pack_b(lo, hi); }
#pragma unroll
            for (int nt = 0; nt < 2; ++nt) { float xf[8];
#pragma unroll
                for (int e = 0; e < 8; ++e) xf[e] = TM[(8 * fq + e) * FROW + 16 * nt + fr];
                bt[nt] = pack8f(xf); }
            f32x4 X[2][2];
#pragma unroll
            for (int mt = 0; mt < 2; ++mt)
#pragma unroll
                for (int nt = 0; nt < 2; ++nt) X[mt][nt] = __builtin_amdgcn_mfma_f32_16x16x32_bf16(am[mt], bt[nt], (f32x4){0.f, 0.f, 0.f, 0.f}, 0, 0, 0);
            bf16x8 xb[2], a2[2];
#pragma unroll
            for (int nt = 0; nt < 2; ++nt) xb[nt] = pack_b(X[0][nt], X[1][nt]);
#pragma unroll
            for (int mt = 0; mt < 2; ++mt) { const f32x4 lo = *(const LAS f32x4*)(TM + (32 + 16 * mt + fr) * FROW + 32 + 4 * fq), hi = *(const LAS f32x4*)(TM + (32 + 16 * mt + fr) * FROW + 32 + 16 + 4 * fq); a2[mt] = pack_b(lo, hi); }
#pragma unroll
            for (int mt = 0; mt < 2; ++mt)
#pragma unroll
                for (int nt = 0; nt < 2; ++nt) { const f32x4 t21 = __builtin_amdgcn_mfma_f32_16x16x32_bf16(a2[mt], xb[nt], (f32x4){0.f, 0.f, 0.f, 0.f}, 0, 0, 0);
#pragma unroll
                    for (int r = 0; r < 4; ++r) TM[(32 + 16 * mt + 4 * fq + r) * FROW + 16 * nt + fr] = -t21[r]; }
        }
        PREP_BAR();
        DSTAMP(4);
        }
        DN_PF(item + F.G);
        for (int repD = 0; repD < DNREP_D; ++repD) {
#pragma unroll 1
        for (int d = 0; d < 2; ++d) {
            const LAS float* TM = (const LAS float*)(L + DTM_OFF + d * 17408);
            const LAS float* vec = (const LAS float*)(L + DVEC_OFF + d * 1024);
            GAS unsigned char* rec = F.ws + WS_R2 + ((size_t)item * 2 + d) * DNREC;
            bf16x8 ta[4][2];
#pragma unroll
            for (int mt = 0; mt < 4; ++mt)
#pragma unroll
                for (int s = 0; s < 2; ++s) { const f32x4 lo = *(const LAS f32x4*)(TM + (16 * mt + fr) * FROW + 32 * s + 8 * fq), hi = *(const LAS f32x4*)(TM + (16 * mt + fr) * FROW + 32 * s + 8 * fq + 4); ta[mt][s] = pack_b(lo, hi); }
#pragma unroll 1
            for (int tt = 0; tt < 2; ++tt) {
                const int nt = 2 * wave + tt; const bool isv = nt < 8; const int col = 16 * (nt & 7) + fr;
                const int imgoff = isv ? DV_OFF : DK_OFF;
                bf16x8 xb[2];
#pragma unroll
                for (int s = 0; s < 2; ++s) { float xf[8];
#pragma unroll
                    for (int e = 0; e < 8; ++e) { const int j = 32 * s + 8 * fq + e, tj = d ? 63 - j : j;
                        const float x = bf2f(*(const LAS unsigned short*)(L + imgoff + tj * QROW + 2 * col));
                        xf[e] = x * vec[j] * (isv ? 1.f : vec[128 + j]); }
                    xb[s] = pack8f(xf); }
                f32x4 acc[4];
#pragma unroll
                for (int mt = 0; mt < 4; ++mt) { acc[mt] = (f32x4){0.f, 0.f, 0.f, 0.f};
#pragma unroll
                    for (int s = 0; s < 2; ++s) acc[mt] = __builtin_amdgcn_mfma_f32_16x16x32_bf16(ta[mt][s], xb[s], acc[mt], 0, 0, 0); }
                if (isv) {
                    GAS bf16* Uf = (GAS bf16*)(rec + DN_UF) + ((nt * 64 + lane) * 16);
#pragma unroll
                    for (int mt = 0; mt < 4; ++mt) { u32x2 w2; w2.x = cvt_pk_bf16(acc[mt][0], acc[mt][1]); w2.y = cvt_pk_bf16(acc[mt][2], acc[mt][3]); *(GAS u32x2*)(Uf + mt * 4) = w2; }
                } else {
                    GAS bf16* Wp = (GAS bf16*)(rec + DN_W); const int pos = (col & ~31) + invsigma32(col & 31);
#pragma unroll
                    for (int mt = 0; mt < 4; ++mt)
#pragma unroll
                        for (int r = 0; r < 4; ++r) Wp[(16 * mt + 4 * fq + r) * 128 + pos] = (bf16)f2bf(acc[mt][r]);
                }
            }
        }
        PREP_BAR();
        DSTAMP(5);
        }
    }
#ifdef DIAG
    if (F.tid == 0 && F.wg == 0 && l == 0) { for (int k = 0; k < 6; ++k) ((GAS unsigned long long*)(F.ws + WS_CTL + 1024))[48 + k] = tacc[k]; }
#endif
}

__device__ __forceinline__ int swz256(int row, int c16) { return row * 256 + ((c16 ^ (row & 15)) << 4); }
__device__ __forceinline__ int swz128(int row, int c8) { return (row >> 1) * 256 + (((((row & 1) << 3) | c8) ^ ((row >> 1) & 15)) << 4); }
constexpr int DNBUF = 57344;
#define SCAN_BAR() do { asm volatile("s_waitcnt lgkmcnt(0)" ::: "memory"); __builtin_amdgcn_s_barrier(); asm volatile("" ::: "memory"); } while (0)
__device__ __forceinline__ void dn_scan(const Frame& F) {
    if (F.wg >= 128) return;
    const int xcd = F.wg & 7, idx = F.wg >> 3;
    const int chain = xcd * 4 + (idx >> 2), qtr = idx & 3;
    const int b = chain >> 3, h = (chain >> 1) & 3, d = chain & 1;
    const int lane = F.lane, fr = lane & 15, fq = lane >> 4, wave = F.wave;
    LAS unsigned char* L = F.lds;
    const GAS unsigned char* recbase = F.ws + WS_R2;
    const int itembase = (b * NHEAD + h) * NCH;
    if (wave >= 2) {
        const int tl = F.tid - 128;
        u32x4 ra[10], rb[10];
        int woff[10];
#pragma unroll
        for (int i = 0; i < 10; ++i) { const int q = tl + 384 * i;
            if (q < 1024) woff[i] = swz256(q >> 4, q & 15); else if (q < 2048) woff[i] = 16384 + swz256((q - 1024) >> 4, q & 15);
            else if (q < 3072) woff[i] = 32768 + swz128((q - 2048) >> 3, q & 7); else if (q < 3584) woff[i] = 49152 + swz128((q - 3072) >> 3, q & 7); else woff[i] = -1; }
#define DN_LOAD(R, step_) do { const int st_ = (step_) < NCH ? (step_) : NCH - 1; const int n_ = d ? (NCH - 1 - st_) : st_; \
        const GAS u32x4* src_ = (const GAS u32x4*)(recbase + ((size_t)(itembase + n_) * 2 + d) * DNREC) + tl; \
        _Pragma("unroll") for (int i = 0; i < 10; ++i) R[i] = src_[(woff[i] >= 0) ? 384 * i : 0]; } while (0)
#define DN_WRITE(R, bufoff_) do { _Pragma("unroll") for (int i = 0; i < 10; ++i) if (woff[i] >= 0) *(LAS u32x4*)(L + (bufoff_) + woff[i]) = R[i]; } while (0)
        u32x4 rc[10];
        DN_LOAD(ra, 0); DN_LOAD(rb, 1); DN_LOAD(rc, 2);
        DN_WRITE(ra, 0);
        SCAN_BAR();
        for (int s = 0; s < 126; s += 6) {
            DN_LOAD(ra, s + 3); DN_WRITE(rb, DNBUF); SCAN_BAR();
            DN_LOAD(rb, s + 4); DN_WRITE(rc, 0);     SCAN_BAR();
            DN_LOAD(rc, s + 5); DN_WRITE(ra, DNBUF); SCAN_BAR();
            DN_LOAD(ra, s + 6); DN_WRITE(rb, 0);     SCAN_BAR();
            DN_LOAD(rb, s + 7); DN_WRITE(rc, DNBUF); SCAN_BAR();
            DN_LOAD(rc, s + 8); DN_WRITE(ra, 0);     SCAN_BAR();
        }
        DN_WRITE(rb, DNBUF); SCAN_BAR();
        SCAN_BAR();
#undef DN_LOAD
#undef DN_WRITE
        return;
    }
    const int slice = qtr * 2 + wave;
    const GAS float* GL = (const GAS float*)(F.ws + WS_GL);
    GAS bf16* O = (GAS bf16*)(F.ws + (d ? WS_OB : WS_OF));
    f32x4 S[8];
#pragma unroll
    for (int k = 0; k < 8; ++k) S[k] = (f32x4){0.f, 0.f, 0.f, 0.f};
    int offw[4], offk[8], offa[4];
#pragma unroll
    for (int t = 0; t < 4; ++t) { offw[t] = (16 * t + fr) * 256; offa[t] = ((16 * t + fr) >> 1) * 256; }
#pragma unroll
    for (int t = 0; t < 8; ++t) offk[t] = ((16 * t + fr) >> 1) * 256;
    const int x256 = fr & 15;
    const int x128 = (fr >> 1) & 15, p128 = (fr & 1) << 3;
    u32x4 uc0, uc1, un0, un1; float egl_c, egl_n;
#define DN_UFETCH(A0, A1, EG, step_) do { const int st_ = (step_) < NCH ? (step_) : NCH - 1; const int nn_ = d ? (NCH - 1 - st_) : st_; \
        const GAS bf16* Uf_ = (const GAS bf16*)(recbase + ((size_t)(itembase + nn_) * 2 + d) * DNREC + DN_UF); A0 = *(const GAS u32x4*)(Uf_ + (slice * 64 + lane) * 16); A1 = *(const GAS u32x4*)(Uf_ + (slice * 64 + lane) * 16 + 8); \
        EG = GL[(size_t)(itembase + nn_) * 2 + d]; } while (0)
    DN_UFETCH(uc0, uc1, egl_c, 0); DN_UFETCH(un0, un1, egl_n, 1);
    SCAN_BAR();
    for (int step = 0; step < NCH; ++step) {
        const int n = d ? (NCH - 1 - step) : step;
        const int bufoff = (step & 1) ? DNBUF : 0;
        const u32x4 u0 = uc0, u1 = uc1; const float egl = egl_c;
        uc0 = un0; uc1 = un1; egl_c = egl_n;
        DN_UFETCH(un0, un1, egl_n, step + 2);
        const LAS unsigned char* Bw = L + bufoff; const LAS unsigned char* Bq = Bw + 16384; const LAS unsigned char* Bk = Bw + 32768; const LAS unsigned char* Ba = Bw + 49152;
#define LD_WQ(G, s_) do { _Pragma("unroll") for (int mt = 0; mt < 4; ++mt) { const int o_ = offw[mt] + (((4 * (s_) + fq) ^ x256) << 4); G[mt] = *(const LAS bf16x8*)(Bw + o_); G[4 + mt] = *(const LAS bf16x8*)(Bq + o_); } } while (0)
#define MM_WQ(G, s_) do { _Pragma("unroll") for (int mt = 0; mt < 4; ++mt) { V[mt] = __builtin_amdgcn_mfma_f32_16x16x32_bf16(G[mt], SB[s_], V[mt], 0, 0, 0); Q[mt] = __builtin_amdgcn_mfma_f32_16x16x32_bf16(SB[s_], G[4 + mt], Q[mt], 0, 0, 0); } } while (0)
#define LD_K(G, s2_) do { _Pragma("unroll") for (int kt = 0; kt < 8; ++kt) { const int xr_ = (8 * kt + (fr >> 1)) & 15; G[kt] = *(const LAS bf16x8*)(Bk + offk[kt] + (((p128 | (4 * (s2_) + fq)) ^ xr_) << 4)); } } while (0)
#define SCHED_() __builtin_amdgcn_sched_barrier(0)
        bf16x8 g0[8], g1[8];
        LD_WQ(g0, 0);
        bf16x8 SB[4];
#pragma unroll
        for (int s = 0; s < 4; ++s) SB[s] = pack_b(S[2 * s], S[2 * s + 1]);
        f32x4 V[4], Q[4];
#pragma unroll
        for (int mt = 0; mt < 4; ++mt) { V[mt] = (f32x4){0.f, 0.f, 0.f, 0.f}; Q[mt] = (f32x4){0.f, 0.f, 0.f, 0.f}; }
        SCHED_(); LD_WQ(g1, 1); SCHED_(); MM_WQ(g0, 0); SCHED_();
        LD_WQ(g0, 2); SCHED_(); MM_WQ(g1, 1); SCHED_();
        LD_WQ(g1, 3); SCHED_(); MM_WQ(g0, 2); SCHED_();
#pragma unroll
        for (int s2 = 0; s2 < 2; ++s2)
#pragma unroll
            for (int mt = 0; mt < 4; ++mt) { const int xr = (8 * mt + (fr >> 1)) & 15; g0[s2 * 4 + mt] = *(const LAS bf16x8*)(Ba + offa[mt] + (((p128 | (4 * s2 + fq)) ^ xr) << 4)); }
        SCHED_(); MM_WQ(g1, 3); SCHED_();
        LD_K(g1, 0); SCHED_();
        {
            float uu[16]; { float t[8]; unpack8(u0, t);
#pragma unroll
                for (int e = 0; e < 8; ++e) uu[e] = t[e]; unpack8(u1, t);
#pragma unroll
                for (int e = 0; e < 8; ++e) uu[8 + e] = t[e]; }
#pragma unroll
            for (int mt = 0; mt < 4; ++mt)
#pragma unroll
                for (int r = 0; r < 4; ++r) V[mt][r] = uu[mt * 4 + r] - V[mt][r];
        }
        bf16x8 VB[2];
#pragma unroll
        for (int s2 = 0; s2 < 2; ++s2) VB[s2] = pack_b(V[2 * s2], V[2 * s2 + 1]);
#pragma unroll
        for (int kt = 0; kt < 8; ++kt) S[kt] = S[kt] * egl;
        SCHED_();
#pragma unroll
        for (int s2 = 0; s2 < 2; ++s2)
#pragma unroll
            for (int mt = 0; mt < 4; ++mt) Q[mt] = __builtin_amdgcn_mfma_f32_16x16x32_bf16(VB[s2], g0[s2 * 4 + mt], Q[mt], 0, 0, 0);
        SCHED_(); LD_K(g0, 1); SCHED_();
#pragma unroll
        for (int kt = 0; kt < 8; ++kt) S[kt] = __builtin_amdgcn_mfma_f32_16x16x32_bf16(g1[kt], VB[0], S[kt], 0, 0, 0);
        SCHED_();
#pragma unroll
        for (int kt = 0; kt < 8; ++kt) S[kt] = __builtin_amdgcn_mfma_f32_16x16x32_bf16(g0[kt], VB[1], S[kt], 0, 0, 0);
        SCHED_();
#undef LD_WQ
#undef MM_WQ
#undef LD_K
#undef SCHED_
#pragma unroll
        for (int mt = 0; mt < 4; ++mt) {
            const int i = 16 * mt + fr; const int tok = b * SEQ + n * CH + (d ? 63 - i : i);
            u32x2 w2; w2.x = cvt_pk_bf16(Q[mt][0], Q[mt][1]); w2.y = cvt_pk_bf16(Q[mt][2], Q[mt][3]);
            *(GAS u32x2*)(O + (size_t)tok * MIXW + h * HD + slice * 16 + 4 * fq) = w2;
        }
        SCAN_BAR();
    }
}

constexpr int MQ_OFF = 0, MK_OFF = 9216, MV_OFF = 18432, MQK_OFF = 35840, MVEC_OFF = 52480;
constexpr int MQROW = 144;
#ifndef MLREP_1
#define MLREP_1 1
#endif
#ifndef MLREP_2
#define MLREP_2 1
#endif
#ifndef MLREP_3
#define MLREP_3 1
#endif
#ifndef MLREP_4
#define MLREP_4 1
#endif
#ifndef POOLREP
#define POOLREP 1
#endif
__device__ __forceinline__ void ml_prep(const Frame& F, int l) {
    LAS unsigned char* L = F.lds;
    const int lane = F.lane, wave = F.wave, tid = F.tid;
    const GAS bf16* PQ = (const GAS bf16*)(F.ws + WS_PMQ); const GAS bf16* PK = (const GAS bf16*)(F.ws + WS_PMK); const GAS bf16* PV = (const GAS bf16*)(F.ws + WS_PMV);
    const GAS float* SG = (const GAS float*)(F.ws + WS_SG);
    const GAS float* gbias = inp(F, I_ML_GATE_B) + l * 16;
    u32x4 pq, pk, pv0, pv1; float pip = 0.f, pfp = 0.f;
#define ML_PF(item_) do { const int it_ = (item_) < NB * NHEAD * NCH ? (item_) : F.wg; const int b_ = it_ >> 9, h_ = (it_ >> 7) & 3, n_ = it_ & 127; const int t0_ = b_ * SEQ + n_ * CH; \
        const int row_ = tid >> 3, c8_ = tid & 7; \
        pq = *(const GAS u32x4*)(PQ + (size_t)(t0_ + row_) * 256 + h_ * 64 + 8 * c8_); pk = *(const GAS u32x4*)(PK + (size_t)(t0_ + row_) * 256 + h_ * 64 + 8 * c8_); \
        pv0 = *(const GAS u32x4*)(PV + (size_t)(t0_ + (tid >> 4)) * 512 + h_ * 128 + 8 * (tid & 15)); pv1 = *(const GAS u32x4*)(PV + (size_t)(t0_ + 32 + (tid >> 4)) * 512 + h_ * 128 + 8 * (tid & 15)); \
        if (wave < 2) { const int ti_ = wave ? 63 - lane : lane; pip = SG[(size_t)(t0_ + ti_) * 32 + 16 + wave * 4 + h_]; pfp = SG[(size_t)(t0_ + ti_) * 32 + 24 + wave * 4 + h_]; } } while (0)
    ML_PF(F.wg);
    for (int item = F.wg; item < NB * NHEAD * NCH; item += F.G) {
        const int b = item >> 9, h = (item >> 7) & 3, n = item & 127;
        const int t0 = b * SEQ + n * CH;
        float ip_raw = pip, fp_raw = pfp;
        for (int rep1 = 0; rep1 < MLREP_1; ++rep1) {
        {
            const int row = tid >> 3, c8 = tid & 7;
            u32x4 k = pk;
            { float f[8]; unpack8(k, f); k.x = pk2(f[0] * 0.125f, f[1] * 0.125f); k.y = pk2(f[2] * 0.125f, f[3] * 0.125f); k.z = pk2(f[4] * 0.125f, f[5] * 0.125f); k.w = pk2(f[6] * 0.125f, f[7] * 0.125f); }
            *(LAS u32x4*)(L + MQ_OFF + row * MQROW + 16 * c8) = pq;
            *(LAS u32x4*)(L + MK_OFF + row * MQROW + 16 * c8) = k;
            *(LAS u32x4*)(L + MV_OFF + (tid >> 4) * QROW + 16 * (tid & 15)) = pv0;
            *(LAS u32x4*)(L + MV_OFF + (32 + (tid >> 4)) * QROW + 16 * (tid & 15)) = pv1;
            ML_PF(item + F.G);
        }
        PREP_BAR();
        }
        for (int rep2 = 0; rep2 < MLREP_2; ++rep2) {
        {
            const int fr = lane & 15, fq = lane >> 4;
#pragma unroll
            for (int tt = 0; tt < 2; ++tt) {
                const int t = 2 * wave + tt, mt = t >> 2, nt = t & 3;
                f32x4 aq = (f32x4){0.f, 0.f, 0.f, 0.f};
#pragma unroll
                for (int s2 = 0; s2 < 2; ++s2) {
                    const bf16x8 qa = *(const LAS bf16x8*)(L + MQ_OFF + (16 * mt + fr) * MQROW + 64 * s2 + 16 * fq);
                    const bf16x8 kb = *(const LAS bf16x8*)(L + MK_OFF + (16 * nt + fr) * MQROW + 64 * s2 + 16 * fq);
                    aq = __builtin_amdgcn_mfma_f32_16x16x32_bf16(qa, kb, aq, 0, 0, 0);
                }
#pragma unroll
                for (int r = 0; r < 4; ++r) *(LAS float*)(L + MQK_OFF + ((16 * mt + 4 * fq + r) * 65 + 16 * nt + fr) * 4) = aq[r];
            }
        }
        }
        for (int rep3 = 0; rep3 < MLREP_3; ++rep3) {
        if (wave < 2) {
            const int d = wave; const int ti = d ? 63 - lane : lane;
            const float ip = ip_raw + gbias[d * 4 + h];
            const float fp = fp_raw + gbias[8 + d * 4 + h];
            const float bc = wave_incl_scan(logsigmoidf_(fp), lane);
            const float bl = __shfl(bc, 63);
            const float lw = bl - bc + ip;
            const float am = wave_max(lw);
            const float wgt = expf(lw - am);
            const float ipb = ip - bc;
            const float dmax = bc + wave_incl_maxscan(ipb, lane);
            LAS float* vec = (LAS float*)(L + MVEC_OFF + d * 1024);
            vec[lane] = bc; vec[64 + lane] = dmax; vec[128 + lane] = wgt; vec[192 + lane] = ipb;
            GAS float* row = (GAS float*)(F.ws + WS_ML + ((size_t)item * 2 + d) * MLREC + ML_ROW);
            row[lane] = bc; row[64 + lane] = dmax; if (lane == 0) { row[128] = am; row[129] = bl; }
        }
        PREP_BAR();
        }
        for (int rep4 = 0; rep4 < MLREP_4; ++rep4) {
        {
            const LAS float* QKM = (const LAS float*)(L + MQK_OFF);
            for (int it = wave; it < 128; it += NWAVES) {
                const int d = it >> 6, i = it & 63, j = lane;
                const LAS float* vec = (const LAS float*)(L + MVEC_OFF + d * 1024);
                GAS unsigned char* rec = F.ws + WS_ML + ((size_t)item * 2 + d) * MLREC;
                const int ti = d ? 63 - i : i, tj = d ? 63 - j : j;
                const float sv = (j <= i) ? QKM[ti * 65 + tj] * fexp(fminf(vec[i] + vec[192 + j] - vec[64 + i], 0.f)) : 0.f;
                ((GAS bf16*)(rec + ML_ST))[i * 64 + j] = (bf16)f2bf(sv);
                ((GAS bf16*)(rec + ML_Q))[i * 64 + j] = *(const LAS unsigned short*)(L + MQ_OFF + ti * MQROW + 2 * ((j & ~31) + sigma32(j & 31)));
                const float kv = bf2f(*(const LAS unsigned short*)(L + MK_OFF + tj * MQROW + 2 * i));
                ((GAS bf16*)(rec + ML_KWT))[i * 64 + j] = (bf16)f2bf(kv * vec[128 + j]);
            }
            for (int it = wave; it < 36; it += NWAVES) {
                const int d = it / 18, q = it - 18 * d, slice = q >> 1, s2 = q & 1;
                GAS unsigned char* rec = F.ws + WS_ML + ((size_t)item * 2 + d) * MLREC;
                const int fr = lane & 15, fq = lane >> 4;
                unsigned short e8[8];
#pragma unroll
                for (int el = 0; el < 8; ++el) { const int j = 32 * s2 + 8 * fq + el; const int tj = d ? 63 - j : j;
                    e8[el] = (slice < 8) ? *(const LAS unsigned short*)(L + MV_OFF + tj * QROW + 2 * (16 * slice + fr)) : (unsigned short)0x3F80; }
                u32x4 w; w.x = e8[0] | ((unsigned)e8[1] << 16); w.y = e8[2] | ((unsigned)e8[3] << 16); w.z = e8[4] | ((unsigned)e8[5] << 16); w.w = e8[6] | ((unsigned)e8[7] << 16);
                *(GAS u32x4*)(rec + ML_VF + (((slice * 2 + s2) * 64 + lane) * 8) * 2) = w;
            }
        }
        PREP_BAR();
        }
    }
}
constexpr int MLBUF = 25600;
__device__ __forceinline__ void ml_scan(const Frame& F) {
    if (F.wg >= 64) return;
    const int xcd = F.wg & 7, idx = F.wg >> 3;
    const int chain = xcd * 4 + (idx >> 1), hf = idx & 1;
    const int b = chain >> 3, h = (chain >> 1) & 3, d = chain & 1;
    const int lane = F.lane, fr = lane & 15, fq = lane >> 4, wave = F.wave;
    LAS unsigned char* L = F.lds;
    const GAS unsigned char* recbase = F.ws + WS_ML;
    const int itembase = (b * NHEAD + h) * NCH;
    if (wave >= 5) {
        const int tl = F.tid - 320;
        u32x4 ra[9], rb[9]; int woff[9], goff[9];
#pragma unroll
        for (int i = 0; i < 9; ++i) { const int q = tl + 192 * i;
            if (q < 1536) { const int qq = q & 511; woff[i] = (q >> 9) * 8192 + swz128(qq >> 3, qq & 7); goff[i] = q; }
            else if (q < 1600) { woff[i] = 24576 + (q - 1536) * 16; goff[i] = 2688 + (q - 1536); }
            else { woff[i] = -1; goff[i] = 0; } }
#define ML_LOAD(R, step_) do { const int st_ = (step_) < NCH ? (step_) : NCH - 1; const int n_ = d ? (NCH - 1 - st_) : st_; \
        const GAS u32x4* src_ = (const GAS u32x4*)(recbase + ((size_t)(itembase + n_) * 2 + d) * MLREC); \
        _Pragma("unroll") for (int i = 0; i < 9; ++i) R[i] = src_[goff[i]]; } while (0)
#define ML_WRITE(R, bufoff_) do { _Pragma("unroll") for (int i = 0; i < 9; ++i) if (woff[i] >= 0) *(LAS u32x4*)(L + (bufoff_) + woff[i]) = R[i]; } while (0)
        ML_LOAD(ra, 0); ML_LOAD(rb, 1);
        ML_WRITE(ra, 0);
        SCAN_BAR();
        for (int s = 0; s < NCH; s += 2) {
            ML_LOAD(ra, s + 2); ML_WRITE(rb, MLBUF); SCAN_BAR();
            ML_LOAD(rb, s + 3); ML_WRITE(ra, 0);     SCAN_BAR();
        }
#undef ML_LOAD
#undef ML_WRITE
        return;
    }
    const int slice = (wave < 4) ? hf * 4 + wave : 8;
    const bool active = (wave < 4) || (hf == 1);
    GAS bf16* NUM = (GAS bf16*)(F.ws + (d ? WS_NUMB : WS_NUMF)); GAS float* DEN = (GAS float*)(F.ws + WS_DEN);
    f32x4 C[4];
#pragma unroll
    for (int k = 0; k < 4; ++k) C[k] = (f32x4){0.f, 0.f, 0.f, 0.f};
    float m = 0.f;
    int offr[4];
#pragma unroll
    for (int t = 0; t < 4; ++t) offr[t] = ((16 * t + fr) >> 1) * 256;
    const int p128 = (fr & 1) << 3;
    bf16x8 vc0, vc1, vn0, vn1;
#define ML_VFETCH(A0, A1, step_) do { const int st_ = (step_) < NCH ? (step_) : NCH - 1; const int nn_ = d ? (NCH - 1 - st_) : st_; \
        const GAS bf16* Vf_ = (const GAS bf16*)(recbase + ((size_t)(itembase + nn_) * 2 + d) * MLREC + ML_VF); \
        A0 = *(const GAS bf16x8*)(Vf_ + ((slice * 2 + 0) * 64 + lane) * 8); A1 = *(const GAS bf16x8*)(Vf_ + ((slice * 2 + 1) * 64 + lane) * 8); } while (0)
    ML_VFETCH(vc0, vc1, 0); ML_VFETCH(vn0, vn1, 1);
    SCAN_BAR();
    for (int step = 0; step < NCH; ++step) {
        const int n = d ? (NCH - 1 - step) : step;
        const int bufoff = (step & 1) ? MLBUF : 0;
        bf16x8 VF[2]; VF[0] = vc0; VF[1] = vc1;
        vc0 = vn0; vc1 = vn1;
        ML_VFETCH(vn0, vn1, step + 2);
        if (active) {
        const LAS unsigned char* Bq = L + bufoff; const LAS unsigned char* Bs = Bq + 8192; const LAS unsigned char* Bk = Bq + 16384; const LAS float* row = (const LAS float*)(Bq + 24576);
        const float am = row[128], bl = row[129];
        bf16x8 CB[2];
#pragma unroll
        for (int s = 0; s < 2; ++s) CB[s] = pack_b(C[2 * s], C[2 * s + 1]);
        bf16x8 fq_[8], fs_[8], fk_[8];
#pragma unroll
        for (int s = 0; s < 2; ++s)
#pragma unroll
            for (int mt = 0; mt < 4; ++mt) { const int xr = (8 * mt + (fr >> 1)) & 15; const int o = offr[mt] + (((p128 | (4 * s + fq)) ^ xr) << 4);
                fq_[s * 4 + mt] = *(const LAS bf16x8*)(Bq + o); fs_[s * 4 + mt] = *(const LAS bf16x8*)(Bs + o); fk_[s * 4 + mt] = *(const LAS bf16x8*)(Bk + o); }
        f32x4 QC[4], SV[4], KV[4];
#pragma unroll
        for (int mt = 0; mt < 4; ++mt) { QC[mt] = (f32x4){0.f, 0.f, 0.f, 0.f}; SV[mt] = (f32x4){0.f, 0.f, 0.f, 0.f}; KV[mt] = (f32x4){0.f, 0.f, 0.f, 0.f}; }
#pragma unroll
        for (int s = 0; s < 2; ++s)
#pragma unroll
            for (int mt = 0; mt < 4; ++mt) {
                QC[mt] = __builtin_amdgcn_mfma_f32_16x16x32_bf16(CB[s], fq_[s * 4 + mt], QC[mt], 0, 0, 0);
                SV[mt] = __builtin_amdgcn_mfma_f32_16x16x32_bf16(VF[s], fs_[s * 4 + mt], SV[mt], 0, 0, 0);
                KV[mt] = __builtin_amdgcn_mfma_f32_16x16x32_bf16(fk_[s * 4 + mt], VF[s], KV[mt], 0, 0, 0);
            }
#pragma unroll
        for (int mt = 0; mt < 4; ++mt) {
            const int i = 16 * mt + fr; const int tok = b * SEQ + n * CH + (d ? 63 - i : i);
            const float bci = row[i], dmi = row[64 + i];
            const float il = bci + m, mo = fmaxf(il, dmi);
            const float inter = fexp(il - mo), e2 = fexp(dmi - mo);
            const f32x4 res = QC[mt] * inter + SV[mt] * e2;
            if (slice < 8) { u32x2 w2; w2.x = cvt_pk_bf16(res[0], res[1]); w2.y = cvt_pk_bf16(res[2], res[3]); *(GAS u32x2*)(NUM + (size_t)tok * MIXW + h * HD + slice * 16 + 4 * fq) = w2; }
            else if (fq == 0) DEN[(size_t)tok * 8 + h * 2 + d] = fmaxf(fabsf(res[0]), fexp(-mo));
        }
        const float mn = fmaxf(bl + m, am), sp = fexp(bl + m - mn), sc = fexp(am - mn);
#pragma unroll
        for (int kt = 0; kt < 4; ++kt) C[kt] = C[kt] * sp + KV[kt] * sc;
        m = mn;
        }
        SCAN_BAR();
    }
}

template <int H>
__device__ __forceinline__ void pool_block(const GAS bf16* U, GAS bf16* Y, int t0, int g, int lane) {
    constexpr int NR = 32 + 2 * H;
    const int sp0 = t0 & (SEQ - 1);
    float x0[NR], x1[NR];
#pragma unroll
    for (int r = 0; r < NR; ++r) {
        const int sp = sp0 - H + r; const bool ok = (sp >= 0 && sp < SEQ);
        const unsigned u = ok ? *(const GAS unsigned*)(U + (size_t)(t0 - H + r) * MIXW + 128 * g + 2 * lane) : 0u;
        x0[r] = bf2f(u & 0xffffu); x1[r] = bf2f(u >> 16);
    }
    float s0 = 0.f, s1 = 0.f;
#pragma unroll
    for (int r = 0; r < 2 * H; ++r) { s0 += x0[r]; s1 += x1[r]; }
#pragma unroll
    for (int t = 0; t < 32; ++t) {
        const int sp = sp0 + t; const int cnt = min(sp + H, SEQ) - max(sp - H, 0);
        const float inv = 1.0f / (float)cnt;
        *(GAS unsigned*)(Y + (size_t)(t0 + t) * MIXW + 128 * g + 2 * lane) = cvt_pk_bf16(s0 * inv - x0[t + H], s1 * inv - x1[t + H]);
        if (t < 31) { s0 += x0[t + 2 * H] - x0[t]; s1 += x1[t + 2 * H] - x1[t]; }
    }
}
__device__ __forceinline__ void pool_phase(const Frame& F) {
    const GAS bf16* U = (const GAS bf16*)(F.ws + WS_PPOOL); GAS bf16* Y = (GAS bf16*)(F.ws + WS_YP);
    const int gw = F.wg * NWAVES + F.wave, NGW = F.G * NWAVES, lane = F.lane;
    for (int prep = 0; prep < POOLREP; ++prep)
    for (int task = gw; task < (T / 32) * 4; task += NGW) {
        const int g = task & 3, t0 = (task >> 2) * 32;
        if (g == 0) pool_block<1>(U, Y, t0, g, lane); else if (g == 1) pool_block<2>(U, Y, t0, g, lane); else if (g == 2) pool_block<4>(U, Y, t0, g, lane); else pool_block<8>(U, Y, t0, g, lane);
    }
}

__device__ __forceinline__ void norm_phase(const Frame& F, int l, bool dummy = false) {
    const GAS bf16* OF = (const GAS bf16*)(F.ws + WS_OF); const GAS bf16* OB = (const GAS bf16*)(F.ws + WS_OB);
    const GAS bf16* NF = (const GAS bf16*)(F.ws + WS_NUMF); const GAS bf16* NBk = (const GAS bf16*)(F.ws + WS_NUMB); const GAS float* DEN = (const GAS float*)(F.ws + WS_DEN);
    GAS bf16* Z = (GAS bf16*)(F.ws + WS_PZ); GAS bf16* MO = (GAS bf16*)(F.ws + WS_PMO);
    GAS bf16* ZO = dummy ? (GAS bf16*)(F.ws + WS_GATE) : Z; GAS bf16* MOO = dummy ? (GAS bf16*)(F.ws + WS_GATE + 32 * MiB) : MO;
    const int gw = F.wg * NWAVES + F.wave, NGW = F.G * NWAVES, lane = F.lane, h = lane >> 4;
    float nw[8], mw[8];
#pragma unroll
    for (int e = 0; e < 8; ++e) { nw[e] = inp(F, I_DN_NORM)[l * MIXW + 8 * lane + e]; mw[e] = inp(F, I_ML_NORM)[l * MIXW + 8 * lane + e]; }
    for (int t = gw; t < T; t += NGW) {
        const size_t off = (size_t)t * MIXW + 8 * lane;
        {
            float a[8], bq[8], z[8]; unpack8(*(const GAS u32x4*)(OF + off), a); unpack8(*(const GAS u32x4*)(OB + off), bq); unpack8(*(const GAS u32x4*)(Z + off), z);
            float ss = 0.f;
#pragma unroll
            for (int e = 0; e < 8; ++e) { a[e] += bq[e]; ss += a[e] * a[e]; }
            ss += __shfl_xor(ss, 1); ss += __shfl_xor(ss, 2); ss += __shfl_xor(ss, 4); ss += __shfl_xor(ss, 8);
            const float r = 1.0f / sqrtf(ss * (1.f / HD) + NORM_EPS);
            float o[8];
#pragma unroll
            for (int e = 0; e < 8; ++e) o[e] = a[e] * r * nw[e] * siluf_(z[e]);
            u32x4 w; w.x = pk2(o[0], o[1]); w.y = pk2(o[2], o[3]); w.z = pk2(o[4], o[5]); w.w = pk2(o[6], o[7]);
            *(GAS u32x4*)(ZO + off) = w;
        }
        {
            float a[8], bq[8], g[8]; unpack8(*(const GAS u32x4*)(NF + off), a); unpack8(*(const GAS u32x4*)(NBk + off), bq); unpack8(*(const GAS u32x4*)(MO + off), g);
            const float df = 1.0f / DEN[(size_t)t * 8 + h * 2], db = 1.0f / DEN[(size_t)t * 8 + h * 2 + 1];
            float s = 0.f;
#pragma unroll
            for (int e = 0; e < 8; ++e) { a[e] = a[e] * df + bq[e] * db; s += a[e]; }
            s += __shfl_xor(s, 1); s += __shfl_xor(s, 2); s += __shfl_xor(s, 4); s += __shfl_xor(s, 8);
            const float mean = s * (1.f / HD); float ss = 0.f;
#pragma unroll
            for (int e = 0; e < 8; ++e) { a[e] -= mean; ss += a[e] * a[e]; }
            ss += __shfl_xor(ss, 1); ss += __shfl_xor(ss, 2); ss += __shfl_xor(ss, 4); ss += __shfl_xor(ss, 8);
            const float r = 1.0f / sqrtf(ss * (1.f / HD) + NORM_EPS);
            float o[8];
#pragma unroll
            for (int e = 0; e < 8; ++e) o[e] = a[e] * r * mw[e] * sigmoidf_(g[e]);
            u32x4 w; w.x = pk2(o[0], o[1]); w.y = pk2(o[2], o[3]); w.z = pk2(o[4], o[5]); w.w = pk2(o[6], o[7]);
            *(GAS u32x4*)(MOO + off) = w;
        }
    }
}

__device__ __forceinline__ void moe_tables(const Frame& F) {
    LAS int* cnt = (LAS int*)(F.lds + LHIST_OFF + 128); LAS int* pstart = (LAS int*)(F.lds + LHIST_OFF + 256); LAS int* mybase = (LAS int*)(F.lds + LHIST_OFF + 384);
    LAS int* pe = (LAS int*)(F.lds + LPE_OFF);
    const GAS int* hist = (const GAS int*)(F.ws + WS_HIST);
    if (F.tid < 32) { cnt[F.tid] = 0; mybase[F.tid] = 0; }
    __syncthreads();
    { const int e = F.tid & 31, part = F.tid >> 5; int tot = 0, base = 0;
      for (int q = 0; q < 16; ++q) { const int w = part * 16 + q; const int v = hist[w * 32 + e]; tot += v; base += v * min(max(F.wg - w, 0), 1); }
      __hip_atomic_fetch_add(cnt + e, tot, __ATOMIC_RELAXED, __HIP_MEMORY_SCOPE_WORKGROUP); __hip_atomic_fetch_add(mybase + e, base, __ATOMIC_RELAXED, __HIP_MEMORY_SCOPE_WORKGROUP); }
    __syncthreads();
    if (F.tid == 0) { int acc = 0, p = 0; for (int e = 0; e < NEXP; ++e) { pstart[e] = acc; const int np = (cnt[e] + 255) >> 8; for (int q = 0; q < np; ++q) pe[p++] = e; acc += np * 256; } pe[319] = p; }
    __syncthreads();
}
__device__ __forceinline__ void moe_dispatch(const Frame& F) {
    moe_tables(F);
    LAS int* pstart = (LAS int*)(F.lds + LHIST_OFF + 256); LAS int* mybase = (LAS int*)(F.lds + LHIST_OFF + 384);
    LAS int* lpos = (LAS int*)(F.lds);
    LAS int* le = (LAS int*)(F.lds + 1024);
    const GAS int* eid = (const GAS int*)(F.ws + WS_EID); const GAS float* ew = (const GAS float*)(F.ws + WS_EW);
    GAS int* pos = (GAS int*)(F.ws + WS_POS); GAS float* roww = (GAS float*)(F.ws + WS_ROWW);
    const int rows_per_wg = T / F.G, row0 = F.wg * rows_per_wg;
    int my_e = 0; float my_w = 0.f;
    if (F.tid < 256) { my_e = eid[2 * row0 + F.tid]; my_w = ew[2 * row0 + F.tid]; le[F.tid] = my_e; }
    __syncthreads();
    if (F.tid < 256) {
        int rank = 0;
        for (int a = 0; a < F.tid; ++a) rank += (le[a] == my_e) ? 1 : 0;
        const int p = pstart[my_e] + mybase[my_e] + rank;
        lpos[F.tid] = p; pos[2 * row0 + F.tid] = p; roww[p] = my_w; ((GAS int*)(F.ws + WS_ROWTOK))[p] = row0 + (F.tid >> 1);
    }
    __syncthreads();
    if (F.wg == 0 && F.tid < 32) { LAS int* cnt = (LAS int*)(F.lds + LHIST_OFF + 128); const int e = F.tid; const int c0 = cnt[e], pc = (c0 + 255) & ~255;
        GAS int* rt = (GAS int*)(F.ws + WS_ROWTOK); for (int q = c0; q < pc; ++q) rt[pstart[e] + q] = 0; }
    __syncthreads();
}

constexpr int NPHASE = 1 + 15 * DEPTH;
#ifndef PHM
#define PHM 0xFFFF
#endif
#define PHON(b) ((PHM >> (b)) & 1)
#ifndef REPEAT_PHASE
#define REPEAT_PHASE -1
#endif
#define NREP(k) (((k) == REPEAT_PHASE) ? 2 : 1)
__global__ void __launch_bounds__(NWAVES * 64, 2) mega_fwd(Args args) {
    extern __shared__ __attribute__((aligned(16))) unsigned char lds_raw[];
    LAS unsigned char* lds = (LAS unsigned char*)lds_raw;
    const int wave = __builtin_amdgcn_readfirstlane((int)threadIdx.x >> 6);
    for (int u = threadIdx.x; u < (LDS_BYTES - RING_BYTES) / 4; u += NWAVES * 64) ((LAS unsigned*)(lds + RING_BYTES))[u] = 0u;
    __syncthreads();
    if (threadIdx.x == 0) { LAS unsigned long long* ap = (LAS unsigned long long*)(lds + LARG_OFF);
#pragma unroll
        for (int i = 0; i < 23; ++i) ap[i] = (unsigned long long)args.in[i];
        ap[23] = (unsigned long long)args.out; ap[24] = (unsigned long long)args.ws; }
    __syncthreads();
    const int lo = args.ph_lo, hi = args.ph_hi;
    if (hi - lo > 1) { const XcdBarrier b0 = xcd_barrier_post((unsigned*)(args.ws + WS_CTL) + CW_BAR, (volatile LAS unsigned*)(lds + MISC_OFF) + 8);
        if (threadIdx.x == 0) ((volatile LAS unsigned*)(lds + MISC_OFF))[10] = b0.x; }
    __syncthreads();
#ifdef DIAG
    if (threadIdx.x == 0 && blockIdx.x == 0 && lo == 0) ((unsigned long long*)(args.ws + WS_CTL + 1024))[0] = __builtin_amdgcn_s_memrealtime();
#endif
    int ph = lo, rep = 0;
#pragma unroll 1
    while (ph < hi) {
        const Frame F = fresh(lds, wave);
        const bool DRY = (REPEAT_PHASE >= 0) && (rep == 0) && (((ph >= 1) ? ((ph - 1) % 15) : 15) == REPEAT_PHASE);
        const int l = (ph >= 1) ? (ph - 1) / 15 : 0;
        const int k = (ph >= 1) ? (ph - 1) - 15 * l : 15;
        if (PHON(15) && k == 15) {
            wprep_mixer(F, 0);
            __syncthreads();
            ln_phase<0>(F, inp(F, I_LN_IN_G), inp(F, I_LN_IN_B), inp(F, I_W_IN), DIN, true, true, DRY);
        } else if (PHON(0) && k == 0) {
            pg8::StaticOrder S; S.init(F.ws + WS_HB, F.ws + WS_WIN, T, 1536, D, F.G, F.wg);
            EpiG1a E{(GAS bf16*)(F.ws + WS_PQKV)};
            pg8::gemm_phase<EpiG1a, pg8::StaticOrder>(F.lds, F.tid, D, S, E);
        } else if (PHON(1) && k == 1) { dn_prep(F, l);
        } else if (PHON(2) && k == 2) { if (F.wg < 128) dn_scan(F); else wprep_moe(F, l, 128, 128);
        } else if (PHON(3) && k == 3) {
            pg8::StaticOrder S; S.init(F.ws + WS_HB, F.ws + WS_WIN + (size_t)1536 * D * 2, T, 2560, D, F.G, F.wg);
            EpiG1b E{F.ws};
            pg8::gemm_phase<EpiG1b, pg8::StaticOrder>(F.lds, F.tid, D, S, E);
        } else if (PHON(4) && k == 4) { pool_phase(F); ml_prep(F, l);
        } else if (PHON(5) && k == 5) { ml_scan(F);
        } else if (PHON(6) && k == 6) { norm_phase(F, l, DRY);
        } else if (PHON(7) && k == 7) {
            pg8::StaticOrder S; S.init(F.ws + WS_HB, F.ws + WS_WGATE, T, 3072, D, F.G, F.wg);
            EpiGate E{(GAS bf16*)(F.ws + WS_GATE)};
            pg8::gemm_phase<EpiGate, pg8::StaticOrder>(F.lds, F.tid, D, S, E);
        } else if (PHON(8) && k == 8) {
            MergeOrder S; S.Y[0] = (const GAS char*)(F.ws + WS_PZ); S.Y[1] = (const GAS char*)(F.ws + WS_YP); S.Y[2] = (const GAS char*)(F.ws + WS_PMO); S.W = (const GAS char*)(F.ws + WS_WBR); S.G = F.G; S.c = F.wg;
            EpiMerge E{(const GAS bf16*)(F.ws + WS_GATE), (GAS bf16*)(F.ws + WS_MRGP), (GAS bf16*)(F.ws + WS_FIN)};
            pg8::gemm_phase<EpiMerge, MergeOrder>(F.lds, F.tid, MIXW, S, E);
        } else if (PHON(9) && k == 9) {
            pg8::StaticOrder S; S.init(F.ws + WS_FIN, F.ws + WS_WOUT, T, D, D, F.G, F.wg);
            EpiOut E{(const GAS bf16*)(F.ws + WS_HB), DRY ? (GAS bf16*)(F.ws + WS_R2) : (GAS bf16*)F.out};
            pg8::gemm_phase<EpiOut, pg8::StaticOrder>(F.lds, F.tid, D, S, E);
        } else if (PHON(10) && k == 10) {
            ln_phase<1>(F, inp(F, I_LN_MIX_G) + l * D, inp(F, I_LN_MIX_B) + l * D, inp(F, I_ROUTER_W), 32, true, true, DRY);
        } else if (PHON(11) && k == 11) { moe_dispatch(F);
        } else if (PHON(12) && k == 12) {
            moe_tables(F);
            MoeOrder<D, true> S; S.rowtok = (const GAS int*)(F.ws + WS_ROWTOK); S.A = (const GAS char*)(F.ws + WS_HB); S.W = (const GAS char*)((GAS unsigned char*)F.out + 64 * MiB); S.pe = (const LAS int*)(F.lds + LPE_OFF); S.c = F.wg; S.NP = __builtin_amdgcn_readfirstlane(S.pe[319]);
            EpiMoe1 E{(GAS bf16*)(F.ws + WS_ACT)};
            pg8::gemm_phase<EpiMoe1, MoeOrder<D, true>>(F.lds, F.tid, D, S, E);
        } else if (PHON(13) && k == 13) {
            moe_tables(F);
            MoeOrder<DEXP, false> S; S.rowtok = nullptr; S.A = (const GAS char*)(F.ws + WS_ACT); S.W = (const GAS char*)(F.ws + WS_W2); S.pe = (const LAS int*)(F.lds + LPE_OFF); S.c = F.wg; S.NP = __builtin_amdgcn_readfirstlane(S.pe[319]);
            EpiMoe2 E{(GAS bf16*)(F.ws + WS_YROWS), (const GAS float*)(F.ws + WS_ROWW)};
            pg8::gemm_phase<EpiMoe2, MoeOrder<DEXP, false>>(F.lds, F.tid, DEXP, S, E);
        } else if (PHON(14)) {
            const bool last = (l == DEPTH - 1);
            if (!last) { wprep_mixer(F, l + 1); __syncthreads(); }
            ln_phase<2>(F, inp(F, I_LN_FFN_G) + l * D, inp(F, I_LN_FFN_B) + l * D, inp(F, I_W_IN) + (size_t)(last ? l : l + 1) * D * DIN, DIN, !last, !last, DRY);
        }
        const bool again = (k == REPEAT_PHASE) && (rep == 0);
        if (again) rep = 1; else { rep = 0; ++ph; }
        if (ph < hi) { XcdBarrier bar; bar.bar = (unsigned*)(unsigned char*)(F.ws + WS_CTL) + CW_BAR; bar.st = (volatile LAS unsigned*)(F.lds + MISC_OFF) + 8; bar.x = __builtin_amdgcn_readfirstlane(bar.st[2]); xcd_barrier(bar, F.tid); }
#ifdef DIAG
        if (!again && F.tid == 0 && F.wg == 0) ((unsigned long long*)(F.ws + WS_CTL + 1024))[ph] = __builtin_amdgcn_s_memrealtime();
#endif
    }
}

#ifndef N_LAUNCH_MODE
#define N_LAUNCH_MODE 1
#endif
extern "C" void kernel_launch(void* const* d_in, const int* in_sizes, int n_in, void* d_out, int out_size, void* d_ws, size_t ws_size, hipStream_t stream) {
    static int grid = 0;
    if (grid == 0) {
        if (n_in != 23 || out_size != T * D || ws_size < WS_END) { fprintf(stderr, "kernel_launch: unexpected shapes (n_in %d out %d ws %zu)\n", n_in, out_size, ws_size); grid = -1; return; }
        int dev = 0, cus = 0, per_cu = 0;
        if (hipGetDevice(&dev) != hipSuccess || hipDeviceGetAttribute(&cus, hipDeviceAttributeMultiprocessorCount, dev) != hipSuccess) { grid = -1; return; }
        if (hipFuncSetAttribute((const void*)mega_fwd, hipFuncAttributeMaxDynamicSharedMemorySize, LDS_BYTES) != hipSuccess) { fprintf(stderr, "kernel_launch: hipFuncSetAttribute failed\n"); grid = -1; return; }
        (void)hipOccupancyMaxActiveBlocksPerMultiprocessor(&per_cu, (const void*)mega_fwd, NWAVES * 64, LDS_BYTES);
        (void)hipGetLastError();
        grid = cus;
        if (grid != 256) { fprintf(stderr, "kernel_launch: built for 256 CUs, got %d\n", cus); grid = -1; return; }
    }
    if (grid < 0) return;
    (void)hipMemsetAsync((char*)d_ws + WS_CTL, 0, CTL_ZERO_BYTES, stream);
    Args a{};
    for (int i = 0; i < 23; ++i) a.in[i] = (const float*)d_in[i];
    a.out = (float*)d_out; a.ws = (unsigned char*)d_ws;
#if defined(DIAG) && DIAG >= 100
    {
        a.ph_lo = 0; a.ph_hi = NPHASE;
        hipLaunchKernelGGL(mega_fwd, dim3(grid), dim3(NWAVES * 64), LDS_BYTES, stream, a);
        hipLaunchKernelGGL(diag_fill_t, dim3(1024), dim3(256), 0, stream, (float*)d_out, (unsigned char*)d_ws, out_size, (int)(DIAG - 100));
    }
#elif defined(DIAG)
    {
        const int his[12] = {0, 2, 3, 6, 15, 10, 6, 9, 2, 2, 5, 9};
        const int grids[12] = {0, 64, 2, 2, 16, 64, 64, 64, 64, 64, 64, 64}, blocks[12] = {0, 256, 128, 128, 256, 256, 256, 256, 256, 256, 256, 256};
        a.ph_lo = 0; a.ph_hi = his[DIAG];
        hipLaunchKernelGGL(mega_fwd, dim3(grid), dim3(NWAVES * 64), LDS_BYTES, stream, a);
        static int once = 0; if (!once) { once = 1; (void)hipFuncSetAttribute((const void*)diag_kernel, hipFuncAttributeMaxDynamicSharedMemorySize, 81920); }
        DArgs da{}; for (int i = 0; i < 23; ++i) da.in[i] = (const float*)d_in[i]; da.out = (float*)d_out; da.ws = (unsigned char*)d_ws; da.mode = DIAG; da.pad = 0;
        hipLaunchKernelGGL(diag_kernel, dim3(grids[DIAG]), dim3(blocks[DIAG]), 81920, stream, da);
        if (DIAG == 2 || DIAG == 3) {
            a.ph_lo = his[DIAG]; a.ph_hi = his[DIAG] + 1;
            hipLaunchKernelGGL(mega_fwd, dim3(grid), dim3(NWAVES * 64), LDS_BYTES, stream, a);
            da.mode = DIAG + 10;
            hipLaunchKernelGGL(diag_kernel, dim3(2), dim3(128), 81920, stream, da);
        }
        hipLaunchKernelGGL(diag_fill, dim3(1024), dim3(256), 0, stream, (float*)d_out, (unsigned char*)d_ws, out_size);
    }
#elif N_LAUNCH_MODE == 1
    a.ph_lo = 0; a.ph_hi = NPHASE;
    hipLaunchKernelGGL(mega_fwd, dim3(grid), dim3(NWAVES * 64), LDS_BYTES, stream, a);
#else
    for (int p = 0; p < NPHASE; ++p) { a.ph_lo = p; a.ph_hi = p + 1; hipLaunchKernelGGL(mega_fwd, dim3(grid), dim3(NWAVES * 64), LDS_BYTES, stream, a); }
#endif
}
```

```cpp
#include <hip/hip_runtime.h>
#include <cstdio>
#include <cstdint>

#define LAS __attribute__((address_space(3)))
#define GAS __attribute__((address_space(1)))
typedef unsigned short bf16;
typedef short bf16x8 __attribute__((ext_vector_type(8)));
typedef float f32x4 __attribute__((ext_vector_type(4)));
typedef float f32x2 __attribute__((ext_vector_type(2)));
typedef unsigned u32x4 __attribute__((ext_vector_type(4)));
typedef unsigned u32x2 __attribute__((ext_vector_type(2)));
#define RLX_AGENT __ATOMIC_RELAXED, __HIP_MEMORY_SCOPE_AGENT
#define LDS_WAIT() asm volatile("s_waitcnt lgkmcnt(0)" ::: "memory")
#define VM_WAIT() asm volatile("s_waitcnt vmcnt(0)" ::: "memory")

constexpr int NB = 4, SEQ = 8192, T = NB * SEQ, D = 1024, DEPTH = 2;
constexpr int DIN = 7200;
constexpr int MIXW = 512, NHEAD = 4, HD = 128, CH = 64, NCH = SEQ / CH;
constexpr int MLQK = 64;
constexpr int NEXP = 32, DEXP = 512;
constexpr float LN_EPS = 1e-5f, NORM_EPS = 1e-6f;
constexpr float ALPHA = 1.41421356237309515f;
constexpr int NWAVES = 8;
constexpr int NREC = NB * NHEAD * NCH * 2;

constexpr int C_QKV = 0, C_Z = 1536, C_A = 2048, C_B = 2056, C_POOL = 2064, C_MQ = 2576, C_MK = 2832, C_MV = 3088, C_MO = 3600, C_I = 4112, C_F = 4120, C_GATE = 4128;

constexpr size_t MiB = 1u << 20;
constexpr size_t WS_CTL = 0, CTL_ZERO_BYTES = 64 * 1024;
constexpr int CW_BAR = 4096;
constexpr size_t WS_HIST = 1 * MiB;
constexpr size_t WS_EID = WS_HIST + 64 * 1024;
constexpr size_t WS_EW = WS_EID + 256 * 1024;
constexpr size_t WS_POS = WS_EW + 256 * 1024;
constexpr size_t WS_ROWW = WS_POS + 256 * 1024;
constexpr size_t WS_GL = WS_ROWW + 512 * 1024;
constexpr size_t WS_ROWTOK = 3 * MiB;
constexpr size_t WS_WIN = 4 * MiB;
constexpr size_t WS_WGATE = 12 * MiB;
constexpr size_t WS_WBR = 18 * MiB;
constexpr size_t WS_WOUT = 21 * MiB;
constexpr size_t WS_HB = 24 * MiB;
constexpr size_t WS_SG = 88 * MiB;
constexpr size_t WS_DEN = 92 * MiB;
constexpr size_t WS_R1 = 93 * MiB;
constexpr size_t WS_PQKV = WS_R1;
constexpr size_t WS_OF = WS_R1, WS_OB = WS_R1 + 32 * MiB;
constexpr size_t WS_MRGP = WS_R1;
constexpr size_t WS_W13 = WS_R1, WS_W2 = WS_R1 + 64 * MiB;
constexpr size_t WS_R2 = 189 * MiB;
constexpr size_t DNREC = 73728;
constexpr size_t DN_W = 0, DN_QG = 16384, DN_KDT = 32768, DN_ATT = 49152, DN_UF = 57344;
constexpr size_t WS_PZ = 189 * MiB, WS_PPOOL = 221 * MiB, WS_PMQ = 253 * MiB, WS_PMK = 269 * MiB, WS_PMV = 285 * MiB, WS_PMO = 317 * MiB;
constexpr size_t WS_YP = 349 * MiB;
constexpr size_t WS_NUMF = 253 * MiB, WS_NUMB = 285 * MiB;
constexpr size_t WS_FIN = 253 * MiB;
constexpr size_t WS_ML = 381 * MiB;
constexpr size_t MLREC = 44032;
constexpr size_t ML_Q = 0, ML_ST = 8192, ML_KWT = 16384, ML_VF = 24576, ML_ROW = 43008;
constexpr size_t WS_GATE = 381 * MiB;
constexpr size_t WS_XS = 189 * MiB, WS_ACT = 333 * MiB, WS_YROWS = 405 * MiB;
constexpr size_t WS_END = 573 * MiB;
constexpr int MOE_ROWS = 73728;
static_assert(WS_ML + (size_t)NREC * MLREC <= WS_END + 15 * MiB, "ml records");
static_assert(WS_YROWS + (size_t)MOE_ROWS * 1024 * 2 <= WS_END, "moe rows");

constexpr int RING_BYTES = 131072;
constexpr int MISC_OFF = RING_BYTES + 320;
constexpr int LHIST_OFF = RING_BYTES + 1024;
constexpr int LPE_OFF = RING_BYTES + 2048;
constexpr int LARG_OFF = RING_BYTES + 4096;
constexpr int LDS_BYTES = 147456;

__device__ __forceinline__ float bf2f(unsigned b) { return __uint_as_float(b << 16); }
__device__ __forceinline__ unsigned f2bf(float f) { unsigned u = __float_as_uint(f); return (u + 0x7fffu + ((u >> 16) & 1u)) >> 16; }
__device__ __forceinline__ unsigned pk2(float lo, float hi) { return f2bf(lo) | (f2bf(hi) << 16); }
__device__ __forceinline__ float wave_sum(float v) {
    v += __int_as_float(__builtin_amdgcn_update_dpp(0, __float_as_int(v), 0xB1, 0xf, 0xf, true));
    v += __int_as_float(__builtin_amdgcn_update_dpp(0, __float_as_int(v), 0x4E, 0xf, 0xf, true));
    v += __int_as_float(__builtin_amdgcn_update_dpp(0, __float_as_int(v), 0x141, 0xf, 0xf, true));
    v += __int_as_float(__builtin_amdgcn_update_dpp(0, __float_as_int(v), 0x140, 0xf, 0xf, true));
    const int iv = __float_as_int(v);
    return (__int_as_float(__builtin_amdgcn_readlane(iv, 0)) + __int_as_float(__builtin_amdgcn_readlane(iv, 16))) + (__int_as_float(__builtin_amdgcn_readlane(iv, 32)) + __int_as_float(__builtin_amdgcn_readlane(iv, 48)));
}
__device__ __forceinline__ float wave_max(float v) {
    v = fmaxf(v, __int_as_float(__builtin_amdgcn_update_dpp(0, __float_as_int(v), 0xB1, 0xf, 0xf, true)));
    v = fmaxf(v, __int_as_float(__builtin_amdgcn_update_dpp(0, __float_as_int(v), 0x4E, 0xf, 0xf, true)));
    v = fmaxf(v, __int_as_float(__builtin_amdgcn_update_dpp(0, __float_as_int(v), 0x141, 0xf, 0xf, true)));
    v = fmaxf(v, __int_as_float(__builtin_amdgcn_update_dpp(0, __float_as_int(v), 0x140, 0xf, 0xf, true)));
    const int iv = __float_as_int(v);
    return fmaxf(fmaxf(__int_as_float(__builtin_amdgcn_readlane(iv, 0)), __int_as_float(__builtin_amdgcn_readlane(iv, 16))), fmaxf(__int_as_float(__builtin_amdgcn_readlane(iv, 32)), __int_as_float(__builtin_amdgcn_readlane(iv, 48))));
}
__device__ __forceinline__ float fexp(float x) { return __builtin_amdgcn_exp2f(x * 1.44269504089f); }
__device__ __forceinline__ float sigmoidf_(float x) { return 1.0f / (1.0f + expf(-x)); }
__device__ __forceinline__ float siluf_(float x) { return x / (1.0f + expf(-x)); }
__device__ __forceinline__ float softplusf_(float x) { return fmaxf(x, 0.f) + log1pf(expf(-fabsf(x))); }
__device__ __forceinline__ float logsigmoidf_(float x) { return fminf(x, 0.f) - log1pf(expf(-fabsf(x))); }
__host__ __device__ __forceinline__ int sigma32(int p) { const int fq = p >> 3, j = p & 7; return 16 * (j >> 2) + 4 * fq + (j & 3); }

#define XB_TMO      128
#define XB_XCNT(j)  (256  + 64 * (j))
#define XB_XSUB(j)  (1280 + 64 * (j))
#define XB_XGEN(j)  (2304 + 64 * (j))
#define XB_TOP      3328
#define XB_TOPGEN   3392
#define XCD_BAR_WORDS 3456
#define XB_SPIN_CAP (1u << 20)
__device__ __forceinline__ unsigned xb_ld(unsigned* p)              { return __hip_atomic_load(p, __ATOMIC_RELAXED, __HIP_MEMORY_SCOPE_AGENT); }
__device__ __forceinline__ unsigned xb_add(unsigned* p, unsigned v) { return __hip_atomic_fetch_add(p, v, __ATOMIC_RELAXED, __HIP_MEMORY_SCOPE_AGENT); }
__device__ __forceinline__ unsigned xb_xcc_id() { return (unsigned)__builtin_amdgcn_s_getreg((3 << 11) | 20) & 0xFu; }
#define XB_SPIN(cond, bar) do { unsigned _sp = 0; while (cond) { __builtin_amdgcn_s_sleep(1); \
    if ((++_sp & 255u) == 0u) { if (xb_ld(&(bar)[XB_TMO])) break; if (_sp > XB_SPIN_CAP) { atomicAdd(&(bar)[XB_TMO], 1u); break; } } } } while (0)
struct XcdBarrier { unsigned* bar; unsigned x; volatile LAS unsigned* st; };
__device__ __forceinline__ XcdBarrier xcd_barrier_post(unsigned* bar, volatile LAS unsigned* st) {
    XcdBarrier b; b.bar = bar; b.x = xb_xcc_id(); b.st = st;
    if (threadIdx.x == 0) (void)xb_add(&bar[XB_XCNT(b.x)], 1u);
    return b;
}
__device__ __forceinline__ void xcd_barrier_complete(unsigned* bar, unsigned x, unsigned& nloc, unsigned& nx) {
    const unsigned G = 256u;
    unsigned sum, cnt, mine, sp = 0u;
    for (;;) {
        sum = 0u; cnt = 0u; mine = 0u;
#pragma unroll
        for (unsigned j = 0; j < 16; ++j) { const unsigned c = xb_ld(&bar[XB_XCNT(j)]); sum += c; cnt += (c > 0u) ? 1u : 0u; mine = (j == x) ? c : mine; }
        if (sum == G) break;
        __builtin_amdgcn_s_sleep(1);
        if ((++sp & 255u) == 0u) { if (xb_ld(&bar[XB_TMO])) break; if (sp > XB_SPIN_CAP) { atomicAdd(&bar[XB_TMO], 1u); break; } }
    }
    nloc = mine > 0u ? mine : 1u; nx = cnt > 0u ? cnt : 1u;
}
__device__ __forceinline__ void xcd_barrier(const XcdBarrier& b, const int tid) {
    asm volatile("s_waitcnt vmcnt(0)" ::: "memory");
    __syncthreads();
    if (tid == 0) {
        unsigned* bar = b.bar;
        __builtin_amdgcn_s_waitcnt(0);
        unsigned nloc = b.st[0], nx = b.st[1];
        if (nloc == 0u) { xcd_barrier_complete(bar, b.x, nloc, nx); b.st[0] = nloc; b.st[1] = nx; }
        const unsigned old = xb_add(&bar[XB_XSUB(b.x)], 1u);
        const unsigned gen = old / nloc;
        if (old + 1u == (gen + 1u) * nloc) {
            __builtin_amdgcn_fence(__ATOMIC_RELEASE, "agent");
            asm volatile("s_waitcnt vmcnt(0)" ::: "memory");
            const unsigned og = xb_add(&bar[XB_TOP], 1u);
            const unsigned tg = og / nx;
            if (og + 1u == (tg + 1u) * nx) xb_add(&bar[XB_TOPGEN], 1u);
            else XB_SPIN(xb_ld(&bar[XB_TOPGEN]) == tg, bar);
            __builtin_amdgcn_fence(__ATOMIC_ACQUIRE, "agent");
            xb_add(&bar[XB_XGEN(b.x)], 1u);
            asm volatile("s_waitcnt vmcnt(0)" ::: "memory");
        } else {
            XB_SPIN(xb_ld(&bar[XB_XGEN(b.x)]) == gen, bar);
            __builtin_amdgcn_fence(__ATOMIC_ACQUIRE, "agent");
            asm volatile("s_waitcnt vmcnt(0)" ::: "memory");
        }
    }
    __syncthreads();
}

namespace pg8 {
constexpr int BM = 256, BK = 64, HALF = 128, HTB = HALF * BK * 2, STAGE_BYTES = 8 * HTB, NXCD = 8, WGM = 8;
__host__ __device__ __forceinline__ int lds_byte(int r, int c) { const int st = (r >> 4) * 2 + (c >> 5), rr = r & 15, cc = c & 31, ob = rr * 64 + cc * 2; return st * 1024 + (ob ^ (((ob >> 9) & 1) << 5)); }
__host__ __device__ __forceinline__ void stage_rc(int b, int& R, int& C) { const int st = b / 1024, sb = b % 1024, swz = sb ^ (((sb >> 9) & 1) << 5); R = (st >> 1) * 16 + swz / 64; C = (st & 1) * 32 + (swz % 64) / 2; }
__host__ __device__ __forceinline__ int perm32(int rho) { const int n = rho >> 4, i = rho & 15; return 8 * (i >> 2) + 4 * n + (i & 3); }

struct Unit { int pm, pn, aux; const GAS char* A; const GAS char* B; };

__device__ __forceinline__ void tile_of(int L, int nM, int nN, int& pm, int& pn) {
    const int nwg = nM * nN; int wgid = L;
    { const int q = nwg / NXCD, r = nwg % NXCD, xcd = wgid % NXCD, off = wgid / NXCD; wgid = (xcd < r ? xcd * (q + 1) : r * (q + 1) + (xcd - r) * q) + off; }
    const int nig = WGM * nN, gid = wgid / nig, fm = gid * WGM, gsz = (nM - fm) < WGM ? (nM - fm) : WGM;
    pm = fm + ((wgid % nig) % gsz); pn = (wgid % nig) / gsz;
}
struct StaticOrder {
    static constexpr bool GATHER = false;
    const GAS char* A; const GAS char* Bt; int nM, nN, nwg, G, c; size_t tstep;
    __device__ __forceinline__ void init(const GAS void* A_, const GAS void* Bt_, int M, int N, int K, int G_, int c_) { A = (const GAS char*)A_; Bt = (const GAS char*)Bt_; nM = M / BM; nN = N / BM; nwg = nM * nN; G = G_; c = c_; tstep = (size_t)BM * K * 2; }
    __device__ __forceinline__ bool next(int i, Unit& u) const {
        const long L = (long)i * G + c; if (L >= nwg) return false;
        tile_of((int)L, nM, nN, u.pm, u.pn); u.aux = 0; u.A = A + (size_t)u.pm * tstep; u.B = Bt + (size_t)u.pn * tstep; return true;
    }
};

typedef float f32x2_t __attribute__((ext_vector_type(2))); typedef __bf16 bf16x2_t __attribute__((ext_vector_type(2)));
__device__ __forceinline__ unsigned cvt_pk_bf16(float lo, float hi) { f32x2_t v = {lo, hi}; bf16x2_t b = __builtin_convertvector(v, bf16x2_t); return __builtin_bit_cast(unsigned, b); }

template <class Epi, class Sched, bool ALIGN_EPI = true, bool SP2 = true>
__device__ __forceinline__ void gemm_phase(LAS unsigned char* lds, const int tid, const int K, const Sched& S, const Epi& E) {
    const int wid = __builtin_amdgcn_readfirstlane(tid >> 6), lane = tid & 63, wr = wid >> 2, wc = wid & 3, fr = lane & 15, fq = lane >> 4;
    const int nt = K / BK;
    unsigned voffA, voffB;
    { int R, C; stage_rc(tid * 16, R, C); const int Rb = Epi::PERM ? ((R & ~31) + perm32(R & 31)) : R;
        voffA = (unsigned)(R * K + C) * 2u; voffB = (unsigned)(Rb * K + C) * 2u; }
    const size_t pstep = (size_t)64 * K * 2;
    const size_t kstep = (size_t)(BK * 2);
    const size_t hstep = (size_t)HALF * K * 2;
    const unsigned ldsw = (unsigned)wid * 1024u;
    const int aoff = lds_byte(wr * 64 + fr, fq * 8), boff = lds_byte(wc * 32 + fr, fq * 8);
#define PG8_SA(b, h) (((b) * 2 + (h)) * HTB)
#define PG8_SB(b, h) ((4 + (b) * 2 + (h)) * HTB)
#define PG8_STAGE(bufoff, gbase, voff) do { _Pragma("unroll") for (int _i = 0; _i < 2; ++_i) \
        __builtin_amdgcn_global_load_lds((const GAS unsigned*)((const GAS char*)(gbase) + _i * pstep + (voff)), (LAS unsigned*)(lds + (bufoff) + ldsw + _i * 8192), 16, 0, 0); } while (0)
#define PG8_STAGE_A(bufoff, kbase, h_, useNext) do { if constexpr (GATHER) { _Pragma("unroll") for (int _i = 0; _i < 2; ++_i) { const unsigned _o = (useNext) ? gaN[h_][_i] : gaC[h_][_i]; \
        __builtin_amdgcn_global_load_lds((const GAS unsigned*)((const GAS char*)(kbase) + _o), (LAS unsigned*)(lds + (bufoff) + ldsw + _i * 8192), 16, 0, 0); } } \
        else { PG8_STAGE(bufoff, (kbase) + (h_) * hstep, voffA); } } while (0)
#define PG8_LDA(dst, b, h) do { _Pragma("unroll") for (int m = 0; m < 4; ++m) _Pragma("unroll") for (int k = 0; k < 2; ++k) dst[m][k] = *(const LAS bf16x8*)(lds + PG8_SA(b, h) + aoff + m * 2048 + k * 1024); } while (0)
#define PG8_LDB(dst, b, h) do { _Pragma("unroll") for (int n = 0; n < 2; ++n) _Pragma("unroll") for (int k = 0; k < 2; ++k) dst[n][k] = *(const LAS bf16x8*)(lds + PG8_SB(b, h) + boff + n * 2048 + k * 1024); } while (0)
#define PG8_MMA(ai, bj, At, Bt) do { __builtin_amdgcn_s_setprio(1); _Pragma("unroll") for (int m = 0; m < 4; ++m) _Pragma("unroll") for (int n = 0; n < 2; ++n) _Pragma("unroll") for (int k = 0; k < 2; ++k) \
        acc[ai][bj][m][n] = __builtin_amdgcn_mfma_f32_16x16x32_bf16(Bt[n][k], At[m][k], acc[ai][bj][m][n], 0, 0, 0); __builtin_amdgcn_s_setprio(0); } while (0)
#define PG8_WAIT_V(n) asm volatile("s_waitcnt vmcnt(" #n ")" ::: "memory")
#define PG8_WAIT_L(n) asm volatile("s_waitcnt lgkmcnt(" #n ")" ::: "memory")
#define PG8_BAR __builtin_amdgcn_s_barrier()
#define PG8_SCHED __builtin_amdgcn_sched_barrier(0)
    Unit cur, nxt; int ui = 0;
    if (!S.next(0, cur)) return;
    constexpr bool GATHER = Sched::GATHER;
    unsigned gaC[2][2], gaN[2][2];
    int gR = 0, gC = 0; if constexpr (GATHER) { stage_rc(tid * 16, gR, gC); }
#define PG8_GATHER_OFFS(dst, u_) do { if constexpr (GATHER) { _Pragma("unroll") for (int h_ = 0; h_ < 2; ++h_) _Pragma("unroll") for (int i_ = 0; i_ < 2; ++i_) \
        dst[h_][i_] = (unsigned)S.rowtok[(u_).pm * 256 + 128 * h_ + 64 * i_ + gR] * (unsigned)(K * 2) + (unsigned)(gC * 2); } } while (0)
    PG8_GATHER_OFFS(gaC, cur);
#pragma unroll
    for (int h_ = 0; h_ < 2; ++h_)
#pragma unroll
        for (int i_ = 0; i_ < 2; ++i_) gaN[h_][i_] = gaC[h_][i_];
    f32x4 acc[2][2][4][2];
#pragma unroll
    for (int a = 0; a < 2; ++a)
#pragma unroll
        for (int b = 0; b < 2; ++b)
#pragma unroll
            for (int m = 0; m < 4; ++m)
#pragma unroll
                for (int n = 0; n < 2; ++n) acc[a][b][m][n] = (f32x4){0.f, 0.f, 0.f, 0.f};
    bf16x8 At[4][2], B0[2][2], B1[2][2];
    const GAS char* cA = cur.A; const GAS char* cB = cur.B;
    if constexpr (SP2) {
        PG8_STAGE(PG8_SB(0, 0), cB, voffB); PG8_STAGE(PG8_SB(0, 1), cB + hstep, voffB); PG8_STAGE_A(PG8_SA(0, 0), cA, 0, false); PG8_STAGE_A(PG8_SA(0, 1), cA, 1, false);
        if (wr == 1) PG8_BAR;
        PG8_WAIT_V(2); PG8_BAR;
        PG8_STAGE(PG8_SB(1, 0), cB + kstep, voffB); PG8_STAGE_A(PG8_SA(1, 0), cA + kstep, 0, false); PG8_STAGE(PG8_SB(1, 1), cB + hstep + kstep, voffB);
        PG8_WAIT_V(6); PG8_BAR;
    } else {
        PG8_STAGE(PG8_SB(0, 0), cB, voffB); PG8_STAGE(PG8_SA(0, 0), cA, voffA); PG8_STAGE(PG8_SB(0, 1), cB + hstep, voffB); PG8_STAGE(PG8_SA(0, 1), cA + hstep, voffA);
        if (wr == 1) PG8_BAR;
        PG8_WAIT_V(4); PG8_BAR;
        PG8_STAGE(PG8_SB(1, 0), cB + kstep, voffB); PG8_STAGE(PG8_SA(1, 0), cA + kstep, voffA); PG8_STAGE(PG8_SB(1, 1), cB + hstep + kstep, voffB);
        PG8_WAIT_V(6); PG8_BAR;
    }
    for (;;) {
        const bool has_next = S.next(ui + 1, nxt);
        if (has_next) PG8_GATHER_OFFS(gaN, nxt);
        const GAS char* nA = has_next ? nxt.A : cA; const GAS char* nB = has_next ? nxt.B : cB;
        for (int t = 0; t < nt; t += 2) {
            const bool last = (t == nt - 2);
            const GAS char* a1 = cA + (size_t)(t + 1) * kstep;
            const GAS char* a2 = last ? nA : cA + (size_t)(t + 2) * kstep; const GAS char* b2 = last ? nB : cB + (size_t)(t + 2) * kstep;
            const GAS char* a3 = a2 + kstep; const GAS char* b3 = b2 + kstep;
            if constexpr (SP2) {
            PG8_LDB(B0, 0, 0); PG8_LDB(B1, 0, 1); PG8_SCHED; PG8_LDA(At, 0, 0); PG8_STAGE_A(PG8_SA(1, 1), a1, 1, false);
            PG8_WAIT_V(8); PG8_WAIT_L(0); PG8_BAR; PG8_MMA(0, 0, At, B0); PG8_MMA(0, 1, At, B1); PG8_BAR; PG8_SCHED;
            PG8_LDA(At, 0, 1); PG8_STAGE(PG8_SB(0, 0), b2, voffB); PG8_STAGE(PG8_SB(0, 1), b2 + hstep, voffB); PG8_STAGE_A(PG8_SA(0, 0), a2, 0, last && has_next);
            PG8_WAIT_V(8); PG8_WAIT_L(0); PG8_BAR; PG8_MMA(1, 0, At, B0); PG8_MMA(1, 1, At, B1); PG8_BAR; PG8_SCHED;
            PG8_LDB(B0, 1, 0); PG8_LDB(B1, 1, 1); PG8_SCHED; PG8_LDA(At, 1, 0); PG8_STAGE_A(PG8_SA(0, 1), a2, 1, last && has_next);
            PG8_WAIT_V(8); PG8_WAIT_L(0); PG8_BAR; PG8_MMA(0, 0, At, B0); PG8_MMA(0, 1, At, B1); PG8_BAR; PG8_SCHED;
            PG8_LDA(At, 1, 1); PG8_STAGE(PG8_SB(1, 0), b3, voffB); PG8_STAGE(PG8_SB(1, 1), b3 + hstep, voffB); PG8_STAGE_A(PG8_SA(1, 0), a3, 0, last && has_next);
            PG8_WAIT_V(8); PG8_WAIT_L(0); PG8_BAR; PG8_MMA(1, 0, At, B0); PG8_MMA(1, 1, At, B1); PG8_BAR; PG8_SCHED;
            } else {
            PG8_LDB(B0, 0, 0); PG8_SCHED; PG8_LDA(At, 0, 0); PG8_STAGE(PG8_SA(1, 1), a1 + hstep, voffA);
            PG8_WAIT_L(8); PG8_BAR; PG8_WAIT_L(0); PG8_MMA(0, 0, At, B0); PG8_BAR; PG8_SCHED;
            PG8_LDB(B1, 0, 1); PG8_STAGE(PG8_SB(0, 0), b2, voffB);
            PG8_BAR; PG8_WAIT_L(0); PG8_MMA(0, 1, At, B1); PG8_BAR;
            PG8_LDA(At, 0, 1); PG8_STAGE(PG8_SA(0, 0), a2, voffA);
            PG8_BAR; PG8_WAIT_L(0); PG8_MMA(1, 0, At, B0); PG8_BAR; PG8_SCHED;
            PG8_STAGE(PG8_SB(0, 1), b2 + hstep, voffB);
            PG8_WAIT_V(6); PG8_BAR; PG8_MMA(1, 1, At, B1); PG8_BAR;
            PG8_LDB(B0, 1, 0); PG8_SCHED; PG8_LDA(At, 1, 0); PG8_STAGE(PG8_SA(0, 1), a2 + hstep, voffA);
            PG8_WAIT_L(8); PG8_BAR; PG8_WAIT_L(0); PG8_MMA(0, 0, At, B0); PG8_BAR; PG8_SCHED;
            PG8_LDB(B1, 1, 1); PG8_STAGE(PG8_SB(1, 0), b3, voffB);
            PG8_BAR; PG8_WAIT_L(0); PG8_MMA(0, 1, At, B1); PG8_BAR;
            PG8_LDA(At, 1, 1); PG8_STAGE(PG8_SA(1, 0), a3, voffA);
            PG8_BAR; PG8_WAIT_L(0); PG8_MMA(1, 0, At, B0); PG8_BAR; PG8_SCHED;
            PG8_STAGE(PG8_SB(1, 1), b3 + hstep, voffB);
            PG8_WAIT_V(6); PG8_BAR; PG8_MMA(1, 1, At, B1); PG8_BAR;
            }
        }
        if constexpr (ALIGN_EPI) { if (wr == 0) PG8_BAR; }
        E(acc, cur, wr, wc, fr, fq);
        if (!has_next) break;
#pragma unroll
        for (int a = 0; a < 2; ++a)
#pragma unroll
            for (int b = 0; b < 2; ++b)
#pragma unroll
                for (int m = 0; m < 4; ++m)
#pragma unroll
                    for (int n = 0; n < 2; ++n) acc[a][b][m][n] = (f32x4){0.f, 0.f, 0.f, 0.f};
        cur = nxt; cA = nA; cB = nB; ++ui;
#pragma unroll
        for (int h_ = 0; h_ < 2; ++h_)
#pragma unroll
            for (int i_ = 0; i_ < 2; ++i_) gaC[h_][i_] = gaN[h_][i_];
        if constexpr (ALIGN_EPI) { if (wr == 1) PG8_BAR; }
    }
    PG8_WAIT_V(0);
    if constexpr (!ALIGN_EPI) { if (wr == 0) PG8_BAR; }
    PG8_BAR;
#undef PG8_SA
#undef PG8_SB
#undef PG8_STAGE
#undef PG8_LDA
#undef PG8_STAGE_A
#undef PG8_GATHER_OFFS
#undef PG8_LDB
#undef PG8_MMA
#undef PG8_WAIT_V
#undef PG8_WAIT_L
#undef PG8_BAR
#undef PG8_SCHED
}
}

using pg8::Unit; using pg8::cvt_pk_bf16; using pg8::HALF; using pg8::BM;

struct EpiG1a {
    static constexpr bool PERM = true;
    GAS bf16* O;
    __device__ __forceinline__ void operator()(const f32x4 (&acc)[2][2][4][2], const Unit& u, int wr, int wc, int fr, int fq) const {
        const int row0 = u.pm * BM + wr * 64 + fr, col0 = u.pn * BM + wc * 32 + 8 * fq;
#pragma unroll
        for (int ai = 0; ai < 2; ++ai)
#pragma unroll
            for (int m = 0; m < 4; ++m) { GAS bf16* rowp = O + (size_t)(row0 + ai * HALF + m * 16) * 1536 + col0;
#pragma unroll
                for (int bj = 0; bj < 2; ++bj) { const f32x4 v0 = acc[ai][bj][m][0], v1 = acc[ai][bj][m][1];
                    u32x4 w; w.x = cvt_pk_bf16(v0[0], v0[1]); w.y = cvt_pk_bf16(v0[2], v0[3]); w.z = cvt_pk_bf16(v1[0], v1[1]); w.w = cvt_pk_bf16(v1[2], v1[3]);
                    *(GAS u32x4*)(rowp + bj * HALF) = w; } }
    }
};
struct EpiG1b {
    static constexpr bool PERM = true;
    GAS unsigned char* ws;
    __device__ __forceinline__ void operator()(const f32x4 (&acc)[2][2][4][2], const Unit& u, int wr, int wc, int fr, int fq) const {
        const int pn = u.pn; size_t off; int ld, ct;
        if (pn < 2) { off = WS_PZ; ld = 512; ct = pn; } else if (pn < 4) { off = WS_PPOOL; ld = 512; ct = pn - 2; } else if (pn == 4) { off = WS_PMQ; ld = 256; ct = 0; }
        else if (pn == 5) { off = WS_PMK; ld = 256; ct = 0; } else if (pn < 8) { off = WS_PMV; ld = 512; ct = pn - 6; } else { off = WS_PMO; ld = 512; ct = pn - 8; }
        GAS bf16* O = (GAS bf16*)(ws + off);
        const int row0 = u.pm * BM + wr * 64 + fr, col0 = ct * BM + wc * 32 + 8 * fq;
#pragma unroll
        for (int ai = 0; ai < 2; ++ai)
#pragma unroll
            for (int m = 0; m < 4; ++m) { GAS bf16* rowp = O + (size_t)(row0 + ai * HALF + m * 16) * ld + col0;
#pragma unroll
                for (int bj = 0; bj < 2; ++bj) { const f32x4 v0 = acc[ai][bj][m][0], v1 = acc[ai][bj][m][1];
                    u32x4 w; w.x = cvt_pk_bf16(v0[0], v0[1]); w.y = cvt_pk_bf16(v0[2], v0[3]); w.z = cvt_pk_bf16(v1[0], v1[1]); w.w = cvt_pk_bf16(v1[2], v1[3]);
                    *(GAS u32x4*)(rowp + bj * HALF) = w; } }
    }
};
__device__ __forceinline__ float fast_sigmoid(float x) { return __builtin_amdgcn_rcpf(1.0f + __builtin_amdgcn_exp2f(-1.44269504089f * x)); }
struct EpiGate {
    static constexpr bool PERM = true;
    GAS bf16* O;
    __device__ __forceinline__ void operator()(const f32x4 (&acc)[2][2][4][2], const Unit& u, int wr, int wc, int fr, int fq) const {
        const int row0 = u.pm * BM + wr * 64 + fr, col0 = u.pn * BM + wc * 32 + 8 * fq;
#pragma unroll
        for (int ai = 0; ai < 2; ++ai)
#pragma unroll
            for (int m = 0; m < 4; ++m) { GAS bf16* rowp = O + (size_t)(row0 + ai * HALF + m * 16) * 3072 + col0;
#pragma unroll
                for (int bj = 0; bj < 2; ++bj) { f32x4 v0 = acc[ai][bj][m][0], v1 = acc[ai][bj][m][1];
#pragma unroll
                    for (int j = 0; j < 4; ++j) { v0[j] = fast_sigmoid(v0[j]); v1[j] = fast_sigmoid(v1[j]); }
                    u32x4 w; w.x = cvt_pk_bf16(v0[0], v0[1]); w.y = cvt_pk_bf16(v0[2], v0[3]); w.z = cvt_pk_bf16(v1[0], v1[1]); w.w = cvt_pk_bf16(v1[2], v1[3]);
                    *(GAS u32x4*)(rowp + bj * HALF) = w; } }
    }
};
__device__ __forceinline__ void unpack8(const u32x4 w, float (&f)[8]) {
    f[0] = __uint_as_float(w.x << 16); f[1] = __uint_as_float(w.x & 0xffff0000u); f[2] = __uint_as_float(w.y << 16); f[3] = __uint_as_float(w.y & 0xffff0000u);
    f[4] = __uint_as_float(w.z << 16); f[5] = __uint_as_float(w.z & 0xffff0000u); f[6] = __uint_as_float(w.w << 16); f[7] = __uint_as_float(w.w & 0xffff0000u);
}
struct EpiMerge {
    static constexpr bool PERM = true;
    const GAS bf16* GATE; GAS bf16* PART; GAS bf16* FIN;
    __device__ __forceinline__ void operator()(const f32x4 (&acc)[2][2][4][2], const Unit& u, int wr, int wc, int fr, int fq) const {
        const int r = u.aux;
        const int row0 = u.pm * BM + wr * 64 + fr, col0 = u.pn * BM + wc * 32 + 8 * fq;
        GAS bf16* dst = (r == 2) ? FIN : PART;
#pragma unroll
        for (int ai = 0; ai < 2; ++ai) {
            u32x4 gw[4][2], pw[4][2];
#pragma unroll
            for (int m = 0; m < 4; ++m)
#pragma unroll
                for (int bj = 0; bj < 2; ++bj) { const size_t row = (size_t)(row0 + ai * HALF + m * 16); const int c = col0 + bj * HALF;
                    gw[m][bj] = *(const GAS u32x4*)(GATE + row * 3072 + r * 1024 + c);
                    if (r > 0) pw[m][bj] = *(const GAS u32x4*)(PART + row * 1024 + c); }
#pragma unroll
            for (int m = 0; m < 4; ++m)
#pragma unroll
                for (int bj = 0; bj < 2; ++bj) { const size_t row = (size_t)(row0 + ai * HALF + m * 16); const int c = col0 + bj * HALF;
                    const f32x4 v0 = acc[ai][bj][m][0], v1 = acc[ai][bj][m][1];
                    float g[8]; unpack8(gw[m][bj], g);
                    float o[8];
                    o[0] = v0[0] * g[0]; o[1] = v0[1] * g[1]; o[2] = v0[2] * g[2]; o[3] = v0[3] * g[3];
                    o[4] = v1[0] * g[4]; o[5] = v1[1] * g[5]; o[6] = v1[2] * g[6]; o[7] = v1[3] * g[7];
                    if (r > 0) { float p[8]; unpack8(pw[m][bj], p);
#pragma unroll
                        for (int j = 0; j < 8; ++j) o[j] += p[j]; }
                    u32x4 w; w.x = cvt_pk_bf16(o[0], o[1]); w.y = cvt_pk_bf16(o[2], o[3]); w.z = cvt_pk_bf16(o[4], o[5]); w.w = cvt_pk_bf16(o[6], o[7]);
                    *(GAS u32x4*)(dst + row * 1024 + c) = w; }
        }
    }
};
struct EpiOut {
    static constexpr bool PERM = false;
    const GAS bf16* H; GAS bf16* PRE;
    __device__ __forceinline__ void operator()(const f32x4 (&acc)[2][2][4][2], const Unit& u, int wr, int wc, int fr, int fq) const {
        const int row0 = u.pm * BM + wr * 64 + fr, col0 = u.pn * BM + wc * 32 + 4 * fq;
#pragma unroll
        for (int ai = 0; ai < 2; ++ai) {
            u32x2 hv[4][2][2];
#pragma unroll
            for (int m = 0; m < 4; ++m)
#pragma unroll
                for (int bj = 0; bj < 2; ++bj)
#pragma unroll
                    for (int n = 0; n < 2; ++n) hv[m][bj][n] = *(const GAS u32x2*)(H + (size_t)(row0 + ai * HALF + m * 16) * D + col0 + bj * HALF + n * 16);
#pragma unroll
            for (int m = 0; m < 4; ++m)
#pragma unroll
                for (int bj = 0; bj < 2; ++bj)
#pragma unroll
                    for (int n = 0; n < 2; ++n) { const size_t o = (size_t)(row0 + ai * HALF + m * 16) * D + col0 + bj * HALF + n * 16; const u32x2 h2 = hv[m][bj][n]; const f32x4 a = acc[ai][bj][m][n];
                        u32x2 w; w.x = cvt_pk_bf16(ALPHA * bf2f(h2.x & 0xffffu) + a[0], ALPHA * bf2f(h2.x >> 16) + a[1]); w.y = cvt_pk_bf16(ALPHA * bf2f(h2.y & 0xffffu) + a[2], ALPHA * bf2f(h2.y >> 16) + a[3]);
                        *(GAS u32x2*)(PRE + o) = w; }
        }
    }
};
struct EpiMoe1 {
    static constexpr bool PERM = true;
    GAS bf16* ACT;
    __device__ __forceinline__ void operator()(const f32x4 (&acc)[2][2][4][2], const Unit& u, int wr, int wc, int fr, int fq) const {
        const int row0 = u.pm * BM + wr * 64 + fr, col0 = u.pn * 128 + wc * 32 + 8 * fq;
#pragma unroll
        for (int ai = 0; ai < 2; ++ai)
#pragma unroll
            for (int m = 0; m < 4; ++m) { GAS bf16* rowp = ACT + (size_t)(row0 + ai * HALF + m * 16) * DEXP + col0;
                float o[8];
#pragma unroll
                for (int n = 0; n < 2; ++n)
#pragma unroll
                    for (int j = 0; j < 4; ++j) { const float a = acc[ai][0][m][n][j], b = acc[ai][1][m][n][j]; o[n * 4 + j] = a * fast_sigmoid(a) * b; }
                u32x4 w; w.x = cvt_pk_bf16(o[0], o[1]); w.y = cvt_pk_bf16(o[2], o[3]); w.z = cvt_pk_bf16(o[4], o[5]); w.w = cvt_pk_bf16(o[6], o[7]);
                *(GAS u32x4*)rowp = w; }
    }
};
struct EpiMoe2 {
    static constexpr bool PERM = true;
    GAS bf16* Y; const GAS float* roww;
    __device__ __forceinline__ void operator()(const f32x4 (&acc)[2][2][4][2], const Unit& u, int wr, int wc, int fr, int fq) const {
        const int row0 = u.pm * BM + wr * 64 + fr, col0 = u.pn * BM + wc * 32 + 8 * fq;
        float rws[2][4];
#pragma unroll
        for (int ai = 0; ai < 2; ++ai)
#pragma unroll
            for (int m = 0; m < 4; ++m) rws[ai][m] = roww[row0 + ai * HALF + m * 16];
#pragma unroll
        for (int ai = 0; ai < 2; ++ai)
#pragma unroll
            for (int m = 0; m < 4; ++m) { const int row = row0 + ai * HALF + m * 16; const float rw = rws[ai][m]; GAS bf16* rowp = Y + (size_t)row * D + col0;
#pragma unroll
                for (int bj = 0; bj < 2; ++bj) { const f32x4 v0 = acc[ai][bj][m][0] * rw, v1 = acc[ai][bj][m][1] * rw;
                    u32x4 w; w.x = cvt_pk_bf16(v0[0], v0[1]); w.y = cvt_pk_bf16(v0[2], v0[3]); w.z = cvt_pk_bf16(v1[0], v1[1]); w.w = cvt_pk_bf16(v1[2], v1[3]);
                    *(GAS u32x4*)(rowp + bj * HALF) = w; } }
    }
};

struct MergeOrder {
    static constexpr bool GATHER = false;
    const GAS char* Y[3]; const GAS char* W; int G, c;
    __device__ __forceinline__ bool next(int i, Unit& u) const {
        const int j = i / 3, r = i - 3 * j; const int L = j * G + c; if (L >= 128 * 4) return false;
        pg8::tile_of(L, 128, 4, u.pm, u.pn); u.aux = r;
        const GAS char* y = (r == 0) ? Y[0] : ((r == 1) ? Y[1] : Y[2]);
        u.A = y + (size_t)u.pm * (256 * 512 * 2); u.B = W + (size_t)r * (1024 * 512 * 2) + (size_t)u.pn * (256 * 512 * 2); return true;
    }
};
template <int KDIM, bool GATHER_> struct MoeOrder {
    static constexpr bool GATHER = GATHER_;
    const GAS int* rowtok;
    const GAS char* A; const GAS char* W; const LAS int* pe; int c, NP;
    __device__ __forceinline__ bool next(int i, Unit& u) const {
        const int L = i * 256 + c; if (L >= NP * 4) return false;
        const int p = L >> 2, pn = L & 3; const int e = __builtin_amdgcn_readfirstlane(pe[p]);
        u.pm = p; u.pn = pn; u.aux = e; u.A = GATHER_ ? A : A + (size_t)p * (256 * KDIM * 2); u.B = W + (size_t)e * (1024 * KDIM * 2) + (size_t)pn * (256 * KDIM * 2); return true;
    }
};

struct Args {
    const float* in[23]; float* out; unsigned char* ws; int ph_lo, ph_hi;
};
struct Frame {
    LAS unsigned char* lds; int tid, lane, wave, G, wg;
    GAS float* out; GAS unsigned char* ws;
};
__device__ __forceinline__ const GAS float* inp_lds(LAS unsigned char* lds, int i) {
    const unsigned long long v = ((const LAS unsigned long long*)(lds + LARG_OFF))[i];
    const unsigned lo = __builtin_amdgcn_readfirstlane((unsigned)v), hi = __builtin_amdgcn_readfirstlane((unsigned)(v >> 32));
    return (const GAS float*)(((unsigned long long)hi << 32) | lo);
}
__device__ __forceinline__ const GAS float* inp(const Frame& F, int i) { return inp_lds(F.lds, i); }
__device__ __forceinline__ Frame fresh(LAS unsigned char* lds, int wave) {
    Frame F; int wgx = blockIdx.x; unsigned lb = (unsigned)(unsigned long long)lds;
    asm volatile("" : "+s"(wave), "+s"(wgx), "+s"(lb));
    F.lds = (LAS unsigned char*)(unsigned long long)lb;
    int ln = (int)__builtin_amdgcn_mbcnt_hi(~0u, __builtin_amdgcn_mbcnt_lo(~0u, 0u)); asm volatile("" : "+v"(ln));
    F.wave = wave; F.lane = ln; F.tid = wave * 64 + ln;
    F.G = 256; F.wg = wgx;
    F.out = (GAS float*)inp_lds(F.lds, 23); F.ws = (GAS unsigned char*)inp_lds(F.lds, 24);
    return F;
}
enum { I_X = 0, I_LN_IN_G, I_LN_IN_B, I_W_IN, I_CONV, I_A_LOG, I_DT_BIAS, I_DN_NORM, I_POOL_W, I_POOL_SCALE, I_ML_GATE_B, I_ML_NORM, I_W_BRANCH, I_W_OUT, I_LN_MIX_G, I_LN_MIX_B,
       I_ROUTER_W, I_ROUTER_B, I_MOE_W1, I_MOE_W3, I_MOE_W2, I_LN_FFN_G, I_LN_FFN_B };

__device__ __forceinline__ void tr_load(float (&r)[32], const GAS float* W, int ldw, int k0, int n0src, int lane) {
#pragma unroll
    for (int i = 0; i < 32; ++i) { const int kk = 2 * i + (lane >> 5); r[i] = W[(size_t)(k0 + kk) * ldw + n0src + (lane & 31)]; }
}
__device__ __forceinline__ void tr_store(const float (&r)[32], GAS bf16* WT, int dpitch, int k0, int drow0, LAS float* scr, int lane) {
#pragma unroll
    for (int i = 0; i < 32; ++i) { const int kk = 2 * i + (lane >> 5); scr[kk * 33 + (lane & 31)] = r[i]; }
    LDS_WAIT(); asm volatile("" ::: "memory");
    const int c = lane & 7;
#pragma unroll
    for (int j = 0; j < 4; ++j) { const int n = (lane >> 3) + 8 * j; const LAS float* s = scr + (8 * c) * 33 + n;
        u32x4 o; o.x = pk2(s[0 * 33], s[1 * 33]); o.y = pk2(s[2 * 33], s[3 * 33]); o.z = pk2(s[4 * 33], s[5 * 33]); o.w = pk2(s[6 * 33], s[7 * 33]);
        *(GAS u32x4*)(WT + (size_t)(drow0 + n) * dpitch + k0 + 8 * c) = o; }
    LDS_WAIT(); asm volatile("" ::: "memory");
}
__device__ __forceinline__ void tr_item(const GAS float* W, int ldw, int k0, int n0src, GAS bf16* WT, int dpitch, int drow0, LAS float* scr, int lane) {
    float r[32]; tr_load(r, W, ldw, k0, n0src, lane); tr_store(r, WT, dpitch, k0, drow0, scr, lane);
}
__device__ __forceinline__ void tr_segment(const Frame& F, const GAS float* W, int ldw, int K, int n0src, int ncols, GAS bf16* WT, int drow0, int& it) {
    LAS float* scr = (LAS float*)(F.lds + F.wave * 16384);
    const int gw = F.wg * NWAVES + F.wave, NGW = F.G * NWAVES;
    const int nblk = ncols / 32, nitems = (K / 64) * nblk;
    int first = (gw - (it % NGW) + NGW) % NGW;
    for (int r = first; r < nitems; r += NGW) { const int kb = r / nblk, nb = r % nblk; tr_item(W, ldw, 64 * kb, n0src + 32 * nb, WT, K, drow0 + 32 * nb, scr, F.lane); }
    it += nitems;
}
__device__ __forceinline__ void wprep_mixer(const Frame& F, int l) {
    const GAS float* win = inp(F, I_W_IN) + (size_t)l * D * DIN; int it = 0;
    GAS bf16* Wi = (GAS bf16*)(F.ws + WS_WIN); GAS bf16* Wg = (GAS bf16*)(F.ws + WS_WGATE); GAS bf16* Wb = (GAS bf16*)(F.ws + WS_WBR); GAS bf16* Wo = (GAS bf16*)(F.ws + WS_WOUT);
    tr_segment(F, win, DIN, D, C_QKV, 1536, Wi, 0, it);
    tr_segment(F, win, DIN, D, C_Z, 512, Wi, 1536, it);
    tr_segment(F, win, DIN, D, C_POOL, 512, Wi, 2048, it);
    tr_segment(F, win, DIN, D, C_MQ, 256, Wi, 2560, it);
    tr_segment(F, win, DIN, D, C_MK, 256, Wi, 2816, it);
    tr_segment(F, win, DIN, D, C_MV, 512, Wi, 3072, it);
    tr_segment(F, win, DIN, D, C_MO, 512, Wi, 3584, it);
    tr_segment(F, win, DIN, D, C_GATE, 3072, Wg, 0, it);
    const GAS float* wbr = inp(F, I_W_BRANCH) + (size_t)l * 3 * MIXW * D;
    tr_segment(F, wbr, D, MIXW, 0, D, Wb, 0, it);
    tr_segment(F, wbr + (size_t)2 * MIXW * D, D, MIXW, 0, D, Wb + (size_t)2 * D * MIXW, 0, it);
    tr_segment(F, inp(F, I_W_OUT) + (size_t)l * D * D, D, D, 0, D, Wo, 0, it);
    const GAS float* pw = inp(F, I_POOL_W) + (size_t)l * 4 * 128 * 128; const GAS float* ps = inp(F, I_POOL_SCALE) + (size_t)l * MIXW; const GAS float* wb1 = wbr + (size_t)MIXW * D;
    GAS bf16* W1 = Wb + (size_t)D * MIXW;
    for (int idx = F.wg * 512 + F.tid; idx < D * MIXW; idx += F.G * 512) {
        const int m = idx >> 10, d = idx & 1023, g = m >> 7, c = m & 127;
        float s = 0.f;
        for (int dd = 0; dd < 128; ++dd) s += pw[(g * 128 + c) * 128 + dd] * ps[g * 128 + dd] * wb1[(size_t)(g * 128 + dd) * D + d];
        W1[(size_t)d * MIXW + m] = (bf16)f2bf(s);
    }
}
__device__ __forceinline__ void wprep_moe(const Frame& F, int l, int wg0, int nwg) {
    GAS bf16* W13 = (GAS bf16*)((GAS unsigned char*)F.out + 64 * MiB); GAS bf16* W2 = (GAS bf16*)(F.ws + WS_W2);
    LAS float* scr = (LAS float*)(F.lds + F.wave * 16384);
    const int gw = (F.wg - wg0) * NWAVES + F.wave, NGW = nwg * NWAVES;
    const GAS float* w1 = inp(F, I_MOE_W1); const GAS float* w3 = inp(F, I_MOE_W3); const GAS float* w2 = inp(F, I_MOE_W2);
#define MOE_ITEM_LOAD(R, r_) do { const int ri_ = (r_); if (ri_ < 16384) { const int e = ri_ >> 9, which = (ri_ >> 8) & 1, kb = (ri_ >> 4) & 15, nb = ri_ & 15; \
            tr_load(R, (which ? w3 : w1) + ((size_t)l * NEXP + e) * D * DEXP, DEXP, 64 * kb, nb * 32, F.lane); } \
        else if (ri_ < 24576) { const int q = ri_ - 16384, e = q >> 8, kb = (q >> 5) & 7, nb = q & 31; tr_load(R, w2 + ((size_t)l * NEXP + e) * DEXP * D, D, 64 * kb, 32 * nb, F.lane); } } while (0)
#define MOE_ITEM_STORE(R, r_) do { const int ri_ = (r_); if (ri_ < 16384) { const int e = ri_ >> 9, which = (ri_ >> 8) & 1, kb = (ri_ >> 4) & 15, nb = ri_ & 15, n0 = nb * 32; \
            tr_store(R, W13 + (size_t)e * D * D, D, 64 * kb, (n0 >> 7) * 256 + which * 128 + (n0 & 127), scr, F.lane); } \
        else if (ri_ < 24576) { const int q = ri_ - 16384, e = q >> 8, kb = (q >> 5) & 7, nb = q & 31; tr_store(R, W2 + (size_t)e * D * DEXP, DEXP, 64 * kb, 32 * nb, scr, F.lane); } } while (0)
    float ra[32], rb[32];
    MOE_ITEM_LOAD(ra, gw);
    for (int r = gw; r < 24576; r += 2 * NGW) {
        MOE_ITEM_LOAD(rb, r + NGW); MOE_ITEM_STORE(ra, r);
        MOE_ITEM_LOAD(ra, r + 2 * NGW); MOE_ITEM_STORE(rb, r + NGW);
    }
#undef MOE_ITEM_LOAD
#undef MOE_ITEM_STORE
}

__device__ __forceinline__ int w32_addr(int k, int c4) { return (k >> 1) * 256 + (((((k & 1) << 3) | c4) ^ ((k >> 1) & 15)) << 4); }
__device__ __forceinline__ void stage_w32(const Frame& F, const GAS float* src, int ldw, bool gates) {
    for (int idx = F.tid; idx < D * 8; idx += 512) {
        const int k = idx >> 3, c4 = idx & 7;
        int col = 4 * c4;
        if (gates) col = (c4 < 2) ? (C_A + 4 * c4) : (c4 < 4) ? (C_B + 4 * (c4 - 2)) : (c4 < 6) ? (C_I + 4 * (c4 - 4)) : (C_F + 4 * (c4 - 6));
        const f32x4 v = *(const GAS f32x4*)(src + (size_t)k * ldw + col);
        *(LAS f32x4*)(F.lds + w32_addr(k, c4)) = v;
    }
}
template <int MODE>
__device__ __forceinline__ void ln_phase(const Frame& F, const GAS float* gam, const GAS float* bet, const GAS float* w32src, int w32ld, bool do_proj, bool write_hb, bool dummy = false) {
    GAS float* OUTP = dummy ? (GAS float*)(F.ws + WS_R2) : F.out; GAS unsigned char* WSO = dummy ? (F.ws + WS_R2 + 40 * MiB) : F.ws;
    LAS int* lhist = (LAS int*)(F.lds + LHIST_OFF);
    if (do_proj) stage_w32(F, w32src, w32ld, MODE != 1);
    if (MODE == 1 && F.tid < 32) lhist[F.tid] = 0;
    __syncthreads();
    const int lane = F.lane;
    f32x2 gv[8], bv[8];
#pragma unroll
    for (int m = 0; m < 8; ++m) { gv[m] = *(const GAS f32x2*)(gam + 2 * lane + 128 * m); bv[m] = *(const GAS f32x2*)(bet + 2 * lane + 128 * m); }
    GAS bf16* hb = dummy ? (GAS bf16*)(F.ws + WS_R2 + 128 * MiB) : (GAS bf16*)(F.ws + WS_HB);
    const int rows_per_wg = T / F.G;
    const GAS int* posp = (const GAS int*)(F.ws + WS_POS); const GAS bf16* Yr = (const GAS bf16*)(F.ws + WS_YROWS);
    const GAS float* srcp = inp(F, I_X);
    const GAS bf16* preb = (MODE == 1) ? (const GAS bf16*)F.out : (const GAS bf16*)(F.ws + WS_HB);
#define LN_FETCH(V, Y0, Y1, row_) do { const int rw_ = (row_); \
        if (MODE == 0) { _Pragma("unroll") for (int m = 0; m < 8; ++m) V[m] = *(const GAS f32x2*)(srcp + (size_t)rw_ * D + 2 * lane + 128 * m); } \
        else { _Pragma("unroll") for (int m = 0; m < 8; ++m) { const unsigned u_ = *(const GAS unsigned*)(preb + (size_t)rw_ * D + 2 * lane + 128 * m); V[m].x = bf2f(u_ & 0xffffu); V[m].y = bf2f(u_ >> 16); } } \
        if (MODE == 2) { const int p0_ = posp[2 * rw_], p1_ = posp[2 * rw_ + 1]; \
            _Pragma("unroll") for (int m = 0; m < 8; ++m) { Y0[m] = *(const GAS unsigned*)(Yr + (size_t)p0_ * D + 2 * lane + 128 * m); Y1[m] = *(const GAS unsigned*)(Yr + (size_t)p1_ * D + 2 * lane + 128 * m); } } } while (0)
    const int nrow = rows_per_wg / NWAVES, row0 = F.wg * rows_per_wg + F.wave * nrow;
    f32x2 vA[8], vB[8]; unsigned yA0[8], yA1[8], yB0[8], yB1[8];
    LN_FETCH(vA, yA0, yA1, row0);
#pragma unroll 1
    for (int i2 = 0; i2 < nrow; i2 += 2) {
#pragma unroll
      for (int half = 0; half < 2; ++half) {
        const int i = i2 + half; const int row = row0 + i;
        const int nrw = row0 + ((i + 1 < nrow) ? i + 1 : i);
        if (half == 0) LN_FETCH(vB, yB0, yB1, nrw); else LN_FETCH(vA, yA0, yA1, nrw);
        f32x2 v[8];
#pragma unroll
        for (int m = 0; m < 8; ++m) {
            const f32x2 o = half ? vB[m] : vA[m];
            if (MODE == 2) { const unsigned ya = half ? yB0[m] : yA0[m], yb = half ? yB1[m] : yA1[m];
                v[m].x = ALPHA * o.x + bf2f(ya & 0xffffu) + bf2f(yb & 0xffffu); v[m].y = ALPHA * o.y + bf2f(ya >> 16) + bf2f(yb >> 16); }
            else v[m] = o;
        }
        float s = 0.f;
#pragma unroll
        for (int m = 0; m < 8; ++m) s += v[m].x + v[m].y;
        const float mean = wave_sum(s) * (1.f / D);
        float s2 = 0.f;
#pragma unroll
        for (int m = 0; m < 8; ++m) { v[m].x -= mean; v[m].y -= mean; s2 += v[m].x * v[m].x + v[m].y * v[m].y; }
        const float rstd = 1.0f / sqrtf(wave_sum(s2) * (1.f / D) + LN_EPS);
#pragma unroll
        for (int m = 0; m < 8; ++m) { v[m].x = v[m].x * rstd * gv[m].x + bv[m].x; v[m].y = v[m].y * rstd * gv[m].y + bv[m].y; }
        if (!write_hb) {
#pragma unroll
            for (int m = 0; m < 8; ++m) *(GAS f32x2*)(OUTP + (size_t)row * D + 2 * lane + 128 * m) = v[m];
        }
        if (write_hb) {
#pragma unroll
            for (int m = 0; m < 8; ++m) *(GAS unsigned*)(hb + (size_t)row * D + 2 * lane + 128 * m) = pk2(v[m].x, v[m].y);
        }
        if (!do_proj) continue;
        float acc[32];
#pragma unroll
        for (int c = 0; c < 32; ++c) acc[c] = 0.f;
#pragma unroll
        for (int m = 0; m < 8; ++m) {
#pragma unroll
            for (int e = 0; e < 2; ++e) {
                asm volatile("" ::: "memory");
                const int k = 2 * lane + 128 * m + e; const float xv = e ? v[m].y : v[m].x;
#pragma unroll
                for (int c4 = 0; c4 < 8; ++c4) { const f32x4 w = *(const LAS f32x4*)(F.lds + w32_addr(k, c4));
                    acc[4 * c4 + 0] += xv * w[0]; acc[4 * c4 + 1] += xv * w[1]; acc[4 * c4 + 2] += xv * w[2]; acc[4 * c4 + 3] += xv * w[3]; }
            }
        }
        float r16[16], r8[8], r4[4], r2[2], r1;
        { const bool hi = (lane & 32) != 0;
#pragma unroll
          for (int j = 0; j < 16; ++j) { const float a = acc[j], b = acc[j + 16]; const float send = hi ? a : b, keep = hi ? b : a; r16[j] = keep + __shfl_xor(send, 32); } }
        { const bool hi = (lane & 16) != 0;
#pragma unroll
          for (int j = 0; j < 8; ++j) { const float a = r16[j], b = r16[j + 8]; const float send = hi ? a : b, keep = hi ? b : a; r8[j] = keep + __shfl_xor(send, 16); } }
        { const bool hi = (lane & 8) != 0;
#pragma unroll
          for (int j = 0; j < 4; ++j) { const float a = r8[j], b = r8[j + 4]; const float send = hi ? a : b, keep = hi ? b : a; r4[j] = keep + __shfl_xor(send, 8); } }
        { const bool hi = (lane & 4) != 0;
#pragma unroll
          for (int j = 0; j < 2; ++j) { const float a = r4[j], b = r4[j + 2]; const float send = hi ? a : b, keep = hi ? b : a; r2[j] = keep + __shfl_xor(send, 4); } }
        { const bool hi = (lane & 2) != 0; const float a = r2[0], b = r2[1]; const float send = hi ? a : b, keep = hi ? b : a; r1 = keep + __shfl_xor(send, 2); }
        r1 += __shfl_xor(r1, 1);
        if (MODE != 1) {
            if ((lane & 1) == 0) ((GAS float*)(WSO + WS_SG))[(size_t)row * 32 + (lane >> 1)] = r1;
        } else {
            const float score = sigmoidf_(r1);
            const float sel = score + inp(F, I_ROUTER_B)[lane >> 1];
            const int gb = lane & ~7;
            const float v0 = __shfl(sel, gb + 0), v1 = __shfl(sel, gb + 2), v2 = __shfl(sel, gb + 4), v3 = __shfl(sel, gb + 6);
            int i1 = 0; float m1 = v0;
            if (v1 > m1) { m1 = v1; i1 = 1; } if (v2 > m1) { m1 = v2; i1 = 2; } if (v3 > m1) { m1 = v3; i1 = 3; }
            int i2 = -1; float m2 = -3.0e38f;
            if (i1 != 0 && v0 > m2) { m2 = v0; i2 = 0; } if (i1 != 1 && v1 > m2) { m2 = v1; i2 = 1; } if (i1 != 2 && v2 > m2) { m2 = v2; i2 = 2; } if (i1 != 3 && v3 > m2) { m2 = v3; i2 = 3; }
            float gs = m1 + m2; int gi = lane >> 3;
#pragma unroll
            for (int o = 8; o < 64; o <<= 1) { const float og = __shfl_xor(gs, o); const int oi = __shfl_xor(gi, o); if (og > gs || (og == gs && oi < gi)) { gs = og; gi = oi; } }
            const int src = gi * 8;
            const int e1 = gi * 4 + __shfl(i1, src), e2 = gi * 4 + __shfl(i2, src);
            const float s1 = __shfl(score, 2 * e1), s2 = __shfl(score, 2 * e2);
            if (lane == 0) {
                GAS int* eid = (GAS int*)(WSO + WS_EID); GAS float* ew = (GAS float*)(WSO + WS_EW);
                const float inv = 1.0f / (s1 + s2);
                eid[2 * row] = e1; eid[2 * row + 1] = e2; ew[2 * row] = s1 * inv; ew[2 * row + 1] = s2 * inv;
                __hip_atomic_fetch_add(lhist + e1, 1, __ATOMIC_RELAXED, __HIP_MEMORY_SCOPE_WORKGROUP); __hip_atomic_fetch_add(lhist + e2, 1, __ATOMIC_RELAXED, __HIP_MEMORY_SCOPE_WORKGROUP);
            }
        }
      }
    }
#undef LN_FETCH
    if (MODE == 1) {
        __syncthreads();
        if (F.tid < 32) ((GAS int*)(WSO + WS_HIST))[F.wg * 32 + F.tid] = lhist[F.tid];
    }
    __syncthreads();
}

__device__ __forceinline__ int invsigma32(int w) { return 8 * ((w >> 2) & 3) + 4 * (w >> 4) + (w & 3); }
__device__ __forceinline__ float wave_incl_scan(float v, int lane) {
#pragma unroll
    for (int o = 1; o < 64; o <<= 1) { const float t = __shfl_up(v, o); if (lane >= o) v += t; }
    return v;
}
__device__ __forceinline__ float wave_incl_maxscan(float v, int lane) {
#pragma unroll
    for (int o = 1; o < 64; o <<= 1) { const float t = __shfl_up(v, o); if (lane >= o) v = fmaxf(v, t); }
    return v;
}
constexpr int DQ_OFF = 0, DK_OFF = 17408, DV_OFF = 34816, DGM_OFF = 52224, DQK_OFF = 69632, DTM_OFF = 87040, DVEC_OFF = 121856;
constexpr int QROW = 272;
constexpr int FROW = 68;
__device__ __forceinline__ bf16x8 pack_b(const f32x4 lo, const f32x4 hi) {
    u32x4 w; w.x = cvt_pk_bf16(lo[0], lo[1]); w.y = cvt_pk_bf16(lo[2], lo[3]); w.z = cvt_pk_bf16(hi[0], hi[1]); w.w = cvt_pk_bf16(hi[2], hi[3]);
    return __builtin_bit_cast(bf16x8, w);
}
__device__ __forceinline__ bf16x8 pack8f(const float (&f)[8]) {
    u32x4 w; w.x = cvt_pk_bf16(f[0], f[1]); w.y = cvt_pk_bf16(f[2], f[3]); w.z = cvt_pk_bf16(f[4], f[5]); w.w = cvt_pk_bf16(f[6], f[7]);
    return __builtin_bit_cast(bf16x8, w);
}
#define PREP_BAR() do { asm volatile("s_waitcnt lgkmcnt(0)" ::: "memory"); __builtin_amdgcn_s_barrier(); asm volatile("" ::: "memory"); } while (0)
#ifndef DNREP_A
#define DNREP_A 1
#endif
#ifndef DNREP_B
#define DNREP_B 1
#endif
#ifndef DNREP_C
#define DNREP_C 1
#endif
#ifndef DNREP_D
#define DNREP_D 1
#endif
__device__ __forceinline__ void dn_prep(const Frame& F, int l) {
    LAS unsigned char* L = F.lds;
    const int lane = F.lane, wave = F.wave, tid = F.tid, fr = lane & 15, fq = lane >> 4;
    const GAS bf16* P = (const GAS bf16*)(F.ws + WS_PQKV);
    const GAS float* SG = (const GAS float*)(F.ws + WS_SG);
    const GAS float* cw = inp(F, I_CONV) + (size_t)l * 5 * 1536;
    LAS float* GM = (LAS float*)(L + DGM_OFF); LAS float* QKM = (LAS float*)(L + DQK_OFF);
#ifdef DIAG
    unsigned long long tacc[7] = {0, 0, 0, 0, 0, 0, 0}; unsigned long long tprev = __builtin_amdgcn_s_memrealtime();
#define DSTAMP(k) do { const unsigned long long tn_ = __builtin_amdgcn_s_memrealtime(); tacc[k] += tn_ - tprev; tprev = tn_; } while (0)
#else
#define DSTAMP(k) do {} while (0)
#endif
    unsigned praw[12][3]; float pga = 0.f, pgb = 0.f;
#define DN_PF(item_) do { const int it_ = (item_) < NB * NHEAD * NCH ? (item_) : F.wg; const int b_ = it_ >> 9, h_ = (it_ >> 7) & 3, n_ = it_ & 127; \
        _Pragma("unroll") for (int rr = 0; rr < 12; ++rr) { const int sp_ = n_ * CH + 8 * wave + rr - 2; const bool ok_ = (sp_ >= 0 && sp_ < SEQ); \
            const GAS bf16* src_ = P + (size_t)(b_ * SEQ + (ok_ ? sp_ : 0)) * 1536 + h_ * 128 + 2 * lane; \
            _Pragma("unroll") for (int p = 0; p < 3; ++p) { const unsigned u_ = *(const GAS unsigned*)(src_ + p * 512); praw[rr][p] = ok_ ? u_ : 0u; } } \
        if (wave < 2) { const int ti_ = wave ? 63 - lane : lane; const int t0_ = b_ * SEQ + n_ * CH; pga = SG[(size_t)(t0_ + ti_) * 32 + wave * 4 + h_]; pgb = SG[(size_t)(t0_ + ti_) * 32 + 8 + wave * 4 + h_]; } } while (0)
    DN_PF(F.wg);
    for (int item = F.wg; item < NB * NHEAD * NCH; item += F.G) {
        const int b = item >> 9, h = (item >> 7) & 3, n = item & 127;
        const int t0 = b * SEQ + n * CH;
        for (int repA = 0; repA < DNREP_A; ++repA) {
        {
            float w[3][5][2];
#pragma unroll
            for (int p = 0; p < 3; ++p)
#pragma unroll
                for (int j = 0; j < 5; ++j) { const f32x2 t = *(const GAS f32x2*)(cw + j * 1536 + p * 512 + h * 128 + 2 * lane); w[p][j][0] = t.x; w[p][j][1] = t.y; }
#pragma unroll
            for (int ii = 0; ii < 8; ++ii) {
                const int i = 8 * wave + ii;
                float y[3][2];
#pragma unroll
                for (int p = 0; p < 3; ++p) { y[p][0] = 0.f; y[p][1] = 0.f; }
#pragma unroll
                for (int j = 0; j < 5; ++j)
#pragma unroll
                    for (int p = 0; p < 3; ++p) { const unsigned u = praw[ii + j][p]; y[p][0] += bf2f(u & 0xffffu) * w[p][j][0]; y[p][1] += bf2f(u >> 16) * w[p][j][1]; }
#pragma unroll
                for (int p = 0; p < 3; ++p) { y[p][0] = y[p][0] * fast_sigmoid(y[p][0]); y[p][1] = y[p][1] * fast_sigmoid(y[p][1]); }
                const float sq = wave_sum(y[0][0] * y[0][0] + y[0][1] * y[0][1]), sk = wave_sum(y[1][0] * y[1][0] + y[1][1] * y[1][1]);
                const float rq = __builtin_amdgcn_rsqf(sq + NORM_EPS) * 0.08838834764831845f, rk = __builtin_amdgcn_rsqf(sk + NORM_EPS);
                *(LAS unsigned*)(L + DQ_OFF + i * QROW + 4 * lane) = cvt_pk_bf16(y[0][0] * rq, y[0][1] * rq);
                *(LAS unsigned*)(L + DK_OFF + i * QROW + 4 * lane) = cvt_pk_bf16(y[1][0] * rk, y[1][1] * rk);
                *(LAS unsigned*)(L + DV_OFF + i * QROW + 4 * lane) = cvt_pk_bf16(y[2][0], y[2][1]);
            }
            if (wave < 2) {
                const int d = wave; const int ti = d ? 63 - lane : lane;
                const float a = pga, bb = pgb;
                const float beta = sigmoidf_(bb);
                const float g = -expf(inp(F, I_A_LOG)[l * 8 + d * 4 + h]) * softplusf_(a + inp(F, I_DT_BIAS)[l * 8 + d * 4 + h]);
                const float gc = wave_incl_scan(g, lane);
                const float gl = __shfl(gc, 63);
                LAS float* vec = (LAS float*)(L + DVEC_OFF + d * 1024);
                vec[lane] = beta; vec[64 + lane] = gc; vec[128 + lane] = expf(gc); vec[192 + lane] = expf(gl - gc);
                if (lane == 63) ((GAS float*)(F.ws + WS_GL))[(size_t)item * 2 + d] = expf(gc);
            }
        }
        PREP_BAR();
        DSTAMP(0);
        }
        for (int repB = 0; repB < DNREP_B; ++repB) {
        {
#pragma unroll
            for (int tt = 0; tt < 2; ++tt) {
                const int t = 2 * wave + tt, mt = t >> 2, nt = t & 3;
                f32x4 ag = (f32x4){0.f, 0.f, 0.f, 0.f}, aq = (f32x4){0.f, 0.f, 0.f, 0.f};
#pragma unroll
                for (int s = 0; s < 4; ++s) {
                    const bf16x8 ka = *(const LAS bf16x8*)(L + DK_OFF + (16 * mt + fr) * QROW + 64 * s + 16 * fq);
                    const bf16x8 qa = *(const LAS bf16x8*)(L + DQ_OFF + (16 * mt + fr) * QROW + 64 * s + 16 * fq);
                    const bf16x8 kb = *(const LAS bf16x8*)(L + DK_OFF + (16 * nt + fr) * QROW + 64 * s + 16 * fq);
                    ag = __builtin_amdgcn_mfma_f32_16x16x32_bf16(ka, kb, ag, 0, 0, 0);
                    aq = __builtin_amdgcn_mfma_f32_16x16x32_bf16(qa, kb, aq, 0, 0, 0);
                }
#pragma unroll
                for (int r = 0; r < 4; ++r) { GM[(16 * mt + 4 * fq + r) * FROW + 16 * nt + fr] = ag[r]; QKM[(16 * mt + 4 * fq + r) * FROW + 16 * nt + fr] = aq[r]; }
            }
        }
        PREP_BAR();
        DSTAMP(1);
        }
        for (int repC = 0; repC < DNREP_C; ++repC) {
        {
#pragma unroll 4
            for (int e = 0; e < 16; ++e) {
                const int idx = tid + 512 * e, d = idx >> 12, i = (idx >> 6) & 63, j = idx & 63;
                const LAS float* vec = (const LAS float*)(L + DVEC_OFF + d * 1024);
                const int ti = d ? 63 - i : i, tj = d ? 63 - j : j;
                float v = (j < i) ? vec[i] * GM[ti * FROW + tj] * fexp(fminf(vec[64 + i] - vec[64 + j], 0.f)) : 0.f;
                if ((i & 31) == 0 && j >= (i & 32)) v = (j == i) ? 1.f : 0.f;
                *(LAS float*)(L + DTM_OFF + d * 17408 + (i * FROW + j) * 4) = v;
            }
        }
        PREP_BAR();
        DSTAMP(2);
        if (wave < 4) {
            const int d = wave >> 1, hb = wave & 1, c = lane & 31;
            LAS float* TM = (LAS float*)(L + DTM_OFF + d * 17408) + (32 * hb) * FROW + 32 * hb;
#define SUBST_PART(NB4, BASE) do { f32x4 m4[NB4]; float tv_[4 * NB4]; \
                _Pragma("unroll") for (int q = 0; q < NB4; ++q) m4[q] = *(const LAS f32x4*)(TM + i * FROW + (BASE) + 4 * q); \
                _Pragma("unroll") for (int q = 0; q < 4 * NB4; ++q) tv_[q] = TM[((BASE) + q) * FROW + c]; \
                _Pragma("unroll") for (int q = 0; q < NB4; ++q) { a0 -= m4[q][0] * tv_[4 * q]; a1 -= m4[q][1] * tv_[4 * q + 1]; a2 -= m4[q][2] * tv_[4 * q + 2]; a3 -= m4[q][3] * tv_[4 * q + 3]; } } while (0)
#define SUBST_END() do { const float tv = ((c == i) ? 1.f : 0.f) + ((a0 + a1) + (a2 + a3)); asm volatile("s_waitcnt lgkmcnt(0)" ::: "memory"); TM[i * FROW + c] = tv; } while (0)
#pragma unroll 1
            for (int i = 1; i < 16; ++i) { float a0 = 0.f, a1 = 0.f, a2 = 0.f, a3 = 0.f; SUBST_PART(4, 0); SUBST_END(); }
#pragma unroll 1
            for (int i = 16; i < 32; ++i) { float a0 = 0.f, a1 = 0.f, a2 = 0.f, a3 = 0.f; SUBST_PART(4, 0); asm volatile("" ::: "memory"); SUBST_PART(4, 16); SUBST_END(); }
#undef SUBST_PART
#undef SUBST_END
        } else {
            const int tw = wave - 4;
            for (int it = tw; it < 128; it += 4) {
                const int d = it >> 6, i = it & 63, ti = d ? 63 - i : i;
                const LAS float* vec = (const LAS float*)(L + DVEC_OFF + d * 1024);
                GAS unsigned char* rec = F.ws + WS_R2 + ((size_t)item * 2 + d) * DNREC;
                { const int p = 2 * lane; const int kk = (p & ~31) + sigma32(p & 31);
                  const unsigned u = *(const LAS unsigned*)(L + DQ_OFF + ti * QROW + 2 * kk); const float e = vec[128 + i];
                  *(GAS unsigned*)(rec + DN_QG + (i * 128 + p) * 2) = cvt_pk_bf16(bf2f(u & 0xffffu) * e, bf2f(u >> 16) * e); }
                { const int p = lane; const int j = (p & ~31) + sigma32(p & 31), tj = d ? 63 - j : j;
                  const float v = (j <= i) ? QKM[ti * FROW + tj] * fexp(fminf(vec[64 + i] - vec[64 + j], 0.f)) : 0.f;
                  ((GAS bf16*)(rec + DN_ATT))[i * 64 + p] = (bf16)f2bf(v); }
            }
            for (int it = tw; it < 128; it += 4) {
                const int d = it >> 6, kk = 2 * (it & 63);
                const LAS float* vec = (const LAS float*)(L + DVEC_OFF + d * 1024);
                GAS bf16* Kd = (GAS bf16*)(F.ws + WS_R2 + ((size_t)item * 2 + d) * DNREC + DN_KDT);
                const int p = lane; const int j = (p & ~31) + sigma32(p & 31), tj = d ? 63 - j : j;
                const unsigned u = *(const LAS unsigned*)(L + DK_OFF + tj * QROW + 2 * kk); const float e = vec[192 + j];
                Kd[kk * 64 + p] = (bf16)f2bf(bf2f(u & 0xffffu) * e); Kd[(kk + 1) * 64 + p] = (bf16)f2bf(bf2f(u >> 16) * e);
            }
        }
        PREP_BAR();
        DSTAMP(3);
        if (wave < 2) {
            LAS float* TM = (LAS float*)(L + DTM_OFF + wave * 17408);
            bf16x8 am[2], bt[2];
#pragma unroll
            for (int mt = 0; mt < 2; ++mt) { const f32x4 lo = *(const LAS f32x4*)(TM + (32 + 16 * mt + fr) * FROW + 8 * fq), hi = *(const LAS f32x4*)(TM + (32 + 16 * mt + fr) * FROW + 8 * fq + 4); am[mt] = pack_b(lo, hi); }
#pragma unroll
            for (int nt = 0; nt < 2; ++nt) { float xf[8];
#pragma unroll
                for (int e = 0; e < 8; ++e) xf[e] = TM[(8 * fq + e) * FROW + 16 * nt + fr];
                bt[nt] = pack8f(xf); }
            f32x4 X[2][2];
#pragma unroll
            for (int mt = 0; mt < 2; ++mt)
#pragma unroll
                for (int nt = 0; nt < 2; ++nt) X[mt][nt] = __builtin_amdgcn_mfma_f32_16x16x32_bf16(am[mt], bt[nt], (f32x4){0.f, 0.f, 0.f, 0.f}, 0, 0, 0);
            bf16x8 xb[2], a2[2];
#pragma unroll
            for (int nt = 0; nt < 2; ++nt) xb[nt] = pack_b(X[0][nt], X[1][nt]);
#pragma unroll
            for (int mt = 0; mt < 2; ++mt) { const f32x4 lo = *(const LAS f32x4*)(TM + (32 + 16 * mt + fr) * FROW + 32 + 4 * fq), hi = *(const LAS f32x4*)(TM + (32 + 16 * mt + fr) * FROW + 32 + 16 + 4 * fq); a2[mt] = pack_b(lo, hi); }
#pragma unroll
            for (int mt = 0; mt < 2; ++mt)
#pragma unroll
                for (int nt = 0; nt < 2; ++nt) { const f32x4 t21 = __builtin_amdgcn_mfma_f32_16x16x32_bf16(a2[mt], xb[nt], (f32x4){0.f, 0.f, 0.f, 0.f}, 0, 0, 0);
#pragma unroll
                    for (int r = 0; r < 4; ++r) TM[(32 + 16 * mt + 4 * fq + r) * FROW + 16 * nt + fr] = -t21[r]; }
        }
        PREP_BAR();
        DSTAMP(4);
        }
        DN_PF(item + F.G);
        for (int repD = 0; repD < DNREP_D; ++repD) {
#pragma unroll 1
        for (int d = 0; d < 2; ++d) {
            const LAS float* TM = (const LAS float*)(L + DTM_OFF + d * 17408);
            const LAS float* vec = (const LAS float*)(L + DVEC_OFF + d * 1024);
            GAS unsigned char* rec = F.ws + WS_R2 + ((size_t)item * 2 + d) * DNREC;
            bf16x8 ta[4][2];
#pragma unroll
            for (int mt = 0; mt < 4; ++mt)
#pragma unroll
                for (int s = 0; s < 2; ++s) { const f32x4 lo = *(const LAS f32x4*)(TM + (16 * mt + fr) * FROW + 32 * s + 8 * fq), hi = *(const LAS f32x4*)(TM + (16 * mt + fr) * FROW + 32 * s + 8 * fq + 4); ta[mt][s] = pack_b(lo, hi); }
#pragma unroll 1
            for (int tt = 0; tt < 2; ++tt) {
                const int nt = 2 * wave + tt; const bool isv = nt < 8; const int col = 16 * (nt & 7) + fr;
                const int imgoff = isv ? DV_OFF : DK_OFF;
                bf16x8 xb[2];
#pragma unroll
                for (int s = 0; s < 2; ++s) { float xf[8];
#pragma unroll
                    for (int e = 0; e < 8; ++e) { const int j = 32 * s + 8 * fq + e, tj = d ? 63 - j : j;
                        const float x = bf2f(*(const LAS unsigned short*)(L + imgoff + tj * QROW + 2 * col));
                        xf[e] = x * vec[j] * (isv ? 1.f : vec[128 + j]); }
                    xb[s] = pack8f(xf); }
                f32x4 acc[4];
#pragma unroll
                for (int mt = 0; mt < 4; ++mt) { acc[mt] = (f32x4){0.f, 0.f, 0.f, 0.f};
#pragma unroll
                    for (int s = 0; s < 2; ++s) acc[mt] = __builtin_amdgcn_mfma_f32_16x16x32_bf16(ta[mt][s], xb[s], acc[mt], 0, 0, 0); }
                if (isv) {
                    GAS bf16* Uf = (GAS bf16*)(rec + DN_UF) + ((nt * 64 + lane) * 16);
#pragma unroll
                    for (int mt = 0; mt < 4; ++mt) { u32x2 w2; w2.x = cvt_pk_bf16(acc[mt][0], acc[mt][1]); w2.y = cvt_pk_bf16(acc[mt][2], acc[mt][3]); *(GAS u32x2*)(Uf + mt * 4) = w2; }
                } else {
                    GAS bf16* Wp = (GAS bf16*)(rec + DN_W); const int pos = (col & ~31) + invsigma32(col & 31);
#pragma unroll
                    for (int mt = 0; mt < 4; ++mt)
#pragma unroll
                        for (int r = 0; r < 4; ++r) Wp[(16 * mt + 4 * fq + r) * 128 + pos] = (bf16)f2bf(acc[mt][r]);
                }
            }
        }
        PREP_BAR();
        DSTAMP(5);
        }
    }
#ifdef DIAG
    if (F.tid == 0 && F.wg == 0 && l == 0) { for (int k = 0; k < 6; ++k) ((GAS unsigned long long*)(F.ws + WS_CTL + 1024))[48 + k] = tacc[k]; }
#endif
}

__device__ __forceinline__ int swz256(int row, int c16) { return row * 256 + ((c16 ^ (row & 15)) << 4); }
__device__ __forceinline__ int swz128(int row, int c8) { return (row >> 1) * 256 + (((((row & 1) << 3) | c8) ^ ((row >> 1) & 15)) << 4); }
constexpr int DNBUF = 57344;
#define SCAN_BAR() do { asm volatile("s_waitcnt lgkmcnt(0)" ::: "memory"); __builtin_amdgcn_s_barrier(); asm volatile("" ::: "memory"); } while (0)
__device__ __forceinline__ void dn_scan(const Frame& F) {
    if (F.wg >= 128) return;
    const int xcd = F.wg & 7, idx = F.wg >> 3;
    const int chain = xcd * 4 + (idx >> 2), qtr = idx & 3;
    const int b = chain >> 3, h = (chain >> 1) & 3, d = chain & 1;
    const int lane = F.lane, fr = lane & 15, fq = lane >> 4, wave = F.wave;
    LAS unsigned char* L = F.lds;
    const GAS unsigned char* recbase = F.ws + WS_R2;
    const int itembase = (b * NHEAD + h) * NCH;
    if (wave >= 2) {
        const int tl = F.tid - 128;
        u32x4 ra[10], rb[10];
        int woff[10];
#pragma unroll
        for (int i = 0; i < 10; ++i) { const int q = tl + 384 * i;
            if (q < 1024) woff[i] = swz256(q >> 4, q & 15); else if (q < 2048) woff[i] = 16384 + swz256((q - 1024) >> 4, q & 15);
            else if (q < 3072) woff[i] = 32768 + swz128((q - 2048) >> 3, q & 7); else if (q < 3584) woff[i] = 49152 + swz128((q - 3072) >> 3, q & 7); else woff[i] = -1; }
#define DN_LOAD(R, step_) do { const int st_ = (step_) < NCH ? (step_) : NCH - 1; const int n_ = d ? (NCH - 1 - st_) : st_; \
        const GAS u32x4* src_ = (const GAS u32x4*)(recbase + ((size_t)(itembase + n_) * 2 + d) * DNREC) + tl; \
        _Pragma("unroll") for (int i = 0; i < 10; ++i) R[i] = src_[(woff[i] >= 0) ? 384 * i : 0]; } while (0)
#define DN_WRITE(R, bufoff_) do { _Pragma("unroll") for (int i = 0; i < 10; ++i) if (woff[i] >= 0) *(LAS u32x4*)(L + (bufoff_) + woff[i]) = R[i]; } while (0)
        u32x4 rc[10];
        DN_LOAD(ra, 0); DN_LOAD(rb, 1); DN_LOAD(rc, 2);
        DN_WRITE(ra, 0);
        SCAN_BAR();
        for (int s = 0; s < 126; s += 6) {
            DN_LOAD(ra, s + 3); DN_WRITE(rb, DNBUF); SCAN_BAR();
            DN_LOAD(rb, s + 4); DN_WRITE(rc, 0);     SCAN_BAR();
            DN_LOAD(rc, s + 5); DN_WRITE(ra, DNBUF); SCAN_BAR();
            DN_LOAD(ra, s + 6); DN_WRITE(rb, 0);     SCAN_BAR();
            DN_LOAD(rb, s + 7); DN_WRITE(rc, DNBUF); SCAN_BAR();
            DN_LOAD(rc, s + 8); DN_WRITE(ra, 0);     SCAN_BAR();
        }
        DN_WRITE(rb, DNBUF); SCAN_BAR();
        SCAN_BAR();
#undef DN_LOAD
#undef DN_WRITE
        return;
    }
    const int slice = qtr * 2 + wave;
    const GAS float* GL = (const GAS float*)(F.ws + WS_GL);
    GAS bf16* O = (GAS bf16*)(F.ws + (d ? WS_OB : WS_OF));
    f32x4 S[8];
#pragma unroll
    for (int k = 0; k < 8; ++k) S[k] = (f32x4){0.f, 0.f, 0.f, 0.f};
    int offw[4], offk[8], offa[4];
#pragma unroll
    for (int t = 0; t < 4; ++t) { offw[t] = (16 * t + fr) * 256; offa[t] = ((16 * t + fr) >> 1) * 256; }
#pragma unroll
    for (int t = 0; t < 8; ++t) offk[t] = ((16 * t + fr) >> 1) * 256;
    const int x256 = fr & 15;
    const int x128 = (fr >> 1) & 15, p128 = (fr & 1) << 3;
    u32x4 uc0, uc1, un0, un1; float egl_c, egl_n;
    int vz = 0; asm volatile("" : "+v"(vz));
#define DN_UFETCH(A0, A1, EG, step_) do { const int st_ = (step_) < NCH ? (step_) : NCH - 1; const int nn_ = d ? (NCH - 1 - st_) : st_; \
        const GAS bf16* Uf_ = (const GAS bf16*)(recbase + ((size_t)(itembase + nn_) * 2 + d) * DNREC + DN_UF); A0 = *(const GAS u32x4*)(Uf_ + (slice * 64 + lane) * 16); A1 = *(const GAS u32x4*)(Uf_ + (slice * 64 + lane) * 16 + 8); \
        EG = GL[(size_t)(itembase + nn_) * 2 + d + vz]; } while (0)
    DN_UFETCH(uc0, uc1, egl_c, 0); DN_UFETCH(un0, un1, egl_n, 1);
    SCAN_BAR();
    for (int step = 0; step < NCH; ++step) {
        const int n = d ? (NCH - 1 - step) : step;
        const int bufoff = (step & 1) ? DNBUF : 0;
        const u32x4 u0 = uc0, u1 = uc1; const float egl = egl_c;
        uc0 = un0; uc1 = un1; egl_c = egl_n;
        DN_UFETCH(un0, un1, egl_n, step + 2);
        const LAS unsigned char* Bw = L + bufoff; const LAS unsigned char* Bq = Bw + 16384; const LAS unsigned char* Bk = Bw + 32768; const LAS unsigned char* Ba = Bw + 49152;
#define LD_WQ(G, s_) do { _Pragma("unroll") for (int mt = 0; mt < 4; ++mt) { const int o_ = offw[mt] + (((4 * (s_) + fq) ^ x256) << 4); G[mt] = *(const LAS bf16x8*)(Bw + o_); G[4 + mt] = *(const LAS bf16x8*)(Bq + o_); } } while (0)
#define MM_WQ(G, s_) do { _Pragma("unroll") for (int mt = 0; mt < 4; ++mt) { V[mt] = __builtin_amdgcn_mfma_f32_16x16x32_bf16(G[mt], SB[s_], V[mt], 0, 0, 0); Q[mt] = __builtin_amdgcn_mfma_f32_16x16x32_bf16(SB[s_], G[4 + mt], Q[mt], 0, 0, 0); } } while (0)
#define LD_K(G, s2_) do { _Pragma("unroll") for (int kt = 0; kt < 8; ++kt) { const int xr_ = (8 * kt + (fr >> 1)) & 15; G[kt] = *(const LAS bf16x8*)(Bk + offk[kt] + (((p128 | (4 * (s2_) + fq)) ^ xr_) << 4)); } } while (0)
#define SCHED_() __builtin_amdgcn_sched_barrier(0)
        bf16x8 g0[8], g1[8];
        LD_WQ(g0, 0);
        bf16x8 SB[4];
#pragma unroll
        for (int s = 0; s < 4; ++s) SB[s] = pack_b(S[2 * s], S[2 * s + 1]);
        f32x4 V[4], Q[4];
#pragma unroll
        for (int mt = 0; mt < 4; ++mt) { V[mt] = (f32x4){0.f, 0.f, 0.f, 0.f}; Q[mt] = (f32x4){0.f, 0.f, 0.f, 0.f}; }
        SCHED_(); LD_WQ(g1, 1); SCHED_(); MM_WQ(g0, 0); SCHED_();
        LD_WQ(g0, 2); SCHED_(); MM_WQ(g1, 1); SCHED_();
        LD_WQ(g1, 3); SCHED_(); MM_WQ(g0, 2); SCHED_();
#pragma unroll
        for (int s2 = 0; s2 < 2; ++s2)
#pragma unroll
            for (int mt = 0; mt < 4; ++mt) { const int xr = (8 * mt + (fr >> 1)) & 15; g0[s2 * 4 + mt] = *(const LAS bf16x8*)(Ba + offa[mt] + (((p128 | (4 * s2 + fq)) ^ xr) << 4)); }
        SCHED_(); MM_WQ(g1, 3); SCHED_();
        LD_K(g1, 0); SCHED_();
        {
            float uu[16]; { float t[8]; unpack8(u0, t);
#pragma unroll
                for (int e = 0; e < 8; ++e) uu[e] = t[e]; unpack8(u1, t);
#pragma unroll
                for (int e = 0; e < 8; ++e) uu[8 + e] = t[e]; }
#pragma unroll
            for (int mt = 0; mt < 4; ++mt)
#pragma unroll
                for (int r = 0; r < 4; ++r) V[mt][r] = uu[mt * 4 + r] - V[mt][r];
        }
        bf16x8 VB[2];
#pragma unroll
        for (int s2 = 0; s2 < 2; ++s2) VB[s2] = pack_b(V[2 * s2], V[2 * s2 + 1]);
#pragma unroll
        for (int kt = 0; kt < 8; ++kt) S[kt] = S[kt] * egl;
        SCHED_();
#pragma unroll
        for (int s2 = 0; s2 < 2; ++s2)
#pragma unroll
            for (int mt = 0; mt < 4; ++mt) Q[mt] = __builtin_amdgcn_mfma_f32_16x16x32_bf16(VB[s2], g0[s2 * 4 + mt], Q[mt], 0, 0, 0);
        SCHED_(); LD_K(g0, 1); SCHED_();
#pragma unroll
        for (int kt = 0; kt < 8; ++kt) S[kt] = __builtin_amdgcn_mfma_f32_16x16x32_bf16(g1[kt], VB[0], S[kt], 0, 0, 0);
        SCHED_();
#pragma unroll
        for (int kt = 0; kt < 8; ++kt) S[kt] = __builtin_amdgcn_mfma_f32_16x16x32_bf16(g0[kt], VB[1], S[kt], 0, 0, 0);
        SCHED_();
#undef LD_WQ
#undef MM_WQ
#undef LD_K
#undef SCHED_
#pragma unroll
        for (int mt = 0; mt < 4; ++mt) {
            const int i = 16 * mt + fr; const int tok = b * SEQ + n * CH + (d ? 63 - i : i);
            u32x2 w2; w2.x = cvt_pk_bf16(Q[mt][0], Q[mt][1]); w2.y = cvt_pk_bf16(Q[mt][2], Q[mt][3]);
            *(GAS u32x2*)(O + (size_t)tok * MIXW + h * HD + slice * 16 + 4 * fq) = w2;
        }
        SCAN_BAR();
    }
}

constexpr int MQ_OFF = 0, MK_OFF = 9216, MV_OFF = 18432, MQK_OFF = 35840, MVEC_OFF = 52480;
constexpr int MQROW = 144;
#ifndef MLREP_1
#define MLREP_1 1
#endif
#ifndef MLREP_2
#define MLREP_2 1
#endif
#ifndef MLREP_3
#define MLREP_3 1
#endif
#ifndef MLREP_4
#define MLREP_4 1
#endif
#ifndef POOLREP
#define POOLREP 1
#endif
__device__ __forceinline__ void ml_prep(const Frame& F, int l) {
    LAS unsigned char* L = F.lds;
    const int lane = F.lane, wave = F.wave, tid = F.tid;
    const GAS bf16* PQ = (const GAS bf16*)(F.ws + WS_PMQ); const GAS bf16* PK = (const GAS bf16*)(F.ws + WS_PMK); const GAS bf16* PV = (const GAS bf16*)(F.ws + WS_PMV);
    const GAS float* SG = (const GAS float*)(F.ws + WS_SG);
    const GAS float* gbias = inp(F, I_ML_GATE_B) + l * 16;
    u32x4 pq, pk, pv0, pv1; float pip = 0.f, pfp = 0.f;
#define ML_PF(item_) do { const int it_ = (item_) < NB * NHEAD * NCH ? (item_) : F.wg; const int b_ = it_ >> 9, h_ = (it_ >> 7) & 3, n_ = it_ & 127; const int t0_ = b_ * SEQ + n_ * CH; \
        const int row_ = tid >> 3, c8_ = tid & 7; \
        pq = *(const GAS u32x4*)(PQ + (size_t)(t0_ + row_) * 256 + h_ * 64 + 8 * c8_); pk = *(const GAS u32x4*)(PK + (size_t)(t0_ + row_) * 256 + h_ * 64 + 8 * c8_); \
        pv0 = *(const GAS u32x4*)(PV + (size_t)(t0_ + (tid >> 4)) * 512 + h_ * 128 + 8 * (tid & 15)); pv1 = *(const GAS u32x4*)(PV + (size_t)(t0_ + 32 + (tid >> 4)) * 512 + h_ * 128 + 8 * (tid & 15)); \
        if (wave < 2) { const int ti_ = wave ? 63 - lane : lane; pip = SG[(size_t)(t0_ + ti_) * 32 + 16 + wave * 4 + h_]; pfp = SG[(size_t)(t0_ + ti_) * 32 + 24 + wave * 4 + h_]; } } while (0)
    ML_PF(F.wg);
    for (int item = F.wg; item < NB * NHEAD * NCH; item += F.G) {
        const int b = item >> 9, h = (item >> 7) & 3, n = item & 127;
        const int t0 = b * SEQ + n * CH;
        float ip_raw = pip, fp_raw = pfp;
        for (int rep1 = 0; rep1 < MLREP_1; ++rep1) {
        {
            const int row = tid >> 3, c8 = tid & 7;
            u32x4 k = pk;
            { float f[8]; unpack8(k, f); k.x = pk2(f[0] * 0.125f, f[1] * 0.125f); k.y = pk2(f[2] * 0.125f, f[3] * 0.125f); k.z = pk2(f[4] * 0.125f, f[5] * 0.125f); k.w = pk2(f[6] * 0.125f, f[7] * 0.125f); }
            *(LAS u32x4*)(L + MQ_OFF + row * MQROW + 16 * c8) = pq;
            *(LAS u32x4*)(L + MK_OFF + row * MQROW + 16 * c8) = k;
            *(LAS u32x4*)(L + MV_OFF + (tid >> 4) * QROW + 16 * (tid & 15)) = pv0;
            *(LAS u32x4*)(L + MV_OFF + (32 + (tid >> 4)) * QROW + 16 * (tid & 15)) = pv1;
            ML_PF(item + F.G);
        }
        PREP_BAR();
        }
        for (int rep2 = 0; rep2 < MLREP_2; ++rep2) {
        {
            const int fr = lane & 15, fq = lane >> 4;
#pragma unroll
            for (int tt = 0; tt < 2; ++tt) {
                const int t = 2 * wave + tt, mt = t >> 2, nt = t & 3;
                f32x4 aq = (f32x4){0.f, 0.f, 0.f, 0.f};
#pragma unroll
                for (int s2 = 0; s2 < 2; ++s2) {
                    const bf16x8 qa = *(const LAS bf16x8*)(L + MQ_OFF + (16 * mt + fr) * MQROW + 64 * s2 + 16 * fq);
                    const bf16x8 kb = *(const LAS bf16x8*)(L + MK_OFF + (16 * nt + fr) * MQROW + 64 * s2 + 16 * fq);
                    aq = __builtin_amdgcn_mfma_f32_16x16x32_bf16(qa, kb, aq, 0, 0, 0);
                }
#pragma unroll
                for (int r = 0; r < 4; ++r) *(LAS float*)(L + MQK_OFF + ((16 * mt + 4 * fq + r) * 65 + 16 * nt + fr) * 4) = aq[r];
            }
        }
        }
        for (int rep3 = 0; rep3 < MLREP_3; ++rep3) {
        if (wave < 2) {
            const int d = wave; const int ti = d ? 63 - lane : lane;
            const float ip = ip_raw + gbias[d * 4 + h];
            const float fp = fp_raw + gbias[8 + d * 4 + h];
            const float bc = wave_incl_scan(logsigmoidf_(fp), lane);
            const float bl = __shfl(bc, 63);
            const float lw = bl - bc + ip;
            const float am = wave_max(lw);
            const float wgt = expf(lw - am);
            const float ipb = ip - bc;
            const float dmax = bc + wave_incl_maxscan(ipb, lane);
            LAS float* vec = (LAS float*)(L + MVEC_OFF + d * 1024);
            vec[lane] = bc; vec[64 + lane] = dmax; vec[128 + lane] = wgt; vec[192 + lane] = ipb;
            GAS float* row = (GAS float*)(F.ws + WS_ML + ((size_t)item * 2 + d) * MLREC + ML_ROW);
            row[lane] = bc; row[64 + lane] = dmax; if (lane == 0) { row[128] = am; row[129] = bl; }
        }
        PREP_BAR();
        }
        for (int rep4 = 0; rep4 < MLREP_4; ++rep4) {
        {
            const LAS float* QKM = (const LAS float*)(L + MQK_OFF);
            for (int it = wave; it < 128; it += NWAVES) {
                const int d = it >> 6, i = it & 63, j = lane;
                const LAS float* vec = (const LAS float*)(L + MVEC_OFF + d * 1024);
                GAS unsigned char* rec = F.ws + WS_ML + ((size_t)item * 2 + d) * MLREC;
                const int ti = d ? 63 - i : i, tj = d ? 63 - j : j;
                const float sv = (j <= i) ? QKM[ti * 65 + tj] * fexp(fminf(vec[i] + vec[192 + j] - vec[64 + i], 0.f)) : 0.f;
                ((GAS bf16*)(rec + ML_ST))[i * 64 + j] = (bf16)f2bf(sv);
                ((GAS bf16*)(rec + ML_Q))[i * 64 + j] = *(const LAS unsigned short*)(L + MQ_OFF + ti * MQROW + 2 * ((j & ~31) + sigma32(j & 31)));
                const float kv = bf2f(*(const LAS unsigned short*)(L + MK_OFF + tj * MQROW + 2 * i));
                ((GAS bf16*)(rec + ML_KWT))[i * 64 + j] = (bf16)f2bf(kv * vec[128 + j]);
            }
            for (int it = wave; it < 36; it += NWAVES) {
                const int d = it / 18, q = it - 18 * d, slice = q >> 1, s2 = q & 1;
                GAS unsigned char* rec = F.ws + WS_ML + ((size_t)item * 2 + d) * MLREC;
                const int fr = lane & 15, fq = lane >> 4;
                unsigned short e8[8];
#pragma unroll
                for (int el = 0; el < 8; ++el) { const int j = 32 * s2 + 8 * fq + el; const int tj = d ? 63 - j : j;
                    e8[el] = (slice < 8) ? *(const LAS unsigned short*)(L + MV_OFF + tj * QROW + 2 * (16 * slice + fr)) : (unsigned short)0x3F80; }
                u32x4 w; w.x = e8[0] | ((unsigned)e8[1] << 16); w.y = e8[2] | ((unsigned)e8[3] << 16); w.z = e8[4] | ((unsigned)e8[5] << 16); w.w = e8[6] | ((unsigned)e8[7] << 16);
                *(GAS u32x4*)(rec + ML_VF + (((slice * 2 + s2) * 64 + lane) * 8) * 2) = w;
            }
        }
        PREP_BAR();
        }
    }
}
constexpr int MLBUF = 25600;
__device__ __forceinline__ void ml_scan(const Frame& F) {
    if (F.wg >= 64) return;
    const int xcd = F.wg & 7, idx = F.wg >> 3;
    const int chain = xcd * 4 + (idx >> 1), hf = idx & 1;
    const int b = chain >> 3, h = (chain >> 1) & 3, d = chain & 1;
    const int lane = F.lane, fr = lane & 15, fq = lane >> 4, wave = F.wave;
    LAS unsigned char* L = F.lds;
    const GAS unsigned char* recbase = F.ws + WS_ML;
    const int itembase = (b * NHEAD + h) * NCH;
    if (wave >= 5) {
        const int tl = F.tid - 320;
        u32x4 ra[9], rb[9]; int woff[9], goff[9];
#pragma unroll
        for (int i = 0; i < 9; ++i) { const int q = tl + 192 * i;
            if (q < 1536) { const int qq = q & 511; woff[i] = (q >> 9) * 8192 + swz128(qq >> 3, qq & 7); goff[i] = q; }
            else if (q < 1600) { woff[i] = 24576 + (q - 1536) * 16; goff[i] = 2688 + (q - 1536); }
            else { woff[i] = -1; goff[i] = 0; } }
#define ML_LOAD(R, step_) do { const int st_ = (step_) < NCH ? (step_) : NCH - 1; const int n_ = d ? (NCH - 1 - st_) : st_; \
        const GAS u32x4* src_ = (const GAS u32x4*)(recbase + ((size_t)(itembase + n_) * 2 + d) * MLREC); \
        _Pragma("unroll") for (int i = 0; i < 9; ++i) R[i] = src_[goff[i]]; } while (0)
#define ML_WRITE(R, bufoff_) do { _Pragma("unroll") for (int i = 0; i < 9; ++i) if (woff[i] >= 0) *(LAS u32x4*)(L + (bufoff_) + woff[i]) = R[i]; } while (0)
        ML_LOAD(ra, 0); ML_LOAD(rb, 1);
        ML_WRITE(ra, 0);
        SCAN_BAR();
        for (int s = 0; s < NCH; s += 2) {
            ML_LOAD(ra, s + 2); ML_WRITE(rb, MLBUF); SCAN_BAR();
            ML_LOAD(rb, s + 3); ML_WRITE(ra, 0);     SCAN_BAR();
        }
#undef ML_LOAD
#undef ML_WRITE
        return;
    }
    const int slice = (wave < 4) ? hf * 4 + wave : 8;
    const bool active = (wave < 4) || (hf == 1);
    GAS bf16* NUM = (GAS bf16*)(F.ws + (d ? WS_NUMB : WS_NUMF)); GAS float* DEN = (GAS float*)(F.ws + WS_DEN);
    f32x4 C[4];
#pragma unroll
    for (int k = 0; k < 4; ++k) C[k] = (f32x4){0.f, 0.f, 0.f, 0.f};
    float m = 0.f;
    int offr[4];
#pragma unroll
    for (int t = 0; t < 4; ++t) offr[t] = ((16 * t + fr) >> 1) * 256;
    const int p128 = (fr & 1) << 3;
    bf16x8 vc0, vc1, vn0, vn1;
#define ML_VFETCH(A0, A1, step_) do { const int st_ = (step_) < NCH ? (step_) : NCH - 1; const int nn_ = d ? (NCH - 1 - st_) : st_; \
        const GAS bf16* Vf_ = (const GAS bf16*)(recbase + ((size_t)(itembase + nn_) * 2 + d) * MLREC + ML_VF); \
        A0 = *(const GAS bf16x8*)(Vf_ + ((slice * 2 + 0) * 64 + lane) * 8); A1 = *(const GAS bf16x8*)(Vf_ + ((slice * 2 + 1) * 64 + lane) * 8); } while (0)
    ML_VFETCH(vc0, vc1, 0); ML_VFETCH(vn0, vn1, 1);
    SCAN_BAR();
    for (int step = 0; step < NCH; ++step) {
        const int n = d ? (NCH - 1 - step) : step;
        const int bufoff = (step & 1) ? MLBUF : 0;
        bf16x8 VF[2]; VF[0] = vc0; VF[1] = vc1;
        vc0 = vn0; vc1 = vn1;
        ML_VFETCH(vn0, vn1, step + 2);
        if (active) {
        const LAS unsigned char* Bq = L + bufoff; const LAS unsigned char* Bs = Bq + 8192; const LAS unsigned char* Bk = Bq + 16384; const LAS float* row = (const LAS float*)(Bq + 24576);
        const float am = row[128], bl = row[129];
        bf16x8 CB[2];
#pragma unroll
        for (int s = 0; s < 2; ++s) CB[s] = pack_b(C[2 * s], C[2 * s + 1]);
        bf16x8 fq_[8], fs_[8], fk_[8];
#pragma unroll
        for (int s = 0; s < 2; ++s)
#pragma unroll
            for (int mt = 0; mt < 4; ++mt) { const int xr = (8 * mt + (fr >> 1)) & 15; const int o = offr[mt] + (((p128 | (4 * s + fq)) ^ xr) << 4);
                fq_[s * 4 + mt] = *(const LAS bf16x8*)(Bq + o); fs_[s * 4 + mt] = *(const LAS bf16x8*)(Bs + o); fk_[s * 4 + mt] = *(const LAS bf16x8*)(Bk + o); }
        f32x4 QC[4], SV[4], KV[4];
#pragma unroll
        for (int mt = 0; mt < 4; ++mt) { QC[mt] = (f32x4){0.f, 0.f, 0.f, 0.f}; SV[mt] = (f32x4){0.f, 0.f, 0.f, 0.f}; KV[mt] = (f32x4){0.f, 0.f, 0.f, 0.f}; }
#pragma unroll
        for (int s = 0; s < 2; ++s)
#pragma unroll
            for (int mt = 0; mt < 4; ++mt) {
                QC[mt] = __builtin_amdgcn_mfma_f32_16x16x32_bf16(CB[s], fq_[s * 4 + mt], QC[mt], 0, 0, 0);
                SV[mt] = __builtin_amdgcn_mfma_f32_16x16x32_bf16(VF[s], fs_[s * 4 + mt], SV[mt], 0, 0, 0);
                KV[mt] = __builtin_amdgcn_mfma_f32_16x16x32_bf16(fk_[s * 4 + mt], VF[s], KV[mt], 0, 0, 0);
            }
#pragma unroll
        for (int mt = 0; mt < 4; ++mt) {
            const int i = 16 * mt + fr; const int tok = b * SEQ + n * CH + (d ? 63 - i : i);
            const float bci = row[i], dmi = row[64 + i];
            const float il = bci + m, mo = fmaxf(il, dmi);
            const float inter = fexp(il - mo), e2 = fexp(dmi - mo);
            const f32x4 res = QC[mt] * inter + SV[mt] * e2;
            if (slice < 8) { u32x2 w2; w2.x = cvt_pk_bf16(res[0], res[1]); w2.y = cvt_pk_bf16(res[2], res[3]); *(GAS u32x2*)(NUM + (size_t)tok * MIXW + h * HD + slice * 16 + 4 * fq) = w2; }
            else if (fq == 0) DEN[(size_t)tok * 8 + h * 2 + d] = fmaxf(fabsf(res[0]), fexp(-mo));
        }
        const float mn = fmaxf(bl + m, am), sp = fexp(bl + m - mn), sc = fexp(am - mn);
#pragma unroll
        for (int kt = 0; kt < 4; ++kt) C[kt] = C[kt] * sp + KV[kt] * sc;
        m = mn;
        }
        SCAN_BAR();
    }
}

template <int H>
__device__ __forceinline__ void pool_block(const GAS bf16* U, GAS bf16* Y, int t0, int g, int lane) {
    constexpr int NR = 32 + 2 * H;
    const int sp0 = t0 & (SEQ - 1);
    float x0[NR], x1[NR];
#pragma unroll
    for (int r = 0; r < NR; ++r) {
        const int sp = sp0 - H + r; const bool ok = (sp >= 0 && sp < SEQ);
        const unsigned u = ok ? *(const GAS unsigned*)(U + (size_t)(t0 - H + r) * MIXW + 128 * g + 2 * lane) : 0u;
        x0[r] = bf2f(u & 0xffffu); x1[r] = bf2f(u >> 16);
    }
    float s0 = 0.f, s1 = 0.f;
#pragma unroll
    for (int r = 0; r < 2 * H; ++r) { s0 += x0[r]; s1 += x1[r]; }
#pragma unroll
    for (int t = 0; t < 32; ++t) {
        const int sp = sp0 + t; const int cnt = min(sp + H, SEQ) - max(sp - H, 0);
        const float inv = 1.0f / (float)cnt;
        *(GAS unsigned*)(Y + (size_t)(t0 + t) * MIXW + 128 * g + 2 * lane) = cvt_pk_bf16(s0 * inv - x0[t + H], s1 * inv - x1[t + H]);
        if (t < 31) { s0 += x0[t + 2 * H] - x0[t]; s1 += x1[t + 2 * H] - x1[t]; }
    }
}
__device__ __forceinline__ void pool_phase(const Frame& F) {
    const GAS bf16* U = (const GAS bf16*)(F.ws + WS_PPOOL); GAS bf16* Y = (GAS bf16*)(F.ws + WS_YP);
    const int gw = F.wg * NWAVES + F.wave, NGW = F.G * NWAVES, lane = F.lane;
    for (int prep = 0; prep < POOLREP; ++prep)
    for (int task = gw; task < (T / 32) * 4; task += NGW) {
        const int g = task & 3, t0 = (task >> 2) * 32;
        if (g == 0) pool_block<1>(U, Y, t0, g, lane); else if (g == 1) pool_block<2>(U, Y, t0, g, lane); else if (g == 2) pool_block<4>(U, Y, t0, g, lane); else pool_block<8>(U, Y, t0, g, lane);
    }
}

__device__ __forceinline__ void norm_phase(const Frame& F, int l, bool dummy, const int which, const int wg0, const int nwg) {
    const GAS bf16* OF = (const GAS bf16*)(F.ws + WS_OF); const GAS bf16* OB = (const GAS bf16*)(F.ws + WS_OB);
    const GAS bf16* NF = (const GAS bf16*)(F.ws + WS_NUMF); const GAS bf16* NBk = (const GAS bf16*)(F.ws + WS_NUMB); const GAS float* DEN = (const GAS float*)(F.ws + WS_DEN);
    GAS bf16* Z = (GAS bf16*)(F.ws + WS_PZ); GAS bf16* MO = (GAS bf16*)(F.ws + WS_PMO);
    GAS bf16* ZO = dummy ? (GAS bf16*)(F.ws + WS_GATE) : Z; GAS bf16* MOO = dummy ? (GAS bf16*)(F.ws + WS_GATE + 32 * MiB) : MO;
    const int gw = (F.wg - wg0) * NWAVES + F.wave, NGW = nwg * NWAVES, lane = F.lane, h = lane >> 4;
    float nw[8], mw[8];
#pragma unroll
    for (int e = 0; e < 8; ++e) { nw[e] = inp(F, I_DN_NORM)[l * MIXW + 8 * lane + e]; mw[e] = inp(F, I_ML_NORM)[l * MIXW + 8 * lane + e]; }
    for (int t = gw; t < T; t += NGW) {
        const size_t off = (size_t)t * MIXW + 8 * lane;
        if (which != 2) {
            float a[8], bq[8], z[8]; unpack8(*(const GAS u32x4*)(OF + off), a); unpack8(*(const GAS u32x4*)(OB + off), bq); unpack8(*(const GAS u32x4*)(Z + off), z);
            float ss = 0.f;
#pragma unroll
            for (int e = 0; e < 8; ++e) { a[e] += bq[e]; ss += a[e] * a[e]; }
            ss += __shfl_xor(ss, 1); ss += __shfl_xor(ss, 2); ss += __shfl_xor(ss, 4); ss += __shfl_xor(ss, 8);
            const float r = 1.0f / sqrtf(ss * (1.f / HD) + NORM_EPS);
            float o[8];
#pragma unroll
            for (int e = 0; e < 8; ++e) o[e] = a[e] * r * nw[e] * siluf_(z[e]);
            u32x4 w; w.x = pk2(o[0], o[1]); w.y = pk2(o[2], o[3]); w.z = pk2(o[4], o[5]); w.w = pk2(o[6], o[7]);
            *(GAS u32x4*)(ZO + off) = w;
        }
        if (which != 1) {
            float a[8], bq[8], g[8]; unpack8(*(const GAS u32x4*)(NF + off), a); unpack8(*(const GAS u32x4*)(NBk + off), bq); unpack8(*(const GAS u32x4*)(MO + off), g);
            const float df = 1.0f / DEN[(size_t)t * 8 + h * 2], db = 1.0f / DEN[(size_t)t * 8 + h * 2 + 1];
            float s = 0.f;
#pragma unroll
            for (int e = 0; e < 8; ++e) { a[e] = a[e] * df + bq[e] * db; s += a[e]; }
            s += __shfl_xor(s, 1); s += __shfl_xor(s, 2); s += __shfl_xor(s, 4); s += __shfl_xor(s, 8);
            const float mean = s * (1.f / HD); float ss = 0.f;
#pragma unroll
            for (int e = 0; e < 8; ++e) { a[e] -= mean; ss += a[e] * a[e]; }
            ss += __shfl_xor(ss, 1); ss += __shfl_xor(ss, 2); ss += __shfl_xor(ss, 4); ss += __shfl_xor(ss, 8);
            const float r = 1.0f / sqrtf(ss * (1.f / HD) + NORM_EPS);
            float o[8];
#pragma unroll
            for (int e = 0; e < 8; ++e) o[e] = a[e] * r * mw[e] * sigmoidf_(g[e]);
            u32x4 w; w.x = pk2(o[0], o[1]); w.y = pk2(o[2], o[3]); w.z = pk2(o[4], o[5]); w.w = pk2(o[6], o[7]);
            *(GAS u32x4*)(MOO + off) = w;
        }
    }
}

__device__ __forceinline__ void moe_tables(const Frame& F) {
    LAS int* cnt = (LAS int*)(F.lds + LHIST_OFF + 128); LAS int* pstart = (LAS int*)(F.lds + LHIST_OFF + 256); LAS int* mybase = (LAS int*)(F.lds + LHIST_OFF + 384);
    LAS int* pe = (LAS int*)(F.lds + LPE_OFF);
    const GAS int* hist = (const GAS int*)(F.ws + WS_HIST);
    if (F.tid < 32) { cnt[F.tid] = 0; mybase[F.tid] = 0; }
    __syncthreads();
    { const int e = F.tid & 31, part = F.tid >> 5; int tot = 0, base = 0;
      for (int q = 0; q < 16; ++q) { const int w = part * 16 + q; const int v = hist[w * 32 + e]; tot += v; base += v * min(max(F.wg - w, 0), 1); }
      __hip_atomic_fetch_add(cnt + e, tot, __ATOMIC_RELAXED, __HIP_MEMORY_SCOPE_WORKGROUP); __hip_atomic_fetch_add(mybase + e, base, __ATOMIC_RELAXED, __HIP_MEMORY_SCOPE_WORKGROUP); }
    __syncthreads();
    if (F.tid == 0) { int acc = 0, p = 0; for (int e = 0; e < NEXP; ++e) { pstart[e] = acc; const int np = (cnt[e] + 255) >> 8; for (int q = 0; q < np; ++q) pe[p++] = e; acc += np * 256; } pe[319] = p; }
    __syncthreads();
}
__device__ __forceinline__ void moe_dispatch(const Frame& F) {
    moe_tables(F);
    LAS int* pstart = (LAS int*)(F.lds + LHIST_OFF + 256); LAS int* mybase = (LAS int*)(F.lds + LHIST_OFF + 384);
    LAS int* lpos = (LAS int*)(F.lds);
    LAS int* le = (LAS int*)(F.lds + 1024);
    const GAS int* eid = (const GAS int*)(F.ws + WS_EID); const GAS float* ew = (const GAS float*)(F.ws + WS_EW);
    GAS int* pos = (GAS int*)(F.ws + WS_POS); GAS float* roww = (GAS float*)(F.ws + WS_ROWW);
    const int rows_per_wg = T / F.G, row0 = F.wg * rows_per_wg;
    int my_e = 0; float my_w = 0.f;
    if (F.tid < 256) { my_e = eid[2 * row0 + F.tid]; my_w = ew[2 * row0 + F.tid]; le[F.tid] = my_e; }
    __syncthreads();
    if (F.tid < 256) {
        int rank = 0;
        for (int a = 0; a < F.tid; ++a) rank += (le[a] == my_e) ? 1 : 0;
        const int p = pstart[my_e] + mybase[my_e] + rank;
        lpos[F.tid] = p; pos[2 * row0 + F.tid] = p; roww[p] = my_w; ((GAS int*)(F.ws + WS_ROWTOK))[p] = row0 + (F.tid >> 1);
    }
    __syncthreads();
    if (F.wg == 0 && F.tid < 32) { LAS int* cnt = (LAS int*)(F.lds + LHIST_OFF + 128); const int e = F.tid; const int c0 = cnt[e], pc = (c0 + 255) & ~255;
        GAS int* rt = (GAS int*)(F.ws + WS_ROWTOK); for (int q = c0; q < pc; ++q) rt[pstart[e] + q] = 0; }
    __syncthreads();
}

constexpr int NPHASE = 1 + 15 * DEPTH;
#ifndef PHM
#define PHM 0xFFFF
#endif
#define PHON(b) ((PHM >> (b)) & 1)
#ifndef REPEAT_PHASE
#define REPEAT_PHASE -1
#endif
#define NREP(k) (((k) == REPEAT_PHASE) ? 2 : 1)
__global__ void __launch_bounds__(NWAVES * 64, 2) mega_fwd(Args args) {
    extern __shared__ __attribute__((aligned(16))) unsigned char lds_raw[];
    LAS unsigned char* lds = (LAS unsigned char*)lds_raw;
    const int wave = __builtin_amdgcn_readfirstlane((int)threadIdx.x >> 6);
    for (int u = threadIdx.x; u < (LDS_BYTES - RING_BYTES) / 4; u += NWAVES * 64) ((LAS unsigned*)(lds + RING_BYTES))[u] = 0u;
    __syncthreads();
    if (threadIdx.x == 0) { LAS unsigned long long* ap = (LAS unsigned long long*)(lds + LARG_OFF);
#pragma unroll
        for (int i = 0; i < 23; ++i) ap[i] = (unsigned long long)args.in[i];
        ap[23] = (unsigned long long)args.out; ap[24] = (unsigned long long)args.ws; }
    __syncthreads();
    const int lo = args.ph_lo, hi = args.ph_hi;
    if (hi - lo > 1) { const XcdBarrier b0 = xcd_barrier_post((unsigned*)(args.ws + WS_CTL) + CW_BAR, (volatile LAS unsigned*)(lds + MISC_OFF) + 8);
        if (threadIdx.x == 0) ((volatile LAS unsigned*)(lds + MISC_OFF))[10] = b0.x; }
    __syncthreads();
#ifdef DIAG
    if (threadIdx.x == 0 && blockIdx.x == 0 && lo == 0) ((unsigned long long*)(args.ws + WS_CTL + 1024))[0] = __builtin_amdgcn_s_memrealtime();
#endif
    int ph = lo, rep = 0;
#pragma unroll 1
    while (ph < hi) {
        const Frame F = fresh(lds, wave);
        const bool DRY = (REPEAT_PHASE >= 0) && (rep == 0) && (((ph >= 1) ? ((ph - 1) % 15) : 15) == REPEAT_PHASE);
        const int l = (ph >= 1) ? (ph - 1) / 15 : 0;
        const int k = (ph >= 1) ? (ph - 1) - 15 * l : 15;
        if (PHON(15) && k == 15) {
            wprep_mixer(F, 0);
            __syncthreads();
            ln_phase<0>(F, inp(F, I_LN_IN_G), inp(F, I_LN_IN_B), inp(F, I_W_IN), DIN, true, true, DRY);
        } else if (PHON(0) && k == 0) {
            pg8::StaticOrder S; S.init(F.ws + WS_HB, F.ws + WS_WIN, T, 1536, D, F.G, F.wg);
            EpiG1a E{(GAS bf16*)(F.ws + WS_PQKV)};
            pg8::gemm_phase<EpiG1a, pg8::StaticOrder>(F.lds, F.tid, D, S, E);
        } else if (PHON(1) && k == 1) { dn_prep(F, l);
        } else if (PHON(2) && k == 2) { if (F.wg < 128) dn_scan(F); else wprep_moe(F, l, 128, 128);
        } else if (PHON(3) && k == 3) {
            pg8::StaticOrder S; S.init(F.ws + WS_HB, F.ws + WS_WIN + (size_t)1536 * D * 2, T, 2560, D, F.G, F.wg);
            EpiG1b E{F.ws};
            pg8::gemm_phase<EpiG1b, pg8::StaticOrder>(F.lds, F.tid, D, S, E);
        } else if (PHON(4) && k == 4) { pool_phase(F); ml_prep(F, l);
        } else if (PHON(5) && k == 5) { if (F.wg < 64) ml_scan(F); else norm_phase(F, l, false, 1, 64, 192);
        } else if (PHON(6) && k == 6) { norm_phase(F, l, DRY, 2, 0, 256);
        } else if (PHON(7) && k == 7) {
            pg8::StaticOrder S; S.init(F.ws + WS_HB, F.ws + WS_WGATE, T, 3072, D, F.G, F.wg);
            EpiGate E{(GAS bf16*)(F.ws + WS_GATE)};
            pg8::gemm_phase<EpiGate, pg8::StaticOrder>(F.lds, F.tid, D, S, E);
        } else if (PHON(8) && k == 8) {
            MergeOrder S; S.Y[0] = (const GAS char*)(F.ws + WS_PZ); S.Y[1] = (const GAS char*)(F.ws + WS_YP); S.Y[2] = (const GAS char*)(F.ws + WS_PMO); S.W = (const GAS char*)(F.ws + WS_WBR); S.G = F.G; S.c = F.wg;
            EpiMerge E{(const GAS bf16*)(F.ws + WS_GATE), (GAS bf16*)(F.ws + WS_MRGP), (GAS bf16*)(F.ws + WS_FIN)};
            pg8::gemm_phase<EpiMerge, MergeOrder>(F.lds, F.tid, MIXW, S, E);
        } else if (PHON(9) && k == 9) {
            pg8::StaticOrder S; S.init(F.ws + WS_FIN, F.ws + WS_WOUT, T, D, D, F.G, F.wg);
            EpiOut E{(const GAS bf16*)(F.ws + WS_HB), DRY ? (GAS bf16*)(F.ws + WS_R2) : (GAS bf16*)F.out};
            pg8::gemm_phase<EpiOut, pg8::StaticOrder>(F.lds, F.tid, D, S, E);
        } else if (PHON(10) && k == 10) {
            ln_phase<1>(F, inp(F, I_LN_MIX_G) + l * D, inp(F, I_LN_MIX_B) + l * D, inp(F, I_ROUTER_W), 32, true, true, DRY);
        } else if (PHON(11) && k == 11) { moe_dispatch(F);
        } else if (PHON(12) && k == 12) {
            moe_tables(F);
            MoeOrder<D, true> S; S.rowtok = (const GAS int*)(F.ws + WS_ROWTOK); S.A = (const GAS char*)(F.ws + WS_HB); S.W = (const GAS char*)((GAS unsigned char*)F.out + 64 * MiB); S.pe = (const LAS int*)(F.lds + LPE_OFF); S.c = F.wg; S.NP = __builtin_amdgcn_readfirstlane(S.pe[319]);
            EpiMoe1 E{(GAS bf16*)(F.ws + WS_ACT)};
            pg8::gemm_phase<EpiMoe1, MoeOrder<D, true>>(F.lds, F.tid, D, S, E);
        } else if (PHON(13) && k == 13) {
            moe_tables(F);
            MoeOrder<DEXP, false> S; S.rowtok = nullptr; S.A = (const GAS char*)(F.ws + WS_ACT); S.W = (const GAS char*)(F.ws + WS_W2); S.pe = (const LAS int*)(F.lds + LPE_OFF); S.c = F.wg; S.NP = __builtin_amdgcn_readfirstlane(S.pe[319]);
            EpiMoe2 E{(GAS bf16*)(F.ws + WS_YROWS), (const GAS float*)(F.ws + WS_ROWW)};
            pg8::gemm_phase<EpiMoe2, MoeOrder<DEXP, false>>(F.lds, F.tid, DEXP, S, E);
        } else if (PHON(14)) {
            const bool last = (l == DEPTH - 1);
            if (!last) { wprep_mixer(F, l + 1); __syncthreads(); }
            ln_phase<2>(F, inp(F, I_LN_FFN_G) + l * D, inp(F, I_LN_FFN_B) + l * D, inp(F, I_W_IN) + (size_t)(last ? l : l + 1) * D * DIN, DIN, !last, !last, DRY);
        }
        const bool again = (k == REPEAT_PHASE) && (rep == 0);
        if (again) rep = 1; else { rep = 0; ++ph; }
        if (ph < hi) { XcdBarrier bar; bar.bar = (unsigned*)(unsigned char*)(F.ws + WS_CTL) + CW_BAR; bar.st = (volatile LAS unsigned*)(F.lds + MISC_OFF) + 8; bar.x = __builtin_amdgcn_readfirstlane(bar.st[2]); xcd_barrier(bar, F.tid); }
#ifdef DIAG
        if (!again && F.tid == 0 && F.wg == 0) ((unsigned long long*)(F.ws + WS_CTL + 1024))[ph] = __builtin_amdgcn_s_memrealtime();
#endif
    }
}

#ifndef N_LAUNCH_MODE
#define N_LAUNCH_MODE 1
#endif
extern "C" void kernel_launch(void* const* d_in, const int* in_sizes, int n_in, void* d_out, int out_size, void* d_ws, size_t ws_size, hipStream_t stream) {
    static int grid = 0;
    if (grid == 0) {
        if (n_in != 23 || out_size != T * D || ws_size < WS_END) { fprintf(stderr, "kernel_launch: unexpected shapes (n_in %d out %d ws %zu)\n", n_in, out_size, ws_size); grid = -1; return; }
        int dev = 0, cus = 0, per_cu = 0;
        if (hipGetDevice(&dev) != hipSuccess || hipDeviceGetAttribute(&cus, hipDeviceAttributeMultiprocessorCount, dev) != hipSuccess) { grid = -1; return; }
        if (hipFuncSetAttribute((const void*)mega_fwd, hipFuncAttributeMaxDynamicSharedMemorySize, LDS_BYTES) != hipSuccess) { fprintf(stderr, "kernel_launch: hipFuncSetAttribute failed\n"); grid = -1; return; }
        (void)hipOccupancyMaxActiveBlocksPerMultiprocessor(&per_cu, (const void*)mega_fwd, NWAVES * 64, LDS_BYTES);
        (void)hipGetLastError();
        grid = cus;
        if (grid != 256) { fprintf(stderr, "kernel_launch: built for 256 CUs, got %d\n", cus); grid = -1; return; }
    }
    if (grid < 0) return;
    (void)hipMemsetAsync((char*)d_ws + WS_CTL, 0, CTL_ZERO_BYTES, stream);
    Args a{};
    for (int i = 0; i < 23; ++i) a.in[i] = (const float*)d_in[i];
    a.out = (float*)d_out; a.ws = (unsigned char*)d_ws;
#if defined(DIAG) && DIAG >= 100
    {
        a.ph_lo = 0; a.ph_hi = NPHASE;
        hipLaunchKernelGGL(mega_fwd, dim3(grid), dim3(NWAVES * 64), LDS_BYTES, stream, a);
        hipLaunchKernelGGL(diag_fill_t, dim3(1024), dim3(256), 0, stream, (float*)d_out, (unsigned char*)d_ws, out_size, (int)(DIAG - 100));
    }
#elif defined(DIAG)
    {
        const int his[12] = {0, 2, 3, 6, 15, 10, 6, 9, 2, 2, 5, 9};
        const int grids[12] = {0, 64, 2, 2, 16, 64, 64, 64, 64, 64, 64, 64}, blocks[12] = {0, 256, 128, 128, 256, 256, 256, 256, 256, 256, 256, 256};
        a.ph_lo = 0; a.ph_hi = his[DIAG];
        hipLaunchKernelGGL(mega_fwd, dim3(grid), dim3(NWAVES * 64), LDS_BYTES, stream, a);
        static int once = 0; if (!once) { once = 1; (void)hipFuncSetAttribute((const void*)diag_kernel, hipFuncAttributeMaxDynamicSharedMemorySize, 81920); }
        DArgs da{}; for (int i = 0; i < 23; ++i) da.in[i] = (const float*)d_in[i]; da.out = (float*)d_out; da.ws = (unsigned char*)d_ws; da.mode = DIAG; da.pad = 0;
        hipLaunchKernelGGL(diag_kernel, dim3(grids[DIAG]), dim3(blocks[DIAG]), 81920, stream, da);
        if (DIAG == 2 || DIAG == 3) {
            a.ph_lo = his[DIAG]; a.ph_hi = his[DIAG] + 1;
            hipLaunchKernelGGL(mega_fwd, dim3(grid), dim3(NWAVES * 64), LDS_BYTES, stream, a);
            da.mode = DIAG + 10;
            hipLaunchKernelGGL(diag_kernel, dim3(2), dim3(128), 81920, stream, da);
        }
        hipLaunchKernelGGL(diag_fill, dim3(1024), dim3(256), 0, stream, (float*)d_out, (unsigned char*)d_ws, out_size);
    }
#elif N_LAUNCH_MODE == 1
    a.ph_lo = 0; a.ph_hi = NPHASE;
    hipLaunchKernelGGL(mega_fwd, dim3(grid), dim3(NWAVES * 64), LDS_BYTES, stream, a);
#else
    for (int p = 0; p < NPHASE; ++p) { a.ph_lo = p; a.ph_hi = p + 1; hipLaunchKernelGGL(mega_fwd, dim3(grid), dim3(NWAVES * 64), LDS_BYTES, stream, a); }
#endif
}
```

```cpp
#include <hip/hip_runtime.h>
#include <cstdio>
#include <cstdint>

#define LAS __attribute__((address_space(3)))
#define GAS __attribute__((address_space(1)))
typedef unsigned short bf16;
typedef short bf16x8 __attribute__((ext_vector_type(8)));
typedef float f32x4 __attribute__((ext_vector_type(4)));
typedef float f32x2 __attribute__((ext_vector_type(2)));
typedef unsigned u32x4 __attribute__((ext_vector_type(4)));
typedef unsigned u32x2 __attribute__((ext_vector_type(2)));
#define RLX_AGENT __ATOMIC_RELAXED, __HIP_MEMORY_SCOPE_AGENT
#define LDS_WAIT() asm volatile("s_waitcnt lgkmcnt(0)" ::: "memory")
#define VM_WAIT() asm volatile("s_waitcnt vmcnt(0)" ::: "memory")

constexpr int NB = 4, SEQ = 8192, T = NB * SEQ, D = 1024, DEPTH = 2;
constexpr int DIN = 7200;
constexpr int MIXW = 512, NHEAD = 4, HD = 128, CH = 64, NCH = SEQ / CH;
constexpr int MLQK = 64;
constexpr int NEXP = 32, DEXP = 512;
constexpr float LN_EPS = 1e-5f, NORM_EPS = 1e-6f;
constexpr float ALPHA = 1.41421356237309515f;
constexpr int NWAVES = 8;
constexpr int NREC = NB * NHEAD * NCH * 2;

constexpr int C_QKV = 0, C_Z = 1536, C_A = 2048, C_B = 2056, C_POOL = 2064, C_MQ = 2576, C_MK = 2832, C_MV = 3088, C_MO = 3600, C_I = 4112, C_F = 4120, C_GATE = 4128;

constexpr size_t MiB = 1u << 20;
constexpr size_t WS_CTL = 0, CTL_ZERO_BYTES = 64 * 1024;
constexpr int CW_BAR = 4096;
constexpr size_t WS_HIST = 1 * MiB;
constexpr size_t WS_EID = WS_HIST + 64 * 1024;
constexpr size_t WS_EW = WS_EID + 256 * 1024;
constexpr size_t WS_POS = WS_EW + 256 * 1024;
constexpr size_t WS_ROWW = WS_POS + 256 * 1024;
constexpr size_t WS_GL = WS_ROWW + 512 * 1024;
constexpr size_t WS_ROWTOK = 3 * MiB;
constexpr size_t WS_WIN = 4 * MiB;
constexpr size_t WS_WGATE = 12 * MiB;
constexpr size_t WS_WBR = 18 * MiB;
constexpr size_t WS_WOUT = 21 * MiB;
constexpr size_t WS_HB = 24 * MiB;
constexpr size_t WS_SG = 88 * MiB;
constexpr size_t WS_DEN = 92 * MiB;
constexpr size_t WS_R1 = 93 * MiB;
constexpr size_t WS_PQKV = WS_R1;
constexpr size_t WS_OF = WS_R1, WS_OB = WS_R1 + 32 * MiB;
constexpr size_t WS_MRGP = WS_R1;
constexpr size_t WS_W13 = WS_R1, WS_W2 = WS_R1 + 64 * MiB;
constexpr size_t WS_R2 = 189 * MiB;
constexpr size_t DNREC = 73728;
constexpr size_t DN_W = 0, DN_QG = 16384, DN_KDT = 32768, DN_ATT = 49152, DN_UF = 57344;
constexpr size_t WS_PZ = 189 * MiB, WS_PPOOL = 221 * MiB, WS_PMQ = 253 * MiB, WS_PMK = 269 * MiB, WS_PMV = 285 * MiB, WS_PMO = 317 * MiB;
constexpr size_t WS_YP = 349 * MiB;
constexpr size_t WS_NUMF = 253 * MiB, WS_NUMB = 285 * MiB;
constexpr size_t WS_FIN = 253 * MiB;
constexpr size_t WS_ML = 381 * MiB;
constexpr size_t MLREC = 44032;
constexpr size_t ML_Q = 0, ML_ST = 8192, ML_KWT = 16384, ML_VF = 24576, ML_ROW = 43008;
constexpr size_t WS_GATE = 381 * MiB;
constexpr size_t WS_XS = 189 * MiB, WS_ACT = 333 * MiB, WS_YROWS = 405 * MiB;
constexpr size_t WS_END = 573 * MiB;
constexpr int MOE_ROWS = 73728;
static_assert(WS_ML + (size_t)NREC * MLREC <= WS_END + 15 * MiB, "ml records");
static_assert(WS_YROWS + (size_t)MOE_ROWS * 1024 * 2 <= WS_END, "moe rows");

constexpr int RING_BYTES = 131072;
constexpr int MISC_OFF = RING_BYTES + 320;
constexpr int LHIST_OFF = RING_BYTES + 1024;
constexpr int LPE_OFF = RING_BYTES + 2048;
constexpr int LARG_OFF = RING_BYTES + 4096;
constexpr int LDS_BYTES = 147456;

__device__ __forceinline__ float bf2f(unsigned b) { return __uint_as_float(b << 16); }
__device__ __forceinline__ unsigned f2bf(float f) { unsigned u = __float_as_uint(f); return (u + 0x7fffu + ((u >> 16) & 1u)) >> 16; }
__device__ __forceinline__ unsigned pk2(float lo, float hi) { return f2bf(lo) | (f2bf(hi) << 16); }
__device__ __forceinline__ float wave_sum(float v) {
    v += __int_as_float(__builtin_amdgcn_update_dpp(0, __float_as_int(v), 0xB1, 0xf, 0xf, true));
    v += __int_as_float(__builtin_amdgcn_update_dpp(0, __float_as_int(v), 0x4E, 0xf, 0xf, true));
    v += __int_as_float(__builtin_amdgcn_update_dpp(0, __float_as_int(v), 0x141, 0xf, 0xf, true));
    v += __int_as_float(__builtin_amdgcn_update_dpp(0, __float_as_int(v), 0x140, 0xf, 0xf, true));
    const int iv = __float_as_int(v);
    return (__int_as_float(__builtin_amdgcn_readlane(iv, 0)) + __int_as_float(__builtin_amdgcn_readlane(iv, 16))) + (__int_as_float(__builtin_amdgcn_readlane(iv, 32)) + __int_as_float(__builtin_amdgcn_readlane(iv, 48)));
}
__device__ __forceinline__ float wave_max(float v) {
    v = fmaxf(v, __int_as_float(__builtin_amdgcn_update_dpp(0, __float_as_int(v), 0xB1, 0xf, 0xf, true)));
    v = fmaxf(v, __int_as_float(__builtin_amdgcn_update_dpp(0, __float_as_int(v), 0x4E, 0xf, 0xf, true)));
    v = fmaxf(v, __int_as_float(__builtin_amdgcn_update_dpp(0, __float_as_int(v), 0x141, 0xf, 0xf, true)));
    v = fmaxf(v, __int_as_float(__builtin_amdgcn_update_dpp(0, __float_as_int(v), 0x140, 0xf, 0xf, true)));
    const int iv = __float_as_int(v);
    return fmaxf(fmaxf(__int_as_float(__builtin_amdgcn_readlane(iv, 0)), __int_as_float(__builtin_amdgcn_readlane(iv, 16))), fmaxf(__int_as_float(__builtin_amdgcn_readlane(iv, 32)), __int_as_float(__builtin_amdgcn_readlane(iv, 48))));
}
__device__ __forceinline__ float fexp(float x) { return __builtin_amdgcn_exp2f(x * 1.44269504089f); }
__device__ __forceinline__ float sigmoidf_(float x) { return 1.0f / (1.0f + expf(-x)); }
__device__ __forceinline__ float siluf_(float x) { return x / (1.0f + expf(-x)); }
__device__ __forceinline__ float softplusf_(float x) { return fmaxf(x, 0.f) + log1pf(expf(-fabsf(x))); }
__device__ __forceinline__ float logsigmoidf_(float x) { return fminf(x, 0.f) - log1pf(expf(-fabsf(x))); }
__host__ __device__ __forceinline__ int sigma32(int p) { const int fq = p >> 3, j = p & 7; return 16 * (j >> 2) + 4 * fq + (j & 3); }

#define XB_TMO      128
#define XB_XCNT(j)  (256  + 64 * (j))
#define XB_XSUB(j)  (1280 + 64 * (j))
#define XB_XGEN(j)  (2304 + 64 * (j))
#define XB_TOP      3328
#define XB_TOPGEN   3392
#define XCD_BAR_WORDS 3456
#define XB_SPIN_CAP (1u << 20)
__device__ __forceinline__ unsigned xb_ld(unsigned* p)              { return __hip_atomic_load(p, __ATOMIC_RELAXED, __HIP_MEMORY_SCOPE_AGENT); }
__device__ __forceinline__ unsigned xb_add(unsigned* p, unsigned v) { return __hip_atomic_fetch_add(p, v, __ATOMIC_RELAXED, __HIP_MEMORY_SCOPE_AGENT); }
__device__ __forceinline__ unsigned xb_xcc_id() { return (unsigned)__builtin_amdgcn_s_getreg((3 << 11) | 20) & 0xFu; }
#define XB_SPIN(cond, bar) do { unsigned _sp = 0; while (cond) { __builtin_amdgcn_s_sleep(1); \
    if ((++_sp & 255u) == 0u) { if (xb_ld(&(bar)[XB_TMO])) break; if (_sp > XB_SPIN_CAP) { atomicAdd(&(bar)[XB_TMO], 1u); break; } } } } while (0)
struct XcdBarrier { unsigned* bar; unsigned x; volatile LAS unsigned* st; };
__device__ __forceinline__ XcdBarrier xcd_barrier_post(unsigned* bar, volatile LAS unsigned* st) {
    XcdBarrier b; b.bar = bar; b.x = xb_xcc_id(); b.st = st;
    if (threadIdx.x == 0) (void)xb_add(&bar[XB_XCNT(b.x)], 1u);
    return b;
}
__device__ __forceinline__ void xcd_barrier_complete(unsigned* bar, unsigned x, unsigned& nloc, unsigned& nx) {
    const unsigned G = 256u;
    unsigned sum, cnt, mine, sp = 0u;
    for (;;) {
        sum = 0u; cnt = 0u; mine = 0u;
#pragma unroll
        for (unsigned j = 0; j < 16; ++j) { const unsigned c = xb_ld(&bar[XB_XCNT(j)]); sum += c; cnt += (c > 0u) ? 1u : 0u; mine = (j == x) ? c : mine; }
        if (sum == G) break;
        __builtin_amdgcn_s_sleep(1);
        if ((++sp & 255u) == 0u) { if (xb_ld(&bar[XB_TMO])) break; if (sp > XB_SPIN_CAP) { atomicAdd(&bar[XB_TMO], 1u); break; } }
    }
    nloc = mine > 0u ? mine : 1u; nx = cnt > 0u ? cnt : 1u;
}
__device__ __forceinline__ void xcd_barrier(const XcdBarrier& b, const int tid) {
    asm volatile("s_waitcnt vmcnt(0)" ::: "memory");
    __syncthreads();
    if (tid == 0) {
        unsigned* bar = b.bar;
        __builtin_amdgcn_s_waitcnt(0);
        unsigned nloc = b.st[0], nx = b.st[1];
        if (nloc == 0u) { xcd_barrier_complete(bar, b.x, nloc, nx); b.st[0] = nloc; b.st[1] = nx; }
        const unsigned old = xb_add(&bar[XB_XSUB(b.x)], 1u);
        const unsigned gen = old / nloc;
        if (old + 1u == (gen + 1u) * nloc) {
            __builtin_amdgcn_fence(__ATOMIC_RELEASE, "agent");
            asm volatile("s_waitcnt vmcnt(0)" ::: "memory");
            const unsigned og = xb_add(&bar[XB_TOP], 1u);
            const unsigned tg = og / nx;
            if (og + 1u == (tg + 1u) * nx) xb_add(&bar[XB_TOPGEN], 1u);
            else XB_SPIN(xb_ld(&bar[XB_TOPGEN]) == tg, bar);
            __builtin_amdgcn_fence(__ATOMIC_ACQUIRE, "agent");
            xb_add(&bar[XB_XGEN(b.x)], 1u);
            asm volatile("s_waitcnt vmcnt(0)" ::: "memory");
        } else {
            XB_SPIN(xb_ld(&bar[XB_XGEN(b.x)]) == gen, bar);
            __builtin_amdgcn_fence(__ATOMIC_ACQUIRE, "agent");
            asm volatile("s_waitcnt vmcnt(0)" ::: "memory");
        }
    }
    __syncthreads();
}

namespace pg8 {
constexpr int BM = 256, BK = 64, HALF = 128, HTB = HALF * BK * 2, STAGE_BYTES = 8 * HTB, NXCD = 8, WGM = 8;
__host__ __device__ __forceinline__ int lds_byte(int r, int c) { const int st = (r >> 4) * 2 + (c >> 5), rr = r & 15, cc = c & 31, ob = rr * 64 + cc * 2; return st * 1024 + (ob ^ (((ob >> 9) & 1) << 5)); }
__host__ __device__ __forceinline__ void stage_rc(int b, int& R, int& C) { const int st = b / 1024, sb = b % 1024, swz = sb ^ (((sb >> 9) & 1) << 5); R = (st >> 1) * 16 + swz / 64; C = (st & 1) * 32 + (swz % 64) / 2; }
__host__ __device__ __forceinline__ int perm32(int rho) { const int n = rho >> 4, i = rho & 15; return 8 * (i >> 2) + 4 * n + (i & 3); }

struct Unit { int pm, pn, aux; const GAS char* A; const GAS char* B; };

__device__ __forceinline__ void tile_of(int L, int nM, int nN, int& pm, int& pn) {
    const int nwg = nM * nN; int wgid = L;
    { const int q = nwg / NXCD, r = nwg % NXCD, xcd = wgid % NXCD, off = wgid / NXCD; wgid = (xcd < r ? xcd * (q + 1) : r * (q + 1) + (xcd - r) * q) + off; }
    const int nig = WGM * nN, gid = wgid / nig, fm = gid * WGM, gsz = (nM - fm) < WGM ? (nM - fm) : WGM;
    pm = fm + ((wgid % nig) % gsz); pn = (wgid % nig) / gsz;
}
struct StaticOrder {
    static constexpr bool GATHER = false;
    const GAS char* A; const GAS char* Bt; int nM, nN, nwg, G, c; size_t tstep;
    __device__ __forceinline__ void init(const GAS void* A_, const GAS void* Bt_, int M, int N, int K, int G_, int c_) { A = (const GAS char*)A_; Bt = (const GAS char*)Bt_; nM = M / BM; nN = N / BM; nwg = nM * nN; G = G_; c = c_; tstep = (size_t)BM * K * 2; }
    __device__ __forceinline__ bool next(int i, Unit& u) const {
        const long L = (long)i * G + c; if (L >= nwg) return false;
        tile_of((int)L, nM, nN, u.pm, u.pn); u.aux = 0; u.A = A + (size_t)u.pm * tstep; u.B = Bt + (size_t)u.pn * tstep; return true;
    }
};

typedef float f32x2_t __attribute__((ext_vector_type(2))); typedef __bf16 bf16x2_t __attribute__((ext_vector_type(2)));
__device__ __forceinline__ unsigned cvt_pk_bf16(float lo, float hi) { f32x2_t v = {lo, hi}; bf16x2_t b = __builtin_convertvector(v, bf16x2_t); return __builtin_bit_cast(unsigned, b); }

__device__ __forceinline__ bf16 bf1(float x) { return (bf16)(cvt_pk_bf16(x, x) & 0xffffu); }
template <class Epi, class Sched, bool ALIGN_EPI = true, bool SP2 = true>
__device__ __forceinline__ void gemm_phase(LAS unsigned char* lds, const int tid, const int K, const Sched& S, const Epi& E) {
    const int wid = __builtin_amdgcn_readfirstlane(tid >> 6), lane = tid & 63, wr = wid >> 2, wc = wid & 3, fr = lane & 15, fq = lane >> 4;
    const int nt = K / BK;
    unsigned voffA, voffB;
    { int R, C; stage_rc(tid * 16, R, C); const int Rb = Epi::PERM ? ((R & ~31) + perm32(R & 31)) : R;
        voffA = (unsigned)(R * K + C) * 2u; voffB = (unsigned)(Rb * K + C) * 2u; }
    const size_t pstep = (size_t)64 * K * 2;
    const size_t kstep = (size_t)(BK * 2);
    const size_t hstep = (size_t)HALF * K * 2;
    const unsigned ldsw = (unsigned)wid * 1024u;
    const int aoff = lds_byte(wr * 64 + fr, fq * 8), boff = lds_byte(wc * 32 + fr, fq * 8);
#define PG8_SA(b, h) (((b) * 2 + (h)) * HTB)
#define PG8_SB(b, h) ((4 + (b) * 2 + (h)) * HTB)
#define PG8_STAGE(bufoff, gbase, voff) do { _Pragma("unroll") for (int _i = 0; _i < 2; ++_i) \
        __builtin_amdgcn_global_load_lds((const GAS unsigned*)((const GAS char*)(gbase) + _i * pstep + (voff)), (LAS unsigned*)(lds + (bufoff) + ldsw + _i * 8192), 16, 0, 0); } while (0)
#define PG8_STAGE_A(bufoff, kbase, h_, useNext) do { if constexpr (GATHER) { _Pragma("unroll") for (int _i = 0; _i < 2; ++_i) { const unsigned _o = (useNext) ? gaN[h_][_i] : gaC[h_][_i]; \
        __builtin_amdgcn_global_load_lds((const GAS unsigned*)((const GAS char*)(kbase) + _o), (LAS unsigned*)(lds + (bufoff) + ldsw + _i * 8192), 16, 0, 0); } } \
        else { PG8_STAGE(bufoff, (kbase) + (h_) * hstep, voffA); } } while (0)
#define PG8_LDA(dst, b, h) do { _Pragma("unroll") for (int m = 0; m < 4; ++m) _Pragma("unroll") for (int k = 0; k < 2; ++k) dst[m][k] = *(const LAS bf16x8*)(lds + PG8_SA(b, h) + aoff + m * 2048 + k * 1024); } while (0)
#define PG8_LDB(dst, b, h) do { _Pragma("unroll") for (int n = 0; n < 2; ++n) _Pragma("unroll") for (int k = 0; k < 2; ++k) dst[n][k] = *(const LAS bf16x8*)(lds + PG8_SB(b, h) + boff + n * 2048 + k * 1024); } while (0)
#define PG8_MMA(ai, bj, At, Bt) do { __builtin_amdgcn_s_setprio(1); _Pragma("unroll") for (int m = 0; m < 4; ++m) _Pragma("unroll") for (int n = 0; n < 2; ++n) _Pragma("unroll") for (int k = 0; k < 2; ++k) \
        acc[ai][bj][m][n] = __builtin_amdgcn_mfma_f32_16x16x32_bf16(Bt[n][k], At[m][k], acc[ai][bj][m][n], 0, 0, 0); __builtin_amdgcn_s_setprio(0); } while (0)
#define PG8_WAIT_V(n) asm volatile("s_waitcnt vmcnt(" #n ")" ::: "memory")
#define PG8_WAIT_L(n) asm volatile("s_waitcnt lgkmcnt(" #n ")" ::: "memory")
#define PG8_BAR __builtin_amdgcn_s_barrier()
#define PG8_SCHED __builtin_amdgcn_sched_barrier(0)
    Unit cur, nxt; int ui = 0;
    if (!S.next(0, cur)) return;
    constexpr bool GATHER = Sched::GATHER;
    unsigned gaC[2][2], gaN[2][2];
    int gR = 0, gC = 0; if constexpr (GATHER) { stage_rc(tid * 16, gR, gC); }
#define PG8_GATHER_OFFS(dst, u_) do { if constexpr (GATHER) { _Pragma("unroll") for (int h_ = 0; h_ < 2; ++h_) _Pragma("unroll") for (int i_ = 0; i_ < 2; ++i_) \
        dst[h_][i_] = (unsigned)S.rowtok[(u_).pm * 256 + 128 * h_ + 64 * i_ + gR] * (unsigned)(K * 2) + (unsigned)(gC * 2); } } while (0)
    PG8_GATHER_OFFS(gaC, cur);
#pragma unroll
    for (int h_ = 0; h_ < 2; ++h_)
#pragma unroll
        for (int i_ = 0; i_ < 2; ++i_) gaN[h_][i_] = gaC[h_][i_];
    f32x4 acc[2][2][4][2];
#pragma unroll
    for (int a = 0; a < 2; ++a)
#pragma unroll
        for (int b = 0; b < 2; ++b)
#pragma unroll
            for (int m = 0; m < 4; ++m)
#pragma unroll
                for (int n = 0; n < 2; ++n) acc[a][b][m][n] = (f32x4){0.f, 0.f, 0.f, 0.f};
    bf16x8 At[4][2], B0[2][2], B1[2][2];
    const GAS char* cA = cur.A; const GAS char* cB = cur.B;
    if constexpr (SP2) {
        PG8_STAGE(PG8_SB(0, 0), cB, voffB); PG8_STAGE(PG8_SB(0, 1), cB + hstep, voffB); PG8_STAGE_A(PG8_SA(0, 0), cA, 0, false); PG8_STAGE_A(PG8_SA(0, 1), cA, 1, false);
        if (wr == 1) PG8_BAR;
        PG8_WAIT_V(2); PG8_BAR;
        PG8_STAGE(PG8_SB(1, 0), cB + kstep, voffB); PG8_STAGE_A(PG8_SA(1, 0), cA + kstep, 0, false); PG8_STAGE(PG8_SB(1, 1), cB + hstep + kstep, voffB);
        PG8_WAIT_V(6); PG8_BAR;
    } else {
        PG8_STAGE(PG8_SB(0, 0), cB, voffB); PG8_STAGE(PG8_SA(0, 0), cA, voffA); PG8_STAGE(PG8_SB(0, 1), cB + hstep, voffB); PG8_STAGE(PG8_SA(0, 1), cA + hstep, voffA);
        if (wr == 1) PG8_BAR;
        PG8_WAIT_V(4); PG8_BAR;
        PG8_STAGE(PG8_SB(1, 0), cB + kstep, voffB); PG8_STAGE(PG8_SA(1, 0), cA + kstep, voffA); PG8_STAGE(PG8_SB(1, 1), cB + hstep + kstep, voffB);
        PG8_WAIT_V(6); PG8_BAR;
    }
    for (;;) {
        const bool has_next = S.next(ui + 1, nxt);
        if (has_next) PG8_GATHER_OFFS(gaN, nxt);
        const GAS char* nA = has_next ? nxt.A : cA; const GAS char* nB = has_next ? nxt.B : cB;
        for (int t = 0; t < nt; t += 2) {
            const bool last = (t == nt - 2);
            const GAS char* a1 = cA + (size_t)(t + 1) * kstep;
            const GAS char* a2 = last ? nA : cA + (size_t)(t + 2) * kstep; const GAS char* b2 = last ? nB : cB + (size_t)(t + 2) * kstep;
            const GAS char* a3 = a2 + kstep; const GAS char* b3 = b2 + kstep;
            if constexpr (SP2) {
            PG8_LDB(B0, 0, 0); PG8_LDB(B1, 0, 1); PG8_SCHED; PG8_LDA(At, 0, 0); PG8_STAGE_A(PG8_SA(1, 1), a1, 1, false);
            PG8_WAIT_V(8); PG8_WAIT_L(0); PG8_BAR; PG8_MMA(0, 0, At, B0); PG8_MMA(0, 1, At, B1); PG8_BAR; PG8_SCHED;
            PG8_LDA(At, 0, 1); PG8_STAGE(PG8_SB(0, 0), b2, voffB); PG8_STAGE(PG8_SB(0, 1), b2 + hstep, voffB); PG8_STAGE_A(PG8_SA(0, 0), a2, 0, last && has_next);
            PG8_WAIT_V(8); PG8_WAIT_L(0); PG8_BAR; PG8_MMA(1, 0, At, B0); PG8_MMA(1, 1, At, B1); PG8_BAR; PG8_SCHED;
            PG8_LDB(B0, 1, 0); PG8_LDB(B1, 1, 1); PG8_SCHED; PG8_LDA(At, 1, 0); PG8_STAGE_A(PG8_SA(0, 1), a2, 1, last && has_next);
            PG8_WAIT_V(8); PG8_WAIT_L(0); PG8_BAR; PG8_MMA(0, 0, At, B0); PG8_MMA(0, 1, At, B1); PG8_BAR; PG8_SCHED;
            PG8_LDA(At, 1, 1); PG8_STAGE(PG8_SB(1, 0), b3, voffB); PG8_STAGE(PG8_SB(1, 1), b3 + hstep, voffB); PG8_STAGE_A(PG8_SA(1, 0), a3, 0, last && has_next);
            PG8_WAIT_V(8); PG8_WAIT_L(0); PG8_BAR; PG8_MMA(1, 0, At, B0); PG8_MMA(1, 1, At, B1); PG8_BAR; PG8_SCHED;
            } else {
            PG8_LDB(B0, 0, 0); PG8_SCHED; PG8_LDA(At, 0, 0); PG8_STAGE(PG8_SA(1, 1), a1 + hstep, voffA);
            PG8_WAIT_L(8); PG8_BAR; PG8_WAIT_L(0); PG8_MMA(0, 0, At, B0); PG8_BAR; PG8_SCHED;
            PG8_LDB(B1, 0, 1); PG8_STAGE(PG8_SB(0, 0), b2, voffB);
            PG8_BAR; PG8_WAIT_L(0); PG8_MMA(0, 1, At, B1); PG8_BAR;
            PG8_LDA(At, 0, 1); PG8_STAGE(PG8_SA(0, 0), a2, voffA);
            PG8_BAR; PG8_WAIT_L(0); PG8_MMA(1, 0, At, B0); PG8_BAR; PG8_SCHED;
            PG8_STAGE(PG8_SB(0, 1), b2 + hstep, voffB);
            PG8_WAIT_V(6); PG8_BAR; PG8_MMA(1, 1, At, B1); PG8_BAR;
            PG8_LDB(B0, 1, 0); PG8_SCHED; PG8_LDA(At, 1, 0); PG8_STAGE(PG8_SA(0, 1), a2 + hstep, voffA);
            PG8_WAIT_L(8); PG8_BAR; PG8_WAIT_L(0); PG8_MMA(0, 0, At, B0); PG8_BAR; PG8_SCHED;
            PG8_LDB(B1, 1, 1); PG8_STAGE(PG8_SB(1, 0), b3, voffB);
            PG8_BAR; PG8_WAIT_L(0); PG8_MMA(0, 1, At, B1); PG8_BAR;
            PG8_LDA(At, 1, 1); PG8_STAGE(PG8_SA(1, 0), a3, voffA);
            PG8_BAR; PG8_WAIT_L(0); PG8_MMA(1, 0, At, B0); PG8_BAR; PG8_SCHED;
            PG8_STAGE(PG8_SB(1, 1), b3 + hstep, voffB);
            PG8_WAIT_V(6); PG8_BAR; PG8_MMA(1, 1, At, B1); PG8_BAR;
            }
        }
        if constexpr (ALIGN_EPI) { if (wr == 0) PG8_BAR; }
        E(acc, cur, wr, wc, fr, fq);
        if (!has_next) break;
#pragma unroll
        for (int a = 0; a < 2; ++a)
#pragma unroll
            for (int b = 0; b < 2; ++b)
#pragma unroll
                for (int m = 0; m < 4; ++m)
#pragma unroll
                    for (int n = 0; n < 2; ++n) acc[a][b][m][n] = (f32x4){0.f, 0.f, 0.f, 0.f};
        cur = nxt; cA = nA; cB = nB; ++ui;
#pragma unroll
        for (int h_ = 0; h_ < 2; ++h_)
#pragma unroll
            for (int i_ = 0; i_ < 2; ++i_) gaC[h_][i_] = gaN[h_][i_];
        if constexpr (ALIGN_EPI) { if (wr == 1) PG8_BAR; }
    }
    PG8_WAIT_V(0);
    if constexpr (!ALIGN_EPI) { if (wr == 0) PG8_BAR; }
    PG8_BAR;
#undef PG8_SA
#undef PG8_SB
#undef PG8_STAGE
#undef PG8_LDA
#undef PG8_STAGE_A
#undef PG8_GATHER_OFFS
#undef PG8_LDB
#undef PG8_MMA
#undef PG8_WAIT_V
#undef PG8_WAIT_L
#undef PG8_BAR
#undef PG8_SCHED
}
}

using pg8::Unit; using pg8::cvt_pk_bf16; using pg8::bf1; using pg8::HALF; using pg8::BM;

struct EpiG1a {
    static constexpr bool PERM = true;
    GAS bf16* O;
    __device__ __forceinline__ void operator()(const f32x4 (&acc)[2][2][4][2], const Unit& u, int wr, int wc, int fr, int fq) const {
        const int row0 = u.pm * BM + wr * 64 + fr, col0 = u.pn * BM + wc * 32 + 8 * fq;
#pragma unroll
        for (int ai = 0; ai < 2; ++ai)
#pragma unroll
            for (int m = 0; m < 4; ++m) { GAS bf16* rowp = O + (size_t)(row0 + ai * HALF + m * 16) * 1536 + col0;
#pragma unroll
                for (int bj = 0; bj < 2; ++bj) { const f32x4 v0 = acc[ai][bj][m][0], v1 = acc[ai][bj][m][1];
                    u32x4 w; w.x = cvt_pk_bf16(v0[0], v0[1]); w.y = cvt_pk_bf16(v0[2], v0[3]); w.z = cvt_pk_bf16(v1[0], v1[1]); w.w = cvt_pk_bf16(v1[2], v1[3]);
                    *(GAS u32x4*)(rowp + bj * HALF) = w; } }
    }
};
struct EpiG1b {
    static constexpr bool PERM = true;
    GAS unsigned char* ws;
    __device__ __forceinline__ void operator()(const f32x4 (&acc)[2][2][4][2], const Unit& u, int wr, int wc, int fr, int fq) const {
        const int pn = u.pn; size_t off; int ld, ct;
        if (pn < 2) { off = WS_PZ; ld = 512; ct = pn; } else if (pn < 4) { off = WS_PPOOL; ld = 512; ct = pn - 2; } else if (pn == 4) { off = WS_PMQ; ld = 256; ct = 0; }
        else if (pn == 5) { off = WS_PMK; ld = 256; ct = 0; } else if (pn < 8) { off = WS_PMV; ld = 512; ct = pn - 6; } else { off = WS_PMO; ld = 512; ct = pn - 8; }
        GAS bf16* O = (GAS bf16*)(ws + off);
        const int row0 = u.pm * BM + wr * 64 + fr, col0 = ct * BM + wc * 32 + 8 * fq;
#pragma unroll
        for (int ai = 0; ai < 2; ++ai)
#pragma unroll
            for (int m = 0; m < 4; ++m) { GAS bf16* rowp = O + (size_t)(row0 + ai * HALF + m * 16) * ld + col0;
#pragma unroll
                for (int bj = 0; bj < 2; ++bj) { const f32x4 v0 = acc[ai][bj][m][0], v1 = acc[ai][bj][m][1];
                    u32x4 w; w.x = cvt_pk_bf16(v0[0], v0[1]); w.y = cvt_pk_bf16(v0[2], v0[3]); w.z = cvt_pk_bf16(v1[0], v1[1]); w.w = cvt_pk_bf16(v1[2], v1[3]);
                    *(GAS u32x4*)(rowp + bj * HALF) = w; } }
    }
};
__device__ __forceinline__ float fast_sigmoid(float x) { return __builtin_amdgcn_rcpf(1.0f + __builtin_amdgcn_exp2f(-1.44269504089f * x)); }
struct EpiGate {
    static constexpr bool PERM = true;
    GAS bf16* O;
    __device__ __forceinline__ void operator()(const f32x4 (&acc)[2][2][4][2], const Unit& u, int wr, int wc, int fr, int fq) const {
        const int row0 = u.pm * BM + wr * 64 + fr, col0 = u.pn * BM + wc * 32 + 8 * fq;
#pragma unroll
        for (int ai = 0; ai < 2; ++ai)
#pragma unroll
            for (int m = 0; m < 4; ++m) { GAS bf16* rowp = O + (size_t)(row0 + ai * HALF + m * 16) * 3072 + col0;
#pragma unroll
                for (int bj = 0; bj < 2; ++bj) { f32x4 v0 = acc[ai][bj][m][0], v1 = acc[ai][bj][m][1];
#pragma unroll
                    for (int j = 0; j < 4; ++j) { v0[j] = fast_sigmoid(v0[j]); v1[j] = fast_sigmoid(v1[j]); }
                    u32x4 w; w.x = cvt_pk_bf16(v0[0], v0[1]); w.y = cvt_pk_bf16(v0[2], v0[3]); w.z = cvt_pk_bf16(v1[0], v1[1]); w.w = cvt_pk_bf16(v1[2], v1[3]);
                    *(GAS u32x4*)(rowp + bj * HALF) = w; } }
    }
};
__device__ __forceinline__ void unpack8(const u32x4 w, float (&f)[8]) {
    f[0] = __uint_as_float(w.x << 16); f[1] = __uint_as_float(w.x & 0xffff0000u); f[2] = __uint_as_float(w.y << 16); f[3] = __uint_as_float(w.y & 0xffff0000u);
    f[4] = __uint_as_float(w.z << 16); f[5] = __uint_as_float(w.z & 0xffff0000u); f[6] = __uint_as_float(w.w << 16); f[7] = __uint_as_float(w.w & 0xffff0000u);
}
struct EpiMerge {
    static constexpr bool PERM = true;
    const GAS bf16* GATE; GAS bf16* PART; GAS bf16* FIN;
    __device__ __forceinline__ void operator()(const f32x4 (&acc)[2][2][4][2], const Unit& u, int wr, int wc, int fr, int fq) const {
        const int r = u.aux;
        const int row0 = u.pm * BM + wr * 64 + fr, col0 = u.pn * BM + wc * 32 + 8 * fq;
        GAS bf16* dst = (r == 2) ? FIN : PART;
#pragma unroll
        for (int ai = 0; ai < 2; ++ai) {
            u32x4 gw[4][2], pw[4][2];
#pragma unroll
            for (int m = 0; m < 4; ++m)
#pragma unroll
                for (int bj = 0; bj < 2; ++bj) { const size_t row = (size_t)(row0 + ai * HALF + m * 16); const int c = col0 + bj * HALF;
                    gw[m][bj] = *(const GAS u32x4*)(GATE + row * 3072 + r * 1024 + c);
                    if (r > 0) pw[m][bj] = *(const GAS u32x4*)(PART + row * 1024 + c); }
#pragma unroll
            for (int m = 0; m < 4; ++m)
#pragma unroll
                for (int bj = 0; bj < 2; ++bj) { const size_t row = (size_t)(row0 + ai * HALF + m * 16); const int c = col0 + bj * HALF;
                    const f32x4 v0 = acc[ai][bj][m][0], v1 = acc[ai][bj][m][1];
                    float g[8]; unpack8(gw[m][bj], g);
                    float o[8];
                    o[0] = v0[0] * g[0]; o[1] = v0[1] * g[1]; o[2] = v0[2] * g[2]; o[3] = v0[3] * g[3];
                    o[4] = v1[0] * g[4]; o[5] = v1[1] * g[5]; o[6] = v1[2] * g[6]; o[7] = v1[3] * g[7];
                    if (r > 0) { float p[8]; unpack8(pw[m][bj], p);
#pragma unroll
                        for (int j = 0; j < 8; ++j) o[j] += p[j]; }
                    u32x4 w; w.x = cvt_pk_bf16(o[0], o[1]); w.y = cvt_pk_bf16(o[2], o[3]); w.z = cvt_pk_bf16(o[4], o[5]); w.w = cvt_pk_bf16(o[6], o[7]);
                    *(GAS u32x4*)(dst + row * 1024 + c) = w; }
        }
    }
};
struct EpiOut {
    static constexpr bool PERM = false;
    const GAS bf16* H; GAS bf16* PRE;
    __device__ __forceinline__ void operator()(const f32x4 (&acc)[2][2][4][2], const Unit& u, int wr, int wc, int fr, int fq) const {
        const int row0 = u.pm * BM + wr * 64 + fr, col0 = u.pn * BM + wc * 32 + 4 * fq;
#pragma unroll
        for (int ai = 0; ai < 2; ++ai) {
            u32x2 hv[4][2][2];
#pragma unroll
            for (int m = 0; m < 4; ++m)
#pragma unroll
                for (int bj = 0; bj < 2; ++bj)
#pragma unroll
                    for (int n = 0; n < 2; ++n) hv[m][bj][n] = *(const GAS u32x2*)(H + (size_t)(row0 + ai * HALF + m * 16) * D + col0 + bj * HALF + n * 16);
#pragma unroll
            for (int m = 0; m < 4; ++m)
#pragma unroll
                for (int bj = 0; bj < 2; ++bj)
#pragma unroll
                    for (int n = 0; n < 2; ++n) { const size_t o = (size_t)(row0 + ai * HALF + m * 16) * D + col0 + bj * HALF + n * 16; const u32x2 h2 = hv[m][bj][n]; const f32x4 a = acc[ai][bj][m][n];
                        u32x2 w; w.x = cvt_pk_bf16(ALPHA * bf2f(h2.x & 0xffffu) + a[0], ALPHA * bf2f(h2.x >> 16) + a[1]); w.y = cvt_pk_bf16(ALPHA * bf2f(h2.y & 0xffffu) + a[2], ALPHA * bf2f(h2.y >> 16) + a[3]);
                        *(GAS u32x2*)(PRE + o) = w; }
        }
    }
};
struct EpiMoe1 {
    static constexpr bool PERM = true;
    GAS bf16* ACT;
    __device__ __forceinline__ void operator()(const f32x4 (&acc)[2][2][4][2], const Unit& u, int wr, int wc, int fr, int fq) const {
        const int row0 = u.pm * BM + wr * 64 + fr, col0 = u.pn * 128 + wc * 32 + 8 * fq;
#pragma unroll
        for (int ai = 0; ai < 2; ++ai)
#pragma unroll
            for (int m = 0; m < 4; ++m) { GAS bf16* rowp = ACT + (size_t)(row0 + ai * HALF + m * 16) * DEXP + col0;
                float o[8];
#pragma unroll
                for (int n = 0; n < 2; ++n)
#pragma unroll
                    for (int j = 0; j < 4; ++j) { const float a = acc[ai][0][m][n][j], b = acc[ai][1][m][n][j]; o[n * 4 + j] = a * fast_sigmoid(a) * b; }
                u32x4 w; w.x = cvt_pk_bf16(o[0], o[1]); w.y = cvt_pk_bf16(o[2], o[3]); w.z = cvt_pk_bf16(o[4], o[5]); w.w = cvt_pk_bf16(o[6], o[7]);
                *(GAS u32x4*)rowp = w; }
    }
};
struct EpiMoe2 {
    static constexpr bool PERM = true;
    GAS bf16* Y; const GAS float* roww;
    __device__ __forceinline__ void operator()(const f32x4 (&acc)[2][2][4][2], const Unit& u, int wr, int wc, int fr, int fq) const {
        const int row0 = u.pm * BM + wr * 64 + fr, col0 = u.pn * BM + wc * 32 + 8 * fq;
        float rws[2][4];
#pragma unroll
        for (int ai = 0; ai < 2; ++ai)
#pragma unroll
            for (int m = 0; m < 4; ++m) rws[ai][m] = roww[row0 + ai * HALF + m * 16];
#pragma unroll
        for (int ai = 0; ai < 2; ++ai)
#pragma unroll
            for (int m = 0; m < 4; ++m) { const int row = row0 + ai * HALF + m * 16; const float rw = rws[ai][m]; GAS bf16* rowp = Y + (size_t)row * D + col0;
#pragma unroll
                for (int bj = 0; bj < 2; ++bj) { const f32x4 v0 = acc[ai][bj][m][0] * rw, v1 = acc[ai][bj][m][1] * rw;
                    u32x4 w; w.x = cvt_pk_bf16(v0[0], v0[1]); w.y = cvt_pk_bf16(v0[2], v0[3]); w.z = cvt_pk_bf16(v1[0], v1[1]); w.w = cvt_pk_bf16(v1[2], v1[3]);
                    *(GAS u32x4*)(rowp + bj * HALF) = w; } }
    }
};

struct MergeOrder {
    static constexpr bool GATHER = false;
    const GAS char* Y[3]; const GAS char* W; int G, c;
    __device__ __forceinline__ bool next(int i, Unit& u) const {
        const int j = i / 3, r = i - 3 * j; const int L = j * G + c; if (L >= 128 * 4) return false;
        pg8::tile_of(L, 128, 4, u.pm, u.pn); u.aux = r;
        const GAS char* y = (r == 0) ? Y[0] : ((r == 1) ? Y[1] : Y[2]);
        u.A = y + (size_t)u.pm * (256 * 512 * 2); u.B = W + (size_t)r * (1024 * 512 * 2) + (size_t)u.pn * (256 * 512 * 2); return true;
    }
};
template <int KDIM, bool GATHER_> struct MoeOrder {
    static constexpr bool GATHER = GATHER_;
    const GAS int* rowtok;
    const GAS char* A; const GAS char* W; const LAS int* pe; int c, NP;
    __device__ __forceinline__ bool next(int i, Unit& u) const {
        const int L = i * 256 + c; if (L >= NP * 4) return false;
        const int p = L >> 2, pn = L & 3; const int e = __builtin_amdgcn_readfirstlane(pe[p]);
        u.pm = p; u.pn = pn; u.aux = e; u.A = GATHER_ ? A : A + (size_t)p * (256 * KDIM * 2); u.B = W + (size_t)e * (1024 * KDIM * 2) + (size_t)pn * (256 * KDIM * 2); return true;
    }
};

struct Args {
    const float* in[23]; float* out; unsigned char* ws; int ph_lo, ph_hi;
};
struct Frame {
    LAS unsigned char* lds; int tid, lane, wave, G, wg;
    GAS float* out; GAS unsigned char* ws;
};
__device__ __forceinline__ const GAS float* inp_lds(LAS unsigned char* lds, int i) {
    const unsigned long long v = ((const LAS unsigned long long*)(lds + LARG_OFF))[i];
    const unsigned lo = __builtin_amdgcn_readfirstlane((unsigned)v), hi = __builtin_amdgcn_readfirstlane((unsigned)(v >> 32));
    return (const GAS float*)(((unsigned long long)hi << 32) | lo);
}
__device__ __forceinline__ const GAS float* inp(const Frame& F, int i) { return inp_lds(F.lds, i); }
__device__ __forceinline__ Frame fresh(LAS unsigned char* lds, int wave) {
    Frame F; int wgx = blockIdx.x; unsigned lb = (unsigned)(unsigned long long)lds;
    asm volatile("" : "+s"(wave), "+s"(wgx), "+s"(lb));
    F.lds = (LAS unsigned char*)(unsigned long long)lb;
    int ln = (int)__builtin_amdgcn_mbcnt_hi(~0u, __builtin_amdgcn_mbcnt_lo(~0u, 0u)); asm volatile("" : "+v"(ln));
    F.wave = wave; F.lane = ln; F.tid = wave * 64 + ln;
    F.G = 256; F.wg = wgx;
    F.out = (GAS float*)inp_lds(F.lds, 23); F.ws = (GAS unsigned char*)inp_lds(F.lds, 24);
    return F;
}
enum { I_X = 0, I_LN_IN_G, I_LN_IN_B, I_W_IN, I_CONV, I_A_LOG, I_DT_BIAS, I_DN_NORM, I_POOL_W, I_POOL_SCALE, I_ML_GATE_B, I_ML_NORM, I_W_BRANCH, I_W_OUT, I_LN_MIX_G, I_LN_MIX_B,
       I_ROUTER_W, I_ROUTER_B, I_MOE_W1, I_MOE_W3, I_MOE_W2, I_LN_FFN_G, I_LN_FFN_B };

__device__ __forceinline__ void tr_load(float (&r)[32], const GAS float* W, int ldw, int k0, int n0src, int lane) {
#pragma unroll
    for (int i = 0; i < 32; ++i) { const int kk = 2 * i + (lane >> 5); r[i] = W[(size_t)(k0 + kk) * ldw + n0src + (lane & 31)]; }
}
__device__ __forceinline__ void tr_store(const float (&r)[32], GAS bf16* WT, int dpitch, int k0, int drow0, LAS float* scr, int lane) {
#pragma unroll
    for (int i = 0; i < 32; ++i) { const int kk = 2 * i + (lane >> 5); scr[kk * 33 + (lane & 31)] = r[i]; }
    LDS_WAIT(); asm volatile("" ::: "memory");
    const int c = lane & 7;
#pragma unroll
    for (int j = 0; j < 4; ++j) { const int n = (lane >> 3) + 8 * j; const LAS float* s = scr + (8 * c) * 33 + n;
        u32x4 o; o.x = cvt_pk_bf16(s[0 * 33], s[1 * 33]); o.y = cvt_pk_bf16(s[2 * 33], s[3 * 33]); o.z = cvt_pk_bf16(s[4 * 33], s[5 * 33]); o.w = cvt_pk_bf16(s[6 * 33], s[7 * 33]);
        *(GAS u32x4*)(WT + (size_t)(drow0 + n) * dpitch + k0 + 8 * c) = o; }
    LDS_WAIT(); asm volatile("" ::: "memory");
}
__device__ __forceinline__ void tr_item(const GAS float* W, int ldw, int k0, int n0src, GAS bf16* WT, int dpitch, int drow0, LAS float* scr, int lane) {
    float r[32]; tr_load(r, W, ldw, k0, n0src, lane); tr_store(r, WT, dpitch, k0, drow0, scr, lane);
}
__device__ __forceinline__ void tr_segment(const Frame& F, const GAS float* W, int ldw, int K, int n0src, int ncols, GAS bf16* WT, int drow0, int& it) {
    LAS float* scr = (LAS float*)(F.lds + F.wave * 16384);
    const int gw = F.wg * NWAVES + F.wave, NGW = F.G * NWAVES;
    const int nblk = ncols / 32, nitems = (K / 64) * nblk;
    int first = (gw - (it % NGW) + NGW) % NGW;
    for (int r = first; r < nitems; r += NGW) { const int kb = r / nblk, nb = r % nblk; tr_item(W, ldw, 64 * kb, n0src + 32 * nb, WT, K, drow0 + 32 * nb, scr, F.lane); }
    it += nitems;
}
__device__ __forceinline__ void wprep_mixer(const Frame& F, int l) {
    const GAS float* win = inp(F, I_W_IN) + (size_t)l * D * DIN; int it = 0;
    GAS bf16* Wi = (GAS bf16*)(F.ws + WS_WIN); GAS bf16* Wg = (GAS bf16*)(F.ws + WS_WGATE); GAS bf16* Wb = (GAS bf16*)(F.ws + WS_WBR); GAS bf16* Wo = (GAS bf16*)(F.ws + WS_WOUT);
    tr_segment(F, win, DIN, D, C_QKV, 1536, Wi, 0, it);
    tr_segment(F, win, DIN, D, C_Z, 512, Wi, 1536, it);
    tr_segment(F, win, DIN, D, C_POOL, 512, Wi, 2048, it);
    tr_segment(F, win, DIN, D, C_MQ, 256, Wi, 2560, it);
    tr_segment(F, win, DIN, D, C_MK, 256, Wi, 2816, it);
    tr_segment(F, win, DIN, D, C_MV, 512, Wi, 3072, it);
    tr_segment(F, win, DIN, D, C_MO, 512, Wi, 3584, it);
    tr_segment(F, win, DIN, D, C_GATE, 3072, Wg, 0, it);
    const GAS float* wbr = inp(F, I_W_BRANCH) + (size_t)l * 3 * MIXW * D;
    tr_segment(F, wbr, D, MIXW, 0, D, Wb, 0, it);
    tr_segment(F, wbr + (size_t)2 * MIXW * D, D, MIXW, 0, D, Wb + (size_t)2 * D * MIXW, 0, it);
    tr_segment(F, inp(F, I_W_OUT) + (size_t)l * D * D, D, D, 0, D, Wo, 0, it);
    const GAS float* pw = inp(F, I_POOL_W) + (size_t)l * 4 * 128 * 128; const GAS float* ps = inp(F, I_POOL_SCALE) + (size_t)l * MIXW; const GAS float* wb1 = wbr + (size_t)MIXW * D;
    GAS bf16* W1 = Wb + (size_t)D * MIXW;
    for (int idx = F.wg * 512 + F.tid; idx < D * MIXW; idx += F.G * 512) {
        const int m = idx >> 10, d = idx & 1023, g = m >> 7, c = m & 127;
        float s = 0.f;
        for (int dd = 0; dd < 128; ++dd) s += pw[(g * 128 + c) * 128 + dd] * ps[g * 128 + dd] * wb1[(size_t)(g * 128 + dd) * D + d];
        W1[(size_t)d * MIXW + m] = (bf16)f2bf(s);
    }
}
__device__ __forceinline__ void wprep_moe(const Frame& F, int l, int wg0, int nwg) {
    GAS bf16* W13 = (GAS bf16*)((GAS unsigned char*)F.out + 64 * MiB); GAS bf16* W2 = (GAS bf16*)(F.ws + WS_W2);
    LAS float* scr = (LAS float*)(F.lds + F.wave * 16384);
    const int gw = (F.wg - wg0) * NWAVES + F.wave, NGW = nwg * NWAVES;
    const GAS float* w1 = inp(F, I_MOE_W1); const GAS float* w3 = inp(F, I_MOE_W3); const GAS float* w2 = inp(F, I_MOE_W2);
#define MOE_ITEM_LOAD(R, r_) do { const int ri_ = (r_); if (ri_ < 16384) { const int e = ri_ >> 9, which = (ri_ >> 8) & 1, kb = (ri_ >> 4) & 15, nb = ri_ & 15; \
            tr_load(R, (which ? w3 : w1) + ((size_t)l * NEXP + e) * D * DEXP, DEXP, 64 * kb, nb * 32, F.lane); } \
        else if (ri_ < 24576) { const int q = ri_ - 16384, e = q >> 8, kb = (q >> 5) & 7, nb = q & 31; tr_load(R, w2 + ((size_t)l * NEXP + e) * DEXP * D, D, 64 * kb, 32 * nb, F.lane); } } while (0)
#define MOE_ITEM_STORE(R, r_) do { const int ri_ = (r_); if (ri_ < 16384) { const int e = ri_ >> 9, which = (ri_ >> 8) & 1, kb = (ri_ >> 4) & 15, nb = ri_ & 15, n0 = nb * 32; \
            tr_store(R, W13 + (size_t)e * D * D, D, 64 * kb, (n0 >> 7) * 256 + which * 128 + (n0 & 127), scr, F.lane); } \
        else if (ri_ < 24576) { const int q = ri_ - 16384, e = q >> 8, kb = (q >> 5) & 7, nb = q & 31; tr_store(R, W2 + (size_t)e * D * DEXP, DEXP, 64 * kb, 32 * nb, scr, F.lane); } } while (0)
    float ra[32], rb[32];
    MOE_ITEM_LOAD(ra, gw);
    for (int r = gw; r < 24576; r += 2 * NGW) {
        MOE_ITEM_LOAD(rb, r + NGW); MOE_ITEM_STORE(ra, r);
        MOE_ITEM_LOAD(ra, r + 2 * NGW); MOE_ITEM_STORE(rb, r + NGW);
    }
#undef MOE_ITEM_LOAD
#undef MOE_ITEM_STORE
}

__device__ __forceinline__ int w32_addr(int k, int c4) { return (k >> 1) * 256 + (((((k & 1) << 3) | c4) ^ ((k >> 1) & 15)) << 4); }
__device__ __forceinline__ void stage_w32(const Frame& F, const GAS float* src, int ldw, bool gates) {
    for (int idx = F.tid; idx < D * 8; idx += 512) {
        const int k = idx >> 3, c4 = idx & 7;
        int col = 4 * c4;
        if (gates) col = (c4 < 2) ? (C_A + 4 * c4) : (c4 < 4) ? (C_B + 4 * (c4 - 2)) : (c4 < 6) ? (C_I + 4 * (c4 - 4)) : (C_F + 4 * (c4 - 6));
        const f32x4 v = *(const GAS f32x4*)(src + (size_t)k * ldw + col);
        *(LAS f32x4*)(F.lds + w32_addr(k, c4)) = v;
    }
}
template <int MODE>
__device__ __forceinline__ void ln_phase(const Frame& F, const GAS float* gam, const GAS float* bet, const GAS float* w32src, int w32ld, bool do_proj, bool write_hb, bool dummy = false) {
    GAS float* OUTP = dummy ? (GAS float*)(F.ws + WS_R2) : F.out; GAS unsigned char* WSO = dummy ? (F.ws + WS_R2 + 40 * MiB) : F.ws;
    LAS int* lhist = (LAS int*)(F.lds + LHIST_OFF);
    if (do_proj) stage_w32(F, w32src, w32ld, MODE != 1);
    if (MODE == 1 && F.tid < 32) lhist[F.tid] = 0;
    __syncthreads();
    const int lane = F.lane;
    GAS bf16* hb = dummy ? (GAS bf16*)(F.ws + WS_R2 + 128 * MiB) : (GAS bf16*)(F.ws + WS_HB);
    const int rows_per_wg = T / F.G;
    const GAS int* posp = (const GAS int*)(F.ws + WS_POS); const GAS bf16* Yr = (const GAS bf16*)(F.ws + WS_YROWS);
    const GAS float* srcp = inp(F, I_X);
    const GAS bf16* preb = (MODE == 1) ? (const GAS bf16*)F.out : (const GAS bf16*)(F.ws + WS_HB);
#define LN_FETCH(V, Y0, Y1, row_) do { const int rw_ = (row_); \
        if (MODE == 0) { _Pragma("unroll") for (int m = 0; m < 8; ++m) V[m] = *(const GAS f32x2*)(srcp + (size_t)rw_ * D + 2 * lane + 128 * m); } \
        else { _Pragma("unroll") for (int m = 0; m < 8; ++m) { const unsigned u_ = *(const GAS unsigned*)(preb + (size_t)rw_ * D + 2 * lane + 128 * m); V[m].x = bf2f(u_ & 0xffffu); V[m].y = bf2f(u_ >> 16); } } \
        if (MODE == 2) { const int p0_ = posp[2 * rw_], p1_ = posp[2 * rw_ + 1]; \
            _Pragma("unroll") for (int m = 0; m < 8; ++m) { Y0[m] = *(const GAS unsigned*)(Yr + (size_t)p0_ * D + 2 * lane + 128 * m); Y1[m] = *(const GAS unsigned*)(Yr + (size_t)p1_ * D + 2 * lane + 128 * m); } } } while (0)
    const int nrow = rows_per_wg / NWAVES, row0 = F.wg * rows_per_wg + F.wave * nrow;
    f32x2 vA[8], vB[8]; unsigned yA0[8], yA1[8], yB0[8], yB1[8];
    LN_FETCH(vA, yA0, yA1, row0);
#pragma unroll 1
    for (int i2 = 0; i2 < nrow; i2 += 2) {
#pragma unroll
      for (int half = 0; half < 2; ++half) {
        const int i = i2 + half; const int row = row0 + i;
        const int nrw = row0 + ((i + 1 < nrow) ? i + 1 : i);
        if (half == 0) LN_FETCH(vB, yB0, yB1, nrw); else LN_FETCH(vA, yA0, yA1, nrw);
        f32x2 v[8];
#pragma unroll
        for (int m = 0; m < 8; ++m) {
            const f32x2 o = half ? vB[m] : vA[m];
            if (MODE == 2) { const unsigned ya = half ? yB0[m] : yA0[m], yb = half ? yB1[m] : yA1[m];
                v[m].x = ALPHA * o.x + bf2f(ya & 0xffffu) + bf2f(yb & 0xffffu); v[m].y = ALPHA * o.y + bf2f(ya >> 16) + bf2f(yb >> 16); }
            else v[m] = o;
        }
        float s = 0.f;
#pragma unroll
        for (int m = 0; m < 8; ++m) s += v[m].x + v[m].y;
        const float mean = wave_sum(s) * (1.f / D);
        float s2 = 0.f;
#pragma unroll
        for (int m = 0; m < 8; ++m) { v[m].x -= mean; v[m].y -= mean; s2 += v[m].x * v[m].x + v[m].y * v[m].y; }
        const float rstd = 1.0f / sqrtf(wave_sum(s2) * (1.f / D) + LN_EPS);
        { int goz = 2 * lane; asm volatile("" : "+v"(goz));
#pragma unroll
          for (int m = 0; m < 8; ++m) { const f32x2 g2 = *(const GAS f32x2*)(gam + goz + 128 * m), b2 = *(const GAS f32x2*)(bet + goz + 128 * m); v[m].x = v[m].x * rstd * g2.x + b2.x; v[m].y = v[m].y * rstd * g2.y + b2.y; } }
        if (!write_hb) {
#pragma unroll
            for (int m = 0; m < 8; ++m) *(GAS f32x2*)(OUTP + (size_t)row * D + 2 * lane + 128 * m) = v[m];
        }
        if (write_hb) {
#pragma unroll
            for (int m = 0; m < 8; ++m) *(GAS unsigned*)(hb + (size_t)row * D + 2 * lane + 128 * m) = cvt_pk_bf16(v[m].x, v[m].y);
        }
        if (!do_proj) continue;
        float acc[32];
#pragma unroll
        for (int c = 0; c < 32; ++c) acc[c] = 0.f;
        {
            f32x4 w0[4], w1[4];
#define W32_LD(W, g_) do { const int k_ = 2 * lane + 128 * ((g_) >> 2) + (((g_) >> 1) & 1); const int cb_ = ((g_) & 1) * 4; _Pragma("unroll") for (int c4 = 0; c4 < 4; ++c4) W[c4] = *(const LAS f32x4*)(F.lds + w32_addr(k_, cb_ + c4)); } while (0)
#define W32_FMA(W, g_) do { const float xv_ = (((g_) >> 1) & 1) ? v[(g_) >> 2].y : v[(g_) >> 2].x; const int cb_ = ((g_) & 1) * 4; _Pragma("unroll") for (int c4 = 0; c4 < 4; ++c4) { \
                acc[4 * (cb_ + c4) + 0] += xv_ * W[c4][0]; acc[4 * (cb_ + c4) + 1] += xv_ * W[c4][1]; acc[4 * (cb_ + c4) + 2] += xv_ * W[c4][2]; acc[4 * (cb_ + c4) + 3] += xv_ * W[c4][3]; } } while (0)
#define W32_SB() __builtin_amdgcn_sched_barrier(0)
            W32_LD(w0, 0);
#pragma unroll
            for (int g = 0; g < 32; g += 2) {
                W32_SB(); W32_LD(w1, g + 1); W32_SB(); W32_FMA(w0, g);
                W32_SB(); if (g + 2 < 32) W32_LD(w0, g + 2); W32_SB(); W32_FMA(w1, g + 1);
            }
#undef W32_LD
#undef W32_FMA
#undef W32_SB
        }
        float r16[16], r8[8], r4[4], r2[2], r1;
        { const bool hi = (lane & 32) != 0;
#pragma unroll
          for (int j = 0; j < 16; ++j) { const float a = acc[j], b = acc[j + 16]; const float send = hi ? a : b, keep = hi ? b : a; r16[j] = keep + __shfl_xor(send, 32); } }
        { const bool hi = (lane & 16) != 0;
#pragma unroll
          for (int j = 0; j < 8; ++j) { const float a = r16[j], b = r16[j + 8]; const float send = hi ? a : b, keep = hi ? b : a; r8[j] = keep + __shfl_xor(send, 16); } }
        { const bool hi = (lane & 8) != 0;
#pragma unroll
          for (int j = 0; j < 4; ++j) { const float a = r8[j], b = r8[j + 4]; const float send = hi ? a : b, keep = hi ? b : a; r4[j] = keep + __shfl_xor(send, 8); } }
        { const bool hi = (lane & 4) != 0;
#pragma unroll
          for (int j = 0; j < 2; ++j) { const float a = r4[j], b = r4[j + 2]; const float send = hi ? a : b, keep = hi ? b : a; r2[j] = keep + __shfl_xor(send, 4); } }
        { const bool hi = (lane & 2) != 0; const float a = r2[0], b = r2[1]; const float send = hi ? a : b, keep = hi ? b : a; r1 = keep + __shfl_xor(send, 2); }
        r1 += __shfl_xor(r1, 1);
        if (MODE != 1) {
            if ((lane & 1) == 0) ((GAS float*)(WSO + WS_SG))[(size_t)row * 32 + (lane >> 1)] = r1;
        } else {
            const float score = sigmoidf_(r1);
            const float sel = score + inp(F, I_ROUTER_B)[lane >> 1];
            const int gb = lane & ~7;
            const float v0 = __shfl(sel, gb + 0), v1 = __shfl(sel, gb + 2), v2 = __shfl(sel, gb + 4), v3 = __shfl(sel, gb + 6);
            int i1 = 0; float m1 = v0;
            if (v1 > m1) { m1 = v1; i1 = 1; } if (v2 > m1) { m1 = v2; i1 = 2; } if (v3 > m1) { m1 = v3; i1 = 3; }
            int i2 = -1; float m2 = -3.0e38f;
            if (i1 != 0 && v0 > m2) { m2 = v0; i2 = 0; } if (i1 != 1 && v1 > m2) { m2 = v1; i2 = 1; } if (i1 != 2 && v2 > m2) { m2 = v2; i2 = 2; } if (i1 != 3 && v3 > m2) { m2 = v3; i2 = 3; }
            float gs = m1 + m2; int gi = lane >> 3;
#pragma unroll
            for (int o = 8; o < 64; o <<= 1) { const float og = __shfl_xor(gs, o); const int oi = __shfl_xor(gi, o); if (og > gs || (og == gs && oi < gi)) { gs = og; gi = oi; } }
            const int src = gi * 8;
            const int e1 = gi * 4 + __shfl(i1, src), e2 = gi * 4 + __shfl(i2, src);
            const float s1 = __shfl(score, 2 * e1), s2 = __shfl(score, 2 * e2);
            if (lane == 0) {
                GAS int* eid = (GAS int*)(WSO + WS_EID); GAS float* ew = (GAS float*)(WSO + WS_EW);
                const float inv = 1.0f / (s1 + s2);
                eid[2 * row] = e1; eid[2 * row + 1] = e2; ew[2 * row] = s1 * inv; ew[2 * row + 1] = s2 * inv;
                __hip_atomic_fetch_add(lhist + e1, 1, __ATOMIC_RELAXED, __HIP_MEMORY_SCOPE_WORKGROUP); __hip_atomic_fetch_add(lhist + e2, 1, __ATOMIC_RELAXED, __HIP_MEMORY_SCOPE_WORKGROUP);
            }
        }
      }
    }
#undef LN_FETCH
    if (MODE == 1) {
        __syncthreads();
        if (F.tid < 32) ((GAS int*)(WSO + WS_HIST))[F.wg * 32 + F.tid] = lhist[F.tid];
    }
    __syncthreads();
}

__device__ __forceinline__ int invsigma32(int w) { return 8 * ((w >> 2) & 3) + 4 * (w >> 4) + (w & 3); }
__device__ __forceinline__ float wave_incl_scan(float v, int lane) {
#pragma unroll
    for (int o = 1; o < 64; o <<= 1) { const float t = __shfl_up(v, o); if (lane >= o) v += t; }
    return v;
}
__device__ __forceinline__ float wave_incl_maxscan(float v, int lane) {
#pragma unroll
    for (int o = 1; o < 64; o <<= 1) { const float t = __shfl_up(v, o); if (lane >= o) v = fmaxf(v, t); }
    return v;
}
constexpr int DQ_OFF = 0, DK_OFF = 17408, DV_OFF = 34816, DGM_OFF = 52224, DQK_OFF = 69632, DTM_OFF = 87040, DVEC_OFF = 121856;
constexpr int QROW = 272;
constexpr int FROW = 68;
__device__ __forceinline__ bf16x8 pack_b(const f32x4 lo, const f32x4 hi) {
    u32x4 w; w.x = cvt_pk_bf16(lo[0], lo[1]); w.y = cvt_pk_bf16(lo[2], lo[3]); w.z = cvt_pk_bf16(hi[0], hi[1]); w.w = cvt_pk_bf16(hi[2], hi[3]);
    return __builtin_bit_cast(bf16x8, w);
}
__device__ __forceinline__ bf16x8 pack8f(const float (&f)[8]) {
    u32x4 w; w.x = cvt_pk_bf16(f[0], f[1]); w.y = cvt_pk_bf16(f[2], f[3]); w.z = cvt_pk_bf16(f[4], f[5]); w.w = cvt_pk_bf16(f[6], f[7]);
    return __builtin_bit_cast(bf16x8, w);
}
#define PREP_BAR() do { asm volatile("s_waitcnt lgkmcnt(0)" ::: "memory"); __builtin_amdgcn_s_barrier(); asm volatile("" ::: "memory"); } while (0)
#ifndef DNREP_A
#define DNREP_A 1
#endif
#ifndef DNREP_B
#define DNREP_B 1
#endif
#ifndef DNREP_C
#define DNREP_C 1
#endif
#ifndef DNREP_D
#define DNREP_D 1
#endif
__device__ __forceinline__ void dn_prep(const Frame& F, int l) {
    LAS unsigned char* L = F.lds;
    const int lane = F.lane, wave = F.wave, tid = F.tid, fr = lane & 15, fq = lane >> 4;
    const GAS bf16* P = (const GAS bf16*)(F.ws + WS_PQKV);
    const GAS float* SG = (const GAS float*)(F.ws + WS_SG);
    const GAS float* cw = inp(F, I_CONV) + (size_t)l * 5 * 1536;
    LAS float* GM = (LAS float*)(L + DGM_OFF); LAS float* QKM = (LAS float*)(L + DQK_OFF);
#ifdef DIAG
    unsigned long long tacc[7] = {0, 0, 0, 0, 0, 0, 0}; unsigned long long tprev = __builtin_amdgcn_s_memrealtime();
#define DSTAMP(k) do { const unsigned long long tn_ = __builtin_amdgcn_s_memrealtime(); tacc[k] += tn_ - tprev; tprev = tn_; } while (0)
#else
#define DSTAMP(k) do {} while (0)
#endif
    unsigned praw[12][3]; float pga = 0.f, pgb = 0.f;
#define DN_PF(item_) do { const int it_ = (item_) < NB * NHEAD * NCH ? (item_) : F.wg; const int b_ = it_ >> 9, h_ = (it_ >> 7) & 3, n_ = it_ & 127; \
        _Pragma("unroll") for (int rr = 0; rr < 12; ++rr) { const int sp_ = n_ * CH + 8 * wave + rr - 2; const bool ok_ = (sp_ >= 0 && sp_ < SEQ); \
            const GAS bf16* src_ = P + (size_t)(b_ * SEQ + (ok_ ? sp_ : 0)) * 1536 + h_ * 128 + 2 * lane; \
            _Pragma("unroll") for (int p = 0; p < 3; ++p) { const unsigned u_ = *(const GAS unsigned*)(src_ + p * 512); praw[rr][p] = ok_ ? u_ : 0u; } } \
        if (wave < 2) { const int ti_ = wave ? 63 - lane : lane; const int t0_ = b_ * SEQ + n_ * CH; pga = SG[(size_t)(t0_ + ti_) * 32 + wave * 4 + h_]; pgb = SG[(size_t)(t0_ + ti_) * 32 + 8 + wave * 4 + h_]; } } while (0)
    DN_PF(F.wg);
    for (int item = F.wg; item < NB * NHEAD * NCH; item += F.G) {
        const int b = item >> 9, h = (item >> 7) & 3, n = item & 127;
        const int t0 = b * SEQ + n * CH;
        for (int repA = 0; repA < DNREP_A; ++repA) {
        {
            float w[3][5][2];
#pragma unroll
            for (int p = 0; p < 3; ++p)
#pragma unroll
                for (int j = 0; j < 5; ++j) { const f32x2 t = *(const GAS f32x2*)(cw + j * 1536 + p * 512 + h * 128 + 2 * lane); w[p][j][0] = t.x; w[p][j][1] = t.y; }
            f32x2 ya[8][3];
#pragma unroll
            for (int ii = 0; ii < 8; ++ii)
#pragma unroll
                for (int p = 0; p < 3; ++p) ya[ii][p] = (f32x2){0.f, 0.f};
#pragma unroll
            for (int rr = 0; rr < 12; ++rr) {
                f32x2 xs[3];
#pragma unroll
                for (int p = 0; p < 3; ++p) { const unsigned u = praw[rr][p]; xs[p] = (f32x2){bf2f(u & 0xffffu), __uint_as_float(u & 0xffff0000u)}; }
#pragma unroll
                for (int j = 0; j < 5; ++j) { const int ii = rr - j;
                    if (ii >= 0 && ii < 8) {
#pragma unroll
                        for (int p = 0; p < 3; ++p) ya[ii][p] += xs[p] * (f32x2){w[p][j][0], w[p][j][1]}; } }
            }
#pragma unroll
            for (int ii = 0; ii < 8; ++ii) {
                const int i = 8 * wave + ii;
                float y[3][2];
#pragma unroll
                for (int p = 0; p < 3; ++p) { y[p][0] = ya[ii][p].x * fast_sigmoid(ya[ii][p].x); y[p][1] = ya[ii][p].y * fast_sigmoid(ya[ii][p].y); }
                const float sq = wave_sum(y[0][0] * y[0][0] + y[0][1] * y[0][1]), sk = wave_sum(y[1][0] * y[1][0] + y[1][1] * y[1][1]);
                const float rq = __builtin_amdgcn_rsqf(sq + NORM_EPS) * 0.08838834764831845f, rk = __builtin_amdgcn_rsqf(sk + NORM_EPS);
                *(LAS unsigned*)(L + DQ_OFF + i * QROW + 4 * lane) = cvt_pk_bf16(y[0][0] * rq, y[0][1] * rq);
                *(LAS unsigned*)(L + DK_OFF + i * QROW + 4 * lane) = cvt_pk_bf16(y[1][0] * rk, y[1][1] * rk);
                *(LAS unsigned*)(L + DV_OFF + i * QROW + 4 * lane) = cvt_pk_bf16(y[2][0], y[2][1]);
            }
            if (wave < 2) {
                const int d = wave; const int ti = d ? 63 - lane : lane;
                const float a = pga, bb = pgb;
                const float beta = sigmoidf_(bb);
                const float g = -expf(inp(F, I_A_LOG)[l * 8 + d * 4 + h]) * softplusf_(a + inp(F, I_DT_BIAS)[l * 8 + d * 4 + h]);
                const float gc = wave_incl_scan(g, lane);
                const float gl = __shfl(gc, 63);
                LAS float* vec = (LAS float*)(L + DVEC_OFF + d * 1024);
                vec[lane] = beta; vec[64 + lane] = gc; vec[128 + lane] = expf(gc); vec[192 + lane] = expf(gl - gc);
                if (lane == 63) ((GAS float*)(F.ws + WS_GL))[(size_t)item * 2 + d] = expf(gc);
            }
        }
        PREP_BAR();
        DSTAMP(0);
        }
        for (int repB = 0; repB < DNREP_B; ++repB) {
        {
#pragma unroll
            for (int tt = 0; tt < 2; ++tt) {
                const int t = 2 * wave + tt, mt = t >> 2, nt = t & 3;
                f32x4 ag = (f32x4){0.f, 0.f, 0.f, 0.f}, aq = (f32x4){0.f, 0.f, 0.f, 0.f};
#pragma unroll
                for (int s = 0; s < 4; ++s) {
                    const bf16x8 ka = *(const LAS bf16x8*)(L + DK_OFF + (16 * mt + fr) * QROW + 64 * s + 16 * fq);
                    const bf16x8 qa = *(const LAS bf16x8*)(L + DQ_OFF + (16 * mt + fr) * QROW + 64 * s + 16 * fq);
                    const bf16x8 kb = *(const LAS bf16x8*)(L + DK_OFF + (16 * nt + fr) * QROW + 64 * s + 16 * fq);
                    ag = __builtin_amdgcn_mfma_f32_16x16x32_bf16(ka, kb, ag, 0, 0, 0);
                    aq = __builtin_amdgcn_mfma_f32_16x16x32_bf16(qa, kb, aq, 0, 0, 0);
                }
#pragma unroll
                for (int r = 0; r < 4; ++r) { GM[(16 * mt + 4 * fq + r) * FROW + 16 * nt + fr] = ag[r]; QKM[(16 * mt + 4 * fq + r) * FROW + 16 * nt + fr] = aq[r]; }
            }
        }
        PREP_BAR();
        DSTAMP(1);
        }
        for (int repC = 0; repC < DNREP_C; ++repC) {
        {
#pragma unroll 4
            for (int e = 0; e < 16; ++e) {
                const int idx = tid + 512 * e, d = idx >> 12, i = (idx >> 6) & 63, j = idx & 63;
                const LAS float* vec = (const LAS float*)(L + DVEC_OFF + d * 1024);
                const int ti = d ? 63 - i : i, tj = d ? 63 - j : j;
                float v = (j < i) ? vec[i] * GM[ti * FROW + tj] * fexp(fminf(vec[64 + i] - vec[64 + j], 0.f)) : 0.f;
                if ((i & 31) == 0 && j >= (i & 32)) v = (j == i) ? 1.f : 0.f;
                *(LAS float*)(L + DTM_OFF + d * 17408 + (i * FROW + j) * 4) = v;
            }
        }
        PREP_BAR();
        DSTAMP(2);
        if (wave < 4) {
            const int d = wave >> 1, hb = wave & 1, c = lane & 31;
            LAS float* TM = (LAS float*)(L + DTM_OFF + d * 17408) + (32 * hb) * FROW + 32 * hb;
#define SUBST_PART(NB4, BASE) do { f32x4 m4[NB4]; float tv_[4 * NB4]; \
                _Pragma("unroll") for (int q = 0; q < NB4; ++q) m4[q] = *(const LAS f32x4*)(TM + i * FROW + (BASE) + 4 * q); \
                _Pragma("unroll") for (int q = 0; q < 4 * NB4; ++q) tv_[q] = TM[((BASE) + q) * FROW + c]; \
                _Pragma("unroll") for (int q = 0; q < NB4; ++q) { a0 -= m4[q][0] * tv_[4 * q]; a1 -= m4[q][1] * tv_[4 * q + 1]; a2 -= m4[q][2] * tv_[4 * q + 2]; a3 -= m4[q][3] * tv_[4 * q + 3]; } } while (0)
#define SUBST_END() do { const float tv = ((c == i) ? 1.f : 0.f) + ((a0 + a1) + (a2 + a3)); asm volatile("s_waitcnt lgkmcnt(0)" ::: "memory"); TM[i * FROW + c] = tv; } while (0)
#pragma unroll 1
            for (int i = 1; i < 16; ++i) { float a0 = 0.f, a1 = 0.f, a2 = 0.f, a3 = 0.f; SUBST_PART(4, 0); SUBST_END(); }
#pragma unroll 1
            for (int i = 16; i < 32; ++i) { float a0 = 0.f, a1 = 0.f, a2 = 0.f, a3 = 0.f; SUBST_PART(4, 0); asm volatile("" ::: "memory"); SUBST_PART(4, 16); SUBST_END(); }
#undef SUBST_PART
#undef SUBST_END
        } else {
            const int tw = wave - 4;
            for (int it = tw; it < 128; it += 4) {
                const int d = it >> 6, i = it & 63, ti = d ? 63 - i : i;
                const LAS float* vec = (const LAS float*)(L + DVEC_OFF + d * 1024);
                GAS unsigned char* rec = F.ws + WS_R2 + ((size_t)item * 2 + d) * DNREC;
                { const int p = 2 * lane; const int kk = (p & ~31) + sigma32(p & 31);
                  const unsigned u = *(const LAS unsigned*)(L + DQ_OFF + ti * QROW + 2 * kk); const float e = vec[128 + i];
                  *(GAS unsigned*)(rec + DN_QG + (i * 128 + p) * 2) = cvt_pk_bf16(bf2f(u & 0xffffu) * e, bf2f(u >> 16) * e); }
                { const int p = lane; const int j = (p & ~31) + sigma32(p & 31), tj = d ? 63 - j : j;
                  const float v = (j <= i) ? QKM[ti * FROW + tj] * fexp(fminf(vec[64 + i] - vec[64 + j], 0.f)) : 0.f;
                  ((GAS bf16*)(rec + DN_ATT))[i * 64 + p] = bf1(v); }
            }
            for (int it = tw; it < 128; it += 4) {
                const int d = it >> 6, kk = 2 * (it & 63);
                const LAS float* vec = (const LAS float*)(L + DVEC_OFF + d * 1024);
                GAS bf16* Kd = (GAS bf16*)(F.ws + WS_R2 + ((size_t)item * 2 + d) * DNREC + DN_KDT);
                const int p = lane; const int j = (p & ~31) + sigma32(p & 31), tj = d ? 63 - j : j;
                const unsigned u = *(const LAS unsigned*)(L + DK_OFF + tj * QROW + 2 * kk); const float e = vec[192 + j];
                Kd[kk * 64 + p] = bf1(bf2f(u & 0xffffu) * e); Kd[(kk + 1) * 64 + p] = bf1(bf2f(u >> 16) * e);
            }
        }
        PREP_BAR();
        DSTAMP(3);
        if (wave < 2) {
            LAS float* TM = (LAS float*)(L + DTM_OFF + wave * 17408);
            bf16x8 am[2], bt[2];
#pragma unroll
            for (int mt = 0; mt < 2; ++mt) { const f32x4 lo = *(const LAS f32x4*)(TM + (32 + 16 * mt + fr) * FROW + 8 * fq), hi = *(const LAS f32x4*)(TM + (32 + 16 * mt + fr) * FROW + 8 * fq + 4); am[mt] = pack_b(lo, hi); }
#pragma unroll
            for (int nt = 0; nt < 2; ++nt) { float xf[8];
#pragma unroll
                for (int e = 0; e < 8; ++e) xf[e] = TM[(8 * fq + e) * FROW + 16 * nt + fr];
                bt[nt] = pack8f(xf); }
            f32x4 X[2][2];
#pragma unroll
            for (int mt = 0; mt < 2; ++mt)
#pragma unroll
                for (int nt = 0; nt < 2; ++nt) X[mt][nt] = __builtin_amdgcn_mfma_f32_16x16x32_bf16(am[mt], bt[nt], (f32x4){0.f, 0.f, 0.f, 0.f}, 0, 0, 0);
            bf16x8 xb[2], a2[2];
#pragma unroll
            for (int nt = 0; nt < 2; ++nt) xb[nt] = pack_b(X[0][nt], X[1][nt]);
#pragma unroll
            for (int mt = 0; mt < 2; ++mt) { const f32x4 lo = *(const LAS f32x4*)(TM + (32 + 16 * mt + fr) * FROW + 32 + 4 * fq), hi = *(const LAS f32x4*)(TM + (32 + 16 * mt + fr) * FROW + 32 + 16 + 4 * fq); a2[mt] = pack_b(lo, hi); }
#pragma unroll
            for (int mt = 0; mt < 2; ++mt)
#pragma unroll
                for (int nt = 0; nt < 2; ++nt) { const f32x4 t21 = __builtin_amdgcn_mfma_f32_16x16x32_bf16(a2[mt], xb[nt], (f32x4){0.f, 0.f, 0.f, 0.f}, 0, 0, 0);
#pragma unroll
                    for (int r = 0; r < 4; ++r) TM[(32 + 16 * mt + 4 * fq + r) * FROW + 16 * nt + fr] = -t21[r]; }
        }
        PREP_BAR();
        DSTAMP(4);
        }
        DN_PF(item + F.G);
        for (int repD = 0; repD < DNREP_D; ++repD) {
#pragma unroll 1
        for (int d = 0; d < 2; ++d) {
            const LAS float* TM = (const LAS float*)(L + DTM_OFF + d * 17408);
            const LAS float* vec = (const LAS float*)(L + DVEC_OFF + d * 1024);
            GAS unsigned char* rec = F.ws + WS_R2 + ((size_t)item * 2 + d) * DNREC;
            bf16x8 ta[4][2];
#pragma unroll
            for (int mt = 0; mt < 4; ++mt)
#pragma unroll
                for (int s = 0; s < 2; ++s) { const f32x4 lo = *(const LAS f32x4*)(TM + (16 * mt + fr) * FROW + 32 * s + 8 * fq), hi = *(const LAS f32x4*)(TM + (16 * mt + fr) * FROW + 32 * s + 8 * fq + 4); ta[mt][s] = pack_b(lo, hi); }
#pragma unroll 1
            for (int tt = 0; tt < 2; ++tt) {
                const int nt = 2 * wave + tt; const bool isv = nt < 8; const int col = 16 * (nt & 7) + fr;
                const int imgoff = isv ? DV_OFF : DK_OFF;
                bf16x8 xb[2];
#pragma unroll
                for (int s = 0; s < 2; ++s) { float xf[8];
#pragma unroll
                    for (int e = 0; e < 8; ++e) { const int j = 32 * s + 8 * fq + e, tj = d ? 63 - j : j;
                        const float x = bf2f(*(const LAS unsigned short*)(L + imgoff + tj * QROW + 2 * col));
                        xf[e] = x * vec[j] * (isv ? 1.f : vec[128 + j]); }
                    xb[s] = pack8f(xf); }
                f32x4 acc[4];
#pragma unroll
                for (int mt = 0; mt < 4; ++mt) { acc[mt] = (f32x4){0.f, 0.f, 0.f, 0.f};
#pragma unroll
                    for (int s = 0; s < 2; ++s) acc[mt] = __builtin_amdgcn_mfma_f32_16x16x32_bf16(ta[mt][s], xb[s], acc[mt], 0, 0, 0); }
                if (isv) {
                    GAS bf16* Uf = (GAS bf16*)(rec + DN_UF) + ((nt * 64 + lane) * 16);
#pragma unroll
                    for (int mt = 0; mt < 4; ++mt) { u32x2 w2; w2.x = cvt_pk_bf16(acc[mt][0], acc[mt][1]); w2.y = cvt_pk_bf16(acc[mt][2], acc[mt][3]); *(GAS u32x2*)(Uf + mt * 4) = w2; }
                } else {
                    GAS bf16* Wp = (GAS bf16*)(rec + DN_W); const int pos = (col & ~31) + invsigma32(col & 31);
#pragma unroll
                    for (int mt = 0; mt < 4; ++mt)
#pragma unroll
                        for (int r = 0; r < 4; ++r) Wp[(16 * mt + 4 * fq + r) * 128 + pos] = bf1(acc[mt][r]);
                }
            }
        }
        PREP_BAR();
        DSTAMP(5);
        }
    }
#ifdef DIAG
    if (F.tid == 0 && F.wg == 0 && l == 0) { for (int k = 0; k < 6; ++k) ((GAS unsigned long long*)(F.ws + WS_CTL + 1024))[48 + k] = tacc[k]; }
#endif
}

__device__ __forceinline__ int swz256(int row, int c16) { return row * 256 + ((c16 ^ (row & 15)) << 4); }
__device__ __forceinline__ int swz128(int row, int c8) { return (row >> 1) * 256 + (((((row & 1) << 3) | c8) ^ ((row >> 1) & 15)) << 4); }
constexpr int DNBUF = 57344;
#define SCAN_BAR() do { asm volatile("s_waitcnt lgkmcnt(0)" ::: "memory"); __builtin_amdgcn_s_barrier(); asm volatile("" ::: "memory"); } while (0)
__device__ __forceinline__ void dn_scan(const Frame& F) {
    if (F.wg >= 128) return;
    const int xcd = F.wg & 7, idx = F.wg >> 3;
    const int chain = xcd * 4 + (idx >> 2), qtr = idx & 3;
    const int b = chain >> 3, h = (chain >> 1) & 3, d = chain & 1;
    const int lane = F.lane, fr = lane & 15, fq = lane >> 4, wave = F.wave;
    LAS unsigned char* L = F.lds;
    const GAS unsigned char* recbase = F.ws + WS_R2;
    const int itembase = (b * NHEAD + h) * NCH;
    if (wave >= 2) {
        const int tl = F.tid - 128;
        u32x4 ra[10], rb[10];
        int woff[10];
#pragma unroll
        for (int i = 0; i < 10; ++i) { const int q = tl + 384 * i;
            if (q < 1024) woff[i] = swz256(q >> 4, q & 15); else if (q < 2048) woff[i] = 16384 + swz256((q - 1024) >> 4, q & 15);
            else if (q < 3072) woff[i] = 32768 + swz128((q - 2048) >> 3, q & 7); else if (q < 3584) woff[i] = 49152 + swz128((q - 3072) >> 3, q & 7); else woff[i] = -1; }
#define DN_LOAD(R, step_) do { const int st_ = (step_) < NCH ? (step_) : NCH - 1; const int n_ = d ? (NCH - 1 - st_) : st_; \
        const GAS u32x4* src_ = (const GAS u32x4*)(recbase + ((size_t)(itembase + n_) * 2 + d) * DNREC) + tl; \
        _Pragma("unroll") for (int i = 0; i < 10; ++i) R[i] = src_[(woff[i] >= 0) ? 384 * i : 0]; } while (0)
#define DN_WRITE(R, bufoff_) do { _Pragma("unroll") for (int i = 0; i < 10; ++i) if (woff[i] >= 0) *(LAS u32x4*)(L + (bufoff_) + woff[i]) = R[i]; } while (0)
        u32x4 rc[10];
        DN_LOAD(ra, 0); DN_LOAD(rb, 1); DN_LOAD(rc, 2);
        DN_WRITE(ra, 0);
        SCAN_BAR();
        for (int s = 0; s < 126; s += 6) {
            DN_LOAD(ra, s + 3); DN_WRITE(rb, DNBUF); SCAN_BAR();
            DN_LOAD(rb, s + 4); DN_WRITE(rc, 0);     SCAN_BAR();
            DN_LOAD(rc, s + 5); DN_WRITE(ra, DNBUF); SCAN_BAR();
            DN_LOAD(ra, s + 6); DN_WRITE(rb, 0);     SCAN_BAR();
            DN_LOAD(rb, s + 7); DN_WRITE(rc, DNBUF); SCAN_BAR();
            DN_LOAD(rc, s + 8); DN_WRITE(ra, 0);     SCAN_BAR();
        }
        DN_WRITE(rb, DNBUF); SCAN_BAR();
        SCAN_BAR();
#undef DN_LOAD
#undef DN_WRITE
        return;
    }
    const int slice = qtr * 2 + wave;
    const GAS float* GL = (const GAS float*)(F.ws + WS_GL);
    GAS bf16* O = (GAS bf16*)(F.ws + (d ? WS_OB : WS_OF));
    f32x4 S[8];
#pragma unroll
    for (int k = 0; k < 8; ++k) S[k] = (f32x4){0.f, 0.f, 0.f, 0.f};
    int offw[4], offk[8], offa[4];
#pragma unroll
    for (int t = 0; t < 4; ++t) { offw[t] = (16 * t + fr) * 256; offa[t] = ((16 * t + fr) >> 1) * 256; }
#pragma unroll
    for (int t = 0; t < 8; ++t) offk[t] = ((16 * t + fr) >> 1) * 256;
    const int x256 = fr & 15;
    const int x128 = (fr >> 1) & 15, p128 = (fr & 1) << 3;
    u32x4 uc0, uc1, un0, un1; float egl_c, egl_n;
    int vz = 0; asm volatile("" : "+v"(vz));
#define DN_UFETCH(A0, A1, EG, step_) do { const int st_ = (step_) < NCH ? (step_) : NCH - 1; const int nn_ = d ? (NCH - 1 - st_) : st_; \
        const GAS bf16* Uf_ = (const GAS bf16*)(recbase + ((size_t)(itembase + nn_) * 2 + d) * DNREC + DN_UF); A0 = *(const GAS u32x4*)(Uf_ + (slice * 64 + lane) * 16); A1 = *(const GAS u32x4*)(Uf_ + (slice * 64 + lane) * 16 + 8); \
        EG = GL[(size_t)(itembase + nn_) * 2 + d + vz]; } while (0)
    DN_UFETCH(uc0, uc1, egl_c, 0); DN_UFETCH(un0, un1, egl_n, 1);
    SCAN_BAR();
    for (int step = 0; step < NCH; ++step) {
        const int n = d ? (NCH - 1 - step) : step;
        const int bufoff = (step & 1) ? DNBUF : 0;
        const u32x4 u0 = uc0, u1 = uc1; const float egl = egl_c;
        uc0 = un0; uc1 = un1; egl_c = egl_n;
        DN_UFETCH(un0, un1, egl_n, step + 2);
        const LAS unsigned char* Bw = L + bufoff; const LAS unsigned char* Bq = Bw + 16384; const LAS unsigned char* Bk = Bw + 32768; const LAS unsigned char* Ba = Bw + 49152;
#define LD_WQ(G, s_) do { _Pragma("unroll") for (int mt = 0; mt < 4; ++mt) { const int o_ = offw[mt] + (((4 * (s_) + fq) ^ x256) << 4); G[mt] = *(const LAS bf16x8*)(Bw + o_); G[4 + mt] = *(const LAS bf16x8*)(Bq + o_); } } while (0)
#define MM_WQ(G, s_) do { _Pragma("unroll") for (int mt = 0; mt < 4; ++mt) { V[mt] = __builtin_amdgcn_mfma_f32_16x16x32_bf16(G[mt], SB[s_], V[mt], 0, 0, 0); Q[mt] = __builtin_amdgcn_mfma_f32_16x16x32_bf16(SB[s_], G[4 + mt], Q[mt], 0, 0, 0); } } while (0)
#define LD_K(G, s2_) do { _Pragma("unroll") for (int kt = 0; kt < 8; ++kt) { const int xr_ = (8 * kt + (fr >> 1)) & 15; G[kt] = *(const LAS bf16x8*)(Bk + offk[kt] + (((p128 | (4 * (s2_) + fq)) ^ xr_) << 4)); } } while (0)
#define SCHED_() __builtin_amdgcn_sched_barrier(0)
        bf16x8 g0[8], g1[8];
        LD_WQ(g0, 0);
        bf16x8 SB[4];
#pragma unroll
        for (int s = 0; s < 4; ++s) SB[s] = pack_b(S[2 * s], S[2 * s + 1]);
        f32x4 V[4], Q[4];
#pragma unroll
        for (int mt = 0; mt < 4; ++mt) { V[mt] = (f32x4){0.f, 0.f, 0.f, 0.f}; Q[mt] = (f32x4){0.f, 0.f, 0.f, 0.f}; }
        SCHED_(); LD_WQ(g1, 1); SCHED_(); MM_WQ(g0, 0); SCHED_();
        LD_WQ(g0, 2); SCHED_(); MM_WQ(g1, 1); SCHED_();
        LD_WQ(g1, 3); SCHED_(); MM_WQ(g0, 2); SCHED_();
#pragma unroll
        for (int s2 = 0; s2 < 2; ++s2)
#pragma unroll
            for (int mt = 0; mt < 4; ++mt) { const int xr = (8 * mt + (fr >> 1)) & 15; g0[s2 * 4 + mt] = *(const LAS bf16x8*)(Ba + offa[mt] + (((p128 | (4 * s2 + fq)) ^ xr) << 4)); }
        SCHED_(); MM_WQ(g1, 3); SCHED_();
        LD_K(g1, 0); SCHED_();
        {
            float uu[16]; { float t[8]; unpack8(u0, t);
#pragma unroll
                for (int e = 0; e < 8; ++e) uu[e] = t[e]; unpack8(u1, t);
#pragma unroll
                for (int e = 0; e < 8; ++e) uu[8 + e] = t[e]; }
#pragma unroll
            for (int mt = 0; mt < 4; ++mt)
#pragma unroll
                for (int r = 0; r < 4; ++r) V[mt][r] = uu[mt * 4 + r] - V[mt][r];
        }
        bf16x8 VB[2];
#pragma unroll
        for (int s2 = 0; s2 < 2; ++s2) VB[s2] = pack_b(V[2 * s2], V[2 * s2 + 1]);
#pragma unroll
        for (int kt = 0; kt < 8; ++kt) S[kt] = S[kt] * egl;
        SCHED_();
#pragma unroll
        for (int s2 = 0; s2 < 2; ++s2)
#pragma unroll
            for (int mt = 0; mt < 4; ++mt) Q[mt] = __builtin_amdgcn_mfma_f32_16x16x32_bf16(VB[s2], g0[s2 * 4 + mt], Q[mt], 0, 0, 0);
        SCHED_(); LD_K(g0, 1); SCHED_();
#pragma unroll
        for (int kt = 0; kt < 8; ++kt) S[kt] = __builtin_amdgcn_mfma_f32_16x16x32_bf16(g1[kt], VB[0], S[kt], 0, 0, 0);
        SCHED_();
#pragma unroll
        for (int kt = 0; kt < 8; ++kt) S[kt] = __builtin_amdgcn_mfma_f32_16x16x32_bf16(g0[kt], VB[1], S[kt], 0, 0, 0);
        SCHED_();
#undef LD_WQ
#undef MM_WQ
#undef LD_K
#undef SCHED_
#pragma unroll
        for (int mt = 0; mt < 4; ++mt) {
            const int i = 16 * mt + fr; const int tok = b * SEQ + n * CH + (d ? 63 - i : i);
            u32x2 w2; w2.x = cvt_pk_bf16(Q[mt][0], Q[mt][1]); w2.y = cvt_pk_bf16(Q[mt][2], Q[mt][3]);
            *(GAS u32x2*)(O + (size_t)tok * MIXW + h * HD + slice * 16 + 4 * fq) = w2;
        }
        SCAN_BAR();
    }
}

constexpr int MQ_OFF = 0, MK_OFF = 9216, MV_OFF = 18432, MQK_OFF = 35840, MVEC_OFF = 52480;
constexpr int MQROW = 144;
#ifndef MLREP_1
#define MLREP_1 1
#endif
#ifndef MLREP_2
#define MLREP_2 1
#endif
#ifndef MLREP_3
#define MLREP_3 1
#endif
#ifndef MLREP_4
#define MLREP_4 1
#endif
#ifndef POOLREP
#define POOLREP 1
#endif
__device__ __forceinline__ void ml_prep(const Frame& F, int l) {
    LAS unsigned char* L = F.lds;
    const int lane = F.lane, wave = F.wave, tid = F.tid;
    const GAS bf16* PQ = (const GAS bf16*)(F.ws + WS_PMQ); const GAS bf16* PK = (const GAS bf16*)(F.ws + WS_PMK); const GAS bf16* PV = (const GAS bf16*)(F.ws + WS_PMV);
    const GAS float* SG = (const GAS float*)(F.ws + WS_SG);
    const GAS float* gbias = inp(F, I_ML_GATE_B) + l * 16;
    u32x4 pq, pk, pv0, pv1; float pip = 0.f, pfp = 0.f;
#define ML_PF(item_) do { const int it_ = (item_) < NB * NHEAD * NCH ? (item_) : F.wg; const int b_ = it_ >> 9, h_ = (it_ >> 7) & 3, n_ = it_ & 127; const int t0_ = b_ * SEQ + n_ * CH; \
        const int row_ = tid >> 3, c8_ = tid & 7; \
        pq = *(const GAS u32x4*)(PQ + (size_t)(t0_ + row_) * 256 + h_ * 64 + 8 * c8_); pk = *(const GAS u32x4*)(PK + (size_t)(t0_ + row_) * 256 + h_ * 64 + 8 * c8_); \
        pv0 = *(const GAS u32x4*)(PV + (size_t)(t0_ + (tid >> 4)) * 512 + h_ * 128 + 8 * (tid & 15)); pv1 = *(const GAS u32x4*)(PV + (size_t)(t0_ + 32 + (tid >> 4)) * 512 + h_ * 128 + 8 * (tid & 15)); \
        if (wave < 2) { const int ti_ = wave ? 63 - lane : lane; pip = SG[(size_t)(t0_ + ti_) * 32 + 16 + wave * 4 + h_]; pfp = SG[(size_t)(t0_ + ti_) * 32 + 24 + wave * 4 + h_]; } } while (0)
    ML_PF(F.wg);
    for (int item = F.wg; item < NB * NHEAD * NCH; item += F.G) {
        const int b = item >> 9, h = (item >> 7) & 3, n = item & 127;
        const int t0 = b * SEQ + n * CH;
        float ip_raw = pip, fp_raw = pfp;
        for (int rep1 = 0; rep1 < MLREP_1; ++rep1) {
        {
            const int row = tid >> 3, c8 = tid & 7;
            u32x4 k = pk;
            { float f[8]; unpack8(k, f); k.x = cvt_pk_bf16(f[0] * 0.125f, f[1] * 0.125f); k.y = cvt_pk_bf16(f[2] * 0.125f, f[3] * 0.125f); k.z = cvt_pk_bf16(f[4] * 0.125f, f[5] * 0.125f); k.w = cvt_pk_bf16(f[6] * 0.125f, f[7] * 0.125f); }
            *(LAS u32x4*)(L + MQ_OFF + row * MQROW + 16 * c8) = pq;
            *(LAS u32x4*)(L + MK_OFF + row * MQROW + 16 * c8) = k;
            *(LAS u32x4*)(L + MV_OFF + (tid >> 4) * QROW + 16 * (tid & 15)) = pv0;
            *(LAS u32x4*)(L + MV_OFF + (32 + (tid >> 4)) * QROW + 16 * (tid & 15)) = pv1;
            ML_PF(item + F.G);
        }
        PREP_BAR();
        }
        for (int rep2 = 0; rep2 < MLREP_2; ++rep2) {
        {
            const int fr = lane & 15, fq = lane >> 4;
#pragma unroll
            for (int tt = 0; tt < 2; ++tt) {
                const int t = 2 * wave + tt, mt = t >> 2, nt = t & 3;
                f32x4 aq = (f32x4){0.f, 0.f, 0.f, 0.f};
#pragma unroll
                for (int s2 = 0; s2 < 2; ++s2) {
                    const bf16x8 qa = *(const LAS bf16x8*)(L + MQ_OFF + (16 * mt + fr) * MQROW + 64 * s2 + 16 * fq);
                    const bf16x8 kb = *(const LAS bf16x8*)(L + MK_OFF + (16 * nt + fr) * MQROW + 64 * s2 + 16 * fq);
                    aq = __builtin_amdgcn_mfma_f32_16x16x32_bf16(qa, kb, aq, 0, 0, 0);
                }
#pragma unroll
                for (int r = 0; r < 4; ++r) *(LAS float*)(L + MQK_OFF + ((16 * mt + 4 * fq + r) * 65 + 16 * nt + fr) * 4) = aq[r];
            }
        }
        }
        for (int rep3 = 0; rep3 < MLREP_3; ++rep3) {
        if (wave < 2) {
            const int d = wave; const int ti = d ? 63 - lane : lane;
            const float ip = ip_raw + gbias[d * 4 + h];
            const float fp = fp_raw + gbias[8 + d * 4 + h];
            const float bc = wave_incl_scan(logsigmoidf_(fp), lane);
            const float bl = __shfl(bc, 63);
            const float lw = bl - bc + ip;
            const float am = wave_max(lw);
            const float wgt = expf(lw - am);
            const float ipb = ip - bc;
            const float dmax = bc + wave_incl_maxscan(ipb, lane);
            LAS float* vec = (LAS float*)(L + MVEC_OFF + d * 1024);
            vec[lane] = bc; vec[64 + lane] = dmax; vec[128 + lane] = wgt; vec[192 + lane] = ipb;
            GAS float* row = (GAS float*)(F.ws + WS_ML + ((size_t)item * 2 + d) * MLREC + ML_ROW);
            row[lane] = bc; row[64 + lane] = dmax; if (lane == 0) { row[128] = am; row[129] = bl; }
        }
        PREP_BAR();
        }
        for (int rep4 = 0; rep4 < MLREP_4; ++rep4) {
        {
            const LAS float* QKM = (const LAS float*)(L + MQK_OFF);
            for (int it = wave; it < 128; it += NWAVES) {
                const int d = it >> 6, i = it & 63, j = lane;
                const LAS float* vec = (const LAS float*)(L + MVEC_OFF + d * 1024);
                GAS unsigned char* rec = F.ws + WS_ML + ((size_t)item * 2 + d) * MLREC;
                const int ti = d ? 63 - i : i, tj = d ? 63 - j : j;
                const float sv = (j <= i) ? QKM[ti * 65 + tj] * fexp(fminf(vec[i] + vec[192 + j] - vec[64 + i], 0.f)) : 0.f;
                ((GAS bf16*)(rec + ML_ST))[i * 64 + j] = bf1(sv);
                ((GAS bf16*)(rec + ML_Q))[i * 64 + j] = *(const LAS unsigned short*)(L + MQ_OFF + ti * MQROW + 2 * ((j & ~31) + sigma32(j & 31)));
                const float kv = bf2f(*(const LAS unsigned short*)(L + MK_OFF + tj * MQROW + 2 * i));
                ((GAS bf16*)(rec + ML_KWT))[i * 64 + j] = bf1(kv * vec[128 + j]);
            }
            for (int it = wave; it < 36; it += NWAVES) {
                const int d = it / 18, q = it - 18 * d, slice = q >> 1, s2 = q & 1;
                GAS unsigned char* rec = F.ws + WS_ML + ((size_t)item * 2 + d) * MLREC;
                const int fr = lane & 15, fq = lane >> 4;
                unsigned short e8[8];
#pragma unroll
                for (int el = 0; el < 8; ++el) { const int j = 32 * s2 + 8 * fq + el; const int tj = d ? 63 - j : j;
                    e8[el] = (slice < 8) ? *(const LAS unsigned short*)(L + MV_OFF + tj * QROW + 2 * (16 * slice + fr)) : (unsigned short)0x3F80; }
                u32x4 w; w.x = e8[0] | ((unsigned)e8[1] << 16); w.y = e8[2] | ((unsigned)e8[3] << 16); w.z = e8[4] | ((unsigned)e8[5] << 16); w.w = e8[6] | ((unsigned)e8[7] << 16);
                *(GAS u32x4*)(rec + ML_VF + (((slice * 2 + s2) * 64 + lane) * 8) * 2) = w;
            }
        }
        PREP_BAR();
        }
    }
}
constexpr int MLBUF = 25600;
__device__ __forceinline__ void ml_scan(const Frame& F) {
    if (F.wg >= 96) return;
    const int xcd = F.wg & 7, idx = F.wg >> 3;
    const int chain = xcd * 4 + idx / 3, third = idx % 3;
    const int b = chain >> 3, h = (chain >> 1) & 3, d = chain & 1;
    const int lane = F.lane, fr = lane & 15, fq = lane >> 4, wave = F.wave;
    LAS unsigned char* L = F.lds;
    const GAS unsigned char* recbase = F.ws + WS_ML;
    const int itembase = (b * NHEAD + h) * NCH;
    if (wave >= 3) {
        const int tl = F.tid - 192;
        u32x4 ra[5], rb[5]; int woff[5], goff[5];
#pragma unroll
        for (int i = 0; i < 5; ++i) { const int q = tl + 320 * i;
            if (q < 1536) { const int qq = q & 511; woff[i] = (q >> 9) * 8192 + swz128(qq >> 3, qq & 7); goff[i] = q; }
            else { woff[i] = 24576 + (q - 1536) * 16; goff[i] = 2688 + (q - 1536); } }
#define ML_LOAD(R, step_) do { const int st_ = (step_) < NCH ? (step_) : NCH - 1; const int n_ = d ? (NCH - 1 - st_) : st_; \
        const GAS u32x4* src_ = (const GAS u32x4*)(recbase + ((size_t)(itembase + n_) * 2 + d) * MLREC); \
        _Pragma("unroll") for (int i = 0; i < 5; ++i) R[i] = src_[goff[i]]; } while (0)
#define ML_WRITE(R, bufoff_) do { _Pragma("unroll") for (int i = 0; i < 5; ++i) *(LAS u32x4*)(L + (bufoff_) + woff[i]) = R[i]; } while (0)
        ML_LOAD(ra, 0); ML_LOAD(rb, 1);
        ML_WRITE(ra, 0);
        SCAN_BAR();
        for (int s = 0; s < NCH; s += 2) {
            ML_LOAD(ra, s + 2); ML_WRITE(rb, MLBUF); SCAN_BAR();
            ML_LOAD(rb, s + 3); ML_WRITE(ra, 0);     SCAN_BAR();
        }
#undef ML_LOAD
#undef ML_WRITE
        return;
    }
    const int slice = third * 3 + wave;
    const bool active = true;
    GAS bf16* NUM = (GAS bf16*)(F.ws + (d ? WS_NUMB : WS_NUMF)); GAS float* DEN = (GAS float*)(F.ws + WS_DEN);
    f32x4 C[4];
#pragma unroll
    for (int k = 0; k < 4; ++k) C[k] = (f32x4){0.f, 0.f, 0.f, 0.f};
    float m = 0.f;
    int offr[4];
#pragma unroll
    for (int t = 0; t < 4; ++t) offr[t] = ((16 * t + fr) >> 1) * 256;
    const int p128 = (fr & 1) << 3;
    bf16x8 vc0, vc1, vn0, vn1;
#define ML_VFETCH(A0, A1, step_) do { const int st_ = (step_) < NCH ? (step_) : NCH - 1; const int nn_ = d ? (NCH - 1 - st_) : st_; \
        const GAS bf16* Vf_ = (const GAS bf16*)(recbase + ((size_t)(itembase + nn_) * 2 + d) * MLREC + ML_VF); \
        A0 = *(const GAS bf16x8*)(Vf_ + ((slice * 2 + 0) * 64 + lane) * 8); A1 = *(const GAS bf16x8*)(Vf_ + ((slice * 2 + 1) * 64 + lane) * 8); } while (0)
    ML_VFETCH(vc0, vc1, 0); ML_VFETCH(vn0, vn1, 1);
    SCAN_BAR();
    for (int step = 0; step < NCH; ++step) {
        const int n = d ? (NCH - 1 - step) : step;
        const int bufoff = (step & 1) ? MLBUF : 0;
        bf16x8 VF[2]; VF[0] = vc0; VF[1] = vc1;
        vc0 = vn0; vc1 = vn1;
        ML_VFETCH(vn0, vn1, step + 2);
        if (active) {
        const LAS unsigned char* Bq = L + bufoff; const LAS unsigned char* Bs = Bq + 8192; const LAS unsigned char* Bk = Bq + 16384; const LAS float* row = (const LAS float*)(Bq + 24576);
        const float am = row[128], bl = row[129];
        bf16x8 CB[2];
#pragma unroll
        for (int s = 0; s < 2; ++s) CB[s] = pack_b(C[2 * s], C[2 * s + 1]);
        bf16x8 fq_[8], fs_[8], fk_[8];
#pragma unroll
        for (int s = 0; s < 2; ++s)
#pragma unroll
            for (int mt = 0; mt < 4; ++mt) { const int xr = (8 * mt + (fr >> 1)) & 15; const int o = offr[mt] + (((p128 | (4 * s + fq)) ^ xr) << 4);
                fq_[s * 4 + mt] = *(const LAS bf16x8*)(Bq + o); fs_[s * 4 + mt] = *(const LAS bf16x8*)(Bs + o); fk_[s * 4 + mt] = *(const LAS bf16x8*)(Bk + o); }
        f32x4 QC[4], SV[4], KV[4];
#pragma unroll
        for (int mt = 0; mt < 4; ++mt) { QC[mt] = (f32x4){0.f, 0.f, 0.f, 0.f}; SV[mt] = (f32x4){0.f, 0.f, 0.f, 0.f}; KV[mt] = (f32x4){0.f, 0.f, 0.f, 0.f}; }
#pragma unroll
        for (int s = 0; s < 2; ++s)
#pragma unroll
            for (int mt = 0; mt < 4; ++mt) {
                QC[mt] = __builtin_amdgcn_mfma_f32_16x16x32_bf16(CB[s], fq_[s * 4 + mt], QC[mt], 0, 0, 0);
                SV[mt] = __builtin_amdgcn_mfma_f32_16x16x32_bf16(VF[s], fs_[s * 4 + mt], SV[mt], 0, 0, 0);
                KV[mt] = __builtin_amdgcn_mfma_f32_16x16x32_bf16(fk_[s * 4 + mt], VF[s], KV[mt], 0, 0, 0);
            }
#pragma unroll
        for (int mt = 0; mt < 4; ++mt) {
            const int i = 16 * mt + fr; const int tok = b * SEQ + n * CH + (d ? 63 - i : i);
            const float bci = row[i], dmi = row[64 + i];
            const float il = bci + m, mo = fmaxf(il, dmi);
            const float inter = fexp(il - mo), e2 = fexp(dmi - mo);
            const f32x4 res = QC[mt] * inter + SV[mt] * e2;
            if (slice < 8) { u32x2 w2; w2.x = cvt_pk_bf16(res[0], res[1]); w2.y = cvt_pk_bf16(res[2], res[3]); *(GAS u32x2*)(NUM + (size_t)tok * MIXW + h * HD + slice * 16 + 4 * fq) = w2; }
            else if (fq == 0) DEN[(size_t)tok * 8 + h * 2 + d] = fmaxf(fabsf(res[0]), fexp(-mo));
        }
        const float mn = fmaxf(bl + m, am), sp = fexp(bl + m - mn), sc = fexp(am - mn);
#pragma unroll
        for (int kt = 0; kt < 4; ++kt) C[kt] = C[kt] * sp + KV[kt] * sc;
        m = mn;
        }
        SCAN_BAR();
    }
}

template <int H>
__device__ __forceinline__ void pool_block(const GAS bf16* U, GAS bf16* Y, int t0, int g, int lane) {
    constexpr int NR = 32 + 2 * H;
    const int sp0 = t0 & (SEQ - 1);
    float x0[NR], x1[NR];
#pragma unroll
    for (int r = 0; r < NR; ++r) {
        const int sp = sp0 - H + r; const bool ok = (sp >= 0 && sp < SEQ);
        const unsigned u = ok ? *(const GAS unsigned*)(U + (size_t)(t0 - H + r) * MIXW + 128 * g + 2 * lane) : 0u;
        x0[r] = bf2f(u & 0xffffu); x1[r] = bf2f(u >> 16);
    }
    float s0 = 0.f, s1 = 0.f;
#pragma unroll
    for (int r = 0; r < 2 * H; ++r) { s0 += x0[r]; s1 += x1[r]; }
#pragma unroll
    for (int t = 0; t < 32; ++t) {
        const int sp = sp0 + t; const int cnt = min(sp + H, SEQ) - max(sp - H, 0);
        const float inv = 1.0f / (float)cnt;
        *(GAS unsigned*)(Y + (size_t)(t0 + t) * MIXW + 128 * g + 2 * lane) = cvt_pk_bf16(s0 * inv - x0[t + H], s1 * inv - x1[t + H]);
        if (t < 31) { s0 += x0[t + 2 * H] - x0[t]; s1 += x1[t + 2 * H] - x1[t]; }
    }
}
__device__ __forceinline__ void pool_phase(const Frame& F) {
    const GAS bf16* U = (const GAS bf16*)(F.ws + WS_PPOOL); GAS bf16* Y = (GAS bf16*)(F.ws + WS_YP);
    const int gw = F.wg * NWAVES + F.wave, NGW = F.G * NWAVES, lane = F.lane;
    for (int prep = 0; prep < POOLREP; ++prep)
    for (int task = gw; task < (T / 32) * 4; task += NGW) {
        const int g = task & 3, t0 = (task >> 2) * 32;
        if (g == 0) pool_block<1>(U, Y, t0, g, lane); else if (g == 1) pool_block<2>(U, Y, t0, g, lane); else if (g == 2) pool_block<4>(U, Y, t0, g, lane); else pool_block<8>(U, Y, t0, g, lane);
    }
}

__device__ __forceinline__ void norm_phase(const Frame& F, int l, bool dummy, const int which, const int wg0, const int nwg) {
    const GAS bf16* OF = (const GAS bf16*)(F.ws + WS_OF); const GAS bf16* OB = (const GAS bf16*)(F.ws + WS_OB);
    const GAS bf16* NF = (const GAS bf16*)(F.ws + WS_NUMF); const GAS bf16* NBk = (const GAS bf16*)(F.ws + WS_NUMB); const GAS float* DEN = (const GAS float*)(F.ws + WS_DEN);
    GAS bf16* Z = (GAS bf16*)(F.ws + WS_PZ); GAS bf16* MO = (GAS bf16*)(F.ws + WS_PMO);
    GAS bf16* ZO = dummy ? (GAS bf16*)(F.ws + WS_GATE) : Z; GAS bf16* MOO = dummy ? (GAS bf16*)(F.ws + WS_GATE + 32 * MiB) : MO;
    const int gw = (F.wg - wg0) * NWAVES + F.wave, NGW = nwg * NWAVES, lane = F.lane, h = lane >> 4;
    float nw[8], mw[8];
#pragma unroll
    for (int e = 0; e < 8; ++e) { nw[e] = inp(F, I_DN_NORM)[l * MIXW + 8 * lane + e]; mw[e] = inp(F, I_ML_NORM)[l * MIXW + 8 * lane + e]; }
    for (int t = gw; t < T; t += NGW) {
        const size_t off = (size_t)t * MIXW + 8 * lane;
        if (which != 2) {
            float a[8], bq[8], z[8]; unpack8(*(const GAS u32x4*)(OF + off), a); unpack8(*(const GAS u32x4*)(OB + off), bq); unpack8(*(const GAS u32x4*)(Z + off), z);
            float ss = 0.f;
#pragma unroll
            for (int e = 0; e < 8; ++e) { a[e] += bq[e]; ss += a[e] * a[e]; }
            ss += __shfl_xor(ss, 1); ss += __shfl_xor(ss, 2); ss += __shfl_xor(ss, 4); ss += __shfl_xor(ss, 8);
            const float r = 1.0f / sqrtf(ss * (1.f / HD) + NORM_EPS);
            float o[8];
#pragma unroll
            for (int e = 0; e < 8; ++e) o[e] = a[e] * r * nw[e] * siluf_(z[e]);
            u32x4 w; w.x = cvt_pk_bf16(o[0], o[1]); w.y = cvt_pk_bf16(o[2], o[3]); w.z = cvt_pk_bf16(o[4], o[5]); w.w = cvt_pk_bf16(o[6], o[7]);
            *(GAS u32x4*)(ZO + off) = w;
        }
        if (which != 1) {
            float a[8], bq[8], g[8]; unpack8(*(const GAS u32x4*)(NF + off), a); unpack8(*(const GAS u32x4*)(NBk + off), bq); unpack8(*(const GAS u32x4*)(MO + off), g);
            const float df = 1.0f / DEN[(size_t)t * 8 + h * 2], db = 1.0f / DEN[(size_t)t * 8 + h * 2 + 1];
            float s = 0.f;
#pragma unroll
            for (int e = 0; e < 8; ++e) { a[e] = a[e] * df + bq[e] * db; s += a[e]; }
            s += __shfl_xor(s, 1); s += __shfl_xor(s, 2); s += __shfl_xor(s, 4); s += __shfl_xor(s, 8);
            const float mean = s * (1.f / HD); float ss = 0.f;
#pragma unroll
            for (int e = 0; e < 8; ++e) { a[e] -= mean; ss += a[e] * a[e]; }
            ss += __shfl_xor(ss, 1); ss += __shfl_xor(ss, 2); ss += __shfl_xor(ss, 4); ss += __shfl_xor(ss, 8);
            const float r = 1.0f / sqrtf(ss * (1.f / HD) + NORM_EPS);
            float o[8];
#pragma unroll
            for (int e = 0; e < 8; ++e) o[e] = a[e] * r * mw[e] * sigmoidf_(g[e]);
            u32x4 w; w.x = cvt_pk_bf16(o[0], o[1]); w.y = cvt_pk_bf16(o[2], o[3]); w.z = cvt_pk_bf16(o[4], o[5]); w.w = cvt_pk_bf16(o[6], o[7]);
            *(GAS u32x4*)(MOO + off) = w;
        }
    }
}

__device__ __forceinline__ void moe_tables(const Frame& F) {
    LAS int* cnt = (LAS int*)(F.lds + LHIST_OFF + 128); LAS int* pstart = (LAS int*)(F.lds + LHIST_OFF + 256); LAS int* mybase = (LAS int*)(F.lds + LHIST_OFF + 384);
    LAS int* pe = (LAS int*)(F.lds + LPE_OFF);
    const GAS int* hist = (const GAS int*)(F.ws + WS_HIST);
    if (F.tid < 32) { cnt[F.tid] = 0; mybase[F.tid] = 0; }
    __syncthreads();
    { const int e = F.tid & 31, part = F.tid >> 5; int tot = 0, base = 0;
      for (int q = 0; q < 16; ++q) { const int w = part * 16 + q; const int v = hist[w * 32 + e]; tot += v; base += v * min(max(F.wg - w, 0), 1); }
      __hip_atomic_fetch_add(cnt + e, tot, __ATOMIC_RELAXED, __HIP_MEMORY_SCOPE_WORKGROUP); __hip_atomic_fetch_add(mybase + e, base, __ATOMIC_RELAXED, __HIP_MEMORY_SCOPE_WORKGROUP); }
    __syncthreads();
    if (F.tid == 0) { int acc = 0, p = 0; for (int e = 0; e < NEXP; ++e) { pstart[e] = acc; const int np = (cnt[e] + 255) >> 8; for (int q = 0; q < np; ++q) pe[p++] = e; acc += np * 256; } pe[319] = p; }
    __syncthreads();
}
__device__ __forceinline__ void moe_dispatch(const Frame& F) {
    moe_tables(F);
    LAS int* pstart = (LAS int*)(F.lds + LHIST_OFF + 256); LAS int* mybase = (LAS int*)(F.lds + LHIST_OFF + 384);
    LAS int* lpos = (LAS int*)(F.lds);
    LAS int* le = (LAS int*)(F.lds + 1024);
    const GAS int* eid = (const GAS int*)(F.ws + WS_EID); const GAS float* ew = (const GAS float*)(F.ws + WS_EW);
    GAS int* pos = (GAS int*)(F.ws + WS_POS); GAS float* roww = (GAS float*)(F.ws + WS_ROWW);
    const int rows_per_wg = T / F.G, row0 = F.wg * rows_per_wg;
    int my_e = 0; float my_w = 0.f;
    if (F.tid < 256) { my_e = eid[2 * row0 + F.tid]; my_w = ew[2 * row0 + F.tid]; le[F.tid] = my_e; }
    __syncthreads();
    if (F.tid < 256) {
        int rank = 0;
        for (int a = 0; a < F.tid; ++a) rank += (le[a] == my_e) ? 1 : 0;
        const int p = pstart[my_e] + mybase[my_e] + rank;
        lpos[F.tid] = p; pos[2 * row0 + F.tid] = p; roww[p] = my_w; ((GAS int*)(F.ws + WS_ROWTOK))[p] = row0 + (F.tid >> 1);
    }
    __syncthreads();
    if (F.wg == 0 && F.tid < 32) { LAS int* cnt = (LAS int*)(F.lds + LHIST_OFF + 128); const int e = F.tid; const int c0 = cnt[e], pc = (c0 + 255) & ~255;
        GAS int* rt = (GAS int*)(F.ws + WS_ROWTOK); for (int q = c0; q < pc; ++q) rt[pstart[e] + q] = 0; }
    __syncthreads();
}

constexpr int NPHASE = 1 + 15 * DEPTH;
#ifndef PHM
#define PHM 0xFFFF
#endif
#define PHON(b) ((PHM >> (b)) & 1)
#ifndef REPEAT_PHASE
#define REPEAT_PHASE -1
#endif
#define NREP(k) (((k) == REPEAT_PHASE) ? 2 : 1)
__global__ void __launch_bounds__(NWAVES * 64, 2) mega_fwd(Args args) {
    extern __shared__ __attribute__((aligned(16))) unsigned char lds_raw[];
    LAS unsigned char* lds = (LAS unsigned char*)lds_raw;
    const int wave = __builtin_amdgcn_readfirstlane((int)threadIdx.x >> 6);
    for (int u = threadIdx.x; u < (LDS_BYTES - RING_BYTES) / 4; u += NWAVES * 64) ((LAS unsigned*)(lds + RING_BYTES))[u] = 0u;
    __syncthreads();
    if (threadIdx.x == 0) { LAS unsigned long long* ap = (LAS unsigned long long*)(lds + LARG_OFF);
#pragma unroll
        for (int i = 0; i < 23; ++i) ap[i] = (unsigned long long)args.in[i];
        ap[23] = (unsigned long long)args.out; ap[24] = (unsigned long long)args.ws; }
    __syncthreads();
    const int lo = args.ph_lo, hi = args.ph_hi;
    if (hi - lo > 1) { const XcdBarrier b0 = xcd_barrier_post((unsigned*)(args.ws + WS_CTL) + CW_BAR, (volatile LAS unsigned*)(lds + MISC_OFF) + 8);
        if (threadIdx.x == 0) ((volatile LAS unsigned*)(lds + MISC_OFF))[10] = b0.x; }
    __syncthreads();
#ifdef DIAG
    if (threadIdx.x == 0 && blockIdx.x == 0 && lo == 0) ((unsigned long long*)(args.ws + WS_CTL + 1024))[0] = __builtin_amdgcn_s_memrealtime();
#endif
    int ph = lo, rep = 0;
#pragma unroll 1
    while (ph < hi) {
        const Frame F = fresh(lds, wave);
        const bool DRY = (REPEAT_PHASE >= 0) && (rep == 0) && (((ph >= 1) ? ((ph - 1) % 15) : 15) == REPEAT_PHASE);
        const int l = (ph >= 1) ? (ph - 1) / 15 : 0;
        const int k = (ph >= 1) ? (ph - 1) - 15 * l : 15;
        if (PHON(15) && k == 15) {
            wprep_mixer(F, 0);
            __syncthreads();
            ln_phase<0>(F, inp(F, I_LN_IN_G), inp(F, I_LN_IN_B), inp(F, I_W_IN), DIN, true, true, DRY);
        } else if (PHON(0) && k == 0) {
            pg8::StaticOrder S; S.init(F.ws + WS_HB, F.ws + WS_WIN, T, 1536, D, F.G, F.wg);
            EpiG1a E{(GAS bf16*)(F.ws + WS_PQKV)};
            pg8::gemm_phase<EpiG1a, pg8::StaticOrder>(F.lds, F.tid, D, S, E);
        } else if (PHON(1) && k == 1) { dn_prep(F, l);
        } else if (PHON(2) && k == 2) { if (F.wg < 128) dn_scan(F); else wprep_moe(F, l, 128, 128);
        } else if (PHON(3) && k == 3) {
            pg8::StaticOrder S; S.init(F.ws + WS_HB, F.ws + WS_WIN + (size_t)1536 * D * 2, T, 2560, D, F.G, F.wg);
            EpiG1b E{F.ws};
            pg8::gemm_phase<EpiG1b, pg8::StaticOrder>(F.lds, F.tid, D, S, E);
        } else if (PHON(4) && k == 4) { pool_phase(F); ml_prep(F, l);
        } else if (PHON(5) && k == 5) { if (F.wg < 96) ml_scan(F); else norm_phase(F, l, false, 1, 96, 160);
        } else if (PHON(6) && k == 6) { norm_phase(F, l, DRY, 2, 0, 256);
        } else if (PHON(7) && k == 7) {
            pg8::StaticOrder S; S.init(F.ws + WS_HB, F.ws + WS_WGATE, T, 3072, D, F.G, F.wg);
            EpiGate E{(GAS bf16*)(F.ws + WS_GATE)};
            pg8::gemm_phase<EpiGate, pg8::StaticOrder>(F.lds, F.tid, D, S, E);
        } else if (PHON(8) && k == 8) {
            MergeOrder S; S.Y[0] = (const GAS char*)(F.ws + WS_PZ); S.Y[1] = (const GAS char*)(F.ws + WS_YP); S.Y[2] = (const GAS char*)(F.ws + WS_PMO); S.W = (const GAS char*)(F.ws + WS_WBR); S.G = F.G; S.c = F.wg;
            EpiMerge E{(const GAS bf16*)(F.ws + WS_GATE), (GAS bf16*)(F.ws + WS_MRGP), (GAS bf16*)(F.ws + WS_FIN)};
            pg8::gemm_phase<EpiMerge, MergeOrder>(F.lds, F.tid, MIXW, S, E);
        } else if (PHON(9) && k == 9) {
            pg8::StaticOrder S; S.init(F.ws + WS_FIN, F.ws + WS_WOUT, T, D, D, F.G, F.wg);
            EpiOut E{(const GAS bf16*)(F.ws + WS_HB), DRY ? (GAS bf16*)(F.ws + WS_R2) : (GAS bf16*)F.out};
            pg8::gemm_phase<EpiOut, pg8::StaticOrder>(F.lds, F.tid, D, S, E);
        } else if (PHON(10) && k == 10) {
            ln_phase<1>(F, inp(F, I_LN_MIX_G) + l * D, inp(F, I_LN_MIX_B) + l * D, inp(F, I_ROUTER_W), 32, true, true, DRY);
        } else if (PHON(11) && k == 11) { moe_dispatch(F);
        } else if (PHON(12) && k == 12) {
            moe_tables(F);
            MoeOrder<D, true> S; S.rowtok = (const GAS int*)(F.ws + WS_ROWTOK); S.A = (const GAS char*)(F.ws + WS_HB); S.W = (const GAS char*)((GAS unsigned char*)F.out + 64 * MiB); S.pe = (const LAS int*)(F.lds + LPE_OFF); S.c = F.wg; S.NP = __builtin_amdgcn_readfirstlane(S.pe[319]);
            EpiMoe1 E{(GAS bf16*)(F.ws + WS_ACT)};
            pg8::gemm_phase<EpiMoe1, MoeOrder<D, true>>(F.lds, F.tid, D, S, E);
        } else if (PHON(13) && k == 13) {
            moe_tables(F);
            MoeOrder<DEXP, false> S; S.rowtok = nullptr; S.A = (const GAS char*)(F.ws + WS_ACT); S.W = (const GAS char*)(F.ws + WS_W2); S.pe = (const LAS int*)(F.lds + LPE_OFF); S.c = F.wg; S.NP = __builtin_amdgcn_readfirstlane(S.pe[319]);
            EpiMoe2 E{(GAS bf16*)(F.ws + WS_YROWS), (const GAS float*)(F.ws + WS_ROWW)};
            pg8::gemm_phase<EpiMoe2, MoeOrder<DEXP, false>>(F.lds, F.tid, DEXP, S, E);
        } else if (PHON(14)) {
            const bool last = (l == DEPTH - 1);
            if (!last) { wprep_mixer(F, l + 1); __syncthreads(); }
            ln_phase<2>(F, inp(F, I_LN_FFN_G) + l * D, inp(F, I_LN_FFN_B) + l * D, inp(F, I_W_IN) + (size_t)(last ? l : l + 1) * D * DIN, DIN, !last, !last, DRY);
        }
        const bool again = (k == REPEAT_PHASE) && (rep == 0);
        if (again) rep = 1; else { rep = 0; ++ph; }
        if (ph < hi) { XcdBarrier bar; bar.bar = (unsigned*)(unsigned char*)(F.ws + WS_CTL) + CW_BAR; bar.st = (volatile LAS unsigned*)(F.lds + MISC_OFF) + 8; bar.x = __builtin_amdgcn_readfirstlane(bar.st[2]); xcd_barrier(bar, F.tid); }
#ifdef DIAG
        if (!again && F.tid == 0 && F.wg == 0) ((unsigned long long*)(F.ws + WS_CTL + 1024))[ph] = __builtin_amdgcn_s_memrealtime();
#endif
    }
}

#ifndef N_LAUNCH_MODE
#define N_LAUNCH_MODE 1
#endif
extern "C" void kernel_launch(void* const* d_in, const int* in_sizes, int n_in, void* d_out, int out_size, void* d_ws, size_t ws_size, hipStream_t stream) {
    static int grid = 0;
    if (grid == 0) {
        if (n_in != 23 || out_size != T * D || ws_size < WS_END) { fprintf(stderr, "kernel_launch: unexpected shapes (n_in %d out %d ws %zu)\n", n_in, out_size, ws_size); grid = -1; return; }
        int dev = 0, cus = 0, per_cu = 0;
        if (hipGetDevice(&dev) != hipSuccess || hipDeviceGetAttribute(&cus, hipDeviceAttributeMultiprocessorCount, dev) != hipSuccess) { grid = -1; return; }
        if (hipFuncSetAttribute((const void*)mega_fwd, hipFuncAttributeMaxDynamicSharedMemorySize, LDS_BYTES) != hipSuccess) { fprintf(stderr, "kernel_launch: hipFuncSetAttribute failed\n"); grid = -1; return; }
        (void)hipOccupancyMaxActiveBlocksPerMultiprocessor(&per_cu, (const void*)mega_fwd, NWAVES * 64, LDS_BYTES);
        (void)hipGetLastError();
        grid = cus;
        if (grid != 256) { fprintf(stderr, "kernel_launch: built for 256 CUs, got %d\n", cus); grid = -1; return; }
    }
    if (grid < 0) return;
    (void)hipMemsetAsync((char*)d_ws + WS_CTL, 0, CTL_ZERO_BYTES, stream);
    Args a{};
    for (int i = 0; i < 23; ++i) a.in[i] = (const float*)d_in[i];
    a.out = (float*)d_out; a.ws = (unsigned char*)d_ws;
#if defined(DIAG) && DIAG >= 100
    {
        a.ph_lo = 0; a.ph_hi = NPHASE;
        hipLaunchKernelGGL(mega_fwd, dim3(grid), dim3(NWAVES * 64), LDS_BYTES, stream, a);
        hipLaunchKernelGGL(diag_fill_t, dim3(1024), dim3(256), 0, stream, (float*)d_out, (unsigned char*)d_ws, out_size, (int)(DIAG - 100));
    }
#elif defined(DIAG)
    {
        const int his[12] = {0, 2, 3, 6, 15, 10, 6, 9, 2, 2, 5, 9};
        const int grids[12] = {0, 64, 2, 2, 16, 64, 64, 64, 64, 64, 64, 64}, blocks[12] = {0, 256, 128, 128, 256, 256, 256, 256, 256, 256, 256, 256};
        a.ph_lo = 0; a.ph_hi = his[DIAG];
        hipLaunchKernelGGL(mega_fwd, dim3(grid), dim3(NWAVES * 64), LDS_BYTES, stream, a);
        static int once = 0; if (!once) { once = 1; (void)hipFuncSetAttribute((const void*)diag_kernel, hipFuncAttributeMaxDynamicSharedMemorySize, 81920); }
        DArgs da{}; for (int i = 0; i < 23; ++i) da.in[i] = (const float*)d_in[i]; da.out = (float*)d_out; da.ws = (unsigned char*)d_ws; da.mode = DIAG; da.pad = 0;
        hipLaunchKernelGGL(diag_kernel, dim3(grids[DIAG]), dim3(blocks[DIAG]), 81920, stream, da);
        if (DIAG == 2 || DIAG == 3) {
            a.ph_lo = his[DIAG]; a.ph_hi = his[DIAG] + 1;
            hipLaunchKernelGGL(mega_fwd, dim3(grid), dim3(NWAVES * 64), LDS_BYTES, stream, a);
            da.mode = DIAG + 10;
            hipLaunchKernelGGL(diag_kernel, dim3(2), dim3(128), 81920, stream, da);
        }
        hipLaunchKernelGGL(diag_fill, dim3(1024), dim3(256), 0, stream, (float*)d_out, (unsigned char*)d_ws, out_size);
    }
#elif N_LAUNCH_MODE == 1
    a.ph_lo = 0; a.ph_hi = NPHASE;
    hipLaunchKernelGGL(mega_fwd, dim3(grid), dim3(NWAVES * 64), LDS_BYTES, stream, a);
#else
    for (int p = 0; p < NPHASE; ++p) { a.ph_lo = p; a.ph_hi = p + 1; hipLaunchKernelGGL(mega_fwd, dim3(grid), dim3(NWAVES * 64), LDS_BYTES, stream, a); }
#endif
}
```

```cpp
#include <hip/hip_runtime.h>
#include <cstdio>
#include <cstdint>

#define LAS __attribute__((address_space(3)))
#define GAS __attribute__((address_space(1)))
typedef unsigned short bf16;
typedef short bf16x8 __attribute__((ext_vector_type(8)));
typedef float f32x4 __attribute__((ext_vector_type(4)));
typedef float f32x2 __attribute__((ext_vector_type(2)));
typedef unsigned u32x4 __attribute__((ext_vector_type(4)));
typedef unsigned u32x2 __attribute__((ext_vector_type(2)));
#define RLX_AGENT __ATOMIC_RELAXED, __HIP_MEMORY_SCOPE_AGENT
#define LDS_WAIT() asm volatile("s_waitcnt lgkmcnt(0)" ::: "memory")
#define VM_WAIT() asm volatile("s_waitcnt vmcnt(0)" ::: "memory")

constexpr int NB = 4, SEQ = 8192, T = NB * SEQ, D = 1024, DEPTH = 2;
constexpr int DIN = 7200;
constexpr int MIXW = 512, NHEAD = 4, HD = 128, CH = 64, NCH = SEQ / CH;
constexpr int MLQK = 64;
constexpr int NEXP = 32, DEXP = 512;
constexpr float LN_EPS = 1e-5f, NORM_EPS = 1e-6f;
constexpr float ALPHA = 1.41421356237309515f;
constexpr int NWAVES = 8;
constexpr int NREC = NB * NHEAD * NCH * 2;

constexpr int C_QKV = 0, C_Z = 1536, C_A = 2048, C_B = 2056, C_POOL = 2064, C_MQ = 2576, C_MK = 2832, C_MV = 3088, C_MO = 3600, C_I = 4112, C_F = 4120, C_GATE = 4128;

constexpr size_t MiB = 1u << 20;
constexpr size_t WS_CTL = 0, CTL_ZERO_BYTES = 64 * 1024;
constexpr int CW_BAR = 4096;
constexpr size_t WS_HIST = 1 * MiB;
constexpr size_t WS_EID = WS_HIST + 64 * 1024;
constexpr size_t WS_EW = WS_EID + 256 * 1024;
constexpr size_t WS_POS = WS_EW + 256 * 1024;
constexpr size_t WS_ROWW = WS_POS + 256 * 1024;
constexpr size_t WS_GL = WS_ROWW + 512 * 1024;
constexpr size_t WS_ROWTOK = 3 * MiB;
constexpr size_t WS_WIN = 4 * MiB;
constexpr size_t WS_WGATE = 12 * MiB;
constexpr size_t WS_WBR = 18 * MiB;
constexpr size_t WS_WOUT = 21 * MiB;
constexpr size_t WS_HB = 24 * MiB;
constexpr size_t WS_SG = 88 * MiB;
constexpr size_t WS_DEN = 92 * MiB;
constexpr size_t WS_R1 = 93 * MiB;
constexpr size_t WS_PQKV = WS_R1;
constexpr size_t WS_OF = WS_R1, WS_OB = WS_R1 + 32 * MiB;
constexpr size_t WS_MRGP = WS_R1;
constexpr size_t WS_W13 = WS_R1, WS_W2 = WS_R1 + 64 * MiB;
constexpr size_t WS_R2 = 189 * MiB;
constexpr size_t DNREC = 73728;
constexpr size_t DN_W = 0, DN_QG = 16384, DN_KDT = 32768, DN_ATT = 49152, DN_UF = 57344;
constexpr size_t WS_PZ = 189 * MiB, WS_PPOOL = 221 * MiB, WS_PMQ = 253 * MiB, WS_PMK = 269 * MiB, WS_PMV = 285 * MiB, WS_PMO = 317 * MiB;
constexpr size_t WS_YP = 349 * MiB;
constexpr size_t WS_NUMF = 253 * MiB, WS_NUMB = 285 * MiB;
constexpr size_t WS_FIN = 253 * MiB;
constexpr size_t WS_ML = 381 * MiB;
constexpr size_t MLREC = 44032;
constexpr size_t ML_Q = 0, ML_ST = 8192, ML_KWT = 16384, ML_VF = 24576, ML_ROW = 43008;
constexpr size_t WS_GATE = 381 * MiB;
constexpr size_t WS_XS = 189 * MiB, WS_ACT = 333 * MiB, WS_YROWS = 405 * MiB;
constexpr size_t WS_END = 573 * MiB;
constexpr int MOE_ROWS = 73728;
static_assert(WS_ML + (size_t)NREC * MLREC <= WS_END + 15 * MiB, "ml records");
static_assert(WS_YROWS + (size_t)MOE_ROWS * 1024 * 2 <= WS_END, "moe rows");

constexpr int RING_BYTES = 131072;
constexpr int MISC_OFF = RING_BYTES + 320;
constexpr int LHIST_OFF = RING_BYTES + 1024;
constexpr int LPE_OFF = RING_BYTES + 2048;
constexpr int LARG_OFF = RING_BYTES + 4096;
constexpr int LDS_BYTES = 147456;

__device__ __forceinline__ float bf2f(unsigned b) { return __uint_as_float(b << 16); }
__device__ __forceinline__ unsigned f2bf(float f) { unsigned u = __float_as_uint(f); return (u + 0x7fffu + ((u >> 16) & 1u)) >> 16; }
__device__ __forceinline__ unsigned pk2(float lo, float hi) { return f2bf(lo) | (f2bf(hi) << 16); }
__device__ __forceinline__ float wave_sum(float v) {
    v += __int_as_float(__builtin_amdgcn_update_dpp(0, __float_as_int(v), 0xB1, 0xf, 0xf, true));
    v += __int_as_float(__builtin_amdgcn_update_dpp(0, __float_as_int(v), 0x4E, 0xf, 0xf, true));
    v += __int_as_float(__builtin_amdgcn_update_dpp(0, __float_as_int(v), 0x141, 0xf, 0xf, true));
    v += __int_as_float(__builtin_amdgcn_update_dpp(0, __float_as_int(v), 0x140, 0xf, 0xf, true));
    const int iv = __float_as_int(v);
    return (__int_as_float(__builtin_amdgcn_readlane(iv, 0)) + __int_as_float(__builtin_amdgcn_readlane(iv, 16))) + (__int_as_float(__builtin_amdgcn_readlane(iv, 32)) + __int_as_float(__builtin_amdgcn_readlane(iv, 48)));
}
__device__ __forceinline__ float wave_max(float v) {
    v = fmaxf(v, __int_as_float(__builtin_amdgcn_update_dpp(0, __float_as_int(v), 0xB1, 0xf, 0xf, true)));
    v = fmaxf(v, __int_as_float(__builtin_amdgcn_update_dpp(0, __float_as_int(v), 0x4E, 0xf, 0xf, true)));
    v = fmaxf(v, __int_as_float(__builtin_amdgcn_update_dpp(0, __float_as_int(v), 0x141, 0xf, 0xf, true)));
    v = fmaxf(v, __int_as_float(__builtin_amdgcn_update_dpp(0, __float_as_int(v), 0x140, 0xf, 0xf, true)));
    const int iv = __float_as_int(v);
    return fmaxf(fmaxf(__int_as_float(__builtin_amdgcn_readlane(iv, 0)), __int_as_float(__builtin_amdgcn_readlane(iv, 16))), fmaxf(__int_as_float(__builtin_amdgcn_readlane(iv, 32)), __int_as_float(__builtin_amdgcn_readlane(iv, 48))));
}
__device__ __forceinline__ float fexp(float x) { return __builtin_amdgcn_exp2f(x * 1.44269504089f); }
__device__ __forceinline__ float sigmoidf_(float x) { return 1.0f / (1.0f + expf(-x)); }
__device__ __forceinline__ float siluf_(float x) { return x / (1.0f + expf(-x)); }
__device__ __forceinline__ float softplusf_(float x) { return fmaxf(x, 0.f) + log1pf(expf(-fabsf(x))); }
__device__ __forceinline__ float logsigmoidf_(float x) { return fminf(x, 0.f) - log1pf(expf(-fabsf(x))); }
__host__ __device__ __forceinline__ int sigma32(int p) { const int fq = p >> 3, j = p & 7; return 16 * (j >> 2) + 4 * fq + (j & 3); }

#define XB_TMO      128
#define XB_XCNT(j)  (256  + 64 * (j))
#define XB_XSUB(j)  (1280 + 64 * (j))
#define XB_XGEN(j)  (2304 + 64 * (j))
#define XB_TOP      3328
#define XB_TOPGEN   3392
#define XCD_BAR_WORDS 3456
#define XB_SPIN_CAP (1u << 20)
__device__ __forceinline__ unsigned xb_ld(unsigned* p)              { return __hip_atomic_load(p, __ATOMIC_RELAXED, __HIP_MEMORY_SCOPE_AGENT); }
__device__ __forceinline__ unsigned xb_add(unsigned* p, unsigned v) { return __hip_atomic_fetch_add(p, v, __ATOMIC_RELAXED, __HIP_MEMORY_SCOPE_AGENT); }
__device__ __forceinline__ unsigned xb_xcc_id() { return (unsigned)__builtin_amdgcn_s_getreg((3 << 11) | 20) & 0xFu; }
#define XB_SPIN(cond, bar) do { unsigned _sp = 0; while (cond) { __builtin_amdgcn_s_sleep(1); \
    if ((++_sp & 255u) == 0u) { if (xb_ld(&(bar)[XB_TMO])) break; if (_sp > XB_SPIN_CAP) { atomicAdd(&(bar)[XB_TMO], 1u); break; } } } } while (0)
struct XcdBarrier { unsigned* bar; unsigned x; volatile LAS unsigned* st; };
__device__ __forceinline__ XcdBarrier xcd_barrier_post(unsigned* bar, volatile LAS unsigned* st) {
    XcdBarrier b; b.bar = bar; b.x = xb_xcc_id(); b.st = st;
    if (threadIdx.x == 0) (void)xb_add(&bar[XB_XCNT(b.x)], 1u);
    return b;
}
__device__ __forceinline__ void xcd_barrier_complete(unsigned* bar, unsigned x, unsigned& nloc, unsigned& nx) {
    const unsigned G = 256u;
    unsigned sum, cnt, mine, sp = 0u;
    for (;;) {
        sum = 0u; cnt = 0u; mine = 0u;
#pragma unroll
        for (unsigned j = 0; j < 16; ++j) { const unsigned c = xb_ld(&bar[XB_XCNT(j)]); sum += c; cnt += (c > 0u) ? 1u : 0u; mine = (j == x) ? c : mine; }
        if (sum == G) break;
        __builtin_amdgcn_s_sleep(1);
        if ((++sp & 255u) == 0u) { if (xb_ld(&bar[XB_TMO])) break; if (sp > XB_SPIN_CAP) { atomicAdd(&bar[XB_TMO], 1u); break; } }
    }
    nloc = mine > 0u ? mine : 1u; nx = cnt > 0u ? cnt : 1u;
}
__device__ __forceinline__ void xcd_barrier(const XcdBarrier& b, const int tid) {
    asm volatile("s_waitcnt vmcnt(0)" ::: "memory");
    __syncthreads();
    if (tid == 0) {
        unsigned* bar = b.bar;
        __builtin_amdgcn_s_waitcnt(0);
        unsigned nloc = b.st[0], nx = b.st[1];
        if (nloc == 0u) { xcd_barrier_complete(bar, b.x, nloc, nx); b.st[0] = nloc; b.st[1] = nx; }
        const unsigned old = xb_add(&bar[XB_XSUB(b.x)], 1u);
        const unsigned gen = old / nloc;
        if (old + 1u == (gen + 1u) * nloc) {
            __builtin_amdgcn_fence(__ATOMIC_RELEASE, "agent");
            asm volatile("s_waitcnt vmcnt(0)" ::: "memory");
            const unsigned og = xb_add(&bar[XB_TOP], 1u);
            const unsigned tg = og / nx;
            if (og + 1u == (tg + 1u) * nx) xb_add(&bar[XB_TOPGEN], 1u);
            else XB_SPIN(xb_ld(&bar[XB_TOPGEN]) == tg, bar);
            __builtin_amdgcn_fence(__ATOMIC_ACQUIRE, "agent");
            xb_add(&bar[XB_XGEN(b.x)], 1u);
            asm volatile("s_waitcnt vmcnt(0)" ::: "memory");
        } else {
            XB_SPIN(xb_ld(&bar[XB_XGEN(b.x)]) == gen, bar);
            __builtin_amdgcn_fence(__ATOMIC_ACQUIRE, "agent");
            asm volatile("s_waitcnt vmcnt(0)" ::: "memory");
        }
    }
    __syncthreads();
}

namespace pg8 {
constexpr int BM = 256, BK = 64, HALF = 128, HTB = HALF * BK * 2, STAGE_BYTES = 8 * HTB, NXCD = 8, WGM = 8;
__host__ __device__ __forceinline__ int lds_byte(int r, int c) { const int st = (r >> 4) * 2 + (c >> 5), rr = r & 15, cc = c & 31, ob = rr * 64 + cc * 2; return st * 1024 + (ob ^ (((ob >> 9) & 1) << 5)); }
__host__ __device__ __forceinline__ void stage_rc(int b, int& R, int& C) { const int st = b / 1024, sb = b % 1024, swz = sb ^ (((sb >> 9) & 1) << 5); R = (st >> 1) * 16 + swz / 64; C = (st & 1) * 32 + (swz % 64) / 2; }
__host__ __device__ __forceinline__ int perm32(int rho) { const int n = rho >> 4, i = rho & 15; return 8 * (i >> 2) + 4 * n + (i & 3); }

struct Unit { int pm, pn, aux; const GAS char* A; const GAS char* B; };

__device__ __forceinline__ void tile_of(int L, int nM, int nN, int& pm, int& pn) {
    const int nwg = nM * nN; int wgid = L;
    { const int q = nwg / NXCD, r = nwg % NXCD, xcd = wgid % NXCD, off = wgid / NXCD; wgid = (xcd < r ? xcd * (q + 1) : r * (q + 1) + (xcd - r) * q) + off; }
    const int nig = WGM * nN, gid = wgid / nig, fm = gid * WGM, gsz = (nM - fm) < WGM ? (nM - fm) : WGM;
    pm = fm + ((wgid % nig) % gsz); pn = (wgid % nig) / gsz;
}
struct StaticOrder {
    static constexpr bool GATHER = false;
    const GAS char* A; const GAS char* Bt; int nM, nN, nwg, G, c; size_t tstep;
    __device__ __forceinline__ void init(const GAS void* A_, const GAS void* Bt_, int M, int N, int K, int G_, int c_) { A = (const GAS char*)A_; Bt = (const GAS char*)Bt_; nM = M / BM; nN = N / BM; nwg = nM * nN; G = G_; c = c_; tstep = (size_t)BM * K * 2; }
    __device__ __forceinline__ bool next(int i, Unit& u) const {
        const long L = (long)i * G + c; if (L >= nwg) return false;
        tile_of((int)L, nM, nN, u.pm, u.pn); u.aux = 0; u.A = A + (size_t)u.pm * tstep; u.B = Bt + (size_t)u.pn * tstep; return true;
    }
};

typedef float f32x2_t __attribute__((ext_vector_type(2))); typedef __bf16 bf16x2_t __attribute__((ext_vector_type(2)));
__device__ __forceinline__ unsigned cvt_pk_bf16(float lo, float hi) { f32x2_t v = {lo, hi}; bf16x2_t b = __builtin_convertvector(v, bf16x2_t); return __builtin_bit_cast(unsigned, b); }

__device__ __forceinline__ bf16 bf1(float x) { return (bf16)(cvt_pk_bf16(x, x) & 0xffffu); }
template <class Epi, class Sched, bool ALIGN_EPI = true, bool SP2 = true>
__device__ __forceinline__ void gemm_phase(LAS unsigned char* lds, const int tid, const int K, const Sched& S, const Epi& E) {
    const int wid = __builtin_amdgcn_readfirstlane(tid >> 6), lane = tid & 63, wr = wid >> 2, wc = wid & 3, fr = lane & 15, fq = lane >> 4;
    const int nt = K / BK;
    unsigned voffA, voffB;
    { int R, C; stage_rc(tid * 16, R, C); const int Rb = Epi::PERM ? ((R & ~31) + perm32(R & 31)) : R;
        voffA = (unsigned)(R * K + C) * 2u; voffB = (unsigned)(Rb * K + C) * 2u; }
    const size_t pstep = (size_t)64 * K * 2;
    const size_t kstep = (size_t)(BK * 2);
    const size_t hstep = (size_t)HALF * K * 2;
    const unsigned ldsw = (unsigned)wid * 1024u;
    const int aoff = lds_byte(wr * 64 + fr, fq * 8), boff = lds_byte(wc * 32 + fr, fq * 8);
#define PG8_SA(b, h) (((b) * 2 + (h)) * HTB)
#define PG8_SB(b, h) ((4 + (b) * 2 + (h)) * HTB)
#define PG8_STAGE(bufoff, gbase, voff) do { _Pragma("unroll") for (int _i = 0; _i < 2; ++_i) \
        __builtin_amdgcn_global_load_lds((const GAS unsigned*)((const GAS char*)(gbase) + _i * pstep + (voff)), (LAS unsigned*)(lds + (bufoff) + ldsw + _i * 8192), 16, 0, 0); } while (0)
#define PG8_STAGE_A(bufoff, kbase, h_, useNext) do { if constexpr (GATHER) { _Pragma("unroll") for (int _i = 0; _i < 2; ++_i) { const unsigned _o = (useNext) ? gaN[h_][_i] : gaC[h_][_i]; \
        __builtin_amdgcn_global_load_lds((const GAS unsigned*)((const GAS char*)(kbase) + _o), (LAS unsigned*)(lds + (bufoff) + ldsw + _i * 8192), 16, 0, 0); } } \
        else { PG8_STAGE(bufoff, (kbase) + (h_) * hstep, voffA); } } while (0)
#define PG8_LDA(dst, b, h) do { _Pragma("unroll") for (int m = 0; m < 4; ++m) _Pragma("unroll") for (int k = 0; k < 2; ++k) dst[m][k] = *(const LAS bf16x8*)(lds + PG8_SA(b, h) + aoff + m * 2048 + k * 1024); } while (0)
#define PG8_LDB(dst, b, h) do { _Pragma("unroll") for (int n = 0; n < 2; ++n) _Pragma("unroll") for (int k = 0; k < 2; ++k) dst[n][k] = *(const LAS bf16x8*)(lds + PG8_SB(b, h) + boff + n * 2048 + k * 1024); } while (0)
#define PG8_MMA(ai, bj, At, Bt) do { __builtin_amdgcn_s_setprio(1); _Pragma("unroll") for (int m = 0; m < 4; ++m) _Pragma("unroll") for (int n = 0; n < 2; ++n) _Pragma("unroll") for (int k = 0; k < 2; ++k) \
        acc[ai][bj][m][n] = __builtin_amdgcn_mfma_f32_16x16x32_bf16(Bt[n][k], At[m][k], acc[ai][bj][m][n], 0, 0, 0); __builtin_amdgcn_s_setprio(0); } while (0)
#define PG8_WAIT_V(n) asm volatile("s_waitcnt vmcnt(" #n ")" ::: "memory")
#define PG8_WAIT_L(n) asm volatile("s_waitcnt lgkmcnt(" #n ")" ::: "memory")
#define PG8_BAR __builtin_amdgcn_s_barrier()
#define PG8_SCHED __builtin_amdgcn_sched_barrier(0)
    Unit cur, nxt; int ui = 0;
    if (!S.next(0, cur)) return;
    constexpr bool GATHER = Sched::GATHER;
    unsigned gaC[2][2], gaN[2][2];
    int gR = 0, gC = 0; if constexpr (GATHER) { stage_rc(tid * 16, gR, gC); }
#define PG8_GATHER_OFFS(dst, u_) do { if constexpr (GATHER) { _Pragma("unroll") for (int h_ = 0; h_ < 2; ++h_) _Pragma("unroll") for (int i_ = 0; i_ < 2; ++i_) \
        dst[h_][i_] = (unsigned)S.rowtok[(u_).pm * 256 + 128 * h_ + 64 * i_ + gR] * (unsigned)(K * 2) + (unsigned)(gC * 2); } } while (0)
    PG8_GATHER_OFFS(gaC, cur);
#pragma unroll
    for (int h_ = 0; h_ < 2; ++h_)
#pragma unroll
        for (int i_ = 0; i_ < 2; ++i_) gaN[h_][i_] = gaC[h_][i_];
    f32x4 acc[2][2][4][2];
#pragma unroll
    for (int a = 0; a < 2; ++a)
#pragma unroll
        for (int b = 0; b < 2; ++b)
#pragma unroll
            for (int m = 0; m < 4; ++m)
#pragma unroll
                for (int n = 0; n < 2; ++n) acc[a][b][m][n] = (f32x4){0.f, 0.f, 0.f, 0.f};
    bf16x8 At[4][2], B0[2][2], B1[2][2];
    const GAS char* cA = cur.A; const GAS char* cB = cur.B;
    if constexpr (SP2) {
        PG8_STAGE(PG8_SB(0, 0), cB, voffB); PG8_STAGE(PG8_SB(0, 1), cB + hstep, voffB); PG8_STAGE_A(PG8_SA(0, 0), cA, 0, false); PG8_STAGE_A(PG8_SA(0, 1), cA, 1, false);
        if (wr == 1) PG8_BAR;
        PG8_WAIT_V(2); PG8_BAR;
        PG8_STAGE(PG8_SB(1, 0), cB + kstep, voffB); PG8_STAGE_A(PG8_SA(1, 0), cA + kstep, 0, false); PG8_STAGE(PG8_SB(1, 1), cB + hstep + kstep, voffB);
        PG8_WAIT_V(6); PG8_BAR;
    } else {
        PG8_STAGE(PG8_SB(0, 0), cB, voffB); PG8_STAGE(PG8_SA(0, 0), cA, voffA); PG8_STAGE(PG8_SB(0, 1), cB + hstep, voffB); PG8_STAGE(PG8_SA(0, 1), cA + hstep, voffA);
        if (wr == 1) PG8_BAR;
        PG8_WAIT_V(4); PG8_BAR;
        PG8_STAGE(PG8_SB(1, 0), cB + kstep, voffB); PG8_STAGE(PG8_SA(1, 0), cA + kstep, voffA); PG8_STAGE(PG8_SB(1, 1), cB + hstep + kstep, voffB);
        PG8_WAIT_V(6); PG8_BAR;
    }
    for (;;) {
        const bool has_next = S.next(ui + 1, nxt);
        if (has_next) PG8_GATHER_OFFS(gaN, nxt);
        const GAS char* nA = has_next ? nxt.A : cA; const GAS char* nB = has_next ? nxt.B : cB;
        for (int t = 0; t < nt; t += 2) {
            const bool last = (t == nt - 2);
            const GAS char* a1 = cA + (size_t)(t + 1) * kstep;
            const GAS char* a2 = last ? nA : cA + (size_t)(t + 2) * kstep; const GAS char* b2 = last ? nB : cB + (size_t)(t + 2) * kstep;
            const GAS char* a3 = a2 + kstep; const GAS char* b3 = b2 + kstep;
            if constexpr (SP2) {
            PG8_LDB(B0, 0, 0); PG8_LDB(B1, 0, 1); PG8_SCHED; PG8_LDA(At, 0, 0); PG8_STAGE_A(PG8_SA(1, 1), a1, 1, false);
            PG8_WAIT_V(8); PG8_WAIT_L(0); PG8_BAR; PG8_MMA(0, 0, At, B0); PG8_MMA(0, 1, At, B1); PG8_BAR; PG8_SCHED;
            PG8_LDA(At, 0, 1); PG8_STAGE(PG8_SB(0, 0), b2, voffB); PG8_STAGE(PG8_SB(0, 1), b2 + hstep, voffB); PG8_STAGE_A(PG8_SA(0, 0), a2, 0, last && has_next);
            PG8_WAIT_V(8); PG8_WAIT_L(0); PG8_BAR; PG8_MMA(1, 0, At, B0); PG8_MMA(1, 1, At, B1); PG8_BAR; PG8_SCHED;
            PG8_LDB(B0, 1, 0); PG8_LDB(B1, 1, 1); PG8_SCHED; PG8_LDA(At, 1, 0); PG8_STAGE_A(PG8_SA(0, 1), a2, 1, last && has_next);
            PG8_WAIT_V(8); PG8_WAIT_L(0); PG8_BAR; PG8_MMA(0, 0, At, B0); PG8_MMA(0, 1, At, B1); PG8_BAR; PG8_SCHED;
            PG8_LDA(At, 1, 1); PG8_STAGE(PG8_SB(1, 0), b3, voffB); PG8_STAGE(PG8_SB(1, 1), b3 + hstep, voffB); PG8_STAGE_A(PG8_SA(1, 0), a3, 0, last && has_next);
            PG8_WAIT_V(8); PG8_WAIT_L(0); PG8_BAR; PG8_MMA(1, 0, At, B0); PG8_MMA(1, 1, At, B1); PG8_BAR; PG8_SCHED;
            } else {
            PG8_LDB(B0, 0, 0); PG8_SCHED; PG8_LDA(At, 0, 0); PG8_STAGE(PG8_SA(1, 1), a1 + hstep, voffA);
            PG8_WAIT_L(8); PG8_BAR; PG8_WAIT_L(0); PG8_MMA(0, 0, At, B0); PG8_BAR; PG8_SCHED;
            PG8_LDB(B1, 0, 1); PG8_STAGE(PG8_SB(0, 0), b2, voffB);
            PG8_BAR; PG8_WAIT_L(0); PG8_MMA(0, 1, At, B1); PG8_BAR;
            PG8_LDA(At, 0, 1); PG8_STAGE(PG8_SA(0, 0), a2, voffA);
            PG8_BAR; PG8_WAIT_L(0); PG8_MMA(1, 0, At, B0); PG8_BAR; PG8_SCHED;
            PG8_STAGE(PG8_SB(0, 1), b2 + hstep, voffB);
            PG8_WAIT_V(6); PG8_BAR; PG8_MMA(1, 1, At, B1); PG8_BAR;
            PG8_LDB(B0, 1, 0); PG8_SCHED; PG8_LDA(At, 1, 0); PG8_STAGE(PG8_SA(0, 1), a2 + hstep, voffA);
            PG8_WAIT_L(8); PG8_BAR; PG8_WAIT_L(0); PG8_MMA(0, 0, At, B0); PG8_BAR; PG8_SCHED;
            PG8_LDB(B1, 1, 1); PG8_STAGE(PG8_SB(1, 0), b3, voffB);
            PG8_BAR; PG8_WAIT_L(0); PG8_MMA(0, 1, At, B1); PG8_BAR;
            PG8_LDA(At, 1, 1); PG8_STAGE(PG8_SA(1, 0), a3, voffA);
            PG8_BAR; PG8_WAIT_L(0); PG8_MMA(1, 0, At, B0); PG8_BAR; PG8_SCHED;
            PG8_STAGE(PG8_SB(1, 1), b3 + hstep, voffB);
            PG8_WAIT_V(6); PG8_BAR; PG8_MMA(1, 1, At, B1); PG8_BAR;
            }
        }
        if constexpr (ALIGN_EPI) { if (wr == 0) PG8_BAR; }
        E(acc, cur, wr, wc, fr, fq);
        if (!has_next) break;
#pragma unroll
        for (int a = 0; a < 2; ++a)
#pragma unroll
            for (int b = 0; b < 2; ++b)
#pragma unroll
                for (int m = 0; m < 4; ++m)
#pragma unroll
                    for (int n = 0; n < 2; ++n) acc[a][b][m][n] = (f32x4){0.f, 0.f, 0.f, 0.f};
        cur = nxt; cA = nA; cB = nB; ++ui;
#pragma unroll
        for (int h_ = 0; h_ < 2; ++h_)
#pragma unroll
            for (int i_ = 0; i_ < 2; ++i_) gaC[h_][i_] = gaN[h_][i_];
        if constexpr (ALIGN_EPI) { if (wr == 1) PG8_BAR; }
    }
    PG8_WAIT_V(0);
    if constexpr (!ALIGN_EPI) { if (wr == 0) PG8_BAR; }
    PG8_BAR;
#undef PG8_SA
#undef PG8_SB
#undef PG8_STAGE
#undef PG8_LDA
#undef PG8_STAGE_A
#undef PG8_GATHER_OFFS
#undef PG8_LDB
#undef PG8_MMA
#undef PG8_WAIT_V
#undef PG8_WAIT_L
#undef PG8_BAR
#undef PG8_SCHED
}
}

using pg8::Unit; using pg8::cvt_pk_bf16; using pg8::bf1; using pg8::HALF; using pg8::BM;

struct EpiG1a {
    static constexpr bool PERM = true;
    GAS bf16* O;
    __device__ __forceinline__ void operator()(const f32x4 (&acc)[2][2][4][2], const Unit& u, int wr, int wc, int fr, int fq) const {
        const int row0 = u.pm * BM + wr * 64 + fr, col0 = u.pn * BM + wc * 32 + 8 * fq;
#pragma unroll
        for (int ai = 0; ai < 2; ++ai)
#pragma unroll
            for (int m = 0; m < 4; ++m) { GAS bf16* rowp = O + (size_t)(row0 + ai * HALF + m * 16) * 1536 + col0;
#pragma unroll
                for (int bj = 0; bj < 2; ++bj) { const f32x4 v0 = acc[ai][bj][m][0], v1 = acc[ai][bj][m][1];
                    u32x4 w; w.x = cvt_pk_bf16(v0[0], v0[1]); w.y = cvt_pk_bf16(v0[2], v0[3]); w.z = cvt_pk_bf16(v1[0], v1[1]); w.w = cvt_pk_bf16(v1[2], v1[3]);
                    *(GAS u32x4*)(rowp + bj * HALF) = w; } }
    }
};
struct EpiG1b {
    static constexpr bool PERM = true;
    GAS unsigned char* ws;
    __device__ __forceinline__ void operator()(const f32x4 (&acc)[2][2][4][2], const Unit& u, int wr, int wc, int fr, int fq) const {
        const int pn = u.pn; size_t off; int ld, ct;
        if (pn < 2) { off = WS_PZ; ld = 512; ct = pn; } else if (pn < 4) { off = WS_PPOOL; ld = 512; ct = pn - 2; } else if (pn == 4) { off = WS_PMQ; ld = 256; ct = 0; }
        else if (pn == 5) { off = WS_PMK; ld = 256; ct = 0; } else if (pn < 8) { off = WS_PMV; ld = 512; ct = pn - 6; } else { off = WS_PMO; ld = 512; ct = pn - 8; }
        GAS bf16* O = (GAS bf16*)(ws + off);
        const int row0 = u.pm * BM + wr * 64 + fr, col0 = ct * BM + wc * 32 + 8 * fq;
#pragma unroll
        for (int ai = 0; ai < 2; ++ai)
#pragma unroll
            for (int m = 0; m < 4; ++m) { GAS bf16* rowp = O + (size_t)(row0 + ai * HALF + m * 16) * ld + col0;
#pragma unroll
                for (int bj = 0; bj < 2; ++bj) { const f32x4 v0 = acc[ai][bj][m][0], v1 = acc[ai][bj][m][1];
                    u32x4 w; w.x = cvt_pk_bf16(v0[0], v0[1]); w.y = cvt_pk_bf16(v0[2], v0[3]); w.z = cvt_pk_bf16(v1[0], v1[1]); w.w = cvt_pk_bf16(v1[2], v1[3]);
                    *(GAS u32x4*)(rowp + bj * HALF) = w; } }
    }
};
__device__ __forceinline__ float fast_sigmoid(float x) { return __builtin_amdgcn_rcpf(1.0f + __builtin_amdgcn_exp2f(-1.44269504089f * x)); }
struct EpiGate {
    static constexpr bool PERM = true;
    GAS bf16* O;
    __device__ __forceinline__ void operator()(const f32x4 (&acc)[2][2][4][2], const Unit& u, int wr, int wc, int fr, int fq) const {
        const int row0 = u.pm * BM + wr * 64 + fr, col0 = u.pn * BM + wc * 32 + 8 * fq;
#pragma unroll
        for (int ai = 0; ai < 2; ++ai)
#pragma unroll
            for (int m = 0; m < 4; ++m) { GAS bf16* rowp = O + (size_t)(row0 + ai * HALF + m * 16) * 3072 + col0;
#pragma unroll
                for (int bj = 0; bj < 2; ++bj) { f32x4 v0 = acc[ai][bj][m][0], v1 = acc[ai][bj][m][1];
#pragma unroll
                    for (int j = 0; j < 4; ++j) { v0[j] = fast_sigmoid(v0[j]); v1[j] = fast_sigmoid(v1[j]); }
                    u32x4 w; w.x = cvt_pk_bf16(v0[0], v0[1]); w.y = cvt_pk_bf16(v0[2], v0[3]); w.z = cvt_pk_bf16(v1[0], v1[1]); w.w = cvt_pk_bf16(v1[2], v1[3]);
                    *(GAS u32x4*)(rowp + bj * HALF) = w; } }
    }
};
__device__ __forceinline__ void unpack8(const u32x4 w, float (&f)[8]) {
    f[0] = __uint_as_float(w.x << 16); f[1] = __uint_as_float(w.x & 0xffff0000u); f[2] = __uint_as_float(w.y << 16); f[3] = __uint_as_float(w.y & 0xffff0000u);
    f[4] = __uint_as_float(w.z << 16); f[5] = __uint_as_float(w.z & 0xffff0000u); f[6] = __uint_as_float(w.w << 16); f[7] = __uint_as_float(w.w & 0xffff0000u);
}
struct EpiMerge {
    static constexpr bool PERM = true;
    const GAS bf16* GATE; GAS bf16* PART; GAS bf16* FIN;
    __device__ __forceinline__ void operator()(const f32x4 (&acc)[2][2][4][2], const Unit& u, int wr, int wc, int fr, int fq) const {
        const int r = u.aux;
        const int row0 = u.pm * BM + wr * 64 + fr, col0 = u.pn * BM + wc * 32 + 8 * fq;
        GAS bf16* dst = (r == 2) ? FIN : PART;
#pragma unroll
        for (int ai = 0; ai < 2; ++ai) {
            u32x4 gw[4][2], pw[4][2];
#pragma unroll
            for (int m = 0; m < 4; ++m)
#pragma unroll
                for (int bj = 0; bj < 2; ++bj) { const size_t row = (size_t)(row0 + ai * HALF + m * 16); const int c = col0 + bj * HALF;
                    gw[m][bj] = *(const GAS u32x4*)(GATE + row * 3072 + r * 1024 + c);
                    if (r > 0) pw[m][bj] = *(const GAS u32x4*)(PART + row * 1024 + c); }
#pragma unroll
            for (int m = 0; m < 4; ++m)
#pragma unroll
                for (int bj = 0; bj < 2; ++bj) { const size_t row = (size_t)(row0 + ai * HALF + m * 16); const int c = col0 + bj * HALF;
                    const f32x4 v0 = acc[ai][bj][m][0], v1 = acc[ai][bj][m][1];
                    float g[8]; unpack8(gw[m][bj], g);
                    float o[8];
                    o[0] = v0[0] * g[0]; o[1] = v0[1] * g[1]; o[2] = v0[2] * g[2]; o[3] = v0[3] * g[3];
                    o[4] = v1[0] * g[4]; o[5] = v1[1] * g[5]; o[6] = v1[2] * g[6]; o[7] = v1[3] * g[7];
                    if (r > 0) { float p[8]; unpack8(pw[m][bj], p);
#pragma unroll
                        for (int j = 0; j < 8; ++j) o[j] += p[j]; }
                    u32x4 w; w.x = cvt_pk_bf16(o[0], o[1]); w.y = cvt_pk_bf16(o[2], o[3]); w.z = cvt_pk_bf16(o[4], o[5]); w.w = cvt_pk_bf16(o[6], o[7]);
                    *(GAS u32x4*)(dst + row * 1024 + c) = w; }
        }
    }
};
struct EpiOut {
    static constexpr bool PERM = false;
    const GAS bf16* H; GAS bf16* PRE;
    __device__ __forceinline__ void operator()(const f32x4 (&acc)[2][2][4][2], const Unit& u, int wr, int wc, int fr, int fq) const {
        const int row0 = u.pm * BM + wr * 64 + fr, col0 = u.pn * BM + wc * 32 + 4 * fq;
#pragma unroll
        for (int ai = 0; ai < 2; ++ai) {
            u32x2 hv[4][2][2];
#pragma unroll
            for (int m = 0; m < 4; ++m)
#pragma unroll
                for (int bj = 0; bj < 2; ++bj)
#pragma unroll
                    for (int n = 0; n < 2; ++n) hv[m][bj][n] = *(const GAS u32x2*)(H + (size_t)(row0 + ai * HALF + m * 16) * D + col0 + bj * HALF + n * 16);
#pragma unroll
            for (int m = 0; m < 4; ++m)
#pragma unroll
                for (int bj = 0; bj < 2; ++bj)
#pragma unroll
                    for (int n = 0; n < 2; ++n) { const size_t o = (size_t)(row0 + ai * HALF + m * 16) * D + col0 + bj * HALF + n * 16; const u32x2 h2 = hv[m][bj][n]; const f32x4 a = acc[ai][bj][m][n];
                        u32x2 w; w.x = cvt_pk_bf16(ALPHA * bf2f(h2.x & 0xffffu) + a[0], ALPHA * bf2f(h2.x >> 16) + a[1]); w.y = cvt_pk_bf16(ALPHA * bf2f(h2.y & 0xffffu) + a[2], ALPHA * bf2f(h2.y >> 16) + a[3]);
                        *(GAS u32x2*)(PRE + o) = w; }
        }
    }
};
struct EpiMoe1 {
    static constexpr bool PERM = true;
    GAS bf16* ACT;
    __device__ __forceinline__ void operator()(const f32x4 (&acc)[2][2][4][2], const Unit& u, int wr, int wc, int fr, int fq) const {
        const int row0 = u.pm * BM + wr * 64 + fr, col0 = u.pn * 128 + wc * 32 + 8 * fq;
#pragma unroll
        for (int ai = 0; ai < 2; ++ai)
#pragma unroll
            for (int m = 0; m < 4; ++m) { GAS bf16* rowp = ACT + (size_t)(row0 + ai * HALF + m * 16) * DEXP + col0;
                float o[8];
#pragma unroll
                for (int n = 0; n < 2; ++n)
#pragma unroll
                    for (int j = 0; j < 4; ++j) { const float a = acc[ai][0][m][n][j], b = acc[ai][1][m][n][j]; o[n * 4 + j] = a * fast_sigmoid(a) * b; }
                u32x4 w; w.x = cvt_pk_bf16(o[0], o[1]); w.y = cvt_pk_bf16(o[2], o[3]); w.z = cvt_pk_bf16(o[4], o[5]); w.w = cvt_pk_bf16(o[6], o[7]);
                *(GAS u32x4*)rowp = w; }
    }
};
struct EpiMoe2 {
    static constexpr bool PERM = true;
    GAS bf16* Y; const GAS float* roww;
    __device__ __forceinline__ void operator()(const f32x4 (&acc)[2][2][4][2], const Unit& u, int wr, int wc, int fr, int fq) const {
        const int row0 = u.pm * BM + wr * 64 + fr, col0 = u.pn * BM + wc * 32 + 8 * fq;
        float rws[2][4];
#pragma unroll
        for (int ai = 0; ai < 2; ++ai)
#pragma unroll
            for (int m = 0; m < 4; ++m) rws[ai][m] = roww[row0 + ai * HALF + m * 16];
#pragma unroll
        for (int ai = 0; ai < 2; ++ai)
#pragma unroll
            for (int m = 0; m < 4; ++m) { const int row = row0 + ai * HALF + m * 16; const float rw = rws[ai][m]; GAS bf16* rowp = Y + (size_t)row * D + col0;
#pragma unroll
                for (int bj = 0; bj < 2; ++bj) { const f32x4 v0 = acc[ai][bj][m][0] * rw, v1 = acc[ai][bj][m][1] * rw;
                    u32x4 w; w.x = cvt_pk_bf16(v0[0], v0[1]); w.y = cvt_pk_bf16(v0[2], v0[3]); w.z = cvt_pk_bf16(v1[0], v1[1]); w.w = cvt_pk_bf16(v1[2], v1[3]);
                    *(GAS u32x4*)(rowp + bj * HALF) = w; } }
    }
};

struct MergeOrder {
    static constexpr bool GATHER = false;
    const GAS char* Y[3]; const GAS char* W; int G, c;
    __device__ __forceinline__ bool next(int i, Unit& u) const {
        const int j = i / 3, r = i - 3 * j; const int L = j * G + c; if (L >= 128 * 4) return false;
        pg8::tile_of(L, 128, 4, u.pm, u.pn); u.aux = r;
        const GAS char* y = (r == 0) ? Y[0] : ((r == 1) ? Y[1] : Y[2]);
        u.A = y + (size_t)u.pm * (256 * 512 * 2); u.B = W + (size_t)r * (1024 * 512 * 2) + (size_t)u.pn * (256 * 512 * 2); return true;
    }
};
template <int KDIM, bool GATHER_> struct MoeOrder {
    static constexpr bool GATHER = GATHER_;
    const GAS int* rowtok;
    const GAS char* A; const GAS char* W; const LAS int* pe; int c, NP;
    __device__ __forceinline__ bool next(int i, Unit& u) const {
        const int L = i * 256 + c; if (L >= NP * 4) return false;
        const int p = L >> 2, pn = L & 3; const int e = __builtin_amdgcn_readfirstlane(pe[p]);
        u.pm = p; u.pn = pn; u.aux = e; u.A = GATHER_ ? A : A + (size_t)p * (256 * KDIM * 2); u.B = W + (size_t)e * (1024 * KDIM * 2) + (size_t)pn * (256 * KDIM * 2); return true;
    }
};

struct Args {
    const float* in[23]; float* out; unsigned char* ws; int ph_lo, ph_hi;
};
struct Frame {
    LAS unsigned char* lds; int tid, lane, wave, G, wg;
    GAS float* out; GAS unsigned char* ws;
};
__device__ __forceinline__ const GAS float* inp_lds(LAS unsigned char* lds, int i) {
    const unsigned long long v = ((const LAS unsigned long long*)(lds + LARG_OFF))[i];
    const unsigned lo = __builtin_amdgcn_readfirstlane((unsigned)v), hi = __builtin_amdgcn_readfirstlane((unsigned)(v >> 32));
    return (const GAS float*)(((unsigned long long)hi << 32) | lo);
}
__device__ __forceinline__ const GAS float* inp(const Frame& F, int i) { return inp_lds(F.lds, i); }
__device__ __forceinline__ Frame fresh(LAS unsigned char* lds, int wave) {
    Frame F; int wgx = blockIdx.x; unsigned lb = (unsigned)(unsigned long long)lds;
    asm volatile("" : "+s"(wave), "+s"(wgx), "+s"(lb));
    F.lds = (LAS unsigned char*)(unsigned long long)lb;
    int ln = (int)__builtin_amdgcn_mbcnt_hi(~0u, __builtin_amdgcn_mbcnt_lo(~0u, 0u)); asm volatile("" : "+v"(ln));
    F.wave = wave; F.lane = ln; F.tid = wave * 64 + ln;
    F.G = 256; F.wg = wgx;
    F.out = (GAS float*)inp_lds(F.lds, 23); F.ws = (GAS unsigned char*)inp_lds(F.lds, 24);
    return F;
}
enum { I_X = 0, I_LN_IN_G, I_LN_IN_B, I_W_IN, I_CONV, I_A_LOG, I_DT_BIAS, I_DN_NORM, I_POOL_W, I_POOL_SCALE, I_ML_GATE_B, I_ML_NORM, I_W_BRANCH, I_W_OUT, I_LN_MIX_G, I_LN_MIX_B,
       I_ROUTER_W, I_ROUTER_B, I_MOE_W1, I_MOE_W3, I_MOE_W2, I_LN_FFN_G, I_LN_FFN_B };

__device__ __forceinline__ void tr_load(float (&r)[32], const GAS float* W, int ldw, int k0, int n0src, int lane) {
#pragma unroll
    for (int i = 0; i < 32; ++i) { const int kk = 2 * i + (lane >> 5); r[i] = W[(size_t)(k0 + kk) * ldw + n0src + (lane & 31)]; }
}
__device__ __forceinline__ void tr_store(const float (&r)[32], GAS bf16* WT, int dpitch, int k0, int drow0, LAS float* scr, int lane) {
#pragma unroll
    for (int i = 0; i < 32; ++i) { const int kk = 2 * i + (lane >> 5); scr[kk * 33 + (lane & 31)] = r[i]; }
    LDS_WAIT(); asm volatile("" ::: "memory");
    const int c = lane & 7;
#pragma unroll
    for (int j = 0; j < 4; ++j) { const int n = (lane >> 3) + 8 * j; const LAS float* s = scr + (8 * c) * 33 + n;
        u32x4 o; o.x = cvt_pk_bf16(s[0 * 33], s[1 * 33]); o.y = cvt_pk_bf16(s[2 * 33], s[3 * 33]); o.z = cvt_pk_bf16(s[4 * 33], s[5 * 33]); o.w = cvt_pk_bf16(s[6 * 33], s[7 * 33]);
        *(GAS u32x4*)(WT + (size_t)(drow0 + n) * dpitch + k0 + 8 * c) = o; }
    LDS_WAIT(); asm volatile("" ::: "memory");
}
__device__ __forceinline__ void tr_item(const GAS float* W, int ldw, int k0, int n0src, GAS bf16* WT, int dpitch, int drow0, LAS float* scr, int lane) {
    float r[32]; tr_load(r, W, ldw, k0, n0src, lane); tr_store(r, WT, dpitch, k0, drow0, scr, lane);
}
__device__ __forceinline__ void tr_segment(const Frame& F, const GAS float* W, int ldw, int K, int n0src, int ncols, GAS bf16* WT, int drow0, int& it) {
    LAS float* scr = (LAS float*)(F.lds + F.wave * 16384);
    const int gw = F.wg * NWAVES + F.wave, NGW = F.G * NWAVES;
    const int nblk = ncols / 32, nitems = (K / 64) * nblk;
    int first = (gw - (it % NGW) + NGW) % NGW;
    for (int r = first; r < nitems; r += NGW) { const int kb = r / nblk, nb = r % nblk; tr_item(W, ldw, 64 * kb, n0src + 32 * nb, WT, K, drow0 + 32 * nb, scr, F.lane); }
    it += nitems;
}
__device__ __forceinline__ void wprep_mixer(const Frame& F, int l) {
    const GAS float* win = inp(F, I_W_IN) + (size_t)l * D * DIN; int it = 0;
    GAS bf16* Wi = (GAS bf16*)(F.ws + WS_WIN); GAS bf16* Wg = (GAS bf16*)(F.ws + WS_WGATE); GAS bf16* Wb = (GAS bf16*)(F.ws + WS_WBR); GAS bf16* Wo = (GAS bf16*)(F.ws + WS_WOUT);
    tr_segment(F, win, DIN, D, C_QKV, 1536, Wi, 0, it);
    tr_segment(F, win, DIN, D, C_Z, 512, Wi, 1536, it);
    tr_segment(F, win, DIN, D, C_POOL, 512, Wi, 2048, it);
    tr_segment(F, win, DIN, D, C_MQ, 256, Wi, 2560, it);
    tr_segment(F, win, DIN, D, C_MK, 256, Wi, 2816, it);
    tr_segment(F, win, DIN, D, C_MV, 512, Wi, 3072, it);
    tr_segment(F, win, DIN, D, C_MO, 512, Wi, 3584, it);
    tr_segment(F, win, DIN, D, C_GATE, 3072, Wg, 0, it);
    const GAS float* wbr = inp(F, I_W_BRANCH) + (size_t)l * 3 * MIXW * D;
    tr_segment(F, wbr, D, MIXW, 0, D, Wb, 0, it);
    tr_segment(F, wbr + (size_t)2 * MIXW * D, D, MIXW, 0, D, Wb + (size_t)2 * D * MIXW, 0, it);
    tr_segment(F, inp(F, I_W_OUT) + (size_t)l * D * D, D, D, 0, D, Wo, 0, it);
    const GAS float* pw = inp(F, I_POOL_W) + (size_t)l * 4 * 128 * 128; const GAS float* ps = inp(F, I_POOL_SCALE) + (size_t)l * MIXW; const GAS float* wb1 = wbr + (size_t)MIXW * D;
    GAS bf16* W1 = Wb + (size_t)D * MIXW;
    for (int idx = F.wg * 512 + F.tid; idx < D * MIXW; idx += F.G * 512) {
        const int m = idx >> 10, d = idx & 1023, g = m >> 7, c = m & 127;
        float s = 0.f;
        for (int dd = 0; dd < 128; ++dd) s += pw[(g * 128 + c) * 128 + dd] * ps[g * 128 + dd] * wb1[(size_t)(g * 128 + dd) * D + d];
        W1[(size_t)d * MIXW + m] = (bf16)f2bf(s);
    }
}
__device__ __forceinline__ void wprep_moe(const Frame& F, int l, int wg0, int nwg) {
    GAS bf16* W13 = (GAS bf16*)((GAS unsigned char*)F.out + 64 * MiB); GAS bf16* W2 = (GAS bf16*)(F.ws + WS_W2);
    LAS float* scr = (LAS float*)(F.lds + F.wave * 16384);
    const int gw = (F.wg - wg0) * NWAVES + F.wave, NGW = nwg * NWAVES;
    const GAS float* w1 = inp(F, I_MOE_W1); const GAS float* w3 = inp(F, I_MOE_W3); const GAS float* w2 = inp(F, I_MOE_W2);
#define MOE_ITEM_LOAD(R, r_) do { const int ri_ = (r_); if (ri_ < 16384) { const int e = ri_ >> 9, which = (ri_ >> 8) & 1, kb = (ri_ >> 4) & 15, nb = ri_ & 15; \
            tr_load(R, (which ? w3 : w1) + ((size_t)l * NEXP + e) * D * DEXP, DEXP, 64 * kb, nb * 32, F.lane); } \
        else if (ri_ < 24576) { const int q = ri_ - 16384, e = q >> 8, kb = (q >> 5) & 7, nb = q & 31; tr_load(R, w2 + ((size_t)l * NEXP + e) * DEXP * D, D, 64 * kb, 32 * nb, F.lane); } } while (0)
#define MOE_ITEM_STORE(R, r_) do { const int ri_ = (r_); if (ri_ < 16384) { const int e = ri_ >> 9, which = (ri_ >> 8) & 1, kb = (ri_ >> 4) & 15, nb = ri_ & 15, n0 = nb * 32; \
            tr_store(R, W13 + (size_t)e * D * D, D, 64 * kb, (n0 >> 7) * 256 + which * 128 + (n0 & 127), scr, F.lane); } \
        else if (ri_ < 24576) { const int q = ri_ - 16384, e = q >> 8, kb = (q >> 5) & 7, nb = q & 31; tr_store(R, W2 + (size_t)e * D * DEXP, DEXP, 64 * kb, 32 * nb, scr, F.lane); } } while (0)
    float ra[32], rb[32];
    MOE_ITEM_LOAD(ra, gw);
    for (int r = gw; r < 24576; r += 2 * NGW) {
        MOE_ITEM_LOAD(rb, r + NGW); MOE_ITEM_STORE(ra, r);
        MOE_ITEM_LOAD(ra, r + 2 * NGW); MOE_ITEM_STORE(rb, r + NGW);
    }
#undef MOE_ITEM_LOAD
#undef MOE_ITEM_STORE
}

__device__ __forceinline__ int w32_addr(int k, int c4) { return (k >> 1) * 256 + (((((k & 1) << 3) | c4) ^ ((k >> 1) & 15)) << 4); }
__device__ __forceinline__ void stage_w32(const Frame& F, const GAS float* src, int ldw, bool gates) {
    for (int idx = F.tid; idx < D * 8; idx += 512) {
        const int k = idx >> 3, c4 = idx & 7;
        int col = 4 * c4;
        if (gates) col = (c4 < 2) ? (C_A + 4 * c4) : (c4 < 4) ? (C_B + 4 * (c4 - 2)) : (c4 < 6) ? (C_I + 4 * (c4 - 4)) : (C_F + 4 * (c4 - 6));
        const f32x4 v = *(const GAS f32x4*)(src + (size_t)k * ldw + col);
        *(LAS f32x4*)(F.lds + w32_addr(k, c4)) = v;
    }
}
template <int MODE>
__device__ __forceinline__ void ln_phase(const Frame& F, const GAS float* gam, const GAS float* bet, const GAS float* w32src, int w32ld, bool do_proj, bool write_hb, bool dummy = false) {
    GAS float* OUTP = dummy ? (GAS float*)(F.ws + WS_R2) : F.out; GAS unsigned char* WSO = dummy ? (F.ws + WS_R2 + 40 * MiB) : F.ws;
    LAS int* lhist = (LAS int*)(F.lds + LHIST_OFF);
    if (do_proj) stage_w32(F, w32src, w32ld, MODE != 1);
    if (MODE == 1 && F.tid < 32) lhist[F.tid] = 0;
    __syncthreads();
    const int lane = F.lane;
    GAS bf16* hb = dummy ? (GAS bf16*)(F.ws + WS_R2 + 128 * MiB) : (GAS bf16*)(F.ws + WS_HB);
    const int rows_per_wg = T / F.G;
    const GAS int* posp = (const GAS int*)(F.ws + WS_POS); const GAS bf16* Yr = (const GAS bf16*)(F.ws + WS_YROWS);
    const GAS float* srcp = inp(F, I_X);
    const GAS bf16* preb = (MODE == 1) ? (const GAS bf16*)F.out : (const GAS bf16*)(F.ws + WS_HB);
#define LN_FETCH(V, Y0, Y1, row_) do { const int rw_ = (row_); \
        if (MODE == 0) { _Pragma("unroll") for (int m = 0; m < 8; ++m) V[m] = *(const GAS f32x2*)(srcp + (size_t)rw_ * D + 2 * lane + 128 * m); } \
        else { _Pragma("unroll") for (int m = 0; m < 8; ++m) { const unsigned u_ = *(const GAS unsigned*)(preb + (size_t)rw_ * D + 2 * lane + 128 * m); V[m].x = bf2f(u_ & 0xffffu); V[m].y = bf2f(u_ >> 16); } } \
        if (MODE == 2) { const int p0_ = posp[2 * rw_], p1_ = posp[2 * rw_ + 1]; \
            _Pragma("unroll") for (int m = 0; m < 8; ++m) { Y0[m] = *(const GAS unsigned*)(Yr + (size_t)p0_ * D + 2 * lane + 128 * m); Y1[m] = *(const GAS unsigned*)(Yr + (size_t)p1_ * D + 2 * lane + 128 * m); } } } while (0)
    const int nrow = rows_per_wg / NWAVES, row0 = F.wg * rows_per_wg + F.wave * nrow;
    f32x2 gvr[8], bvr[8];
    if constexpr (MODE == 2) {
#pragma unroll
        for (int m = 0; m < 8; ++m) { gvr[m] = *(const GAS f32x2*)(gam + 2 * lane + 128 * m); bvr[m] = *(const GAS f32x2*)(bet + 2 * lane + 128 * m); }
    }
    f32x2 vA[8], vB[8]; unsigned yA0[8], yA1[8], yB0[8], yB1[8];
    LN_FETCH(vA, yA0, yA1, row0);
#pragma unroll 1
    for (int i2 = 0; i2 < nrow; i2 += 2) {
#pragma unroll
      for (int half = 0; half < 2; ++half) {
        const int i = i2 + half; const int row = row0 + i;
        const int nrw = row0 + ((i + 1 < nrow) ? i + 1 : i);
        if (half == 0) LN_FETCH(vB, yB0, yB1, nrw); else LN_FETCH(vA, yA0, yA1, nrw);
        f32x2 v[8];
#pragma unroll
        for (int m = 0; m < 8; ++m) {
            const f32x2 o = half ? vB[m] : vA[m];
            if (MODE == 2) { const unsigned ya = half ? yB0[m] : yA0[m], yb = half ? yB1[m] : yA1[m];
                v[m].x = ALPHA * o.x + bf2f(ya & 0xffffu) + bf2f(yb & 0xffffu); v[m].y = ALPHA * o.y + bf2f(ya >> 16) + bf2f(yb >> 16); }
            else v[m] = o;
        }
        float s = 0.f;
#pragma unroll
        for (int m = 0; m < 8; ++m) s += v[m].x + v[m].y;
        const float mean = wave_sum(s) * (1.f / D);
        float s2 = 0.f;
#pragma unroll
        for (int m = 0; m < 8; ++m) { v[m].x -= mean; v[m].y -= mean; s2 += v[m].x * v[m].x + v[m].y * v[m].y; }
        const float rstd = 1.0f / sqrtf(wave_sum(s2) * (1.f / D) + LN_EPS);
        if constexpr (MODE == 2) {
#pragma unroll
            for (int m = 0; m < 8; ++m) { v[m].x = v[m].x * rstd * gvr[m].x + bvr[m].x; v[m].y = v[m].y * rstd * gvr[m].y + bvr[m].y; }
        } else { int goz = 2 * lane; asm volatile("" : "+v"(goz));
#pragma unroll
          for (int m = 0; m < 8; ++m) { const f32x2 g2 = *(const GAS f32x2*)(gam + goz + 128 * m), b2 = *(const GAS f32x2*)(bet + goz + 128 * m); v[m].x = v[m].x * rstd * g2.x + b2.x; v[m].y = v[m].y * rstd * g2.y + b2.y; } }
        if (!write_hb) {
#pragma unroll
            for (int m = 0; m < 8; ++m) *(GAS f32x2*)(OUTP + (size_t)row * D + 2 * lane + 128 * m) = v[m];
        }
        if (write_hb) {
#pragma unroll
            for (int m = 0; m < 8; ++m) *(GAS unsigned*)(hb + (size_t)row * D + 2 * lane + 128 * m) = cvt_pk_bf16(v[m].x, v[m].y);
        }
        if (!do_proj) continue;
        float acc[32];
#pragma unroll
        for (int c = 0; c < 32; ++c) acc[c] = 0.f;
        {
            f32x4 w0[4], w1[4];
#define W32_LD(W, g_) do { const int k_ = 2 * lane + 128 * ((g_) >> 2) + (((g_) >> 1) & 1); const int cb_ = ((g_) & 1) * 4; _Pragma("unroll") for (int c4 = 0; c4 < 4; ++c4) W[c4] = *(const LAS f32x4*)(F.lds + w32_addr(k_, cb_ + c4)); } while (0)
#define W32_FMA(W, g_) do { const float xv_ = (((g_) >> 1) & 1) ? v[(g_) >> 2].y : v[(g_) >> 2].x; const int cb_ = ((g_) & 1) * 4; _Pragma("unroll") for (int c4 = 0; c4 < 4; ++c4) { \
                acc[4 * (cb_ + c4) + 0] += xv_ * W[c4][0]; acc[4 * (cb_ + c4) + 1] += xv_ * W[c4][1]; acc[4 * (cb_ + c4) + 2] += xv_ * W[c4][2]; acc[4 * (cb_ + c4) + 3] += xv_ * W[c4][3]; } } while (0)
#define W32_SB() __builtin_amdgcn_sched_barrier(0)
            W32_LD(w0, 0);
#pragma unroll
            for (int g = 0; g < 32; g += 2) {
                W32_SB(); W32_LD(w1, g + 1); W32_SB(); W32_FMA(w0, g);
                W32_SB(); if (g + 2 < 32) W32_LD(w0, g + 2); W32_SB(); W32_FMA(w1, g + 1);
            }
#undef W32_LD
#undef W32_FMA
#undef W32_SB
        }
        float r16[16], r8[8], r4[4], r2[2], r1;
        { const bool hi = (lane & 32) != 0;
#pragma unroll
          for (int j = 0; j < 16; ++j) { const float a = acc[j], b = acc[j + 16]; const float send = hi ? a : b, keep = hi ? b : a; r16[j] = keep + __shfl_xor(send, 32); } }
        { const bool hi = (lane & 16) != 0;
#pragma unroll
          for (int j = 0; j < 8; ++j) { const float a = r16[j], b = r16[j + 8]; const float send = hi ? a : b, keep = hi ? b : a; r8[j] = keep + __shfl_xor(send, 16); } }
        { const bool hi = (lane & 8) != 0;
#pragma unroll
          for (int j = 0; j < 4; ++j) { const float a = r8[j], b = r8[j + 4]; const float send = hi ? a : b, keep = hi ? b : a; r4[j] = keep + __shfl_xor(send, 8); } }
        { const bool hi = (lane & 4) != 0;
#pragma unroll
          for (int j = 0; j < 2; ++j) { const float a = r4[j], b = r4[j + 2]; const float send = hi ? a : b, keep = hi ? b : a; r2[j] = keep + __shfl_xor(send, 4); } }
        { const bool hi = (lane & 2) != 0; const float a = r2[0], b = r2[1]; const float send = hi ? a : b, keep = hi ? b : a; r1 = keep + __shfl_xor(send, 2); }
        r1 += __shfl_xor(r1, 1);
        if (MODE != 1) {
            if ((lane & 1) == 0) ((GAS float*)(WSO + WS_SG))[(size_t)row * 32 + (lane >> 1)] = r1;
        } else {
            const float score = sigmoidf_(r1);
            const float sel = score + inp(F, I_ROUTER_B)[lane >> 1];
            const int gb = lane & ~7;
            const float v0 = __shfl(sel, gb + 0), v1 = __shfl(sel, gb + 2), v2 = __shfl(sel, gb + 4), v3 = __shfl(sel, gb + 6);
            int i1 = 0; float m1 = v0;
            if (v1 > m1) { m1 = v1; i1 = 1; } if (v2 > m1) { m1 = v2; i1 = 2; } if (v3 > m1) { m1 = v3; i1 = 3; }
            int i2 = -1; float m2 = -3.0e38f;
            if (i1 != 0 && v0 > m2) { m2 = v0; i2 = 0; } if (i1 != 1 && v1 > m2) { m2 = v1; i2 = 1; } if (i1 != 2 && v2 > m2) { m2 = v2; i2 = 2; } if (i1 != 3 && v3 > m2) { m2 = v3; i2 = 3; }
            float gs = m1 + m2; int gi = lane >> 3;
#pragma unroll
            for (int o = 8; o < 64; o <<= 1) { const float og = __shfl_xor(gs, o); const int oi = __shfl_xor(gi, o); if (og > gs || (og == gs && oi < gi)) { gs = og; gi = oi; } }
            const int src = gi * 8;
            const int e1 = gi * 4 + __shfl(i1, src), e2 = gi * 4 + __shfl(i2, src);
            const float s1 = __shfl(score, 2 * e1), s2 = __shfl(score, 2 * e2);
            if (lane == 0) {
                GAS int* eid = (GAS int*)(WSO + WS_EID); GAS float* ew = (GAS float*)(WSO + WS_EW);
                const float inv = 1.0f / (s1 + s2);
                eid[2 * row] = e1; eid[2 * row + 1] = e2; ew[2 * row] = s1 * inv; ew[2 * row + 1] = s2 * inv;
                __hip_atomic_fetch_add(lhist + e1, 1, __ATOMIC_RELAXED, __HIP_MEMORY_SCOPE_WORKGROUP); __hip_atomic_fetch_add(lhist + e2, 1, __ATOMIC_RELAXED, __HIP_MEMORY_SCOPE_WORKGROUP);
            }
        }
      }
    }
#undef LN_FETCH
    if (MODE == 1) {
        __syncthreads();
        if (F.tid < 32) ((GAS int*)(WSO + WS_HIST))[F.wg * 32 + F.tid] = lhist[F.tid];
    }
    __syncthreads();
}

__device__ __forceinline__ int invsigma32(int w) { return 8 * ((w >> 2) & 3) + 4 * (w >> 4) + (w & 3); }
__device__ __forceinline__ float wave_incl_scan(float v, int lane) {
#pragma unroll
    for (int o = 1; o < 64; o <<= 1) { const float t = __shfl_up(v, o); if (lane >= o) v += t; }
    return v;
}
__device__ __forceinline__ float wave_incl_maxscan(float v, int lane) {
#pragma unroll
    for (int o = 1; o < 64; o <<= 1) { const float t = __shfl_up(v, o); if (lane >= o) v = fmaxf(v, t); }
    return v;
}
constexpr int DQ_OFF = 0, DK_OFF = 17408, DV_OFF = 34816, DGM_OFF = 52224, DQK_OFF = 69632, DTM_OFF = 87040, DVEC_OFF = 121856;
constexpr int QROW = 272;
constexpr int FROW = 68;
__device__ __forceinline__ bf16x8 pack_b(const f32x4 lo, const f32x4 hi) {
    u32x4 w; w.x = cvt_pk_bf16(lo[0], lo[1]); w.y = cvt_pk_bf16(lo[2], lo[3]); w.z = cvt_pk_bf16(hi[0], hi[1]); w.w = cvt_pk_bf16(hi[2], hi[3]);
    return __builtin_bit_cast(bf16x8, w);
}
__device__ __forceinline__ bf16x8 pack8f(const float (&f)[8]) {
    u32x4 w; w.x = cvt_pk_bf16(f[0], f[1]); w.y = cvt_pk_bf16(f[2], f[3]); w.z = cvt_pk_bf16(f[4], f[5]); w.w = cvt_pk_bf16(f[6], f[7]);
    return __builtin_bit_cast(bf16x8, w);
}
#define PREP_BAR() do { asm volatile("s_waitcnt lgkmcnt(0)" ::: "memory"); __builtin_amdgcn_s_barrier(); asm volatile("" ::: "memory"); } while (0)
#ifndef DNREP_A
#define DNREP_A 1
#endif
#ifndef DNREP_B
#define DNREP_B 1
#endif
#ifndef DNREP_C
#define DNREP_C 1
#endif
#ifndef DNREP_D
#define DNREP_D 1
#endif
__device__ __forceinline__ void dn_prep(const Frame& F, int l) {
    LAS unsigned char* L = F.lds;
    const int lane = F.lane, wave = F.wave, tid = F.tid, fr = lane & 15, fq = lane >> 4;
    const GAS bf16* P = (const GAS bf16*)(F.ws + WS_PQKV);
    const GAS float* SG = (const GAS float*)(F.ws + WS_SG);
    const GAS float* cw = inp(F, I_CONV) + (size_t)l * 5 * 1536;
    LAS float* GM = (LAS float*)(L + DGM_OFF); LAS float* QKM = (LAS float*)(L + DQK_OFF);
#ifdef DIAG
    unsigned long long tacc[7] = {0, 0, 0, 0, 0, 0, 0}; unsigned long long tprev = __builtin_amdgcn_s_memrealtime();
#define DSTAMP(k) do { const unsigned long long tn_ = __builtin_amdgcn_s_memrealtime(); tacc[k] += tn_ - tprev; tprev = tn_; } while (0)
#else
#define DSTAMP(k) do {} while (0)
#endif
    unsigned praw[12][3]; float pga = 0.f, pgb = 0.f;
#define DN_PF(item_) do { const int it_ = (item_) < NB * NHEAD * NCH ? (item_) : F.wg; const int b_ = it_ >> 9, h_ = (it_ >> 7) & 3, n_ = it_ & 127; \
        _Pragma("unroll") for (int rr = 0; rr < 12; ++rr) { const int sp_ = n_ * CH + 8 * wave + rr - 2; const bool ok_ = (sp_ >= 0 && sp_ < SEQ); \
            const GAS bf16* src_ = P + (size_t)(b_ * SEQ + (ok_ ? sp_ : 0)) * 1536 + h_ * 128 + 2 * lane; \
            _Pragma("unroll") for (int p = 0; p < 3; ++p) { const unsigned u_ = *(const GAS unsigned*)(src_ + p * 512); praw[rr][p] = ok_ ? u_ : 0u; } } \
        if (wave < 2) { const int ti_ = wave ? 63 - lane : lane; const int t0_ = b_ * SEQ + n_ * CH; pga = SG[(size_t)(t0_ + ti_) * 32 + wave * 4 + h_]; pgb = SG[(size_t)(t0_ + ti_) * 32 + 8 + wave * 4 + h_]; } } while (0)
    DN_PF(F.wg);
    for (int item = F.wg; item < NB * NHEAD * NCH; item += F.G) {
        const int b = item >> 9, h = (item >> 7) & 3, n = item & 127;
        const int t0 = b * SEQ + n * CH;
        for (int repA = 0; repA < DNREP_A; ++repA) {
        {
            float w[3][5][2];
#pragma unroll
            for (int p = 0; p < 3; ++p)
#pragma unroll
                for (int j = 0; j < 5; ++j) { const f32x2 t = *(const GAS f32x2*)(cw + j * 1536 + p * 512 + h * 128 + 2 * lane); w[p][j][0] = t.x; w[p][j][1] = t.y; }
            f32x2 ya[8][3];
#pragma unroll
            for (int ii = 0; ii < 8; ++ii)
#pragma unroll
                for (int p = 0; p < 3; ++p) ya[ii][p] = (f32x2){0.f, 0.f};
#pragma unroll
            for (int rr = 0; rr < 12; ++rr) {
                f32x2 xs[3];
#pragma unroll
                for (int p = 0; p < 3; ++p) { const unsigned u = praw[rr][p]; xs[p] = (f32x2){bf2f(u & 0xffffu), __uint_as_float(u & 0xffff0000u)}; }
#pragma unroll
                for (int j = 0; j < 5; ++j) { const int ii = rr - j;
                    if (ii >= 0 && ii < 8) {
#pragma unroll
                        for (int p = 0; p < 3; ++p) ya[ii][p] += xs[p] * (f32x2){w[p][j][0], w[p][j][1]}; } }
            }
#pragma unroll
            for (int ii = 0; ii < 8; ++ii) {
                const int i = 8 * wave + ii;
                float y[3][2];
#pragma unroll
                for (int p = 0; p < 3; ++p) { y[p][0] = ya[ii][p].x * fast_sigmoid(ya[ii][p].x); y[p][1] = ya[ii][p].y * fast_sigmoid(ya[ii][p].y); }
                const float sq = wave_sum(y[0][0] * y[0][0] + y[0][1] * y[0][1]), sk = wave_sum(y[1][0] * y[1][0] + y[1][1] * y[1][1]);
                const float rq = __builtin_amdgcn_rsqf(sq + NORM_EPS) * 0.08838834764831845f, rk = __builtin_amdgcn_rsqf(sk + NORM_EPS);
                *(LAS unsigned*)(L + DQ_OFF + i * QROW + 4 * lane) = cvt_pk_bf16(y[0][0] * rq, y[0][1] * rq);
                *(LAS unsigned*)(L + DK_OFF + i * QROW + 4 * lane) = cvt_pk_bf16(y[1][0] * rk, y[1][1] * rk);
                *(LAS unsigned*)(L + DV_OFF + i * QROW + 4 * lane) = cvt_pk_bf16(y[2][0], y[2][1]);
            }
            if (wave < 2) {
                const int d = wave; const int ti = d ? 63 - lane : lane;
                const float a = pga, bb = pgb;
                const float beta = sigmoidf_(bb);
                const float g = -expf(inp(F, I_A_LOG)[l * 8 + d * 4 + h]) * softplusf_(a + inp(F, I_DT_BIAS)[l * 8 + d * 4 + h]);
                const float gc = wave_incl_scan(g, lane);
                const float gl = __shfl(gc, 63);
                LAS float* vec = (LAS float*)(L + DVEC_OFF + d * 1024);
                vec[lane] = beta; vec[64 + lane] = gc; vec[128 + lane] = expf(gc); vec[192 + lane] = expf(gl - gc);
                if (lane == 63) ((GAS float*)(F.ws + WS_GL))[(size_t)item * 2 + d] = expf(gc);
            }
        }
        PREP_BAR();
        DSTAMP(0);
        }
        for (int repB = 0; repB < DNREP_B; ++repB) {
        {
#pragma unroll
            for (int tt = 0; tt < 2; ++tt) {
                const int t = 2 * wave + tt, mt = t >> 2, nt = t & 3;
                f32x4 ag = (f32x4){0.f, 0.f, 0.f, 0.f}, aq = (f32x4){0.f, 0.f, 0.f, 0.f};
#pragma unroll
                for (int s = 0; s < 4; ++s) {
                    const bf16x8 ka = *(const LAS bf16x8*)(L + DK_OFF + (16 * mt + fr) * QROW + 64 * s + 16 * fq);
                    const bf16x8 qa = *(const LAS bf16x8*)(L + DQ_OFF + (16 * mt + fr) * QROW + 64 * s + 16 * fq);
                    const bf16x8 kb = *(const LAS bf16x8*)(L + DK_OFF + (16 * nt + fr) * QROW + 64 * s + 16 * fq);
                    ag = __builtin_amdgcn_mfma_f32_16x16x32_bf16(ka, kb, ag, 0, 0, 0);
                    aq = __builtin_amdgcn_mfma_f32_16x16x32_bf16(qa, kb, aq, 0, 0, 0);
                }
#pragma unroll
                for (int r = 0; r < 4; ++r) { GM[(16 * mt + 4 * fq + r) * FROW + 16 * nt + fr] = ag[r]; QKM[(16 * mt + 4 * fq + r) * FROW + 16 * nt + fr] = aq[r]; }
            }
        }
        PREP_BAR();
        DSTAMP(1);
        }
        for (int repC = 0; repC < DNREP_C; ++repC) {
        {
#pragma unroll 4
            for (int e = 0; e < 16; ++e) {
                const int idx = tid + 512 * e, d = idx >> 12, i = (idx >> 6) & 63, j = idx & 63;
                const LAS float* vec = (const LAS float*)(L + DVEC_OFF + d * 1024);
                const int ti = d ? 63 - i : i, tj = d ? 63 - j : j;
                float v = (j < i) ? vec[i] * GM[ti * FROW + tj] * fexp(fminf(vec[64 + i] - vec[64 + j], 0.f)) : 0.f;
                if ((i & 31) == 0 && j >= (i & 32)) v = (j == i) ? 1.f : 0.f;
                *(LAS float*)(L + DTM_OFF + d * 17408 + (i * FROW + j) * 4) = v;
            }
        }
        PREP_BAR();
        DSTAMP(2);
        if (wave < 4) {
            const int d = wave >> 1, hb = wave & 1, c = lane & 31;
            LAS float* TM = (LAS float*)(L + DTM_OFF + d * 17408) + (32 * hb) * FROW + 32 * hb;
#define SUBST_PART(NB4, BASE) do { f32x4 m4[NB4]; float tv_[4 * NB4]; \
                _Pragma("unroll") for (int q = 0; q < NB4; ++q) m4[q] = *(const LAS f32x4*)(TM + i * FROW + (BASE) + 4 * q); \
                _Pragma("unroll") for (int q = 0; q < 4 * NB4; ++q) tv_[q] = TM[((BASE) + q) * FROW + c]; \
                _Pragma("unroll") for (int q = 0; q < NB4; ++q) { a0 -= m4[q][0] * tv_[4 * q]; a1 -= m4[q][1] * tv_[4 * q + 1]; a2 -= m4[q][2] * tv_[4 * q + 2]; a3 -= m4[q][3] * tv_[4 * q + 3]; } } while (0)
#define SUBST_END() do { const float tv = ((c == i) ? 1.f : 0.f) + ((a0 + a1) + (a2 + a3)); asm volatile("s_waitcnt lgkmcnt(0)" ::: "memory"); TM[i * FROW + c] = tv; } while (0)
#pragma unroll 1
            for (int i = 1; i < 16; ++i) { float a0 = 0.f, a1 = 0.f, a2 = 0.f, a3 = 0.f; SUBST_PART(4, 0); SUBST_END(); }
#pragma unroll 1
            for (int i = 16; i < 32; ++i) { float a0 = 0.f, a1 = 0.f, a2 = 0.f, a3 = 0.f; SUBST_PART(4, 0); asm volatile("" ::: "memory"); SUBST_PART(4, 16); SUBST_END(); }
#undef SUBST_PART
#undef SUBST_END
        } else {
            const int tw = wave - 4;
#pragma unroll 4
            for (int it = tw; it < 128; it += 4) {
                const int d = it >> 6, i = it & 63, ti = d ? 63 - i : i;
                const LAS float* vec = (const LAS float*)(L + DVEC_OFF + d * 1024);
                GAS unsigned char* rec = F.ws + WS_R2 + ((size_t)item * 2 + d) * DNREC;
                { const int p = 2 * lane; const int kk = (p & ~31) + sigma32(p & 31);
                  const unsigned u = *(const LAS unsigned*)(L + DQ_OFF + ti * QROW + 2 * kk); const float e = vec[128 + i];
                  *(GAS unsigned*)(rec + DN_QG + (i * 128 + p) * 2) = cvt_pk_bf16(bf2f(u & 0xffffu) * e, bf2f(u >> 16) * e); }
                { const int p = lane; const int j = (p & ~31) + sigma32(p & 31), tj = d ? 63 - j : j;
                  const float v = (j <= i) ? QKM[ti * FROW + tj] * fexp(fminf(vec[64 + i] - vec[64 + j], 0.f)) : 0.f;
                  ((GAS bf16*)(rec + DN_ATT))[i * 64 + p] = bf1(v); }
            }
#pragma unroll 4
            for (int it = tw; it < 128; it += 4) {
                const int d = it >> 6, kk = 2 * (it & 63);
                const LAS float* vec = (const LAS float*)(L + DVEC_OFF + d * 1024);
                GAS bf16* Kd = (GAS bf16*)(F.ws + WS_R2 + ((size_t)item * 2 + d) * DNREC + DN_KDT);
                const int p = lane; const int j = (p & ~31) + sigma32(p & 31), tj = d ? 63 - j : j;
                const unsigned u = *(const LAS unsigned*)(L + DK_OFF + tj * QROW + 2 * kk); const float e = vec[192 + j];
                Kd[kk * 64 + p] = bf1(bf2f(u & 0xffffu) * e); Kd[(kk + 1) * 64 + p] = bf1(bf2f(u >> 16) * e);
            }
        }
        PREP_BAR();
        DSTAMP(3);
        if (wave < 2) {
            LAS float* TM = (LAS float*)(L + DTM_OFF + wave * 17408);
            bf16x8 am[2], bt[2];
#pragma unroll
            for (int mt = 0; mt < 2; ++mt) { const f32x4 lo = *(const LAS f32x4*)(TM + (32 + 16 * mt + fr) * FROW + 8 * fq), hi = *(const LAS f32x4*)(TM + (32 + 16 * mt + fr) * FROW + 8 * fq + 4); am[mt] = pack_b(lo, hi); }
#pragma unroll
            for (int nt = 0; nt < 2; ++nt) { float xf[8];
#pragma unroll
                for (int e = 0; e < 8; ++e) xf[e] = TM[(8 * fq + e) * FROW + 16 * nt + fr];
                bt[nt] = pack8f(xf); }
            f32x4 X[2][2];
#pragma unroll
            for (int mt = 0; mt < 2; ++mt)
#pragma unroll
                for (int nt = 0; nt < 2; ++nt) X[mt][nt] = __builtin_amdgcn_mfma_f32_16x16x32_bf16(am[mt], bt[nt], (f32x4){0.f, 0.f, 0.f, 0.f}, 0, 0, 0);
            bf16x8 xb[2], a2[2];
#pragma unroll
            for (int nt = 0; nt < 2; ++nt) xb[nt] = pack_b(X[0][nt], X[1][nt]);
#pragma unroll
            for (int mt = 0; mt < 2; ++mt) { const f32x4 lo = *(const LAS f32x4*)(TM + (32 + 16 * mt + fr) * FROW + 32 + 4 * fq), hi = *(const LAS f32x4*)(TM + (32 + 16 * mt + fr) * FROW + 32 + 16 + 4 * fq); a2[mt] = pack_b(lo, hi); }
#pragma unroll
            for (int mt = 0; mt < 2; ++mt)
#pragma unroll
                for (int nt = 0; nt < 2; ++nt) { const f32x4 t21 = __builtin_amdgcn_mfma_f32_16x16x32_bf16(a2[mt], xb[nt], (f32x4){0.f, 0.f, 0.f, 0.f}, 0, 0, 0);
#pragma unroll
                    for (int r = 0; r < 4; ++r) TM[(32 + 16 * mt + 4 * fq + r) * FROW + 16 * nt + fr] = -t21[r]; }
        }
        PREP_BAR();
        DSTAMP(4);
        }
        DN_PF(item + F.G);
        for (int repD = 0; repD < DNREP_D; ++repD) {
#pragma unroll 1
        for (int d = 0; d < 2; ++d) {
            const LAS float* TM = (const LAS float*)(L + DTM_OFF + d * 17408);
            const LAS float* vec = (const LAS float*)(L + DVEC_OFF + d * 1024);
            GAS unsigned char* rec = F.ws + WS_R2 + ((size_t)item * 2 + d) * DNREC;
            bf16x8 ta[4][2];
#pragma unroll
            for (int mt = 0; mt < 4; ++mt)
#pragma unroll
                for (int s = 0; s < 2; ++s) { const f32x4 lo = *(const LAS f32x4*)(TM + (16 * mt + fr) * FROW + 32 * s + 8 * fq), hi = *(const LAS f32x4*)(TM + (16 * mt + fr) * FROW + 32 * s + 8 * fq + 4); ta[mt][s] = pack_b(lo, hi); }
#pragma unroll 1
            for (int tt = 0; tt < 2; ++tt) {
                const int nt = 2 * wave + tt; const bool isv = nt < 8; const int col = 16 * (nt & 7) + fr;
                const int imgoff = isv ? DV_OFF : DK_OFF;
                bf16x8 xb[2];
#pragma unroll
                for (int s = 0; s < 2; ++s) { float xf[8];
#pragma unroll
                    for (int e = 0; e < 8; ++e) { const int j = 32 * s + 8 * fq + e, tj = d ? 63 - j : j;
                        const float x = bf2f(*(const LAS unsigned short*)(L + imgoff + tj * QROW + 2 * col));
                        xf[e] = x * vec[j] * (isv ? 1.f : vec[128 + j]); }
                    xb[s] = pack8f(xf); }
                f32x4 acc[4];
#pragma unroll
                for (int mt = 0; mt < 4; ++mt) { acc[mt] = (f32x4){0.f, 0.f, 0.f, 0.f};
#pragma unroll
                    for (int s = 0; s < 2; ++s) acc[mt] = __builtin_amdgcn_mfma_f32_16x16x32_bf16(ta[mt][s], xb[s], acc[mt], 0, 0, 0); }
                if (isv) {
                    GAS bf16* Uf = (GAS bf16*)(rec + DN_UF) + ((nt * 64 + lane) * 16);
#pragma unroll
                    for (int mt = 0; mt < 4; ++mt) { u32x2 w2; w2.x = cvt_pk_bf16(acc[mt][0], acc[mt][1]); w2.y = cvt_pk_bf16(acc[mt][2], acc[mt][3]); *(GAS u32x2*)(Uf + mt * 4) = w2; }
                } else {
                    GAS bf16* Wp = (GAS bf16*)(rec + DN_W); const int pos = (col & ~31) + invsigma32(col & 31);
#pragma unroll
                    for (int mt = 0; mt < 4; ++mt)
#pragma unroll
                        for (int r = 0; r < 4; ++r) Wp[(16 * mt + 4 * fq + r) * 128 + pos] = bf1(acc[mt][r]);
                }
            }
        }
        PREP_BAR();
        DSTAMP(5);
        }
    }
#ifdef DIAG
    if (F.tid == 0 && F.wg == 0 && l == 0) { for (int k = 0; k < 6; ++k) ((GAS unsigned long long*)(F.ws + WS_CTL + 1024))[48 + k] = tacc[k]; }
#endif
}

__device__ __forceinline__ int swz256(int row, int c16) { return row * 256 + ((c16 ^ (row & 15)) << 4); }
__device__ __forceinline__ int swz128(int row, int c8) { return (row >> 1) * 256 + (((((row & 1) << 3) | c8) ^ ((row >> 1) & 15)) << 4); }
constexpr int DNBUF = 57344;
#define SCAN_BAR() do { asm volatile("s_waitcnt lgkmcnt(0)" ::: "memory"); __builtin_amdgcn_s_barrier(); asm volatile("" ::: "memory"); } while (0)
__device__ __forceinline__ void dn_scan(const Frame& F) {
    if (F.wg >= 128) return;
    const int xcd = F.wg & 7, idx = F.wg >> 3;
    const int chain = xcd * 4 + (idx >> 2), qtr = idx & 3;
    const int b = chain >> 3, h = (chain >> 1) & 3, d = chain & 1;
    const int lane = F.lane, fr = lane & 15, fq = lane >> 4, wave = F.wave;
    LAS unsigned char* L = F.lds;
    const GAS unsigned char* recbase = F.ws + WS_R2;
    const int itembase = (b * NHEAD + h) * NCH;
    if (wave >= 2) {
        const int tl = F.tid - 128;
        u32x4 ra[10], rb[10];
        int woff[10];
#pragma unroll
        for (int i = 0; i < 10; ++i) { const int q = tl + 384 * i;
            if (q < 1024) woff[i] = swz256(q >> 4, q & 15); else if (q < 2048) woff[i] = 16384 + swz256((q - 1024) >> 4, q & 15);
            else if (q < 3072) woff[i] = 32768 + swz128((q - 2048) >> 3, q & 7); else if (q < 3584) woff[i] = 49152 + swz128((q - 3072) >> 3, q & 7); else woff[i] = -1; }
#define DN_LOAD(R, step_) do { const int st_ = (step_) < NCH ? (step_) : NCH - 1; const int n_ = d ? (NCH - 1 - st_) : st_; \
        const GAS u32x4* src_ = (const GAS u32x4*)(recbase + ((size_t)(itembase + n_) * 2 + d) * DNREC) + tl; \
        _Pragma("unroll") for (int i = 0; i < 10; ++i) R[i] = src_[(woff[i] >= 0) ? 384 * i : 0]; } while (0)
#define DN_WRITE(R, bufoff_) do { _Pragma("unroll") for (int i = 0; i < 10; ++i) if (woff[i] >= 0) *(LAS u32x4*)(L + (bufoff_) + woff[i]) = R[i]; } while (0)
        u32x4 rc[10];
        DN_LOAD(ra, 0); DN_LOAD(rb, 1); DN_LOAD(rc, 2);
        DN_WRITE(ra, 0);
        SCAN_BAR();
        for (int s = 0; s < 126; s += 6) {
            DN_LOAD(ra, s + 3); DN_WRITE(rb, DNBUF); SCAN_BAR();
            DN_LOAD(rb, s + 4); DN_WRITE(rc, 0);     SCAN_BAR();
            DN_LOAD(rc, s + 5); DN_WRITE(ra, DNBUF); SCAN_BAR();
            DN_LOAD(ra, s + 6); DN_WRITE(rb, 0);     SCAN_BAR();
            DN_LOAD(rb, s + 7); DN_WRITE(rc, DNBUF); SCAN_BAR();
            DN_LOAD(rc, s + 8); DN_WRITE(ra, 0);     SCAN_BAR();
        }
        DN_WRITE(rb, DNBUF); SCAN_BAR();
        SCAN_BAR();
#undef DN_LOAD
#undef DN_WRITE
        return;
    }
    const int slice = qtr * 2 + wave;
    const GAS float* GL = (const GAS float*)(F.ws + WS_GL);
    GAS bf16* O = (GAS bf16*)(F.ws + (d ? WS_OB : WS_OF));
    f32x4 S[8];
#pragma unroll
    for (int k = 0; k < 8; ++k) S[k] = (f32x4){0.f, 0.f, 0.f, 0.f};
    int offw[4], offk[8], offa[4];
#pragma unroll
    for (int t = 0; t < 4; ++t) { offw[t] = (16 * t + fr) * 256; offa[t] = ((16 * t + fr) >> 1) * 256; }
#pragma unroll
    for (int t = 0; t < 8; ++t) offk[t] = ((16 * t + fr) >> 1) * 256;
    const int x256 = fr & 15;
    const int x128 = (fr >> 1) & 15, p128 = (fr & 1) << 3;
    u32x4 uc0, uc1, un0, un1; float egl_c, egl_n;
    int vz = 0; asm volatile("" : "+v"(vz));
#define DN_UFETCH(A0, A1, EG, step_) do { const int st_ = (step_) < NCH ? (step_) : NCH - 1; const int nn_ = d ? (NCH - 1 - st_) : st_; \
        const GAS bf16* Uf_ = (const GAS bf16*)(recbase + ((size_t)(itembase + nn_) * 2 + d) * DNREC + DN_UF); A0 = *(const GAS u32x4*)(Uf_ + (slice * 64 + lane) * 16); A1 = *(const GAS u32x4*)(Uf_ + (slice * 64 + lane) * 16 + 8); \
        EG = GL[(size_t)(itembase + nn_) * 2 + d + vz]; } while (0)
    DN_UFETCH(uc0, uc1, egl_c, 0); DN_UFETCH(un0, un1, egl_n, 1);
    SCAN_BAR();
    for (int step = 0; step < NCH; ++step) {
        const int n = d ? (NCH - 1 - step) : step;
        const int bufoff = (step & 1) ? DNBUF : 0;
        const u32x4 u0 = uc0, u1 = uc1; const float egl = egl_c;
        uc0 = un0; uc1 = un1; egl_c = egl_n;
        DN_UFETCH(un0, un1, egl_n, step + 2);
        const LAS unsigned char* Bw = L + bufoff; const LAS unsigned char* Bq = Bw + 16384; const LAS unsigned char* Bk = Bw + 32768; const LAS unsigned char* Ba = Bw + 49152;
#define LD_WQ(G, s_) do { _Pragma("unroll") for (int mt = 0; mt < 4; ++mt) { const int o_ = offw[mt] + (((4 * (s_) + fq) ^ x256) << 4); G[mt] = *(const LAS bf16x8*)(Bw + o_); G[4 + mt] = *(const LAS bf16x8*)(Bq + o_); } } while (0)
#define MM_WQ(G, s_) do { _Pragma("unroll") for (int mt = 0; mt < 4; ++mt) { V[mt] = __builtin_amdgcn_mfma_f32_16x16x32_bf16(G[mt], SB[s_], V[mt], 0, 0, 0); Q[mt] = __builtin_amdgcn_mfma_f32_16x16x32_bf16(SB[s_], G[4 + mt], Q[mt], 0, 0, 0); } } while (0)
#define LD_K(G, s2_) do { _Pragma("unroll") for (int kt = 0; kt < 8; ++kt) { const int xr_ = (8 * kt + (fr >> 1)) & 15; G[kt] = *(const LAS bf16x8*)(Bk + offk[kt] + (((p128 | (4 * (s2_) + fq)) ^ xr_) << 4)); } } while (0)
#define SCHED_() __builtin_amdgcn_sched_barrier(0)
        bf16x8 g0[8], g1[8];
        LD_WQ(g0, 0);
        bf16x8 SB[4];
#pragma unroll
        for (int s = 0; s < 4; ++s) SB[s] = pack_b(S[2 * s], S[2 * s + 1]);
        f32x4 V[4], Q[4];
#pragma unroll
        for (int mt = 0; mt < 4; ++mt) { V[mt] = (f32x4){0.f, 0.f, 0.f, 0.f}; Q[mt] = (f32x4){0.f, 0.f, 0.f, 0.f}; }
        SCHED_(); LD_WQ(g1, 1); SCHED_(); MM_WQ(g0, 0); SCHED_();
        LD_WQ(g0, 2); SCHED_(); MM_WQ(g1, 1); SCHED_();
        LD_WQ(g1, 3); SCHED_(); MM_WQ(g0, 2); SCHED_();
#pragma unroll
        for (int s2 = 0; s2 < 2; ++s2)
#pragma unroll
            for (int mt = 0; mt < 4; ++mt) { const int xr = (8 * mt + (fr >> 1)) & 15; g0[s2 * 4 + mt] = *(const LAS bf16x8*)(Ba + offa[mt] + (((p128 | (4 * s2 + fq)) ^ xr) << 4)); }
        SCHED_(); MM_WQ(g1, 3); SCHED_();
        LD_K(g1, 0); SCHED_();
        {
            float uu[16]; { float t[8]; unpack8(u0, t);
#pragma unroll
                for (int e = 0; e < 8; ++e) uu[e] = t[e]; unpack8(u1, t);
#pragma unroll
                for (int e = 0; e < 8; ++e) uu[8 + e] = t[e]; }
#pragma unroll
            for (int mt = 0; mt < 4; ++mt)
#pragma unroll
                for (int r = 0; r < 4; ++r) V[mt][r] = uu[mt * 4 + r] - V[mt][r];
        }
        bf16x8 VB[2];
#pragma unroll
        for (int s2 = 0; s2 < 2; ++s2) VB[s2] = pack_b(V[2 * s2], V[2 * s2 + 1]);
#pragma unroll
        for (int kt = 0; kt < 8; ++kt) S[kt] = S[kt] * egl;
        SCHED_();
#pragma unroll
        for (int s2 = 0; s2 < 2; ++s2)
#pragma unroll
            for (int mt = 0; mt < 4; ++mt) Q[mt] = __builtin_amdgcn_mfma_f32_16x16x32_bf16(VB[s2], g0[s2 * 4 + mt], Q[mt], 0, 0, 0);
        SCHED_(); LD_K(g0, 1); SCHED_();
#pragma unroll
        for (int kt = 0; kt < 8; ++kt) S[kt] = __builtin_amdgcn_mfma_f32_16x16x32_bf16(g1[kt], VB[0], S[kt], 0, 0, 0);
        SCHED_();
#pragma unroll
        for (int kt = 0; kt < 8; ++kt) S[kt] = __builtin_amdgcn_mfma_f32_16x16x32_bf16(g0[kt], VB[1], S[kt], 0, 0, 0);
        SCHED_();
#undef LD_WQ
#undef MM_WQ
#undef LD_K
#undef SCHED_
#pragma unroll
        for (int mt = 0; mt < 4; ++mt) {
            const int i = 16 * mt + fr; const int tok = b * SEQ + n * CH + (d ? 63 - i : i);
            u32x2 w2; w2.x = cvt_pk_bf16(Q[mt][0], Q[mt][1]); w2.y = cvt_pk_bf16(Q[mt][2], Q[mt][3]);
            *(GAS u32x2*)(O + (size_t)tok * MIXW + h * HD + slice * 16 + 4 * fq) = w2;
        }
        SCAN_BAR();
    }
}

constexpr int MQ_OFF = 0, MK_OFF = 9216, MV_OFF = 18432, MQK_OFF = 35840, MVEC_OFF = 52480;
constexpr int MQROW = 144;
#ifndef MLREP_1
#define MLREP_1 1
#endif
#ifndef MLREP_2
#define MLREP_2 1
#endif
#ifndef MLREP_3
#define MLREP_3 1
#endif
#ifndef MLREP_4
#define MLREP_4 1
#endif
#ifndef POOLREP
#define POOLREP 1
#endif
__device__ __forceinline__ void ml_prep(const Frame& F, int l) {
    LAS unsigned char* L = F.lds;
    const int lane = F.lane, wave = F.wave, tid = F.tid;
    const GAS bf16* PQ = (const GAS bf16*)(F.ws + WS_PMQ); const GAS bf16* PK = (const GAS bf16*)(F.ws + WS_PMK); const GAS bf16* PV = (const GAS bf16*)(F.ws + WS_PMV);
    const GAS float* SG = (const GAS float*)(F.ws + WS_SG);
    const GAS float* gbias = inp(F, I_ML_GATE_B) + l * 16;
    u32x4 pq, pk, pv0, pv1; float pip = 0.f, pfp = 0.f;
#define ML_PF(item_) do { const int it_ = (item_) < NB * NHEAD * NCH ? (item_) : F.wg; const int b_ = it_ >> 9, h_ = (it_ >> 7) & 3, n_ = it_ & 127; const int t0_ = b_ * SEQ + n_ * CH; \
        const int row_ = tid >> 3, c8_ = tid & 7; \
        pq = *(const GAS u32x4*)(PQ + (size_t)(t0_ + row_) * 256 + h_ * 64 + 8 * c8_); pk = *(const GAS u32x4*)(PK + (size_t)(t0_ + row_) * 256 + h_ * 64 + 8 * c8_); \
        pv0 = *(const GAS u32x4*)(PV + (size_t)(t0_ + (tid >> 4)) * 512 + h_ * 128 + 8 * (tid & 15)); pv1 = *(const GAS u32x4*)(PV + (size_t)(t0_ + 32 + (tid >> 4)) * 512 + h_ * 128 + 8 * (tid & 15)); \
        if (wave < 2) { const int ti_ = wave ? 63 - lane : lane; pip = SG[(size_t)(t0_ + ti_) * 32 + 16 + wave * 4 + h_]; pfp = SG[(size_t)(t0_ + ti_) * 32 + 24 + wave * 4 + h_]; } } while (0)
    ML_PF(F.wg);
    for (int item = F.wg; item < NB * NHEAD * NCH; item += F.G) {
        const int b = item >> 9, h = (item >> 7) & 3, n = item & 127;
        const int t0 = b * SEQ + n * CH;
        float ip_raw = pip, fp_raw = pfp;
        for (int rep1 = 0; rep1 < MLREP_1; ++rep1) {
        {
            const int row = tid >> 3, c8 = tid & 7;
            u32x4 k = pk;
            { float f[8]; unpack8(k, f); k.x = cvt_pk_bf16(f[0] * 0.125f, f[1] * 0.125f); k.y = cvt_pk_bf16(f[2] * 0.125f, f[3] * 0.125f); k.z = cvt_pk_bf16(f[4] * 0.125f, f[5] * 0.125f); k.w = cvt_pk_bf16(f[6] * 0.125f, f[7] * 0.125f); }
            *(LAS u32x4*)(L + MQ_OFF + row * MQROW + 16 * c8) = pq;
            *(LAS u32x4*)(L + MK_OFF + row * MQROW + 16 * c8) = k;
            *(LAS u32x4*)(L + MV_OFF + (tid >> 4) * QROW + 16 * (tid & 15)) = pv0;
            *(LAS u32x4*)(L + MV_OFF + (32 + (tid >> 4)) * QROW + 16 * (tid & 15)) = pv1;
            ML_PF(item + F.G);
        }
        PREP_BAR();
        }
        for (int rep2 = 0; rep2 < MLREP_2; ++rep2) {
        {
            const int fr = lane & 15, fq = lane >> 4;
#pragma unroll
            for (int tt = 0; tt < 2; ++tt) {
                const int t = 2 * wave + tt, mt = t >> 2, nt = t & 3;
                f32x4 aq = (f32x4){0.f, 0.f, 0.f, 0.f};
#pragma unroll
                for (int s2 = 0; s2 < 2; ++s2) {
                    const bf16x8 qa = *(const LAS bf16x8*)(L + MQ_OFF + (16 * mt + fr) * MQROW + 64 * s2 + 16 * fq);
                    const bf16x8 kb = *(const LAS bf16x8*)(L + MK_OFF + (16 * nt + fr) * MQROW + 64 * s2 + 16 * fq);
                    aq = __builtin_amdgcn_mfma_f32_16x16x32_bf16(qa, kb, aq, 0, 0, 0);
                }
#pragma unroll
                for (int r = 0; r < 4; ++r) *(LAS float*)(L + MQK_OFF + ((16 * mt + 4 * fq + r) * 65 + 16 * nt + fr) * 4) = aq[r];
            }
        }
        }
        for (int rep3 = 0; rep3 < MLREP_3; ++rep3) {
        if (wave < 2) {
            const int d = wave; const int ti = d ? 63 - lane : lane;
            const float ip = ip_raw + gbias[d * 4 + h];
            const float fp = fp_raw + gbias[8 + d * 4 + h];
            const float bc = wave_incl_scan(logsigmoidf_(fp), lane);
            const float bl = __shfl(bc, 63);
            const float lw = bl - bc + ip;
            const float am = wave_max(lw);
            const float wgt = expf(lw - am);
            const float ipb = ip - bc;
            const float dmax = bc + wave_incl_maxscan(ipb, lane);
            LAS float* vec = (LAS float*)(L + MVEC_OFF + d * 1024);
            vec[lane] = bc; vec[64 + lane] = dmax; vec[128 + lane] = wgt; vec[192 + lane] = ipb;
            GAS float* row = (GAS float*)(F.ws + WS_ML + ((size_t)item * 2 + d) * MLREC + ML_ROW);
            row[lane] = bc; row[64 + lane] = dmax; if (lane == 0) { row[128] = am; row[129] = bl; }
        }
        PREP_BAR();
        }
        for (int rep4 = 0; rep4 < MLREP_4; ++rep4) {
        {
            const LAS float* QKM = (const LAS float*)(L + MQK_OFF);
#pragma unroll 4
            for (int it = wave; it < 128; it += NWAVES) {
                const int d = it >> 6, i = it & 63, j = lane;
                const LAS float* vec = (const LAS float*)(L + MVEC_OFF + d * 1024);
                GAS unsigned char* rec = F.ws + WS_ML + ((size_t)item * 2 + d) * MLREC;
                const int ti = d ? 63 - i : i, tj = d ? 63 - j : j;
                const float sv = (j <= i) ? QKM[ti * 65 + tj] * fexp(fminf(vec[i] + vec[192 + j] - vec[64 + i], 0.f)) : 0.f;
                ((GAS bf16*)(rec + ML_ST))[i * 64 + j] = bf1(sv);
                ((GAS bf16*)(rec + ML_Q))[i * 64 + j] = *(const LAS unsigned short*)(L + MQ_OFF + ti * MQROW + 2 * ((j & ~31) + sigma32(j & 31)));
                const float kv = bf2f(*(const LAS unsigned short*)(L + MK_OFF + tj * MQROW + 2 * i));
                ((GAS bf16*)(rec + ML_KWT))[i * 64 + j] = bf1(kv * vec[128 + j]);
            }
            for (int it = wave; it < 36; it += NWAVES) {
                const int d = it / 18, q = it - 18 * d, slice = q >> 1, s2 = q & 1;
                GAS unsigned char* rec = F.ws + WS_ML + ((size_t)item * 2 + d) * MLREC;
                const int fr = lane & 15, fq = lane >> 4;
                unsigned short e8[8];
#pragma unroll
                for (int el = 0; el < 8; ++el) { const int j = 32 * s2 + 8 * fq + el; const int tj = d ? 63 - j : j;
                    e8[el] = (slice < 8) ? *(const LAS unsigned short*)(L + MV_OFF + tj * QROW + 2 * (16 * slice + fr)) : (unsigned short)0x3F80; }
                u32x4 w; w.x = e8[0] | ((unsigned)e8[1] << 16); w.y = e8[2] | ((unsigned)e8[3] << 16); w.z = e8[4] | ((unsigned)e8[5] << 16); w.w = e8[6] | ((unsigned)e8[7] << 16);
                *(GAS u32x4*)(rec + ML_VF + (((slice * 2 + s2) * 64 + lane) * 8) * 2) = w;
            }
        }
        PREP_BAR();
        }
    }
}
constexpr int MLBUF = 25600;
__device__ __forceinline__ void ml_scan(const Frame& F) {
    if (F.wg >= 96) return;
    const int xcd = F.wg & 7, idx = F.wg >> 3;
    const int chain = xcd * 4 + idx / 3, third = idx % 3;
    const int b = chain >> 3, h = (chain >> 1) & 3, d = chain & 1;
    const int lane = F.lane, fr = lane & 15, fq = lane >> 4, wave = F.wave;
    LAS unsigned char* L = F.lds;
    const GAS unsigned char* recbase = F.ws + WS_ML;
    const int itembase = (b * NHEAD + h) * NCH;
    if (wave >= 3) {
        const int tl = F.tid - 192;
        u32x4 ra[5], rb[5]; int woff[5], goff[5];
#pragma unroll
        for (int i = 0; i < 5; ++i) { const int q = tl + 320 * i;
            if (q < 1536) { const int qq = q & 511; woff[i] = (q >> 9) * 8192 + swz128(qq >> 3, qq & 7); goff[i] = q; }
            else { woff[i] = 24576 + (q - 1536) * 16; goff[i] = 2688 + (q - 1536); } }
#define ML_LOAD(R, step_) do { const int st_ = (step_) < NCH ? (step_) : NCH - 1; const int n_ = d ? (NCH - 1 - st_) : st_; \
        const GAS u32x4* src_ = (const GAS u32x4*)(recbase + ((size_t)(itembase + n_) * 2 + d) * MLREC); \
        _Pragma("unroll") for (int i = 0; i < 5; ++i) R[i] = src_[goff[i]]; } while (0)
#define ML_WRITE(R, bufoff_) do { _Pragma("unroll") for (int i = 0; i < 5; ++i) *(LAS u32x4*)(L + (bufoff_) + woff[i]) = R[i]; } while (0)
        ML_LOAD(ra, 0); ML_LOAD(rb, 1);
        ML_WRITE(ra, 0);
        SCAN_BAR();
        for (int s = 0; s < NCH; s += 2) {
            ML_LOAD(ra, s + 2); ML_WRITE(rb, MLBUF); SCAN_BAR();
            ML_LOAD(rb, s + 3); ML_WRITE(ra, 0);     SCAN_BAR();
        }
#undef ML_LOAD
#undef ML_WRITE
        return;
    }
    const int slice = third * 3 + wave;
    const bool active = true;
    GAS bf16* NUM = (GAS bf16*)(F.ws + (d ? WS_NUMB : WS_NUMF)); GAS float* DEN = (GAS float*)(F.ws + WS_DEN);
    f32x4 C[4];
#pragma unroll
    for (int k = 0; k < 4; ++k) C[k] = (f32x4){0.f, 0.f, 0.f, 0.f};
    float m = 0.f;
    int offr[4];
#pragma unroll
    for (int t = 0; t < 4; ++t) offr[t] = ((16 * t + fr) >> 1) * 256;
    const int p128 = (fr & 1) << 3;
    bf16x8 vc0, vc1, vn0, vn1;
#define ML_VFETCH(A0, A1, step_) do { const int st_ = (step_) < NCH ? (step_) : NCH - 1; const int nn_ = d ? (NCH - 1 - st_) : st_; \
        const GAS bf16* Vf_ = (const GAS bf16*)(recbase + ((size_t)(itembase + nn_) * 2 + d) * MLREC + ML_VF); \
        A0 = *(const GAS bf16x8*)(Vf_ + ((slice * 2 + 0) * 64 + lane) * 8); A1 = *(const GAS bf16x8*)(Vf_ + ((slice * 2 + 1) * 64 + lane) * 8); } while (0)
    ML_VFETCH(vc0, vc1, 0); ML_VFETCH(vn0, vn1, 1);
    SCAN_BAR();
    for (int step = 0; step < NCH; ++step) {
        const int n = d ? (NCH - 1 - step) : step;
        const int bufoff = (step & 1) ? MLBUF : 0;
        bf16x8 VF[2]; VF[0] = vc0; VF[1] = vc1;
        vc0 = vn0; vc1 = vn1;
        ML_VFETCH(vn0, vn1, step + 2);
        if (active) {
        const LAS unsigned char* Bq = L + bufoff; const LAS unsigned char* Bs = Bq + 8192; const LAS unsigned char* Bk = Bq + 16384; const LAS float* row = (const LAS float*)(Bq + 24576);
        const float am = row[128], bl = row[129];
        bf16x8 CB[2];
#pragma unroll
        for (int s = 0; s < 2; ++s) CB[s] = pack_b(C[2 * s], C[2 * s + 1]);
        bf16x8 fq_[8], fs_[8], fk_[8];
#pragma unroll
        for (int s = 0; s < 2; ++s)
#pragma unroll
            for (int mt = 0; mt < 4; ++mt) { const int xr = (8 * mt + (fr >> 1)) & 15; const int o = offr[mt] + (((p128 | (4 * s + fq)) ^ xr) << 4);
                fq_[s * 4 + mt] = *(const LAS bf16x8*)(Bq + o); fs_[s * 4 + mt] = *(const LAS bf16x8*)(Bs + o); fk_[s * 4 + mt] = *(const LAS bf16x8*)(Bk + o); }
        f32x4 QC[4], SV[4], KV[4];
#pragma unroll
        for (int mt = 0; mt < 4; ++mt) { QC[mt] = (f32x4){0.f, 0.f, 0.f, 0.f}; SV[mt] = (f32x4){0.f, 0.f, 0.f, 0.f}; KV[mt] = (f32x4){0.f, 0.f, 0.f, 0.f}; }
#pragma unroll
        for (int s = 0; s < 2; ++s)
#pragma unroll
            for (int mt = 0; mt < 4; ++mt) {
                QC[mt] = __builtin_amdgcn_mfma_f32_16x16x32_bf16(CB[s], fq_[s * 4 + mt], QC[mt], 0, 0, 0);
                SV[mt] = __builtin_amdgcn_mfma_f32_16x16x32_bf16(VF[s], fs_[s * 4 + mt], SV[mt], 0, 0, 0);
                KV[mt] = __builtin_amdgcn_mfma_f32_16x16x32_bf16(fk_[s * 4 + mt], VF[s], KV[mt], 0, 0, 0);
            }
#pragma unroll
        for (int mt = 0; mt < 4; ++mt) {
            const int i = 16 * mt + fr; const int tok = b * SEQ + n * CH + (d ? 63 - i : i);
            const float bci = row[i], dmi = row[64 + i];
            const float il = bci + m, mo = fmaxf(il, dmi);
            const float inter = fexp(il - mo), e2 = fexp(dmi - mo);
            const f32x4 res = QC[mt] * inter + SV[mt] * e2;
            if (slice < 8) { u32x2 w2; w2.x = cvt_pk_bf16(res[0], res[1]); w2.y = cvt_pk_bf16(res[2], res[3]); *(GAS u32x2*)(NUM + (size_t)tok * MIXW + h * HD + slice * 16 + 4 * fq) = w2; }
            else if (fq == 0) DEN[(size_t)tok * 8 + h * 2 + d] = fmaxf(fabsf(res[0]), fexp(-mo));
        }
        const float mn = fmaxf(bl + m, am), sp = fexp(bl + m - mn), sc = fexp(am - mn);
#pragma unroll
        for (int kt = 0; kt < 4; ++kt) C[kt] = C[kt] * sp + KV[kt] * sc;
        m = mn;
        }
        SCAN_BAR();
    }
}

template <int H>
__device__ __forceinline__ void pool_block(const GAS bf16* U, GAS bf16* Y, int t0, int g, int lane) {
    constexpr int NR = 32 + 2 * H;
    const int sp0 = t0 & (SEQ - 1);
    float x0[NR], x1[NR];
#pragma unroll
    for (int r = 0; r < NR; ++r) {
        const int sp = sp0 - H + r; const bool ok = (sp >= 0 && sp < SEQ);
        const unsigned u = ok ? *(const GAS unsigned*)(U + (size_t)(t0 - H + r) * MIXW + 128 * g + 2 * lane) : 0u;
        x0[r] = bf2f(u & 0xffffu); x1[r] = bf2f(u >> 16);
    }
    float s0 = 0.f, s1 = 0.f;
#pragma unroll
    for (int r = 0; r < 2 * H; ++r) { s0 += x0[r]; s1 += x1[r]; }
#pragma unroll
    for (int t = 0; t < 32; ++t) {
        const int sp = sp0 + t; const int cnt = min(sp + H, SEQ) - max(sp - H, 0);
        const float inv = 1.0f / (float)cnt;
        *(GAS unsigned*)(Y + (size_t)(t0 + t) * MIXW + 128 * g + 2 * lane) = cvt_pk_bf16(s0 * inv - x0[t + H], s1 * inv - x1[t + H]);
        if (t < 31) { s0 += x0[t + 2 * H] - x0[t]; s1 += x1[t + 2 * H] - x1[t]; }
    }
}
__device__ __forceinline__ void pool_phase(const Frame& F) {
    const GAS bf16* U = (const GAS bf16*)(F.ws + WS_PPOOL); GAS bf16* Y = (GAS bf16*)(F.ws + WS_YP);
    const int gw = F.wg * NWAVES + F.wave, NGW = F.G * NWAVES, lane = F.lane;
    for (int prep = 0; prep < POOLREP; ++prep)
    for (int task = gw; task < (T / 32) * 4; task += NGW) {
        const int g = task & 3, t0 = (task >> 2) * 32;
        if (g == 0) pool_block<1>(U, Y, t0, g, lane); else if (g == 1) pool_block<2>(U, Y, t0, g, lane); else if (g == 2) pool_block<4>(U, Y, t0, g, lane); else pool_block<8>(U, Y, t0, g, lane);
    }
}

__device__ __forceinline__ void norm_phase(const Frame& F, int l, bool dummy, const int which, const int wg0, const int nwg) {
    const GAS bf16* OF = (const GAS bf16*)(F.ws + WS_OF); const GAS bf16* OB = (const GAS bf16*)(F.ws + WS_OB);
    const GAS bf16* NF = (const GAS bf16*)(F.ws + WS_NUMF); const GAS bf16* NBk = (const GAS bf16*)(F.ws + WS_NUMB); const GAS float* DEN = (const GAS float*)(F.ws + WS_DEN);
    GAS bf16* Z = (GAS bf16*)(F.ws + WS_PZ); GAS bf16* MO = (GAS bf16*)(F.ws + WS_PMO);
    GAS bf16* ZO = dummy ? (GAS bf16*)(F.ws + WS_GATE) : Z; GAS bf16* MOO = dummy ? (GAS bf16*)(F.ws + WS_GATE + 32 * MiB) : MO;
    const int gw = (F.wg - wg0) * NWAVES + F.wave, NGW = nwg * NWAVES, lane = F.lane, h = lane >> 4;
    float nw[8], mw[8];
#pragma unroll
    for (int e = 0; e < 8; ++e) { nw[e] = inp(F, I_DN_NORM)[l * MIXW + 8 * lane + e]; mw[e] = inp(F, I_ML_NORM)[l * MIXW + 8 * lane + e]; }
    for (int t = gw; t < T; t += NGW) {
        const size_t off = (size_t)t * MIXW + 8 * lane;
        if (which != 2) {
            float a[8], bq[8], z[8]; unpack8(*(const GAS u32x4*)(OF + off), a); unpack8(*(const GAS u32x4*)(OB + off), bq); unpack8(*(const GAS u32x4*)(Z + off), z);
            float ss = 0.f;
#pragma unroll
            for (int e = 0; e < 8; ++e) { a[e] += bq[e]; ss += a[e] * a[e]; }
            ss += __shfl_xor(ss, 1); ss += __shfl_xor(ss, 2); ss += __shfl_xor(ss, 4); ss += __shfl_xor(ss, 8);
            const float r = 1.0f / sqrtf(ss * (1.f / HD) + NORM_EPS);
            float o[8];
#pragma unroll
            for (int e = 0; e < 8; ++e) o[e] = a[e] * r * nw[e] * siluf_(z[e]);
            u32x4 w; w.x = cvt_pk_bf16(o[0], o[1]); w.y = cvt_pk_bf16(o[2], o[3]); w.z = cvt_pk_bf16(o[4], o[5]); w.w = cvt_pk_bf16(o[6], o[7]);
            *(GAS u32x4*)(ZO + off) = w;
        }
        if (which != 1) {
            float a[8], bq[8], g[8]; unpack8(*(const GAS u32x4*)(NF + off), a); unpack8(*(const GAS u32x4*)(NBk + off), bq); unpack8(*(const GAS u32x4*)(MO + off), g);
            const float df = 1.0f / DEN[(size_t)t * 8 + h * 2], db = 1.0f / DEN[(size_t)t * 8 + h * 2 + 1];
            float s = 0.f;
#pragma unroll
            for (int e = 0; e < 8; ++e) { a[e] = a[e] * df + bq[e] * db; s += a[e]; }
            s += __shfl_xor(s, 1); s += __shfl_xor(s, 2); s += __shfl_xor(s, 4); s += __shfl_xor(s, 8);
            const float mean = s * (1.f / HD); float ss = 0.f;
#pragma unroll
            for (int e = 0; e < 8; ++e) { a[e] -= mean; ss += a[e] * a[e]; }
            ss += __shfl_xor(ss, 1); ss += __shfl_xor(ss, 2); ss += __shfl_xor(ss, 4); ss += __shfl_xor(ss, 8);
            const float r = 1.0f / sqrtf(ss * (1.f / HD) + NORM_EPS);
            float o[8];
#pragma unroll
            for (int e = 0; e < 8; ++e) o[e] = a[e] * r * mw[e] * sigmoidf_(g[e]);
            u32x4 w; w.x = cvt_pk_bf16(o[0], o[1]); w.y = cvt_pk_bf16(o[2], o[3]); w.z = cvt_pk_bf16(o[4], o[5]); w.w = cvt_pk_bf16(o[6], o[7]);
            *(GAS u32x4*)(MOO + off) = w;
        }
    }
}

__device__ __forceinline__ void moe_tables(const Frame& F) {
    LAS int* cnt = (LAS int*)(F.lds + LHIST_OFF + 128); LAS int* pstart = (LAS int*)(F.lds + LHIST_OFF + 256); LAS int* mybase = (LAS int*)(F.lds + LHIST_OFF + 384);
    LAS int* pe = (LAS int*)(F.lds + LPE_OFF);
    const GAS int* hist = (const GAS int*)(F.ws + WS_HIST);
    if (F.tid < 32) { cnt[F.tid] = 0; mybase[F.tid] = 0; }
    __syncthreads();
    { const int e = F.tid & 31, part = F.tid >> 5; int tot = 0, base = 0;
      for (int q = 0; q < 16; ++q) { const int w = part * 16 + q; const int v = hist[w * 32 + e]; tot += v; base += v * min(max(F.wg - w, 0), 1); }
      __hip_atomic_fetch_add(cnt + e, tot, __ATOMIC_RELAXED, __HIP_MEMORY_SCOPE_WORKGROUP); __hip_atomic_fetch_add(mybase + e, base, __ATOMIC_RELAXED, __HIP_MEMORY_SCOPE_WORKGROUP); }
    __syncthreads();
    if (F.tid == 0) { int acc = 0, p = 0; for (int e = 0; e < NEXP; ++e) { pstart[e] = acc; const int np = (cnt[e] + 255) >> 8; for (int q = 0; q < np; ++q) pe[p++] = e; acc += np * 256; } pe[319] = p; }
    __syncthreads();
}
__device__ __forceinline__ void moe_dispatch(const Frame& F) {
    moe_tables(F);
    LAS int* pstart = (LAS int*)(F.lds + LHIST_OFF + 256); LAS int* mybase = (LAS int*)(F.lds + LHIST_OFF + 384);
    LAS int* lpos = (LAS int*)(F.lds);
    LAS int* le = (LAS int*)(F.lds + 1024);
    const GAS int* eid = (const GAS int*)(F.ws + WS_EID); const GAS float* ew = (const GAS float*)(F.ws + WS_EW);
    GAS int* pos = (GAS int*)(F.ws + WS_POS); GAS float* roww = (GAS float*)(F.ws + WS_ROWW);
    const int rows_per_wg = T / F.G, row0 = F.wg * rows_per_wg;
    int my_e = 0; float my_w = 0.f;
    if (F.tid < 256) { my_e = eid[2 * row0 + F.tid]; my_w = ew[2 * row0 + F.tid]; le[F.tid] = my_e; }
    __syncthreads();
    if (F.tid < 256) {
        int rank = 0;
        for (int a = 0; a < F.tid; ++a) rank += (le[a] == my_e) ? 1 : 0;
        const int p = pstart[my_e] + mybase[my_e] + rank;
        lpos[F.tid] = p; pos[2 * row0 + F.tid] = p; roww[p] = my_w; ((GAS int*)(F.ws + WS_ROWTOK))[p] = row0 + (F.tid >> 1);
    }
    __syncthreads();
    if (F.wg == 0 && F.tid < 32) { LAS int* cnt = (LAS int*)(F.lds + LHIST_OFF + 128); const int e = F.tid; const int c0 = cnt[e], pc = (c0 + 255) & ~255;
        GAS int* rt = (GAS int*)(F.ws + WS_ROWTOK); for (int q = c0; q < pc; ++q) rt[pstart[e] + q] = 0; }
    __syncthreads();
}

constexpr int NPHASE = 1 + 15 * DEPTH;
#ifndef PHM
#define PHM 0xFFFF
#endif
#define PHON(b) ((PHM >> (b)) & 1)
#ifndef REPEAT_PHASE
#define REPEAT_PHASE -1
#endif
#define NREP(k) (((k) == REPEAT_PHASE) ? 2 : 1)
__global__ void __launch_bounds__(NWAVES * 64, 2) mega_fwd(Args args) {
    extern __shared__ __attribute__((aligned(16))) unsigned char lds_raw[];
    LAS unsigned char* lds = (LAS unsigned char*)lds_raw;
    const int wave = __builtin_amdgcn_readfirstlane((int)threadIdx.x >> 6);
    for (int u = threadIdx.x; u < (LDS_BYTES - RING_BYTES) / 4; u += NWAVES * 64) ((LAS unsigned*)(lds + RING_BYTES))[u] = 0u;
    __syncthreads();
    if (threadIdx.x == 0) { LAS unsigned long long* ap = (LAS unsigned long long*)(lds + LARG_OFF);
#pragma unroll
        for (int i = 0; i < 23; ++i) ap[i] = (unsigned long long)args.in[i];
        ap[23] = (unsigned long long)args.out; ap[24] = (unsigned long long)args.ws; }
    __syncthreads();
    const int lo = args.ph_lo, hi = args.ph_hi;
    if (hi - lo > 1) { const XcdBarrier b0 = xcd_barrier_post((unsigned*)(args.ws + WS_CTL) + CW_BAR, (volatile LAS unsigned*)(lds + MISC_OFF) + 8);
        if (threadIdx.x == 0) ((volatile LAS unsigned*)(lds + MISC_OFF))[10] = b0.x; }
    __syncthreads();
#ifdef DIAG
    if (threadIdx.x == 0 && blockIdx.x == 0 && lo == 0) ((unsigned long long*)(args.ws + WS_CTL + 1024))[0] = __builtin_amdgcn_s_memrealtime();
#endif
    int ph = lo, rep = 0;
#pragma unroll 1
    while (ph < hi) {
        const Frame F = fresh(lds, wave);
        const bool DRY = (REPEAT_PHASE >= 0) && (rep == 0) && (((ph >= 1) ? ((ph - 1) % 15) : 15) == REPEAT_PHASE);
        const int l = (ph >= 1) ? (ph - 1) / 15 : 0;
        const int k = (ph >= 1) ? (ph - 1) - 15 * l : 15;
        if (PHON(15) && k == 15) {
            wprep_mixer(F, 0);
            __syncthreads();
            ln_phase<0>(F, inp(F, I_LN_IN_G), inp(F, I_LN_IN_B), inp(F, I_W_IN), DIN, true, true, DRY);
        } else if (PHON(0) && k == 0) {
            pg8::StaticOrder S; S.init(F.ws + WS_HB, F.ws + WS_WIN, T, 1536, D, F.G, F.wg);
            EpiG1a E{(GAS bf16*)(F.ws + WS_PQKV)};
            pg8::gemm_phase<EpiG1a, pg8::StaticOrder>(F.lds, F.tid, D, S, E);
        } else if (PHON(1) && k == 1) { dn_prep(F, l);
        } else if (PHON(2) && k == 2) { if (F.wg < 128) dn_scan(F); else wprep_moe(F, l, 128, 128);
        } else if (PHON(3) && k == 3) {
            pg8::StaticOrder S; S.init(F.ws + WS_HB, F.ws + WS_WIN + (size_t)1536 * D * 2, T, 2560, D, F.G, F.wg);
            EpiG1b E{F.ws};
            pg8::gemm_phase<EpiG1b, pg8::StaticOrder>(F.lds, F.tid, D, S, E);
        } else if (PHON(4) && k == 4) { pool_phase(F); ml_prep(F, l);
        } else if (PHON(5) && k == 5) { if (F.wg < 96) ml_scan(F); else norm_phase(F, l, false, 1, 96, 160);
        } else if (PHON(6) && k == 6) { norm_phase(F, l, DRY, 2, 0, 256);
        } else if (PHON(7) && k == 7) {
            pg8::StaticOrder S; S.init(F.ws + WS_HB, F.ws + WS_WGATE, T, 3072, D, F.G, F.wg);
            EpiGate E{(GAS bf16*)(F.ws + WS_GATE)};
            pg8::gemm_phase<EpiGate, pg8::StaticOrder>(F.lds, F.tid, D, S, E);
        } else if (PHON(8) && k == 8) {
            MergeOrder S; S.Y[0] = (const GAS char*)(F.ws + WS_PZ); S.Y[1] = (const GAS char*)(F.ws + WS_YP); S.Y[2] = (const GAS char*)(F.ws + WS_PMO); S.W = (const GAS char*)(F.ws + WS_WBR); S.G = F.G; S.c = F.wg;
            EpiMerge E{(const GAS bf16*)(F.ws + WS_GATE), (GAS bf16*)(F.ws + WS_MRGP), (GAS bf16*)(F.ws + WS_FIN)};
            pg8::gemm_phase<EpiMerge, MergeOrder>(F.lds, F.tid, MIXW, S, E);
        } else if (PHON(9) && k == 9) {
            pg8::StaticOrder S; S.init(F.ws + WS_FIN, F.ws + WS_WOUT, T, D, D, F.G, F.wg);
            EpiOut E{(const GAS bf16*)(F.ws + WS_HB), DRY ? (GAS bf16*)(F.ws + WS_R2) : (GAS bf16*)F.out};
            pg8::gemm_phase<EpiOut, pg8::StaticOrder>(F.lds, F.tid, D, S, E);
        } else if (PHON(10) && k == 10) {
            ln_phase<1>(F, inp(F, I_LN_MIX_G) + l * D, inp(F, I_LN_MIX_B) + l * D, inp(F, I_ROUTER_W), 32, true, true, DRY);
        } else if (PHON(11) && k == 11) { moe_dispatch(F);
        } else if (PHON(12) && k == 12) {
            moe_tables(F);
            MoeOrder<D, true> S; S.rowtok = (const GAS int*)(F.ws + WS_ROWTOK); S.A = (const GAS char*)(F.ws + WS_HB); S.W = (const GAS char*)((GAS unsigned char*)F.out + 64 * MiB); S.pe = (const LAS int*)(F.lds + LPE_OFF); S.c = F.wg; S.NP = __builtin_amdgcn_readfirstlane(S.pe[319]);
            EpiMoe1 E{(GAS bf16*)(F.ws + WS_ACT)};
            pg8::gemm_phase<EpiMoe1, MoeOrder<D, true>>(F.lds, F.tid, D, S, E);
        } else if (PHON(13) && k == 13) {
            moe_tables(F);
            MoeOrder<DEXP, false> S; S.rowtok = nullptr; S.A = (const GAS char*)(F.ws + WS_ACT); S.W = (const GAS char*)(F.ws + WS_W2); S.pe = (const LAS int*)(F.lds + LPE_OFF); S.c = F.wg; S.NP = __builtin_amdgcn_readfirstlane(S.pe[319]);
            EpiMoe2 E{(GAS bf16*)(F.ws + WS_YROWS), (const GAS float*)(F.ws + WS_ROWW)};
            pg8::gemm_phase<EpiMoe2, MoeOrder<DEXP, false>>(F.lds, F.tid, DEXP, S, E);
        } else if (PHON(14)) {
            const bool last = (l == DEPTH - 1);
            if (!last) { wprep_mixer(F, l + 1); __syncthreads(); }
            ln_phase<2>(F, inp(F, I_LN_FFN_G) + l * D, inp(F, I_LN_FFN_B) + l * D, inp(F, I_W_IN) + (size_t)(last ? l : l + 1) * D * DIN, DIN, !last, !last, DRY);
        }
        const bool again = (k == REPEAT_PHASE) && (rep == 0);
        if (again) rep = 1; else { rep = 0; ++ph; }
        if (ph < hi) { XcdBarrier bar; bar.bar = (unsigned*)(unsigned char*)(F.ws + WS_CTL) + CW_BAR; bar.st = (volatile LAS unsigned*)(F.lds + MISC_OFF) + 8; bar.x = __builtin_amdgcn_readfirstlane(bar.st[2]); xcd_barrier(bar, F.tid); }
#ifdef DIAG
        if (!again && F.tid == 0 && F.wg == 0) ((unsigned long long*)(F.ws + WS_CTL + 1024))[ph] = __builtin_amdgcn_s_memrealtime();
#endif
    }
}

#ifndef N_LAUNCH_MODE
#define N_LAUNCH_MODE 1
#endif
extern "C" void kernel_launch(void* const* d_in, const int* in_sizes, int n_in, void* d_out, int out_size, void* d_ws, size_t ws_size, hipStream_t stream) {
    static int grid = 0;
    if (grid == 0) {
        if (n_in != 23 || out_size != T * D || ws_size < WS_END) { fprintf(stderr, "kernel_launch: unexpected shapes (n_in %d out %d ws %zu)\n", n_in, out_size, ws_size); grid = -1; return; }
        int dev = 0, cus = 0, per_cu = 0;
        if (hipGetDevice(&dev) != hipSuccess || hipDeviceGetAttribute(&cus, hipDeviceAttributeMultiprocessorCount, dev) != hipSuccess) { grid = -1; return; }
        if (hipFuncSetAttribute((const void*)mega_fwd, hipFuncAttributeMaxDynamicSharedMemorySize, LDS_BYTES) != hipSuccess) { fprintf(stderr, "kernel_launch: hipFuncSetAttribute failed\n"); grid = -1; return; }
        (void)hipOccupancyMaxActiveBlocksPerMultiprocessor(&per_cu, (const void*)mega_fwd, NWAVES * 64, LDS_BYTES);
        (void)hipGetLastError();
        grid = cus;
        if (grid != 256) { fprintf(stderr, "kernel_launch: built for 256 CUs, got %d\n", cus); grid = -1; return; }
    }
    if (grid < 0) return;
    (void)hipMemsetAsync((char*)d_ws + WS_CTL, 0, CTL_ZERO_BYTES, stream);
    Args a{};
    for (int i = 0; i < 23; ++i) a.in[i] = (const float*)d_in[i];
    a.out = (float*)d_out; a.ws = (unsigned char*)d_ws;
#if defined(DIAG) && DIAG >= 100
    {
        a.ph_lo = 0; a.ph_hi = NPHASE;
        hipLaunchKernelGGL(mega_fwd, dim3(grid), dim3(NWAVES * 64), LDS_BYTES, stream, a);
        hipLaunchKernelGGL(diag_fill_t, dim3(1024), dim3(256), 0, stream, (float*)d_out, (unsigned char*)d_ws, out_size, (int)(DIAG - 100));
    }
#elif defined(DIAG)
    {
        const int his[12] = {0, 2, 3, 6, 15, 10, 6, 9, 2, 2, 5, 9};
        const int grids[12] = {0, 64, 2, 2, 16, 64, 64, 64, 64, 64, 64, 64}, blocks[12] = {0, 256, 128, 128, 256, 256, 256, 256, 256, 256, 256, 256};
        a.ph_lo = 0; a.ph_hi = his[DIAG];
        hipLaunchKernelGGL(mega_fwd, dim3(grid), dim3(NWAVES * 64), LDS_BYTES, stream, a);
        static int once = 0; if (!once) { once = 1; (void)hipFuncSetAttribute((const void*)diag_kernel, hipFuncAttributeMaxDynamicSharedMemorySize, 81920); }
        DArgs da{}; for (int i = 0; i < 23; ++i) da.in[i] = (const float*)d_in[i]; da.out = (float*)d_out; da.ws = (unsigned char*)d_ws; da.mode = DIAG; da.pad = 0;
        hipLaunchKernelGGL(diag_kernel, dim3(grids[DIAG]), dim3(blocks[DIAG]), 81920, stream, da);
        if (DIAG == 2 || DIAG == 3) {
            a.ph_lo = his[DIAG]; a.ph_hi = his[DIAG] + 1;
            hipLaunchKernelGGL(mega_fwd, dim3(grid), dim3(NWAVES * 64), LDS_BYTES, stream, a);
            da.mode = DIAG + 10;
            hipLaunchKernelGGL(diag_kernel, dim3(2), dim3(128), 81920, stream, da);
        }
        hipLaunchKernelGGL(diag_fill, dim3(1024), dim3(256), 0, stream, (float*)d_out, (unsigned char*)d_ws, out_size);
    }
#elif N_LAUNCH_MODE == 1
    a.ph_lo = 0; a.ph_hi = NPHASE;
    hipLaunchKernelGGL(mega_fwd, dim3(grid), dim3(NWAVES * 64), LDS_BYTES, stream, a);
#else
    for (int p = 0; p < NPHASE; ++p) { a.ph_lo = p; a.ph_hi = p + 1; hipLaunchKernelGGL(mega_fwd, dim3(grid), dim3(NWAVES * 64), LDS_BYTES, stream, a); }
#endif
}
```

```cpp
#include <hip/hip_runtime.h>
#include <cstdio>
#include <cstdint>

#define LAS __attribute__((address_space(3)))
#define GAS __attribute__((address_space(1)))
typedef unsigned short bf16;
typedef short bf16x8 __attribute__((ext_vector_type(8)));
typedef float f32x4 __attribute__((ext_vector_type(4)));
typedef float f32x2 __attribute__((ext_vector_type(2)));
typedef unsigned u32x4 __attribute__((ext_vector_type(4)));
typedef unsigned u32x2 __attribute__((ext_vector_type(2)));
#define RLX_AGENT __ATOMIC_RELAXED, __HIP_MEMORY_SCOPE_AGENT
#define LDS_WAIT() asm volatile("s_waitcnt lgkmcnt(0)" ::: "memory")
#define VM_WAIT() asm volatile("s_waitcnt vmcnt(0)" ::: "memory")

constexpr int NB = 4, SEQ = 8192, T = NB * SEQ, D = 1024, DEPTH = 2;
constexpr int DIN = 7200;
constexpr int MIXW = 512, NHEAD = 4, HD = 128, CH = 64, NCH = SEQ / CH;
constexpr int MLQK = 64;
constexpr int NEXP = 32, DEXP = 512;
constexpr float LN_EPS = 1e-5f, NORM_EPS = 1e-6f;
constexpr float ALPHA = 1.41421356237309515f;
constexpr int NWAVES = 8;
constexpr int NREC = NB * NHEAD * NCH * 2;

constexpr int C_QKV = 0, C_Z = 1536, C_A = 2048, C_B = 2056, C_POOL = 2064, C_MQ = 2576, C_MK = 2832, C_MV = 3088, C_MO = 3600, C_I = 4112, C_F = 4120, C_GATE = 4128;

constexpr size_t MiB = 1u << 20;
constexpr size_t WS_CTL = 0, CTL_ZERO_BYTES = 64 * 1024;
constexpr int CW_BAR = 4096;
constexpr size_t WS_HIST = 1 * MiB;
constexpr size_t WS_EID = WS_HIST + 64 * 1024;
constexpr size_t WS_EW = WS_EID + 256 * 1024;
constexpr size_t WS_POS = WS_EW + 256 * 1024;
constexpr size_t WS_ROWW = WS_POS + 256 * 1024;
constexpr size_t WS_GL = WS_ROWW + 512 * 1024;
constexpr size_t WS_ROWTOK = 3 * MiB;
constexpr size_t WS_WIN = 4 * MiB;
constexpr size_t WS_WGATE = 12 * MiB;
constexpr size_t WS_WBR = 18 * MiB;
constexpr size_t WS_WOUT = 21 * MiB;
constexpr size_t WS_HB = 24 * MiB;
constexpr size_t WS_SG = 88 * MiB;
constexpr size_t WS_DEN = 92 * MiB;
constexpr size_t WS_R1 = 93 * MiB;
constexpr size_t WS_PQKV = WS_R1;
constexpr size_t WS_OF = WS_R1, WS_OB = WS_R1 + 32 * MiB;
constexpr size_t WS_MRGP = WS_R1;
constexpr size_t WS_W13 = WS_R1, WS_W2 = WS_R1 + 64 * MiB;
constexpr size_t WS_R2 = 189 * MiB;
constexpr size_t DNREC = 73728;
constexpr size_t DN_W = 0, DN_QG = 16384, DN_KDT = 32768, DN_ATT = 49152, DN_UF = 57344;
constexpr size_t WS_PZ = 189 * MiB, WS_PPOOL = 221 * MiB, WS_PMQ = 253 * MiB, WS_PMK = 269 * MiB, WS_PMV = 285 * MiB, WS_PMO = 317 * MiB;
constexpr size_t WS_YP = 349 * MiB;
constexpr size_t WS_NUMF = 253 * MiB, WS_NUMB = 285 * MiB;
constexpr size_t WS_FIN = 253 * MiB;
constexpr size_t WS_ML = 381 * MiB;
constexpr size_t MLREC = 44032;
constexpr size_t ML_Q = 0, ML_ST = 8192, ML_KWT = 16384, ML_VF = 24576, ML_ROW = 43008;
constexpr size_t WS_GATE = 381 * MiB;
constexpr size_t WS_XS = 189 * MiB, WS_ACT = 333 * MiB, WS_YROWS = 405 * MiB;
constexpr size_t WS_END = 573 * MiB;
constexpr int MOE_ROWS = 73728;
static_assert(WS_ML + (size_t)NREC * MLREC <= WS_END + 15 * MiB, "ml records");
static_assert(WS_YROWS + (size_t)MOE_ROWS * 1024 * 2 <= WS_END, "moe rows");

constexpr int RING_BYTES = 131072;
constexpr int MISC_OFF = RING_BYTES + 320;
constexpr int LHIST_OFF = RING_BYTES + 1024;
constexpr int LPE_OFF = RING_BYTES + 2048;
constexpr int LARG_OFF = RING_BYTES + 4096;
constexpr int LDS_BYTES = 147456;

__device__ __forceinline__ float bf2f(unsigned b) { return __uint_as_float(b << 16); }
__device__ __forceinline__ unsigned f2bf(float f) { unsigned u = __float_as_uint(f); return (u + 0x7fffu + ((u >> 16) & 1u)) >> 16; }
__device__ __forceinline__ unsigned pk2(float lo, float hi) { return f2bf(lo) | (f2bf(hi) << 16); }
__device__ __forceinline__ float wave_sum(float v) {
    v += __int_as_float(__builtin_amdgcn_update_dpp(0, __float_as_int(v), 0xB1, 0xf, 0xf, true));
    v += __int_as_float(__builtin_amdgcn_update_dpp(0, __float_as_int(v), 0x4E, 0xf, 0xf, true));
    v += __int_as_float(__builtin_amdgcn_update_dpp(0, __float_as_int(v), 0x141, 0xf, 0xf, true));
    v += __int_as_float(__builtin_amdgcn_update_dpp(0, __float_as_int(v), 0x140, 0xf, 0xf, true));
    const int iv = __float_as_int(v);
    return (__int_as_float(__builtin_amdgcn_readlane(iv, 0)) + __int_as_float(__builtin_amdgcn_readlane(iv, 16))) + (__int_as_float(__builtin_amdgcn_readlane(iv, 32)) + __int_as_float(__builtin_amdgcn_readlane(iv, 48)));
}
__device__ __forceinline__ float wave_max(float v) {
    v = fmaxf(v, __int_as_float(__builtin_amdgcn_update_dpp(0, __float_as_int(v), 0xB1, 0xf, 0xf, true)));
    v = fmaxf(v, __int_as_float(__builtin_amdgcn_update_dpp(0, __float_as_int(v), 0x4E, 0xf, 0xf, true)));
    v = fmaxf(v, __int_as_float(__builtin_amdgcn_update_dpp(0, __float_as_int(v), 0x141, 0xf, 0xf, true)));
    v = fmaxf(v, __int_as_float(__builtin_amdgcn_update_dpp(0, __float_as_int(v), 0x140, 0xf, 0xf, true)));
    const int iv = __float_as_int(v);
    return fmaxf(fmaxf(__int_as_float(__builtin_amdgcn_readlane(iv, 0)), __int_as_float(__builtin_amdgcn_readlane(iv, 16))), fmaxf(__int_as_float(__builtin_amdgcn_readlane(iv, 32)), __int_as_float(__builtin_amdgcn_readlane(iv, 48))));
}
__device__ __forceinline__ float fexp(float x) { return __builtin_amdgcn_exp2f(x * 1.44269504089f); }
__device__ __forceinline__ float sigmoidf_(float x) { return 1.0f / (1.0f + expf(-x)); }
__device__ __forceinline__ float siluf_(float x) { return x / (1.0f + expf(-x)); }
__device__ __forceinline__ float softplusf_(float x) { return fmaxf(x, 0.f) + log1pf(expf(-fabsf(x))); }
__device__ __forceinline__ float logsigmoidf_(float x) { return fminf(x, 0.f) - log1pf(expf(-fabsf(x))); }
__host__ __device__ __forceinline__ int sigma32(int p) { const int fq = p >> 3, j = p & 7; return 16 * (j >> 2) + 4 * fq + (j & 3); }

#define XB_TMO      128
#define XB_XCNT(j)  (256  + 64 * (j))
#define XB_XSUB(j)  (1280 + 64 * (j))
#define XB_XGEN(j)  (2304 + 64 * (j))
#define XB_TOP      3328
#define XB_TOPGEN   3392
#define XCD_BAR_WORDS 3456
#define XB_SPIN_CAP (1u << 20)
__device__ __forceinline__ unsigned xb_ld(unsigned* p)              { return __hip_atomic_load(p, __ATOMIC_RELAXED, __HIP_MEMORY_SCOPE_AGENT); }
__device__ __forceinline__ unsigned xb_add(unsigned* p, unsigned v) { return __hip_atomic_fetch_add(p, v, __ATOMIC_RELAXED, __HIP_MEMORY_SCOPE_AGENT); }
__device__ __forceinline__ unsigned xb_xcc_id() { return (unsigned)__builtin_amdgcn_s_getreg((3 << 11) | 20) & 0xFu; }
#define XB_SPIN(cond, bar) do { unsigned _sp = 0; while (cond) { __builtin_amdgcn_s_sleep(1); \
    if ((++_sp & 255u) == 0u) { if (xb_ld(&(bar)[XB_TMO])) break; if (_sp > XB_SPIN_CAP) { atomicAdd(&(bar)[XB_TMO], 1u); break; } } } } while (0)
struct XcdBarrier { unsigned* bar; unsigned x; volatile LAS unsigned* st; };
__device__ __forceinline__ XcdBarrier xcd_barrier_post(unsigned* bar, volatile LAS unsigned* st) {
    XcdBarrier b; b.bar = bar; b.x = xb_xcc_id(); b.st = st;
    if (threadIdx.x == 0) (void)xb_add(&bar[XB_XCNT(b.x)], 1u);
    return b;
}
__device__ __forceinline__ void xcd_barrier_complete(unsigned* bar, unsigned x, unsigned& nloc, unsigned& nx) {
    const unsigned G = 256u;
    unsigned sum, cnt, mine, sp = 0u;
    for (;;) {
        sum = 0u; cnt = 0u; mine = 0u;
#pragma unroll
        for (unsigned j = 0; j < 16; ++j) { const unsigned c = xb_ld(&bar[XB_XCNT(j)]); sum += c; cnt += (c > 0u) ? 1u : 0u; mine = (j == x) ? c : mine; }
        if (sum == G) break;
        __builtin_amdgcn_s_sleep(1);
        if ((++sp & 255u) == 0u) { if (xb_ld(&bar[XB_TMO])) break; if (sp > XB_SPIN_CAP) { atomicAdd(&bar[XB_TMO], 1u); break; } }
    }
    nloc = mine > 0u ? mine : 1u; nx = cnt > 0u ? cnt : 1u;
}
__device__ __forceinline__ void xcd_barrier(const XcdBarrier& b, const int tid) {
    asm volatile("s_waitcnt vmcnt(0)" ::: "memory");
    __syncthreads();
    if (tid == 0) {
        unsigned* bar = b.bar;
        __builtin_amdgcn_s_waitcnt(0);
        unsigned nloc = b.st[0], nx = b.st[1];
        if (nloc == 0u) { xcd_barrier_complete(bar, b.x, nloc, nx); b.st[0] = nloc; b.st[1] = nx; }
        const unsigned old = xb_add(&bar[XB_XSUB(b.x)], 1u);
        const unsigned gen = old / nloc;
        if (old + 1u == (gen + 1u) * nloc) {
            __builtin_amdgcn_fence(__ATOMIC_RELEASE, "agent");
            asm volatile("s_waitcnt vmcnt(0)" ::: "memory");
            const unsigned og = xb_add(&bar[XB_TOP], 1u);
            const unsigned tg = og / nx;
            if (og + 1u == (tg + 1u) * nx) xb_add(&bar[XB_TOPGEN], 1u);
            else XB_SPIN(xb_ld(&bar[XB_TOPGEN]) == tg, bar);
            __builtin_amdgcn_fence(__ATOMIC_ACQUIRE, "agent");
            xb_add(&bar[XB_XGEN(b.x)], 1u);
            asm volatile("s_waitcnt vmcnt(0)" ::: "memory");
        } else {
            XB_SPIN(xb_ld(&bar[XB_XGEN(b.x)]) == gen, bar);
            __builtin_amdgcn_fence(__ATOMIC_ACQUIRE, "agent");
            asm volatile("s_waitcnt vmcnt(0)" ::: "memory");
        }
    }
    __syncthreads();
}

namespace pg8 {
constexpr int BM = 256, BK = 64, HALF = 128, HTB = HALF * BK * 2, STAGE_BYTES = 8 * HTB, NXCD = 8, WGM = 8;
__host__ __device__ __forceinline__ int lds_byte(int r, int c) { const int st = (r >> 4) * 2 + (c >> 5), rr = r & 15, cc = c & 31, ob = rr * 64 + cc * 2; return st * 1024 + (ob ^ (((ob >> 9) & 1) << 5)); }
__host__ __device__ __forceinline__ void stage_rc(int b, int& R, int& C) { const int st = b / 1024, sb = b % 1024, swz = sb ^ (((sb >> 9) & 1) << 5); R = (st >> 1) * 16 + swz / 64; C = (st & 1) * 32 + (swz % 64) / 2; }
__host__ __device__ __forceinline__ int perm32(int rho) { const int n = rho >> 4, i = rho & 15; return 8 * (i >> 2) + 4 * n + (i & 3); }

struct Unit { int pm, pn, aux; const GAS char* A; const GAS char* B; };

__device__ __forceinline__ void tile_of(int L, int nM, int nN, int& pm, int& pn) {
    const int nwg = nM * nN; int wgid = L;
    { const int q = nwg / NXCD, r = nwg % NXCD, xcd = wgid % NXCD, off = wgid / NXCD; wgid = (xcd < r ? xcd * (q + 1) : r * (q + 1) + (xcd - r) * q) + off; }
    const int nig = WGM * nN, gid = wgid / nig, fm = gid * WGM, gsz = (nM - fm) < WGM ? (nM - fm) : WGM;
    pm = fm + ((wgid % nig) % gsz); pn = (wgid % nig) / gsz;
}
struct StaticOrder {
    static constexpr bool GATHER = false;
    const GAS char* A; const GAS char* Bt; int nM, nN, nwg, G, c; size_t tstep;
    __device__ __forceinline__ void init(const GAS void* A_, const GAS void* Bt_, int M, int N, int K, int G_, int c_) { A = (const GAS char*)A_; Bt = (const GAS char*)Bt_; nM = M / BM; nN = N / BM; nwg = nM * nN; G = G_; c = c_; tstep = (size_t)BM * K * 2; }
    __device__ __forceinline__ bool next(int i, Unit& u) const {
        const long L = (long)i * G + c; if (L >= nwg) return false;
        tile_of((int)L, nM, nN, u.pm, u.pn); u.aux = 0; u.A = A + (size_t)u.pm * tstep; u.B = Bt + (size_t)u.pn * tstep; return true;
    }
};

typedef float f32x2_t __attribute__((ext_vector_type(2))); typedef __bf16 bf16x2_t __attribute__((ext_vector_type(2)));
__device__ __forceinline__ unsigned cvt_pk_bf16(float lo, float hi) { f32x2_t v = {lo, hi}; bf16x2_t b = __builtin_convertvector(v, bf16x2_t); return __builtin_bit_cast(unsigned, b); }

__device__ __forceinline__ bf16 bf1(float x) { return (bf16)(cvt_pk_bf16(x, x) & 0xffffu); }
template <class Epi, class Sched, bool ALIGN_EPI = true, bool SP2 = true>
__device__ __forceinline__ void gemm_phase(LAS unsigned char* lds, const int tid, const int K, const Sched& S, const Epi& E) {
    const int wid = __builtin_amdgcn_readfirstlane(tid >> 6), lane = tid & 63, wr = wid >> 2, wc = wid & 3, fr = lane & 15, fq = lane >> 4;
    const int nt = K / BK;
    unsigned voffA, voffB;
    { int R, C; stage_rc(tid * 16, R, C); const int Rb = Epi::PERM ? ((R & ~31) + perm32(R & 31)) : R;
        voffA = (unsigned)(R * K + C) * 2u; voffB = (unsigned)(Rb * K + C) * 2u; }
    const size_t pstep = (size_t)64 * K * 2;
    const size_t kstep = (size_t)(BK * 2);
    const size_t hstep = (size_t)HALF * K * 2;
    const unsigned ldsw = (unsigned)wid * 1024u;
    const int aoff = lds_byte(wr * 64 + fr, fq * 8), boff = lds_byte(wc * 32 + fr, fq * 8);
#define PG8_SA(b, h) (((b) * 2 + (h)) * HTB)
#define PG8_SB(b, h) ((4 + (b) * 2 + (h)) * HTB)
#define PG8_STAGE(bufoff, gbase, voff) do { _Pragma("unroll") for (int _i = 0; _i < 2; ++_i) \
        __builtin_amdgcn_global_load_lds((const GAS unsigned*)((const GAS char*)(gbase) + _i * pstep + (voff)), (LAS unsigned*)(lds + (bufoff) + ldsw + _i * 8192), 16, 0, 0); } while (0)
#define PG8_STAGE_A(bufoff, kbase, h_, useNext) do { if constexpr (GATHER) { _Pragma("unroll") for (int _i = 0; _i < 2; ++_i) { const unsigned _o = (useNext) ? gaN[h_][_i] : gaC[h_][_i]; \
        __builtin_amdgcn_global_load_lds((const GAS unsigned*)((const GAS char*)(kbase) + _o), (LAS unsigned*)(lds + (bufoff) + ldsw + _i * 8192), 16, 0, 0); } } \
        else { PG8_STAGE(bufoff, (kbase) + (h_) * hstep, voffA); } } while (0)
#define PG8_LDA(dst, b, h) do { _Pragma("unroll") for (int m = 0; m < 4; ++m) _Pragma("unroll") for (int k = 0; k < 2; ++k) dst[m][k] = *(const LAS bf16x8*)(lds + PG8_SA(b, h) + aoff + m * 2048 + k * 1024); } while (0)
#define PG8_LDB(dst, b, h) do { _Pragma("unroll") for (int n = 0; n < 2; ++n) _Pragma("unroll") for (int k = 0; k < 2; ++k) dst[n][k] = *(const LAS bf16x8*)(lds + PG8_SB(b, h) + boff + n * 2048 + k * 1024); } while (0)
#define PG8_MMA(ai, bj, At, Bt) do { __builtin_amdgcn_s_setprio(1); _Pragma("unroll") for (int m = 0; m < 4; ++m) _Pragma("unroll") for (int n = 0; n < 2; ++n) _Pragma("unroll") for (int k = 0; k < 2; ++k) \
        acc[ai][bj][m][n] = __builtin_amdgcn_mfma_f32_16x16x32_bf16(Bt[n][k], At[m][k], acc[ai][bj][m][n], 0, 0, 0); __builtin_amdgcn_s_setprio(0); } while (0)
#define PG8_WAIT_V(n) asm volatile("s_waitcnt vmcnt(" #n ")" ::: "memory")
#define PG8_WAIT_L(n) asm volatile("s_waitcnt lgkmcnt(" #n ")" ::: "memory")
#define PG8_BAR __builtin_amdgcn_s_barrier()
#define PG8_SCHED __builtin_amdgcn_sched_barrier(0)
    Unit cur, nxt; int ui = 0;
    if (!S.next(0, cur)) return;
    constexpr bool GATHER = Sched::GATHER;
    unsigned gaC[2][2], gaN[2][2];
    int gR = 0, gC = 0; if constexpr (GATHER) { stage_rc(tid * 16, gR, gC); }
#define PG8_GATHER_OFFS(dst, u_) do { if constexpr (GATHER) { _Pragma("unroll") for (int h_ = 0; h_ < 2; ++h_) _Pragma("unroll") for (int i_ = 0; i_ < 2; ++i_) \
        dst[h_][i_] = (unsigned)S.rowtok[(u_).pm * 256 + 128 * h_ + 64 * i_ + gR] * (unsigned)(K * 2) + (unsigned)(gC * 2); } } while (0)
    PG8_GATHER_OFFS(gaC, cur);
#pragma unroll
    for (int h_ = 0; h_ < 2; ++h_)
#pragma unroll
        for (int i_ = 0; i_ < 2; ++i_) gaN[h_][i_] = gaC[h_][i_];
    f32x4 acc[2][2][4][2];
#pragma unroll
    for (int a = 0; a < 2; ++a)
#pragma unroll
        for (int b = 0; b < 2; ++b)
#pragma unroll
            for (int m = 0; m < 4; ++m)
#pragma unroll
                for (int n = 0; n < 2; ++n) acc[a][b][m][n] = (f32x4){0.f, 0.f, 0.f, 0.f};
    bf16x8 At[4][2], B0[2][2], B1[2][2];
    const GAS char* cA = cur.A; const GAS char* cB = cur.B;
    if constexpr (SP2) {
        PG8_STAGE(PG8_SB(0, 0), cB, voffB); PG8_STAGE(PG8_SB(0, 1), cB + hstep, voffB); PG8_STAGE_A(PG8_SA(0, 0), cA, 0, false); PG8_STAGE_A(PG8_SA(0, 1), cA, 1, false);
        if (wr == 1) PG8_BAR;
        PG8_WAIT_V(2); PG8_BAR;
        PG8_STAGE(PG8_SB(1, 0), cB + kstep, voffB); PG8_STAGE_A(PG8_SA(1, 0), cA + kstep, 0, false); PG8_STAGE(PG8_SB(1, 1), cB + hstep + kstep, voffB);
        PG8_WAIT_V(6); PG8_BAR;
    } else {
        PG8_STAGE(PG8_SB(0, 0), cB, voffB); PG8_STAGE(PG8_SA(0, 0), cA, voffA); PG8_STAGE(PG8_SB(0, 1), cB + hstep, voffB); PG8_STAGE(PG8_SA(0, 1), cA + hstep, voffA);
        if (wr == 1) PG8_BAR;
        PG8_WAIT_V(4); PG8_BAR;
        PG8_STAGE(PG8_SB(1, 0), cB + kstep, voffB); PG8_STAGE(PG8_SA(1, 0), cA + kstep, voffA); PG8_STAGE(PG8_SB(1, 1), cB + hstep + kstep, voffB);
        PG8_WAIT_V(6); PG8_BAR;
    }
    for (;;) {
        const bool has_next = S.next(ui + 1, nxt);
        if (has_next) PG8_GATHER_OFFS(gaN, nxt);
        const GAS char* nA = has_next ? nxt.A : cA; const GAS char* nB = has_next ? nxt.B : cB;
        for (int t = 0; t < nt; t += 2) {
            const bool last = (t == nt - 2);
            const GAS char* a1 = cA + (size_t)(t + 1) * kstep;
            const GAS char* a2 = last ? nA : cA + (size_t)(t + 2) * kstep; const GAS char* b2 = last ? nB : cB + (size_t)(t + 2) * kstep;
            const GAS char* a3 = a2 + kstep; const GAS char* b3 = b2 + kstep;
            if constexpr (SP2) {
            PG8_LDB(B0, 0, 0); PG8_LDB(B1, 0, 1); PG8_SCHED; PG8_LDA(At, 0, 0); PG8_STAGE_A(PG8_SA(1, 1), a1, 1, false);
            PG8_WAIT_V(8); PG8_WAIT_L(0); PG8_BAR; PG8_MMA(0, 0, At, B0); PG8_MMA(0, 1, At, B1); PG8_BAR; PG8_SCHED;
            PG8_LDA(At, 0, 1); PG8_STAGE(PG8_SB(0, 0), b2, voffB); PG8_STAGE(PG8_SB(0, 1), b2 + hstep, voffB); PG8_STAGE_A(PG8_SA(0, 0), a2, 0, last && has_next);
            PG8_WAIT_V(8); PG8_WAIT_L(0); PG8_BAR; PG8_MMA(1, 0, At, B0); PG8_MMA(1, 1, At, B1); PG8_BAR; PG8_SCHED;
            PG8_LDB(B0, 1, 0); PG8_LDB(B1, 1, 1); PG8_SCHED; PG8_LDA(At, 1, 0); PG8_STAGE_A(PG8_SA(0, 1), a2, 1, last && has_next);
            PG8_WAIT_V(8); PG8_WAIT_L(0); PG8_BAR; PG8_MMA(0, 0, At, B0); PG8_MMA(0, 1, At, B1); PG8_BAR; PG8_SCHED;
            PG8_LDA(At, 1, 1); PG8_STAGE(PG8_SB(1, 0), b3, voffB); PG8_STAGE(PG8_SB(1, 1), b3 + hstep, voffB); PG8_STAGE_A(PG8_SA(1, 0), a3, 0, last && has_next);
            PG8_WAIT_V(8); PG8_WAIT_L(0); PG8_BAR; PG8_MMA(1, 0, At, B0); PG8_MMA(1, 1, At, B1); PG8_BAR; PG8_SCHED;
            } else {
            PG8_LDB(B0, 0, 0); PG8_SCHED; PG8_LDA(At, 0, 0); PG8_STAGE(PG8_SA(1, 1), a1 + hstep, voffA);
            PG8_WAIT_L(8); PG8_BAR; PG8_WAIT_L(0); PG8_MMA(0, 0, At, B0); PG8_BAR; PG8_SCHED;
            PG8_LDB(B1, 0, 1); PG8_STAGE(PG8_SB(0, 0), b2, voffB);
            PG8_BAR; PG8_WAIT_L(0); PG8_MMA(0, 1, At, B1); PG8_BAR;
            PG8_LDA(At, 0, 1); PG8_STAGE(PG8_SA(0, 0), a2, voffA);
            PG8_BAR; PG8_WAIT_L(0); PG8_MMA(1, 0, At, B0); PG8_BAR; PG8_SCHED;
            PG8_STAGE(PG8_SB(0, 1), b2 + hstep, voffB);
            PG8_WAIT_V(6); PG8_BAR; PG8_MMA(1, 1, At, B1); PG8_BAR;
            PG8_LDB(B0, 1, 0); PG8_SCHED; PG8_LDA(At, 1, 0); PG8_STAGE(PG8_SA(0, 1), a2 + hstep, voffA);
            PG8_WAIT_L(8); PG8_BAR; PG8_WAIT_L(0); PG8_MMA(0, 0, At, B0); PG8_BAR; PG8_SCHED;
            PG8_LDB(B1, 1, 1); PG8_STAGE(PG8_SB(1, 0), b3, voffB);
            PG8_BAR; PG8_WAIT_L(0); PG8_MMA(0, 1, At, B1); PG8_BAR;
            PG8_LDA(At, 1, 1); PG8_STAGE(PG8_SA(1, 0), a3, voffA);
            PG8_BAR; PG8_WAIT_L(0); PG8_MMA(1, 0, At, B0); PG8_BAR; PG8_SCHED;
            PG8_STAGE(PG8_SB(1, 1), b3 + hstep, voffB);
            PG8_WAIT_V(6); PG8_BAR; PG8_MMA(1, 1, At, B1); PG8_BAR;
            }
        }
        if constexpr (ALIGN_EPI) { if (wr == 0) PG8_BAR; }
        E(acc, cur, wr, wc, fr, fq);
        if (!has_next) break;
#pragma unroll
        for (int a = 0; a < 2; ++a)
#pragma unroll
            for (int b = 0; b < 2; ++b)
#pragma unroll
                for (int m = 0; m < 4; ++m)
#pragma unroll
                    for (int n = 0; n < 2; ++n) acc[a][b][m][n] = (f32x4){0.f, 0.f, 0.f, 0.f};
        cur = nxt; cA = nA; cB = nB; ++ui;
#pragma unroll
        for (int h_ = 0; h_ < 2; ++h_)
#pragma unroll
            for (int i_ = 0; i_ < 2; ++i_) gaC[h_][i_] = gaN[h_][i_];
        if constexpr (ALIGN_EPI) { if (wr == 1) PG8_BAR; }
    }
    PG8_WAIT_V(0);
    if constexpr (!ALIGN_EPI) { if (wr == 0) PG8_BAR; }
    PG8_BAR;
#undef PG8_SA
#undef PG8_SB
#undef PG8_STAGE
#undef PG8_LDA
#undef PG8_STAGE_A
#undef PG8_GATHER_OFFS
#undef PG8_LDB
#undef PG8_MMA
#undef PG8_WAIT_V
#undef PG8_WAIT_L
#undef PG8_BAR
#undef PG8_SCHED
}
}

using pg8::Unit; using pg8::cvt_pk_bf16; using pg8::bf1; using pg8::HALF; using pg8::BM;

struct EpiG1a {
    static constexpr bool PERM = true;
    GAS bf16* O;
    __device__ __forceinline__ void operator()(const f32x4 (&acc)[2][2][4][2], const Unit& u, int wr, int wc, int fr, int fq) const {
        const int row0 = u.pm * BM + wr * 64 + fr, col0 = u.pn * BM + wc * 32 + 8 * fq;
#pragma unroll
        for (int ai = 0; ai < 2; ++ai)
#pragma unroll
            for (int m = 0; m < 4; ++m) { GAS bf16* rowp = O + (size_t)(row0 + ai * HALF + m * 16) * 1536 + col0;
#pragma unroll
                for (int bj = 0; bj < 2; ++bj) { const f32x4 v0 = acc[ai][bj][m][0], v1 = acc[ai][bj][m][1];
                    u32x4 w; w.x = cvt_pk_bf16(v0[0], v0[1]); w.y = cvt_pk_bf16(v0[2], v0[3]); w.z = cvt_pk_bf16(v1[0], v1[1]); w.w = cvt_pk_bf16(v1[2], v1[3]);
                    *(GAS u32x4*)(rowp + bj * HALF) = w; } }
    }
};
struct EpiG1b {
    static constexpr bool PERM = true;
    GAS unsigned char* ws;
    __device__ __forceinline__ void operator()(const f32x4 (&acc)[2][2][4][2], const Unit& u, int wr, int wc, int fr, int fq) const {
        const int pn = u.pn; size_t off; int ld, ct;
        if (pn < 2) { off = WS_PZ; ld = 512; ct = pn; } else if (pn < 4) { off = WS_PPOOL; ld = 512; ct = pn - 2; } else if (pn == 4) { off = WS_PMQ; ld = 256; ct = 0; }
        else if (pn == 5) { off = WS_PMK; ld = 256; ct = 0; } else if (pn < 8) { off = WS_PMV; ld = 512; ct = pn - 6; } else { off = WS_PMO; ld = 512; ct = pn - 8; }
        GAS bf16* O = (GAS bf16*)(ws + off);
        const int row0 = u.pm * BM + wr * 64 + fr, col0 = ct * BM + wc * 32 + 8 * fq;
#pragma unroll
        for (int ai = 0; ai < 2; ++ai)
#pragma unroll
            for (int m = 0; m < 4; ++m) { GAS bf16* rowp = O + (size_t)(row0 + ai * HALF + m * 16) * ld + col0;
#pragma unroll
                for (int bj = 0; bj < 2; ++bj) { const f32x4 v0 = acc[ai][bj][m][0], v1 = acc[ai][bj][m][1];
                    u32x4 w; w.x = cvt_pk_bf16(v0[0], v0[1]); w.y = cvt_pk_bf16(v0[2], v0[3]); w.z = cvt_pk_bf16(v1[0], v1[1]); w.w = cvt_pk_bf16(v1[2], v1[3]);
                    *(GAS u32x4*)(rowp + bj * HALF) = w; } }
    }
};
__device__ __forceinline__ float fast_sigmoid(float x) { return __builtin_amdgcn_rcpf(1.0f + __builtin_amdgcn_exp2f(-1.44269504089f * x)); }
struct EpiGate {
    static constexpr bool PERM = true;
    GAS bf16* O;
    __device__ __forceinline__ void operator()(const f32x4 (&acc)[2][2][4][2], const Unit& u, int wr, int wc, int fr, int fq) const {
        const int row0 = u.pm * BM + wr * 64 + fr, col0 = u.pn * BM + wc * 32 + 8 * fq;
#pragma unroll
        for (int ai = 0; ai < 2; ++ai)
#pragma unroll
            for (int m = 0; m < 4; ++m) { GAS bf16* rowp = O + (size_t)(row0 + ai * HALF + m * 16) * 3072 + col0;
#pragma unroll
                for (int bj = 0; bj < 2; ++bj) { f32x4 v0 = acc[ai][bj][m][0], v1 = acc[ai][bj][m][1];
#pragma unroll
                    for (int j = 0; j < 4; ++j) { v0[j] = fast_sigmoid(v0[j]); v1[j] = fast_sigmoid(v1[j]); }
                    u32x4 w; w.x = cvt_pk_bf16(v0[0], v0[1]); w.y = cvt_pk_bf16(v0[2], v0[3]); w.z = cvt_pk_bf16(v1[0], v1[1]); w.w = cvt_pk_bf16(v1[2], v1[3]);
                    *(GAS u32x4*)(rowp + bj * HALF) = w; } }
    }
};
__device__ __forceinline__ void unpack8(const u32x4 w, float (&f)[8]) {
    f[0] = __uint_as_float(w.x << 16); f[1] = __uint_as_float(w.x & 0xffff0000u); f[2] = __uint_as_float(w.y << 16); f[3] = __uint_as_float(w.y & 0xffff0000u);
    f[4] = __uint_as_float(w.z << 16); f[5] = __uint_as_float(w.z & 0xffff0000u); f[6] = __uint_as_float(w.w << 16); f[7] = __uint_as_float(w.w & 0xffff0000u);
}
struct EpiMerge {
    static constexpr bool PERM = true;
    const GAS bf16* GATE; GAS bf16* PART; GAS bf16* FIN;
    __device__ __forceinline__ void operator()(const f32x4 (&acc)[2][2][4][2], const Unit& u, int wr, int wc, int fr, int fq) const {
        const int r = u.aux;
        const int row0 = u.pm * BM + wr * 64 + fr, col0 = u.pn * BM + wc * 32 + 8 * fq;
        GAS bf16* dst = (r == 2) ? FIN : PART;
#pragma unroll
        for (int ai = 0; ai < 2; ++ai) {
            u32x4 gw[4][2], pw[4][2];
#pragma unroll
            for (int m = 0; m < 4; ++m)
#pragma unroll
                for (int bj = 0; bj < 2; ++bj) { const size_t row = (size_t)(row0 + ai * HALF + m * 16); const int c = col0 + bj * HALF;
                    gw[m][bj] = *(const GAS u32x4*)(GATE + row * 3072 + r * 1024 + c);
                    if (r > 0) pw[m][bj] = *(const GAS u32x4*)(PART + row * 1024 + c); }
#pragma unroll
            for (int m = 0; m < 4; ++m)
#pragma unroll
                for (int bj = 0; bj < 2; ++bj) { const size_t row = (size_t)(row0 + ai * HALF + m * 16); const int c = col0 + bj * HALF;
                    const f32x4 v0 = acc[ai][bj][m][0], v1 = acc[ai][bj][m][1];
                    float g[8]; unpack8(gw[m][bj], g);
                    float o[8];
                    o[0] = v0[0] * g[0]; o[1] = v0[1] * g[1]; o[2] = v0[2] * g[2]; o[3] = v0[3] * g[3];
                    o[4] = v1[0] * g[4]; o[5] = v1[1] * g[5]; o[6] = v1[2] * g[6]; o[7] = v1[3] * g[7];
                    if (r > 0) { float p[8]; unpack8(pw[m][bj], p);
#pragma unroll
                        for (int j = 0; j < 8; ++j) o[j] += p[j]; }
                    u32x4 w; w.x = cvt_pk_bf16(o[0], o[1]); w.y = cvt_pk_bf16(o[2], o[3]); w.z = cvt_pk_bf16(o[4], o[5]); w.w = cvt_pk_bf16(o[6], o[7]);
                    *(GAS u32x4*)(dst + row * 1024 + c) = w; }
        }
    }
};
struct EpiOut {
    static constexpr bool PERM = false;
    const GAS bf16* H; GAS bf16* PRE;
    __device__ __forceinline__ void operator()(const f32x4 (&acc)[2][2][4][2], const Unit& u, int wr, int wc, int fr, int fq) const {
        const int row0 = u.pm * BM + wr * 64 + fr, col0 = u.pn * BM + wc * 32 + 4 * fq;
#pragma unroll
        for (int ai = 0; ai < 2; ++ai) {
            u32x2 hv[4][2][2];
#pragma unroll
            for (int m = 0; m < 4; ++m)
#pragma unroll
                for (int bj = 0; bj < 2; ++bj)
#pragma unroll
                    for (int n = 0; n < 2; ++n) hv[m][bj][n] = *(const GAS u32x2*)(H + (size_t)(row0 + ai * HALF + m * 16) * D + col0 + bj * HALF + n * 16);
#pragma unroll
            for (int m = 0; m < 4; ++m)
#pragma unroll
                for (int bj = 0; bj < 2; ++bj)
#pragma unroll
                    for (int n = 0; n < 2; ++n) { const size_t o = (size_t)(row0 + ai * HALF + m * 16) * D + col0 + bj * HALF + n * 16; const u32x2 h2 = hv[m][bj][n]; const f32x4 a = acc[ai][bj][m][n];
                        u32x2 w; w.x = cvt_pk_bf16(ALPHA * bf2f(h2.x & 0xffffu) + a[0], ALPHA * bf2f(h2.x >> 16) + a[1]); w.y = cvt_pk_bf16(ALPHA * bf2f(h2.y & 0xffffu) + a[2], ALPHA * bf2f(h2.y >> 16) + a[3]);
                        *(GAS u32x2*)(PRE + o) = w; }
        }
    }
};
struct EpiMoe1 {
    static constexpr bool PERM = true;
    GAS bf16* ACT;
    __device__ __forceinline__ void operator()(const f32x4 (&acc)[2][2][4][2], const Unit& u, int wr, int wc, int fr, int fq) const {
        const int row0 = u.pm * BM + wr * 64 + fr, col0 = u.pn * 128 + wc * 32 + 8 * fq;
#pragma unroll
        for (int ai = 0; ai < 2; ++ai)
#pragma unroll
            for (int m = 0; m < 4; ++m) { GAS bf16* rowp = ACT + (size_t)(row0 + ai * HALF + m * 16) * DEXP + col0;
                float o[8];
#pragma unroll
                for (int n = 0; n < 2; ++n)
#pragma unroll
                    for (int j = 0; j < 4; ++j) { const float a = acc[ai][0][m][n][j], b = acc[ai][1][m][n][j]; o[n * 4 + j] = a * fast_sigmoid(a) * b; }
                u32x4 w; w.x = cvt_pk_bf16(o[0], o[1]); w.y = cvt_pk_bf16(o[2], o[3]); w.z = cvt_pk_bf16(o[4], o[5]); w.w = cvt_pk_bf16(o[6], o[7]);
                *(GAS u32x4*)rowp = w; }
    }
};
struct EpiMoe2 {
    static constexpr bool PERM = true;
    GAS bf16* Y; const GAS float* roww;
    __device__ __forceinline__ void operator()(const f32x4 (&acc)[2][2][4][2], const Unit& u, int wr, int wc, int fr, int fq) const {
        const int row0 = u.pm * BM + wr * 64 + fr, col0 = u.pn * BM + wc * 32 + 8 * fq;
        float rws[2][4];
#pragma unroll
        for (int ai = 0; ai < 2; ++ai)
#pragma unroll
            for (int m = 0; m < 4; ++m) rws[ai][m] = roww[row0 + ai * HALF + m * 16];
#pragma unroll
        for (int ai = 0; ai < 2; ++ai)
#pragma unroll
            for (int m = 0; m < 4; ++m) { const int row = row0 + ai * HALF + m * 16; const float rw = rws[ai][m]; GAS bf16* rowp = Y + (size_t)row * D + col0;
#pragma unroll
                for (int bj = 0; bj < 2; ++bj) { const f32x4 v0 = acc[ai][bj][m][0] * rw, v1 = acc[ai][bj][m][1] * rw;
                    u32x4 w; w.x = cvt_pk_bf16(v0[0], v0[1]); w.y = cvt_pk_bf16(v0[2], v0[3]); w.z = cvt_pk_bf16(v1[0], v1[1]); w.w = cvt_pk_bf16(v1[2], v1[3]);
                    *(GAS u32x4*)(rowp + bj * HALF) = w; } }
    }
};

struct MergeOrder {
    static constexpr bool GATHER = false;
    const GAS char* Y[3]; const GAS char* W; int G, c;
    __device__ __forceinline__ bool next(int i, Unit& u) const {
        const int j = i / 3, r = i - 3 * j; const int L = j * G + c; if (L >= 128 * 4) return false;
        pg8::tile_of(L, 128, 4, u.pm, u.pn); u.aux = r;
        const GAS char* y = (r == 0) ? Y[0] : ((r == 1) ? Y[1] : Y[2]);
        u.A = y + (size_t)u.pm * (256 * 512 * 2); u.B = W + (size_t)r * (1024 * 512 * 2) + (size_t)u.pn * (256 * 512 * 2); return true;
    }
};
template <int KDIM, bool GATHER_> struct MoeOrder {
    static constexpr bool GATHER = GATHER_;
    const GAS int* rowtok;
    const GAS char* A; const GAS char* W; const LAS int* pe; int c, NP;
    __device__ __forceinline__ bool next(int i, Unit& u) const {
        const int L = i * 256 + c; if (L >= NP * 4) return false;
        const int p = L >> 2, pn = L & 3; const int e = __builtin_amdgcn_readfirstlane(pe[p]);
        u.pm = p; u.pn = pn; u.aux = e; u.A = GATHER_ ? A : A + (size_t)p * (256 * KDIM * 2); u.B = W + (size_t)e * (1024 * KDIM * 2) + (size_t)pn * (256 * KDIM * 2); return true;
    }
};

struct Args {
    const float* in[23]; float* out; unsigned char* ws; int ph_lo, ph_hi;
};
struct Frame {
    LAS unsigned char* lds; int tid, lane, wave, G, wg;
    GAS float* out; GAS unsigned char* ws;
};
__device__ __forceinline__ const GAS float* inp_lds(LAS unsigned char* lds, int i) {
    const unsigned long long v = ((const LAS unsigned long long*)(lds + LARG_OFF))[i];
    const unsigned lo = __builtin_amdgcn_readfirstlane((unsigned)v), hi = __builtin_amdgcn_readfirstlane((unsigned)(v >> 32));
    return (const GAS float*)(((unsigned long long)hi << 32) | lo);
}
__device__ __forceinline__ const GAS float* inp(const Frame& F, int i) { return inp_lds(F.lds, i); }
__device__ __forceinline__ Frame fresh(LAS unsigned char* lds, int wave) {
    Frame F; int wgx = blockIdx.x; unsigned lb = (unsigned)(unsigned long long)lds;
    asm volatile("" : "+s"(wave), "+s"(wgx), "+s"(lb));
    F.lds = (LAS unsigned char*)(unsigned long long)lb;
    int ln = (int)__builtin_amdgcn_mbcnt_hi(~0u, __builtin_amdgcn_mbcnt_lo(~0u, 0u)); asm volatile("" : "+v"(ln));
    F.wave = wave; F.lane = ln; F.tid = wave * 64 + ln;
    F.G = 256; F.wg = wgx;
    F.out = (GAS float*)inp_lds(F.lds, 23); F.ws = (GAS unsigned char*)inp_lds(F.lds, 24);
    return F;
}
enum { I_X = 0, I_LN_IN_G, I_LN_IN_B, I_W_IN, I_CONV, I_A_LOG, I_DT_BIAS, I_DN_NORM, I_POOL_W, I_POOL_SCALE, I_ML_GATE_B, I_ML_NORM, I_W_BRANCH, I_W_OUT, I_LN_MIX_G, I_LN_MIX_B,
       I_ROUTER_W, I_ROUTER_B, I_MOE_W1, I_MOE_W3, I_MOE_W2, I_LN_FFN_G, I_LN_FFN_B };

__device__ __forceinline__ void tr_load(float (&r)[32], const GAS float* W, int ldw, int k0, int n0src, int lane) {
#pragma unroll
    for (int i = 0; i < 32; ++i) { const int kk = 2 * i + (lane >> 5); r[i] = W[(size_t)(k0 + kk) * ldw + n0src + (lane & 31)]; }
}
__device__ __forceinline__ void tr_store(const float (&r)[32], GAS bf16* WT, int dpitch, int k0, int drow0, LAS float* scr, int lane) {
#pragma unroll
    for (int i = 0; i < 32; ++i) { const int kk = 2 * i + (lane >> 5); scr[kk * 33 + (lane & 31)] = r[i]; }
    LDS_WAIT(); asm volatile("" ::: "memory");
    const int c = lane & 7;
#pragma unroll
    for (int j = 0; j < 4; ++j) { const int n = (lane >> 3) + 8 * j; const LAS float* s = scr + (8 * c) * 33 + n;
        u32x4 o; o.x = cvt_pk_bf16(s[0 * 33], s[1 * 33]); o.y = cvt_pk_bf16(s[2 * 33], s[3 * 33]); o.z = cvt_pk_bf16(s[4 * 33], s[5 * 33]); o.w = cvt_pk_bf16(s[6 * 33], s[7 * 33]);
        *(GAS u32x4*)(WT + (size_t)(drow0 + n) * dpitch + k0 + 8 * c) = o; }
    LDS_WAIT(); asm volatile("" ::: "memory");
}
__device__ __forceinline__ void tr_item(const GAS float* W, int ldw, int k0, int n0src, GAS bf16* WT, int dpitch, int drow0, LAS float* scr, int lane) {
    float r[32]; tr_load(r, W, ldw, k0, n0src, lane); tr_store(r, WT, dpitch, k0, drow0, scr, lane);
}
__device__ __forceinline__ void tr_segment(const Frame& F, const GAS float* W, int ldw, int K, int n0src, int ncols, GAS bf16* WT, int drow0, int& it) {
    LAS float* scr = (LAS float*)(F.lds + F.wave * 16384);
    const int gw = F.wg * NWAVES + F.wave, NGW = F.G * NWAVES;
    const int nblk = ncols / 32, nitems = (K / 64) * nblk;
    int first = (gw - (it % NGW) + NGW) % NGW;
    for (int r = first; r < nitems; r += NGW) { const int kb = r / nblk, nb = r % nblk; tr_item(W, ldw, 64 * kb, n0src + 32 * nb, WT, K, drow0 + 32 * nb, scr, F.lane); }
    it += nitems;
}
__device__ __forceinline__ void wprep_mixer(const Frame& F, int l) {
    const GAS float* win = inp(F, I_W_IN) + (size_t)l * D * DIN; int it = 0;
    GAS bf16* Wi = (GAS bf16*)(F.ws + WS_WIN); GAS bf16* Wg = (GAS bf16*)(F.ws + WS_WGATE); GAS bf16* Wb = (GAS bf16*)(F.ws + WS_WBR); GAS bf16* Wo = (GAS bf16*)(F.ws + WS_WOUT);
    tr_segment(F, win, DIN, D, C_QKV, 1536, Wi, 0, it);
    tr_segment(F, win, DIN, D, C_Z, 512, Wi, 1536, it);
    tr_segment(F, win, DIN, D, C_POOL, 512, Wi, 2048, it);
    tr_segment(F, win, DIN, D, C_MQ, 256, Wi, 2560, it);
    tr_segment(F, win, DIN, D, C_MK, 256, Wi, 2816, it);
    tr_segment(F, win, DIN, D, C_MV, 512, Wi, 3072, it);
    tr_segment(F, win, DIN, D, C_MO, 512, Wi, 3584, it);
    tr_segment(F, win, DIN, D, C_GATE, 3072, Wg, 0, it);
    const GAS float* wbr = inp(F, I_W_BRANCH) + (size_t)l * 3 * MIXW * D;
    tr_segment(F, wbr, D, MIXW, 0, D, Wb, 0, it);
    tr_segment(F, wbr + (size_t)2 * MIXW * D, D, MIXW, 0, D, Wb + (size_t)2 * D * MIXW, 0, it);
    tr_segment(F, inp(F, I_W_OUT) + (size_t)l * D * D, D, D, 0, D, Wo, 0, it);
    const GAS float* pw = inp(F, I_POOL_W) + (size_t)l * 4 * 128 * 128; const GAS float* ps = inp(F, I_POOL_SCALE) + (size_t)l * MIXW; const GAS float* wb1 = wbr + (size_t)MIXW * D;
    GAS bf16* W1 = Wb + (size_t)D * MIXW;
    for (int idx = F.wg * 512 + F.tid; idx < D * MIXW; idx += F.G * 512) {
        const int m = idx >> 10, d = idx & 1023, g = m >> 7, c = m & 127;
        float s = 0.f;
        for (int dd = 0; dd < 128; ++dd) s += pw[(g * 128 + c) * 128 + dd] * ps[g * 128 + dd] * wb1[(size_t)(g * 128 + dd) * D + d];
        W1[(size_t)d * MIXW + m] = (bf16)f2bf(s);
    }
}
__device__ __forceinline__ void wprep_moe(const Frame& F, int l, int wg0, int nwg) {
    GAS bf16* W13 = (GAS bf16*)((GAS unsigned char*)F.out + 64 * MiB); GAS bf16* W2 = (GAS bf16*)(F.ws + WS_W2);
    LAS float* scr = (LAS float*)(F.lds + F.wave * 16384);
    const int gw = (F.wg - wg0) * NWAVES + F.wave, NGW = nwg * NWAVES;
    const GAS float* w1 = inp(F, I_MOE_W1); const GAS float* w3 = inp(F, I_MOE_W3); const GAS float* w2 = inp(F, I_MOE_W2);
#define MOE_ITEM_LOAD(R, r_) do { const int ri_ = (r_); if (ri_ < 16384) { const int e = ri_ >> 9, which = (ri_ >> 8) & 1, kb = (ri_ >> 4) & 15, nb = ri_ & 15; \
            tr_load(R, (which ? w3 : w1) + ((size_t)l * NEXP + e) * D * DEXP, DEXP, 64 * kb, nb * 32, F.lane); } \
        else if (ri_ < 24576) { const int q = ri_ - 16384, e = q >> 8, kb = (q >> 5) & 7, nb = q & 31; tr_load(R, w2 + ((size_t)l * NEXP + e) * DEXP * D, D, 64 * kb, 32 * nb, F.lane); } } while (0)
#define MOE_ITEM_STORE(R, r_) do { const int ri_ = (r_); if (ri_ < 16384) { const int e = ri_ >> 9, which = (ri_ >> 8) & 1, kb = (ri_ >> 4) & 15, nb = ri_ & 15, n0 = nb * 32; \
            tr_store(R, W13 + (size_t)e * D * D, D, 64 * kb, (n0 >> 7) * 256 + which * 128 + (n0 & 127), scr, F.lane); } \
        else if (ri_ < 24576) { const int q = ri_ - 16384, e = q >> 8, kb = (q >> 5) & 7, nb = q & 31; tr_store(R, W2 + (size_t)e * D * DEXP, DEXP, 64 * kb, 32 * nb, scr, F.lane); } } while (0)
    float ra[32], rb[32];
    MOE_ITEM_LOAD(ra, gw);
    for (int r = gw; r < 24576; r += 2 * NGW) {
        MOE_ITEM_LOAD(rb, r + NGW); MOE_ITEM_STORE(ra, r);
        MOE_ITEM_LOAD(ra, r + 2 * NGW); MOE_ITEM_STORE(rb, r + NGW);
    }
#undef MOE_ITEM_LOAD
#undef MOE_ITEM_STORE
}

#define LN_BAR() do { asm volatile("s_waitcnt lgkmcnt(0)" ::: "memory"); __builtin_amdgcn_s_barrier(); asm volatile("" ::: "memory"); } while (0)
constexpr int LN_HLO = 32768, LN_PART = 65536;
template <int MODE>
__device__ __forceinline__ void ln_phase(const Frame& F, const GAS float* gam, const GAS float* bet, const GAS float* w32src, int w32ld, bool do_proj, bool write_hb, bool dummy = false) {
    GAS float* OUTP = dummy ? (GAS float*)(F.ws + WS_R2) : F.out; GAS unsigned char* WSO = dummy ? (F.ws + WS_R2 + 40 * MiB) : F.ws;
    LAS int* lhist = (LAS int*)(F.lds + LHIST_OFF);
    if (MODE == 1 && F.tid < 32) lhist[F.tid] = 0;
    const int lane = F.lane, fr = lane & 15, fq = lane >> 4;
    bf16x8 Whi[4][2], Wlo[4][2];
    if (do_proj) {
#pragma unroll
        for (int t = 0; t < 4; ++t) {
#pragma unroll
            for (int nt = 0; nt < 2; ++nt) {
                const int o = 16 * nt + fr; int col = o;
                if (MODE != 1) { const int c4 = o >> 2; col = ((c4 < 2) ? (C_A + 4 * c4) : (c4 < 4) ? (C_B + 4 * (c4 - 2)) : (c4 < 6) ? (C_I + 4 * (c4 - 4)) : (C_F + 4 * (c4 - 6))) + (o & 3); }
                const GAS float* wp = w32src + (size_t)(32 * (4 * F.wave + t) + 8 * fq) * w32ld + col;
#pragma unroll
                for (int j = 0; j < 8; ++j) { const float w = wp[(size_t)j * w32ld]; const unsigned h = f2bf(w); Whi[t][nt][j] = (short)h; Wlo[t][nt][j] = (short)f2bf(w - bf2f(h)); }
            }
        }
    }
    __syncthreads();
    GAS bf16* hb = dummy ? (GAS bf16*)(F.ws + WS_R2 + 128 * MiB) : (GAS bf16*)(F.ws + WS_HB);
    const int rows_per_wg = T / F.G;
    const GAS int* posp = (const GAS int*)(F.ws + WS_POS); const GAS bf16* Yr = (const GAS bf16*)(F.ws + WS_YROWS);
    const GAS float* srcp = inp(F, I_X);
    const GAS bf16* preb = (MODE == 1) ? (const GAS bf16*)F.out : (const GAS bf16*)(F.ws + WS_HB);
    const int nrow = rows_per_wg / NWAVES, row0 = F.wg * rows_per_wg + F.wave * nrow;
    int posv = 0; if (MODE == 2) posv = posp[2 * row0 + (lane & 31)];
    float rbias = 0.f; if (MODE == 1) rbias = inp(F, I_ROUTER_B)[lane & 31];
#define LN_FETCH(R, Y0, Y1, i_) do { const int ii_ = (i_); const int rw_ = row0 + ii_; \
        if (MODE == 0) { _Pragma("unroll") for (int q = 0; q < 4; ++q) R[q] = *(const GAS u32x4*)(srcp + (size_t)rw_ * D + 8 * lane + 512 * (q >> 1) + 4 * (q & 1)); } \
        else { _Pragma("unroll") for (int m = 0; m < 2; ++m) R[m] = *(const GAS u32x4*)(preb + (size_t)rw_ * D + 8 * lane + 512 * m); } \
        if (MODE == 2) { const int p0_ = __builtin_amdgcn_readlane(posv, 2 * ii_), p1_ = __builtin_amdgcn_readlane(posv, 2 * ii_ + 1); \
            _Pragma("unroll") for (int m = 0; m < 2; ++m) { Y0[m] = *(const GAS u32x4*)(Yr + (size_t)p0_ * D + 8 * lane + 512 * m); Y1[m] = *(const GAS u32x4*)(Yr + (size_t)p1_ * D + 8 * lane + 512 * m); } } } while (0)
    float gvr[16], bvr[16];
    if constexpr (MODE == 2) {
#pragma unroll
        for (int q = 0; q < 4; ++q) { const f32x4 g4 = *(const GAS f32x4*)(gam + 8 * lane + 512 * (q >> 1) + 4 * (q & 1)), b4 = *(const GAS f32x4*)(bet + 8 * lane + 512 * (q >> 1) + 4 * (q & 1));
#pragma unroll
            for (int c = 0; c < 4; ++c) { gvr[4 * q + c] = g4[c]; bvr[4 * q + c] = b4[c]; } }
    }
    u32x4 rA[4], rB[4], yA0[2], yA1[2], yB0[2], yB1[2];
    LN_FETCH(rA, yA0, yA1, 0);
#pragma unroll 1
    for (int i2 = 0; i2 < nrow; i2 += 2) {
#pragma unroll
      for (int half = 0; half < 2; ++half) {
        const int i = i2 + half; const int row = row0 + i;
        const int nri = (i + 1 < nrow) ? i + 1 : i;
        if (half == 0) LN_FETCH(rB, yB0, yB1, nri); else LN_FETCH(rA, yA0, yA1, nri);
        float v[16];
#pragma unroll
        for (int m = 0; m < 2; ++m) {
#pragma unroll
            for (int q = 0; q < 4; ++q) {
                if (MODE == 0) { const u32x4 lo4 = half ? rB[2 * m] : rA[2 * m], hi4 = half ? rB[2 * m + 1] : rA[2 * m + 1];
                    v[8 * m + q] = __uint_as_float(lo4[q]); v[8 * m + 4 + q] = __uint_as_float(hi4[q]); }
                else { const unsigned u = half ? rB[m][q] : rA[m][q];
                    float x0 = __uint_as_float(u << 16), x1 = __uint_as_float(u & 0xffff0000u);
                    if (MODE == 2) { const unsigned ya = half ? yB0[m][q] : yA0[m][q], yb = half ? yB1[m][q] : yA1[m][q];
                        x0 = ALPHA * x0 + __uint_as_float(ya << 16) + __uint_as_float(yb << 16); x1 = ALPHA * x1 + __uint_as_float(ya & 0xffff0000u) + __uint_as_float(yb & 0xffff0000u); }
                    v[8 * m + 2 * q] = x0; v[8 * m + 2 * q + 1] = x1; }
            }
        }
        float s = 0.f;
#pragma unroll
        for (int c = 0; c < 16; ++c) s += v[c];
        const float mean = wave_sum(s) * (1.f / D);
        float s2 = 0.f;
#pragma unroll
        for (int c = 0; c < 16; ++c) { v[c] -= mean; s2 += v[c] * v[c]; }
        const float rstd = 1.0f / sqrtf(wave_sum(s2) * (1.f / D) + LN_EPS);
        if constexpr (MODE == 2) {
#pragma unroll
            for (int c = 0; c < 16; ++c) v[c] = v[c] * rstd * gvr[c] + bvr[c];
        } else { int goz = 8 * lane; asm volatile("" : "+v"(goz));
#pragma unroll
          for (int q = 0; q < 4; ++q) { const f32x4 g4 = *(const GAS f32x4*)(gam + goz + 512 * (q >> 1) + 4 * (q & 1)), b4 = *(const GAS f32x4*)(bet + goz + 512 * (q >> 1) + 4 * (q & 1));
#pragma unroll
            for (int c = 0; c < 4; ++c) v[4 * q + c] = v[4 * q + c] * rstd * g4[c] + b4[c]; } }
        if (!write_hb) {
#pragma unroll
            for (int q = 0; q < 4; ++q) *(GAS f32x4*)(OUTP + (size_t)row * D + 8 * lane + 512 * (q >> 1) + 4 * (q & 1)) = (f32x4){v[4 * q], v[4 * q + 1], v[4 * q + 2], v[4 * q + 3]};
        }
        u32x4 hp[2];
#pragma unroll
        for (int m = 0; m < 2; ++m)
#pragma unroll
            for (int q = 0; q < 4; ++q) hp[m][q] = cvt_pk_bf16(v[8 * m + 2 * q], v[8 * m + 2 * q + 1]);
        if (write_hb) {
#pragma unroll
            for (int m = 0; m < 2; ++m) *(GAS u32x4*)(hb + (size_t)row * D + 8 * lane + 512 * m) = hp[m];
        }
        if (do_proj) {
            const int brow = F.wave + 8 * half;
#pragma unroll
            for (int m = 0; m < 2; ++m) {
                u32x4 lp;
#pragma unroll
                for (int q = 0; q < 4; ++q) lp[q] = cvt_pk_bf16(v[8 * m + 2 * q] - __uint_as_float(hp[m][q] << 16), v[8 * m + 2 * q + 1] - __uint_as_float(hp[m][q] & 0xffff0000u));
                const int a = brow * 2048 + (((lane + 64 * m) ^ brow) << 4);
                *(LAS u32x4*)(F.lds + a) = hp[m]; *(LAS u32x4*)(F.lds + LN_HLO + a) = lp;
            }
        }
      }
      if (!do_proj) continue;
      LN_BAR();
      {
        f32x4 a0 = {0.f, 0.f, 0.f, 0.f}, a1 = {0.f, 0.f, 0.f, 0.f};
        bf16x8 bh[4], bl[4];
#pragma unroll
        for (int t = 0; t < 4; ++t) { const int a = fr * 2048 + (((4 * (4 * F.wave + t) + fq) ^ fr) << 4); bh[t] = *(const LAS bf16x8*)(F.lds + a); bl[t] = *(const LAS bf16x8*)(F.lds + LN_HLO + a); }
#pragma unroll
        for (int t = 0; t < 4; ++t) {
            a0 = __builtin_amdgcn_mfma_f32_16x16x32_bf16(Whi[t][0], bh[t], a0, 0, 0, 0); a1 = __builtin_amdgcn_mfma_f32_16x16x32_bf16(Whi[t][1], bh[t], a1, 0, 0, 0);
            a0 = __builtin_amdgcn_mfma_f32_16x16x32_bf16(Whi[t][0], bl[t], a0, 0, 0, 0); a1 = __builtin_amdgcn_mfma_f32_16x16x32_bf16(Whi[t][1], bl[t], a1, 0, 0, 0);
            a0 = __builtin_amdgcn_mfma_f32_16x16x32_bf16(Wlo[t][0], bh[t], a0, 0, 0, 0); a1 = __builtin_amdgcn_mfma_f32_16x16x32_bf16(Wlo[t][1], bh[t], a1, 0, 0, 0);
        }
        *(LAS f32x4*)(F.lds + LN_PART + F.wave * 2048 + fr * 128 + (((0 + fq) ^ (fr & 7)) << 4)) = a0;
        *(LAS f32x4*)(F.lds + LN_PART + F.wave * 2048 + fr * 128 + (((4 + fq) ^ (fr & 7)) << 4)) = a1;
      }
      LN_BAR();
      {
        const int rsel = lane >> 5, o = lane & 31, brow = F.wave + 8 * rsel, row = row0 + i2 + rsel;
        const int pa = LN_PART + brow * 128 + (((o >> 2) ^ (brow & 7)) << 4) + (o & 3) * 4;
        float r1 = 0.f;
#pragma unroll
        for (int p8 = 0; p8 < 8; ++p8) r1 += *(const LAS float*)(F.lds + pa + p8 * 2048);
        if (MODE != 1) {
            ((GAS float*)(WSO + WS_SG))[(size_t)row * 32 + o] = r1;
        } else {
            const float score = sigmoidf_(r1);
            const float sel = score + rbias;
            const int hsel = lane & 32, gb = lane & ~3;
            const float v0 = __shfl(sel, gb + 0), v1 = __shfl(sel, gb + 1), v2 = __shfl(sel, gb + 2), v3 = __shfl(sel, gb + 3);
            int i1 = 0; float m1 = v0;
            if (v1 > m1) { m1 = v1; i1 = 1; } if (v2 > m1) { m1 = v2; i1 = 2; } if (v3 > m1) { m1 = v3; i1 = 3; }
            int ix2 = -1; float m2 = -3.0e38f;
            if (i1 != 0 && v0 > m2) { m2 = v0; ix2 = 0; } if (i1 != 1 && v1 > m2) { m2 = v1; ix2 = 1; } if (i1 != 2 && v2 > m2) { m2 = v2; ix2 = 2; } if (i1 != 3 && v3 > m2) { m2 = v3; ix2 = 3; }
            float gs = m1 + m2; int gi = o >> 2;
#pragma unroll
            for (int ofs = 4; ofs < 32; ofs <<= 1) { const float og = __shfl_xor(gs, ofs); const int oi = __shfl_xor(gi, ofs); if (og > gs || (og == gs && oi < gi)) { gs = og; gi = oi; } }
            const int src = hsel + gi * 4;
            const int e1 = gi * 4 + __shfl(i1, src), e2 = gi * 4 + __shfl(ix2, src);
            const float s1 = __shfl(score, hsel + e1), sc2 = __shfl(score, hsel + e2);
            if (o == 0) {
                GAS int* eid = (GAS int*)(WSO + WS_EID); GAS float* ew = (GAS float*)(WSO + WS_EW);
                const float inv = 1.0f / (s1 + sc2);
                eid[2 * row] = e1; eid[2 * row + 1] = e2; ew[2 * row] = s1 * inv; ew[2 * row + 1] = sc2 * inv;
                __hip_atomic_fetch_add(lhist + e1, 1, __ATOMIC_RELAXED, __HIP_MEMORY_SCOPE_WORKGROUP); __hip_atomic_fetch_add(lhist + e2, 1, __ATOMIC_RELAXED, __HIP_MEMORY_SCOPE_WORKGROUP);
            }
        }
      }
    }
#undef LN_FETCH
    if (MODE == 1) {
        __syncthreads();
        if (F.tid < 32) ((GAS int*)(WSO + WS_HIST))[F.wg * 32 + F.tid] = lhist[F.tid];
    }
    __syncthreads();
}

__device__ __forceinline__ int invsigma32(int w) { return 8 * ((w >> 2) & 3) + 4 * (w >> 4) + (w & 3); }
__device__ __forceinline__ float wave_incl_scan(float v, int lane) {
#pragma unroll
    for (int o = 1; o < 64; o <<= 1) { const float t = __shfl_up(v, o); if (lane >= o) v += t; }
    return v;
}
__device__ __forceinline__ float wave_incl_maxscan(float v, int lane) {
#pragma unroll
    for (int o = 1; o < 64; o <<= 1) { const float t = __shfl_up(v, o); if (lane >= o) v = fmaxf(v, t); }
    return v;
}
constexpr int DQ_OFF = 0, DK_OFF = 17408, DV_OFF = 34816, DGM_OFF = 52224, DQK_OFF = 69632, DTM_OFF = 87040, DVEC_OFF = 121856;
constexpr int QROW = 272;
constexpr int FROW = 68;
__device__ __forceinline__ bf16x8 pack_b(const f32x4 lo, const f32x4 hi) {
    u32x4 w; w.x = cvt_pk_bf16(lo[0], lo[1]); w.y = cvt_pk_bf16(lo[2], lo[3]); w.z = cvt_pk_bf16(hi[0], hi[1]); w.w = cvt_pk_bf16(hi[2], hi[3]);
    return __builtin_bit_cast(bf16x8, w);
}
__device__ __forceinline__ bf16x8 pack8f(const float (&f)[8]) {
    u32x4 w; w.x = cvt_pk_bf16(f[0], f[1]); w.y = cvt_pk_bf16(f[2], f[3]); w.z = cvt_pk_bf16(f[4], f[5]); w.w = cvt_pk_bf16(f[6], f[7]);
    return __builtin_bit_cast(bf16x8, w);
}
#define PREP_BAR() do { asm volatile("s_waitcnt lgkmcnt(0)" ::: "memory"); __builtin_amdgcn_s_barrier(); asm volatile("" ::: "memory"); } while (0)
#ifndef DNREP_A
#define DNREP_A 1
#endif
#ifndef DNREP_B
#define DNREP_B 1
#endif
#ifndef DNREP_C
#define DNREP_C 1
#endif
#ifndef DNREP_D
#define DNREP_D 1
#endif
__device__ __forceinline__ void dn_prep(const Frame& F, int l) {
    LAS unsigned char* L = F.lds;
    const int lane = F.lane, wave = F.wave, tid = F.tid, fr = lane & 15, fq = lane >> 4;
    const GAS bf16* P = (const GAS bf16*)(F.ws + WS_PQKV);
    const GAS float* SG = (const GAS float*)(F.ws + WS_SG);
    const GAS float* cw = inp(F, I_CONV) + (size_t)l * 5 * 1536;
    LAS float* GM = (LAS float*)(L + DGM_OFF); LAS float* QKM = (LAS float*)(L + DQK_OFF);
#ifdef DIAG
    unsigned long long tacc[7] = {0, 0, 0, 0, 0, 0, 0}; unsigned long long tprev = __builtin_amdgcn_s_memrealtime();
#define DSTAMP(k) do { const unsigned long long tn_ = __builtin_amdgcn_s_memrealtime(); tacc[k] += tn_ - tprev; tprev = tn_; } while (0)
#else
#define DSTAMP(k) do {} while (0)
#endif
    unsigned praw[12][3]; float pga = 0.f, pgb = 0.f;
#define DN_PF(item_) do { const int it_ = (item_) < NB * NHEAD * NCH ? (item_) : F.wg; const int b_ = it_ >> 9, h_ = (it_ >> 7) & 3, n_ = it_ & 127; \
        _Pragma("unroll") for (int rr = 0; rr < 12; ++rr) { const int sp_ = n_ * CH + 8 * wave + rr - 2; const bool ok_ = (sp_ >= 0 && sp_ < SEQ); \
            const GAS bf16* src_ = P + (size_t)(b_ * SEQ + (ok_ ? sp_ : 0)) * 1536 + h_ * 128 + 2 * lane; \
            _Pragma("unroll") for (int p = 0; p < 3; ++p) { const unsigned u_ = *(const GAS unsigned*)(src_ + p * 512); praw[rr][p] = ok_ ? u_ : 0u; } } \
        if (wave < 2) { const int ti_ = wave ? 63 - lane : lane; const int t0_ = b_ * SEQ + n_ * CH; pga = SG[(size_t)(t0_ + ti_) * 32 + wave * 4 + h_]; pgb = SG[(size_t)(t0_ + ti_) * 32 + 8 + wave * 4 + h_]; } } while (0)
    DN_PF(F.wg);
    for (int item = F.wg; item < NB * NHEAD * NCH; item += F.G) {
        const int b = item >> 9, h = (item >> 7) & 3, n = item & 127;
        const int t0 = b * SEQ + n * CH;
        for (int repA = 0; repA < DNREP_A; ++repA) {
        {
            float w[3][5][2];
#pragma unroll
            for (int p = 0; p < 3; ++p)
#pragma unroll
                for (int j = 0; j < 5; ++j) { const f32x2 t = *(const GAS f32x2*)(cw + j * 1536 + p * 512 + h * 128 + 2 * lane); w[p][j][0] = t.x; w[p][j][1] = t.y; }
            f32x2 ya[8][3];
#pragma unroll
            for (int ii = 0; ii < 8; ++ii)
#pragma unroll
                for (int p = 0; p < 3; ++p) ya[ii][p] = (f32x2){0.f, 0.f};
#pragma unroll
            for (int rr = 0; rr < 12; ++rr) {
                f32x2 xs[3];
#pragma unroll
                for (int p = 0; p < 3; ++p) { const unsigned u = praw[rr][p]; xs[p] = (f32x2){bf2f(u & 0xffffu), __uint_as_float(u & 0xffff0000u)}; }
#pragma unroll
                for (int j = 0; j < 5; ++j) { const int ii = rr - j;
                    if (ii >= 0 && ii < 8) {
#pragma unroll
                        for (int p = 0; p < 3; ++p) ya[ii][p] += xs[p] * (f32x2){w[p][j][0], w[p][j][1]}; } }
            }
#pragma unroll
            for (int ii = 0; ii < 8; ++ii) {
                const int i = 8 * wave + ii;
                float y[3][2];
#pragma unroll
                for (int p = 0; p < 3; ++p) { y[p][0] = ya[ii][p].x * fast_sigmoid(ya[ii][p].x); y[p][1] = ya[ii][p].y * fast_sigmoid(ya[ii][p].y); }
                const float sq = wave_sum(y[0][0] * y[0][0] + y[0][1] * y[0][1]), sk = wave_sum(y[1][0] * y[1][0] + y[1][1] * y[1][1]);
                const float rq = __builtin_amdgcn_rsqf(sq + NORM_EPS) * 0.08838834764831845f, rk = __builtin_amdgcn_rsqf(sk + NORM_EPS);
                *(LAS unsigned*)(L + DQ_OFF + i * QROW + 4 * lane) = cvt_pk_bf16(y[0][0] * rq, y[0][1] * rq);
                *(LAS unsigned*)(L + DK_OFF + i * QROW + 4 * lane) = cvt_pk_bf16(y[1][0] * rk, y[1][1] * rk);
                *(LAS unsigned*)(L + DV_OFF + i * QROW + 4 * lane) = cvt_pk_bf16(y[2][0], y[2][1]);
            }
            if (wave < 2) {
                const int d = wave; const int ti = d ? 63 - lane : lane;
                const float a = pga, bb = pgb;
                const float beta = sigmoidf_(bb);
                const float g = -expf(inp(F, I_A_LOG)[l * 8 + d * 4 + h]) * softplusf_(a + inp(F, I_DT_BIAS)[l * 8 + d * 4 + h]);
                const float gc = wave_incl_scan(g, lane);
                const float gl = __shfl(gc, 63);
                LAS float* vec = (LAS float*)(L + DVEC_OFF + d * 1024);
                vec[lane] = beta; vec[64 + lane] = gc; vec[128 + lane] = expf(gc); vec[192 + lane] = expf(gl - gc);
                if (lane == 63) ((GAS float*)(F.ws + WS_GL))[(size_t)item * 2 + d] = expf(gc);
            }
        }
        PREP_BAR();
        DSTAMP(0);
        }
        for (int repB = 0; repB < DNREP_B; ++repB) {
        {
#pragma unroll
            for (int tt = 0; tt < 2; ++tt) {
                const int t = 2 * wave + tt, mt = t >> 2, nt = t & 3;
                f32x4 ag = (f32x4){0.f, 0.f, 0.f, 0.f}, aq = (f32x4){0.f, 0.f, 0.f, 0.f};
#pragma unroll
                for (int s = 0; s < 4; ++s) {
                    const bf16x8 ka = *(const LAS bf16x8*)(L + DK_OFF + (16 * mt + fr) * QROW + 64 * s + 16 * fq);
                    const bf16x8 qa = *(const LAS bf16x8*)(L + DQ_OFF + (16 * mt + fr) * QROW + 64 * s + 16 * fq);
                    const bf16x8 kb = *(const LAS bf16x8*)(L + DK_OFF + (16 * nt + fr) * QROW + 64 * s + 16 * fq);
                    ag = __builtin_amdgcn_mfma_f32_16x16x32_bf16(ka, kb, ag, 0, 0, 0);
                    aq = __builtin_amdgcn_mfma_f32_16x16x32_bf16(qa, kb, aq, 0, 0, 0);
                }
#pragma unroll
                for (int r = 0; r < 4; ++r) { GM[(16 * mt + 4 * fq + r) * FROW + 16 * nt + fr] = ag[r]; QKM[(16 * mt + 4 * fq + r) * FROW + 16 * nt + fr] = aq[r]; }
            }
        }
        PREP_BAR();
        DSTAMP(1);
        }
        for (int repC = 0; repC < DNREP_C; ++repC) {
        {
#pragma unroll 4
            for (int e = 0; e < 16; ++e) {
                const int idx = tid + 512 * e, d = idx >> 12, i = (idx >> 6) & 63, j = idx & 63;
                const LAS float* vec = (const LAS float*)(L + DVEC_OFF + d * 1024);
                const int ti = d ? 63 - i : i, tj = d ? 63 - j : j;
                float v = (j < i) ? vec[i] * GM[ti * FROW + tj] * fexp(fminf(vec[64 + i] - vec[64 + j], 0.f)) : 0.f;
                if ((i & 31) == 0 && j >= (i & 32)) v = (j == i) ? 1.f : 0.f;
                *(LAS float*)(L + DTM_OFF + d * 17408 + (i * FROW + j) * 4) = v;
            }
        }
        PREP_BAR();
        DSTAMP(2);
        if (wave < 4) {
            const int d = wave >> 1, hb = wave & 1, c = lane & 31;
            LAS float* TM = (LAS float*)(L + DTM_OFF + d * 17408) + (32 * hb) * FROW + 32 * hb;
#define SUBST_PART(NB4, BASE) do { f32x4 m4[NB4]; float tv_[4 * NB4]; \
                _Pragma("unroll") for (int q = 0; q < NB4; ++q) m4[q] = *(const LAS f32x4*)(TM + i * FROW + (BASE) + 4 * q); \
                _Pragma("unroll") for (int q = 0; q < 4 * NB4; ++q) tv_[q] = TM[((BASE) + q) * FROW + c]; \
                _Pragma("unroll") for (int q = 0; q < NB4; ++q) { a0 -= m4[q][0] * tv_[4 * q]; a1 -= m4[q][1] * tv_[4 * q + 1]; a2 -= m4[q][2] * tv_[4 * q + 2]; a3 -= m4[q][3] * tv_[4 * q + 3]; } } while (0)
#define SUBST_END() do { const float tv = ((c == i) ? 1.f : 0.f) + ((a0 + a1) + (a2 + a3)); asm volatile("s_waitcnt lgkmcnt(0)" ::: "memory"); TM[i * FROW + c] = tv; } while (0)
#pragma unroll 1
            for (int i = 1; i < 16; ++i) { float a0 = 0.f, a1 = 0.f, a2 = 0.f, a3 = 0.f; SUBST_PART(4, 0); SUBST_END(); }
#pragma unroll 1
            for (int i = 16; i < 32; ++i) { float a0 = 0.f, a1 = 0.f, a2 = 0.f, a3 = 0.f; SUBST_PART(4, 0); asm volatile("" ::: "memory"); SUBST_PART(4, 16); SUBST_END(); }
#undef SUBST_PART
#undef SUBST_END
        } else {
            const int tw = wave - 4;
#pragma unroll 4
            for (int it = tw; it < 128; it += 4) {
                const int d = it >> 6, i = it & 63, ti = d ? 63 - i : i;
                const LAS float* vec = (const LAS float*)(L + DVEC_OFF + d * 1024);
                GAS unsigned char* rec = F.ws + WS_R2 + ((size_t)item * 2 + d) * DNREC;
                { const int p = 2 * lane; const int kk = (p & ~31) + sigma32(p & 31);
                  const unsigned u = *(const LAS unsigned*)(L + DQ_OFF + ti * QROW + 2 * kk); const float e = vec[128 + i];
                  *(GAS unsigned*)(rec + DN_QG + (i * 128 + p) * 2) = cvt_pk_bf16(bf2f(u & 0xffffu) * e, bf2f(u >> 16) * e); }
                { const int p = lane; const int j = (p & ~31) + sigma32(p & 31), tj = d ? 63 - j : j;
                  const float v = (j <= i) ? QKM[ti * FROW + tj] * fexp(fminf(vec[64 + i] - vec[64 + j], 0.f)) : 0.f;
                  ((GAS bf16*)(rec + DN_ATT))[i * 64 + p] = bf1(v); }
            }
#pragma unroll 4
            for (int it = tw; it < 128; it += 4) {
                const int d = it >> 6, kk = 2 * (it & 63);
                const LAS float* vec = (const LAS float*)(L + DVEC_OFF + d * 1024);
                GAS bf16* Kd = (GAS bf16*)(F.ws + WS_R2 + ((size_t)item * 2 + d) * DNREC + DN_KDT);
                const int p = lane; const int j = (p & ~31) + sigma32(p & 31), tj = d ? 63 - j : j;
                const unsigned u = *(const LAS unsigned*)(L + DK_OFF + tj * QROW + 2 * kk); const float e = vec[192 + j];
                Kd[kk * 64 + p] = bf1(bf2f(u & 0xffffu) * e); Kd[(kk + 1) * 64 + p] = bf1(bf2f(u >> 16) * e);
            }
        }
        PREP_BAR();
        DSTAMP(3);
        if (wave < 2) {
            LAS float* TM = (LAS float*)(L + DTM_OFF + wave * 17408);
            bf16x8 am[2], bt[2];
#pragma unroll
            for (int mt = 0; mt < 2; ++mt) { const f32x4 lo = *(const LAS f32x4*)(TM + (32 + 16 * mt + fr) * FROW + 8 * fq), hi = *(const LAS f32x4*)(TM + (32 + 16 * mt + fr) * FROW + 8 * fq + 4); am[mt] = pack_b(lo, hi); }
#pragma unroll
            for (int nt = 0; nt < 2; ++nt) { float xf[8];
#pragma unroll
                for (int e = 0; e < 8; ++e) xf[e] = TM[(8 * fq + e) * FROW + 16 * nt + fr];
                bt[nt] = pack8f(xf); }
            f32x4 X[2][2];
#pragma unroll
            for (int mt = 0; mt < 2; ++mt)
#pragma unroll
                for (int nt = 0; nt < 2; ++nt) X[mt][nt] = __builtin_amdgcn_mfma_f32_16x16x32_bf16(am[mt], bt[nt], (f32x4){0.f, 0.f, 0.f, 0.f}, 0, 0, 0);
            bf16x8 xb[2], a2[2];
#pragma unroll
            for (int nt = 0; nt < 2; ++nt) xb[nt] = pack_b(X[0][nt], X[1][nt]);
#pragma unroll
            for (int mt = 0; mt < 2; ++mt) { const f32x4 lo = *(const LAS f32x4*)(TM + (32 + 16 * mt + fr) * FROW + 32 + 4 * fq), hi = *(const LAS f32x4*)(TM + (32 + 16 * mt + fr) * FROW + 32 + 16 + 4 * fq); a2[mt] = pack_b(lo, hi); }
#pragma unroll
            for (int mt = 0; mt < 2; ++mt)
#pragma unroll
                for (int nt = 0; nt < 2; ++nt) { const f32x4 t21 = __builtin_amdgcn_mfma_f32_16x16x32_bf16(a2[mt], xb[nt], (f32x4){0.f, 0.f, 0.f, 0.f}, 0, 0, 0);
#pragma unroll
                    for (int r = 0; r < 4; ++r) TM[(32 + 16 * mt + 4 * fq + r) * FROW + 16 * nt + fr] = -t21[r]; }
        }
        PREP_BAR();
        DSTAMP(4);
        }
        DN_PF(item + F.G);
        for (int repD = 0; repD < DNREP_D; ++repD) {
#pragma unroll 1
        for (int d = 0; d < 2; ++d) {
            const LAS float* TM = (const LAS float*)(L + DTM_OFF + d * 17408);
            const LAS float* vec = (const LAS float*)(L + DVEC_OFF + d * 1024);
            GAS unsigned char* rec = F.ws + WS_R2 + ((size_t)item * 2 + d) * DNREC;
            bf16x8 ta[4][2];
#pragma unroll
            for (int mt = 0; mt < 4; ++mt)
#pragma unroll
                for (int s = 0; s < 2; ++s) { const f32x4 lo = *(const LAS f32x4*)(TM + (16 * mt + fr) * FROW + 32 * s + 8 * fq), hi = *(const LAS f32x4*)(TM + (16 * mt + fr) * FROW + 32 * s + 8 * fq + 4); ta[mt][s] = pack_b(lo, hi); }
#pragma unroll 1
            for (int tt = 0; tt < 2; ++tt) {
                const int nt = 2 * wave + tt; const bool isv = nt < 8; const int col = 16 * (nt & 7) + fr;
                const int imgoff = isv ? DV_OFF : DK_OFF;
                bf16x8 xb[2];
#pragma unroll
                for (int s = 0; s < 2; ++s) { float xf[8];
#pragma unroll
                    for (int e = 0; e < 8; ++e) { const int j = 32 * s + 8 * fq + e, tj = d ? 63 - j : j;
                        const float x = bf2f(*(const LAS unsigned short*)(L + imgoff + tj * QROW + 2 * col));
                        xf[e] = x * vec[j] * (isv ? 1.f : vec[128 + j]); }
                    xb[s] = pack8f(xf); }
                f32x4 acc[4];
#pragma unroll
                for (int mt = 0; mt < 4; ++mt) { acc[mt] = (f32x4){0.f, 0.f, 0.f, 0.f};
#pragma unroll
                    for (int s = 0; s < 2; ++s) acc[mt] = __builtin_amdgcn_mfma_f32_16x16x32_bf16(ta[mt][s], xb[s], acc[mt], 0, 0, 0); }
                if (isv) {
                    GAS bf16* Uf = (GAS bf16*)(rec + DN_UF) + ((nt * 64 + lane) * 16);
#pragma unroll
                    for (int mt = 0; mt < 4; ++mt) { u32x2 w2; w2.x = cvt_pk_bf16(acc[mt][0], acc[mt][1]); w2.y = cvt_pk_bf16(acc[mt][2], acc[mt][3]); *(GAS u32x2*)(Uf + mt * 4) = w2; }
                } else {
                    GAS bf16* Wp = (GAS bf16*)(rec + DN_W); const int pos = (col & ~31) + invsigma32(col & 31);
#pragma unroll
                    for (int mt = 0; mt < 4; ++mt)
#pragma unroll
                        for (int r = 0; r < 4; ++r) Wp[(16 * mt + 4 * fq + r) * 128 + pos] = bf1(acc[mt][r]);
                }
            }
        }
        PREP_BAR();
        DSTAMP(5);
        }
    }
#ifdef DIAG
    if (F.tid == 0 && F.wg == 0 && l == 0) { for (int k = 0; k < 6; ++k) ((GAS unsigned long long*)(F.ws + WS_CTL + 1024))[48 + k] = tacc[k]; }
#endif
}

__device__ __forceinline__ int swz256(int row, int c16) { return row * 256 + ((c16 ^ (row & 15)) << 4); }
__device__ __forceinline__ int swz128(int row, int c8) { return (row >> 1) * 256 + (((((row & 1) << 3) | c8) ^ ((row >> 1) & 15)) << 4); }
constexpr int DNBUF = 57344;
#define SCAN_BAR() do { asm volatile("s_waitcnt lgkmcnt(0)" ::: "memory"); __builtin_amdgcn_s_barrier(); asm volatile("" ::: "memory"); } while (0)
__device__ __forceinline__ void dn_scan(const Frame& F) {
    if (F.wg >= 128) return;
    const int xcd = F.wg & 7, idx = F.wg >> 3;
    const int chain = xcd * 4 + (idx >> 2), qtr = idx & 3;
    const int b = chain >> 3, h = (chain >> 1) & 3, d = chain & 1;
    const int lane = F.lane, fr = lane & 15, fq = lane >> 4, wave = F.wave;
    LAS unsigned char* L = F.lds;
    const GAS unsigned char* recbase = F.ws + WS_R2;
    const int itembase = (b * NHEAD + h) * NCH;
    if (wave >= 2) {
        const int tl = F.tid - 128;
        u32x4 ra[10], rb[10];
        int woff[10];
#pragma unroll
        for (int i = 0; i < 10; ++i) { const int q = tl + 384 * i;
            if (q < 1024) woff[i] = swz256(q >> 4, q & 15); else if (q < 2048) woff[i] = 16384 + swz256((q - 1024) >> 4, q & 15);
            else if (q < 3072) woff[i] = 32768 + swz128((q - 2048) >> 3, q & 7); else if (q < 3584) woff[i] = 49152 + swz128((q - 3072) >> 3, q & 7); else woff[i] = -1; }
#define DN_LOAD(R, step_) do { const int st_ = (step_) < NCH ? (step_) : NCH - 1; const int n_ = d ? (NCH - 1 - st_) : st_; \
        const GAS u32x4* src_ = (const GAS u32x4*)(recbase + ((size_t)(itembase + n_) * 2 + d) * DNREC) + tl; \
        _Pragma("unroll") for (int i = 0; i < 10; ++i) R[i] = src_[(woff[i] >= 0) ? 384 * i : 0]; } while (0)
#define DN_WRITE(R, bufoff_) do { _Pragma("unroll") for (int i = 0; i < 10; ++i) if (woff[i] >= 0) *(LAS u32x4*)(L + (bufoff_) + woff[i]) = R[i]; } while (0)
        u32x4 rc[10];
        DN_LOAD(ra, 0); DN_LOAD(rb, 1); DN_LOAD(rc, 2);
        DN_WRITE(ra, 0);
        SCAN_BAR();
        for (int s = 0; s < 126; s += 6) {
            DN_LOAD(ra, s + 3); DN_WRITE(rb, DNBUF); SCAN_BAR();
            DN_LOAD(rb, s + 4); DN_WRITE(rc, 0);     SCAN_BAR();
            DN_LOAD(rc, s + 5); DN_WRITE(ra, DNBUF); SCAN_BAR();
            DN_LOAD(ra, s + 6); DN_WRITE(rb, 0);     SCAN_BAR();
            DN_LOAD(rb, s + 7); DN_WRITE(rc, DNBUF); SCAN_BAR();
            DN_LOAD(rc, s + 8); DN_WRITE(ra, 0);     SCAN_BAR();
        }
        DN_WRITE(rb, DNBUF); SCAN_BAR();
        SCAN_BAR();
#undef DN_LOAD
#undef DN_WRITE
        return;
    }
    const int slice = qtr * 2 + wave;
    const GAS float* GL = (const GAS float*)(F.ws + WS_GL);
    GAS bf16* O = (GAS bf16*)(F.ws + (d ? WS_OB : WS_OF));
    f32x4 S[8];
#pragma unroll
    for (int k = 0; k < 8; ++k) S[k] = (f32x4){0.f, 0.f, 0.f, 0.f};
    int offw[4], offk[8], offa[4];
#pragma unroll
    for (int t = 0; t < 4; ++t) { offw[t] = (16 * t + fr) * 256; offa[t] = ((16 * t + fr) >> 1) * 256; }
#pragma unroll
    for (int t = 0; t < 8; ++t) offk[t] = ((16 * t + fr) >> 1) * 256;
    const int x256 = fr & 15;
    const int x128 = (fr >> 1) & 15, p128 = (fr & 1) << 3;
    u32x4 uc0, uc1, un0, un1; float egl_c, egl_n;
    int vz = 0; asm volatile("" : "+v"(vz));
#define DN_UFETCH(A0, A1, EG, step_) do { const int st_ = (step_) < NCH ? (step_) : NCH - 1; const int nn_ = d ? (NCH - 1 - st_) : st_; \
        const GAS bf16* Uf_ = (const GAS bf16*)(recbase + ((size_t)(itembase + nn_) * 2 + d) * DNREC + DN_UF); A0 = *(const GAS u32x4*)(Uf_ + (slice * 64 + lane) * 16); A1 = *(const GAS u32x4*)(Uf_ + (slice * 64 + lane) * 16 + 8); \
        EG = GL[(size_t)(itembase + nn_) * 2 + d + vz]; } while (0)
    DN_UFETCH(uc0, uc1, egl_c, 0); DN_UFETCH(un0, un1, egl_n, 1);
    SCAN_BAR();
    for (int step = 0; step < NCH; ++step) {
        const int n = d ? (NCH - 1 - step) : step;
        const int bufoff = (step & 1) ? DNBUF : 0;
        const u32x4 u0 = uc0, u1 = uc1; const float egl = egl_c;
        uc0 = un0; uc1 = un1; egl_c = egl_n;
        DN_UFETCH(un0, un1, egl_n, step + 2);
        const LAS unsigned char* Bw = L + bufoff; const LAS unsigned char* Bq = Bw + 16384; const LAS unsigned char* Bk = Bw + 32768; const LAS unsigned char* Ba = Bw + 49152;
#define LD_WQ(G, s_) do { _Pragma("unroll") for (int mt = 0; mt < 4; ++mt) { const int o_ = offw[mt] + (((4 * (s_) + fq) ^ x256) << 4); G[mt] = *(const LAS bf16x8*)(Bw + o_); G[4 + mt] = *(const LAS bf16x8*)(Bq + o_); } } while (0)
#define MM_WQ(G, s_) do { _Pragma("unroll") for (int mt = 0; mt < 4; ++mt) { V[mt] = __builtin_amdgcn_mfma_f32_16x16x32_bf16(G[mt], SB[s_], V[mt], 0, 0, 0); Q[mt] = __builtin_amdgcn_mfma_f32_16x16x32_bf16(SB[s_], G[4 + mt], Q[mt], 0, 0, 0); } } while (0)
#define LD_K(G, s2_) do { _Pragma("unroll") for (int kt = 0; kt < 8; ++kt) { const int xr_ = (8 * kt + (fr >> 1)) & 15; G[kt] = *(const LAS bf16x8*)(Bk + offk[kt] + (((p128 | (4 * (s2_) + fq)) ^ xr_) << 4)); } } while (0)
#define SCHED_() __builtin_amdgcn_sched_barrier(0)
        bf16x8 g0[8], g1[8];
        LD_WQ(g0, 0);
        bf16x8 SB[4];
#pragma unroll
        for (int s = 0; s < 4; ++s) SB[s] = pack_b(S[2 * s], S[2 * s + 1]);
        f32x4 V[4], Q[4];
#pragma unroll
        for (int mt = 0; mt < 4; ++mt) { V[mt] = (f32x4){0.f, 0.f, 0.f, 0.f}; Q[mt] = (f32x4){0.f, 0.f, 0.f, 0.f}; }
        SCHED_(); LD_WQ(g1, 1); SCHED_(); MM_WQ(g0, 0); SCHED_();
        LD_WQ(g0, 2); SCHED_(); MM_WQ(g1, 1); SCHED_();
        LD_WQ(g1, 3); SCHED_(); MM_WQ(g0, 2); SCHED_();
#pragma unroll
        for (int s2 = 0; s2 < 2; ++s2)
#pragma unroll
            for (int mt = 0; mt < 4; ++mt) { const int xr = (8 * mt + (fr >> 1)) & 15; g0[s2 * 4 + mt] = *(const LAS bf16x8*)(Ba + offa[mt] + (((p128 | (4 * s2 + fq)) ^ xr) << 4)); }
        SCHED_(); MM_WQ(g1, 3); SCHED_();
        LD_K(g1, 0); SCHED_();
        {
            float uu[16]; { float t[8]; unpack8(u0, t);
#pragma unroll
                for (int e = 0; e < 8; ++e) uu[e] = t[e]; unpack8(u1, t);
#pragma unroll
                for (int e = 0; e < 8; ++e) uu[8 + e] = t[e]; }
#pragma unroll
            for (int mt = 0; mt < 4; ++mt)
#pragma unroll
                for (int r = 0; r < 4; ++r) V[mt][r] = uu[mt * 4 + r] - V[mt][r];
        }
        bf16x8 VB[2];
#pragma unroll
        for (int s2 = 0; s2 < 2; ++s2) VB[s2] = pack_b(V[2 * s2], V[2 * s2 + 1]);
#pragma unroll
        for (int kt = 0; kt < 8; ++kt) S[kt] = S[kt] * egl;
        SCHED_();
#pragma unroll
        for (int s2 = 0; s2 < 2; ++s2)
#pragma unroll
            for (int mt = 0; mt < 4; ++mt) Q[mt] = __builtin_amdgcn_mfma_f32_16x16x32_bf16(VB[s2], g0[s2 * 4 + mt], Q[mt], 0, 0, 0);
        SCHED_(); LD_K(g0, 1); SCHED_();
#pragma unroll
        for (int kt = 0; kt < 8; ++kt) S[kt] = __builtin_amdgcn_mfma_f32_16x16x32_bf16(g1[kt], VB[0], S[kt], 0, 0, 0);
        SCHED_();
#pragma unroll
        for (int kt = 0; kt < 8; ++kt) S[kt] = __builtin_amdgcn_mfma_f32_16x16x32_bf16(g0[kt], VB[1], S[kt], 0, 0, 0);
        SCHED_();
#undef LD_WQ
#undef MM_WQ
#undef LD_K
#undef SCHED_
#pragma unroll
        for (int mt = 0; mt < 4; ++mt) {
            const int i = 16 * mt + fr; const int tok = b * SEQ + n * CH + (d ? 63 - i : i);
            u32x2 w2; w2.x = cvt_pk_bf16(Q[mt][0], Q[mt][1]); w2.y = cvt_pk_bf16(Q[mt][2], Q[mt][3]);
            *(GAS u32x2*)(O + (size_t)tok * MIXW + h * HD + slice * 16 + 4 * fq) = w2;
        }
        SCAN_BAR();
    }
}

constexpr int MQ_OFF = 0, MK_OFF = 9216, MV_OFF = 18432, MQK_OFF = 35840, MVEC_OFF = 52480;
constexpr int MQROW = 144;
#ifndef MLREP_1
#define MLREP_1 1
#endif
#ifndef MLREP_2
#define MLREP_2 1
#endif
#ifndef MLREP_3
#define MLREP_3 1
#endif
#ifndef MLREP_4
#define MLREP_4 1
#endif
#ifndef POOLREP
#define POOLREP 1
#endif
__device__ __forceinline__ void ml_prep(const Frame& F, int l) {
    LAS unsigned char* L = F.lds;
    const int lane = F.lane, wave = F.wave, tid = F.tid;
    const GAS bf16* PQ = (const GAS bf16*)(F.ws + WS_PMQ); const GAS bf16* PK = (const GAS bf16*)(F.ws + WS_PMK); const GAS bf16* PV = (const GAS bf16*)(F.ws + WS_PMV);
    const GAS float* SG = (const GAS float*)(F.ws + WS_SG);
    const GAS float* gbias = inp(F, I_ML_GATE_B) + l * 16;
    u32x4 pq, pk, pv0, pv1; float pip = 0.f, pfp = 0.f;
#define ML_PF(item_) do { const int it_ = (item_) < NB * NHEAD * NCH ? (item_) : F.wg; const int b_ = it_ >> 9, h_ = (it_ >> 7) & 3, n_ = it_ & 127; const int t0_ = b_ * SEQ + n_ * CH; \
        const int row_ = tid >> 3, c8_ = tid & 7; \
        pq = *(const GAS u32x4*)(PQ + (size_t)(t0_ + row_) * 256 + h_ * 64 + 8 * c8_); pk = *(const GAS u32x4*)(PK + (size_t)(t0_ + row_) * 256 + h_ * 64 + 8 * c8_); \
        pv0 = *(const GAS u32x4*)(PV + (size_t)(t0_ + (tid >> 4)) * 512 + h_ * 128 + 8 * (tid & 15)); pv1 = *(const GAS u32x4*)(PV + (size_t)(t0_ + 32 + (tid >> 4)) * 512 + h_ * 128 + 8 * (tid & 15)); \
        if (wave < 2) { const int ti_ = wave ? 63 - lane : lane; pip = SG[(size_t)(t0_ + ti_) * 32 + 16 + wave * 4 + h_]; pfp = SG[(size_t)(t0_ + ti_) * 32 + 24 + wave * 4 + h_]; } } while (0)
    ML_PF(F.wg);
    for (int item = F.wg; item < NB * NHEAD * NCH; item += F.G) {
        const int b = item >> 9, h = (item >> 7) & 3, n = item & 127;
        const int t0 = b * SEQ + n * CH;
        float ip_raw = pip, fp_raw = pfp;
        for (int rep1 = 0; rep1 < MLREP_1; ++rep1) {
        {
            const int row = tid >> 3, c8 = tid & 7;
            u32x4 k = pk;
            { float f[8]; unpack8(k, f); k.x = cvt_pk_bf16(f[0] * 0.125f, f[1] * 0.125f); k.y = cvt_pk_bf16(f[2] * 0.125f, f[3] * 0.125f); k.z = cvt_pk_bf16(f[4] * 0.125f, f[5] * 0.125f); k.w = cvt_pk_bf16(f[6] * 0.125f, f[7] * 0.125f); }
            *(LAS u32x4*)(L + MQ_OFF + row * MQROW + 16 * c8) = pq;
            *(LAS u32x4*)(L + MK_OFF + row * MQROW + 16 * c8) = k;
            *(LAS u32x4*)(L + MV_OFF + (tid >> 4) * QROW + 16 * (tid & 15)) = pv0;
            *(LAS u32x4*)(L + MV_OFF + (32 + (tid >> 4)) * QROW + 16 * (tid & 15)) = pv1;
            ML_PF(item + F.G);
        }
        PREP_BAR();
        }
        for (int rep2 = 0; rep2 < MLREP_2; ++rep2) {
        {
            const int fr = lane & 15, fq = lane >> 4;
#pragma unroll
            for (int tt = 0; tt < 2; ++tt) {
                const int t = 2 * wave + tt, mt = t >> 2, nt = t & 3;
                f32x4 aq = (f32x4){0.f, 0.f, 0.f, 0.f};
#pragma unroll
                for (int s2 = 0; s2 < 2; ++s2) {
                    const bf16x8 qa = *(const LAS bf16x8*)(L + MQ_OFF + (16 * mt + fr) * MQROW + 64 * s2 + 16 * fq);
                    const bf16x8 kb = *(const LAS bf16x8*)(L + MK_OFF + (16 * nt + fr) * MQROW + 64 * s2 + 16 * fq);
                    aq = __builtin_amdgcn_mfma_f32_16x16x32_bf16(qa, kb, aq, 0, 0, 0);
                }
#pragma unroll
                for (int r = 0; r < 4; ++r) *(LAS float*)(L + MQK_OFF + ((16 * mt + 4 * fq + r) * 65 + 16 * nt + fr) * 4) = aq[r];
            }
        }
        }
        for (int rep3 = 0; rep3 < MLREP_3; ++rep3) {
        if (wave < 2) {
            const int d = wave; const int ti = d ? 63 - lane : lane;
            const float ip = ip_raw + gbias[d * 4 + h];
            const float fp = fp_raw + gbias[8 + d * 4 + h];
            const float bc = wave_incl_scan(logsigmoidf_(fp), lane);
            const float bl = __shfl(bc, 63);
            const float lw = bl - bc + ip;
            const float am = wave_max(lw);
            const float wgt = expf(lw - am);
            const float ipb = ip - bc;
            const float dmax = bc + wave_incl_maxscan(ipb, lane);
            LAS float* vec = (LAS float*)(L + MVEC_OFF + d * 1024);
            vec[lane] = bc; vec[64 + lane] = dmax; vec[128 + lane] = wgt; vec[192 + lane] = ipb;
            GAS float* row = (GAS float*)(F.ws + WS_ML + ((size_t)item * 2 + d) * MLREC + ML_ROW);
            row[lane] = bc; row[64 + lane] = dmax; if (lane == 0) { row[128] = am; row[129] = bl; }
        }
        PREP_BAR();
        }
        for (int rep4 = 0; rep4 < MLREP_4; ++rep4) {
        {
            const LAS float* QKM = (const LAS float*)(L + MQK_OFF);
#pragma unroll 4
            for (int it = wave; it < 128; it += NWAVES) {
                const int d = it >> 6, i = it & 63, j = lane;
                const LAS float* vec = (const LAS float*)(L + MVEC_OFF + d * 1024);
                GAS unsigned char* rec = F.ws + WS_ML + ((size_t)item * 2 + d) * MLREC;
                const int ti = d ? 63 - i : i, tj = d ? 63 - j : j;
                const float sv = (j <= i) ? QKM[ti * 65 + tj] * fexp(fminf(vec[i] + vec[192 + j] - vec[64 + i], 0.f)) : 0.f;
                ((GAS bf16*)(rec + ML_ST))[i * 64 + j] = bf1(sv);
                ((GAS bf16*)(rec + ML_Q))[i * 64 + j] = *(const LAS unsigned short*)(L + MQ_OFF + ti * MQROW + 2 * ((j & ~31) + sigma32(j & 31)));
                const float kv = bf2f(*(const LAS unsigned short*)(L + MK_OFF + tj * MQROW + 2 * i));
                ((GAS bf16*)(rec + ML_KWT))[i * 64 + j] = bf1(kv * vec[128 + j]);
            }
            for (int it = wave; it < 36; it += NWAVES) {
                const int d = it / 18, q = it - 18 * d, slice = q >> 1, s2 = q & 1;
                GAS unsigned char* rec = F.ws + WS_ML + ((size_t)item * 2 + d) * MLREC;
                const int fr = lane & 15, fq = lane >> 4;
                unsigned short e8[8];
#pragma unroll
                for (int el = 0; el < 8; ++el) { const int j = 32 * s2 + 8 * fq + el; const int tj = d ? 63 - j : j;
                    e8[el] = (slice < 8) ? *(const LAS unsigned short*)(L + MV_OFF + tj * QROW + 2 * (16 * slice + fr)) : (unsigned short)0x3F80; }
                u32x4 w; w.x = e8[0] | ((unsigned)e8[1] << 16); w.y = e8[2] | ((unsigned)e8[3] << 16); w.z = e8[4] | ((unsigned)e8[5] << 16); w.w = e8[6] | ((unsigned)e8[7] << 16);
                *(GAS u32x4*)(rec + ML_VF + (((slice * 2 + s2) * 64 + lane) * 8) * 2) = w;
            }
        }
        PREP_BAR();
        }
    }
}
constexpr int MLBUF = 25600;
__device__ __forceinline__ void ml_scan(const Frame& F) {
    if (F.wg >= 96) return;
    const int xcd = F.wg & 7, idx = F.wg >> 3;
    const int chain = xcd * 4 + idx / 3, third = idx % 3;
    const int b = chain >> 3, h = (chain >> 1) & 3, d = chain & 1;
    const int lane = F.lane, fr = lane & 15, fq = lane >> 4, wave = F.wave;
    LAS unsigned char* L = F.lds;
    const GAS unsigned char* recbase = F.ws + WS_ML;
    const int itembase = (b * NHEAD + h) * NCH;
    if (wave >= 3) {
        const int tl = F.tid - 192;
        u32x4 ra[5], rb[5]; int woff[5], goff[5];
#pragma unroll
        for (int i = 0; i < 5; ++i) { const int q = tl + 320 * i;
            if (q < 1536) { const int qq = q & 511; woff[i] = (q >> 9) * 8192 + swz128(qq >> 3, qq & 7); goff[i] = q; }
            else { woff[i] = 24576 + (q - 1536) * 16; goff[i] = 2688 + (q - 1536); } }
#define ML_LOAD(R, step_) do { const int st_ = (step_) < NCH ? (step_) : NCH - 1; const int n_ = d ? (NCH - 1 - st_) : st_; \
        const GAS u32x4* src_ = (const GAS u32x4*)(recbase + ((size_t)(itembase + n_) * 2 + d) * MLREC); \
        _Pragma("unroll") for (int i = 0; i < 5; ++i) R[i] = src_[goff[i]]; } while (0)
#define ML_WRITE(R, bufoff_) do { _Pragma("unroll") for (int i = 0; i < 5; ++i) *(LAS u32x4*)(L + (bufoff_) + woff[i]) = R[i]; } while (0)
        ML_LOAD(ra, 0); ML_LOAD(rb, 1);
        ML_WRITE(ra, 0);
        SCAN_BAR();
        for (int s = 0; s < NCH; s += 2) {
            ML_LOAD(ra, s + 2); ML_WRITE(rb, MLBUF); SCAN_BAR();
            ML_LOAD(rb, s + 3); ML_WRITE(ra, 0);     SCAN_BAR();
        }
#undef ML_LOAD
#undef ML_WRITE
        return;
    }
    const int slice = third * 3 + wave;
    const bool active = true;
    GAS bf16* NUM = (GAS bf16*)(F.ws + (d ? WS_NUMB : WS_NUMF)); GAS float* DEN = (GAS float*)(F.ws + WS_DEN);
    f32x4 C[4];
#pragma unroll
    for (int k = 0; k < 4; ++k) C[k] = (f32x4){0.f, 0.f, 0.f, 0.f};
    float m = 0.f;
    int offr[4];
#pragma unroll
    for (int t = 0; t < 4; ++t) offr[t] = ((16 * t + fr) >> 1) * 256;
    const int p128 = (fr & 1) << 3;
    bf16x8 vc0, vc1, vn0, vn1;
#define ML_VFETCH(A0, A1, step_) do { const int st_ = (step_) < NCH ? (step_) : NCH - 1; const int nn_ = d ? (NCH - 1 - st_) : st_; \
        const GAS bf16* Vf_ = (const GAS bf16*)(recbase + ((size_t)(itembase + nn_) * 2 + d) * MLREC + ML_VF); \
        A0 = *(const GAS bf16x8*)(Vf_ + ((slice * 2 + 0) * 64 + lane) * 8); A1 = *(const GAS bf16x8*)(Vf_ + ((slice * 2 + 1) * 64 + lane) * 8); } while (0)
    ML_VFETCH(vc0, vc1, 0); ML_VFETCH(vn0, vn1, 1);
    SCAN_BAR();
    for (int step = 0; step < NCH; ++step) {
        const int n = d ? (NCH - 1 - step) : step;
        const int bufoff = (step & 1) ? MLBUF : 0;
        bf16x8 VF[2]; VF[0] = vc0; VF[1] = vc1;
        vc0 = vn0; vc1 = vn1;
        ML_VFETCH(vn0, vn1, step + 2);
        if (active) {
        const LAS unsigned char* Bq = L + bufoff; const LAS unsigned char* Bs = Bq + 8192; const LAS unsigned char* Bk = Bq + 16384; const LAS float* row = (const LAS float*)(Bq + 24576);
        const float am = row[128], bl = row[129];
        bf16x8 CB[2];
#pragma unroll
        for (int s = 0; s < 2; ++s) CB[s] = pack_b(C[2 * s], C[2 * s + 1]);
        bf16x8 fq_[8], fs_[8], fk_[8];
#pragma unroll
        for (int s = 0; s < 2; ++s)
#pragma unroll
            for (int mt = 0; mt < 4; ++mt) { const int xr = (8 * mt + (fr >> 1)) & 15; const int o = offr[mt] + (((p128 | (4 * s + fq)) ^ xr) << 4);
                fq_[s * 4 + mt] = *(const LAS bf16x8*)(Bq + o); fs_[s * 4 + mt] = *(const LAS bf16x8*)(Bs + o); fk_[s * 4 + mt] = *(const LAS bf16x8*)(Bk + o); }
        f32x4 QC[4], SV[4], KV[4];
#pragma unroll
        for (int mt = 0; mt < 4; ++mt) { QC[mt] = (f32x4){0.f, 0.f, 0.f, 0.f}; SV[mt] = (f32x4){0.f, 0.f, 0.f, 0.f}; KV[mt] = (f32x4){0.f, 0.f, 0.f, 0.f}; }
#pragma unroll
        for (int s = 0; s < 2; ++s)
#pragma unroll
            for (int mt = 0; mt < 4; ++mt) {
                QC[mt] = __builtin_amdgcn_mfma_f32_16x16x32_bf16(CB[s], fq_[s * 4 + mt], QC[mt], 0, 0, 0);
                SV[mt] = __builtin_amdgcn_mfma_f32_16x16x32_bf16(VF[s], fs_[s * 4 + mt], SV[mt], 0, 0, 0);
                KV[mt] = __builtin_amdgcn_mfma_f32_16x16x32_bf16(fk_[s * 4 + mt], VF[s], KV[mt], 0, 0, 0);
            }
#pragma unroll
        for (int mt = 0; mt < 4; ++mt) {
            const int i = 16 * mt + fr; const int tok = b * SEQ + n * CH + (d ? 63 - i : i);
            const float bci = row[i], dmi = row[64 + i];
            const float il = bci + m, mo = fmaxf(il, dmi);
            const float inter = fexp(il - mo), e2 = fexp(dmi - mo);
            const f32x4 res = QC[mt] * inter + SV[mt] * e2;
            if (slice < 8) { u32x2 w2; w2.x = cvt_pk_bf16(res[0], res[1]); w2.y = cvt_pk_bf16(res[2], res[3]); *(GAS u32x2*)(NUM + (size_t)tok * MIXW + h * HD + slice * 16 + 4 * fq) = w2; }
            else if (fq == 0) DEN[(size_t)tok * 8 + h * 2 + d] = fmaxf(fabsf(res[0]), fexp(-mo));
        }
        const float mn = fmaxf(bl + m, am), sp = fexp(bl + m - mn), sc = fexp(am - mn);
#pragma unroll
        for (int kt = 0; kt < 4; ++kt) C[kt] = C[kt] * sp + KV[kt] * sc;
        m = mn;
        }
        SCAN_BAR();
    }
}

template <int H>
__device__ __forceinline__ void pool_block(const GAS bf16* U, GAS bf16* Y, int t0, int g, int lane) {
    constexpr int NR = 32 + 2 * H;
    const int sp0 = t0 & (SEQ - 1);
    float x0[NR], x1[NR];
#pragma unroll
    for (int r = 0; r < NR; ++r) {
        const int sp = sp0 - H + r; const bool ok = (sp >= 0 && sp < SEQ);
        const unsigned u = ok ? *(const GAS unsigned*)(U + (size_t)(t0 - H + r) * MIXW + 128 * g + 2 * lane) : 0u;
        x0[r] = bf2f(u & 0xffffu); x1[r] = bf2f(u >> 16);
    }
    float s0 = 0.f, s1 = 0.f;
#pragma unroll
    for (int r = 0; r < 2 * H; ++r) { s0 += x0[r]; s1 += x1[r]; }
#pragma unroll
    for (int t = 0; t < 32; ++t) {
        const int sp = sp0 + t; const int cnt = min(sp + H, SEQ) - max(sp - H, 0);
        const float inv = 1.0f / (float)cnt;
        *(GAS unsigned*)(Y + (size_t)(t0 + t) * MIXW + 128 * g + 2 * lane) = cvt_pk_bf16(s0 * inv - x0[t + H], s1 * inv - x1[t + H]);
        if (t < 31) { s0 += x0[t + 2 * H] - x0[t]; s1 += x1[t + 2 * H] - x1[t]; }
    }
}
__device__ __forceinline__ void pool_phase(const Frame& F) {
    const GAS bf16* U = (const GAS bf16*)(F.ws + WS_PPOOL); GAS bf16* Y = (GAS bf16*)(F.ws + WS_YP);
    const int gw = F.wg * NWAVES + F.wave, NGW = F.G * NWAVES, lane = F.lane;
    for (int prep = 0; prep < POOLREP; ++prep)
    for (int task = gw; task < (T / 32) * 4; task += NGW) {
        const int g = task & 3, t0 = (task >> 2) * 32;
        if (g == 0) pool_block<1>(U, Y, t0, g, lane); else if (g == 1) pool_block<2>(U, Y, t0, g, lane); else if (g == 2) pool_block<4>(U, Y, t0, g, lane); else pool_block<8>(U, Y, t0, g, lane);
    }
}

__device__ __forceinline__ void norm_phase(const Frame& F, int l, bool dummy, const int which, const int wg0, const int nwg) {
    const GAS bf16* OF = (const GAS bf16*)(F.ws + WS_OF); const GAS bf16* OB = (const GAS bf16*)(F.ws + WS_OB);
    const GAS bf16* NF = (const GAS bf16*)(F.ws + WS_NUMF); const GAS bf16* NBk = (const GAS bf16*)(F.ws + WS_NUMB); const GAS float* DEN = (const GAS float*)(F.ws + WS_DEN);
    GAS bf16* Z = (GAS bf16*)(F.ws + WS_PZ); GAS bf16* MO = (GAS bf16*)(F.ws + WS_PMO);
    GAS bf16* ZO = dummy ? (GAS bf16*)(F.ws + WS_GATE) : Z; GAS bf16* MOO = dummy ? (GAS bf16*)(F.ws + WS_GATE + 32 * MiB) : MO;
    const int gw = (F.wg - wg0) * NWAVES + F.wave, NGW = nwg * NWAVES, lane = F.lane, h = lane >> 4;
    float nw[8], mw[8];
#pragma unroll
    for (int e = 0; e < 8; ++e) { nw[e] = inp(F, I_DN_NORM)[l * MIXW + 8 * lane + e]; mw[e] = inp(F, I_ML_NORM)[l * MIXW + 8 * lane + e]; }
    for (int t = gw; t < T; t += NGW) {
        const size_t off = (size_t)t * MIXW + 8 * lane;
        if (which != 2) {
            float a[8], bq[8], z[8]; unpack8(*(const GAS u32x4*)(OF + off), a); unpack8(*(const GAS u32x4*)(OB + off), bq); unpack8(*(const GAS u32x4*)(Z + off), z);
            float ss = 0.f;
#pragma unroll
            for (int e = 0; e < 8; ++e) { a[e] += bq[e]; ss += a[e] * a[e]; }
            ss += __shfl_xor(ss, 1); ss += __shfl_xor(ss, 2); ss += __shfl_xor(ss, 4); ss += __shfl_xor(ss, 8);
            const float r = 1.0f / sqrtf(ss * (1.f / HD) + NORM_EPS);
            float o[8];
#pragma unroll
            for (int e = 0; e < 8; ++e) o[e] = a[e] * r * nw[e] * siluf_(z[e]);
            u32x4 w; w.x = cvt_pk_bf16(o[0], o[1]); w.y = cvt_pk_bf16(o[2], o[3]); w.z = cvt_pk_bf16(o[4], o[5]); w.w = cvt_pk_bf16(o[6], o[7]);
            *(GAS u32x4*)(ZO + off) = w;
        }
        if (which != 1) {
            float a[8], bq[8], g[8]; unpack8(*(const GAS u32x4*)(NF + off), a); unpack8(*(const GAS u32x4*)(NBk + off), bq); unpack8(*(const GAS u32x4*)(MO + off), g);
            const float df = 1.0f / DEN[(size_t)t * 8 + h * 2], db = 1.0f / DEN[(size_t)t * 8 + h * 2 + 1];
            float s = 0.f;
#pragma unroll
            for (int e = 0; e < 8; ++e) { a[e] = a[e] * df + bq[e] * db; s += a[e]; }
            s += __shfl_xor(s, 1); s += __shfl_xor(s, 2); s += __shfl_xor(s, 4); s += __shfl_xor(s, 8);
            const float mean = s * (1.f / HD); float ss = 0.f;
#pragma unroll
            for (int e = 0; e < 8; ++e) { a[e] -= mean; ss += a[e] * a[e]; }
            ss += __shfl_xor(ss, 1); ss += __shfl_xor(ss, 2); ss += __shfl_xor(ss, 4); ss += __shfl_xor(ss, 8);
            const float r = 1.0f / sqrtf(ss * (1.f / HD) + NORM_EPS);
            float o[8];
#pragma unroll
            for (int e = 0; e < 8; ++e) o[e] = a[e] * r * mw[e] * sigmoidf_(g[e]);
            u32x4 w; w.x = cvt_pk_bf16(o[0], o[1]); w.y = cvt_pk_bf16(o[2], o[3]); w.z = cvt_pk_bf16(o[4], o[5]); w.w = cvt_pk_bf16(o[6], o[7]);
            *(GAS u32x4*)(MOO + off) = w;
        }
    }
}

__device__ __forceinline__ void moe_tables(const Frame& F) {
    LAS int* cnt = (LAS int*)(F.lds + LHIST_OFF + 128); LAS int* pstart = (LAS int*)(F.lds + LHIST_OFF + 256); LAS int* mybase = (LAS int*)(F.lds + LHIST_OFF + 384);
    LAS int* pe = (LAS int*)(F.lds + LPE_OFF);
    const GAS int* hist = (const GAS int*)(F.ws + WS_HIST);
    if (F.tid < 32) { cnt[F.tid] = 0; mybase[F.tid] = 0; }
    __syncthreads();
    { const int e = F.tid & 31, part = F.tid >> 5; int tot = 0, base = 0;
      for (int q = 0; q < 16; ++q) { const int w = part * 16 + q; const int v = hist[w * 32 + e]; tot += v; base += v * min(max(F.wg - w, 0), 1); }
      __hip_atomic_fetch_add(cnt + e, tot, __ATOMIC_RELAXED, __HIP_MEMORY_SCOPE_WORKGROUP); __hip_atomic_fetch_add(mybase + e, base, __ATOMIC_RELAXED, __HIP_MEMORY_SCOPE_WORKGROUP); }
    __syncthreads();
    if (F.tid == 0) { int acc = 0, p = 0; for (int e = 0; e < NEXP; ++e) { pstart[e] = acc; const int np = (cnt[e] + 255) >> 8; for (int q = 0; q < np; ++q) pe[p++] = e; acc += np * 256; } pe[319] = p; }
    __syncthreads();
}
__device__ __forceinline__ void moe_dispatch(const Frame& F) {
    moe_tables(F);
    LAS int* pstart = (LAS int*)(F.lds + LHIST_OFF + 256); LAS int* mybase = (LAS int*)(F.lds + LHIST_OFF + 384);
    LAS int* lpos = (LAS int*)(F.lds);
    LAS int* le = (LAS int*)(F.lds + 1024);
    const GAS int* eid = (const GAS int*)(F.ws + WS_EID); const GAS float* ew = (const GAS float*)(F.ws + WS_EW);
    GAS int* pos = (GAS int*)(F.ws + WS_POS); GAS float* roww = (GAS float*)(F.ws + WS_ROWW);
    const int rows_per_wg = T / F.G, row0 = F.wg * rows_per_wg;
    int my_e = 0; float my_w = 0.f;
    if (F.tid < 256) { my_e = eid[2 * row0 + F.tid]; my_w = ew[2 * row0 + F.tid]; le[F.tid] = my_e; }
    __syncthreads();
    if (F.tid < 256) {
        int rank = 0;
        for (int a = 0; a < F.tid; ++a) rank += (le[a] == my_e) ? 1 : 0;
        const int p = pstart[my_e] + mybase[my_e] + rank;
        lpos[F.tid] = p; pos[2 * row0 + F.tid] = p; roww[p] = my_w; ((GAS int*)(F.ws + WS_ROWTOK))[p] = row0 + (F.tid >> 1);
    }
    __syncthreads();
    if (F.wg == 0 && F.tid < 32) { LAS int* cnt = (LAS int*)(F.lds + LHIST_OFF + 128); const int e = F.tid; const int c0 = cnt[e], pc = (c0 + 255) & ~255;
        GAS int* rt = (GAS int*)(F.ws + WS_ROWTOK); for (int q = c0; q < pc; ++q) rt[pstart[e] + q] = 0; }
    __syncthreads();
}

constexpr int NPHASE = 1 + 15 * DEPTH;
#ifndef PHM
#define PHM 0xFFFF
#endif
#define PHON(b) ((PHM >> (b)) & 1)
#ifndef REPEAT_PHASE
#define REPEAT_PHASE -1
#endif
#define NREP(k) (((k) == REPEAT_PHASE) ? 2 : 1)
__global__ void __launch_bounds__(NWAVES * 64, 2) mega_fwd(Args args) {
    extern __shared__ __attribute__((aligned(16))) unsigned char lds_raw[];
    LAS unsigned char* lds = (LAS unsigned char*)lds_raw;
    const int wave = __builtin_amdgcn_readfirstlane((int)threadIdx.x >> 6);
    for (int u = threadIdx.x; u < (LDS_BYTES - RING_BYTES) / 4; u += NWAVES * 64) ((LAS unsigned*)(lds + RING_BYTES))[u] = 0u;
    __syncthreads();
    if (threadIdx.x == 0) { LAS unsigned long long* ap = (LAS unsigned long long*)(lds + LARG_OFF);
#pragma unroll
        for (int i = 0; i < 23; ++i) ap[i] = (unsigned long long)args.in[i];
        ap[23] = (unsigned long long)args.out; ap[24] = (unsigned long long)args.ws; }
    __syncthreads();
    const int lo = args.ph_lo, hi = args.ph_hi;
    if (hi - lo > 1) { const XcdBarrier b0 = xcd_barrier_post((unsigned*)(args.ws + WS_CTL) + CW_BAR, (volatile LAS unsigned*)(lds + MISC_OFF) + 8);
        if (threadIdx.x == 0) ((volatile LAS unsigned*)(lds + MISC_OFF))[10] = b0.x; }
    __syncthreads();
#ifdef DIAG
    if (threadIdx.x == 0 && blockIdx.x == 0 && lo == 0) ((unsigned long long*)(args.ws + WS_CTL + 1024))[0] = __builtin_amdgcn_s_memrealtime();
#endif
    int ph = lo, rep = 0;
#pragma unroll 1
    while (ph < hi) {
        const Frame F = fresh(lds, wave);
        const bool DRY = (REPEAT_PHASE >= 0) && (rep == 0) && (((ph >= 1) ? ((ph - 1) % 15) : 15) == REPEAT_PHASE);
        const int l = (ph >= 1) ? (ph - 1) / 15 : 0;
        const int k = (ph >= 1) ? (ph - 1) - 15 * l : 15;
        if (PHON(15) && k == 15) {
            wprep_mixer(F, 0);
            __syncthreads();
            ln_phase<0>(F, inp(F, I_LN_IN_G), inp(F, I_LN_IN_B), inp(F, I_W_IN), DIN, true, true, DRY);
        } else if (PHON(0) && k == 0) {
            pg8::StaticOrder S; S.init(F.ws + WS_HB, F.ws + WS_WIN, T, 1536, D, F.G, F.wg);
            EpiG1a E{(GAS bf16*)(F.ws + WS_PQKV)};
            pg8::gemm_phase<EpiG1a, pg8::StaticOrder>(F.lds, F.tid, D, S, E);
        } else if (PHON(1) && k == 1) { dn_prep(F, l);
        } else if (PHON(2) && k == 2) { if (F.wg < 128) dn_scan(F); else wprep_moe(F, l, 128, 128);
        } else if (PHON(3) && k == 3) {
            pg8::StaticOrder S; S.init(F.ws + WS_HB, F.ws + WS_WIN + (size_t)1536 * D * 2, T, 2560, D, F.G, F.wg);
            EpiG1b E{F.ws};
            pg8::gemm_phase<EpiG1b, pg8::StaticOrder>(F.lds, F.tid, D, S, E);
        } else if (PHON(4) && k == 4) { pool_phase(F); ml_prep(F, l);
        } else if (PHON(5) && k == 5) { if (F.wg < 96) ml_scan(F); else norm_phase(F, l, false, 1, 96, 160);
        } else if (PHON(6) && k == 6) { norm_phase(F, l, DRY, 2, 0, 256);
        } else if (PHON(7) && k == 7) {
            pg8::StaticOrder S; S.init(F.ws + WS_HB, F.ws + WS_WGATE, T, 3072, D, F.G, F.wg);
            EpiGate E{(GAS bf16*)(F.ws + WS_GATE)};
            pg8::gemm_phase<EpiGate, pg8::StaticOrder>(F.lds, F.tid, D, S, E);
        } else if (PHON(8) && k == 8) {
            MergeOrder S; S.Y[0] = (const GAS char*)(F.ws + WS_PZ); S.Y[1] = (const GAS char*)(F.ws + WS_YP); S.Y[2] = (const GAS char*)(F.ws + WS_PMO); S.W = (const GAS char*)(F.ws + WS_WBR); S.G = F.G; S.c = F.wg;
            EpiMerge E{(const GAS bf16*)(F.ws + WS_GATE), (GAS bf16*)(F.ws + WS_MRGP), (GAS bf16*)(F.ws + WS_FIN)};
            pg8::gemm_phase<EpiMerge, MergeOrder>(F.lds, F.tid, MIXW, S, E);
        } else if (PHON(9) && k == 9) {
            pg8::StaticOrder S; S.init(F.ws + WS_FIN, F.ws + WS_WOUT, T, D, D, F.G, F.wg);
            EpiOut E{(const GAS bf16*)(F.ws + WS_HB), DRY ? (GAS bf16*)(F.ws + WS_R2) : (GAS bf16*)F.out};
            pg8::gemm_phase<EpiOut, pg8::StaticOrder>(F.lds, F.tid, D, S, E);
        } else if (PHON(10) && k == 10) {
            ln_phase<1>(F, inp(F, I_LN_MIX_G) + l * D, inp(F, I_LN_MIX_B) + l * D, inp(F, I_ROUTER_W), 32, true, true, DRY);
        } else if (PHON(11) && k == 11) { moe_dispatch(F);
        } else if (PHON(12) && k == 12) {
            moe_tables(F);
            MoeOrder<D, true> S; S.rowtok = (const GAS int*)(F.ws + WS_ROWTOK); S.A = (const GAS char*)(F.ws + WS_HB); S.W = (const GAS char*)((GAS unsigned char*)F.out + 64 * MiB); S.pe = (const LAS int*)(F.lds + LPE_OFF); S.c = F.wg; S.NP = __builtin_amdgcn_readfirstlane(S.pe[319]);
            EpiMoe1 E{(GAS bf16*)(F.ws + WS_ACT)};
            pg8::gemm_phase<EpiMoe1, MoeOrder<D, true>>(F.lds, F.tid, D, S, E);
        } else if (PHON(13) && k == 13) {
            moe_tables(F);
            MoeOrder<DEXP, false> S; S.rowtok = nullptr; S.A = (const GAS char*)(F.ws + WS_ACT); S.W = (const GAS char*)(F.ws + WS_W2); S.pe = (const LAS int*)(F.lds + LPE_OFF); S.c = F.wg; S.NP = __builtin_amdgcn_readfirstlane(S.pe[319]);
            EpiMoe2 E{(GAS bf16*)(F.ws + WS_YROWS), (const GAS float*)(F.ws + WS_ROWW)};
            pg8::gemm_phase<EpiMoe2, MoeOrder<DEXP, false>>(F.lds, F.tid, DEXP, S, E);
        } else if (PHON(14)) {
            const bool last = (l == DEPTH - 1);
            if (!last) { wprep_mixer(F, l + 1); __syncthreads(); }
            ln_phase<2>(F, inp(F, I_LN_FFN_G) + l * D, inp(F, I_LN_FFN_B) + l * D, inp(F, I_W_IN) + (size_t)(last ? l : l + 1) * D * DIN, DIN, !last, !last, DRY);
        }
        const bool again = (k == REPEAT_PHASE) && (rep == 0);
        if (again) rep = 1; else { rep = 0; ++ph; }
        if (ph < hi) { XcdBarrier bar; bar.bar = (unsigned*)(unsigned char*)(F.ws + WS_CTL) + CW_BAR; bar.st = (volatile LAS unsigned*)(F.lds + MISC_OFF) + 8; bar.x = __builtin_amdgcn_readfirstlane(bar.st[2]); xcd_barrier(bar, F.tid); }
#ifdef DIAG
        if (!again && F.tid == 0 && F.wg == 0) ((unsigned long long*)(F.ws + WS_CTL + 1024))[ph] = __builtin_amdgcn_s_memrealtime();
#endif
    }
}

#ifndef N_LAUNCH_MODE
#define N_LAUNCH_MODE 1
#endif
extern "C" void kernel_launch(void* const* d_in, const int* in_sizes, int n_in, void* d_out, int out_size, void* d_ws, size_t ws_size, hipStream_t stream) {
    static int grid = 0;
    if (grid == 0) {
        if (n_in != 23 || out_size != T * D || ws_size < WS_END) { fprintf(stderr, "kernel_launch: unexpected shapes (n_in %d out %d ws %zu)\n", n_in, out_size, ws_size); grid = -1; return; }
        int dev = 0, cus = 0, per_cu = 0;
        if (hipGetDevice(&dev) != hipSuccess || hipDeviceGetAttribute(&cus, hipDeviceAttributeMultiprocessorCount, dev) != hipSuccess) { grid = -1; return; }
        if (hipFuncSetAttribute((const void*)mega_fwd, hipFuncAttributeMaxDynamicSharedMemorySize, LDS_BYTES) != hipSuccess) { fprintf(stderr, "kernel_launch: hipFuncSetAttribute failed\n"); grid = -1; return; }
        (void)hipOccupancyMaxActiveBlocksPerMultiprocessor(&per_cu, (const void*)mega_fwd, NWAVES * 64, LDS_BYTES);
        (void)hipGetLastError();
        grid = cus;
        if (grid != 256) { fprintf(stderr, "kernel_launch: built for 256 CUs, got %d\n", cus); grid = -1; return; }
    }
    if (grid < 0) return;
    (void)hipMemsetAsync((char*)d_ws + WS_CTL, 0, CTL_ZERO_BYTES, stream);
    Args a{};
    for (int i = 0; i < 23; ++i) a.in[i] = (const float*)d_in[i];
    a.out = (float*)d_out; a.ws = (unsigned char*)d_ws;
#if defined(DIAG) && DIAG >= 100
    {
        a.ph_lo = 0; a.ph_hi = NPHASE;
        hipLaunchKernelGGL(mega_fwd, dim3(grid), dim3(NWAVES * 64), LDS_BYTES, stream, a);
        hipLaunchKernelGGL(diag_fill_t, dim3(1024), dim3(256), 0, stream, (float*)d_out, (unsigned char*)d_ws, out_size, (int)(DIAG - 100));
    }
#elif defined(DIAG)
    {
        const int his[12] = {0, 2, 3, 6, 15, 10, 6, 9, 2, 2, 5, 9};
        const int grids[12] = {0, 64, 2, 2, 16, 64, 64, 64, 64, 64, 64, 64}, blocks[12] = {0, 256, 128, 128, 256, 256, 256, 256, 256, 256, 256, 256};
        a.ph_lo = 0; a.ph_hi = his[DIAG];
        hipLaunchKernelGGL(mega_fwd, dim3(grid), dim3(NWAVES * 64), LDS_BYTES, stream, a);
        static int once = 0; if (!once) { once = 1; (void)hipFuncSetAttribute((const void*)diag_kernel, hipFuncAttributeMaxDynamicSharedMemorySize, 81920); }
        DArgs da{}; for (int i = 0; i < 23; ++i) da.in[i] = (const float*)d_in[i]; da.out = (float*)d_out; da.ws = (unsigned char*)d_ws; da.mode = DIAG; da.pad = 0;
        hipLaunchKernelGGL(diag_kernel, dim3(grids[DIAG]), dim3(blocks[DIAG]), 81920, stream, da);
        if (DIAG == 2 || DIAG == 3) {
            a.ph_lo = his[DIAG]; a.ph_hi = his[DIAG] + 1;
            hipLaunchKernelGGL(mega_fwd, dim3(grid), dim3(NWAVES * 64), LDS_BYTES, stream, a);
            da.mode = DIAG + 10;
            hipLaunchKernelGGL(diag_kernel, dim3(2), dim3(128), 81920, stream, da);
        }
        hipLaunchKernelGGL(diag_fill, dim3(1024), dim3(256), 0, stream, (float*)d_out, (unsigned char*)d_ws, out_size);
    }
#elif N_LAUNCH_MODE == 1
    a.ph_lo = 0; a.ph_hi = NPHASE;
    hipLaunchKernelGGL(mega_fwd, dim3(grid), dim3(NWAVES * 64), LDS_BYTES, stream, a);
#else
    for (int p = 0; p < NPHASE; ++p) { a.ph_lo = p; a.ph_hi = p + 1; hipLaunchKernelGGL(mega_fwd, dim3(grid), dim3(NWAVES * 64), LDS_BYTES, stream, a); }
#endif
}
```

```cpp
#include <hip/hip_runtime.h>
#include <cstdio>
#include <cstdint>

#define LAS __attribute__((address_space(3)))
#define GAS __attribute__((address_space(1)))
typedef unsigned short bf16;
typedef short bf16x8 __attribute__((ext_vector_type(8)));
typedef float f32x4 __attribute__((ext_vector_type(4)));
typedef float f32x2 __attribute__((ext_vector_type(2)));
typedef unsigned u32x4 __attribute__((ext_vector_type(4)));
typedef unsigned u32x2 __attribute__((ext_vector_type(2)));
#define RLX_AGENT __ATOMIC_RELAXED, __HIP_MEMORY_SCOPE_AGENT
#define LDS_WAIT() asm volatile("s_waitcnt lgkmcnt(0)" ::: "memory")
#define VM_WAIT() asm volatile("s_waitcnt vmcnt(0)" ::: "memory")

constexpr int NB = 4, SEQ = 8192, T = NB * SEQ, D = 1024, DEPTH = 2;
constexpr int DIN = 7200;
constexpr int MIXW = 512, NHEAD = 4, HD = 128, CH = 64, NCH = SEQ / CH;
constexpr int MLQK = 64;
constexpr int NEXP = 32, DEXP = 512;
constexpr float LN_EPS = 1e-5f, NORM_EPS = 1e-6f;
constexpr float ALPHA = 1.41421356237309515f;
constexpr int NWAVES = 8;
constexpr int NREC = NB * NHEAD * NCH * 2;

constexpr int C_QKV = 0, C_Z = 1536, C_A = 2048, C_B = 2056, C_POOL = 2064, C_MQ = 2576, C_MK = 2832, C_MV = 3088, C_MO = 3600, C_I = 4112, C_F = 4120, C_GATE = 4128;

constexpr size_t MiB = 1u << 20;
constexpr size_t WS_CTL = 0, CTL_ZERO_BYTES = 64 * 1024;
constexpr int CW_BAR = 4096;
constexpr size_t WS_HIST = 1 * MiB;
constexpr size_t WS_EID = WS_HIST + 64 * 1024;
constexpr size_t WS_EW = WS_EID + 256 * 1024;
constexpr size_t WS_POS = WS_EW + 256 * 1024;
constexpr size_t WS_ROWW = WS_POS + 256 * 1024;
constexpr size_t WS_GL = WS_ROWW + 512 * 1024;
constexpr size_t WS_ROWTOK = 3 * MiB;
constexpr size_t WS_WIN = 4 * MiB;
constexpr size_t WS_WGATE = 12 * MiB;
constexpr size_t WS_WBR = 18 * MiB;
constexpr size_t WS_WOUT = 21 * MiB;
constexpr size_t WS_HB = 24 * MiB;
constexpr size_t WS_SG = 88 * MiB;
constexpr size_t WS_DEN = 92 * MiB;
constexpr size_t WS_R1 = 93 * MiB;
constexpr size_t WS_PQKV = WS_R1;
constexpr size_t WS_OF = WS_R1, WS_OB = WS_R1 + 32 * MiB;
constexpr size_t WS_MRGP = WS_R1;
constexpr size_t WS_W13 = WS_R1, WS_W2 = WS_R1 + 64 * MiB;
constexpr size_t WS_R2 = 189 * MiB;
constexpr size_t DNREC = 73728;
constexpr size_t DN_W = 0, DN_QG = 16384, DN_KDT = 32768, DN_ATT = 49152, DN_UF = 57344;
constexpr size_t WS_PZ = 189 * MiB, WS_PPOOL = 221 * MiB, WS_PMQ = 253 * MiB, WS_PMK = 269 * MiB, WS_PMV = 285 * MiB, WS_PMO = 317 * MiB;
constexpr size_t WS_YP = 349 * MiB;
constexpr size_t WS_NUMF = 253 * MiB, WS_NUMB = 285 * MiB;
constexpr size_t WS_FIN = 253 * MiB;
constexpr size_t WS_ML = 381 * MiB;
constexpr size_t MLREC = 44032;
constexpr size_t ML_Q = 0, ML_ST = 8192, ML_KWT = 16384, ML_VF = 24576, ML_ROW = 43008;
constexpr size_t WS_GATE = 381 * MiB;
constexpr size_t WS_XS = 189 * MiB, WS_ACT = 333 * MiB, WS_YROWS = 405 * MiB;
constexpr size_t WS_END = 573 * MiB;
constexpr size_t WS_G1A = 553 * MiB, WS_END2 = 585 * MiB;
constexpr int MOE_ROWS = 73728;
static_assert(WS_ML + (size_t)NREC * MLREC <= WS_END + 15 * MiB, "ml records");
static_assert(WS_YROWS + (size_t)MOE_ROWS * 1024 * 2 <= WS_END, "moe rows");

constexpr int RING_BYTES = 131072;
constexpr int MISC_OFF = RING_BYTES + 320;
constexpr int LHIST_OFF = RING_BYTES + 1024;
constexpr int LPE_OFF = RING_BYTES + 2048;
constexpr int LARG_OFF = RING_BYTES + 4096;
constexpr int LDS_BYTES = 147456;

__device__ __forceinline__ float bf2f(unsigned b) { return __uint_as_float(b << 16); }
__device__ __forceinline__ unsigned f2bf(float f) { unsigned u = __float_as_uint(f); return (u + 0x7fffu + ((u >> 16) & 1u)) >> 16; }
__device__ __forceinline__ unsigned pk2(float lo, float hi) { return f2bf(lo) | (f2bf(hi) << 16); }
__device__ __forceinline__ float wave_sum(float v) {
    v += __int_as_float(__builtin_amdgcn_update_dpp(0, __float_as_int(v), 0xB1, 0xf, 0xf, true));
    v += __int_as_float(__builtin_amdgcn_update_dpp(0, __float_as_int(v), 0x4E, 0xf, 0xf, true));
    v += __int_as_float(__builtin_amdgcn_update_dpp(0, __float_as_int(v), 0x141, 0xf, 0xf, true));
    v += __int_as_float(__builtin_amdgcn_update_dpp(0, __float_as_int(v), 0x140, 0xf, 0xf, true));
    const int iv = __float_as_int(v);
    return (__int_as_float(__builtin_amdgcn_readlane(iv, 0)) + __int_as_float(__builtin_amdgcn_readlane(iv, 16))) + (__int_as_float(__builtin_amdgcn_readlane(iv, 32)) + __int_as_float(__builtin_amdgcn_readlane(iv, 48)));
}
__device__ __forceinline__ float wave_max(float v) {
    v = fmaxf(v, __int_as_float(__builtin_amdgcn_update_dpp(0, __float_as_int(v), 0xB1, 0xf, 0xf, true)));
    v = fmaxf(v, __int_as_float(__builtin_amdgcn_update_dpp(0, __float_as_int(v), 0x4E, 0xf, 0xf, true)));
    v = fmaxf(v, __int_as_float(__builtin_amdgcn_update_dpp(0, __float_as_int(v), 0x141, 0xf, 0xf, true)));
    v = fmaxf(v, __int_as_float(__builtin_amdgcn_update_dpp(0, __float_as_int(v), 0x140, 0xf, 0xf, true)));
    const int iv = __float_as_int(v);
    return fmaxf(fmaxf(__int_as_float(__builtin_amdgcn_readlane(iv, 0)), __int_as_float(__builtin_amdgcn_readlane(iv, 16))), fmaxf(__int_as_float(__builtin_amdgcn_readlane(iv, 32)), __int_as_float(__builtin_amdgcn_readlane(iv, 48))));
}
__device__ __forceinline__ float fexp(float x) { return __builtin_amdgcn_exp2f(x * 1.44269504089f); }
__device__ __forceinline__ float sigmoidf_(float x) { return 1.0f / (1.0f + expf(-x)); }
__device__ __forceinline__ float siluf_(float x) { return x / (1.0f + expf(-x)); }
__device__ __forceinline__ float softplusf_(float x) { return fmaxf(x, 0.f) + log1pf(expf(-fabsf(x))); }
__device__ __forceinline__ float logsigmoidf_(float x) { return fminf(x, 0.f) - log1pf(expf(-fabsf(x))); }
__host__ __device__ __forceinline__ int sigma32(int p) { const int fq = p >> 3, j = p & 7; return 16 * (j >> 2) + 4 * fq + (j & 3); }

#define XB_TMO      128
#define XB_XCNT(j)  (256  + 64 * (j))
#define XB_XSUB(j)  (1280 + 64 * (j))
#define XB_XGEN(j)  (2304 + 64 * (j))
#define XB_TOP      3328
#define XB_TOPGEN   3392
#define XCD_BAR_WORDS 3456
#define XB_SPIN_CAP (1u << 20)
__device__ __forceinline__ unsigned xb_ld(unsigned* p)              { return __hip_atomic_load(p, __ATOMIC_RELAXED, __HIP_MEMORY_SCOPE_AGENT); }
__device__ __forceinline__ unsigned xb_add(unsigned* p, unsigned v) { return __hip_atomic_fetch_add(p, v, __ATOMIC_RELAXED, __HIP_MEMORY_SCOPE_AGENT); }
__device__ __forceinline__ unsigned xb_xcc_id() { return (unsigned)__builtin_amdgcn_s_getreg((3 << 11) | 20) & 0xFu; }
#define XB_SPIN(cond, bar) do { unsigned _sp = 0; while (cond) { __builtin_amdgcn_s_sleep(1); \
    if ((++_sp & 255u) == 0u) { if (xb_ld(&(bar)[XB_TMO])) break; if (_sp > XB_SPIN_CAP) { atomicAdd(&(bar)[XB_TMO], 1u); break; } } } } while (0)
struct XcdBarrier { unsigned* bar; unsigned x; volatile LAS unsigned* st; };
__device__ __forceinline__ XcdBarrier xcd_barrier_post(unsigned* bar, volatile LAS unsigned* st) {
    XcdBarrier b; b.bar = bar; b.x = xb_xcc_id(); b.st = st;
    if (threadIdx.x == 0) (void)xb_add(&bar[XB_XCNT(b.x)], 1u);
    return b;
}
__device__ __forceinline__ void xcd_barrier_complete(unsigned* bar, unsigned x, unsigned& nloc, unsigned& nx) {
    const unsigned G = 256u;
    unsigned sum, cnt, mine, sp = 0u;
    for (;;) {
        sum = 0u; cnt = 0u; mine = 0u;
#pragma unroll
        for (unsigned j = 0; j < 16; ++j) { const unsigned c = xb_ld(&bar[XB_XCNT(j)]); sum += c; cnt += (c > 0u) ? 1u : 0u; mine = (j == x) ? c : mine; }
        if (sum == G) break;
        __builtin_amdgcn_s_sleep(1);
        if ((++sp & 255u) == 0u) { if (xb_ld(&bar[XB_TMO])) break; if (sp > XB_SPIN_CAP) { atomicAdd(&bar[XB_TMO], 1u); break; } }
    }
    nloc = mine > 0u ? mine : 1u; nx = cnt > 0u ? cnt : 1u;
}
__device__ __forceinline__ void xcd_barrier(const XcdBarrier& b, const int tid) {
    asm volatile("s_waitcnt vmcnt(0)" ::: "memory");
    __syncthreads();
    if (tid == 0) {
        unsigned* bar = b.bar;
        __builtin_amdgcn_s_waitcnt(0);
        unsigned nloc = b.st[0], nx = b.st[1];
        if (nloc == 0u) { xcd_barrier_complete(bar, b.x, nloc, nx); b.st[0] = nloc; b.st[1] = nx; }
        const unsigned old = xb_add(&bar[XB_XSUB(b.x)], 1u);
        const unsigned gen = old / nloc;
        if (old + 1u == (gen + 1u) * nloc) {
            __builtin_amdgcn_fence(__ATOMIC_RELEASE, "agent");
            asm volatile("s_waitcnt vmcnt(0)" ::: "memory");
            const unsigned og = xb_add(&bar[XB_TOP], 1u);
            const unsigned tg = og / nx;
            if (og + 1u == (tg + 1u) * nx) xb_add(&bar[XB_TOPGEN], 1u);
            else XB_SPIN(xb_ld(&bar[XB_TOPGEN]) == tg, bar);
            __builtin_amdgcn_fence(__ATOMIC_ACQUIRE, "agent");
            xb_add(&bar[XB_XGEN(b.x)], 1u);
            asm volatile("s_waitcnt vmcnt(0)" ::: "memory");
        } else {
            XB_SPIN(xb_ld(&bar[XB_XGEN(b.x)]) == gen, bar);
            __builtin_amdgcn_fence(__ATOMIC_ACQUIRE, "agent");
            asm volatile("s_waitcnt vmcnt(0)" ::: "memory");
        }
    }
    __syncthreads();
}

namespace pg8 {
constexpr int BM = 256, BK = 64, HALF = 128, HTB = HALF * BK * 2, STAGE_BYTES = 8 * HTB, NXCD = 8, WGM = 8;
__host__ __device__ __forceinline__ int lds_byte(int r, int c) { const int st = (r >> 4) * 2 + (c >> 5), rr = r & 15, cc = c & 31, ob = rr * 64 + cc * 2; return st * 1024 + (ob ^ (((ob >> 9) & 1) << 5)); }
__host__ __device__ __forceinline__ void stage_rc(int b, int& R, int& C) { const int st = b / 1024, sb = b % 1024, swz = sb ^ (((sb >> 9) & 1) << 5); R = (st >> 1) * 16 + swz / 64; C = (st & 1) * 32 + (swz % 64) / 2; }
__host__ __device__ __forceinline__ int perm32(int rho) { const int n = rho >> 4, i = rho & 15; return 8 * (i >> 2) + 4 * n + (i & 3); }

struct Unit { int pm, pn, aux; const GAS char* A; const GAS char* B; };

__device__ __forceinline__ void tile_of(int L, int nM, int nN, int& pm, int& pn) {
    const int nwg = nM * nN; int wgid = L;
    { const int q = nwg / NXCD, r = nwg % NXCD, xcd = wgid % NXCD, off = wgid / NXCD; wgid = (xcd < r ? xcd * (q + 1) : r * (q + 1) + (xcd - r) * q) + off; }
    const int nig = WGM * nN, gid = wgid / nig, fm = gid * WGM, gsz = (nM - fm) < WGM ? (nM - fm) : WGM;
    pm = fm + ((wgid % nig) % gsz); pn = (wgid % nig) / gsz;
}
struct StaticOrder {
    static constexpr bool GATHER = false;
    const GAS char* A; const GAS char* Bt; int nM, nN, nwg, G, c; size_t tstep;
    __device__ __forceinline__ void init(const GAS void* A_, const GAS void* Bt_, int M, int N, int K, int G_, int c_) { A = (const GAS char*)A_; Bt = (const GAS char*)Bt_; nM = M / BM; nN = N / BM; nwg = nM * nN; G = G_; c = c_; tstep = (size_t)BM * K * 2; }
    __device__ __forceinline__ bool next(int i, Unit& u) const {
        const long L = (long)i * G + c; if (L >= nwg) return false;
        tile_of((int)L, nM, nN, u.pm, u.pn); u.aux = 0; u.A = A + (size_t)u.pm * tstep; u.B = Bt + (size_t)u.pn * tstep; return true;
    }
};

typedef float f32x2_t __attribute__((ext_vector_type(2))); typedef __bf16 bf16x2_t __attribute__((ext_vector_type(2)));
__device__ __forceinline__ unsigned cvt_pk_bf16(float lo, float hi) { f32x2_t v = {lo, hi}; bf16x2_t b = __builtin_convertvector(v, bf16x2_t); return __builtin_bit_cast(unsigned, b); }

__device__ __forceinline__ bf16 bf1(float x) { return (bf16)(cvt_pk_bf16(x, x) & 0xffffu); }
template <class Epi, class Sched, bool ALIGN_EPI = true, bool SP2 = true>
__device__ __forceinline__ void gemm_phase(LAS unsigned char* lds, const int tid, const int K, const Sched& S, const Epi& E) {
    const int wid = __builtin_amdgcn_readfirstlane(tid >> 6), lane = tid & 63, wr = wid >> 2, wc = wid & 3, fr = lane & 15, fq = lane >> 4;
    const int nt = K / BK;
    unsigned voffA, voffB;
    { int R, C; stage_rc(tid * 16, R, C); const int Rb = Epi::PERM ? ((R & ~31) + perm32(R & 31)) : R;
        voffA = (unsigned)(R * K + C) * 2u; voffB = (unsigned)(Rb * K + C) * 2u; }
    const size_t pstep = (size_t)64 * K * 2;
    const size_t kstep = (size_t)(BK * 2);
    const size_t hstep = (size_t)HALF * K * 2;
    const unsigned ldsw = (unsigned)wid * 1024u;
    const int aoff = lds_byte(wr * 64 + fr, fq * 8), boff = lds_byte(wc * 32 + fr, fq * 8);
#define PG8_SA(b, h) (((b) * 2 + (h)) * HTB)
#define PG8_SB(b, h) ((4 + (b) * 2 + (h)) * HTB)
#define PG8_STAGE(bufoff, gbase, voff) do { _Pragma("unroll") for (int _i = 0; _i < 2; ++_i) \
        __builtin_amdgcn_global_load_lds((const GAS unsigned*)((const GAS char*)(gbase) + _i * pstep + (voff)), (LAS unsigned*)(lds + (bufoff) + ldsw + _i * 8192), 16, 0, 0); } while (0)
#define PG8_STAGE_A(bufoff, kbase, h_, useNext) do { if constexpr (GATHER) { _Pragma("unroll") for (int _i = 0; _i < 2; ++_i) { const unsigned _o = (useNext) ? gaN[h_][_i] : gaC[h_][_i]; \
        __builtin_amdgcn_global_load_lds((const GAS unsigned*)((const GAS char*)(kbase) + _o), (LAS unsigned*)(lds + (bufoff) + ldsw + _i * 8192), 16, 0, 0); } } \
        else { PG8_STAGE(bufoff, (kbase) + (h_) * hstep, voffA); } } while (0)
#define PG8_LDA(dst, b, h) do { _Pragma("unroll") for (int m = 0; m < 4; ++m) _Pragma("unroll") for (int k = 0; k < 2; ++k) dst[m][k] = *(const LAS bf16x8*)(lds + PG8_SA(b, h) + aoff + m * 2048 + k * 1024); } while (0)
#define PG8_LDB(dst, b, h) do { _Pragma("unroll") for (int n = 0; n < 2; ++n) _Pragma("unroll") for (int k = 0; k < 2; ++k) dst[n][k] = *(const LAS bf16x8*)(lds + PG8_SB(b, h) + boff + n * 2048 + k * 1024); } while (0)
#define PG8_MMA(ai, bj, At, Bt) do { __builtin_amdgcn_s_setprio(1); _Pragma("unroll") for (int m = 0; m < 4; ++m) _Pragma("unroll") for (int n = 0; n < 2; ++n) _Pragma("unroll") for (int k = 0; k < 2; ++k) \
        acc[ai][bj][m][n] = __builtin_amdgcn_mfma_f32_16x16x32_bf16(Bt[n][k], At[m][k], acc[ai][bj][m][n], 0, 0, 0); __builtin_amdgcn_s_setprio(0); } while (0)
#define PG8_WAIT_V(n) asm volatile("s_waitcnt vmcnt(" #n ")" ::: "memory")
#define PG8_WAIT_L(n) asm volatile("s_waitcnt lgkmcnt(" #n ")" ::: "memory")
#define PG8_BAR __builtin_amdgcn_s_barrier()
#define PG8_SCHED __builtin_amdgcn_sched_barrier(0)
    Unit cur, nxt; int ui = 0;
    if (!S.next(0, cur)) return;
    constexpr bool GATHER = Sched::GATHER;
    unsigned gaC[2][2], gaN[2][2];
    int gR = 0, gC = 0; if constexpr (GATHER) { stage_rc(tid * 16, gR, gC); }
#define PG8_GATHER_OFFS(dst, u_) do { if constexpr (GATHER) { _Pragma("unroll") for (int h_ = 0; h_ < 2; ++h_) _Pragma("unroll") for (int i_ = 0; i_ < 2; ++i_) \
        dst[h_][i_] = (unsigned)S.rowtok[(u_).pm * 256 + 128 * h_ + 64 * i_ + gR] * (unsigned)(K * 2) + (unsigned)(gC * 2); } } while (0)
    PG8_GATHER_OFFS(gaC, cur);
#pragma unroll
    for (int h_ = 0; h_ < 2; ++h_)
#pragma unroll
        for (int i_ = 0; i_ < 2; ++i_) gaN[h_][i_] = gaC[h_][i_];
    f32x4 acc[2][2][4][2];
#pragma unroll
    for (int a = 0; a < 2; ++a)
#pragma unroll
        for (int b = 0; b < 2; ++b)
#pragma unroll
            for (int m = 0; m < 4; ++m)
#pragma unroll
                for (int n = 0; n < 2; ++n) acc[a][b][m][n] = (f32x4){0.f, 0.f, 0.f, 0.f};
    bf16x8 At[4][2], B0[2][2], B1[2][2];
    const GAS char* cA = cur.A; const GAS char* cB = cur.B;
    if constexpr (SP2) {
        PG8_STAGE(PG8_SB(0, 0), cB, voffB); PG8_STAGE(PG8_SB(0, 1), cB + hstep, voffB); PG8_STAGE_A(PG8_SA(0, 0), cA, 0, false); PG8_STAGE_A(PG8_SA(0, 1), cA, 1, false);
        if (wr == 1) PG8_BAR;
        PG8_WAIT_V(2); PG8_BAR;
        PG8_STAGE(PG8_SB(1, 0), cB + kstep, voffB); PG8_STAGE_A(PG8_SA(1, 0), cA + kstep, 0, false); PG8_STAGE(PG8_SB(1, 1), cB + hstep + kstep, voffB);
        PG8_WAIT_V(6); PG8_BAR;
    } else {
        PG8_STAGE(PG8_SB(0, 0), cB, voffB); PG8_STAGE(PG8_SA(0, 0), cA, voffA); PG8_STAGE(PG8_SB(0, 1), cB + hstep, voffB); PG8_STAGE(PG8_SA(0, 1), cA + hstep, voffA);
        if (wr == 1) PG8_BAR;
        PG8_WAIT_V(4); PG8_BAR;
        PG8_STAGE(PG8_SB(1, 0), cB + kstep, voffB); PG8_STAGE(PG8_SA(1, 0), cA + kstep, voffA); PG8_STAGE(PG8_SB(1, 1), cB + hstep + kstep, voffB);
        PG8_WAIT_V(6); PG8_BAR;
    }
    for (;;) {
        const bool has_next = S.next(ui + 1, nxt);
        if (has_next) PG8_GATHER_OFFS(gaN, nxt);
        const GAS char* nA = has_next ? nxt.A : cA; const GAS char* nB = has_next ? nxt.B : cB;
        for (int t = 0; t < nt; t += 2) {
            const bool last = (t == nt - 2);
            const GAS char* a1 = cA + (size_t)(t + 1) * kstep;
            const GAS char* a2 = last ? nA : cA + (size_t)(t + 2) * kstep; const GAS char* b2 = last ? nB : cB + (size_t)(t + 2) * kstep;
            const GAS char* a3 = a2 + kstep; const GAS char* b3 = b2 + kstep;
            if constexpr (SP2) {
            PG8_LDB(B0, 0, 0); PG8_LDB(B1, 0, 1); PG8_SCHED; PG8_LDA(At, 0, 0); PG8_STAGE_A(PG8_SA(1, 1), a1, 1, false);
            PG8_WAIT_V(8); PG8_WAIT_L(0); PG8_BAR; PG8_MMA(0, 0, At, B0); PG8_MMA(0, 1, At, B1); PG8_BAR; PG8_SCHED;
            PG8_LDA(At, 0, 1); PG8_STAGE(PG8_SB(0, 0), b2, voffB); PG8_STAGE(PG8_SB(0, 1), b2 + hstep, voffB); PG8_STAGE_A(PG8_SA(0, 0), a2, 0, last && has_next);
            PG8_WAIT_V(8); PG8_WAIT_L(0); PG8_BAR; PG8_MMA(1, 0, At, B0); PG8_MMA(1, 1, At, B1); PG8_BAR; PG8_SCHED;
            PG8_LDB(B0, 1, 0); PG8_LDB(B1, 1, 1); PG8_SCHED; PG8_LDA(At, 1, 0); PG8_STAGE_A(PG8_SA(0, 1), a2, 1, last && has_next);
            PG8_WAIT_V(8); PG8_WAIT_L(0); PG8_BAR; PG8_MMA(0, 0, At, B0); PG8_MMA(0, 1, At, B1); PG8_BAR; PG8_SCHED;
            PG8_LDA(At, 1, 1); PG8_STAGE(PG8_SB(1, 0), b3, voffB); PG8_STAGE(PG8_SB(1, 1), b3 + hstep, voffB); PG8_STAGE_A(PG8_SA(1, 0), a3, 0, last && has_next);
            PG8_WAIT_V(8); PG8_WAIT_L(0); PG8_BAR; PG8_MMA(1, 0, At, B0); PG8_MMA(1, 1, At, B1); PG8_BAR; PG8_SCHED;
            } else {
            PG8_LDB(B0, 0, 0); PG8_SCHED; PG8_LDA(At, 0, 0); PG8_STAGE(PG8_SA(1, 1), a1 + hstep, voffA);
            PG8_WAIT_L(8); PG8_BAR; PG8_WAIT_L(0); PG8_MMA(0, 0, At, B0); PG8_BAR; PG8_SCHED;
            PG8_LDB(B1, 0, 1); PG8_STAGE(PG8_SB(0, 0), b2, voffB);
            PG8_BAR; PG8_WAIT_L(0); PG8_MMA(0, 1, At, B1); PG8_BAR;
            PG8_LDA(At, 0, 1); PG8_STAGE(PG8_SA(0, 0), a2, voffA);
            PG8_BAR; PG8_WAIT_L(0); PG8_MMA(1, 0, At, B0); PG8_BAR; PG8_SCHED;
            PG8_STAGE(PG8_SB(0, 1), b2 + hstep, voffB);
            PG8_WAIT_V(6); PG8_BAR; PG8_MMA(1, 1, At, B1); PG8_BAR;
            PG8_LDB(B0, 1, 0); PG8_SCHED; PG8_LDA(At, 1, 0); PG8_STAGE(PG8_SA(0, 1), a2 + hstep, voffA);
            PG8_WAIT_L(8); PG8_BAR; PG8_WAIT_L(0); PG8_MMA(0, 0, At, B0); PG8_BAR; PG8_SCHED;
            PG8_LDB(B1, 1, 1); PG8_STAGE(PG8_SB(1, 0), b3, voffB);
            PG8_BAR; PG8_WAIT_L(0); PG8_MMA(0, 1, At, B1); PG8_BAR;
            PG8_LDA(At, 1, 1); PG8_STAGE(PG8_SA(1, 0), a3, voffA);
            PG8_BAR; PG8_WAIT_L(0); PG8_MMA(1, 0, At, B0); PG8_BAR; PG8_SCHED;
            PG8_STAGE(PG8_SB(1, 1), b3 + hstep, voffB);
            PG8_WAIT_V(6); PG8_BAR; PG8_MMA(1, 1, At, B1); PG8_BAR;
            }
        }
        if constexpr (ALIGN_EPI) { if (wr == 0) PG8_BAR; }
        E(acc, cur, wr, wc, fr, fq);
        if (!has_next) break;
        if (!Epi::CHAIN || cur.aux == 2) {
#pragma unroll
        for (int a = 0; a < 2; ++a)
#pragma unroll
            for (int b = 0; b < 2; ++b)
#pragma unroll
                for (int m = 0; m < 4; ++m)
#pragma unroll
                    for (int n = 0; n < 2; ++n) acc[a][b][m][n] = (f32x4){0.f, 0.f, 0.f, 0.f};
        }
        cur = nxt; cA = nA; cB = nB; ++ui;
#pragma unroll
        for (int h_ = 0; h_ < 2; ++h_)
#pragma unroll
            for (int i_ = 0; i_ < 2; ++i_) gaC[h_][i_] = gaN[h_][i_];
        if constexpr (ALIGN_EPI) { if (wr == 1) PG8_BAR; }
    }
    PG8_WAIT_V(0);
    if constexpr (!ALIGN_EPI) { if (wr == 0) PG8_BAR; }
    PG8_BAR;
#undef PG8_SA
#undef PG8_SB
#undef PG8_STAGE
#undef PG8_LDA
#undef PG8_STAGE_A
#undef PG8_GATHER_OFFS
#undef PG8_LDB
#undef PG8_MMA
#undef PG8_WAIT_V
#undef PG8_WAIT_L
#undef PG8_BAR
#undef PG8_SCHED
}
}

using pg8::Unit; using pg8::cvt_pk_bf16; using pg8::bf1; using pg8::HALF; using pg8::BM;

struct EpiG1a {
    static constexpr bool PERM = true; static constexpr bool CHAIN = false;
    GAS bf16* O;
    __device__ __forceinline__ void operator()(const f32x4 (&acc)[2][2][4][2], const Unit& u, int wr, int wc, int fr, int fq) const {
        const int row0 = u.pm * BM + wr * 64 + fr, col0 = u.pn * BM + wc * 32 + 8 * fq;
#pragma unroll
        for (int ai = 0; ai < 2; ++ai)
#pragma unroll
            for (int m = 0; m < 4; ++m) { GAS bf16* rowp = O + (size_t)(row0 + ai * HALF + m * 16) * 1536 + col0;
#pragma unroll
                for (int bj = 0; bj < 2; ++bj) { const f32x4 v0 = acc[ai][bj][m][0], v1 = acc[ai][bj][m][1];
                    u32x4 w; w.x = cvt_pk_bf16(v0[0], v0[1]); w.y = cvt_pk_bf16(v0[2], v0[3]); w.z = cvt_pk_bf16(v1[0], v1[1]); w.w = cvt_pk_bf16(v1[2], v1[3]);
                    *(GAS u32x4*)(rowp + bj * HALF) = w; } }
    }
};
struct EpiG1b {
    static constexpr bool PERM = true; static constexpr bool CHAIN = false;
    GAS unsigned char* ws;
    __device__ __forceinline__ void operator()(const f32x4 (&acc)[2][2][4][2], const Unit& u, int wr, int wc, int fr, int fq) const {
        const int pn = u.pn; size_t off; int ld, ct;
        if (pn < 2) { off = WS_PZ; ld = 512; ct = pn; } else if (pn < 4) { off = WS_PPOOL; ld = 512; ct = pn - 2; } else if (pn == 4) { off = WS_PMQ; ld = 256; ct = 0; }
        else if (pn == 5) { off = WS_PMK; ld = 256; ct = 0; } else if (pn < 8) { off = WS_PMV; ld = 512; ct = pn - 6; } else { off = WS_PMO; ld = 512; ct = pn - 8; }
        GAS bf16* O = (GAS bf16*)(ws + off);
        const bool late = (pn < 4) || (pn >= 8);
        const int row0 = u.pm * BM + wr * 64 + fr, col0 = ct * BM + wc * 32 + 8 * fq;
#pragma unroll
        for (int ai = 0; ai < 2; ++ai)
#pragma unroll
            for (int m = 0; m < 4; ++m) { GAS bf16* rowp = O + (size_t)(row0 + ai * HALF + m * 16) * ld + col0;
#pragma unroll
                for (int bj = 0; bj < 2; ++bj) { const f32x4 v0 = acc[ai][bj][m][0], v1 = acc[ai][bj][m][1];
                    u32x4 w; w.x = cvt_pk_bf16(v0[0], v0[1]); w.y = cvt_pk_bf16(v0[2], v0[3]); w.z = cvt_pk_bf16(v1[0], v1[1]); w.w = cvt_pk_bf16(v1[2], v1[3]);
                    if (late) __builtin_nontemporal_store(w, (GAS u32x4*)(rowp + bj * HALF)); else *(GAS u32x4*)(rowp + bj * HALF) = w; } }
    }
};
__device__ __forceinline__ float fast_sigmoid(float x) { return __builtin_amdgcn_rcpf(1.0f + __builtin_amdgcn_exp2f(-1.44269504089f * x)); }
struct EpiGate {
    static constexpr bool PERM = true; static constexpr bool CHAIN = false;
    GAS bf16* O0; int ld0; GAS bf16* O1; int ld1; int psplit;
    __device__ __forceinline__ void operator()(const f32x4 (&acc)[2][2][4][2], const Unit& u, int wr, int wc, int fr, int fq) const {
        const bool lowp = u.pn < psplit; GAS bf16* O = lowp ? O0 : O1; const int ld = lowp ? ld0 : ld1;
        GAS bf16* tile = O + (((size_t)u.pm * (ld >> 8) + (lowp ? u.pn : u.pn - psplit)) << 16);
        const int wid = wr * 4 + wc, lane = fq * 16 + fr;
#pragma unroll
        for (int ai = 0; ai < 2; ++ai)
#pragma unroll
            for (int m = 0; m < 4; ++m) {
#pragma unroll
                for (int bj = 0; bj < 2; ++bj) { f32x4 v0 = acc[ai][bj][m][0], v1 = acc[ai][bj][m][1];
#pragma unroll
                    for (int j = 0; j < 4; ++j) { v0[j] = fast_sigmoid(v0[j]); v1[j] = fast_sigmoid(v1[j]); }
                    u32x4 w; w.x = cvt_pk_bf16(v0[0], v0[1]); w.y = cvt_pk_bf16(v0[2], v0[3]); w.z = cvt_pk_bf16(v1[0], v1[1]); w.w = cvt_pk_bf16(v1[2], v1[3]);
                    *(GAS u32x4*)(tile + ((((wid * 2 + ai) * 4 + m) * 2 + bj) * 64 + lane) * 8) = w; } }
    }
};
__device__ __forceinline__ void unpack8(const u32x4 w, float (&f)[8]) {
    f[0] = __uint_as_float(w.x << 16); f[1] = __uint_as_float(w.x & 0xffff0000u); f[2] = __uint_as_float(w.y << 16); f[3] = __uint_as_float(w.y & 0xffff0000u);
    f[4] = __uint_as_float(w.z << 16); f[5] = __uint_as_float(w.z & 0xffff0000u); f[6] = __uint_as_float(w.w << 16); f[7] = __uint_as_float(w.w & 0xffff0000u);
}
struct EpiMerge {
    static constexpr bool PERM = true; static constexpr bool CHAIN = true;
    const GAS bf16* G0; const GAS bf16* G1; const GAS bf16* G2; GAS bf16* FIN;
    __device__ __forceinline__ const GAS bf16* gate_tile(int pm, int gpan) const {
        return (gpan < 4) ? (G0 + (((size_t)pm * 4 + gpan) << 16)) : (gpan < 6) ? (G1 + (((size_t)pm * 2 + (gpan - 4)) << 16)) : (G2 + (((size_t)pm * 6 + (gpan - 6)) << 16));
    }
    __device__ __forceinline__ void operator()(f32x4 (&acc)[2][2][4][2], const Unit& u, int wr, int wc, int fr, int fq) const {
        const int r = u.aux;
        const int row0 = u.pm * BM + wr * 64 + fr, col0 = u.pn * BM + wc * 32 + 8 * fq;
        const GAS bf16* ga = gate_tile(u.pm, r * 4 + u.pn); const GAS bf16* gb = gate_tile(u.pm, (r < 2 ? r + 1 : r) * 4 + u.pn);
        const int wid = wr * 4 + wc, lane = fq * 16 + fr;
#pragma unroll
        for (int aq = 0; aq < 4; ++aq) { const int ai = aq >> 1, m0 = 2 * (aq & 1);
            u32x4 gw[2][2], hw[2][2];
#pragma unroll
            for (int mm = 0; mm < 2; ++mm)
#pragma unroll
                for (int bj = 0; bj < 2; ++bj) { const int fo = ((((wid * 2 + ai) * 4 + (m0 + mm)) * 2 + bj) * 64 + lane) * 8;
                    gw[mm][bj] = *(const GAS u32x4*)(ga + fo);
                    if (r < 2) hw[mm][bj] = *(const GAS u32x4*)(gb + fo); }
#pragma unroll
            for (int mm = 0; mm < 2; ++mm)
#pragma unroll
                for (int bj = 0; bj < 2; ++bj) { const int m = m0 + mm; const size_t row = (size_t)(row0 + ai * HALF + m * 16); const int c = col0 + bj * HALF;
                    float g[8]; unpack8(gw[mm][bj], g);
                    if (r < 2) { float h[8]; unpack8(hw[mm][bj], h);
#pragma unroll
                        for (int j = 0; j < 8; ++j) g[j] *= __builtin_amdgcn_rcpf(fmaxf(h[j], 1e-20f)); }
                    f32x4& v0 = acc[ai][bj][m][0]; f32x4& v1 = acc[ai][bj][m][1];
                    v0[0] *= g[0]; v0[1] *= g[1]; v0[2] *= g[2]; v0[3] *= g[3]; v1[0] *= g[4]; v1[1] *= g[5]; v1[2] *= g[6]; v1[3] *= g[7];
                    if (r == 2) { u32x4 w; w.x = cvt_pk_bf16(v0[0], v0[1]); w.y = cvt_pk_bf16(v0[2], v0[3]); w.z = cvt_pk_bf16(v1[0], v1[1]); w.w = cvt_pk_bf16(v1[2], v1[3]);
                        *(GAS u32x4*)(FIN + row * 1024 + c) = w; } }
        }
    }
};
struct EpiOut {
    static constexpr bool PERM = true; static constexpr bool CHAIN = false;
    const GAS bf16* H; GAS bf16* PRE;
    __device__ __forceinline__ void operator()(const f32x4 (&acc)[2][2][4][2], const Unit& u, int wr, int wc, int fr, int fq) const {
        const int row0 = u.pm * BM + wr * 64 + fr, col0 = u.pn * BM + wc * 32 + 8 * fq;
#pragma unroll
        for (int ai = 0; ai < 2; ++ai) {
            u32x4 hv[4][2];
#pragma unroll
            for (int m = 0; m < 4; ++m)
#pragma unroll
                for (int bj = 0; bj < 2; ++bj) hv[m][bj] = *(const GAS u32x4*)(H + (size_t)(row0 + ai * HALF + m * 16) * D + col0 + bj * HALF);
#pragma unroll
            for (int m = 0; m < 4; ++m)
#pragma unroll
                for (int bj = 0; bj < 2; ++bj) { const size_t o = (size_t)(row0 + ai * HALF + m * 16) * D + col0 + bj * HALF; float h[8]; unpack8(hv[m][bj], h);
                    const f32x4 v0 = acc[ai][bj][m][0], v1 = acc[ai][bj][m][1];
                    u32x4 w; w.x = cvt_pk_bf16(ALPHA * h[0] + v0[0], ALPHA * h[1] + v0[1]); w.y = cvt_pk_bf16(ALPHA * h[2] + v0[2], ALPHA * h[3] + v0[3]);
                    w.z = cvt_pk_bf16(ALPHA * h[4] + v1[0], ALPHA * h[5] + v1[1]); w.w = cvt_pk_bf16(ALPHA * h[6] + v1[2], ALPHA * h[7] + v1[3]);
                    *(GAS u32x4*)(PRE + o) = w; }
        }
    }
};
struct EpiMoe1 {
    static constexpr bool PERM = true; static constexpr bool CHAIN = false;
    GAS bf16* ACT;
    __device__ __forceinline__ void operator()(const f32x4 (&acc)[2][2][4][2], const Unit& u, int wr, int wc, int fr, int fq) const {
        const int row0 = u.pm * BM + wr * 64 + fr, col0 = u.pn * 128 + wc * 32 + 8 * fq;
#pragma unroll
        for (int ai = 0; ai < 2; ++ai)
#pragma unroll
            for (int m = 0; m < 4; ++m) { GAS bf16* rowp = ACT + (size_t)(row0 + ai * HALF + m * 16) * DEXP + col0;
                float o[8];
#pragma unroll
                for (int n = 0; n < 2; ++n)
#pragma unroll
                    for (int j = 0; j < 4; ++j) { const float a = acc[ai][0][m][n][j], b = acc[ai][1][m][n][j]; o[n * 4 + j] = a * fast_sigmoid(a) * b; }
                u32x4 w; w.x = cvt_pk_bf16(o[0], o[1]); w.y = cvt_pk_bf16(o[2], o[3]); w.z = cvt_pk_bf16(o[4], o[5]); w.w = cvt_pk_bf16(o[6], o[7]);
                *(GAS u32x4*)rowp = w; }
    }
};
struct EpiMoe2 {
    static constexpr bool PERM = true; static constexpr bool CHAIN = false;
    GAS bf16* Y; const GAS float* roww;
    __device__ __forceinline__ void operator()(const f32x4 (&acc)[2][2][4][2], const Unit& u, int wr, int wc, int fr, int fq) const {
        const int row0 = u.pm * BM + wr * 64 + fr, col0 = u.pn * BM + wc * 32 + 8 * fq;
        float rws[2][4];
#pragma unroll
        for (int ai = 0; ai < 2; ++ai)
#pragma unroll
            for (int m = 0; m < 4; ++m) rws[ai][m] = roww[row0 + ai * HALF + m * 16];
#pragma unroll
        for (int ai = 0; ai < 2; ++ai)
#pragma unroll
            for (int m = 0; m < 4; ++m) { const int row = row0 + ai * HALF + m * 16; const float rw = rws[ai][m]; GAS bf16* rowp = Y + (size_t)row * D + col0;
#pragma unroll
                for (int bj = 0; bj < 2; ++bj) { const f32x4 v0 = acc[ai][bj][m][0] * rw, v1 = acc[ai][bj][m][1] * rw;
                    u32x4 w; w.x = cvt_pk_bf16(v0[0], v0[1]); w.y = cvt_pk_bf16(v0[2], v0[3]); w.z = cvt_pk_bf16(v1[0], v1[1]); w.w = cvt_pk_bf16(v1[2], v1[3]);
                    *(GAS u32x4*)(rowp + bj * HALF) = w; } }
    }
};

struct MergeOrder {
    static constexpr bool GATHER = false;
    const GAS char* Y[3]; const GAS char* W; int G, c;
    __device__ __forceinline__ bool next(int i, Unit& u) const {
        const int j = i / 3, r = i - 3 * j; const int L = j * G + c; if (L >= 128 * 4) return false;
        pg8::tile_of(L, 128, 4, u.pm, u.pn); u.aux = r;
        const GAS char* y = (r == 0) ? Y[0] : ((r == 1) ? Y[1] : Y[2]);
        u.A = y + (size_t)u.pm * (256 * 512 * 2); u.B = W + (size_t)r * (1024 * 512 * 2) + (size_t)u.pn * (256 * 512 * 2); return true;
    }
};
template <int KDIM, bool GATHER_> struct MoeOrder {
    static constexpr bool GATHER = GATHER_;
    const GAS int* rowtok;
    const GAS char* A; const GAS char* W; const LAS int* pe; int c, NP;
    __device__ __forceinline__ bool next(int i, Unit& u) const {
        const int PPX = (NP + 7) >> 3, x = c & 7, q = i * 32 + (c >> 3), lp = q >> 2;
        const int p = x * PPX + lp; if (lp >= PPX || p >= NP) return false;
        const int pn = q & 3; const int e = __builtin_amdgcn_readfirstlane(pe[p]);
        u.pm = p; u.pn = pn; u.aux = e; u.A = GATHER_ ? A : A + (size_t)p * (256 * KDIM * 2); u.B = W + (size_t)e * (1024 * KDIM * 2) + (size_t)pn * (256 * KDIM * 2); return true;
    }
};

struct Args {
    const float* in[23]; float* out; unsigned char* ws; int ph_lo, ph_hi;
};
struct Frame {
    LAS unsigned char* lds; int tid, lane, wave, G, wg;
    GAS float* out; GAS unsigned char* ws;
};
__device__ __forceinline__ const GAS float* inp_lds(LAS unsigned char* lds, int i) {
    const unsigned long long v = ((const LAS unsigned long long*)(lds + LARG_OFF))[i];
    const unsigned lo = __builtin_amdgcn_readfirstlane((unsigned)v), hi = __builtin_amdgcn_readfirstlane((unsigned)(v >> 32));
    return (const GAS float*)(((unsigned long long)hi << 32) | lo);
}
__device__ __forceinline__ const GAS float* inp(const Frame& F, int i) { return inp_lds(F.lds, i); }
__device__ __forceinline__ Frame fresh(LAS unsigned char* lds, int wave) {
    Frame F; int wgx = blockIdx.x; unsigned lb = (unsigned)(unsigned long long)lds;
    asm volatile("" : "+s"(wave), "+s"(wgx), "+s"(lb));
    F.lds = (LAS unsigned char*)(unsigned long long)lb;
    int ln = (int)__builtin_amdgcn_mbcnt_hi(~0u, __builtin_amdgcn_mbcnt_lo(~0u, 0u)); asm volatile("" : "+v"(ln));
    F.wave = wave; F.lane = ln; F.tid = wave * 64 + ln;
    F.G = 256; F.wg = wgx;
    F.out = (GAS float*)inp_lds(F.lds, 23); F.ws = (GAS unsigned char*)inp_lds(F.lds, 24);
    return F;
}
enum { I_X = 0, I_LN_IN_G, I_LN_IN_B, I_W_IN, I_CONV, I_A_LOG, I_DT_BIAS, I_DN_NORM, I_POOL_W, I_POOL_SCALE, I_ML_GATE_B, I_ML_NORM, I_W_BRANCH, I_W_OUT, I_LN_MIX_G, I_LN_MIX_B,
       I_ROUTER_W, I_ROUTER_B, I_MOE_W1, I_MOE_W3, I_MOE_W2, I_LN_FFN_G, I_LN_FFN_B };

__device__ __forceinline__ void tr_load(float (&r)[32], const GAS float* W, int ldw, int k0, int n0src, int lane) {
#pragma unroll
    for (int i = 0; i < 32; ++i) { const int kk = 2 * i + (lane >> 5); r[i] = W[(size_t)(k0 + kk) * ldw + n0src + (lane & 31)]; }
}
__device__ __forceinline__ void tr_store(const float (&r)[32], GAS bf16* WT, int dpitch, int k0, int drow0, LAS float* scr, int lane) {
#pragma unroll
    for (int i = 0; i < 32; ++i) { const int kk = 2 * i + (lane >> 5); scr[kk * 33 + (lane & 31)] = r[i]; }
    LDS_WAIT(); asm volatile("" ::: "memory");
    const int c = lane & 7;
#pragma unroll
    for (int j = 0; j < 4; ++j) { const int n = (lane >> 3) + 8 * j; const LAS float* s = scr + (8 * c) * 33 + n;
        u32x4 o; o.x = cvt_pk_bf16(s[0 * 33], s[1 * 33]); o.y = cvt_pk_bf16(s[2 * 33], s[3 * 33]); o.z = cvt_pk_bf16(s[4 * 33], s[5 * 33]); o.w = cvt_pk_bf16(s[6 * 33], s[7 * 33]);
        *(GAS u32x4*)(WT + (size_t)(drow0 + n) * dpitch + k0 + 8 * c) = o; }
    LDS_WAIT(); asm volatile("" ::: "memory");
}
__device__ __forceinline__ void tr_load4(float (&r)[32], const GAS float* W, int ldw, int k0, int n0src, int lane) {
#pragma unroll
    for (int i = 0; i < 8; ++i) { const f32x4 v = __builtin_nontemporal_load((const GAS f32x4*)(W + (size_t)(k0 + 8 * i + (lane >> 3)) * ldw + n0src + 4 * (lane & 7)));   r[4 * i] = v[0]; r[4 * i + 1] = v[1]; r[4 * i + 2] = v[2]; r[4 * i + 3] = v[3]; }
}
__device__ __forceinline__ void tr_store4(const float (&r)[32], GAS bf16* WT, int dpitch, int k0, int drow0, LAS float* scr, int lane) {
#pragma unroll
    for (int i = 0; i < 8; ++i) { LAS float* d = scr + (8 * i + (lane >> 3)) * 33 + 4 * (lane & 7); d[0] = r[4 * i]; d[1] = r[4 * i + 1]; d[2] = r[4 * i + 2]; d[3] = r[4 * i + 3]; }
    LDS_WAIT(); asm volatile("" ::: "memory");
    const int c = lane & 7;
#pragma unroll
    for (int j = 0; j < 4; ++j) { const int n = (lane >> 3) + 8 * j; const LAS float* s = scr + (8 * c) * 33 + n;
        u32x4 o; o.x = cvt_pk_bf16(s[0 * 33], s[1 * 33]); o.y = cvt_pk_bf16(s[2 * 33], s[3 * 33]); o.z = cvt_pk_bf16(s[4 * 33], s[5 * 33]); o.w = cvt_pk_bf16(s[6 * 33], s[7 * 33]);
        __builtin_nontemporal_store(o, (GAS u32x4*)(WT + (size_t)(drow0 + n) * dpitch + k0 + 8 * c)); }
    LDS_WAIT(); asm volatile("" ::: "memory");
}
__device__ __forceinline__ void tr_item(const GAS float* W, int ldw, int k0, int n0src, GAS bf16* WT, int dpitch, int drow0, LAS float* scr, int lane) {
    float r[32]; tr_load(r, W, ldw, k0, n0src, lane); tr_store(r, WT, dpitch, k0, drow0, scr, lane);
}
__device__ __forceinline__ void tr_segment(const Frame& F, const GAS float* W, int ldw, int K, int n0src, int ncols, GAS bf16* WT, int drow0, int& it) {
    LAS float* scr = (LAS float*)(F.lds + F.wave * 16384);
    const int gw = F.wg * NWAVES + F.wave, NGW = F.G * NWAVES;
    const int nblk = ncols / 32, nitems = (K / 64) * nblk;
    int first = (gw - (it % NGW) + NGW) % NGW;
    for (int r = first; r < nitems; r += NGW) { const int kb = r / nblk, nb = r % nblk; tr_item(W, ldw, 64 * kb, n0src + 32 * nb, WT, K, drow0 + 32 * nb, scr, F.lane); }
    it += nitems;
}
__device__ __forceinline__ void wprep_mixer(const Frame& F, int l, int wg0 = 0, int nwg = 256) {
    const int wgi = F.wg - wg0;
    const GAS float* win = inp(F, I_W_IN) + (size_t)l * D * DIN; int it = 0;
    GAS bf16* Wi = (GAS bf16*)(F.ws + WS_WIN); GAS bf16* Wg = (GAS bf16*)(F.ws + WS_WGATE); GAS bf16* Wb = (GAS bf16*)(F.ws + WS_WBR); GAS bf16* Wo = (GAS bf16*)(F.ws + WS_WOUT);
    const GAS float* wbr = inp(F, I_W_BRANCH) + (size_t)l * 3 * MIXW * D; const GAS float* wout = inp(F, I_W_OUT) + (size_t)l * D * D;
    const GAS float* pw = inp(F, I_POOL_W) + (size_t)l * 4 * 128 * 128; const GAS float* ps = inp(F, I_POOL_SCALE) + (size_t)l * MIXW; const GAS float* wb1 = wbr + (size_t)MIXW * D;
    const int pg = wgi >> 6, pd0 = (wgi & 63) * 16;
    float pv[32], bv[4]; const int dd0 = F.tid & 127, c0 = F.tid >> 7; const float psv = ps[pg * 128 + dd0];
#pragma unroll
    for (int k = 0; k < 32; ++k) pv[k] = pw[(pg * 128 + c0 + 4 * k) * 128 + dd0];
#pragma unroll
    for (int k = 0; k < 4; ++k) { const int i = F.tid + 512 * k; bv[k] = wb1[(size_t)(pg * 128 + (i >> 4)) * D + pd0 + (i & 15)]; }
    {
        LAS float* scr = (LAS float*)(F.lds + F.wave * 16384);
        const int gw = wgi * NWAVES + F.wave, NGW = nwg * NWAVES;
#define MIX_DECODE(ri_) const GAS float* src_; GAS bf16* dst_; int ldw_, k0_, n0_, dp_, dr_; \
        if (ri_ < 2048) { const int kb = ri_ >> 7, nbg = ri_ & 127; \
            n0_ = nbg < 48 ? C_QKV + 32 * nbg : nbg < 64 ? C_Z + 32 * (nbg - 48) : nbg < 80 ? C_POOL + 32 * (nbg - 64) : nbg < 88 ? C_MQ + 32 * (nbg - 80) : nbg < 96 ? C_MK + 32 * (nbg - 88) : nbg < 112 ? C_MV + 32 * (nbg - 96) : C_MO + 32 * (nbg - 112); \
            src_ = win; ldw_ = DIN; k0_ = 64 * kb; dst_ = Wi; dp_ = D; dr_ = 32 * nbg; } \
        else if (ri_ < 3584) { const int q = ri_ - 2048, kb = q / 96, nb = q - 96 * kb; src_ = win; ldw_ = DIN; k0_ = 64 * kb; n0_ = C_GATE + 32 * nb; dst_ = Wg; dp_ = D; dr_ = 32 * nb; } \
        else if (ri_ < 4096) { const int q = ri_ - 3584, br = q >> 8, kb = (q >> 5) & 7, nb = q & 31; src_ = wbr + (size_t)(2 * br) * MIXW * D; ldw_ = D; k0_ = 64 * kb; n0_ = 32 * nb; dst_ = Wb + (size_t)(2 * br) * D * MIXW; dp_ = MIXW; dr_ = 32 * nb; } \
        else { const int q = ri_ - 4096, kb = q >> 5, nb = q & 31; src_ = wout; ldw_ = D; k0_ = 64 * kb; n0_ = 32 * nb; dst_ = Wo; dp_ = D; dr_ = 32 * nb; }
#define MIX_LOAD(R, r_) do { const int ri_ = (r_); if (ri_ < 4608) { MIX_DECODE(ri_) (void)dst_; (void)dp_; (void)dr_; tr_load4(R, src_, ldw_, k0_, n0_, F.lane); } } while (0)
#define MIX_STORE(R, r_) do { const int ri_ = (r_); if (ri_ < 4608) { MIX_DECODE(ri_) (void)src_; (void)ldw_; (void)n0_; tr_store4(R, dst_, dp_, k0_, dr_, scr, F.lane); } } while (0)
        float ra[32], rb[32], rc[32];
        for (int r = gw; r < 4608; r += 3 * NGW) {
            MIX_LOAD(ra, r); MIX_LOAD(rb, r + NGW); MIX_LOAD(rc, r + 2 * NGW);
            MIX_STORE(ra, r); MIX_STORE(rb, r + NGW); MIX_STORE(rc, r + 2 * NGW);
        }
#undef MIX_DECODE
#undef MIX_LOAD
#undef MIX_STORE
    }
    GAS bf16* W1 = Wb + (size_t)D * MIXW;
    __syncthreads();
#pragma unroll 1
    for (int tile = wgi; tile < 256; tile += nwg) {
        const int g = tile >> 6, d0 = (tile & 63) * 16;
        LAS float* At = (LAS float*)F.lds;
        LAS float* Bs = (LAS float*)(F.lds + 129 * 128 * 4);
        float psv2 = psv;
        if (tile != wgi) {
            psv2 = ps[g * 128 + dd0];
#pragma unroll
            for (int k = 0; k < 32; ++k) pv[k] = pw[(g * 128 + c0 + 4 * k) * 128 + dd0];
#pragma unroll
            for (int k = 0; k < 4; ++k) { const int i = F.tid + 512 * k; bv[k] = wb1[(size_t)(g * 128 + (i >> 4)) * D + d0 + (i & 15)]; }
        }
#pragma unroll
        for (int k = 0; k < 32; ++k) At[dd0 * 129 + c0 + 4 * k] = pv[k] * psv2;
#pragma unroll
        for (int k = 0; k < 4; ++k) Bs[F.tid + 512 * k] = bv[k];
        __syncthreads();
        const int c = F.tid & 127, dq = F.tid >> 7;
        float a0 = 0.f, a1 = 0.f, a2 = 0.f, a3 = 0.f;
#pragma unroll 8
        for (int dd = 0; dd < 128; ++dd) { const float a = At[dd * 129 + c]; const f32x4 b = *(const LAS f32x4*)(Bs + dd * 16 + 4 * dq); a0 += a * b[0]; a1 += a * b[1]; a2 += a * b[2]; a3 += a * b[3]; }
        const int m = g * 128 + c; GAS bf16* o = W1 + (size_t)(d0 + 4 * dq) * MIXW + m;
        o[0] = (bf16)f2bf(a0); o[MIXW] = (bf16)f2bf(a1); o[2 * MIXW] = (bf16)f2bf(a2); o[3 * MIXW] = (bf16)f2bf(a3);
        __syncthreads();
    }
}
__device__ __forceinline__ void wprep_moe(const Frame& F, int l, int wg0, int nwg) {
    GAS bf16* W13 = (GAS bf16*)((GAS unsigned char*)F.out + 64 * MiB); GAS bf16* W2 = (GAS bf16*)(F.ws + WS_W2);
    LAS float* scr = (LAS float*)(F.lds + F.wave * 16384);
    const int gw = (F.wg - wg0) * NWAVES + F.wave, NGW = nwg * NWAVES;
    const GAS float* w1 = inp(F, I_MOE_W1); const GAS float* w3 = inp(F, I_MOE_W3); const GAS float* w2 = inp(F, I_MOE_W2);
#define MOE_ITEM_LOAD(R, r_) do { const int ri_ = (r_); if (ri_ < 16384) { const int e = ri_ >> 9, which = (ri_ >> 8) & 1, kb = (ri_ >> 4) & 15, nb = ri_ & 15; \
            tr_load4(R, (which ? w3 : w1) + ((size_t)l * NEXP + e) * D * DEXP, DEXP, 64 * kb, nb * 32, F.lane); } \
        else if (ri_ < 24576) { const int q = ri_ - 16384, e = q >> 8, kb = (q >> 5) & 7, nb = q & 31; tr_load4(R, w2 + ((size_t)l * NEXP + e) * DEXP * D, D, 64 * kb, 32 * nb, F.lane); } } while (0)
#define MOE_ITEM_STORE(R, r_) do { const int ri_ = (r_); if (ri_ < 16384) { const int e = ri_ >> 9, which = (ri_ >> 8) & 1, kb = (ri_ >> 4) & 15, nb = ri_ & 15, n0 = nb * 32; \
            tr_store4(R, W13 + (size_t)e * D * D, D, 64 * kb, (n0 >> 7) * 256 + which * 128 + (n0 & 127), scr, F.lane); } \
        else if (ri_ < 24576) { const int q = ri_ - 16384, e = q >> 8, kb = (q >> 5) & 7, nb = q & 31; tr_store4(R, W2 + (size_t)e * D * DEXP, DEXP, 64 * kb, 32 * nb, scr, F.lane); } } while (0)
    float ra[32], rb[32], rc[32], rd[32];
    MOE_ITEM_LOAD(ra, gw); MOE_ITEM_LOAD(rb, gw + NGW); MOE_ITEM_LOAD(rc, gw + 2 * NGW);
    for (int r = gw; r < 24576; r += 4 * NGW) {
        MOE_ITEM_LOAD(rd, r + 3 * NGW); MOE_ITEM_STORE(ra, r);
        MOE_ITEM_LOAD(ra, r + 4 * NGW); MOE_ITEM_STORE(rb, r + NGW);
        MOE_ITEM_LOAD(rb, r + 5 * NGW); MOE_ITEM_STORE(rc, r + 2 * NGW);
        MOE_ITEM_LOAD(rc, r + 6 * NGW); MOE_ITEM_STORE(rd, r + 3 * NGW);
    }
#undef MOE_ITEM_LOAD
#undef MOE_ITEM_STORE
}

#define LN_BAR() do { asm volatile("s_waitcnt lgkmcnt(0)" ::: "memory"); __builtin_amdgcn_s_barrier(); asm volatile("" ::: "memory"); } while (0)
constexpr int LN_HLO = 32768, LN_PART = 65536;
template <int MODE>
__device__ __forceinline__ void ln_phase(const Frame& F, const GAS float* gam, const GAS float* bet, const GAS float* w32src, int w32ld, bool do_proj, bool write_hb, bool dummy = false) {
    GAS float* OUTP = dummy ? (GAS float*)(F.ws + WS_R2) : F.out; GAS unsigned char* WSO = dummy ? (F.ws + WS_R2 + 40 * MiB) : F.ws;
    LAS int* lhist = (LAS int*)(F.lds + LHIST_OFF);
    if (MODE == 1 && F.tid < 32) lhist[F.tid] = 0;
    const int lane = F.lane, fr = lane & 15, fq = lane >> 4;
    bf16x8 Whi[4][2], Wlo[4][2];
    if (do_proj) {
#pragma unroll
        for (int t = 0; t < 4; ++t) {
#pragma unroll
            for (int nt = 0; nt < 2; ++nt) {
                const int o = 16 * nt + fr; int col = o;
                if (MODE != 1) { const int c4 = o >> 2; col = ((c4 < 2) ? (C_A + 4 * c4) : (c4 < 4) ? (C_B + 4 * (c4 - 2)) : (c4 < 6) ? (C_I + 4 * (c4 - 4)) : (C_F + 4 * (c4 - 6))) + (o & 3); }
                const GAS float* wp = w32src + (size_t)(32 * (4 * F.wave + t) + 8 * fq) * w32ld + col;
#pragma unroll
                for (int j = 0; j < 8; ++j) { const float w = wp[(size_t)j * w32ld]; const unsigned h = f2bf(w); Whi[t][nt][j] = (short)h; Wlo[t][nt][j] = (short)f2bf(w - bf2f(h)); }
            }
        }
    }
    __syncthreads();
    GAS bf16* hb = dummy ? (GAS bf16*)(F.ws + WS_R2 + 128 * MiB) : (GAS bf16*)(F.ws + WS_HB);
    const int rows_per_wg = T / F.G;
    const GAS int* posp = (const GAS int*)(F.ws + WS_POS); const GAS bf16* Yr = (const GAS bf16*)(F.ws + WS_YROWS);
    const GAS float* srcp = inp(F, I_X);
    const GAS bf16* preb = (MODE == 1) ? (const GAS bf16*)F.out : (const GAS bf16*)(F.ws + WS_HB);
    const int nrow = rows_per_wg / NWAVES, row0 = F.wg * rows_per_wg + F.wave * nrow;
    int posv = 0; if (MODE == 2) posv = posp[2 * row0 + (lane & 31)];
    float rbias = 0.f; if (MODE == 1) rbias = inp(F, I_ROUTER_B)[lane & 31];
#define LN_FETCH(R, Y0, Y1, i_) do { const int ii_ = (i_); const int rw_ = row0 + ii_; \
        if (MODE == 0) { _Pragma("unroll") for (int q = 0; q < 4; ++q) R[q] = __builtin_nontemporal_load((const GAS u32x4*)(srcp + (size_t)rw_ * D + 8 * lane + 512 * (q >> 1) + 4 * (q & 1))); } \
        else { _Pragma("unroll") for (int m = 0; m < 2; ++m) R[m] = __builtin_nontemporal_load((const GAS u32x4*)(preb + (size_t)rw_ * D + 8 * lane + 512 * m)); } \
        if (MODE == 2) { const int p0_ = __builtin_amdgcn_readlane(posv, 2 * ii_), p1_ = __builtin_amdgcn_readlane(posv, 2 * ii_ + 1); \
            _Pragma("unroll") for (int m = 0; m < 2; ++m) { Y0[m] = __builtin_nontemporal_load((const GAS u32x4*)(Yr + (size_t)p0_ * D + 8 * lane + 512 * m)); Y1[m] = __builtin_nontemporal_load((const GAS u32x4*)(Yr + (size_t)p1_ * D + 8 * lane + 512 * m)); } } } while (0)
    float gvr[16], bvr[16];
    {
#pragma unroll
        for (int q = 0; q < 4; ++q) { const f32x4 g4 = *(const GAS f32x4*)(gam + 8 * lane + 512 * (q >> 1) + 4 * (q & 1)), b4 = *(const GAS f32x4*)(bet + 8 * lane + 512 * (q >> 1) + 4 * (q & 1));
#pragma unroll
            for (int c = 0; c < 4; ++c) { gvr[4 * q + c] = g4[c]; bvr[4 * q + c] = b4[c]; } }
    }
    u32x4 rA[4], rB[4], yA0[2], yA1[2], yB0[2], yB1[2];
    LN_FETCH(rA, yA0, yA1, 0);
#pragma unroll 1
    for (int i2 = 0; i2 < nrow; i2 += 2) {
#pragma unroll
      for (int half = 0; half < 2; ++half) {
        const int i = i2 + half; const int row = row0 + i;
        const int nri = (i + 1 < nrow) ? i + 1 : i;
        if (half == 0) LN_FETCH(rB, yB0, yB1, nri); else LN_FETCH(rA, yA0, yA1, nri);
        float v[16];
#pragma unroll
        for (int m = 0; m < 2; ++m) {
#pragma unroll
            for (int q = 0; q < 4; ++q) {
                if (MODE == 0) { const u32x4 lo4 = half ? rB[2 * m] : rA[2 * m], hi4 = half ? rB[2 * m + 1] : rA[2 * m + 1];
                    v[8 * m + q] = __uint_as_float(lo4[q]); v[8 * m + 4 + q] = __uint_as_float(hi4[q]); }
                else { const unsigned u = half ? rB[m][q] : rA[m][q];
                    float x0 = __uint_as_float(u << 16), x1 = __uint_as_float(u & 0xffff0000u);
                    if (MODE == 2) { const unsigned ya = half ? yB0[m][q] : yA0[m][q], yb = half ? yB1[m][q] : yA1[m][q];
                        x0 = ALPHA * x0 + __uint_as_float(ya << 16) + __uint_as_float(yb << 16); x1 = ALPHA * x1 + __uint_as_float(ya & 0xffff0000u) + __uint_as_float(yb & 0xffff0000u); }
                    v[8 * m + 2 * q] = x0; v[8 * m + 2 * q + 1] = x1; }
            }
        }
        float s = 0.f;
#pragma unroll
        for (int c = 0; c < 16; ++c) s += v[c];
        const float mean = wave_sum(s) * (1.f / D);
        float s2 = 0.f;
#pragma unroll
        for (int c = 0; c < 16; ++c) { v[c] -= mean; s2 += v[c] * v[c]; }
        const float rstd = 1.0f / sqrtf(wave_sum(s2) * (1.f / D) + LN_EPS);
        {
#pragma unroll
            for (int c = 0; c < 16; ++c) v[c] = v[c] * rstd * gvr[c] + bvr[c];
        }
        if (!write_hb) {
#pragma unroll
            for (int q = 0; q < 4; ++q) __builtin_nontemporal_store((f32x4){v[4 * q], v[4 * q + 1], v[4 * q + 2], v[4 * q + 3]}, (GAS f32x4*)(OUTP + (size_t)row * D + 8 * lane + 512 * (q >> 1) + 4 * (q & 1)));
        }
        u32x4 hp[2];
#pragma unroll
        for (int m = 0; m < 2; ++m)
#pragma unroll
            for (int q = 0; q < 4; ++q) hp[m][q] = cvt_pk_bf16(v[8 * m + 2 * q], v[8 * m + 2 * q + 1]);
        if (write_hb) {
#pragma unroll
            for (int m = 0; m < 2; ++m) *(GAS u32x4*)(hb + (size_t)row * D + 8 * lane + 512 * m) = hp[m];
        }
        if (do_proj) {
            const int brow = F.wave + 8 * half;
#pragma unroll
            for (int m = 0; m < 2; ++m) {
                u32x4 lp;
#pragma unroll
                for (int q = 0; q < 4; ++q) lp[q] = cvt_pk_bf16(v[8 * m + 2 * q] - __uint_as_float(hp[m][q] << 16), v[8 * m + 2 * q + 1] - __uint_as_float(hp[m][q] & 0xffff0000u));
                const int a = brow * 2048 + (((lane + 64 * m) ^ brow) << 4);
                *(LAS u32x4*)(F.lds + a) = hp[m]; *(LAS u32x4*)(F.lds + LN_HLO + a) = lp;
            }
        }
      }
      if (!do_proj) continue;
      LN_BAR();
      {
        f32x4 a0 = {0.f, 0.f, 0.f, 0.f}, a1 = {0.f, 0.f, 0.f, 0.f};
        bf16x8 bh[4], bl[4];
#pragma unroll
        for (int t = 0; t < 4; ++t) { const int a = fr * 2048 + (((4 * (4 * F.wave + t) + fq) ^ fr) << 4); bh[t] = *(const LAS bf16x8*)(F.lds + a); bl[t] = *(const LAS bf16x8*)(F.lds + LN_HLO + a); }
#pragma unroll
        for (int t = 0; t < 4; ++t) {
            a0 = __builtin_amdgcn_mfma_f32_16x16x32_bf16(Whi[t][0], bh[t], a0, 0, 0, 0); a1 = __builtin_amdgcn_mfma_f32_16x16x32_bf16(Whi[t][1], bh[t], a1, 0, 0, 0);
            a0 = __builtin_amdgcn_mfma_f32_16x16x32_bf16(Whi[t][0], bl[t], a0, 0, 0, 0); a1 = __builtin_amdgcn_mfma_f32_16x16x32_bf16(Whi[t][1], bl[t], a1, 0, 0, 0);
            a0 = __builtin_amdgcn_mfma_f32_16x16x32_bf16(Wlo[t][0], bh[t], a0, 0, 0, 0); a1 = __builtin_amdgcn_mfma_f32_16x16x32_bf16(Wlo[t][1], bh[t], a1, 0, 0, 0);
        }
        *(LAS f32x4*)(F.lds + LN_PART + F.wave * 2048 + fr * 128 + (((0 + fq) ^ (fr & 7)) << 4)) = a0;
        *(LAS f32x4*)(F.lds + LN_PART + F.wave * 2048 + fr * 128 + (((4 + fq) ^ (fr & 7)) << 4)) = a1;
      }
      LN_BAR();
      {
        const int rsel = lane >> 5, o = lane & 31, brow = F.wave + 8 * rsel, row = row0 + i2 + rsel;
        const int pa = LN_PART + brow * 128 + (((o >> 2) ^ (brow & 7)) << 4) + (o & 3) * 4;
        float r1 = 0.f;
#pragma unroll
        for (int p8 = 0; p8 < 8; ++p8) r1 += *(const LAS float*)(F.lds + pa + p8 * 2048);
        if (MODE != 1) {
            ((GAS float*)(WSO + WS_SG))[(size_t)row * 32 + o] = r1;
        } else {
            const float score = sigmoidf_(r1);
            const float sel = score + rbias;
            const int hsel = lane & 32, gb = lane & ~3;
            const float v0 = __shfl(sel, gb + 0), v1 = __shfl(sel, gb + 1), v2 = __shfl(sel, gb + 2), v3 = __shfl(sel, gb + 3);
            int i1 = 0; float m1 = v0;
            if (v1 > m1) { m1 = v1; i1 = 1; } if (v2 > m1) { m1 = v2; i1 = 2; } if (v3 > m1) { m1 = v3; i1 = 3; }
            int ix2 = -1; float m2 = -3.0e38f;
            if (i1 != 0 && v0 > m2) { m2 = v0; ix2 = 0; } if (i1 != 1 && v1 > m2) { m2 = v1; ix2 = 1; } if (i1 != 2 && v2 > m2) { m2 = v2; ix2 = 2; } if (i1 != 3 && v3 > m2) { m2 = v3; ix2 = 3; }
            float gs = m1 + m2; int gi = o >> 2;
#pragma unroll
            for (int ofs = 4; ofs < 32; ofs <<= 1) { const float og = __shfl_xor(gs, ofs); const int oi = __shfl_xor(gi, ofs); if (og > gs || (og == gs && oi < gi)) { gs = og; gi = oi; } }
            const int src = hsel + gi * 4;
            const int e1 = gi * 4 + __shfl(i1, src), e2 = gi * 4 + __shfl(ix2, src);
            const float s1 = __shfl(score, hsel + e1), sc2 = __shfl(score, hsel + e2);
            if (o == 0) {
                GAS int* eid = (GAS int*)(WSO + WS_EID); GAS float* ew = (GAS float*)(WSO + WS_EW);
                const float inv = 1.0f / (s1 + sc2);
                eid[2 * row] = e1; eid[2 * row + 1] = e2; ew[2 * row] = s1 * inv; ew[2 * row + 1] = sc2 * inv;
                __hip_atomic_fetch_add(lhist + e1, 1, __ATOMIC_RELAXED, __HIP_MEMORY_SCOPE_WORKGROUP); __hip_atomic_fetch_add(lhist + e2, 1, __ATOMIC_RELAXED, __HIP_MEMORY_SCOPE_WORKGROUP);
            }
        }
      }
    }
#undef LN_FETCH
    if (MODE == 1) {
        __syncthreads();
        if (F.tid < 32) ((GAS int*)(WSO + WS_HIST))[F.wg * 32 + F.tid] = lhist[F.tid];
    }
    __syncthreads();
}

__device__ __forceinline__ int invsigma32(int w) { return 8 * ((w >> 2) & 3) + 4 * (w >> 4) + (w & 3); }
__device__ __forceinline__ float wave_incl_scan(float v, int lane) {
#pragma unroll
    for (int o = 1; o < 64; o <<= 1) { const float t = __shfl_up(v, o); if (lane >= o) v += t; }
    return v;
}
__device__ __forceinline__ float wave_incl_maxscan(float v, int lane) {
#pragma unroll
    for (int o = 1; o < 64; o <<= 1) { const float t = __shfl_up(v, o); if (lane >= o) v = fmaxf(v, t); }
    return v;
}
constexpr int DQ_OFF = 0, DK_OFF = 17408, DV_OFF = 34816, DGM_OFF = 52224, DQK_OFF = 69632, DTM_OFF = 87040, DVEC_OFF = 121856;
constexpr int QROW = 272;
constexpr int FROW = 68;
__device__ __forceinline__ bf16x8 pack_b(const f32x4 lo, const f32x4 hi) {
    u32x4 w; w.x = cvt_pk_bf16(lo[0], lo[1]); w.y = cvt_pk_bf16(lo[2], lo[3]); w.z = cvt_pk_bf16(hi[0], hi[1]); w.w = cvt_pk_bf16(hi[2], hi[3]);
    return __builtin_bit_cast(bf16x8, w);
}
__device__ __forceinline__ bf16x8 pack8f(const float (&f)[8]) {
    u32x4 w; w.x = cvt_pk_bf16(f[0], f[1]); w.y = cvt_pk_bf16(f[2], f[3]); w.z = cvt_pk_bf16(f[4], f[5]); w.w = cvt_pk_bf16(f[6], f[7]);
    return __builtin_bit_cast(bf16x8, w);
}
#define PREP_BAR() do { asm volatile("s_waitcnt lgkmcnt(0)" ::: "memory"); __builtin_amdgcn_s_barrier(); asm volatile("" ::: "memory"); } while (0)
#ifndef DNREP_A
#define DNREP_A 1
#endif
#ifndef DNREP_B
#define DNREP_B 1
#endif
#ifndef DNREP_C
#define DNREP_C 1
#endif
#ifndef DNREP_D
#define DNREP_D 1
#endif
__device__ __forceinline__ void dn_prep(const Frame& F, int l) {
    LAS unsigned char* L = F.lds;
    const int lane0 = F.lane, wave = F.wave;
    const GAS bf16* P = (const GAS bf16*)(F.ws + WS_PQKV);
    const GAS float* SG = (const GAS float*)(F.ws + WS_SG);
    const GAS float* cw = inp(F, I_CONV) + (size_t)l * 5 * 1536;
    LAS float* GM = (LAS float*)(L + DGM_OFF); LAS float* QKM = (LAS float*)(L + DQK_OFF);
#ifdef DIAG
    unsigned long long tacc[7] = {0, 0, 0, 0, 0, 0, 0}; unsigned long long tprev = __builtin_amdgcn_s_memrealtime(); unsigned long long tew = 0, tew2 = 0;
#define DSTAMP(k) do { const unsigned long long tn_ = __builtin_amdgcn_s_memrealtime(); tacc[k] += tn_ - tprev; tprev = tn_; } while (0)
#else
#define DSTAMP(k) do {} while (0)
#endif
    unsigned praw[12][3]; float pga = 0.f, pgb = 0.f, pal = 0.f, pdt = 0.f; f32x2 pcw[3][5];
    const GAS float* alog = inp(F, I_A_LOG); const GAS float* dtb = inp(F, I_DT_BIAS);
#define DN_PF(item_) do { const int it_ = (item_) < NB * NHEAD * NCH ? (item_) : F.wg; const int b_ = it_ >> 9, h_ = (it_ >> 7) & 3, n_ = it_ & 127; \
        _Pragma("unroll") for (int rr = 0; rr < 12; ++rr) { const int sp_ = n_ * CH + 8 * wave + rr - 2; const bool ok_ = (sp_ >= 0 && sp_ < SEQ); \
            const GAS bf16* src_ = P + (size_t)(b_ * SEQ + (ok_ ? sp_ : 0)) * 1536 + h_ * 128 + 2 * lane; \
            _Pragma("unroll") for (int p = 0; p < 3; ++p) praw[rr][p] = *(const GAS unsigned*)(src_ + p * 512); } \
        _Pragma("unroll") for (int p = 0; p < 3; ++p) _Pragma("unroll") for (int j = 0; j < 5; ++j) pcw[p][j] = *(const GAS f32x2*)(cw + j * 1536 + p * 512 + h_ * 128 + 2 * lane); \
        if (wave < 2) { const int ti_ = wave ? 63 - lane : lane; const int t0_ = b_ * SEQ + n_ * CH; pga = SG[(size_t)(t0_ + ti_) * 32 + wave * 4 + h_]; pgb = SG[(size_t)(t0_ + ti_) * 32 + 8 + wave * 4 + h_]; \
            pal = alog[l * 8 + wave * 4 + h_]; pdt = dtb[l * 8 + wave * 4 + h_]; } } while (0)
    { const int lane = lane0; DN_PF(F.wg); }
    for (int item = F.wg; item < NB * NHEAD * NCH; item += F.G) {
        int lane_ = lane0; asm volatile("" : "+v"(lane_));
        const int lane = lane_, fr = lane & 15, fq = lane >> 4, tid = wave * 64 + lane;
        const int b = item >> 9, h = (item >> 7) & 3, n = item & 127;
        const int t0 = b * SEQ + n * CH;
        for (int repA = 0; repA < DNREP_A; ++repA) {
        {
            float w[3][5][2];
#pragma unroll
            for (int p = 0; p < 3; ++p)
#pragma unroll
                for (int j = 0; j < 5; ++j) { const f32x2 t = pcw[p][j]; w[p][j][0] = t.x; w[p][j][1] = t.y; }
            f32x2 ya[8][3];
#pragma unroll
            for (int ii = 0; ii < 8; ++ii)
#pragma unroll
                for (int p = 0; p < 3; ++p) ya[ii][p] = (f32x2){0.f, 0.f};
#pragma unroll
            for (int rr = 0; rr < 12; ++rr) {
                const int spr = n * CH + 8 * wave + rr - 2; const bool okr = (spr >= 0 && spr < SEQ);
                f32x2 xs[3];
#pragma unroll
                for (int p = 0; p < 3; ++p) { const unsigned u = okr ? praw[rr][p] : 0u; xs[p] = (f32x2){bf2f(u & 0xffffu), __uint_as_float(u & 0xffff0000u)}; }
#pragma unroll
                for (int j = 0; j < 5; ++j) { const int ii = rr - j;
                    if (ii >= 0 && ii < 8) {
#pragma unroll
                        for (int p = 0; p < 3; ++p) ya[ii][p] += xs[p] * (f32x2){w[p][j][0], w[p][j][1]}; } }
            }
#pragma unroll
            for (int ii = 0; ii < 8; ++ii) {
                const int i = 8 * wave + ii;
                float y[3][2];
#pragma unroll
                for (int p = 0; p < 3; ++p) { y[p][0] = ya[ii][p].x * fast_sigmoid(ya[ii][p].x); y[p][1] = ya[ii][p].y * fast_sigmoid(ya[ii][p].y); }
                const float sq = wave_sum(y[0][0] * y[0][0] + y[0][1] * y[0][1]), sk = wave_sum(y[1][0] * y[1][0] + y[1][1] * y[1][1]);
                const float rq = __builtin_amdgcn_rsqf(sq + NORM_EPS) * 0.08838834764831845f, rk = __builtin_amdgcn_rsqf(sk + NORM_EPS);
                *(LAS unsigned*)(L + DQ_OFF + i * QROW + 4 * lane) = cvt_pk_bf16(y[0][0] * rq, y[0][1] * rq);
                *(LAS unsigned*)(L + DK_OFF + i * QROW + 4 * lane) = cvt_pk_bf16(y[1][0] * rk, y[1][1] * rk);
                *(LAS unsigned*)(L + DV_OFF + i * QROW + 4 * lane) = cvt_pk_bf16(y[2][0], y[2][1]);
            }
            if (wave < 2) {
                const int d = wave; const int ti = d ? 63 - lane : lane;
                const float a = pga, bb = pgb;
                const float beta = sigmoidf_(bb);
                const float g = -expf(pal) * softplusf_(a + pdt);
                const float gc = wave_incl_scan(g, lane);
                const float gl = __shfl(gc, 63);
                LAS float* vec = (LAS float*)(L + DVEC_OFF + d * 1024);
                vec[lane] = beta; vec[64 + lane] = gc; vec[128 + lane] = expf(gc); vec[192 + lane] = expf(gl - gc);
                if (lane == 63) ((GAS float*)(F.ws + WS_GL))[(size_t)item * 2 + d] = expf(gc);
            }
        }
        PREP_BAR();
        DSTAMP(0);
        }
        for (int repB = 0; repB < DNREP_B; ++repB) {
        {
#pragma unroll
            for (int tt = 0; tt < 2; ++tt) {
                const int t = 2 * wave + tt, mt = t >> 2, nt = t & 3;
                f32x4 ag = (f32x4){0.f, 0.f, 0.f, 0.f}, aq = (f32x4){0.f, 0.f, 0.f, 0.f};
#pragma unroll
                for (int s = 0; s < 4; ++s) {
                    const bf16x8 ka = *(const LAS bf16x8*)(L + DK_OFF + (16 * mt + fr) * QROW + 64 * s + 16 * fq);
                    const bf16x8 qa = *(const LAS bf16x8*)(L + DQ_OFF + (16 * mt + fr) * QROW + 64 * s + 16 * fq);
                    const bf16x8 kb = *(const LAS bf16x8*)(L + DK_OFF + (16 * nt + fr) * QROW + 64 * s + 16 * fq);
                    ag = __builtin_amdgcn_mfma_f32_16x16x32_bf16(ka, kb, ag, 0, 0, 0);
                    aq = __builtin_amdgcn_mfma_f32_16x16x32_bf16(qa, kb, aq, 0, 0, 0);
                }
#pragma unroll
                for (int r = 0; r < 4; ++r) { GM[(16 * mt + 4 * fq + r) * FROW + 16 * nt + fr] = ag[r]; QKM[(16 * mt + 4 * fq + r) * FROW + 16 * nt + fr] = aq[r]; }
            }
        }
        PREP_BAR();
        DSTAMP(1);
        }
        for (int repC = 0; repC < DNREP_C; ++repC) {
        {
            float gm[16], bi[16], gi[16], gj[2];
#pragma unroll
            for (int d = 0; d < 2; ++d) gj[d] = ((const LAS float*)(L + DVEC_OFF + d * 1024))[64 + lane];
#pragma unroll
            for (int e = 0; e < 16; ++e) { const int d = e >> 3, i = wave + 8 * (e & 7), ti = d ? 63 - i : i, tj = d ? 63 - lane : lane;
                const LAS float* vec = (const LAS float*)(L + DVEC_OFF + d * 1024);
                gm[e] = GM[ti * FROW + tj]; bi[e] = vec[i]; gi[e] = vec[64 + i]; }
            __builtin_amdgcn_sched_barrier(0);
#pragma unroll
            for (int e = 0; e < 16; ++e) { const int d = e >> 3, i = wave + 8 * (e & 7), j = lane;
                float v = (j < i) ? bi[e] * gm[e] * fexp(fminf(gi[e] - gj[d], 0.f)) : 0.f;
                if ((i & 15) == 0 && j >= (i & 48)) v = (j == i) ? 1.f : 0.f;
                *(LAS float*)(L + DTM_OFF + d * 17408 + (i * FROW + j) * 4) = v; }
        }
        PREP_BAR();
        DSTAMP(2);
        if (wave < 2) {
            {
                const int blk = lane >> 4, c = lane & 15;
                LAS float* TB = (LAS float*)(L + DTM_OFF + wave * 17408) + (16 * blk) * FROW + 16 * blk;
#pragma unroll 1
                for (int i = 1; i < 16; ++i) {
                    f32x4 m4[4]; float tv_[16];
#pragma unroll
                    for (int q = 0; q < 4; ++q) m4[q] = *(const LAS f32x4*)(TB + i * FROW + 4 * q);
#pragma unroll
                    for (int q = 0; q < 16; ++q) tv_[q] = TB[q * FROW + c];
                    float a0 = 0.f, a1 = 0.f, a2 = 0.f, a3 = 0.f;
#pragma unroll
                    for (int q = 0; q < 4; ++q) { a0 -= m4[q][0] * tv_[4 * q]; a1 -= m4[q][1] * tv_[4 * q + 1]; a2 -= m4[q][2] * tv_[4 * q + 2]; a3 -= m4[q][3] * tv_[4 * q + 3]; }
                    const float tv = ((c == i) ? 1.f : 0.f) + ((a0 + a1) + (a2 + a3));
                    asm volatile("s_waitcnt lgkmcnt(0)" ::: "memory"); TB[i * FROW + c] = tv;
                }
                asm volatile("s_waitcnt lgkmcnt(0)" ::: "memory");
            }
            {
                LAS float* TM = (LAS float*)(L + DTM_OFF + wave * 17408);
                const f32x4 z4 = {0.f, 0.f, 0.f, 0.f}; const bool kv = fq < 2; const int fk = fq & 1;
                f32x4 lo[2], hi[2], t22[2]; float xr[2][8];
#pragma unroll
                for (int b = 0; b < 2; ++b) { const int R0 = 32 * b + 16, C0 = 32 * b;
                    lo[b] = *(const LAS f32x4*)(TM + (R0 + fr) * FROW + C0 + 8 * fk); hi[b] = *(const LAS f32x4*)(TM + (R0 + fr) * FROW + C0 + 8 * fk + 4);
                    t22[b] = *(const LAS f32x4*)(TM + (R0 + fr) * FROW + R0 + 4 * fq);
#pragma unroll
                    for (int e = 0; e < 8; ++e) xr[b][e] = TM[(C0 + 8 * fk + e) * FROW + C0 + fr]; }
                __builtin_amdgcn_sched_barrier(0);
#pragma unroll
                for (int b = 0; b < 2; ++b) { const int R0 = 32 * b + 16, C0 = 32 * b;
                    const bf16x8 am = pack_b(kv ? lo[b] : z4, kv ? hi[b] : z4);
                    float xf[8];
#pragma unroll
                    for (int e = 0; e < 8; ++e) xf[e] = kv ? xr[b][e] : 0.f;
                    const bf16x8 bt = pack8f(xf);
                    const f32x4 X = __builtin_amdgcn_mfma_f32_16x16x32_bf16(am, bt, z4, 0, 0, 0);
                    const bf16x8 xb = pack_b(X, z4);
                    const bf16x8 a2 = pack_b(t22[b], z4);
                    const f32x4 t21 = __builtin_amdgcn_mfma_f32_16x16x32_bf16(a2, xb, z4, 0, 0, 0);
#pragma unroll
                    for (int r = 0; r < 4; ++r) TM[(R0 + 4 * fq + r) * FROW + C0 + fr] = -t21[r];
                }
                asm volatile("s_waitcnt lgkmcnt(0)" ::: "memory");
            }
            {
                LAS float* TM = (LAS float*)(L + DTM_OFF + wave * 17408);
                f32x4 mlo[2], mhi[2], tlo[2], thi[2]; float xr[2][8];
#pragma unroll
                for (int mt = 0; mt < 2; ++mt) { mlo[mt] = *(const LAS f32x4*)(TM + (32 + 16 * mt + fr) * FROW + 8 * fq); mhi[mt] = *(const LAS f32x4*)(TM + (32 + 16 * mt + fr) * FROW + 8 * fq + 4);
                    tlo[mt] = *(const LAS f32x4*)(TM + (32 + 16 * mt + fr) * FROW + 32 + 4 * fq); thi[mt] = *(const LAS f32x4*)(TM + (32 + 16 * mt + fr) * FROW + 32 + 16 + 4 * fq); }
#pragma unroll
                for (int nt = 0; nt < 2; ++nt)
#pragma unroll
                    for (int e = 0; e < 8; ++e) xr[nt][e] = TM[(8 * fq + e) * FROW + 16 * nt + fr];
                __builtin_amdgcn_sched_barrier(0);
                bf16x8 am[2], bt[2];
#pragma unroll
                for (int mt = 0; mt < 2; ++mt) am[mt] = pack_b(mlo[mt], mhi[mt]);
#pragma unroll
                for (int nt = 0; nt < 2; ++nt) bt[nt] = pack8f(xr[nt]);
                f32x4 X[2][2];
#pragma unroll
                for (int mt = 0; mt < 2; ++mt)
#pragma unroll
                    for (int nt = 0; nt < 2; ++nt) X[mt][nt] = __builtin_amdgcn_mfma_f32_16x16x32_bf16(am[mt], bt[nt], (f32x4){0.f, 0.f, 0.f, 0.f}, 0, 0, 0);
                bf16x8 xb[2], a2[2];
#pragma unroll
                for (int nt = 0; nt < 2; ++nt) xb[nt] = pack_b(X[0][nt], X[1][nt]);
#pragma unroll
                for (int mt = 0; mt < 2; ++mt) a2[mt] = pack_b(tlo[mt], thi[mt]);
#pragma unroll
                for (int mt = 0; mt < 2; ++mt)
#pragma unroll
                    for (int nt = 0; nt < 2; ++nt) { const f32x4 t21 = __builtin_amdgcn_mfma_f32_16x16x32_bf16(a2[mt], xb[nt], (f32x4){0.f, 0.f, 0.f, 0.f}, 0, 0, 0);
#pragma unroll
                        for (int r = 0; r < 4; ++r) TM[(32 + 16 * mt + 4 * fq + r) * FROW + 16 * nt + fr] = -t21[r]; }
            }
        } else if (wave >= 4) {
#ifdef DIAG
            const unsigned long long te0 = __builtin_amdgcn_s_memrealtime();
#endif
            const int tw = wave - 4;
#define BLO_(u) __uint_as_float((u) << 16)
#define BHI_(u) __uint_as_float((u) & 0xffff0000u)
            {
                const int c8 = lane & 15, base = ((8 * c8) & ~31) + 4 * (c8 & 3);
#pragma unroll 4
                for (int qq = 0; qq < 8; ++qq) {
                    const int row = 4 * (tw + 4 * qq) + (lane >> 4), d = row >> 6, i = row & 63, ti = d ? 63 - i : i;
                    const LAS float* vec = (const LAS float*)(L + DVEC_OFF + d * 1024);
                    const u32x2 lo = *(const LAS u32x2*)(L + DQ_OFF + ti * QROW + 2 * base), hi = *(const LAS u32x2*)(L + DQ_OFF + ti * QROW + 2 * (base + 16));
                    const float e = vec[128 + i];
                    u32x4 w; w.x = cvt_pk_bf16(BLO_(lo.x) * e, BHI_(lo.x) * e); w.y = cvt_pk_bf16(BLO_(lo.y) * e, BHI_(lo.y) * e); w.z = cvt_pk_bf16(BLO_(hi.x) * e, BHI_(hi.x) * e); w.w = cvt_pk_bf16(BLO_(hi.y) * e, BHI_(hi.y) * e);
                    __builtin_nontemporal_store(w, (GAS u32x4*)(F.ws + WS_R2 + ((size_t)item * 2 + d) * DNREC + DN_QG + (i * 128 + 8 * c8) * 2));
                }
            }
            {
                const int c = lane & 7, jb = 32 * (c >> 2) + 4 * (c & 3);
#pragma unroll 2
                for (int qq = 0; qq < 4; ++qq) {
                    const int row = 8 * (tw + 4 * qq) + (lane >> 3), d = row >> 6, i = row & 63, ti = d ? 63 - i : i;
                    const LAS float* vec = (const LAS float*)(L + DVEC_OFF + d * 1024);
                    const float gi = vec[64 + i];
                    float o[8];
#pragma unroll
                    for (int g = 0; g < 2; ++g) { const int j0 = jb + 16 * g;
                        const f32x4 gj = *(const LAS f32x4*)(vec + 64 + j0);
                        const f32x4 qk = *(const LAS f32x4*)(QKM + ti * FROW + (d ? 60 - j0 : j0));
#pragma unroll
                        for (int e = 0; e < 4; ++e) { const float x = d ? qk[3 - e] : qk[e]; o[4 * g + e] = (j0 + e <= i) ? x * fexp(fminf(gi - gj[e], 0.f)) : 0.f; } }
                    u32x4 w; w.x = cvt_pk_bf16(o[0], o[1]); w.y = cvt_pk_bf16(o[2], o[3]); w.z = cvt_pk_bf16(o[4], o[5]); w.w = cvt_pk_bf16(o[6], o[7]);
                    __builtin_nontemporal_store(w, (GAS u32x4*)(F.ws + WS_R2 + ((size_t)item * 2 + d) * DNREC + DN_ATT + (i * 64 + 8 * c) * 2));
                }
            }
            {
                const int c = lane & 7, jb = 32 * (c >> 2) + 4 * (c & 3);
#pragma unroll 2
                for (int qq = 0; qq < 4; ++qq) {
                    const int P = 8 * (tw + 4 * qq) + (lane >> 3), d = P >> 6, kk = 2 * (P & 63);
                    const LAS float* vec = (const LAS float*)(L + DVEC_OFF + d * 1024);
                    float ra[8], rb[8];
#pragma unroll
                    for (int g = 0; g < 2; ++g) { const int j0 = jb + 16 * g;
                        const f32x4 ej = *(const LAS f32x4*)(vec + 192 + j0);
#pragma unroll
                        for (int e = 0; e < 4; ++e) { const int j = j0 + e, tj = d ? 63 - j : j;
                            const unsigned u = *(const LAS unsigned*)(L + DK_OFF + tj * QROW + 2 * kk);
                            ra[4 * g + e] = BLO_(u) * ej[e]; rb[4 * g + e] = BHI_(u) * ej[e]; } }
                    GAS bf16* Kd = (GAS bf16*)(F.ws + WS_R2 + ((size_t)item * 2 + d) * DNREC + DN_KDT);
                    u32x4 w; w.x = cvt_pk_bf16(ra[0], ra[1]); w.y = cvt_pk_bf16(ra[2], ra[3]); w.z = cvt_pk_bf16(ra[4], ra[5]); w.w = cvt_pk_bf16(ra[6], ra[7]);
                    __builtin_nontemporal_store(w, (GAS u32x4*)(Kd + kk * 64 + 8 * c));
                    w.x = cvt_pk_bf16(rb[0], rb[1]); w.y = cvt_pk_bf16(rb[2], rb[3]); w.z = cvt_pk_bf16(rb[4], rb[5]); w.w = cvt_pk_bf16(rb[6], rb[7]);
                    __builtin_nontemporal_store(w, (GAS u32x4*)(Kd + (kk + 1) * 64 + 8 * c));
                }
            }
#undef BLO_
#undef BHI_
#ifdef DIAG
            tew += __builtin_amdgcn_s_memrealtime() - te0;
#endif
        }
        PREP_BAR();
        DSTAMP(3);
        DSTAMP(4);
        }
        DN_PF(item + F.G);
#ifdef DIAG
        const unsigned long long td0 = __builtin_amdgcn_s_memrealtime();
#endif
        for (int repD = 0; repD < DNREP_D; ++repD) {
#pragma unroll 1
        for (int d = 0; d < 2; ++d) {
            const LAS float* TM = (const LAS float*)(L + DTM_OFF + d * 17408);
            const LAS float* vec = (const LAS float*)(L + DVEC_OFF + d * 1024);
            GAS unsigned char* rec = F.ws + WS_R2 + ((size_t)item * 2 + d) * DNREC;
            bf16x8 ta[4][2];
#pragma unroll
            for (int mt = 0; mt < 4; ++mt)
#pragma unroll
                for (int s = 0; s < 2; ++s) { const f32x4 lo = *(const LAS f32x4*)(TM + (16 * mt + fr) * FROW + 32 * s + 8 * fq), hi = *(const LAS f32x4*)(TM + (16 * mt + fr) * FROW + 32 * s + 8 * fq + 4); ta[mt][s] = pack_b(lo, hi); }
            const bool isv = wave < 4; const int imgoff = isv ? DV_OFF : DK_OFF;
            f32x4 cf[2][2], cg[2][2]; unsigned short raw[2][16];
#pragma unroll
            for (int s = 0; s < 2; ++s) { cf[s][0] = *(const LAS f32x4*)(vec + 32 * s + 8 * fq); cf[s][1] = *(const LAS f32x4*)(vec + 32 * s + 8 * fq + 4);
                if (!isv) { cg[s][0] = *(const LAS f32x4*)(vec + 128 + 32 * s + 8 * fq); cg[s][1] = *(const LAS f32x4*)(vec + 128 + 32 * s + 8 * fq + 4); } }
#pragma unroll
            for (int tt = 0; tt < 2; ++tt)
#pragma unroll
                for (int s = 0; s < 2; ++s)
#pragma unroll
                    for (int e = 0; e < 8; ++e) { const int j = 32 * s + 8 * fq + e, tj = d ? 63 - j : j;
                        raw[tt][8 * s + e] = *(const LAS unsigned short*)(L + imgoff + tj * QROW + 2 * (16 * ((2 * wave + tt) & 7) + fr)); }
            __builtin_amdgcn_sched_barrier(0);
            if (!isv) {
#pragma unroll
                for (int s = 0; s < 2; ++s) { cf[s][0] *= cg[s][0]; cf[s][1] *= cg[s][1]; }
            }
#define DN_XB(xb_, tt_) do { _Pragma("unroll") for (int s = 0; s < 2; ++s) { float xf[8]; \
                    _Pragma("unroll") for (int e = 0; e < 8; ++e) xf[e] = bf2f(raw[tt_][8 * s + e]) * cf[s][e >> 2][e & 3]; \
                    xb_[s] = pack8f(xf); } } while (0)
            if (isv) {
#pragma unroll
                for (int tt = 0; tt < 2; ++tt) {
                    const int nt = 2 * wave + tt;
                    bf16x8 xb[2]; DN_XB(xb, tt);
                    f32x4 acc[4];
#pragma unroll
                    for (int mt = 0; mt < 4; ++mt) { acc[mt] = (f32x4){0.f, 0.f, 0.f, 0.f};
#pragma unroll
                        for (int s = 0; s < 2; ++s) acc[mt] = __builtin_amdgcn_mfma_f32_16x16x32_bf16(ta[mt][s], xb[s], acc[mt], 0, 0, 0); }
                    GAS bf16* Uf = (GAS bf16*)(rec + DN_UF) + ((nt * 64 + lane) * 16);
                    u32x4 w0, w1; w0.x = cvt_pk_bf16(acc[0][0], acc[0][1]); w0.y = cvt_pk_bf16(acc[0][2], acc[0][3]); w0.z = cvt_pk_bf16(acc[1][0], acc[1][1]); w0.w = cvt_pk_bf16(acc[1][2], acc[1][3]);
                    w1.x = cvt_pk_bf16(acc[2][0], acc[2][1]); w1.y = cvt_pk_bf16(acc[2][2], acc[2][3]); w1.z = cvt_pk_bf16(acc[3][0], acc[3][1]); w1.w = cvt_pk_bf16(acc[3][2], acc[3][3]);
                    __builtin_nontemporal_store(w0, (GAS u32x4*)Uf); __builtin_nontemporal_store(w1, (GAS u32x4*)(Uf + 8));
                }
            } else {
                u32x2 pk[4];
                GAS bf16* Wp = (GAS bf16*)(rec + DN_W) + 32 * (wave - 4) + 8 * fq;
#pragma unroll
                for (int tt = 0; tt < 2; ++tt) {
                    bf16x8 xb[2]; DN_XB(xb, tt);
                    f32x4 acc[4];
#pragma unroll
                    for (int mt = 0; mt < 4; ++mt) { acc[mt] = (f32x4){0.f, 0.f, 0.f, 0.f};
#pragma unroll
                        for (int s = 0; s < 2; ++s) acc[mt] = __builtin_amdgcn_mfma_f32_16x16x32_bf16(xb[s], ta[mt][s], acc[mt], 0, 0, 0); }
                    if (tt == 0) {
#pragma unroll
                        for (int mt = 0; mt < 4; ++mt) { pk[mt].x = cvt_pk_bf16(acc[mt][0], acc[mt][1]); pk[mt].y = cvt_pk_bf16(acc[mt][2], acc[mt][3]); }
                    } else {
#pragma unroll
                        for (int mt = 0; mt < 4; ++mt) { u32x4 w; w.x = pk[mt].x; w.y = pk[mt].y; w.z = cvt_pk_bf16(acc[mt][0], acc[mt][1]); w.w = cvt_pk_bf16(acc[mt][2], acc[mt][3]);
                            __builtin_nontemporal_store(w, (GAS u32x4*)(Wp + (16 * mt + fr) * 128)); }
                    }
                }
            }
#undef DN_XB
        }
#ifdef DIAG
        if (wave == 7) tew2 += __builtin_amdgcn_s_memrealtime() - td0;
#endif
        DSTAMP(6);
        PREP_BAR();
        DSTAMP(5);
        }
    }
#ifdef DIAG
    if (F.tid == 0 && F.wg == 0 && l == 0) { for (int k = 0; k < 7; ++k) ((GAS unsigned long long*)(F.ws + WS_CTL + 1024))[48 + k] = tacc[k]; }
    if (F.tid == 256 && F.wg == 0 && l == 0) ((GAS unsigned long long*)(F.ws + WS_CTL + 1024))[55] = tew;
    if (F.tid == 448 && F.wg == 0 && l == 0) ((GAS unsigned long long*)(F.ws + WS_CTL + 1024))[56] = tew2;
#endif
}

__device__ __forceinline__ int swz256(int row, int c16) { return row * 256 + ((c16 ^ (row & 15)) << 4); }
__device__ __forceinline__ int swz128(int row, int c8) { return (row >> 1) * 256 + (((((row & 1) << 3) | c8) ^ ((row >> 1) & 15)) << 4); }
constexpr int DNBUF = 57344;
#define SCAN_BAR() do { asm volatile("s_waitcnt lgkmcnt(0)" ::: "memory"); __builtin_amdgcn_s_barrier(); asm volatile("" ::: "memory"); } while (0)
__device__ __forceinline__ void dn_scan(const Frame& F) {
    if (F.wg >= 128) return;
    const int xcd = F.wg & 7, idx = F.wg >> 3;
    const int chain = xcd * 4 + (idx >> 2), qtr = idx & 3;
    const int b = chain >> 3, h = (chain >> 1) & 3, d = chain & 1;
    const int lane = F.lane, fr = lane & 15, fq = lane >> 4, wave = F.wave;
    LAS unsigned char* L = F.lds;
    const GAS unsigned char* recbase = F.ws + WS_R2;
    const int itembase = (b * NHEAD + h) * NCH;
    if (wave >= 2) {
        const int tl = F.tid - 128;
        u32x4 ra[10], rb[10];
        int woff[10];
#pragma unroll
        for (int i = 0; i < 10; ++i) { const int q = tl + 384 * i;
            if (q < 1024) woff[i] = swz256(q >> 4, q & 15); else if (q < 2048) woff[i] = 16384 + swz256((q - 1024) >> 4, q & 15);
            else if (q < 3072) woff[i] = 32768 + swz128((q - 2048) >> 3, q & 7); else if (q < 3584) woff[i] = 49152 + swz128((q - 3072) >> 3, q & 7); else woff[i] = -1; }
#define DN_LOAD(R, step_) do { const int st_ = (step_) < NCH ? (step_) : NCH - 1; const int n_ = d ? (NCH - 1 - st_) : st_; \
        const GAS u32x4* src_ = (const GAS u32x4*)(recbase + ((size_t)(itembase + n_) * 2 + d) * DNREC) + tl; \
        _Pragma("unroll") for (int i = 0; i < 10; ++i) R[i] = src_[(woff[i] >= 0) ? 384 * i : 0]; } while (0)
#define DN_WRITE(R, bufoff_) do { _Pragma("unroll") for (int i = 0; i < 10; ++i) if (woff[i] >= 0) *(LAS u32x4*)(L + (bufoff_) + woff[i]) = R[i]; } while (0)
        u32x4 rc[10];
        DN_LOAD(ra, 0); DN_LOAD(rb, 1); DN_LOAD(rc, 2);
        DN_WRITE(ra, 0);
        SCAN_BAR();
        for (int s = 0; s < 126; s += 6) {
            DN_LOAD(ra, s + 3); DN_WRITE(rb, DNBUF); SCAN_BAR();
            DN_LOAD(rb, s + 4); DN_WRITE(rc, 0);     SCAN_BAR();
            DN_LOAD(rc, s + 5); DN_WRITE(ra, DNBUF); SCAN_BAR();
            DN_LOAD(ra, s + 6); DN_WRITE(rb, 0);     SCAN_BAR();
            DN_LOAD(rb, s + 7); DN_WRITE(rc, DNBUF); SCAN_BAR();
            DN_LOAD(rc, s + 8); DN_WRITE(ra, 0);     SCAN_BAR();
        }
        DN_WRITE(rb, DNBUF); SCAN_BAR();
        SCAN_BAR();
#undef DN_LOAD
#undef DN_WRITE
        return;
    }
    const int slice = qtr * 2 + wave;
    const GAS float* GL = (const GAS float*)(F.ws + WS_GL);
    GAS bf16* O = (GAS bf16*)(F.ws + (d ? WS_OB : WS_OF));
    f32x4 S[8];
#pragma unroll
    for (int k = 0; k < 8; ++k) S[k] = (f32x4){0.f, 0.f, 0.f, 0.f};
    int offw[4], offk[8], offa[4];
#pragma unroll
    for (int t = 0; t < 4; ++t) { offw[t] = (16 * t + fr) * 256; offa[t] = ((16 * t + fr) >> 1) * 256; }
#pragma unroll
    for (int t = 0; t < 8; ++t) offk[t] = ((16 * t + fr) >> 1) * 256;
    const int x256 = fr & 15;
    const int x128 = (fr >> 1) & 15, p128 = (fr & 1) << 3;
    u32x4 uc0, uc1, un0, un1; float egl_c, egl_n;
    int vz = 0; asm volatile("" : "+v"(vz));
#define DN_UFETCH(A0, A1, EG, step_) do { const int st_ = (step_) < NCH ? (step_) : NCH - 1; const int nn_ = d ? (NCH - 1 - st_) : st_; \
        const GAS bf16* Uf_ = (const GAS bf16*)(recbase + ((size_t)(itembase + nn_) * 2 + d) * DNREC + DN_UF); A0 = *(const GAS u32x4*)(Uf_ + (slice * 64 + lane) * 16); A1 = *(const GAS u32x4*)(Uf_ + (slice * 64 + lane) * 16 + 8); \
        EG = GL[(size_t)(itembase + nn_) * 2 + d + vz]; } while (0)
    DN_UFETCH(uc0, uc1, egl_c, 0); DN_UFETCH(un0, un1, egl_n, 1);
    SCAN_BAR();
    for (int step = 0; step < NCH; ++step) {
        const int n = d ? (NCH - 1 - step) : step;
        const int bufoff = (step & 1) ? DNBUF : 0;
        const u32x4 u0 = uc0, u1 = uc1; const float egl = egl_c;
        uc0 = un0; uc1 = un1; egl_c = egl_n;
        DN_UFETCH(un0, un1, egl_n, step + 2);
        const LAS unsigned char* Bw = L + bufoff; const LAS unsigned char* Bq = Bw + 16384; const LAS unsigned char* Bk = Bw + 32768; const LAS unsigned char* Ba = Bw + 49152;
#define LD_WQ(G, s_) do { _Pragma("unroll") for (int mt = 0; mt < 4; ++mt) { const int o_ = offw[mt] + (((4 * (s_) + fq) ^ x256) << 4); G[mt] = *(const LAS bf16x8*)(Bw + o_); G[4 + mt] = *(const LAS bf16x8*)(Bq + o_); } } while (0)
#define MM_WQ(G, s_) do { _Pragma("unroll") for (int mt = 0; mt < 4; ++mt) { V[mt] = __builtin_amdgcn_mfma_f32_16x16x32_bf16(G[mt], SB[s_], V[mt], 0, 0, 0); Q[mt] = __builtin_amdgcn_mfma_f32_16x16x32_bf16(SB[s_], G[4 + mt], Q[mt], 0, 0, 0); } } while (0)
#define LD_K(G, s2_) do { _Pragma("unroll") for (int kt = 0; kt < 8; ++kt) { const int xr_ = (8 * kt + (fr >> 1)) & 15; G[kt] = *(const LAS bf16x8*)(Bk + offk[kt] + (((p128 | (4 * (s2_) + fq)) ^ xr_) << 4)); } } while (0)
#define SCHED_() __builtin_amdgcn_sched_barrier(0)
        bf16x8 g0[8], g1[8];
        LD_WQ(g0, 0);
        bf16x8 SB[4];
#pragma unroll
        for (int s = 0; s < 4; ++s) SB[s] = pack_b(S[2 * s], S[2 * s + 1]);
        f32x4 V[4], Q[4];
#pragma unroll
        for (int mt = 0; mt < 4; ++mt) { V[mt] = (f32x4){0.f, 0.f, 0.f, 0.f}; Q[mt] = (f32x4){0.f, 0.f, 0.f, 0.f}; }
        SCHED_(); LD_WQ(g1, 1); SCHED_(); MM_WQ(g0, 0); SCHED_();
        LD_WQ(g0, 2); SCHED_(); MM_WQ(g1, 1); SCHED_();
        LD_WQ(g1, 3); SCHED_(); MM_WQ(g0, 2); SCHED_();
#pragma unroll
        for (int s2 = 0; s2 < 2; ++s2)
#pragma unroll
            for (int mt = 0; mt < 4; ++mt) { const int xr = (8 * mt + (fr >> 1)) & 15; g0[s2 * 4 + mt] = *(const LAS bf16x8*)(Ba + offa[mt] + (((p128 | (4 * s2 + fq)) ^ xr) << 4)); }
        SCHED_(); MM_WQ(g1, 3); SCHED_();
        LD_K(g1, 0); SCHED_();
        {
            float uu[16]; { float t[8]; unpack8(u0, t);
#pragma unroll
                for (int e = 0; e < 8; ++e) uu[e] = t[e]; unpack8(u1, t);
#pragma unroll
                for (int e = 0; e < 8; ++e) uu[8 + e] = t[e]; }
#pragma unroll
            for (int mt = 0; mt < 4; ++mt)
#pragma unroll
                for (int r = 0; r < 4; ++r) V[mt][r] = uu[mt * 4 + r] - V[mt][r];
        }
        bf16x8 VB[2];
#pragma unroll
        for (int s2 = 0; s2 < 2; ++s2) VB[s2] = pack_b(V[2 * s2], V[2 * s2 + 1]);
#pragma unroll
        for (int kt = 0; kt < 8; ++kt) S[kt] = S[kt] * egl;
        SCHED_();
#pragma unroll
        for (int s2 = 0; s2 < 2; ++s2)
#pragma unroll
            for (int mt = 0; mt < 4; ++mt) Q[mt] = __builtin_amdgcn_mfma_f32_16x16x32_bf16(VB[s2], g0[s2 * 4 + mt], Q[mt], 0, 0, 0);
        SCHED_(); LD_K(g0, 1); SCHED_();
#pragma unroll
        for (int kt = 0; kt < 8; ++kt) S[kt] = __builtin_amdgcn_mfma_f32_16x16x32_bf16(g1[kt], VB[0], S[kt], 0, 0, 0);
        SCHED_();
#pragma unroll
        for (int kt = 0; kt < 8; ++kt) S[kt] = __builtin_amdgcn_mfma_f32_16x16x32_bf16(g0[kt], VB[1], S[kt], 0, 0, 0);
        SCHED_();
#undef LD_WQ
#undef MM_WQ
#undef LD_K
#undef SCHED_
#pragma unroll
        for (int mt = 0; mt < 4; ++mt) {
            const int i = 16 * mt + fr; const int tok = b * SEQ + n * CH + (d ? 63 - i : i);
            u32x2 w2; w2.x = cvt_pk_bf16(Q[mt][0], Q[mt][1]); w2.y = cvt_pk_bf16(Q[mt][2], Q[mt][3]);
            *(GAS u32x2*)(O + (size_t)tok * MIXW + h * HD + slice * 16 + 4 * fq) = w2;
        }
        SCAN_BAR();
    }
}

constexpr int MQ_OFF = 0, MK_OFF = 9216, MV_OFF = 18432, MQK_OFF = 35840, MVEC_OFF = 52480;
constexpr int MQROW = 144;
#ifndef MLREP_1
#define MLREP_1 1
#endif
#ifndef MLREP_2
#define MLREP_2 1
#endif
#ifndef MLREP_3
#define MLREP_3 1
#endif
#ifndef MLREP_4
#define MLREP_4 1
#endif
#ifndef POOLREP
#define POOLREP 1
#endif
__device__ __forceinline__ void ml_prep(const Frame& F, int l) {
    LAS unsigned char* L = F.lds;
    const int lane = F.lane, wave = F.wave, tid = F.tid;
    const GAS bf16* PQ = (const GAS bf16*)(F.ws + WS_PMQ); const GAS bf16* PK = (const GAS bf16*)(F.ws + WS_PMK); const GAS bf16* PV = (const GAS bf16*)(F.ws + WS_PMV);
    const GAS float* SG = (const GAS float*)(F.ws + WS_SG);
    const GAS float* gbias = inp(F, I_ML_GATE_B) + l * 16;
    u32x4 pq, pk, pv0, pv1; float pip = 0.f, pfp = 0.f, pgi = 0.f, pgf = 0.f;
#define ML_PF(item_) do { const int it_ = (item_) < NB * NHEAD * NCH ? (item_) : F.wg; const int b_ = it_ >> 9, h_ = (it_ >> 7) & 3, n_ = it_ & 127; const int t0_ = b_ * SEQ + n_ * CH; \
        const int row_ = tid >> 3, c8_ = tid & 7; \
        pq = *(const GAS u32x4*)(PQ + (size_t)(t0_ + row_) * 256 + h_ * 64 + 8 * c8_); pk = *(const GAS u32x4*)(PK + (size_t)(t0_ + row_) * 256 + h_ * 64 + 8 * c8_); \
        pv0 = *(const GAS u32x4*)(PV + (size_t)(t0_ + (tid >> 4)) * 512 + h_ * 128 + 8 * (tid & 15)); pv1 = *(const GAS u32x4*)(PV + (size_t)(t0_ + 32 + (tid >> 4)) * 512 + h_ * 128 + 8 * (tid & 15)); \
        if (wave < 2) { const int ti_ = wave ? 63 - lane : lane; pip = SG[(size_t)(t0_ + ti_) * 32 + 16 + wave * 4 + h_]; pfp = SG[(size_t)(t0_ + ti_) * 32 + 24 + wave * 4 + h_]; pgi = gbias[wave * 4 + h_]; pgf = gbias[8 + wave * 4 + h_]; } } while (0)
    ML_PF(F.wg);
    for (int item = F.wg; item < NB * NHEAD * NCH; item += F.G) {
        const int b = item >> 9, h = (item >> 7) & 3, n = item & 127;
        const int t0 = b * SEQ + n * CH;
        float ip_raw = pip, fp_raw = pfp; const float gbi = pgi, gbf = pgf;
        for (int rep1 = 0; rep1 < MLREP_1; ++rep1) {
        {
            const int row = tid >> 3, c8 = tid & 7;
            u32x4 k = pk;
            { float f[8]; unpack8(k, f); k.x = cvt_pk_bf16(f[0] * 0.125f, f[1] * 0.125f); k.y = cvt_pk_bf16(f[2] * 0.125f, f[3] * 0.125f); k.z = cvt_pk_bf16(f[4] * 0.125f, f[5] * 0.125f); k.w = cvt_pk_bf16(f[6] * 0.125f, f[7] * 0.125f); }
            *(LAS u32x4*)(L + MQ_OFF + row * MQROW + 16 * c8) = pq;
            *(LAS u32x4*)(L + MK_OFF + row * MQROW + 16 * c8) = k;
            *(LAS u32x4*)(L + MV_OFF + (tid >> 4) * QROW + 16 * (tid & 15)) = pv0;
            *(LAS u32x4*)(L + MV_OFF + (32 + (tid >> 4)) * QROW + 16 * (tid & 15)) = pv1;
            ML_PF(item + F.G);
        }
        PREP_BAR();
        }
        for (int rep2 = 0; rep2 < MLREP_2; ++rep2) {
        {
            const int fr = lane & 15, fq = lane >> 4;
#pragma unroll
            for (int tt = 0; tt < 2; ++tt) {
                const int t = 2 * wave + tt, mt = t >> 2, nt = t & 3;
                f32x4 aq = (f32x4){0.f, 0.f, 0.f, 0.f};
#pragma unroll
                for (int s2 = 0; s2 < 2; ++s2) {
                    const bf16x8 qa = *(const LAS bf16x8*)(L + MQ_OFF + (16 * mt + fr) * MQROW + 64 * s2 + 16 * fq);
                    const bf16x8 kb = *(const LAS bf16x8*)(L + MK_OFF + (16 * nt + fr) * MQROW + 64 * s2 + 16 * fq);
                    aq = __builtin_amdgcn_mfma_f32_16x16x32_bf16(qa, kb, aq, 0, 0, 0);
                }
#pragma unroll
                for (int r = 0; r < 4; ++r) *(LAS float*)(L + MQK_OFF + ((16 * mt + 4 * fq + r) * 65 + 16 * nt + fr) * 4) = aq[r];
            }
        }
        }
        for (int rep3 = 0; rep3 < MLREP_3; ++rep3) {
        if (wave < 2) {
            const int d = wave; const int ti = d ? 63 - lane : lane;
            const float ip = ip_raw + gbi;
            const float fp = fp_raw + gbf;
            const float bc = wave_incl_scan(logsigmoidf_(fp), lane);
            const float bl = __shfl(bc, 63);
            const float lw = bl - bc + ip;
            const float am = wave_max(lw);
            const float wgt = expf(lw - am);
            const float ipb = ip - bc;
            const float dmax = bc + wave_incl_maxscan(ipb, lane);
            LAS float* vec = (LAS float*)(L + MVEC_OFF + d * 1024);
            vec[lane] = bc; vec[64 + lane] = dmax; vec[128 + lane] = wgt; vec[192 + lane] = ipb;
            GAS float* row = (GAS float*)(F.ws + WS_ML + ((size_t)item * 2 + d) * MLREC + ML_ROW);
            row[lane] = bc; row[64 + lane] = dmax; if (lane == 0) { row[128] = am; row[129] = bl; }
        }
        PREP_BAR();
        }
        for (int rep4 = 0; rep4 < MLREP_4; ++rep4) {
        {
            const LAS float* QKM = (const LAS float*)(L + MQK_OFF);
#define BLO_(u) __uint_as_float((u) << 16)
#define BHI_(u) __uint_as_float((u) & 0xffff0000u)
            const int c = lane & 7, rsub = lane >> 3;
#pragma unroll
            for (int gg = 0; gg < 2; ++gg) {
                const int row = 8 * (wave + 8 * gg) + rsub, d = row >> 6, i = row & 63, ti = d ? 63 - i : i;
                const LAS float* vec = (const LAS float*)(L + MVEC_OFF + d * 1024);
                GAS unsigned char* rec = F.ws + WS_ML + ((size_t)item * 2 + d) * MLREC;
                const float bi = vec[i], di = vec[64 + i];
                const f32x4 ib0 = *(const LAS f32x4*)(vec + 192 + 8 * c), ib1 = *(const LAS f32x4*)(vec + 192 + 8 * c + 4);
                float qk[8];
#pragma unroll
                for (int e = 0; e < 8; ++e) { const int j = 8 * c + e, tj = d ? 63 - j : j; qk[e] = QKM[ti * 65 + tj]; }
                const int base = 32 * (c >> 2) + 4 * (c & 3);
                const u32x2 qlo = *(const LAS u32x2*)(L + MQ_OFF + ti * MQROW + 2 * base), qhi = *(const LAS u32x2*)(L + MQ_OFF + ti * MQROW + 2 * (base + 16));
                float o[8];
#pragma unroll
                for (int e = 0; e < 8; ++e) { const int j = 8 * c + e; const float ib = (e < 4) ? ib0[e & 3] : ib1[e & 3];
                    o[e] = (j <= i) ? qk[e] * fexp(fminf(bi + ib - di, 0.f)) : 0.f; }
                u32x4 w; w.x = cvt_pk_bf16(o[0], o[1]); w.y = cvt_pk_bf16(o[2], o[3]); w.z = cvt_pk_bf16(o[4], o[5]); w.w = cvt_pk_bf16(o[6], o[7]);
                __builtin_nontemporal_store(w, (GAS u32x4*)(rec + ML_ST + (i * 64 + 8 * c) * 2));
                u32x4 wq; wq.x = qlo.x; wq.y = qlo.y; wq.z = qhi.x; wq.w = qhi.y;
                __builtin_nontemporal_store(wq, (GAS u32x4*)(rec + ML_Q + (i * 64 + 8 * c) * 2));
            }
#pragma unroll
            for (int gg = 0; gg < 1; ++gg) {
                const int PP = 8 * wave + rsub + 64 * gg, d = PP >> 5, i0 = 2 * (PP & 31);
                const LAS float* vec = (const LAS float*)(L + MVEC_OFF + d * 1024);
                GAS unsigned char* rec = F.ws + WS_ML + ((size_t)item * 2 + d) * MLREC;
                const f32x4 ew0 = *(const LAS f32x4*)(vec + 128 + 8 * c), ew1 = *(const LAS f32x4*)(vec + 128 + 8 * c + 4);
                float ra[8], rb[8];
#pragma unroll
                for (int e = 0; e < 8; ++e) { const int j = 8 * c + e, tj = d ? 63 - j : j; const float ew = (e < 4) ? ew0[e & 3] : ew1[e & 3];
                    const unsigned u = *(const LAS unsigned*)(L + MK_OFF + tj * MQROW + 2 * i0);
                    ra[e] = BLO_(u) * ew; rb[e] = BHI_(u) * ew; }
                u32x4 w; w.x = cvt_pk_bf16(ra[0], ra[1]); w.y = cvt_pk_bf16(ra[2], ra[3]); w.z = cvt_pk_bf16(ra[4], ra[5]); w.w = cvt_pk_bf16(ra[6], ra[7]);
                __builtin_nontemporal_store(w, (GAS u32x4*)(rec + ML_KWT + (i0 * 64 + 8 * c) * 2));
                w.x = cvt_pk_bf16(rb[0], rb[1]); w.y = cvt_pk_bf16(rb[2], rb[3]); w.z = cvt_pk_bf16(rb[4], rb[5]); w.w = cvt_pk_bf16(rb[6], rb[7]);
                __builtin_nontemporal_store(w, (GAS u32x4*)(rec + ML_KWT + ((i0 + 1) * 64 + 8 * c) * 2));
            }
#undef BLO_
#undef BHI_
            for (int it = wave; it < 36; it += NWAVES) {
                const int d = it / 18, q = it - 18 * d, slice = q >> 1, s2 = q & 1;
                GAS unsigned char* rec = F.ws + WS_ML + ((size_t)item * 2 + d) * MLREC;
                const int fr = lane & 15, fq = lane >> 4;
                unsigned short e8[8];
#pragma unroll
                for (int el = 0; el < 8; ++el) { const int j = 32 * s2 + 8 * fq + el; const int tj = d ? 63 - j : j;
                    e8[el] = (slice < 8) ? *(const LAS unsigned short*)(L + MV_OFF + tj * QROW + 2 * (16 * slice + fr)) : (unsigned short)0x3F80; }
                u32x4 w; w.x = e8[0] | ((unsigned)e8[1] << 16); w.y = e8[2] | ((unsigned)e8[3] << 16); w.z = e8[4] | ((unsigned)e8[5] << 16); w.w = e8[6] | ((unsigned)e8[7] << 16);
                __builtin_nontemporal_store(w, (GAS u32x4*)(rec + ML_VF + (((slice * 2 + s2) * 64 + lane) * 8) * 2));
            }
        }
        PREP_BAR();
        }
    }
}
constexpr int MLBUF = 25600;
__device__ __forceinline__ void ml_scan(const Frame& F) {
    if (F.wg >= 96) return;
    const int xcd = F.wg & 7, idx = F.wg >> 3;
    const int chain = xcd * 4 + idx / 3, third = idx % 3;
    const int b = chain >> 3, h = (chain >> 1) & 3, d = chain & 1;
    const int lane = F.lane, fr = lane & 15, fq = lane >> 4, wave = F.wave;
    LAS unsigned char* L = F.lds;
    const GAS unsigned char* recbase = F.ws + WS_ML;
    const int itembase = (b * NHEAD + h) * NCH;
    if (wave >= 3) {
        const int tl = F.tid - 192;
        u32x4 ra[5], rb[5]; int woff[5], goff[5];
#pragma unroll
        for (int i = 0; i < 5; ++i) { const int q = tl + 320 * i;
            if (q < 1536) { const int qq = q & 511; woff[i] = (q >> 9) * 8192 + swz128(qq >> 3, qq & 7); goff[i] = q; }
            else { woff[i] = 24576 + (q - 1536) * 16; goff[i] = 2688 + (q - 1536); } }
#define ML_LOAD(R, step_) do { const int st_ = (step_) < NCH ? (step_) : NCH - 1; const int n_ = d ? (NCH - 1 - st_) : st_; \
        const GAS u32x4* src_ = (const GAS u32x4*)(recbase + ((size_t)(itembase + n_) * 2 + d) * MLREC); \
        _Pragma("unroll") for (int i = 0; i < 5; ++i) R[i] = src_[goff[i]]; } while (0)
#define ML_WRITE(R, bufoff_) do { _Pragma("unroll") for (int i = 0; i < 5; ++i) *(LAS u32x4*)(L + (bufoff_) + woff[i]) = R[i]; } while (0)
        ML_LOAD(ra, 0); ML_LOAD(rb, 1);
        ML_WRITE(ra, 0);
        SCAN_BAR();
        for (int s = 0; s < NCH; s += 2) {
            ML_LOAD(ra, s + 2); ML_WRITE(rb, MLBUF); SCAN_BAR();
            ML_LOAD(rb, s + 3); ML_WRITE(ra, 0);     SCAN_BAR();
        }
#undef ML_LOAD
#undef ML_WRITE
        return;
    }
    const int slice = third * 3 + wave;
    const bool active = true;
    GAS bf16* NUM = (GAS bf16*)(F.ws + (d ? WS_NUMB : WS_NUMF)); GAS float* DEN = (GAS float*)(F.ws + WS_DEN);
    f32x4 C[4];
#pragma unroll
    for (int k = 0; k < 4; ++k) C[k] = (f32x4){0.f, 0.f, 0.f, 0.f};
    float m = 0.f;
    int offr[4];
#pragma unroll
    for (int t = 0; t < 4; ++t) offr[t] = ((16 * t + fr) >> 1) * 256;
    const int p128 = (fr & 1) << 3;
    bf16x8 vc0, vc1, vn0, vn1;
#define ML_VFETCH(A0, A1, step_) do { const int st_ = (step_) < NCH ? (step_) : NCH - 1; const int nn_ = d ? (NCH - 1 - st_) : st_; \
        const GAS bf16* Vf_ = (const GAS bf16*)(recbase + ((size_t)(itembase + nn_) * 2 + d) * MLREC + ML_VF); \
        A0 = *(const GAS bf16x8*)(Vf_ + ((slice * 2 + 0) * 64 + lane) * 8); A1 = *(const GAS bf16x8*)(Vf_ + ((slice * 2 + 1) * 64 + lane) * 8); } while (0)
    ML_VFETCH(vc0, vc1, 0); ML_VFETCH(vn0, vn1, 1);
    SCAN_BAR();
    for (int step = 0; step < NCH; ++step) {
        const int n = d ? (NCH - 1 - step) : step;
        const int bufoff = (step & 1) ? MLBUF : 0;
        bf16x8 VF[2]; VF[0] = vc0; VF[1] = vc1;
        vc0 = vn0; vc1 = vn1;
        ML_VFETCH(vn0, vn1, step + 2);
        if (active) {
        const LAS unsigned char* Bq = L + bufoff; const LAS unsigned char* Bs = Bq + 8192; const LAS unsigned char* Bk = Bq + 16384; const LAS float* row = (const LAS float*)(Bq + 24576);
        const float am = row[128], bl = row[129];
        bf16x8 CB[2];
#pragma unroll
        for (int s = 0; s < 2; ++s) CB[s] = pack_b(C[2 * s], C[2 * s + 1]);
        bf16x8 fq_[8], fs_[8], fk_[8];
#pragma unroll
        for (int s = 0; s < 2; ++s)
#pragma unroll
            for (int mt = 0; mt < 4; ++mt) { const int xr = (8 * mt + (fr >> 1)) & 15; const int o = offr[mt] + (((p128 | (4 * s + fq)) ^ xr) << 4);
                fq_[s * 4 + mt] = *(const LAS bf16x8*)(Bq + o); fs_[s * 4 + mt] = *(const LAS bf16x8*)(Bs + o); fk_[s * 4 + mt] = *(const LAS bf16x8*)(Bk + o); }
        f32x4 QC[4], SV[4], KV[4];
#pragma unroll
        for (int mt = 0; mt < 4; ++mt) { QC[mt] = (f32x4){0.f, 0.f, 0.f, 0.f}; SV[mt] = (f32x4){0.f, 0.f, 0.f, 0.f}; KV[mt] = (f32x4){0.f, 0.f, 0.f, 0.f}; }
#pragma unroll
        for (int s = 0; s < 2; ++s)
#pragma unroll
            for (int mt = 0; mt < 4; ++mt) {
                QC[mt] = __builtin_amdgcn_mfma_f32_16x16x32_bf16(CB[s], fq_[s * 4 + mt], QC[mt], 0, 0, 0);
                SV[mt] = __builtin_amdgcn_mfma_f32_16x16x32_bf16(VF[s], fs_[s * 4 + mt], SV[mt], 0, 0, 0);
                KV[mt] = __builtin_amdgcn_mfma_f32_16x16x32_bf16(fk_[s * 4 + mt], VF[s], KV[mt], 0, 0, 0);
            }
#pragma unroll
        for (int mt = 0; mt < 4; ++mt) {
            const int i = 16 * mt + fr; const int tok = b * SEQ + n * CH + (d ? 63 - i : i);
            const float bci = row[i], dmi = row[64 + i];
            const float il = bci + m, mo = fmaxf(il, dmi);
            const float inter = fexp(il - mo), e2 = fexp(dmi - mo);
            const f32x4 res = QC[mt] * inter + SV[mt] * e2;
            if (slice < 8) { u32x2 w2; w2.x = cvt_pk_bf16(res[0], res[1]); w2.y = cvt_pk_bf16(res[2], res[3]); *(GAS u32x2*)(NUM + (size_t)tok * MIXW + h * HD + slice * 16 + 4 * fq) = w2; }
            else if (fq == 0) DEN[(size_t)tok * 8 + h * 2 + d] = fmaxf(fabsf(res[0]), fexp(-mo));
        }
        const float mn = fmaxf(bl + m, am), sp = fexp(bl + m - mn), sc = fexp(am - mn);
#pragma unroll
        for (int kt = 0; kt < 4; ++kt) C[kt] = C[kt] * sp + KV[kt] * sc;
        m = mn;
        }
        SCAN_BAR();
    }
}

template <int H>
__device__ __forceinline__ void pool_block(const GAS bf16* U, GAS bf16* Y, int t0, int g, int lane) {
    constexpr int NR = 32 + 2 * H;
    const int sp0 = t0 & (SEQ - 1);
    float x0[NR], x1[NR];
#pragma unroll
    for (int r = 0; r < NR; ++r) {
        const int sp = sp0 - H + r; const bool ok = (sp >= 0 && sp < SEQ);
        const unsigned u = ok ? *(const GAS unsigned*)(U + (size_t)(t0 - H + r) * MIXW + 128 * g + 2 * lane) : 0u;
        x0[r] = bf2f(u & 0xffffu); x1[r] = bf2f(u >> 16);
    }
    float s0 = 0.f, s1 = 0.f;
#pragma unroll
    for (int r = 0; r < 2 * H; ++r) { s0 += x0[r]; s1 += x1[r]; }
#pragma unroll
    for (int t = 0; t < 32; ++t) {
        const int sp = sp0 + t; const int cnt = min(sp + H, SEQ) - max(sp - H, 0);
        const float inv = 1.0f / (float)cnt;
        *(GAS unsigned*)(Y + (size_t)(t0 + t) * MIXW + 128 * g + 2 * lane) = cvt_pk_bf16(s0 * inv - x0[t + H], s1 * inv - x1[t + H]);
        if (t < 31) { s0 += x0[t + 2 * H] - x0[t]; s1 += x1[t + 2 * H] - x1[t]; }
    }
}
__device__ __forceinline__ void pool_phase(const Frame& F, int wg0, int nwg) {
    const GAS bf16* U = (const GAS bf16*)(F.ws + WS_PPOOL); GAS bf16* Y = (GAS bf16*)(F.ws + WS_YP);
    const int gw = (F.wg - wg0) * NWAVES + F.wave, NGW = nwg * NWAVES, lane = F.lane;
    for (int prep = 0; prep < POOLREP; ++prep)
    for (int task = gw; task < (T / 32) * 4; task += NGW) {
        const int g = task & 3, t0 = (task >> 2) * 32;
        if (g == 0) pool_block<1>(U, Y, t0, g, lane); else if (g == 1) pool_block<2>(U, Y, t0, g, lane); else if (g == 2) pool_block<4>(U, Y, t0, g, lane); else pool_block<8>(U, Y, t0, g, lane);
    }
}

__device__ __forceinline__ void norm_phase(const Frame& F, int l, bool dummy, const int which, const int wg0, const int nwg) {
    const GAS bf16* OF = (const GAS bf16*)(F.ws + WS_OF); const GAS bf16* OB = (const GAS bf16*)(F.ws + WS_OB);
    const GAS bf16* NF = (const GAS bf16*)(F.ws + WS_NUMF); const GAS bf16* NBk = (const GAS bf16*)(F.ws + WS_NUMB); const GAS float* DEN = (const GAS float*)(F.ws + WS_DEN);
    GAS bf16* Z = (GAS bf16*)(F.ws + WS_PZ); GAS bf16* MO = (GAS bf16*)(F.ws + WS_PMO);
    GAS bf16* ZO = dummy ? (GAS bf16*)(F.ws + WS_GATE) : Z; GAS bf16* MOO = dummy ? (GAS bf16*)(F.ws + WS_GATE + 32 * MiB) : MO;
    const int gw = (F.wg - wg0) * NWAVES + F.wave, NGW = nwg * NWAVES, lane = F.lane, h = lane >> 4;
    float nw[8], mw[8];
#pragma unroll
    for (int e = 0; e < 8; ++e) { nw[e] = inp(F, I_DN_NORM)[l * MIXW + 8 * lane + e]; mw[e] = inp(F, I_ML_NORM)[l * MIXW + 8 * lane + e]; }
    for (int t0 = gw; t0 < T; t0 += 4 * NGW) {
        u32x4 ra[4], rb[4], rc[4]; float df[4], db[4];
#pragma unroll
        for (int j = 0; j < 4; ++j) { const int t = t0 + j * NGW; if (t < T) { const size_t off = (size_t)t * MIXW + 8 * lane;
            if (which != 2) { ra[j] = __builtin_nontemporal_load((const GAS u32x4*)(OF + off)); rb[j] = __builtin_nontemporal_load((const GAS u32x4*)(OB + off)); rc[j] = __builtin_nontemporal_load((const GAS u32x4*)(Z + off)); }
            else { ra[j] = __builtin_nontemporal_load((const GAS u32x4*)(NF + off)); rb[j] = __builtin_nontemporal_load((const GAS u32x4*)(NBk + off)); rc[j] = __builtin_nontemporal_load((const GAS u32x4*)(MO + off)); df[j] = DEN[(size_t)t * 8 + h * 2]; db[j] = DEN[(size_t)t * 8 + h * 2 + 1]; } } }
#pragma unroll
        for (int j = 0; j < 4; ++j) { const int t = t0 + j * NGW; if (t < T) { const size_t off = (size_t)t * MIXW + 8 * lane;
        if (which != 2) {
            float a[8], bq[8], z[8]; unpack8(ra[j], a); unpack8(rb[j], bq); unpack8(rc[j], z);
            float ss = 0.f;
#pragma unroll
            for (int e = 0; e < 8; ++e) { a[e] += bq[e]; ss += a[e] * a[e]; }
            ss += __shfl_xor(ss, 1); ss += __shfl_xor(ss, 2); ss += __shfl_xor(ss, 4); ss += __shfl_xor(ss, 8);
            const float r = __builtin_amdgcn_rsqf(ss * (1.f / HD) + NORM_EPS);
            float o[8];
#pragma unroll
            for (int e = 0; e < 8; ++e) o[e] = a[e] * r * nw[e] * (z[e] * fast_sigmoid(z[e]));
            u32x4 w; w.x = cvt_pk_bf16(o[0], o[1]); w.y = cvt_pk_bf16(o[2], o[3]); w.z = cvt_pk_bf16(o[4], o[5]); w.w = cvt_pk_bf16(o[6], o[7]);
            __builtin_nontemporal_store(w, (GAS u32x4*)(ZO + off));
        } else {
            float a[8], bq[8], g[8]; unpack8(ra[j], a); unpack8(rb[j], bq); unpack8(rc[j], g);
            const float dfi = __builtin_amdgcn_rcpf(df[j]), dbi = __builtin_amdgcn_rcpf(db[j]);
            float s = 0.f;
#pragma unroll
            for (int e = 0; e < 8; ++e) { a[e] = a[e] * dfi + bq[e] * dbi; s += a[e]; }
            s += __shfl_xor(s, 1); s += __shfl_xor(s, 2); s += __shfl_xor(s, 4); s += __shfl_xor(s, 8);
            const float mean = s * (1.f / HD); float ss = 0.f;
#pragma unroll
            for (int e = 0; e < 8; ++e) { a[e] -= mean; ss += a[e] * a[e]; }
            ss += __shfl_xor(ss, 1); ss += __shfl_xor(ss, 2); ss += __shfl_xor(ss, 4); ss += __shfl_xor(ss, 8);
            const float r = __builtin_amdgcn_rsqf(ss * (1.f / HD) + NORM_EPS);
            float o[8];
#pragma unroll
            for (int e = 0; e < 8; ++e) o[e] = a[e] * r * mw[e] * fast_sigmoid(g[e]);
            u32x4 w; w.x = cvt_pk_bf16(o[0], o[1]); w.y = cvt_pk_bf16(o[2], o[3]); w.z = cvt_pk_bf16(o[4], o[5]); w.w = cvt_pk_bf16(o[6], o[7]);
            __builtin_nontemporal_store(w, (GAS u32x4*)(MOO + off));
        } } }
    }
}

__device__ __forceinline__ void moe_tables(const Frame& F) {
    LAS int* cnt = (LAS int*)(F.lds + LHIST_OFF + 128); LAS int* pstart = (LAS int*)(F.lds + LHIST_OFF + 256); LAS int* mybase = (LAS int*)(F.lds + LHIST_OFF + 384);
    LAS int* pe = (LAS int*)(F.lds + LPE_OFF);
    const GAS int* hist = (const GAS int*)(F.ws + WS_HIST);
    if (F.tid < 32) { cnt[F.tid] = 0; mybase[F.tid] = 0; }
    __syncthreads();
    { const int e = F.tid & 31, part = F.tid >> 5; int tot = 0, base = 0;
      for (int q = 0; q < 16; ++q) { const int w = part * 16 + q; const int v = hist[w * 32 + e]; tot += v; base += v * min(max(F.wg - w, 0), 1); }
      __hip_atomic_fetch_add(cnt + e, tot, __ATOMIC_RELAXED, __HIP_MEMORY_SCOPE_WORKGROUP); __hip_atomic_fetch_add(mybase + e, base, __ATOMIC_RELAXED, __HIP_MEMORY_SCOPE_WORKGROUP); }
    __syncthreads();
    if (F.tid < 32) {
        const int e = F.tid; const int np = (cnt[e] + 255) >> 8; int inc = np;
#pragma unroll
        for (int o = 1; o < 32; o <<= 1) { const int t = __shfl_up(inc, o); if (e >= o) inc += t; }
        const int exc = inc - np;
        pstart[e] = exc * 256;
        for (int q = 0; q < np; ++q) pe[exc + q] = e;
        if (e == 31) pe[319] = inc;
    }
    __syncthreads();
}
__device__ __forceinline__ void moe_dispatch(const Frame& F) {
    moe_tables(F);
    LAS int* pstart = (LAS int*)(F.lds + LHIST_OFF + 256); LAS int* mybase = (LAS int*)(F.lds + LHIST_OFF + 384);
    LAS int* lpos = (LAS int*)(F.lds);
    LAS int* le = (LAS int*)(F.lds + 1024);
    const GAS int* eid = (const GAS int*)(F.ws + WS_EID); const GAS float* ew = (const GAS float*)(F.ws + WS_EW);
    GAS int* pos = (GAS int*)(F.ws + WS_POS); GAS float* roww = (GAS float*)(F.ws + WS_ROWW);
    const int rows_per_wg = T / F.G, row0 = F.wg * rows_per_wg;
    int my_e = 0; float my_w = 0.f;
    if (F.tid < 256) { my_e = eid[2 * row0 + F.tid]; my_w = ew[2 * row0 + F.tid]; le[F.tid] = my_e; }
    __syncthreads();
    if (F.tid < 256) {
        int rank = 0;
        for (int a = 0; a < F.tid; ++a) rank += (le[a] == my_e) ? 1 : 0;
        const int p = pstart[my_e] + mybase[my_e] + rank;
        lpos[F.tid] = p; pos[2 * row0 + F.tid] = p; roww[p] = my_w; ((GAS int*)(F.ws + WS_ROWTOK))[p] = row0 + (F.tid >> 1);
    }
    __syncthreads();
    if (F.wg < 32) { LAS int* cnt = (LAS int*)(F.lds + LHIST_OFF + 128); const int e = F.wg; const int c0 = cnt[e], pc = (c0 + 255) & ~255;
        GAS int* rt = (GAS int*)(F.ws + WS_ROWTOK); _Pragma("clang loop vectorize(disable) unroll(disable)") for (int q = c0 + F.tid; q < pc; q += NWAVES * 64) rt[pstart[e] + q] = 0; }
    __syncthreads();
}

#ifndef DIAG_WPH
#define DIAG_WPH 4
#endif
constexpr int NPP = 14;
constexpr int NPHASE = 1 + NPP * DEPTH;
#ifndef PHM
#define PHM 0xFFFF
#endif
#define PHON(b) ((PHM >> (b)) & 1)
#ifndef REPEAT_PHASE
#define REPEAT_PHASE -1
#endif
#define NREP(k) (((k) == REPEAT_PHASE) ? 2 : 1)
__global__ void __launch_bounds__(NWAVES * 64, 2) mega_fwd(Args args) {
    extern __shared__ __attribute__((aligned(16))) unsigned char lds_raw[];
    LAS unsigned char* lds = (LAS unsigned char*)lds_raw;
    const int wave = __builtin_amdgcn_readfirstlane((int)threadIdx.x >> 6);
    for (int u = threadIdx.x; u < (LDS_BYTES - RING_BYTES) / 4; u += NWAVES * 64) ((LAS unsigned*)(lds + RING_BYTES))[u] = 0u;
    __syncthreads();
    if (threadIdx.x == 0) { LAS unsigned long long* ap = (LAS unsigned long long*)(lds + LARG_OFF);
#pragma unroll
        for (int i = 0; i < 23; ++i) ap[i] = (unsigned long long)args.in[i];
        ap[23] = (unsigned long long)args.out; ap[24] = (unsigned long long)args.ws; }
    __syncthreads();
    const int lo = args.ph_lo, hi = args.ph_hi;
    if (hi - lo > 1) { const XcdBarrier b0 = xcd_barrier_post((unsigned*)(args.ws + WS_CTL) + CW_BAR, (volatile LAS unsigned*)(lds + MISC_OFF) + 8);
        if (threadIdx.x == 0) ((volatile LAS unsigned*)(lds + MISC_OFF))[10] = b0.x; }
    __syncthreads();
#ifdef DIAG
    if (threadIdx.x == 0 && blockIdx.x == 0 && lo == 0) ((unsigned long long*)(args.ws + WS_CTL + 1024))[0] = __builtin_amdgcn_s_memrealtime();
#endif
    int ph = lo, rep = 0;
#pragma unroll 1
    while (ph < hi) {
        const Frame F = fresh(lds, wave);
        const bool DRY = (REPEAT_PHASE >= 0) && (rep == 0) && (((ph >= 1) ? ((ph - 1) % NPP) : 15) == REPEAT_PHASE);
        const int l = (ph >= 1) ? (ph - 1) / NPP : 0;
        const int k = (ph >= 1) ? (ph - 1) - NPP * l : 15;
        if (PHON(15) && k == 15) {
            wprep_mixer(F, 0);
            __syncthreads();
#ifdef DIAG
            if (F.tid == 0 && F.wg == 0) { unsigned long long* st_ = (unsigned long long*)(F.ws + WS_CTL + 1024); st_[60] = __builtin_amdgcn_s_memrealtime() - st_[0]; }
#endif
            ln_phase<0>(F, inp(F, I_LN_IN_G), inp(F, I_LN_IN_B), inp(F, I_W_IN), DIN, true, true, DRY);
        } else if (PHON(0) && k == 0) {
            pg8::StaticOrder S; S.init(F.ws + WS_HB, F.ws + WS_WIN, T, 1536, D, F.G, F.wg);
            EpiG1a E{(GAS bf16*)(F.ws + WS_PQKV)};
            pg8::gemm_phase<EpiG1a, pg8::StaticOrder>(F.lds, F.tid, D, S, E);
        } else if (PHON(1) && k == 1) { dn_prep(F, l);
        } else if (PHON(3) && k == 3) {
            pg8::StaticOrder S; S.init(F.ws + WS_HB, F.ws + WS_WIN + (size_t)1536 * D * 2, T, 2560, D, F.G, F.wg);
            EpiG1b E{F.ws};
            pg8::gemm_phase<EpiG1b, pg8::StaticOrder>(F.lds, F.tid, D, S, E);
        } else if (PHON(4) && k == 4) { ml_prep(F, l);
        } else if (PHON(5) && k == 5) {
            if (F.wg < 96) ml_scan(F); else { norm_phase(F, l, false, 1, 96, 160); if (F.wg >= 192) wprep_moe(F, l, 192, 64); else pool_phase(F, 96, 96); }
        } else if ((PHON(2) && k == 2) || (PHON(6) && k == 6)) {
            if (k == 2 && F.wg < 128) dn_scan(F);
            else {
                if (k == 6) norm_phase(F, l, DRY, 2, 0, 256);
                pg8::StaticOrder S; EpiGate E;
                if (k == 2) { S.init(F.ws + WS_HB, F.ws + WS_WGATE, T, 1536, D, 128, F.wg - 128); E.O0 = (GAS bf16*)F.out; E.ld0 = 1024; E.O1 = (GAS bf16*)(F.ws + WS_G1A); E.ld1 = 512; E.psplit = 4; }
                else { S.init(F.ws + WS_HB, F.ws + WS_WGATE + (size_t)1536 * D * 2, T, 1536, D, F.G, F.wg); E.O0 = (GAS bf16*)(F.ws + WS_GATE); E.ld0 = 1536; E.O1 = E.O0; E.ld1 = 1536; E.psplit = 0; }
                pg8::gemm_phase<EpiGate, pg8::StaticOrder>(F.lds, F.tid, D, S, E);
            }
        } else if (PHON(7) && k == 7) {
            MergeOrder S; S.Y[0] = (const GAS char*)(F.ws + WS_PZ); S.Y[1] = (const GAS char*)(F.ws + WS_YP); S.Y[2] = (const GAS char*)(F.ws + WS_PMO); S.W = (const GAS char*)(F.ws + WS_WBR); S.G = F.G; S.c = F.wg;
            EpiMerge E{(const GAS bf16*)F.out, (const GAS bf16*)(F.ws + WS_G1A), (const GAS bf16*)(F.ws + WS_GATE), (GAS bf16*)(F.ws + WS_FIN)};
            pg8::gemm_phase<EpiMerge, MergeOrder>(F.lds, F.tid, MIXW, S, E);
        } else if (PHON(8) && k == 8) {
            pg8::StaticOrder S; S.init(F.ws + WS_FIN, F.ws + WS_WOUT, T, D, D, F.G, F.wg);
            EpiOut E{(const GAS bf16*)(F.ws + WS_HB), DRY ? (GAS bf16*)(F.ws + WS_R2) : (GAS bf16*)F.out};
            pg8::gemm_phase<EpiOut, pg8::StaticOrder>(F.lds, F.tid, D, S, E);
        } else if (PHON(9) && k == 9) {
            ln_phase<1>(F, inp(F, I_LN_MIX_G) + l * D, inp(F, I_LN_MIX_B) + l * D, inp(F, I_ROUTER_W), 32, true, true, DRY);
        } else if (PHON(10) && k == 10) { moe_dispatch(F);
        } else if (PHON(11) && k == 11) {
            MoeOrder<D, true> S; S.rowtok = (const GAS int*)(F.ws + WS_ROWTOK); S.A = (const GAS char*)(F.ws + WS_HB); S.W = (const GAS char*)((GAS unsigned char*)F.out + 64 * MiB); S.pe = (const LAS int*)(F.lds + LPE_OFF); S.c = F.wg; S.NP = __builtin_amdgcn_readfirstlane(S.pe[319]);
            EpiMoe1 E{(GAS bf16*)(F.ws + WS_ACT)};
            pg8::gemm_phase<EpiMoe1, MoeOrder<D, true>>(F.lds, F.tid, D, S, E);
            if (l + 1 < DEPTH) {
                const int ppx4 = ((S.NP + 7) >> 3) * 4, rounds = (ppx4 + 31) >> 5, jrem = ppx4 - ((rounds - 1) << 5);
                const int wg0 = (jrem >= 24) ? 0 : 8 * jrem;
                if (F.wg >= wg0) wprep_mixer(F, l + 1, wg0, 256 - wg0);
            }
        } else if (PHON(12) && k == 12) {
            MoeOrder<DEXP, false> S; S.rowtok = nullptr; S.A = (const GAS char*)(F.ws + WS_ACT); S.W = (const GAS char*)(F.ws + WS_W2); S.pe = (const LAS int*)(F.lds + LPE_OFF); S.c = F.wg; S.NP = __builtin_amdgcn_readfirstlane(S.pe[319]);
            EpiMoe2 E{(GAS bf16*)(F.ws + WS_YROWS), (const GAS float*)(F.ws + WS_ROWW)};
            pg8::gemm_phase<EpiMoe2, MoeOrder<DEXP, false>>(F.lds, F.tid, DEXP, S, E);
        } else if (PHON(13)) {
            const bool last = (l == DEPTH - 1);
            ln_phase<2>(F, inp(F, I_LN_FFN_G) + l * D, inp(F, I_LN_FFN_B) + l * D, inp(F, I_W_IN) + (size_t)(last ? l : l + 1) * D * DIN, DIN, !last, !last, DRY);
        }
#ifdef DIAG
        if (F.tid == 0 && ph == DIAG_WPH) ((unsigned long long*)(F.ws + WS_CTL + 4096))[F.wg] = __builtin_amdgcn_s_memrealtime();
#endif
        const bool again = (k == REPEAT_PHASE) && (rep == 0);
        if (again) rep = 1; else { rep = 0; ++ph; }
        if (ph < hi) { XcdBarrier bar; bar.bar = (unsigned*)(unsigned char*)(F.ws + WS_CTL) + CW_BAR; bar.st = (volatile LAS unsigned*)(F.lds + MISC_OFF) + 8; bar.x = __builtin_amdgcn_readfirstlane(bar.st[2]); xcd_barrier(bar, F.tid); }
#ifdef DIAG
        if (!again && F.tid == 0 && F.wg == 0) ((unsigned long long*)(F.ws + WS_CTL + 1024))[ph] = __builtin_amdgcn_s_memrealtime();
#endif
    }
}

#if defined(DIAG) && DIAG >= 200
__global__ void diag_spin(unsigned char* ws, int p) {
    const unsigned long long* st = (const unsigned long long*)(ws + WS_CTL + 1024);
    unsigned long long dt = ((p >= 48) ? st[p] : (st[p + 1] - st[p])) * 4ull;
    if (p >= 100) { const unsigned long long* tw = (const unsigned long long*)(ws + WS_CTL + 4096); unsigned long long mx = 0, sm = 0; for (int i = 0; i < 256; ++i) { const unsigned long long v = tw[i] - st[DIAG_WPH]; mx = v > mx ? v : mx; sm += v; }
        dt = (p == 100) ? (mx - sm / 256) * 4ull : (sm / 256) * 4ull; }
    const unsigned long long t0 = __builtin_amdgcn_s_memrealtime();
    while (__builtin_amdgcn_s_memrealtime() - t0 < dt) { __builtin_amdgcn_s_sleep(8); }
}
#endif
#ifndef N_LAUNCH_MODE
#define N_LAUNCH_MODE 1
#endif
extern "C" void kernel_launch(void* const* d_in, const int* in_sizes, int n_in, void* d_out, int out_size, void* d_ws, size_t ws_size, hipStream_t stream) {
    static int grid = 0;
    if (grid == 0) {
        if (n_in != 23 || out_size != T * D || ws_size < WS_END2) { fprintf(stderr, "kernel_launch: unexpected shapes (n_in %d out %d ws %zu)\n", n_in, out_size, ws_size); grid = -1; return; }
        int dev = 0, cus = 0, per_cu = 0;
        if (hipGetDevice(&dev) != hipSuccess || hipDeviceGetAttribute(&cus, hipDeviceAttributeMultiprocessorCount, dev) != hipSuccess) { grid = -1; return; }
        if (hipFuncSetAttribute((const void*)mega_fwd, hipFuncAttributeMaxDynamicSharedMemorySize, LDS_BYTES) != hipSuccess) { fprintf(stderr, "kernel_launch: hipFuncSetAttribute failed\n"); grid = -1; return; }
        (void)hipOccupancyMaxActiveBlocksPerMultiprocessor(&per_cu, (const void*)mega_fwd, NWAVES * 64, LDS_BYTES);
        (void)hipGetLastError();
        grid = cus;
        if (grid != 256) { fprintf(stderr, "kernel_launch: built for 256 CUs, got %d\n", cus); grid = -1; return; }
    }
    if (grid < 0) return;
    (void)hipMemsetAsync((char*)d_ws + WS_CTL, 0, CTL_ZERO_BYTES, stream);
    Args a{};
    for (int i = 0; i < 23; ++i) a.in[i] = (const float*)d_in[i];
    a.out = (float*)d_out; a.ws = (unsigned char*)d_ws;
#if defined(DIAG) && DIAG >= 200
    {
        a.ph_lo = 0; a.ph_hi = NPHASE;
        hipLaunchKernelGGL(mega_fwd, dim3(grid), dim3(NWAVES * 64), LDS_BYTES, stream, a);
        hipLaunchKernelGGL(diag_spin, dim3(1), dim3(64), 0, stream, (unsigned char*)d_ws, (int)(DIAG - 200));
    }
#elif defined(DIAG) && DIAG >= 100
    {
        a.ph_lo = 0; a.ph_hi = NPHASE;
        hipLaunchKernelGGL(mega_fwd, dim3(grid), dim3(NWAVES * 64), LDS_BYTES, stream, a);
        hipLaunchKernelGGL(diag_fill_t, dim3(1024), dim3(256), 0, stream, (float*)d_out, (unsigned char*)d_ws, out_size, (int)(DIAG - 100));
    }
#elif defined(DIAG)
    {
        const int his[12] = {0, 2, 3, 6, 15, 10, 6, 9, 2, 2, 5, 9};
        const int grids[12] = {0, 64, 2, 2, 16, 64, 64, 64, 64, 64, 64, 64}, blocks[12] = {0, 256, 128, 128, 256, 256, 256, 256, 256, 256, 256, 256};
        a.ph_lo = 0; a.ph_hi = his[DIAG];
        hipLaunchKernelGGL(mega_fwd, dim3(grid), dim3(NWAVES * 64), LDS_BYTES, stream, a);
        static int once = 0; if (!once) { once = 1; (void)hipFuncSetAttribute((const void*)diag_kernel, hipFuncAttributeMaxDynamicSharedMemorySize, 81920); }
        DArgs da{}; for (int i = 0; i < 23; ++i) da.in[i] = (const float*)d_in[i]; da.out = (float*)d_out; da.ws = (unsigned char*)d_ws; da.mode = DIAG; da.pad = 0;
        hipLaunchKernelGGL(diag_kernel, dim3(grids[DIAG]), dim3(blocks[DIAG]), 81920, stream, da);
        if (DIAG == 2 || DIAG == 3) {
            a.ph_lo = his[DIAG]; a.ph_hi = his[DIAG] + 1;
            hipLaunchKernelGGL(mega_fwd, dim3(grid), dim3(NWAVES * 64), LDS_BYTES, stream, a);
            da.mode = DIAG + 10;
            hipLaunchKernelGGL(diag_kernel, dim3(2), dim3(128), 81920, stream, da);
        }
        hipLaunchKernelGGL(diag_fill, dim3(1024), dim3(256), 0, stream, (float*)d_out, (unsigned char*)d_ws, out_size);
    }
#elif N_LAUNCH_MODE == 1
    a.ph_lo = 0; a.ph_hi = NPHASE;
    hipLaunchKernelGGL(mega_fwd, dim3(grid), dim3(NWAVES * 64), LDS_BYTES, stream, a);
#else
    for (int p = 0; p < NPHASE; ++p) { a.ph_lo = p; a.ph_hi = p + 1; hipLaunchKernelGGL(mega_fwd, dim3(grid), dim3(NWAVES * 64), LDS_BYTES, stream, a); }
#endif
}
```
